# Optimizing an MI355X kernel written in HIP

```python
import jax
import jax.numpy as jnp
from jax import lax
import numpy as np

D_MODEL = 1024
BATCH = 16
SEQ = 2048
DEPTH = 2

GRID_W = 64
CTX_LEN = 256
N_MIXERS = 4
GROUP_WIDTH = D_MODEL // N_MIXERS
MIX_WIDTH = N_MIXERS * GROUP_WIDTH
HEAD_DIM = 64
HGRN_HEADS = GROUP_WIDTH // HEAD_DIM
HGRN_CHUNK = 16
CONV_WIDTH = 3
RET_HEADS = GROUP_WIDTH // HEAD_DIM
RET_CHUNK = 128
ATT_Q_HEADS = GROUP_WIDTH // HEAD_DIM
ATT_KV_HEADS = 2
ATT_GROUP = ATT_Q_HEADS // ATT_KV_HEADS
KV_WIDTH = ATT_KV_HEADS * HEAD_DIM
ATT_BLOCK_Q = 128
ROPE_THETA = 10000.0
N_EXPERT_GROUPS = 4
EXPERTS_PER_GROUP = 4
N_EXPERTS = N_EXPERT_GROUPS * EXPERTS_PER_GROUP
TOP_K_IN_GROUP = 2
D_EXPERT = D_MODEL // 2
NORM_EPS = 1e-6
SPLIT_SIZES = (GROUP_WIDTH,) * 12 + (GROUP_WIDTH, KV_WIDTH, KV_WIDTH)
IN_WIDTH = 13 * GROUP_WIDTH + 2 * KV_WIDTH

kernel_name = 'hybrid_head_group_diffusion_block'


def rms_norm(x, gain):
    xf = x.astype(jnp.float32)
    y = xf * lax.rsqrt(jnp.mean(xf * xf, axis=-1, keepdims=True) + NORM_EPS)
    return (y * gain.astype(jnp.float32)).astype(x.dtype)


def head_rms_norm(a, gain):
    b, t, w = a.shape
    af = a.astype(jnp.float32).reshape(b, t, w // HEAD_DIM, HEAD_DIM)
    af = af * lax.rsqrt(jnp.mean(af * af, axis=-1, keepdims=True) + NORM_EPS)
    return (af.reshape(b, t, w) * gain.astype(jnp.float32)).astype(a.dtype)


def modulate(h, shift, scale):
    return h * (1.0 + scale) + shift


def split_heads(a, n_heads):
    b, t, _ = a.shape
    return a.reshape(b, t, n_heads, -1).transpose(0, 2, 1, 3)


def merge_heads(a):
    b, h, t, d = a.shape
    return a.transpose(0, 2, 1, 3).reshape(b, t, h * d)


def split_columns(p):
    parts, start = [], 0
    for width in SPLIT_SIZES:
        parts.append(p[..., start:start + width])
        start += width
    return parts


def flip_time(a, direction):
    return a if direction == 0 else jnp.flip(a, axis=2)


def axial_rope_tables(rows):
    t = jnp.arange(rows * GRID_W)
    row = (t // GRID_W).astype(jnp.float32)
    col = (t % GRID_W).astype(jnp.float32)
    n_freq = HEAD_DIM // 4
    inv_freq = ROPE_THETA ** (-jnp.arange(n_freq, dtype=jnp.float32) / n_freq)
    ang = jnp.concatenate([row[:, None] * inv_freq, col[:, None] * inv_freq], axis=-1)
    return jnp.cos(ang), jnp.sin(ang)


def apply_rope(a, cos, sin):
    af = a.astype(jnp.float32).reshape(a.shape[:-1] + (HEAD_DIM // 2, 2))
    x1, x2 = af[..., 0], af[..., 1]
    out = jnp.stack([x1 * cos - x2 * sin, x1 * sin + x2 * cos], axis=-1)
    return out.reshape(a.shape).astype(a.dtype)


def gla_chunk(q, k, v, log_f, s0):
    out_dtype = v.dtype
    q, k, v, log_f = (a.astype(jnp.float32) for a in (q, k, v, log_f))
    b, h, t, dk = q.shape
    dv = v.shape[-1]
    c = HGRN_CHUNK
    n = t // c
    q, k, log_f = (a.reshape(b, h, n, c, dk) for a in (q, k, log_f))
    v = v.reshape(b, h, n, c, dv)
    cum = jnp.cumsum(log_f, axis=3)
    causal = jnp.tril(jnp.ones((c, c), dtype=bool))
    rel = cum[:, :, :, :, None, :] - cum[:, :, :, None, :, :]
    decay = jnp.exp(jnp.where(causal[:, :, None], rel, -jnp.inf))
    scores = jnp.einsum('bhntd,bhnsd,bhntsd->bhnts', q, k, decay)
    o_intra = jnp.einsum('bhnts,bhnse->bhnte', scores, v)
    last = cum[:, :, :, -1]
    chunk_kv = jnp.einsum('bhnsd,bhnse->bhnde', k * jnp.exp(last[:, :, :, None] - cum), v)

    def step(state, inp):
        kv_c, last_c = inp
        return state * jnp.exp(last_c)[..., None] + kv_c, state

    s_final, s_in = lax.scan(step, s0.astype(jnp.float32),
                             (jnp.moveaxis(chunk_kv, 2, 0), jnp.moveaxis(last, 2, 0)))
    s_in = jnp.moveaxis(s_in, 0, 2)
    o_inter = jnp.einsum('bhntd,bhnde->bhnte', q * jnp.exp(cum), s_in)
    return (o_intra + o_inter).reshape(b, h, t, dv).astype(out_dtype), s_final


def gla_final_state(k, v, log_f):
    k, v, log_f = (a.astype(jnp.float32) for a in (k, v, log_f))
    cum = jnp.cumsum(log_f, axis=2)
    return jnp.einsum('bhsd,bhse->bhde', k * jnp.exp(cum[:, :, -1:] - cum), v)


def retention_chunk(q, k, v, log_gamma, s0):
    out_dtype = v.dtype
    q, k, v = (a.astype(jnp.float32) for a in (q, k, v))
    b, h, t, dk = q.shape
    dv = v.shape[-1]
    c = RET_CHUNK
    n = t // c
    q, k = (a.reshape(b, h, n, c, dk) for a in (q, k))
    v = v.reshape(b, h, n, c, dv)
    lg = log_gamma.astype(jnp.float32)[:, None]
    pos = jnp.arange(c, dtype=jnp.float32)
    rel = pos[:, None] - pos[None, :]
    decay = jnp.where(rel >= 0, jnp.exp(lg[:, :, None] * jnp.maximum(rel, 0.0)), 0.0)
    scores = jnp.einsum('bhntd,bhnsd->bhnts', q, k) * decay[None, :, None]
    o_intra = jnp.einsum('bhnts,bhnse->bhnte', scores, v)
    k_dec = k * jnp.exp(lg * (c - 1 - pos))[None, :, None, :, None]
    chunk_kv = jnp.einsum('bhnsd,bhnse->bhnde', k_dec, v)
    chunk_decay = jnp.exp(lg[:, 0] * c)[None, :, None, None]

    def step(state, kv_c):
        return state * chunk_decay + kv_c, state

    s_final, s_in = lax.scan(step, s0.astype(jnp.float32), jnp.moveaxis(chunk_kv, 2, 0))
    s_in = jnp.moveaxis(s_in, 0, 2)
    o_inter = jnp.einsum('bhntd,bhnde->bhnte', q * jnp.exp(lg * (pos + 1.0))[None, :, None, :, None], s_in)
    return (o_intra + o_inter).reshape(b, h, t, dv).astype(out_dtype), s_final


def retention_final_state(k, v, log_gamma):
    k, v = k.astype(jnp.float32), v.astype(jnp.float32)
    length = k.shape[2]
    lg = log_gamma.astype(jnp.float32)[:, None]
    w = jnp.exp(lg * (length - 1 - jnp.arange(length, dtype=jnp.float32)))
    return jnp.einsum('bhsd,bhse->bhde', k * w[None, :, :, None], v)


def hgrn2_mixer(px, pc, lower_bound, norm_gain, with_ctx_out):
    def key_and_log_decay(z, direction):
        lb = lower_bound[direction]
        f = lb + (1.0 - lb) * jax.nn.sigmoid(z.astype(jnp.float32))
        return split_heads(1.0 - f, HGRN_HEADS), split_heads(jnp.log(f), HGRN_HEADS)

    qx, ix = split_heads(px[0], HGRN_HEADS), split_heads(px[1], HGRN_HEADS)
    ic = split_heads(pc[1], HGRN_HEADS)
    zero = jnp.zeros((ic.shape[0], HGRN_HEADS, HEAD_DIM, HEAD_DIM), jnp.float32)
    ox, oc = 0.0, 0.0
    for direction in range(2):
        kx, lfx = key_and_log_decay(px[2 + direction], direction)
        kc, lfc = key_and_log_decay(pc[2 + direction], direction)
        if with_ctx_out:
            qc = split_heads(pc[0], HGRN_HEADS)
            oc_d, s_ctx = gla_chunk(flip_time(qc, direction), flip_time(kc, direction),
                                    flip_time(ic, direction), flip_time(lfc, direction), zero)
            oc = oc + flip_time(oc_d, direction)
        else:
            s_ctx = gla_final_state(flip_time(kc, direction), flip_time(ic, direction), flip_time(lfc, direction))
        ox_d, _ = gla_chunk(flip_time(qx, direction), flip_time(kx, direction),
                            flip_time(ix, direction), flip_time(lfx, direction), s_ctx)
        ox = ox + flip_time(ox_d, direction)
    out_x = head_rms_norm(merge_heads(ox), norm_gain) * jax.nn.silu(px[4])
    out_c = head_rms_norm(merge_heads(oc), norm_gain) * jax.nn.silu(pc[4]) if with_ctx_out else None
    return out_x, out_c


def depthwise_conv_centred(u, w):
    return lax.conv_general_dilated(
        u, w[:, None, :].astype(u.dtype), window_strides=(1,),
        padding=[(CONV_WIDTH // 2, CONV_WIDTH // 2)],
        dimension_numbers=('NWC', 'WIO', 'NWC'), feature_group_count=u.shape[-1])


def short_conv_mixer(px, pc, conv_w, with_ctx_out):
    def run(p):
        b_gate, c_gate, h = p
        return b_gate * depthwise_conv_centred(c_gate * h, conv_w)
    return run(px), (run(pc) if with_ctx_out else None)


def retention_mixer(px, pc, log_gamma, norm_gain, with_ctx_out):
    scale = HEAD_DIM ** -0.5

    def qkv(p):
        return split_heads(p[0], RET_HEADS) * scale, split_heads(p[1], RET_HEADS), split_heads(p[2], RET_HEADS)

    qx, kx, vx = qkv(px)
    qc, kc, vc = qkv(pc)
    zero = jnp.zeros((kc.shape[0], RET_HEADS, HEAD_DIM, HEAD_DIM), jnp.float32)
    ox, oc = 0.0, 0.0
    for direction in range(2):
        if with_ctx_out:
            oc_d, s_ctx = retention_chunk(flip_time(qc, direction), flip_time(kc, direction),
                                          flip_time(vc, direction), log_gamma[direction], zero)
            oc = oc + flip_time(oc_d, direction)
        else:
            s_ctx = retention_final_state(flip_time(kc, direction), flip_time(vc, direction), log_gamma[direction])
        ox_d, _ = retention_chunk(flip_time(qx, direction), flip_time(kx, direction),
                                  flip_time(vx, direction), log_gamma[direction], s_ctx)
        ox = ox + flip_time(ox_d, direction)
    out_x = head_rms_norm(merge_heads(ox), norm_gain) * jax.nn.silu(px[3])
    out_c = head_rms_norm(merge_heads(oc), norm_gain) * jax.nn.silu(pc[3]) if with_ctx_out else None
    return out_x, out_c


def gqa_softmax(q, k, v):
    s = jnp.einsum('bkgqd,bknd->bkgqn', q, k, preferred_element_type=jnp.float32) * (HEAD_DIM ** -0.5)
    p = jax.nn.softmax(s, axis=-1)
    return jnp.einsum('bkgqn,bknd->bkgqd', p.astype(v.dtype), v)


def blocked_attention(q, k, v):
    b, hq, t, d = q.shape
    nb = t // ATT_BLOCK_Q
    qb = q.reshape(b, ATT_KV_HEADS, ATT_GROUP, nb, ATT_BLOCK_Q, d).transpose(3, 0, 1, 2, 4, 5)
    ob = lax.map(lambda qi: gqa_softmax(qi, k, v), qb)
    return ob.transpose(1, 2, 3, 0, 4, 5).reshape(b, hq, t, d)


def attention_mixer(px, pc, q_norm, k_norm, rope_cos, rope_sin, with_ctx_out):
    qx = apply_rope(rms_norm(split_heads(px[0], ATT_Q_HEADS), q_norm), rope_cos, rope_sin)
    kx = apply_rope(rms_norm(split_heads(px[1], ATT_KV_HEADS), k_norm), rope_cos, rope_sin)
    vx = split_heads(px[2], ATT_KV_HEADS)
    kc = rms_norm(split_heads(pc[1], ATT_KV_HEADS), k_norm)
    vc = split_heads(pc[2], ATT_KV_HEADS)
    keys = jnp.concatenate([kc, kx], axis=2)
    vals = jnp.concatenate([vc, vx], axis=2)
    out_x = merge_heads(blocked_attention(qx, keys, vals))
    out_c = None
    if with_ctx_out:
        qc = rms_norm(split_heads(pc[0], ATT_Q_HEADS), q_norm)
        b, _, length, d = qc.shape
        oc = gqa_softmax(qc.reshape(b, ATT_KV_HEADS, ATT_GROUP, length, d), kc, vc)
        out_c = merge_heads(oc.reshape(b, ATT_Q_HEADS, length, d))
    return out_x, out_c


def hierarchical_moe(h, w_rg, b_rg, w_re, b_re, w_gate, w_up, w_down):
    n = h.shape[0]
    group_prob = jax.nn.softmax((h @ w_rg + b_rg).astype(jnp.float32), axis=-1)
    group_p, group_idx = lax.top_k(group_prob, 1)
    expert_logits = (h @ w_re + b_re).astype(jnp.float32).reshape(n, N_EXPERT_GROUPS, EXPERTS_PER_GROUP)
    in_group = jnp.take_along_axis(expert_logits, group_idx[:, :, None], axis=1)[:, 0]
    expert_p, expert_idx = lax.top_k(jax.nn.softmax(in_group, axis=-1), TOP_K_IN_GROUP)
    expert_p = expert_p / jnp.sum(expert_p, axis=-1, keepdims=True)
    weights = group_p * expert_p
    expert_id = group_idx * EXPERTS_PER_GROUP + expert_idx
    combine = jnp.sum(jax.nn.one_hot(expert_id, N_EXPERTS, dtype=jnp.float32) * weights[..., None], axis=1)
    y = jnp.zeros(h.shape, jnp.float32)
    for e in range(N_EXPERTS):
        hidden = jax.nn.silu(h @ w_gate[e]) * (h @ w_up[e])
        y = y + combine[:, e:e + 1] * (hidden @ w_down[e]).astype(jnp.float32)
    return y.astype(h.dtype)


def setup_inputs(seed: int = 0) -> dict:
    key = jax.random.key(seed)
    ks = jax.random.split(key, 24)

    def nrm(k, shape, scale):
        return jax.random.normal(k, shape, jnp.float32) * scale

    ret_base_logit = jnp.log(2.0 ** (5.0 + jnp.arange(RET_HEADS, dtype=jnp.float32)) - 1.0)
    return {
        'x': nrm(ks[0], (BATCH, SEQ, D_MODEL), 1.0),
        'c': nrm(ks[1], (BATCH, D_MODEL), 1.0),
        'ctx': nrm(ks[2], (BATCH, CTX_LEN, D_MODEL), 1.0),
        'c_ctx': nrm(ks[3], (D_MODEL,), 1.0),
        'ada_w': nrm(ks[4], (DEPTH, D_MODEL, 6 * D_MODEL), 0.5 * D_MODEL ** -0.5),
        'ada_b': nrm(ks[5], (DEPTH, 6 * D_MODEL), 0.02),
        'norm_mix': 1.0 + nrm(ks[6], (DEPTH, D_MODEL), 0.02),
        'norm_ffn': 1.0 + nrm(ks[7], (DEPTH, D_MODEL), 0.02),
        'w_in': nrm(ks[8], (DEPTH, D_MODEL, IN_WIDTH), D_MODEL ** -0.5),
        'hgrn_lb_logits': nrm(ks[9], (DEPTH, 2, GROUP_WIDTH), 0.5),
        'hgrn_norm': 1.0 + nrm(ks[10], (DEPTH, GROUP_WIDTH), 0.02),
        'conv_w': nrm(ks[11], (DEPTH, CONV_WIDTH, GROUP_WIDTH), CONV_WIDTH ** -0.5),
        'ret_decay_logit': ret_base_logit + nrm(ks[12], (DEPTH, 2, RET_HEADS), 0.1),
        'ret_norm': 1.0 + nrm(ks[13], (DEPTH, GROUP_WIDTH), 0.02),
        'q_norm': 1.0 + nrm(ks[14], (DEPTH, HEAD_DIM), 0.02),
        'k_norm': 1.0 + nrm(ks[15], (DEPTH, HEAD_DIM), 0.02),
        'w_out': nrm(ks[16], (DEPTH, MIX_WIDTH, D_MODEL), MIX_WIDTH ** -0.5),
        'router_group_w': nrm(ks[17], (DEPTH, D_MODEL, N_EXPERT_GROUPS), D_MODEL ** -0.5),
        'router_group_b': nrm(ks[18], (DEPTH, N_EXPERT_GROUPS), 0.01),
        'router_expert_w': nrm(ks[19], (DEPTH, D_MODEL, N_EXPERTS), D_MODEL ** -0.5),
        'router_expert_b': nrm(ks[20], (DEPTH, N_EXPERTS), 0.01),
        'expert_w_gate': nrm(ks[21], (DEPTH, N_EXPERTS, D_MODEL, D_EXPERT), D_MODEL ** -0.5),
        'expert_w_up': nrm(ks[22], (DEPTH, N_EXPERTS, D_MODEL, D_EXPERT), D_MODEL ** -0.5),
        'expert_w_down': nrm(ks[23], (DEPTH, N_EXPERTS, D_EXPERT, D_MODEL), D_EXPERT ** -0.5),
    }


def reference(x, c, ctx, c_ctx, ada_w, ada_b, norm_mix, norm_ffn, w_in, hgrn_lb_logits, hgrn_norm,
              conv_w, ret_decay_logit, ret_norm, q_norm, k_norm, w_out, router_group_w, router_group_b,
              router_expert_w, router_expert_b, expert_w_gate, expert_w_up, expert_w_down):
    b, t, d = x.shape
    rows = t // GRID_W
    rope_cos, rope_sin = axial_rope_tables(rows)
    lb_w = jax.nn.softmax(hgrn_lb_logits.astype(jnp.float32), axis=0)
    lower_bounds = jnp.cumsum(lb_w, axis=0) - lb_w[0]
    silu_c = jax.nn.silu(c)
    silu_cc = jax.nn.silu(c_ctx)
    for layer in range(DEPTH):
        with_ctx_out = layer < DEPTH - 1
        mod_x = jnp.split(silu_c @ ada_w[layer] + ada_b[layer], 6, axis=-1)
        mod_c = jnp.split(silu_cc @ ada_w[layer] + ada_b[layer], 6, axis=-1)

        hx = modulate(rms_norm(x, norm_mix[layer]), mod_x[0][:, None], mod_x[1][:, None])
        hc = modulate(rms_norm(ctx, norm_mix[layer]), mod_c[0], mod_c[1])
        px = split_columns(hx @ w_in[layer])
        pc = split_columns(hc @ w_in[layer])
        log_gamma = jax.nn.log_sigmoid(ret_decay_logit[layer].astype(jnp.float32))
        ax, ac = hgrn2_mixer(px[0:5], pc[0:5], lower_bounds[layer], hgrn_norm[layer], with_ctx_out)
        bx, bc = short_conv_mixer(px[5:8], pc[5:8], conv_w[layer], with_ctx_out)
        rx, rc = retention_mixer(px[8:12], pc[8:12], log_gamma, ret_norm[layer], with_ctx_out)
        gx, gc = attention_mixer(px[12:15], pc[12:15], q_norm[layer], k_norm[layer], rope_cos, rope_sin,
                                 with_ctx_out)
        x = x + mod_x[2][:, None] * (jnp.concatenate([ax, bx, rx, gx], axis=-1) @ w_out[layer])

        hx2 = modulate(rms_norm(x, norm_ffn[layer]), mod_x[3][:, None], mod_x[4][:, None])
        moe_args = (router_group_w[layer], router_group_b[layer], router_expert_w[layer],
                    router_expert_b[layer], expert_w_gate[layer], expert_w_up[layer], expert_w_down[layer])
        if with_ctx_out:
            ctx = ctx + mod_c[2] * (jnp.concatenate([ac, bc, rc, gc], axis=-1) @ w_out[layer])
            hc2 = modulate(rms_norm(ctx, norm_ffn[layer]), mod_c[3], mod_c[4])
            y = hierarchical_moe(jnp.concatenate([hx2.reshape(-1, d), hc2.reshape(-1, d)], axis=0), *moe_args)
            x = x + mod_x[5][:, None] * y[:b * t].reshape(b, t, d)
            ctx = ctx + mod_c[5] * y[b * t:].reshape(ctx.shape)
        else:
            y = hierarchical_moe(hx2.reshape(-1, d), *moe_args)
            x = x + mod_x[5][:, None] * y.reshape(b, t, d)
    return x
```

```cpp
#include <hip/hip_runtime.h>
#include <hip/hip_bf16.h>
#include <cstdio>
#include <cstdint>
#include <cmath>
#ifndef DEBUG_CHECK
#define DEBUG_CHECK 0
#endif
#define DENSE_WGM 4
#ifndef NAIVE_ATTN
#define NAIVE_ATTN 0
#endif

namespace pg8 {
#define PG8_LAS __attribute__((address_space(3)))
typedef unsigned short bf16_t;
typedef short bf16x8 __attribute__((ext_vector_type(8)));
typedef float f32x4 __attribute__((ext_vector_type(4)));
typedef unsigned u32x4 __attribute__((ext_vector_type(4)));
constexpr int BM = 256, BK = 64, HALF = 128, HTB = HALF * BK * 2  , STAGE_BYTES = 8 * HTB, NXCD = 8, WGM = 8;

__host__ __device__ __forceinline__ int lds_byte(int r, int c) { const int st = (r >> 4) * 2 + (c >> 5), rr = r & 15, cc = c & 31, ob = rr * 64 + cc * 2; return st * 1024 + (ob ^ (((ob >> 9) & 1) << 5)); }
__host__ __device__ __forceinline__ void stage_rc(int b, int& R, int& C) { const int st = b / 1024, sb = b % 1024, swz = sb ^ (((sb >> 9) & 1) << 5); R = (st >> 1) * 16 + swz / 64; C = (st & 1) * 32 + (swz % 64) / 2; }
__host__ __device__ __forceinline__ void stage_rc8(int b, int& R, int& C) { const int blk = b >> 11, rr = (b >> 7) & 15, ps = (b >> 5) & 3, k = (b >> 4) & 1, gl = ps ^ ((rr >> 1) & 3); R = blk * 16 + rr; C = (gl * 2 + k) * 8; }
__host__ __device__ __forceinline__ int perm32(int rho) { const int n = rho >> 4, i = rho & 15; return 8 * (i >> 2) + 4 * n + (i & 3); }

struct Unit { const char* a; const char* b; const char* b2; int pm, pn, x0, x1; };
struct Gemm { int lda, ldb, K; const int* rowidx; };
typedef int i32x8 __attribute__((ext_vector_type(8)));
typedef int i32x4 __attribute__((ext_vector_type(4)));
__device__ __forceinline__ i32x8 pg8_cat(bf16x8 a, bf16x8 b) { const i32x4 x = __builtin_bit_cast(i32x4, a), y = __builtin_bit_cast(i32x4, b); return (i32x8){x[0], x[1], x[2], x[3], y[0], y[1], y[2], y[3]}; }
__device__ __forceinline__ unsigned cvt_pk_bf16(float lo, float hi) { unsigned r; asm volatile("v_cvt_pk_bf16_f32 %0, %1, %2" : "=v"(r) : "v"(lo), "v"(hi)); return r; }

template <class Epi, class Sched, bool ALIGN_EPI = false, bool SP2 = false, bool GATHER = false, bool FP8 = false>
__device__ __forceinline__ void gemm_phase(PG8_LAS unsigned char* lds, const Gemm g, const Sched& S, const Epi& E, const int tid) {
    const int wid = __builtin_amdgcn_readfirstlane(tid >> 6), lane = tid & 63, wr = wid >> 2, wc = wid & 3, fr = lane & 15, fq = lane >> 4;
    const int K = g.K, nt = K / BK;
    unsigned voffA[2], voffB[2];
#pragma unroll
    for (int i = 0; i < 2; ++i) { int R, C; if constexpr (FP8) stage_rc8(tid * 16 + i * 8192, R, C); else stage_rc(tid * 16 + i * 8192, R, C); const int Rb = Epi::PERM ? ((R & ~31) + perm32(R & 31)) : R;
        voffA[i] = (unsigned)(R * g.lda + C) * 2u; voffB[i] = (unsigned)(Rb * g.ldb + C) * 2u; }
    unsigned gc[2][2] = {{0u, 0u}, {0u, 0u}}, gn[2][2] = {{0u, 0u}, {0u, 0u}}; int gR[2] = {0, 0}, gC[2] = {0, 0};
    if constexpr (GATHER) {
#pragma unroll
        for (int i = 0; i < 2; ++i) { if constexpr (FP8) stage_rc8(tid * 16 + i * 8192, gR[i], gC[i]); else stage_rc(tid * 16 + i * 8192, gR[i], gC[i]); } }
#define PG8_GOFF(dst, pm_) do { _Pragma("unroll") for (int _h = 0; _h < 2; ++_h) _Pragma("unroll") for (int _i = 0; _i < 2; ++_i) { \
        int _r = g.rowidx[(size_t)((pm_) * 256 + _h * 128 + gR[_i]) * 4]; _r = _r < 0 ? 0 : _r; dst[_h][_i] = (unsigned)(_r * g.lda + gC[_i]) * 2u; } } while (0)
    const size_t kstep = (size_t)(BK * 2);
    const size_t hstepA = (size_t)HALF * g.lda * 2, hstepB = (size_t)HALF * g.ldb * 2;
    const unsigned ldsw = (unsigned)wid * 1024u;
    const int aoff = FP8 ? (wr * 4) * 2048 + fr * 128 + ((fq ^ ((fr >> 1) & 3)) * 32) : lds_byte(wr * 64 + fr, fq * 8), boff = FP8 ? (wc * 2) * 2048 + fr * 128 + ((fq ^ ((fr >> 1) & 3)) * 32) : lds_byte(wc * 32 + fr, fq * 8);
#define PG8_SA(b, h) (((b) * 2 + (h)) * HTB)
#define PG8_SB(b, h) ((4 + (b) * 2 + (h)) * HTB)
#define PG8_STAGE(bufoff, gbase, voff) do { _Pragma("unroll") for (int _i = 0; _i < 2; ++_i) \
        __builtin_amdgcn_global_load_lds((const unsigned*)((const char*)(gbase) + (voff)[_i]), (PG8_LAS unsigned*)(lds + (bufoff) + ldsw + _i * 8192), 16, 0, 0); } while (0)
#define PG8_STAGE_A(bufoff, tbase, hh, NX) do { if constexpr (GATHER) { _Pragma("unroll") for (int _i = 0; _i < 2; ++_i) { const unsigned _o = (NX) ? gn[hh][_i] : gc[hh][_i]; \
        __builtin_amdgcn_global_load_lds((const unsigned*)((const char*)(tbase) + _o), (PG8_LAS unsigned*)(lds + (bufoff) + ldsw + _i * 8192), 16, 0, 0); } } \
        else { PG8_STAGE(bufoff, (tbase) + (hh) * hstepA, voffA); } } while (0)
#define PG8_LDA(dst, b, h) do { if constexpr (FP8) { _Pragma("unroll") for (int m = 0; m < 4; ++m) dst##8[m] = *(const PG8_LAS i32x8*)(lds + PG8_SA(b, h) + aoff + m * 2048); } \
        else { _Pragma("unroll") for (int m = 0; m < 4; ++m) _Pragma("unroll") for (int k = 0; k < 2; ++k) dst[m][k] = *(const PG8_LAS bf16x8*)(lds + PG8_SA(b, h) + aoff + m * 2048 + k * 1024); } } while (0)
#define PG8_LDB(dst, b, h) do { if constexpr (FP8) { _Pragma("unroll") for (int n = 0; n < 2; ++n) dst##8[n] = *(const PG8_LAS i32x8*)(lds + PG8_SB(b, h) + boff + n * 2048); } \
        else { _Pragma("unroll") for (int n = 0; n < 2; ++n) _Pragma("unroll") for (int k = 0; k < 2; ++k) dst[n][k] = *(const PG8_LAS bf16x8*)(lds + PG8_SB(b, h) + boff + n * 2048 + k * 1024); } } while (0)
#define PG8_MMA(ai, bj, At, Bt) do { __builtin_amdgcn_s_setprio(1); if constexpr (FP8) { _Pragma("unroll") for (int m = 0; m < 4; ++m) _Pragma("unroll") for (int n = 0; n < 2; ++n) \
        asm volatile("v_mfma_scale_f32_16x16x128_f8f6f4 %0, %1, %2, %0, %3, %3 op_sel_hi:[0,0,0]" : "+v"(acc[ai][bj][m][n]) : "v"(Bt##8[n]), "v"(At##8[m]), "v"(pg8_one)); }     \
        else { _Pragma("unroll") for (int m = 0; m < 4; ++m) _Pragma("unroll") for (int n = 0; n < 2; ++n) _Pragma("unroll") for (int k = 0; k < 2; ++k) \
        acc[ai][bj][m][n] = __builtin_amdgcn_mfma_f32_16x16x32_bf16(Bt[n][k], At[m][k], acc[ai][bj][m][n], 0, 0, 0); } __builtin_amdgcn_s_setprio(0); } while (0)
#define PG8_WAIT_V(n) asm volatile("s_waitcnt vmcnt(" #n ")" ::: "memory")
#define PG8_WAIT_L(n) asm volatile("s_waitcnt lgkmcnt(" #n ")" ::: "memory")
#define PG8_BAR __builtin_amdgcn_s_barrier()
#define PG8_SCHED __builtin_amdgcn_sched_barrier(0)
    Unit cur, nxt; int ui = 0;
    if (!S.next(0, cur)) return;
    f32x4 acc[2][2][4][2];
#pragma unroll
    for (int a = 0; a < 2; ++a)
#pragma unroll
        for (int b = 0; b < 2; ++b)
#pragma unroll
            for (int m = 0; m < 4; ++m)
#pragma unroll
                for (int n = 0; n < 2; ++n) acc[a][b][m][n] = (f32x4){0.f, 0.f, 0.f, 0.f};
    const int pg8_one = 0x7f7f7f7f;
    bf16x8 At[4][2], B0[2][2], B1[2][2];
    i32x8 At8[4], B08[2], B18[2];
    const char* cA = cur.a; const char* cB = cur.b; const char* cB2 = cur.b2; const int nth = nt >> 1;
    if constexpr (GATHER) { PG8_GOFF(gc, cur.pm); }
    S.a_ready(cur);
    if constexpr (SP2) {
        PG8_STAGE(PG8_SB(0, 0), cB, voffB); PG8_STAGE(PG8_SB(0, 1), cB + hstepB, voffB); PG8_STAGE_A(PG8_SA(0, 0), cA, 0, false); PG8_STAGE_A(PG8_SA(0, 1), cA, 1, false);
        if (wr == 1) PG8_BAR;
        PG8_WAIT_V(2); PG8_BAR;
        PG8_STAGE(PG8_SB(1, 0), cB + kstep, voffB); PG8_STAGE_A(PG8_SA(1, 0), cA + kstep, 0, false); PG8_STAGE(PG8_SB(1, 1), cB + hstepB + kstep, voffB);
        PG8_WAIT_V(6); PG8_BAR;
    } else {
        PG8_STAGE(PG8_SB(0, 0), cB, voffB); PG8_STAGE_A(PG8_SA(0, 0), cA, 0, false); PG8_STAGE(PG8_SB(0, 1), cB + hstepB, voffB); PG8_STAGE_A(PG8_SA(0, 1), cA, 1, false);
        if (wr == 1) PG8_BAR;
        PG8_WAIT_V(4); PG8_BAR;
        PG8_STAGE(PG8_SB(1, 0), cB + kstep, voffB); PG8_STAGE_A(PG8_SA(1, 0), cA + kstep, 0, false); PG8_STAGE(PG8_SB(1, 1), cB + hstepB + kstep, voffB);
        PG8_WAIT_V(6); PG8_BAR;
    }
    for (;;) {
        const bool has_next = S.next(ui + 1, nxt);
        if constexpr (GATHER) { if (has_next) { PG8_GOFF(gn, nxt.pm); } }
        const char* nA = has_next ? nxt.a : cA; const char* nB = has_next ? nxt.b : cB;
#pragma nounroll
        for (int t = 0; t < nt; t += 2) {
            const bool last = (t == nt - 2);
            const char* a1 = cA + (size_t)(t + 1) * kstep;
            const char* a2 = last ? nA : cA + (size_t)(t + 2) * kstep; const char* b2 = last ? nB : ((t + 2 < nth) ? cB : cB2) + (size_t)(t + 2) * kstep;
            const char* a3 = a2 + kstep; const char* b3 = b2 + kstep;
            if (last && has_next) S.a_ready(nxt);
            if constexpr (SP2) {
            PG8_LDB(B0, 0, 0); PG8_LDB(B1, 0, 1); PG8_SCHED; PG8_LDA(At, 0, 0); PG8_STAGE_A(PG8_SA(1, 1), a1, 1, false);
            PG8_WAIT_V(8); PG8_WAIT_L(0); PG8_BAR; PG8_MMA(0, 0, At, B0); PG8_MMA(0, 1, At, B1); PG8_BAR; PG8_SCHED;
            PG8_LDA(At, 0, 1); PG8_STAGE(PG8_SB(0, 0), b2, voffB); PG8_STAGE(PG8_SB(0, 1), b2 + hstepB, voffB); PG8_STAGE_A(PG8_SA(0, 0), a2, 0, last);
            PG8_WAIT_V(8); PG8_WAIT_L(0); PG8_BAR; PG8_MMA(1, 0, At, B0); PG8_MMA(1, 1, At, B1); PG8_BAR; PG8_SCHED;
            PG8_LDB(B0, 1, 0); PG8_LDB(B1, 1, 1); PG8_SCHED; PG8_LDA(At, 1, 0); PG8_STAGE_A(PG8_SA(0, 1), a2, 1, last);
            PG8_WAIT_V(8); PG8_WAIT_L(0); PG8_BAR; PG8_MMA(0, 0, At, B0); PG8_MMA(0, 1, At, B1); PG8_BAR; PG8_SCHED;
            PG8_LDA(At, 1, 1); PG8_STAGE(PG8_SB(1, 0), b3, voffB); PG8_STAGE(PG8_SB(1, 1), b3 + hstepB, voffB); PG8_STAGE_A(PG8_SA(1, 0), a3, 0, last);
            PG8_WAIT_V(8); PG8_WAIT_L(0); PG8_BAR; PG8_MMA(1, 0, At, B0); PG8_MMA(1, 1, At, B1); PG8_BAR; PG8_SCHED;
            } else {
            PG8_LDB(B0, 0, 0); PG8_SCHED; PG8_LDA(At, 0, 0); PG8_STAGE_A(PG8_SA(1, 1), a1, 1, false);
            PG8_WAIT_L(8); PG8_BAR; PG8_WAIT_L(0); PG8_MMA(0, 0, At, B0); PG8_BAR; PG8_SCHED;
            PG8_LDB(B1, 0, 1); PG8_STAGE(PG8_SB(0, 0), b2, voffB);
            PG8_BAR; PG8_WAIT_L(0); PG8_MMA(0, 1, At, B1); PG8_BAR;
            PG8_LDA(At, 0, 1); PG8_STAGE_A(PG8_SA(0, 0), a2, 0, last);
            PG8_BAR; PG8_WAIT_L(0); PG8_MMA(1, 0, At, B0); PG8_BAR; PG8_SCHED;
            PG8_STAGE(PG8_SB(0, 1), b2 + hstepB, voffB);
            PG8_WAIT_V(6); PG8_BAR; PG8_MMA(1, 1, At, B1); PG8_BAR;
            PG8_LDB(B0, 1, 0); PG8_SCHED; PG8_LDA(At, 1, 0); PG8_STAGE_A(PG8_SA(0, 1), a2, 1, last);
            PG8_WAIT_L(8); PG8_BAR; PG8_WAIT_L(0); PG8_MMA(0, 0, At, B0); PG8_BAR; PG8_SCHED;
            PG8_LDB(B1, 1, 1); PG8_STAGE(PG8_SB(1, 0), b3, voffB);
            PG8_BAR; PG8_WAIT_L(0); PG8_MMA(0, 1, At, B1); PG8_BAR;
            PG8_LDA(At, 1, 1); PG8_STAGE_A(PG8_SA(1, 0), a3, 0, last);
            PG8_BAR; PG8_WAIT_L(0); PG8_MMA(1, 0, At, B0); PG8_BAR; PG8_SCHED;
            PG8_STAGE(PG8_SB(1, 1), b3 + hstepB, voffB);
            PG8_WAIT_V(6); PG8_BAR; PG8_MMA(1, 1, At, B1); PG8_BAR;
            }
        }
        if constexpr (FP8) asm volatile("s_nop 15\n\ts_nop 7" ::: "memory");
        if constexpr (ALIGN_EPI) { if (wr == 0) PG8_BAR; }
        if constexpr (!Epi::AFTER_DRAIN) { E(acc, cur, wr, wc, fr, fq); S.done(cur); }
        if (!has_next) break;
#pragma unroll
        for (int a = 0; a < 2; ++a)
#pragma unroll
            for (int b = 0; b < 2; ++b)
#pragma unroll
                for (int m = 0; m < 4; ++m)
#pragma unroll
                    for (int n = 0; n < 2; ++n) acc[a][b][m][n] = (f32x4){0.f, 0.f, 0.f, 0.f};
        cur = nxt; cA = nA; cB = nB; cB2 = nxt.b2; ++ui;
        if constexpr (GATHER) { _Pragma("unroll") for (int _h = 0; _h < 2; ++_h) _Pragma("unroll") for (int _i = 0; _i < 2; ++_i) gc[_h][_i] = gn[_h][_i]; }
        if constexpr (ALIGN_EPI) { if (wr == 1) PG8_BAR; }
    }
    PG8_WAIT_V(0);
    if constexpr (!ALIGN_EPI) { if (wr == 0) PG8_BAR; }
    PG8_BAR;
    if constexpr (Epi::AFTER_DRAIN) { E.fused(acc, cur, wr, wc, fr, fq, lds, wid, lane); S.done(cur); }
#undef PG8_SA
#undef PG8_SB
#undef PG8_STAGE
#undef PG8_LDA
#undef PG8_STAGE_A
#undef PG8_GOFF
#undef PG8_LDB
#undef PG8_MMA
#undef PG8_WAIT_V
#undef PG8_WAIT_L
#undef PG8_BAR
#undef PG8_SCHED
}
}

#include <hip/hip_bf16.h>
#include <cmath>
namespace attn_body {
using bf16=__hip_bfloat16;
using bf16x8=__attribute__((ext_vector_type(8)))short;
using s16x4=__attribute__((ext_vector_type(4)))short;
using f32x16=__attribute__((ext_vector_type(16)))float;
using u32x4=__attribute__((ext_vector_type(4)))unsigned;
constexpr int D=64, QP=3584, KP=3584, VP=3584, OP=1024;
constexpr int NW=8,QBLK=32,QB=QBLK*NW,KVBLK=64;
constexpr int ATTN_UNIT_ROWS=QB;
__device__ __forceinline__ int crow(int r,int hi){return (r&3)+8*(r>>2)+4*hi;}
#define SBAR() __builtin_amdgcn_sched_barrier(0)
__device__ __forceinline__ void cmask(f32x16&p0,f32x16&p1,int jb,int qrel,int hi){
  const float NEG=-INFINITY; int kb=64*jb+4*hi;
  #pragma unroll
  for(int r=0;r<16;++r){int kv=kb+(r&3)+8*(r>>2); if(kv>qrel)p0[r]=NEG; if(kv+32>qrel)p1[r]=NEG;}
}

constexpr int NSLOT=3, SLOTB=8192;
constexpr int LDS_K=0, LDS_V=NSLOT*SLOTB, LDS_WS=2*NSLOT*SLOTB, LDS_OST=LDS_WS+NW*64*4, LDS_BYTES=LDS_OST+NW*4096;
constexpr float C2=0.125f*1.4426950408889634f;
__device__ __forceinline__ void glds16(const void*gsrc,unsigned lds_dst){unsigned keep;
  asm volatile("s_mov_b32 %0, m0\n\ts_mov_b32 m0, %2\n\ts_nop 0\n\tglobal_load_lds_dwordx4 %1, off\n\ts_mov_b32 m0, %0":"=&s"(keep):"v"(gsrc),"s"(lds_dst):"memory");}
__device__ __forceinline__ float max3f(float a,float b,float c){float r;asm("v_max3_f32 %0, %1, %2, %3":"=v"(r):"v"(a),"v"(b),"v"(c));return r;}
__device__ __forceinline__ float max2f(float a,float b){float r;asm("v_max_f32_e32 %0, %1, %2":"=v"(r):"v"(a),"v"(b));return r;}
__device__ __forceinline__ float fadd_s(float a,float b){float r;asm("v_add_f32_e32 %0, %1, %2":"=v"(r):"v"(a),"v"(b));return r;}
__device__ __forceinline__ float fsub_s(float a,float b){float r;asm("v_sub_f32_e32 %0, %1, %2":"=v"(r):"v"(a),"v"(b));return r;}
typedef float f32x2_t __attribute__((ext_vector_type(2))); typedef __bf16 bf16x2_t __attribute__((ext_vector_type(2)));
__device__ __forceinline__ unsigned cvtpk_s(float lo,float hi){f32x2_t v={lo,hi};bf16x2_t b=__builtin_convertvector(v,bf16x2_t);return __builtin_bit_cast(unsigned,b);}
#define WAIT_BAR(N) asm volatile("s_waitcnt vmcnt(" #N ") lgkmcnt(0)\n\ts_barrier":::"memory")

__device__ __forceinline__ void qkt(f32x16&p0,f32x16&p1,const char*Kslot,const bf16x8*qr,const f32x16&negm,int r32,int hi){
  const char*kb=Kslot+hi*1024+r32*16;
  #pragma unroll
  for(int d0=0;d0<4;++d0){
    const bf16x8 b0=*reinterpret_cast<const bf16x8*>(kb+d0*2048);
    const bf16x8 b1=*reinterpret_cast<const bf16x8*>(kb+d0*2048+512);
    if(d0==0){p0=__builtin_amdgcn_mfma_f32_32x32x16_bf16(b0,qr[0],negm,0,0,0);p1=__builtin_amdgcn_mfma_f32_32x32x16_bf16(b1,qr[0],negm,0,0,0);}
    else{p0=__builtin_amdgcn_mfma_f32_32x32x16_bf16(b0,qr[d0],p0,0,0,0);p1=__builtin_amdgcn_mfma_f32_32x32x16_bf16(b1,qr[d0],p1,0,0,0);}}
}
typedef __attribute__((address_space(3))) const char* lds_cptr;
typedef short v4i16_t __attribute__((ext_vector_type(4)));
__device__ __forceinline__ void kload8(bf16x8*kf,lds_cptr kp){
  kf[0]=*(const __attribute__((address_space(3))) bf16x8*)(kp);      kf[1]=*(const __attribute__((address_space(3))) bf16x8*)(kp+512);
  kf[2]=*(const __attribute__((address_space(3))) bf16x8*)(kp+2048); kf[3]=*(const __attribute__((address_space(3))) bf16x8*)(kp+2560);
  kf[4]=*(const __attribute__((address_space(3))) bf16x8*)(kp+4096); kf[5]=*(const __attribute__((address_space(3))) bf16x8*)(kp+4608);
  kf[6]=*(const __attribute__((address_space(3))) bf16x8*)(kp+6144); kf[7]=*(const __attribute__((address_space(3))) bf16x8*)(kp+6656);
}
__device__ __forceinline__ void kload2(bf16x8*kf,lds_cptr kp,int j){ kf[2*j]=*(const __attribute__((address_space(3))) bf16x8*)(kp+j*2048); kf[2*j+1]=*(const __attribute__((address_space(3))) bf16x8*)(kp+j*2048+512); }
__device__ __forceinline__ s16x4 vtr(lds_cptr p){ return __builtin_bit_cast(s16x4,__builtin_amdgcn_ds_read_tr16_b64_v4i16((__attribute__((address_space(3))) v4i16_t*)p)); }
__device__ __forceinline__ float rowmax(const f32x16&p0,const f32x16&p1){
  float a=max3f(p0[0],p0[1],p1[0]),b=max3f(p0[2],p0[3],p1[1]);a=max3f(a,p1[2],p1[3]);
  #pragma unroll
  for(int r=4;r<16;r+=4){a=max3f(a,p0[r],p0[r+1]);b=max3f(b,p0[r+2],p0[r+3]);a=max3f(a,p1[r],p1[r+1]);b=max3f(b,p1[r+2],p1[r+3]);}
  const float m=max2f(a,b);
  auto rr=__builtin_amdgcn_permlane32_swap(__float_as_uint(m),__float_as_uint(m),false,false);
  return max2f(__uint_as_float(rr[0]),__uint_as_float(rr[1]));
}
__device__ __forceinline__ void pv(f32x16*o,int vb,bf16x8 pa0,bf16x8 pa1,bf16x8 pa2,bf16x8 pa3){
  #pragma unroll
  for(int d0=0;d0<2;++d0){s16x4 lo[4],hi[4];
    #pragma unroll
    for(int ks=0;ks<4;++ks){
      asm volatile("ds_read_b64_tr_b16 %0,%1 offset:%c2":"=&v"(lo[ks]):"v"(vb),"i"(d0*4096+ks*1024):"memory");
      asm volatile("ds_read_b64_tr_b16 %0,%1 offset:%c2":"=&v"(hi[ks]):"v"(vb),"i"(d0*4096+ks*1024+512):"memory");}
    asm volatile("s_waitcnt lgkmcnt(0)":::"memory");SBAR();
    #define PK(k) (bf16x8){lo[k][0],lo[k][1],lo[k][2],lo[k][3],hi[k][0],hi[k][1],hi[k][2],hi[k][3]}
    o[d0]=__builtin_amdgcn_mfma_f32_32x32x16_bf16(pa0,PK(0),o[d0],0,0,0);
    o[d0]=__builtin_amdgcn_mfma_f32_32x32x16_bf16(pa1,PK(1),o[d0],0,0,0);
    o[d0]=__builtin_amdgcn_mfma_f32_32x32x16_bf16(pa2,PK(2),o[d0],0,0,0);
    o[d0]=__builtin_amdgcn_mfma_f32_32x32x16_bf16(pa3,PK(3),o[d0],0,0,0);
    #undef PK
  }
}

#ifndef ATTN_STORE16
#define ATTN_STORE16(p,v) (*(u32x4*)(p)=(v))
#endif
template<int THRL> __device__ __forceinline__ void attn_unit(int q0,int NT,const bf16*Qh,const bf16*__restrict__ Kh,const bf16*__restrict__ Vh,bf16*Oh,char*shm,const int tid){
  const int lane=tid&63,r32=lane&31,hi=lane>>5; const int wid=__builtin_amdgcn_readfirstlane(tid>>6);
  const bf16*Qw=Qh+(long)(q0+wid*QBLK)*QP;
  const unsigned lds0=(unsigned)(uintptr_t)shm;
  float*wsf=(float*)(shm+LDS_WS)+wid*64;
  const bf16*ksrc=Kh+(long)lane*KP+wid*8;
  const bf16*vsrc=Vh+(long)(16*(wid&3)+(lane>>2))*VP+(wid>>2)*32+(lane&3)*8;
  const unsigned kdst=lds0+LDS_K+wid*1024, vdst=lds0+LDS_V+wid*1024;
  #define DMA_K(t,slot) glds16(ksrc+(long)(t)*KVBLK*KP,(unsigned)__builtin_amdgcn_readfirstlane(kdst+(slot)))
  #define DMA_V(t,slot) glds16(vsrc+(long)(t)*KVBLK*VP,(unsigned)__builtin_amdgcn_readfirstlane(vdst+(slot)))
  const int vb0=(int)(lds0+LDS_V)+((lane>>4)&1)*32+(lane&3)*8+(4*hi+((lane&15)>>2))*64;
  const char*Kbase=shm+LDS_K; bf16x8 kf[8];
  const lds_cptr shm3=(lds_cptr)shm; const lds_cptr kp0=shm3+LDS_K+hi*1024+r32*16; const lds_cptr vp0=shm3+LDS_V+((lane>>4)&1)*32+(lane&3)*8+(4*hi+((lane&15)>>2))*64;
  DMA_K(0,0);DMA_V(0,0);DMA_K(1,SLOTB);
  bf16x8 qr[4];
  #pragma unroll
  for(int d0=0;d0<4;++d0)qr[d0]=*reinterpret_cast<const bf16x8*>(&Qw[(long)r32*QP+d0*16+hi*8]);
  float mhat=0.f,l_reg=0.f;f32x16 o[2];o[0]=f32x16{};o[1]=f32x16{};f32x16 negm=f32x16{};asm volatile("":"+v"(negm));
  #define CMASK(P0,P1,t) do{}while(0)
  bool resc=false;
  #define START(P0,P1) do{ const float rm=rowmax(P0,P1); resc=false; \
    { const float dl=rm; mhat=fadd_s(mhat,dl); \
      _Pragma("unroll") for(int r=0;r<16;++r){P0[r]=fsub_s(P0[r],dl);P1[r]=fsub_s(P1[r],dl);} \
      _Pragma("unroll") for(int r=0;r<16;++r)negm[r]=-mhat; asm volatile("":"+v"(negm)); } \
    _Pragma("unroll") for(int r=0;r<16;++r)P0[r]=__builtin_amdgcn_exp2f(P0[r]); }while(0)
  #define RESC() do{ if(resc){ asm volatile("s_waitcnt lgkmcnt(0)":::"memory"); \
      _Pragma("unroll") for(int d_=0;d_<2;++d_) _Pragma("unroll") for(int r=0;r<16;++r)o[d_][r]*=wsf[crow(r,hi)]; } }while(0)
  f32x16 pA0,pA1,pB0,pB1;
  int sl_prev=0,sl_cur=0,sl_next=SLOTB;
  #define ROT() do{sl_prev=sl_cur;sl_cur=sl_next;sl_next=(sl_next==(NSLOT-1)*SLOTB)?0:sl_next+SLOTB;}while(0)
  DMA_K(2,2*SLOTB);
  WAIT_BAR(3);
  qkt(pA0,pA1,Kbase,qr,negm,r32,hi);asm volatile("s_nop 15\n\ts_nop 7":"+v"(pA0),"+v"(pA1));CMASK(pA0,pA1,0);
  START(pA0,pA1);
  _Pragma("unroll") for(int r=0;r<16;++r)pA1[r]=__builtin_amdgcn_exp2f(pA1[r]);
  WAIT_BAR(0);
  DMA_K(3,0);DMA_V(1,SLOTB);
  ROT();
  kload8(kf,kp0+sl_cur);
  WAIT_BAR(2);
  s16x4 vlo[8],vhi[8]; u32x4 pw0,pw1,pw2,pw3;
  #define PKW(P,B) cvtpk_s(P[B],P[B+1])
  #define PAF(k) __builtin_bit_cast(bf16x8,pw##k)
  #define VFR(i) (bf16x8){vlo[i][0],vlo[i][1],vlo[i][2],vlo[i][3],vhi[i][0],vhi[i][1],vhi[i][2],vhi[i][3]}
  #define PIN(x) asm volatile("":"+v"(x))
  #define MX3(a,b,c) __builtin_fmaxf(__builtin_fmaxf((a),(b)),(c))
  #define GAPA(MF,A0,A1,A2,A3,W0,W1,PW) do{ MF; sacc+=A0; sacc+=A1; sacc+=A2; sacc+=A3; PIN(sacc); W0; W1; PIN(PW); SBAR(); }while(0)
  #define EX(v) __builtin_amdgcn_exp2f(v)
  #define GAPB(MF,X,B) do{ MF; X[B]=EX(X[B]); X[B+1]=EX(X[B+1]); X[B+2]=EX(X[B+2]); X[B+3]=EX(X[B+3]); PIN(X); SBAR(); }while(0)
  #define VRD(i) do{ vlo[i]=vtr(vp_+(((i)>>2)*4096+((i)&3)*1024)); vhi[i]=vtr(vp_+(((i)>>2)*4096+((i)&3)*1024+512)); }while(0)
  #define KRD(G,j) do{ if(G){ kload2(kf,kp0+sl_next,j); SBAR(); } }while(0)
  #define STEP(C0,C1,P0,P1,t,GK,GV,GL) do{ SBAR(); \
    const lds_cptr vp_=vp0+sl_prev; \
    VRD(0); SBAR(); float sacc=(P0[0]+P0[1]); \
    GAPA(C0=__builtin_amdgcn_mfma_f32_32x32x16_bf16(kf[0],qr[0],negm,0,0,0), P0[2],P0[3],P0[4],P0[5],     pw0[0]=PKW(P0,0), pw0[1]=PKW(P0,2), pw0); \
    VRD(4); SBAR(); GAPA(C1=__builtin_amdgcn_mfma_f32_32x32x16_bf16(kf[1],qr[0],negm,0,0,0), P0[6],P0[7],P0[8],P0[9],     pw0[2]=PKW(P0,4), pw0[3]=PKW(P0,6), pw0); \
    VRD(1); SBAR(); GAPA(C0=__builtin_amdgcn_mfma_f32_32x32x16_bf16(kf[2],qr[1],C0,0,0,0),   P0[10],P0[11],P0[12],P0[13], pw1[0]=PKW(P0,8), pw1[1]=PKW(P0,10), pw1); \
    VRD(5); SBAR(); GAPA(C1=__builtin_amdgcn_mfma_f32_32x32x16_bf16(kf[3],qr[1],C1,0,0,0),   P0[14],P0[15],P1[0],P1[1],   pw1[2]=PKW(P0,12),pw1[3]=PKW(P0,14), pw1); \
    VRD(2); SBAR(); GAPA(C0=__builtin_amdgcn_mfma_f32_32x32x16_bf16(kf[4],qr[2],C0,0,0,0),   P1[2],P1[3],P1[4],P1[5],     pw2[0]=PKW(P1,0), pw2[1]=PKW(P1,2), pw2); \
    VRD(6); SBAR(); GAPA(C1=__builtin_amdgcn_mfma_f32_32x32x16_bf16(kf[5],qr[2],C1,0,0,0),   P1[6],P1[7],P1[8],P1[9],     pw2[2]=PKW(P1,4), pw2[3]=PKW(P1,6), pw2); \
    VRD(3); SBAR(); GAPA(C0=__builtin_amdgcn_mfma_f32_32x32x16_bf16(kf[6],qr[3],C0,0,0,0),   P1[10],P1[11],P1[12],P1[13], pw3[0]=PKW(P1,8), pw3[1]=PKW(P1,10), pw3); \
    VRD(7); SBAR(); GAPA(C1=__builtin_amdgcn_mfma_f32_32x32x16_bf16(kf[7],qr[3],C1,0,0,0),   P1[14],P1[15],0.f,0.f,       pw3[2]=PKW(P1,12),pw3[3]=PKW(P1,14), pw3); \
    l_reg+=sacc; \
    if(GK){DMA_K((t)+3,sl_cur);} if(GV){DMA_V((t)+1,sl_next);} \
    CMASK(C0,C1,t); \
    { float a=MX3(C0[0],C0[1],C1[0]),b=MX3(C0[2],C0[3],C1[1]); a=MX3(a,C1[2],C1[3]); \
      _Pragma("unroll") for(int r=4;r<16;r+=4){a=MX3(a,C0[r],C0[r+1]);b=MX3(b,C0[r+2],C0[r+3]);a=MX3(a,C1[r],C1[r+1]);b=MX3(b,C1[r+2],C1[r+3]);} \
      float rm=__builtin_fmaxf(a,b); { auto rr=__builtin_amdgcn_permlane32_swap(__float_as_uint(rm),__float_as_uint(rm),false,false); rm=__builtin_fmaxf(__uint_as_float(rr[0]),__uint_as_float(rr[1])); } \
      resc=false; \
      if(__builtin_expect(__any(rm>(float)THRL),0)){ const float dl=__builtin_fmaxf(rm,0.f); mhat+=dl; \
        _Pragma("unroll") for(int r=0;r<16;++r){C0[r]-=dl;C1[r]-=dl;} \
        _Pragma("unroll") for(int r=0;r<16;++r)negm[r]=-mhat; asm volatile("":"+v"(negm)); \
        const float f=__builtin_amdgcn_exp2f(-dl); l_reg*=f; if(hi==0)wsf[r32]=f; resc=true; } } \
    SBAR(); \
    GAPB(o[0]=__builtin_amdgcn_mfma_f32_32x32x16_bf16(PAF(0),VFR(0),o[0],0,0,0), C0,0); \
    GAPB(o[1]=__builtin_amdgcn_mfma_f32_32x32x16_bf16(PAF(0),VFR(4),o[1],0,0,0), C0,4); \
    KRD(GL,0); GAPB(o[0]=__builtin_amdgcn_mfma_f32_32x32x16_bf16(PAF(1),VFR(1),o[0],0,0,0), C0,8); \
    KRD(GL,1); GAPB(o[1]=__builtin_amdgcn_mfma_f32_32x32x16_bf16(PAF(1),VFR(5),o[1],0,0,0), C0,12); \
    KRD(GL,2); GAPB(o[0]=__builtin_amdgcn_mfma_f32_32x32x16_bf16(PAF(2),VFR(2),o[0],0,0,0), C1,0); \
    KRD(GL,3); GAPB(o[1]=__builtin_amdgcn_mfma_f32_32x32x16_bf16(PAF(2),VFR(6),o[1],0,0,0), C1,4); \
    GAPB(o[0]=__builtin_amdgcn_mfma_f32_32x32x16_bf16(PAF(3),VFR(3),o[0],0,0,0), C1,8); \
    GAPB(o[1]=__builtin_amdgcn_mfma_f32_32x32x16_bf16(PAF(3),VFR(7),o[1],0,0,0), C1,12); \
    }while(0)
  int t=1;
  #undef CMASK
  #define CMASK(P0,P1,t) do{}while(0)
  for(;t+5<NT;t+=2){
    STEP(pB0,pB1,pA0,pA1,t,true,true,true);     WAIT_BAR(2); RESC(); ROT();
    STEP(pA0,pA1,pB0,pB1,t+1,true,true,true);   WAIT_BAR(2); RESC(); ROT();
  }
  #undef CMASK
  #define CMASK(P0,P1,t) do{}while(0)
  #define ENDW(tt) do{ if((tt)+3<NT){WAIT_BAR(2);} else if((tt)+2<NT){WAIT_BAR(1);} else {WAIT_BAR(0);} }while(0)
  for(;t+1<NT;t+=2){
    STEP(pB0,pB1,pA0,pA1,t,(t+3<NT),(t+1<NT),(t+1<NT));       ENDW(t);   RESC(); ROT();
    STEP(pA0,pA1,pB0,pB1,t+1,(t+4<NT),(t+2<NT),(t+2<NT));     ENDW(t+1); RESC(); ROT();
  }
  STEP(pB0,pB1,pA0,pA1,NT-1,false,false,false); RESC();
  { float sacc=pB0[0]+pB0[1]; _Pragma("unroll") for(int r=2;r<16;++r)sacc+=pB0[r]; _Pragma("unroll") for(int r=0;r<16;++r)sacc+=pB1[r]; l_reg+=sacc;
    pw0=(u32x4){PKW(pB0,0),PKW(pB0,2),PKW(pB0,4),PKW(pB0,6)};pw1=(u32x4){PKW(pB0,8),PKW(pB0,10),PKW(pB0,12),PKW(pB0,14)};pw2=(u32x4){PKW(pB1,0),PKW(pB1,2),PKW(pB1,4),PKW(pB1,6)};pw3=(u32x4){PKW(pB1,8),PKW(pB1,10),PKW(pB1,12),PKW(pB1,14)};
    SBAR(); pv(o,vb0+sl_cur,PAF(0),PAF(1),PAF(2),PAF(3)); }
  #undef PKW
  #undef PAF
  #undef VFR
  #undef PIN
  #undef MX3
  #undef GAPA
  #undef GAPB
  #undef EX
  #undef VRD
  #undef KRD
  #undef STEP
  #undef ENDW
  {float la_=l_reg,lb_=l_reg;asm volatile("s_nop 1\n\tv_permlane32_swap_b32 %0, %1\n\ts_nop 1":"+v"(la_),"+v"(lb_));l_reg=la_+lb_;}
  if(hi==0)wsf[32+r32]=l_reg;asm volatile("s_waitcnt lgkmcnt(0)":::"memory");
  float rli[16];
  #pragma unroll
  for(int r=0;r<16;++r)rli[r]=__builtin_amdgcn_rcpf(wsf[32+crow(r,hi)]);
  bf16*Ow=Oh+(long)(q0+wid*QBLK)*OP;
  { bf16*stg=(bf16*)(shm+LDS_OST)+wid*2048;
    #pragma unroll
    for(int r=0;r<16;++r){const int orow=crow(r,hi);
      #pragma unroll
      for(int d0=0;d0<2;++d0)stg[orow*64+d0*32+r32]=__float2bfloat16(o[d0][r]*rli[r]);}
    asm volatile("s_waitcnt lgkmcnt(0)":::"memory");
    #pragma unroll
    for(int i=0;i<4;++i){const int row=i*8+(lane>>3),ch=lane&7; const u32x4 v=*(const u32x4*)(stg+row*64+ch*8); ATTN_STORE16(Ow+(long)row*OP+ch*8,v);} }
  asm volatile("s_waitcnt lgkmcnt(0)\n\ts_barrier":::"memory");
  #undef DMA_K
  #undef DMA_V
  #undef CMASK
  #undef START
  #undef RESC
  #undef ROT
}
constexpr int ATTN_LDS_BYTES=LDS_BYTES;
#undef SBAR
#undef WAIT_BAR
}
constexpr int NWAVES = 8, NTHR = 512;
constexpr int NB = 16, T_LAT = 2048, L_CTX = 256, DM = 1024, RPB = T_LAT + L_CTX  , MROWS = NB * RPB  , NPROJ = 3584, DEPTH = 2;
constexpr int NPANEL = MROWS / 256  , PPB = RPB / 256  ;
constexpr float NORM_EPS = 1e-6f;
constexpr int C_HQ = 0, C_HI = 256, C_HZ = 512  , C_HG = 1024, C_CB = 1280, C_CC = 1536, C_CH = 1792, C_RQ = 2048, C_RK = 2304, C_RV = 2560, C_RG = 2816, C_AQ = 3072, C_AK = 3328, C_AV = 3456;
constexpr size_t MiB = 1u << 20;
constexpr size_t WS_CTL = 0, CTL_ZERO_BYTES = 1 * MiB;
constexpr size_t WS_MOD = 1 * MiB;
constexpr size_t WS_ROPE = 2 * MiB;
constexpr size_t WS_ROUTE = 3 * MiB;
constexpr size_t WS_ROWINFO = 4 * MiB;
constexpr size_t WS_BCNT = 5 * MiB;
constexpr size_t WS_TILEINFO = 6 * MiB;
constexpr size_t WS_DBUF = 7 * MiB;
constexpr size_t WS_W0 = 12 * MiB, WLAYER = 33 * MiB;
constexpr size_t WO_WIN = 0;
constexpr size_t WO_WOUT = 7 * MiB;
constexpr size_t WO_WGU = 9 * MiB;
constexpr size_t WO_WD = 25 * MiB;
constexpr size_t WS_CTX = 78 * MiB;
constexpr size_t WS_ACT = 94 * MiB;
constexpr size_t WS_P = 166 * MiB;
constexpr size_t WS_ASORT = WS_P;
constexpr size_t WS_H = WS_P + 84 * MiB;
constexpr size_t WS_KVS = 418 * MiB;
constexpr size_t WS_END = 490 * MiB;
constexpr int MAXTILES = 168;
constexpr int CW_ERR = 16;
constexpr int CW_BAR = 4096;
constexpr int RING_OFF = 0, RING_BYTES = 139264;
constexpr int LDSCTL_OFF = RING_BYTES, MISC_OFF = LDSCTL_OFF + 320;
constexpr int PTAB_OFF = LDSCTL_OFF + 512;
constexpr int TAB_OFF = LDSCTL_OFF + 1024;
constexpr int LDS_BYTES = 147456;

#define GAS __attribute__((address_space(1)))
#define LAS __attribute__((address_space(3)))
typedef unsigned short bf16;
typedef unsigned v4u __attribute__((ext_vector_type(4)));
typedef unsigned v2u __attribute__((ext_vector_type(2)));
typedef int v4i __attribute__((ext_vector_type(4)));
typedef float f32x4 __attribute__((ext_vector_type(4)));
typedef GAS unsigned gu32;
#define RLX_AGENT __ATOMIC_RELAXED, __HIP_MEMORY_SCOPE_AGENT
#define LDS_WAIT() asm volatile("s_waitcnt lgkmcnt(0)" ::: "memory")
#define VM_WAIT() asm volatile("s_waitcnt vmcnt(0)" ::: "memory")
typedef float pkf32x2_t __attribute__((ext_vector_type(2))); typedef __bf16 pkbf16x2_t __attribute__((ext_vector_type(2)));
__device__ __forceinline__ unsigned pk2(float lo, float hi) { const pkf32x2_t v = {lo, hi}; return __builtin_bit_cast(unsigned, __builtin_convertvector(v, pkbf16x2_t)); }
__device__ __forceinline__ unsigned f2bf(float f) { return pk2(f, 0.f) & 0xffffu; }
__device__ __forceinline__ float bflo(unsigned w) { return __builtin_bit_cast(float, w << 16); }
__device__ __forceinline__ float bfhi(unsigned w) { return __builtin_bit_cast(float, w & 0xffff0000u); }
__device__ __forceinline__ float bf1(bf16 h) { return __builtin_bit_cast(float, (unsigned)h << 16); }
__device__ __forceinline__ unsigned pk4_fp8(float a, float b, float c, float d) { int w = 0; w = __builtin_amdgcn_cvt_pk_fp8_f32(a, b, w, false); w = __builtin_amdgcn_cvt_pk_fp8_f32(c, d, w, true); return (unsigned)w; }
__device__ __forceinline__ float fp8_dec(unsigned b) { const unsigned s = b >> 7, e = (b >> 3) & 15u, m = b & 7u; const float v = e ? (float)(8u + m) * exp2f((float)e - 10.0f) : (float)m * 0.001953125f; return s ? -v : v; }
__device__ __forceinline__ float siluf(float x) { return x * __builtin_amdgcn_rcpf(1.0f + __expf(-x)); }
__device__ __forceinline__ float sigmf(float x) { return __builtin_amdgcn_rcpf(1.0f + __expf(-x)); }
template <int K> __device__ __forceinline__ float xshf(float v) { static_assert(K >= 1 && K < 32, "xshf"); return __builtin_bit_cast(float, __builtin_amdgcn_ds_swizzle(__builtin_bit_cast(int, v), (K << 10) | 0x1f)); }
template <int K> __device__ __forceinline__ int xshi(int v) { static_assert(K >= 1 && K < 32, "xshi"); return __builtin_amdgcn_ds_swizzle(v, (K << 10) | 0x1f); }
__device__ __forceinline__ void half_swap(float& a, float& b) { asm volatile("s_nop 1\n\tv_permlane32_swap_b32 %0, %1\n\ts_nop 1" : "+v"(a), "+v"(b)); }
__device__ __forceinline__ float half_sum(float v) { float a = v, b = v; half_swap(a, b); return a + b; }
__device__ __forceinline__ float half_max(float v) { float a = v, b = v; half_swap(a, b); return fmaxf(a, b); }
__device__ __forceinline__ float sum16(float v) { v += xshf<1>(v); v += xshf<2>(v); v += xshf<4>(v); v += xshf<8>(v); return v; }
__device__ __forceinline__ float sum32(float v) { v = sum16(v); v += xshf<16>(v); return v; }
__device__ __forceinline__ float wave_sum(float v) { return half_sum(sum32(v)); }
#define XB_TMO      128
#define XB_XCNT(j)  (256  + 64 * (j))
#define XB_XSUB(j)  (1280 + 64 * (j))
#define XB_XGEN(j)  (2304 + 64 * (j))
#define XB_TOP      3328
#define XB_TOPGEN   3392
#define XCD_BAR_WORDS 3456
#define XB_SPIN_CAP (1u << 18)

__device__ __forceinline__ unsigned xb_ld(unsigned* p)              { return __hip_atomic_load(p, __ATOMIC_RELAXED, __HIP_MEMORY_SCOPE_AGENT); }
__device__ __forceinline__ unsigned xb_add(unsigned* p, unsigned v) { return __hip_atomic_fetch_add(p, v, __ATOMIC_RELAXED, __HIP_MEMORY_SCOPE_AGENT); }
__device__ __forceinline__ unsigned xb_xcc_id() { return (unsigned)__builtin_amdgcn_s_getreg((3 << 11) | 20) & 0xFu; }
#define XB_SPIN(cond, bar) do { unsigned _sp = 0; while (cond) { __builtin_amdgcn_s_sleep(1); \
    if ((++_sp & 255u) == 0u) { if (xb_ld(&(bar)[XB_TMO])) break; if (_sp > XB_SPIN_CAP) { atomicAdd(&(bar)[XB_TMO], 1u); break; } } } } while (0)

struct XcdBarrier {
    unsigned* bar; unsigned x;
    volatile LAS unsigned* st;
};

__device__ __forceinline__ XcdBarrier xcd_barrier_post(unsigned* bar, volatile LAS unsigned* st) {
    XcdBarrier b; b.bar = bar; b.x = xb_xcc_id(); b.st = st;
    if (threadIdx.x == 0) (void)xb_add(&bar[XB_XCNT(b.x)], 1u);
    return b;
}
__device__ __forceinline__ void xcd_barrier_complete(unsigned* bar, unsigned x, unsigned& nloc, unsigned& nx) {
    const unsigned G = gridDim.x * gridDim.y * gridDim.z;
    unsigned sum, cnt, mine, sp = 0u;
    for (;;) {
        sum = 0u; cnt = 0u; mine = 0u;
#pragma unroll
        for (unsigned j = 0; j < 16; ++j) { const unsigned c = xb_ld(&bar[XB_XCNT(j)]); sum += c; cnt += (c > 0u) ? 1u : 0u; mine = (j == x) ? c : mine; }
        if (sum == G) break;
        __builtin_amdgcn_s_sleep(1);
        if ((++sp & 255u) == 0u) { if (xb_ld(&bar[XB_TMO])) break; if (sp > XB_SPIN_CAP) { atomicAdd(&bar[XB_TMO], 1u); break; } }
    }
    nloc = mine > 0u ? mine : 1u; nx = cnt > 0u ? cnt : 1u;
}

__device__ __forceinline__ void xcd_barrier(const XcdBarrier& b) {
    asm volatile("s_waitcnt vmcnt(0)" ::: "memory");
    __syncthreads();
    if (threadIdx.x == 0) {
        unsigned* bar = b.bar; asm volatile("" : "+s"(bar));
        __builtin_amdgcn_s_waitcnt(0);
        unsigned nloc = b.st[0], nx = b.st[1];
        if (nloc == 0u) { xcd_barrier_complete(bar, b.x, nloc, nx); b.st[0] = nloc; b.st[1] = nx; }
        const unsigned old = xb_add(&bar[XB_XSUB(b.x)], 1u);
        const unsigned gen = old / nloc;
        if (old + 1u == (gen + 1u) * nloc) {
            __builtin_amdgcn_fence(__ATOMIC_RELEASE, "agent");
            asm volatile("s_waitcnt vmcnt(0)" ::: "memory");
            const unsigned og = xb_add(&bar[XB_TOP], 1u);
            const unsigned tg = og / nx;
            if (og + 1u == (tg + 1u) * nx) xb_add(&bar[XB_TOPGEN], 1u);
            else XB_SPIN(xb_ld(&bar[XB_TOPGEN]) == tg, bar);
            __builtin_amdgcn_fence(__ATOMIC_ACQUIRE, "agent");
            xb_add(&bar[XB_XGEN(b.x)], 1u);
            asm volatile("s_waitcnt vmcnt(0)" ::: "memory");
        } else {
            XB_SPIN(xb_ld(&bar[XB_XGEN(b.x)]) == gen, bar);
            __builtin_amdgcn_fence(__ATOMIC_ACQUIRE, "agent");
            asm volatile("s_waitcnt vmcnt(0)" ::: "memory");
        }
    }
    __syncthreads();
}
struct Args { const float* in[24]; float* out; unsigned char* ws; };
enum { I_X = 0, I_C, I_CTX, I_CCTX, I_ADAW, I_ADAB, I_NMIX, I_NFFN, I_WIN, I_LB, I_HNORM, I_CONVW, I_RDEC, I_RNORM, I_QN, I_KN, I_WOUT, I_RGW, I_RGB, I_REW, I_REB, I_EG, I_EU, I_ED };
struct Frame {
    LAS unsigned char* lds;
    volatile LAS unsigned* MISC;
    gu32* ctl;
    int tid, lane, wave, vcu, G;
};
__device__ __forceinline__ const void* lptr(const Frame& F, int i) {
    const volatile LAS unsigned* t = (const volatile LAS unsigned*)(F.lds + PTAB_OFF) + 2 * i;
    const unsigned lo = __builtin_amdgcn_readfirstlane(t[0]), hi = __builtin_amdgcn_readfirstlane(t[1]);
    return (const void*)(const GAS void*)(((unsigned long long)hi << 32) | lo);
}
#define PIN(i) ((const float*)lptr(F, (i)))
#define POUT ((float*)lptr(F, 24))
#define PWS ((unsigned char*)lptr(F, 25))
__device__ __forceinline__ int row_of_latent(int idx) { return (idx >> 11) * RPB + L_CTX + (idx & 2047); }

__device__ __forceinline__ void transpose_item(const float* W, int N, int k0, int n0, bf16* dst, int DP, LAS float* scr, int lane) {
#pragma unroll
    for (int i = 0; i < 8; ++i) { const int kk = 8 * i + (lane >> 3), nc = 4 * (lane & 7); const f32x4 v = *(const f32x4*)(W + (size_t)(k0 + kk) * N + n0 + nc);
        scr[kk * 33 + nc] = v.x; scr[kk * 33 + nc + 1] = v.y; scr[kk * 33 + nc + 2] = v.z; scr[kk * 33 + nc + 3] = v.w; }
    LDS_WAIT(); asm volatile("" ::: "memory");
    const int c = lane & 7;
#pragma unroll
    for (int j = 0; j < 4; ++j) { const int n = (lane >> 3) + 8 * j; const LAS float* s = scr + (8 * c) * 33 + n;
        v4u o; o.x = pk2(s[0 * 33], s[1 * 33]); o.y = pk2(s[2 * 33], s[3 * 33]); o.z = pk2(s[4 * 33], s[5 * 33]); o.w = pk2(s[6 * 33], s[7 * 33]);
        *(GAS v4u*)(dst + (size_t)n * DP + 8 * c) = o; }
    LDS_WAIT(); asm volatile("" ::: "memory");
}
__device__ __forceinline__ void transpose_item8(const float* W, int N, int k0, int n0, unsigned char* dst, int DP, float scale, LAS float* scr, int lane) {
#pragma unroll
    for (int i = 0; i < 8; ++i) { const int kk = 8 * i + (lane >> 3), nc = 4 * (lane & 7); const f32x4 v = *(const f32x4*)(W + (size_t)(k0 + kk) * N + n0 + nc) * scale;
        scr[kk * 33 + nc] = v.x; scr[kk * 33 + nc + 1] = v.y; scr[kk * 33 + nc + 2] = v.z; scr[kk * 33 + nc + 3] = v.w; }
    LDS_WAIT(); asm volatile("" ::: "memory");
    const int c = lane & 7;
#pragma unroll
    for (int j = 0; j < 4; ++j) { const int n = (lane >> 3) + 8 * j; const LAS float* s = scr + (8 * c) * 33 + n;
        v2u o; o.x = pk4_fp8(s[0 * 33], s[1 * 33], s[2 * 33], s[3 * 33]); o.y = pk4_fp8(s[4 * 33], s[5 * 33], s[6 * 33], s[7 * 33]);
        *(GAS v2u*)(dst + (size_t)n * DP + 8 * c) = o; }
    LDS_WAIT(); asm volatile("" ::: "memory");
}
struct WItem { const float* src; unsigned char* dst; int N, DP, f8; };
__device__ __forceinline__ WItem witem_decode(const Frame& F, int it) {
    constexpr int PER_LAYER = 1792 + 512 + 3 * 4096;
    const int l = it / PER_LAYER; int r = it - l * PER_LAYER; unsigned char* ws = PWS + WS_W0 + (size_t)l * WLAYER; WItem w;
    if (r < 1792) { const int kb = r / 112, nb = r % 112; w.src = PIN(I_WIN) + (size_t)l * 1024 * NPROJ + (size_t)kb * 64 * NPROJ + nb * 32; w.N = NPROJ; w.dst = ws + WO_WIN + ((size_t)nb * 32 * 1024 + kb * 64) * 2; w.DP = 2048; w.f8 = 0; return w; }
    r -= 1792;
    if (r < 512) { const int kb = r / 32, nb = r % 32; w.src = PIN(I_WOUT) + (size_t)l * 1024 * 1024 + (size_t)kb * 64 * 1024 + nb * 32; w.N = 1024; w.dst = ws + WO_WOUT + ((size_t)nb * 32 * 1024 + kb * 64) * 2; w.DP = 2048; w.f8 = 0; return w; }
    r -= 512;
    if (r < 8192) { const int up = r >= 4096; r -= up * 4096; const int e = r >> 8, rr = r & 255, kb = rr >> 4, nb = rr & 15, n0 = nb * 32;
        const int drow = e * 1024 + (n0 >> 7) * 256 + up * 128 + (n0 & 127);
        w.src = (up ? PIN(I_EU) : PIN(I_EG)) + (size_t)(l * 16 + e) * 1024 * 512 + (size_t)kb * 64 * 512 + n0; w.N = 512; w.dst = ws + WO_WGU + (size_t)drow * 1024 + kb * 64; w.DP = 1024; w.f8 = 1; return w; }
    r -= 8192;
    { const int e = r >> 8, rr = r & 255, kb = rr >> 5, nb = rr & 31, g = e >> 2, el = e & 3;
        w.src = PIN(I_ED) + (size_t)(l * 16 + e) * 512 * 1024 + (size_t)kb * 64 * 1024 + nb * 32; w.N = 1024; w.dst = ws + WO_WD + ((size_t)g * 1024 + nb * 32) * 2048 + el * 512 + kb * 64; w.DP = 2048; w.f8 = 1; return w; }
}
__device__ __forceinline__ void convert_all_weights(Frame& F) {
    LAS float* scr = (LAS float*)(F.lds + F.wave * 16384);
    const int gw = F.vcu * NWAVES + F.wave, NGW = F.G * NWAVES, lane = F.lane;
    constexpr int NITEMS = DEPTH * (1792 + 512 + 3 * 4096);
    if (gw >= NITEMS) return;
    const int kr = lane >> 3, nc = 4 * (lane & 7);
    WItem cur = witem_decode(F, gw); f32x4 v[8], vn[8];
#pragma unroll
    for (int i = 0; i < 8; ++i) v[i] = *(const f32x4*)(cur.src + (size_t)(8 * i + kr) * cur.N + nc);
    for (int it = gw; it < NITEMS; it += NGW) {
        const int itn = it + NGW; const bool more = itn < NITEMS; WItem nxt = cur;
        if (more) { nxt = witem_decode(F, itn);
#pragma unroll
            for (int i = 0; i < 8; ++i) vn[i] = *(const f32x4*)(nxt.src + (size_t)(8 * i + kr) * nxt.N + nc); }
        const float sc = cur.f8 ? 32.0f : 1.0f;
#pragma unroll
        for (int i = 0; i < 8; ++i) { const int kk = 8 * i + kr; const f32x4 x = v[i] * sc; scr[kk * 33 + nc] = x.x; scr[kk * 33 + nc + 1] = x.y; scr[kk * 33 + nc + 2] = x.z; scr[kk * 33 + nc + 3] = x.w; }
        LDS_WAIT(); asm volatile("" ::: "memory");
        const int c = lane & 7;
#pragma unroll
        for (int j = 0; j < 4; ++j) { const int n = (lane >> 3) + 8 * j; const LAS float* s = scr + (8 * c) * 33 + n;
            if (cur.f8) { v2u o; o.x = pk4_fp8(s[0 * 33], s[1 * 33], s[2 * 33], s[3 * 33]); o.y = pk4_fp8(s[4 * 33], s[5 * 33], s[6 * 33], s[7 * 33]); *(GAS v2u*)(cur.dst + (size_t)n * cur.DP + 8 * c) = o; }
            else { v4u o; o.x = pk2(s[0 * 33], s[1 * 33]); o.y = pk2(s[2 * 33], s[3 * 33]); o.z = pk2(s[4 * 33], s[5 * 33]); o.w = pk2(s[6 * 33], s[7 * 33]); *(GAS v4u*)(cur.dst + (size_t)n * cur.DP + 16 * c) = o; } }
        LDS_WAIT(); asm volatile("" ::: "memory");
        if (more) { cur = nxt;
#pragma unroll
            for (int i = 0; i < 8; ++i) v[i] = vn[i]; }
    }
}

__device__ __forceinline__ void p0_prologue(Frame& F) {
    unsigned char* ws = PWS;
    {
        LAS float* sc = (LAS float*)(F.lds);
        LAS float* red = (LAS float*)(F.lds + 17 * 4096);
        bool staged = false;
        const float* pC = PIN(I_C); const float* pCC = PIN(I_CCTX); const float* pAW = PIN(I_ADAW); const float* pAB = PIN(I_ADAB); const float* pNM = PIN(I_NMIX); const float* pNF = PIN(I_NFFN);
        for (int it = F.vcu; it < DEPTH * 192; it += F.G) {
            if (!staged) {
                for (int i = F.tid; i < 17 * 1024; i += NTHR) { const float v = (i < 16 * 1024) ? pC[i] : pCC[i - 16 * 1024]; sc[i] = siluf(v); }
                staged = true;
            }
            __syncthreads();
            const int l = it / 192, cb = it % 192, n0 = cb * 32, nn = F.tid & 31, ks = F.tid >> 5;
            const float* W = pAW + (size_t)l * 1024 * 6144 + n0 + nn;
            float acc[17];
#pragma unroll
            for (int m = 0; m < 17; ++m) acc[m] = 0.f;
            for (int k = ks * 64; k < ks * 64 + 64; ++k) { const float w = W[(size_t)k * 6144];
#pragma unroll
                for (int m = 0; m < 17; ++m) acc[m] += sc[m * 1024 + k] * w; }
#pragma unroll
            for (int m = 0; m < 17; ++m) red[(ks * 17 + m) * 32 + nn] = acc[m];
            __syncthreads();
            const int kch = n0 >> 10, cc = n0 & 1023;
            float* MOD = (float*)(ws + WS_MOD) + (size_t)(l * 6 + kch) * 17 * 1024;
            for (int i = F.tid; i < 17 * 32; i += NTHR) { const int m = i >> 5, n2 = i & 31; float v = pAB[l * 6144 + n0 + n2];
#pragma unroll
                for (int k2 = 0; k2 < 16; ++k2) v += red[(k2 * 17 + m) * 32 + n2];
                const int col = cc + n2;
                if (kch == 1) v = pNM[l * 1024 + col] * (1.0f + v);
                if (kch == 4) v = pNF[l * 1024 + col] * (1.0f + v);
                MOD[m * 1024 + col] = v; }
        }
        __syncthreads();
    }
    {
        float* RC = (float*)(ws + WS_ROPE); float* RS = RC + 2048 * 32;
        for (int i = (F.vcu * NTHR + F.tid); i < 2048 * 32; i += F.G * NTHR) { const int t = i >> 5, f = i & 31; const float pos = (float)((f < 16) ? (t >> 6) : (t & 63));
            const float invf = exp2f(-(float)(f & 15) * (13.287712379549449f / 16.0f)); const float ang = pos * invf; RC[i] = cosf(ang); RS[i] = sinf(ang); }
    }
    __syncthreads();
    convert_all_weights(F);
    __syncthreads();
}
__device__ __forceinline__ void phase_norm1(Frame& F, const float* xsrc, const float* csrc, const float* nA, const float* nB, bf16* dst) {
    const int gw = F.vcu * NWAVES + F.wave, NGW = F.G * NWAVES, RPW = (MROWS + NGW - 1) / NGW;
    const int c0 = 8 * F.lane;
    int curm = -1; f32x4 a[4], bb[4];
    for (int r = gw * RPW; r < (gw + 1) * RPW && r < MROWS; ++r) {
        const int b = r / RPB, j = r - b * RPB, m = (j < L_CTX) ? 16 : b;
        const float* src = (j < L_CTX) ? csrc + (size_t)(b * L_CTX + j) * DM : xsrc + (size_t)(b * T_LAT + j - L_CTX) * DM;
        if (m != curm) { curm = m;
#pragma unroll
            for (int q = 0; q < 4; ++q) { a[q] = *(const f32x4*)(nA + m * 1024 + c0 + 512 * (q >> 1) + 4 * (q & 1)); bb[q] = *(const f32x4*)(nB + m * 1024 + c0 + 512 * (q >> 1) + 4 * (q & 1)); } }
        f32x4 v[4]; float ss = 0.f;
#pragma unroll
        for (int q = 0; q < 4; ++q) { v[q] = *(const f32x4*)(src + c0 + 512 * (q >> 1) + 4 * (q & 1)); ss += (v[q].x * v[q].x + v[q].y * v[q].y) + (v[q].z * v[q].z + v[q].w * v[q].w); }
        const float rstd = __builtin_amdgcn_rsqf(wave_sum(ss) * (1.0f / DM) + NORM_EPS);
#pragma unroll
        for (int q = 0; q < 2; ++q) { const f32x4 o0 = v[2 * q] * rstd * a[2 * q] + bb[2 * q], o1 = v[2 * q + 1] * rstd * a[2 * q + 1] + bb[2 * q + 1];
            v4u w; w.x = pk2(o0.x, o0.y); w.y = pk2(o0.z, o0.w); w.z = pk2(o1.x, o1.y); w.w = pk2(o1.z, o1.w);
            *(v4u*)(dst + (size_t)r * DM + c0 + 512 * q) = w; }
    }
}

__device__ __forceinline__ void phase_prep(Frame& F, bf16* P, const float* qn, const float* kn, const float* RC, const float* RS) {
    const int gw = F.vcu * NWAVES + F.wave, NGW = F.G * NWAVES;
    const int L = F.lane; const bool act = L < 48, isq = L < 32;
    const int col = isq ? C_AQ + 8 * L : C_AK + 8 * (L - 32), e0 = (8 * L) & 63, p0 = e0 >> 1;
    const float* gp = isq ? qn : kn; const f32x4 g0 = *(const f32x4*)(gp + e0), g1 = *(const f32x4*)(gp + e0 + 4);
    constexpr float C2 = 0.125f * 1.4426950408889634f; const float sc = isq ? C2 : 1.0f;
    for (int r0 = gw; r0 < MROWS; r0 += 4 * NGW) {
        v4u wv[4]; f32x4 cs[4], sn[4]; bool ok[4];
#pragma unroll
        for (int u = 0; u < 4; ++u) { const int r = r0 + u * NGW; ok[u] = r < MROWS; const int rr = ok[u] ? r : gw; const int b = rr / RPB, j = rr - b * RPB; const bool lat = j >= L_CTX;
            cs[u] = (f32x4){1.f, 1.f, 1.f, 1.f}; sn[u] = (f32x4){0.f, 0.f, 0.f, 0.f}; if (lat) { cs[u] = *(const f32x4*)(RC + (j - L_CTX) * 32 + p0); sn[u] = *(const f32x4*)(RS + (j - L_CTX) * 32 + p0); }
            wv[u] = act ? *(const v4u*)(P + (size_t)rr * NPROJ + col) : (v4u){0u, 0u, 0u, 0u}; }
#pragma unroll
        for (int u = 0; u < 4; ++u) { const int r = r0 + u * NGW;
            const unsigned ww[4] = {wv[u].x, wv[u].y, wv[u].z, wv[u].w}; float x[8]; float ss = 0.f;
#pragma unroll
            for (int i = 0; i < 4; ++i) { x[2 * i] = bflo(ww[i]); x[2 * i + 1] = bfhi(ww[i]); ss += x[2 * i] * x[2 * i] + x[2 * i + 1] * x[2 * i + 1]; }
            ss += xshf<1>(ss); ss += xshf<2>(ss); ss += xshf<4>(ss);
            const float rstd = __builtin_amdgcn_rsqf(ss * (1.0f / 64.0f) + NORM_EPS) * sc;
            const float gg[8] = {g0.x, g0.y, g0.z, g0.w, g1.x, g1.y, g1.z, g1.w}, cc[4] = {cs[u].x, cs[u].y, cs[u].z, cs[u].w}, sv[4] = {sn[u].x, sn[u].y, sn[u].z, sn[u].w};
            unsigned o[4];
#pragma unroll
            for (int i = 0; i < 4; ++i) { const float y1 = x[2 * i] * rstd * gg[2 * i], y2 = x[2 * i + 1] * rstd * gg[2 * i + 1]; o[i] = pk2(y1 * cc[i] - y2 * sv[i], y1 * sv[i] + y2 * cc[i]); }
            if (ok[u] && act) *(v4u*)(P + (size_t)r * NPROJ + col) = (v4u){o[0], o[1], o[2], o[3]}; }
    }
}
namespace rc {
constexpr int PT = 144, MB = 64 * PT;
constexpr int O_QP = 0, O_QQ = MB, O_KP = 2 * MB, O_VT = 3 * MB, O_ST = 4 * MB, O_AT = 5 * MB, O_TOT = 6 * MB, SLOT = 6 * MB + 2048;
constexpr int OXP = 68;
typedef float f32x16 __attribute__((ext_vector_type(16)));
typedef float f32x4v __attribute__((ext_vector_type(4)));
typedef short bf16x8 __attribute__((ext_vector_type(8)));
__device__ __forceinline__ int crow(int r, int hi) { return (r & 3) + 8 * (r >> 2) + 4 * hi; }
__device__ __forceinline__ bf16x8 frag32(const LAS unsigned char* M, int row, int kcol, int hi) { return *(const LAS bf16x8*)(M + row * PT + (kcol + hi * 8) * 2); }
__device__ __forceinline__ float clampe(float x) { return fminf(fmaxf(x, -60.f), 60.f); }
__device__ __forceinline__ int seq_of(int mixer, int b, int h, int dir) { return ((mixer * NB + b) * 4 + h) * 2 + dir; }
__device__ __forceinline__ int row_in_batch(int dir, int n) { return (dir == 0) ? n : (n < L_CTX ? (L_CTX - 1 - n) : (RPB + L_CTX - 1 - n)); }
}
struct StageARaw { v4u k[8], v[8]; };
__device__ __forceinline__ void stageA_load(StageARaw& R, const Frame& F, const bf16* P, int mixer, int b, int h, int dir, int c) {
    using namespace rc;
    const int lane = F.lane, r8 = lane >> 3, ch = lane & 7;
    const int ck = (mixer == 0 ? C_HZ + 256 * dir : C_RK) + h * 64 + 8 * ch, cv = (mixer == 0 ? C_HI : C_RV) + h * 64 + 8 * ch;
    const int j0 = row_in_batch(dir, c * 64 + r8); const long step = (dir == 0) ? 8L * NPROJ : -8L * NPROJ;
    const bf16* rp = P + (size_t)(b * RPB + j0) * NPROJ;
#pragma unroll
    for (int i = 0; i < 8; ++i) { R.k[i] = *(const v4u*)(rp + ck); R.v[i] = *(const v4u*)(rp + cv); rp += step; }
}
template <int MIXER>
__device__ __forceinline__ void stageA_compute(const StageARaw& R, Frame& F, bf16* KVS, float* DBUF, int b, int h, int dir, int c, const float* lblog, float gamma) {
    using namespace rc;
    constexpr int HP = 80;
    LAS unsigned char* WL = F.lds + F.wave * 10240; LAS unsigned char* KT = WL; LAS unsigned char* VTm = WL + 5120;
    const int lane = F.lane, seq = seq_of(MIXER, b, h, dir), r8 = lane >> 3, ch = lane & 7;
    unsigned kp[32], vp[32];
    {
        float kk[64];
#pragma unroll
        for (int i = 0; i < 8; ++i) *(LAS v4u*)(WL + (r8 + 8 * i) * PT + 16 * ch) = R.k[i];
#pragma unroll
        for (int s = 0; s < 64; ++s) kk[s] = bf1(*(const LAS unsigned short*)(WL + s * PT + 2 * lane));
        if (MIXER == 0) {
            const float lb = lblog ? sigmf(lblog[512 + dir * 256 + h * 64 + lane] - lblog[dir * 256 + h * 64 + lane]) : 0.f;
            float run = 1.f;
#pragma unroll
            for (int s = 63; s >= 0; --s) { const float f = lb + (1.0f - lb) * sigmf(kk[s]); kk[s] = (1.0f - f) * run; run *= f; }
            DBUF[(size_t)(seq * 36 + c) * 64 + lane] = run;
        } else {
            const float lg2 = __log2f(gamma);
#pragma unroll
            for (int s = 0; s < 64; ++s) kk[s] *= exp2f((float)(63 - s) * lg2);
        }
#pragma unroll
        for (int s = 0; s < 32; ++s) kp[s] = pk2(kk[2 * s], kk[2 * s + 1]);
    }
#pragma unroll
    for (int i = 0; i < 8; ++i) *(LAS v4u*)(WL + (r8 + 8 * i) * PT + 16 * ch) = R.v[i];
#pragma unroll
    for (int s = 0; s < 32; ++s) vp[s] = (unsigned)*(const LAS unsigned short*)(WL + (2 * s) * PT + 2 * lane) | ((unsigned)*(const LAS unsigned short*)(WL + (2 * s + 1) * PT + 2 * lane) << 16);
    const int r = lane & 15, g = lane >> 4;
    f32x4v acc[4][4];
#pragma unroll
    for (int a = 0; a < 4; ++a)
#pragma unroll
        for (int q = 0; q < 4; ++q) acc[a][q] = (f32x4v){0.f, 0.f, 0.f, 0.f};
#pragma unroll
    for (int hh = 0; hh < 2; ++hh) {
#pragma unroll
        for (int i = 0; i < 4; ++i) { const int s0 = 32 * hh + 8 * i; v4u ko, vo;
            ko.x = kp[s0 / 2]; ko.y = kp[s0 / 2 + 1]; ko.z = kp[s0 / 2 + 2]; ko.w = kp[s0 / 2 + 3];
            vo.x = vp[s0 / 2]; vo.y = vp[s0 / 2 + 1]; vo.z = vp[s0 / 2 + 2]; vo.w = vp[s0 / 2 + 3];
            *(LAS v4u*)(KT + lane * HP + 16 * i) = ko; *(LAS v4u*)(VTm + lane * HP + 16 * i) = vo; }
        bf16x8 af[4], bfr[4];
#pragma unroll
        for (int q = 0; q < 4; ++q) { af[q] = *(const LAS bf16x8*)(VTm + (16 * q + r) * HP + 16 * g); bfr[q] = *(const LAS bf16x8*)(KT + (16 * q + r) * HP + 16 * g); }
#pragma unroll
        for (int a = 0; a < 4; ++a)
#pragma unroll
            for (int q = 0; q < 4; ++q) acc[a][q] = __builtin_amdgcn_mfma_f32_16x16x32_bf16(af[a], bfr[q], acc[a][q], 0, 0, 0);
    }
#pragma unroll
    for (int a = 0; a < 4; ++a)
#pragma unroll
        for (int q = 0; q < 4; ++q)
#pragma unroll
            for (int x = 0; x < 4; ++x) *(LAS unsigned short*)(WL + (16 * a + 4 * g + x) * PT + (16 * q + r) * 2) = (unsigned short)f2bf(acc[a][q][x]);
    bf16* dst = KVS + (size_t)(seq * 36 + c) * 4096;
#pragma unroll
    for (int i = 0; i < 8; ++i) { const int idx = lane + 64 * i, e = idx >> 3, d8 = idx & 7; *(v4u*)(dst + e * 64 + d8 * 8) = *(const LAS v4u*)(WL + e * PT + d8 * 16); }
}
__device__ __forceinline__ void recur_stageA_loop(Frame& F, const bf16* P, bf16* KVS, float* DBUF, int u0, int stride, int nunits, const float* lblog, const float* rdec) {
    if (u0 >= nunits) return;
    StageARaw cur;
#define STA_DECODE(u_, it__) const int mh_ = ((u_) + (it__)) & 7, rest_ = (u_) >> 3, c_ = rest_ % 36, bd_ = rest_ / 36, b_ = bd_ >> 1, dir_ = bd_ & 1, mixer_ = mh_ >> 2, h_ = mh_ & 3
    int it = 0;
    for (int u = u0; u < nunits; u += stride, ++it) {
        STA_DECODE(u, it); stageA_load(cur, F, P, mixer_, b_, h_, dir_, c_);
        if (mixer_ == 0) stageA_compute<0>(cur, F, KVS, DBUF, b_, h_, dir_, c_, lblog, 0.f);
        else stageA_compute<1>(cur, F, KVS, DBUF, b_, h_, dir_, c_, nullptr, sigmf(rdec[dir_ * 4 + h_]));
    }
#undef STA_DECODE
}
template <int MIXER>
__device__ __forceinline__ void recur_stageB_seq(Frame& F, bf16* KVS, const float* DBUF, int seq, float gamma) {
    const int e = F.tid >> 3, d8 = F.tid & 7;
    bf16* base = KVS + (size_t)seq * 36 * 4096 + e * 64 + d8 * 8; const float* db = DBUF + (size_t)seq * 36 * 64 + d8 * 8;
    float S[8];
#pragma unroll
    for (int i = 0; i < 8; ++i) S[i] = 0.f;
    const float g64 = (MIXER == 1) ? exp2f(64.0f * __log2f(gamma)) : 0.f;
    constexpr int GB = 4;
    v4u kv[GB], kvn[GB]; f32x4 da[GB], dbv[GB], dan[GB], dbn[GB];
#pragma unroll
    for (int i = 0; i < GB; ++i) { kv[i] = *(const v4u*)(base + (size_t)i * 4096); da[i] = (f32x4){g64, g64, g64, g64}; dbv[i] = da[i];
        if (MIXER == 0) { da[i] = *(const f32x4*)(db + i * 64); dbv[i] = *(const f32x4*)(db + i * 64 + 4); } }
    for (int c0 = 0; c0 < 36; c0 += GB) {
#pragma unroll
        for (int i = 0; i < GB; ++i) { kvn[i] = kv[i]; dan[i] = da[i]; dbn[i] = dbv[i];
            if (c0 + GB < 36) { kvn[i] = *(const v4u*)(base + (size_t)(c0 + GB + i) * 4096); if (MIXER == 0) { dan[i] = *(const f32x4*)(db + (c0 + GB + i) * 64); dbn[i] = *(const f32x4*)(db + (c0 + GB + i) * 64 + 4); } } }
#pragma unroll
        for (int i = 0; i < GB; ++i) {
            v4u so; so.x = pk2(S[0], S[1]); so.y = pk2(S[2], S[3]); so.z = pk2(S[4], S[5]); so.w = pk2(S[6], S[7]);
            *(v4u*)(base + (size_t)(c0 + i) * 4096) = so;
            const float dd[8] = {da[i].x, da[i].y, da[i].z, da[i].w, dbv[i].x, dbv[i].y, dbv[i].z, dbv[i].w}; const unsigned kw[4] = {kv[i].x, kv[i].y, kv[i].z, kv[i].w};
#pragma unroll
            for (int q = 0; q < 4; ++q) { S[2 * q] = dd[2 * q] * S[2 * q] + bflo(kw[q]); S[2 * q + 1] = dd[2 * q + 1] * S[2 * q + 1] + bfhi(kw[q]); }
        }
#pragma unroll
        for (int i = 0; i < GB; ++i) { kv[i] = kvn[i]; da[i] = dan[i]; dbv[i] = dbn[i]; }
    }
}
struct StageCRaw { v4u q[2], k[2], v[2]; v4u s0, s1, g; };
template <int MIXER>
__device__ __forceinline__ void stageC_load(StageCRaw& R, const Frame& F, const bf16* P, const bf16* KVS, int b, int h, int tb) {
    using namespace rc;
    const int dir = F.wave >> 2, wq = F.wave & 3, lane = F.lane, tr = lane >> 3, ch = lane & 7;
    const int c = (dir == 0) ? tb : (tb < 4 ? 3 - tb : 39 - tb), seq = seq_of(MIXER, b, h, dir);
    const int cq = (MIXER == 0 ? C_HQ : C_RQ) + h * 64 + 8 * ch, ck = (MIXER == 0 ? C_HZ + 256 * dir : C_RK) + h * 64 + 8 * ch, cv = (MIXER == 0 ? C_HI : C_RV) + h * 64 + 8 * ch;
    const int j0 = row_in_batch(dir, c * 64 + 16 * wq + tr); const long step = (dir == 0) ? 8L * NPROJ : -8L * NPROJ;
    const bf16* rp = P + (size_t)(b * RPB + j0) * NPROJ;
#pragma unroll
    for (int ii = 0; ii < 2; ++ii) { R.q[ii] = *(const v4u*)(rp + cq); R.k[ii] = *(const v4u*)(rp + ck); R.v[ii] = *(const v4u*)(rp + cv); rp += step; }
    const bf16* src = KVS + (size_t)(seq * 36 + c) * 4096; const int t256 = wq * 64 + lane;
    R.s0 = *(const v4u*)(src + (t256 >> 3) * 64 + (t256 & 7) * 8); R.s1 = *(const v4u*)(src + ((t256 + 256) >> 3) * 64 + (t256 & 7) * 8);
    { const int tok = F.tid >> 3, ech = F.tid & 7; R.g = *(const v4u*)(P + (size_t)(b * RPB + tb * 64 + tok) * NPROJ + (MIXER == 0 ? C_HG : C_RG) + h * 64 + 8 * ech); }
}
template <int MIXER>
__device__ __forceinline__ void stageC_compute(const StageCRaw& R, Frame& F, bf16* ACTo, int b, int h, int tb, const float* lblog, const float* rdec, const float* gain) {
    using namespace rc;
    const int dir = F.wave >> 2, wq = F.wave & 3, lane = F.lane, tr = lane >> 3, ch = lane & 7;
    LAS unsigned char* SL = F.lds + dir * SLOT;
    { const int t256 = wq * 64 + lane;
      *(LAS v4u*)(SL + O_ST + (t256 >> 3) * PT + (t256 & 7) * 16) = R.s0; *(LAS v4u*)(SL + O_ST + ((t256 + 256) >> 3) * PT + (t256 & 7) * 16) = R.s1; }
#pragma unroll
    for (int ii = 0; ii < 2; ++ii) { const int t = 16 * wq + tr + 8 * ii; const unsigned vw[4] = {R.v[ii].x, R.v[ii].y, R.v[ii].z, R.v[ii].w};
#pragma unroll
        for (int x = 0; x < 4; ++x) { *(LAS unsigned short*)(SL + O_VT + (8 * ch + 2 * x) * PT + t * 2) = (unsigned short)(vw[x] & 0xffffu); *(LAS unsigned short*)(SL + O_VT + (8 * ch + 2 * x + 1) * PT + t * 2) = (unsigned short)(vw[x] >> 16); } }
    if (MIXER == 0) {
#pragma unroll
        for (int ii = 0; ii < 2; ++ii) { const int t = 16 * wq + tr + 8 * ii; *(LAS v4u*)(SL + O_QP + t * PT + 16 * ch) = R.q[ii]; *(LAS v4u*)(SL + O_KP + t * PT + 16 * ch) = R.k[ii]; }
        float qv[16], kv[16], q2[16];
#pragma unroll
        for (int i = 0; i < 16; ++i) { qv[i] = bf1(*(const LAS unsigned short*)(SL + O_QP + (16 * wq + i) * PT + 2 * lane)); kv[i] = bf1(*(const LAS unsigned short*)(SL + O_KP + (16 * wq + i) * PT + 2 * lane)); }
        const float lb = lblog ? sigmf(lblog[512 + dir * 256 + h * 64 + lane] - lblog[dir * 256 + h * 64 + lane]) : 0.f;
        float lc[16]; float run = 1.f;
#pragma unroll
        for (int i = 0; i < 16; ++i) { const float f = lb + (1.0f - lb) * sigmf(kv[i]); run *= f; lc[i] = run; kv[i] = 1.0f - f; }
        LAS float* TOT = (LAS float*)(SL + O_TOT); TOT[wq * 64 + lane] = run;
        __syncthreads();
        float pre = 1.f;
#pragma unroll
        for (int q = 0; q < 4; ++q) { const float t = TOT[q * 64 + lane]; if (q < wq) pre *= t; }
        const float rmid = __builtin_amdgcn_rcpf(fmaxf(TOT[lane] * TOT[64 + lane], 1e-30f));
#pragma unroll
        for (int i = 0; i < 16; ++i) { const float pt = pre * lc[i]; q2[i] = qv[i] * pt; const float e1 = fminf(fmaxf(pt * rmid, 1e-30f), 1e30f); qv[i] *= e1; kv[i] *= __builtin_amdgcn_rcpf(e1); }
#pragma unroll
        for (int i = 0; i < 16; ++i) { const int t = 16 * wq + i;
            *(LAS unsigned short*)(SL + O_QP + t * PT + lane * 2) = (unsigned short)f2bf(qv[i]);
            *(LAS unsigned short*)(SL + O_KP + t * PT + lane * 2) = (unsigned short)f2bf(kv[i]);
            *(LAS unsigned short*)(SL + O_QQ + t * PT + lane * 2) = (unsigned short)f2bf(q2[i]); }
    } else {
        const float lg2 = __log2f(sigmf(rdec[dir * 4 + h]));
#pragma unroll
        for (int ii = 0; ii < 2; ++ii) { const int t = 16 * wq + tr + 8 * ii; const float gq = exp2f((float)(t + 1) * lg2) * 0.125f;
            const unsigned qw[4] = {R.q[ii].x, R.q[ii].y, R.q[ii].z, R.q[ii].w}; v4u q1, q2v;
            { unsigned o1[4], o2[4];
#pragma unroll
              for (int x = 0; x < 4; ++x) { const float lo = bflo(qw[x]), hi2 = bfhi(qw[x]); o1[x] = pk2(lo * 0.125f, hi2 * 0.125f); o2[x] = pk2(lo * gq, hi2 * gq); }
              q1 = (v4u){o1[0], o1[1], o1[2], o1[3]}; q2v = (v4u){o2[0], o2[1], o2[2], o2[3]}; }
            *(LAS v4u*)(SL + O_QP + t * PT + 16 * ch) = q1; *(LAS v4u*)(SL + O_QQ + t * PT + 16 * ch) = q2v; *(LAS v4u*)(SL + O_KP + t * PT + 16 * ch) = R.k[ii]; }
    }
    __syncthreads();
    const int ti = wq >> 1, tj = wq & 1, r32 = lane & 31, hi = lane >> 5;
    if (tj <= ti) {
        f32x16 a = {0.f, 0.f, 0.f, 0.f, 0.f, 0.f, 0.f, 0.f, 0.f, 0.f, 0.f, 0.f, 0.f, 0.f, 0.f, 0.f};
#pragma unroll
        for (int kkk = 0; kkk < 4; ++kkk) a = __builtin_amdgcn_mfma_f32_32x32x16_bf16(frag32(SL + O_QP, 32 * ti + r32, 16 * kkk, hi), frag32(SL + O_KP, 32 * tj + r32, 16 * kkk, hi), a, 0, 0, 0);
        const float lg2 = (MIXER == 1) ? __log2f(sigmf(rdec[dir * 4 + h])) : 0.f;
#pragma unroll
        for (int r = 0; r < 16; ++r) { const int dt = 32 * (ti - tj) + crow(r, hi) - r32; float val = a[r];
            if (MIXER == 1) val *= exp2f((float)dt * lg2);
            if (dt < 0) val = 0.f;
            *(LAS unsigned short*)(SL + O_AT + (32 * ti + crow(r, hi)) * PT + (32 * tj + r32) * 2) = (unsigned short)f2bf(val); }
    }
    __syncthreads();
    f32x16 o = {0.f, 0.f, 0.f, 0.f, 0.f, 0.f, 0.f, 0.f, 0.f, 0.f, 0.f, 0.f, 0.f, 0.f, 0.f, 0.f};
#pragma unroll
    for (int st = 0; st < 2; ++st) if (st <= ti) {
#pragma unroll
        for (int kkk = 0; kkk < 2; ++kkk) o = __builtin_amdgcn_mfma_f32_32x32x16_bf16(frag32(SL + O_AT, 32 * ti + r32, 32 * st + 16 * kkk, hi), frag32(SL + O_VT, 32 * tj + r32, 32 * st + 16 * kkk, hi), o, 0, 0, 0); }
#pragma unroll
    for (int kkk = 0; kkk < 4; ++kkk) o = __builtin_amdgcn_mfma_f32_32x32x16_bf16(frag32(SL + O_QQ, 32 * ti + r32, 16 * kkk, hi), frag32(SL + O_ST, 32 * tj + r32, 16 * kkk, hi), o, 0, 0, 0);
    { LAS unsigned char* OX = F.lds + 2 * SLOT + dir * MB;
#pragma unroll
      for (int r = 0; r < 16; ++r) *(LAS unsigned short*)(OX + (32 * ti + crow(r, hi)) * PT + (32 * tj + r32) * 2) = (unsigned short)f2bf(o[r]); }
    __syncthreads();
    { const int tok = F.tid >> 3, ech = F.tid & 7, row = b * RPB + tb * 64 + tok;
      const v4u fw = *(const LAS v4u*)(F.lds + 2 * SLOT + tok * PT + 16 * ech), bw = *(const LAS v4u*)(F.lds + 2 * SLOT + MB + (63 - tok) * PT + 16 * ech);
      const unsigned fws[4] = {fw.x, fw.y, fw.z, fw.w}, bws[4] = {bw.x, bw.y, bw.z, bw.w};
      float ov[8]; float ss = 0.f;
#pragma unroll
      for (int i = 0; i < 4; ++i) { ov[2 * i] = bflo(fws[i]) + bflo(bws[i]); ov[2 * i + 1] = bfhi(fws[i]) + bfhi(bws[i]); ss += ov[2 * i] * ov[2 * i] + ov[2 * i + 1] * ov[2 * i + 1]; }
      ss += xshf<1>(ss); ss += xshf<2>(ss); ss += xshf<4>(ss);
      const float rs = __builtin_amdgcn_rsqf(ss * (1.0f / 64.0f) + NORM_EPS);
      const f32x4 ga = *(const f32x4*)(gain + h * 64 + 8 * ech), gb = *(const f32x4*)(gain + h * 64 + 8 * ech + 4);
      const float gg[8] = {ga.x, ga.y, ga.z, ga.w, gb.x, gb.y, gb.z, gb.w}; const unsigned gws[4] = {R.g.x, R.g.y, R.g.z, R.g.w};
      float res[8];
#pragma unroll
      for (int i = 0; i < 4; ++i) { res[2 * i] = ov[2 * i] * rs * gg[2 * i] * siluf(bflo(gws[i])); res[2 * i + 1] = ov[2 * i + 1] * rs * gg[2 * i + 1] * siluf(bfhi(gws[i])); }
      v4u w4; w4.x = pk2(res[0], res[1]); w4.y = pk2(res[2], res[3]); w4.z = pk2(res[4], res[5]); w4.w = pk2(res[6], res[7]);
      *(v4u*)(ACTo + (size_t)row * DM + (MIXER == 0 ? 0 : 512) + h * 64 + 8 * ech) = w4; }
}
__device__ __forceinline__ void recur_stageC_loop(Frame& F, const bf16* P, const bf16* KVS, bf16* ACTo, int mh0, int ub0, int stride, int nub, int ntb, int tboff, const float* lblog, const float* rdec, const float* hn, const float* rn) {
    if (ub0 >= nub) return;
    StageCRaw cur, nxt;
    { const int mh = mh0 & 7; if ((mh >> 2) == 0) stageC_load<0>(cur, F, P, KVS, ub0 / ntb, mh & 3, tboff + ub0 % ntb); else stageC_load<1>(cur, F, P, KVS, ub0 / ntb, mh & 3, tboff + ub0 % ntb); }
    int i = 0;
    for (int ub = ub0; ub < nub; ub += stride, ++i) {
        const int un = ub + stride; const bool more = un < nub; const int mh = (mh0 + i) & 7, mhn = (mh0 + i + 1) & 7;
        if (more) { if ((mhn >> 2) == 0) stageC_load<0>(nxt, F, P, KVS, un / ntb, mhn & 3, tboff + un % ntb); else stageC_load<1>(nxt, F, P, KVS, un / ntb, mhn & 3, tboff + un % ntb); }
        if ((mh >> 2) == 0) stageC_compute<0>(cur, F, ACTo, ub / ntb, mh & 3, tboff + ub % ntb, lblog, rdec, hn);
        else stageC_compute<1>(cur, F, ACTo, ub / ntb, mh & 3, tboff + ub % ntb, nullptr, rdec, rn);
        if (more) cur = nxt;
    }
}
__device__ __forceinline__ void phase_conv(Frame& F, const bf16* P, bf16* ACTo, const float* convw, bool latent_only) {
    const int gw = F.vcu * NWAVES + F.wave, NGW = F.G * NWAVES, rsel = F.lane >> 5, c0 = 8 * (F.lane & 31);
    f32x4 w0[2], w1[2], w2[2];
#pragma unroll
    for (int hf = 0; hf < 2; ++hf) { w0[hf] = *(const f32x4*)(convw + c0 + 4 * hf); w1[hf] = *(const f32x4*)(convw + 256 + c0 + 4 * hf); w2[hf] = *(const f32x4*)(convw + 512 + c0 + 4 * hf); }
    const int nrows = latent_only ? NB * T_LAT : MROWS;
    auto ld8 = [](const bf16* p, f32x4& a, f32x4& b) { const v4u w = *(const v4u*)p; a = (f32x4){bflo(w.x), bfhi(w.x), bflo(w.y), bfhi(w.y)}; b = (f32x4){bflo(w.z), bfhi(w.z), bflo(w.w), bfhi(w.w)}; };
    for (int idx2 = gw; 2 * idx2 < nrows; idx2 += NGW) {
        const int idx = 2 * idx2 + rsel;
        const int r = latent_only ? row_of_latent(idx) : idx;
        const int b = r / RPB, j = r - b * RPB;
        const bf16* row = P + (size_t)r * NPROJ;
        const bool first = (j == 0) || (j == L_CTX), last = (j == L_CTX - 1) || (j == RPB - 1);
        f32x4 ca, cb, ha, hb, u1a, u1b, u0a = (f32x4){0.f, 0.f, 0.f, 0.f}, u0b = u0a, u2a = u0a, u2b = u0a;
        ld8(row + C_CC + c0, ca, cb); ld8(row + C_CH + c0, ha, hb); u1a = ca * ha; u1b = cb * hb;
        if (!first) { ld8(row - NPROJ + C_CC + c0, ca, cb); ld8(row - NPROJ + C_CH + c0, ha, hb); u0a = ca * ha; u0b = cb * hb; }
        if (!last) { ld8(row + NPROJ + C_CC + c0, ca, cb); ld8(row + NPROJ + C_CH + c0, ha, hb); u2a = ca * ha; u2b = cb * hb; }
        f32x4 ba, bb2; ld8(row + C_CB + c0, ba, bb2);
        const f32x4 xa = ba * (w0[0] * u0a + w1[0] * u1a + w2[0] * u2a), xb = bb2 * (w0[1] * u0b + w1[1] * u1b + w2[1] * u2b);
        v4u w; w.x = pk2(xa.x, xa.y); w.y = pk2(xa.z, xa.w); w.z = pk2(xb.x, xb.y); w.w = pk2(xb.z, xb.w); *(v4u*)(ACTo + (size_t)r * DM + 256 + c0) = w;
    }
}
struct DenseOrder {
    int nM, nN, nwg, G, c, latent_only; const char* A; const char* Bt; size_t tA, tB;
    __device__ __forceinline__ void init(int nM_, int nN_, int G_, int c_, int lat, const void* A_, const void* Bt_, int lda, int ldb) {
        nM = nM_; nN = nN_; nwg = nM * nN; G = G_; c = c_; latent_only = lat; A = (const char*)A_; Bt = (const char*)Bt_; tA = (size_t)256 * lda * 2; tB = (size_t)256 * ldb * 2; }
    __device__ __forceinline__ bool next(int i, pg8::Unit& u) const {
        const long L = (long)i * G + c; if (L >= nwg) return false;
        int wgid = (int)L; { const int q = nwg / pg8::NXCD, r = nwg % pg8::NXCD, xcd = wgid % pg8::NXCD, off = wgid / pg8::NXCD; wgid = (xcd < r ? xcd * (q + 1) : r * (q + 1) + (xcd - r) * q) + off; }
#ifndef DENSE_WGM
#define DENSE_WGM 8
#endif
        const int nig = DENSE_WGM * nN, gid = wgid / nig, fm = gid * DENSE_WGM, gsz = (nM - fm) < DENSE_WGM ? (nM - fm) : DENSE_WGM;
        int pm = fm + ((wgid % nig) % gsz); const int pn = (wgid % nig) / gsz;
        if (latent_only) pm = (pm >> 3) * PPB + 1 + (pm & 7);
        u.pm = pm; u.pn = pn; u.x0 = 0; u.x1 = 0; u.a = A + (size_t)pm * tA; u.b = Bt + (size_t)pn * tB; u.b2 = u.b; return true; }
    __device__ __forceinline__ void a_ready(const pg8::Unit&) const {}
    __device__ __forceinline__ void done(const pg8::Unit&) const {}
};
struct MoeOrder {
    int ncol, nwg, G, c, down; const LAS int* tileb; const char* A; const char* W;
    __device__ __forceinline__ bool next(int i, pg8::Unit& u) const {
        const long L = (long)i * G + c; if (L >= nwg) return false;
        int w = (int)L; { const int q = nwg / pg8::NXCD, r = nwg % pg8::NXCD, xcd = w % pg8::NXCD, off = w / pg8::NXCD; w = (xcd < r ? xcd * (q + 1) : r * (q + 1) + (xcd - r) * q) + off; }
        const int pm = w / ncol, pc = w % ncol;
        const int k = __builtin_amdgcn_readfirstlane(tileb[pm]), g = k / 6, pr = k % 6;
        const int ea = pr < 3 ? 0 : (pr < 5 ? 1 : 2), eb = pr < 3 ? pr + 1 : (pr < 5 ? pr - 1 : 3);
        u.pm = pm; u.pn = pc; u.x0 = 0; u.x1 = 0; u.a = down ? A + (size_t)pm * 256 * 1024 : A;
        if (!down) { const int e = g * 4 + (pc < 4 ? ea : eb); u.b = W + (size_t)(e * 4 + (pc & 3)) * 256 * 1024; u.b2 = u.b; }
        else { const char* base = W + (size_t)(g * 1024 + pc * 256) * 2048; u.b = base + ea * 512; u.b2 = base + eb * 512 - 512; }
        return true; }
    __device__ __forceinline__ void a_ready(const pg8::Unit&) const {}
    __device__ __forceinline__ void done(const pg8::Unit&) const {}
};
struct EpiStore {
    static constexpr bool PERM = true, AFTER_DRAIN = false;
    bf16* O; int ldc;
    __device__ __forceinline__ void operator()(const f32x4 (&acc)[2][2][4][2], const pg8::Unit& u, int wr, int wc, int fr, int fq) const {
        const int row0 = u.pm * 256 + wr * 64 + fr, col0 = u.pn * 256 + wc * 32 + 8 * fq;
#pragma unroll
        for (int ai = 0; ai < 2; ++ai)
#pragma unroll
            for (int m = 0; m < 4; ++m) { bf16* rowp = O + (size_t)(row0 + ai * 128 + m * 16) * ldc + col0;
#pragma unroll
                for (int bj = 0; bj < 2; ++bj) { const f32x4 v0 = acc[ai][bj][m][0], v1 = acc[ai][bj][m][1];
                    v4u w; w.x = pg8::cvt_pk_bf16(v0[0], v0[1]); w.y = pg8::cvt_pk_bf16(v0[2], v0[3]); w.z = pg8::cvt_pk_bf16(v1[0], v1[1]); w.w = pg8::cvt_pk_bf16(v1[2], v1[3]);
                    *(v4u*)(rowp + bj * 128) = w; } }
    }
};
struct EpiResid {
    static constexpr bool PERM = false, AFTER_DRAIN = false;
    const float* xsrc; const float* csrc; float* xdst; float* cdst; const float* gate;
    __device__ __forceinline__ void operator()(const f32x4 (&acc)[2][2][4][2], const pg8::Unit& u, int wr, int wc, int fr, int fq) const {
        const int b = u.pm / PPB, pj = u.pm - b * PPB; const bool isc = pj == 0;
        const float* src = isc ? csrc + (size_t)b * L_CTX * DM : xsrc + (size_t)(b * T_LAT + (pj - 1) * 256) * DM;
        float* dst = isc ? cdst + (size_t)b * L_CTX * DM : xdst + (size_t)(b * T_LAT + (pj - 1) * 256) * DM;
        const int col0 = u.pn * 256 + wc * 32 + 4 * fq; const float* gp = gate + (isc ? 16 : b) * 1024 + col0;
        f32x4 gv[2][2];
#pragma unroll
        for (int bj = 0; bj < 2; ++bj)
#pragma unroll
            for (int n = 0; n < 2; ++n) gv[bj][n] = *(const f32x4*)(gp + bj * 128 + n * 16);
#pragma unroll
        for (int ai = 0; ai < 2; ++ai)
#pragma unroll
            for (int m = 0; m < 4; ++m) { const size_t off = (size_t)(ai * 128 + wr * 64 + m * 16 + fr) * DM + col0;
#pragma unroll
                for (int bj = 0; bj < 2; ++bj)
#pragma unroll
                    for (int n = 0; n < 2; ++n) *(f32x4*)(dst + off + bj * 128 + n * 16) = *(const f32x4*)(src + off + bj * 128 + n * 16) + gv[bj][n] * acc[ai][bj][m][n];
                if (m & 1) asm volatile("" ::: "memory"); }
    }
};
struct EpiGateUp {
    static constexpr bool PERM = true, AFTER_DRAIN = false;
    unsigned char* H; const v4i* rowinfo;
    __device__ __forceinline__ void operator()(const f32x4 (&acc)[2][2][4][2], const pg8::Unit& u, int wr, int wc, int fr, int fq) const {
        const int pos0 = u.pm * 256 + wr * 64 + fr, col0 = u.pn * 128 + wc * 32 + 8 * fq; const bool second = u.pn >= 4;
#pragma unroll
        for (int ai = 0; ai < 2; ++ai)
#pragma unroll
            for (int m = 0; m < 4; ++m) { const int pos = pos0 + ai * 128 + m * 16; const v4i ri = rowinfo[pos];
                const float w = __builtin_bit_cast(float, second ? ri.z : ri.y) * (16.0f / 32.0f);
                const f32x4 g0 = acc[ai][0][m][0] * (1.0f / 32.0f), g1 = acc[ai][0][m][1] * (1.0f / 32.0f), u0 = acc[ai][1][m][0], u1 = acc[ai][1][m][1];
                float h[8];
#pragma unroll
                for (int i = 0; i < 4; ++i) { h[i] = siluf(g0[i]) * u0[i] * w; h[4 + i] = siluf(g1[i]) * u1[i] * w; }
                v2u o; o.x = pk4_fp8(h[0], h[1], h[2], h[3]); o.y = pk4_fp8(h[4], h[5], h[6], h[7]);
                *(v2u*)(H + (size_t)pos * 1024 + col0) = o; }
    }
};
struct EpiDown {
    static constexpr bool PERM = false, AFTER_DRAIN = false;
    float* xdst; float* cdst; const float* gate; const v4i* rowinfo;
    __device__ __forceinline__ void operator()(const f32x4 (&acc)[2][2][4][2], const pg8::Unit& u, int wr, int wc, int fr, int fq) const {
        const int pos0 = u.pm * 256 + wr * 64 + fr, col0 = u.pn * 256 + wc * 32 + 4 * fq;
#pragma unroll
        for (int ai = 0; ai < 2; ++ai)
#pragma unroll
            for (int m = 0; m < 4; ++m) { const int r = rowinfo[pos0 + ai * 128 + m * 16].x;
#ifdef ZERO_MOE
                if (false) {
#else
                if (r >= 0) {
#endif
                    const int b = r / RPB, j = r - b * RPB; const bool isc = j < L_CTX;
                    float* dst = (isc ? cdst + (size_t)(b * L_CTX + j) * DM : xdst + (size_t)(b * T_LAT + j - L_CTX) * DM) + col0;
                    const float* gp = gate + (isc ? 16 : b) * 1024 + col0;
#pragma unroll
                    for (int bj = 0; bj < 2; ++bj)
#pragma unroll
                        for (int n = 0; n < 2; ++n) { float* p = dst + bj * 128 + n * 16; *(f32x4*)p = *(const f32x4*)p + *(const f32x4*)(gp + bj * 128 + n * 16) * (acc[ai][bj][m][n] * (1.0f / 512.0f)); } }
                if (m & 1) asm volatile("" ::: "memory"); }
    }
};

__device__ __forceinline__ void phase_norm2_route(Frame& F, int layer, const float* xsrc, const float* csrc, const float* nA, const float* nB, bf16* dst, bool latent_only) {
    typedef short bf16x8v __attribute__((ext_vector_type(8))); typedef float f32x4v __attribute__((ext_vector_type(4)));
    unsigned char* const ws = PWS;
    LAS int* cnt = (LAS int*)(F.lds + TAB_OFF);
    LAS float* MA = (LAS float*)(F.lds); LAS float* MBv = MA + 2048;
    LAS float* SSP = MA + 4096;
    LAS float* PART = SSP + 128;
    LAS float* LOG = PART + 8 * 16 * 32;
    const int lane = F.lane, wv = F.wave, r16 = lane & 15, g = lane >> 4, k0w = 128 * wv;
    const int nrows = latent_only ? NB * T_LAT : MROWS, NGW = F.G * NWAVES, RPW = (nrows + NGW - 1) / NGW, RPBLK = NWAVES * RPW;
    const int ib0 = (int)blockIdx.x * RPBLK, ib1 = (ib0 + RPBLK < nrows) ? ib0 + RPBLK : nrows;
    int mfirst = 0, mlast = 0;
    if (ib0 < ib1) { const int ra = latent_only ? row_of_latent(ib0) : ib0, rb = latent_only ? row_of_latent(ib1 - 1) : ib1 - 1;
      const int ba = ra / RPB, ja = ra - ba * RPB, bb_ = rb / RPB, jb = rb - bb_ * RPB; mfirst = (ja < L_CTX) ? 16 : ba; mlast = (jb < L_CTX) ? 16 : bb_; }
    for (int i = F.tid; i < 512; i += NTHR) { const int sl = i >> 8, c4 = (i & 255) * 4, mm = sl ? mlast : mfirst;
        *(LAS f32x4*)(MA + sl * 1024 + c4) = *(const f32x4*)(nA + mm * 1024 + c4); *(LAS f32x4*)(MBv + sl * 1024 + c4) = *(const f32x4*)(nB + mm * 1024 + c4); }
    if (F.tid < 24) cnt[F.tid] = 0;
    bf16x8v Bh[4][2], Bl[4][2];
    { const float* rgw = PIN(I_RGW) + (size_t)layer * 1024 * 4; const float* rew = PIN(I_REW) + (size_t)layer * 1024 * 16;
#pragma unroll
      for (int s = 0; s < 4; ++s)
#pragma unroll
          for (int t = 0; t < 2; ++t) { const int n = 16 * t + r16, kb = k0w + 32 * s + 8 * g; unsigned hw[4], lw[4];
#pragma unroll
              for (int i2 = 0; i2 < 4; ++i2) { float w0 = 0.f, w1 = 0.f;
                  if (n < 4) { w0 = rgw[(kb + 2 * i2) * 4 + n]; w1 = rgw[(kb + 2 * i2 + 1) * 4 + n]; } else if (n < 20) { w0 = rew[(kb + 2 * i2) * 16 + n - 4]; w1 = rew[(kb + 2 * i2 + 1) * 16 + n - 4]; }
                  const unsigned hp = pk2(w0, w1); hw[i2] = hp; lw[i2] = pk2(w0 - bflo(hp), w1 - bfhi(hp)); }
              Bh[s][t] = __builtin_bit_cast(bf16x8v, (v4u){hw[0], hw[1], hw[2], hw[3]}); Bl[s][t] = __builtin_bit_cast(bf16x8v, (v4u){lw[0], lw[1], lw[2], lw[3]}); } }
    float biasn = 0.f; { const int n = F.tid & 31; if (n < 4) biasn = PIN(I_RGB)[layer * 4 + n]; else if (n < 20) biasn = PIN(I_REB)[layer * 16 + n - 4]; }
    v4i* ROUTE = (v4i*)(ws + WS_ROUTE);
    __syncthreads();
    for (int g0 = ib0; g0 < ib1; g0 += 16) {
        const bool valid = (g0 + r16) < ib1; const int idx = valid ? g0 + r16 : ib1 - 1;
        const int r = latent_only ? row_of_latent(idx) : idx;
        const int b = r / RPB, j = r - b * RPB, m = (j < L_CTX) ? 16 : b, slot = (m != mfirst) ? 1024 : 0;
        const float* src = ((j < L_CTX) ? csrc + (size_t)(b * L_CTX + j) * DM : xsrc + (size_t)(b * T_LAT + j - L_CTX) * DM) + k0w + 8 * g;
        f32x4 xv[4][2]; float ss = 0.f;
#pragma unroll
        for (int s = 0; s < 4; ++s) { xv[s][0] = *(const f32x4*)(src + 32 * s); xv[s][1] = *(const f32x4*)(src + 32 * s + 4); }
#pragma unroll
        for (int s = 0; s < 4; ++s)
#pragma unroll
            for (int hh = 0; hh < 2; ++hh) { const f32x4 x = xv[s][hh]; ss += (x.x * x.x + x.y * x.y) + (x.z * x.z + x.w * x.w); }
        ss += xshf<16>(ss); ss = half_sum(ss);
        if (lane < 16) SSP[wv * 16 + lane] = ss;
        __syncthreads();
        float tot = 0.f;
#pragma unroll
        for (int w2 = 0; w2 < 8; ++w2) tot += SSP[w2 * 16 + r16];
        const float rstd = __builtin_amdgcn_rsqf(tot * (1.0f / DM) + NORM_EPS);
        f32x4v acc[2] = {{0.f, 0.f, 0.f, 0.f}, {0.f, 0.f, 0.f, 0.f}};
        unsigned char* drow = (unsigned char*)dst + (size_t)r * DM + k0w + 8 * g;
#pragma unroll
        for (int s = 0; s < 4; ++s) { const int co = slot + k0w + 32 * s + 8 * g;
            const f32x4 h0 = xv[s][0] * rstd * *(const LAS f32x4*)(MA + co) + *(const LAS f32x4*)(MBv + co), h1 = xv[s][1] * rstd * *(const LAS f32x4*)(MA + co + 4) + *(const LAS f32x4*)(MBv + co + 4);
            { v2u o; o.x = pk4_fp8(h0.x, h0.y, h0.z, h0.w); o.y = pk4_fp8(h1.x, h1.y, h1.z, h1.w); *(v2u*)(drow + 32 * s) = o; }
            const unsigned p0 = pk2(h0.x, h0.y), p1 = pk2(h0.z, h0.w), p2 = pk2(h1.x, h1.y), p3 = pk2(h1.z, h1.w);
            const unsigned q0 = pk2(h0.x - bflo(p0), h0.y - bfhi(p0)), q1 = pk2(h0.z - bflo(p1), h0.w - bfhi(p1)), q2 = pk2(h1.x - bflo(p2), h1.y - bfhi(p2)), q3 = pk2(h1.z - bflo(p3), h1.w - bfhi(p3));
            const bf16x8v Ah = __builtin_bit_cast(bf16x8v, (v4u){p0, p1, p2, p3}), Al = __builtin_bit_cast(bf16x8v, (v4u){q0, q1, q2, q3});
#pragma unroll
            for (int t = 0; t < 2; ++t) { acc[t] = __builtin_amdgcn_mfma_f32_16x16x32_bf16(Ah, Bh[s][t], acc[t], 0, 0, 0); acc[t] = __builtin_amdgcn_mfma_f32_16x16x32_bf16(Ah, Bl[s][t], acc[t], 0, 0, 0);
                acc[t] = __builtin_amdgcn_mfma_f32_16x16x32_bf16(Al, Bh[s][t], acc[t], 0, 0, 0); } }
#pragma unroll
        for (int t = 0; t < 2; ++t)
#pragma unroll
            for (int x = 0; x < 4; ++x) PART[(wv * 16 + 4 * g + x) * 32 + 16 * t + r16] = acc[t][x];
        __syncthreads();
        { const int row = F.tid >> 5, n = F.tid & 31; float v = biasn;
#pragma unroll
          for (int w2 = 0; w2 < 8; ++w2) v += PART[(w2 * 16 + row) * 32 + n];
          LOG[row * 32 + n] = v; }
        __syncthreads();
        if (F.tid < 16 && (g0 + F.tid) < ib1) {
            const int rr = latent_only ? row_of_latent(g0 + F.tid) : g0 + F.tid;
            float l[20];
#pragma unroll
            for (int jj = 0; jj < 20; ++jj) l[jj] = LOG[F.tid * 32 + jj];
            int gsel = 0; float gm = l[0];
#pragma unroll
            for (int q = 1; q < 4; ++q) if (l[q] > gm) { gm = l[q]; gsel = q; }
            float gs = 0.f;
#pragma unroll
            for (int q = 0; q < 4; ++q) gs += __expf(l[q] - gm);
            const float gp = 1.0f / gs;
            float le[4];
#pragma unroll
            for (int q = 0; q < 4; ++q) le[q] = (gsel == 0) ? l[4 + q] : (gsel == 1) ? l[8 + q] : (gsel == 2) ? l[12 + q] : l[16 + q];
            int e1 = 0; float m1 = le[0];
#pragma unroll
            for (int q = 1; q < 4; ++q) if (le[q] > m1) { m1 = le[q]; e1 = q; }
            int e2 = -1; float m2 = 0.f;
#pragma unroll
            for (int q = 0; q < 4; ++q) if (q != e1 && (e2 < 0 || le[q] > m2)) { m2 = le[q]; e2 = q; }
            const float bexp = __expf(m2 - m1), w1 = gp / (1.0f + bexp), w2 = gp * bexp / (1.0f + bexp);
            const int ea = e1 < e2 ? e1 : e2, eb = e1 < e2 ? e2 : e1; const float wa = e1 < e2 ? w1 : w2, wb = e1 < e2 ? w2 : w1;
            const int pidx = ea == 0 ? eb - 1 : (ea == 1 ? eb + 1 : 5), bucket = gsel * 6 + pidx;
            const int rank = atomicAdd((int*)(cnt + bucket), 1); ROUTE[rr] = (v4i){bucket, rank, __builtin_bit_cast(int, wa), __builtin_bit_cast(int, wb)};
        }
    }
    __syncthreads();
    if (F.tid < 24) ((int*)(ws + WS_BCNT))[blockIdx.x * 24 + F.tid] = cnt[F.tid];
    __syncthreads();
}

__device__ __forceinline__ void phase_scatter(Frame& F, bool latent_only) {
    unsigned char* const ws = PWS;
    LAS int* tab = (LAS int*)(F.lds + TAB_OFF);
    const int* BC = (const int*)(ws + WS_BCNT);
    if (F.tid < 384) { const int k = F.tid >> 4, part = F.tid & 15; int tot = 0, below = 0;
        for (int bb = part * 16; bb < part * 16 + 16 && bb < F.G; ++bb) { const int v = BC[bb * 24 + k]; tot += v; if (bb < (int)blockIdx.x) below += v; }
        tot += xshi<1>(tot); tot += xshi<2>(tot); tot += xshi<4>(tot); tot += xshi<8>(tot); below += xshi<1>(below); below += xshi<2>(below); below += xshi<4>(below); below += xshi<8>(below);
        if (part == 0) { tab[32 + k] = tot; tab[k] = below; } }
    __syncthreads();
    if (F.tid == 0) { int tb = 0; for (int k = 0; k < 24; ++k) { const int nt = (tab[32 + k] + 255) >> 8; tab[64 + k] = tb; tab[96 + k] = nt; tab[k] += tb * 256; tb += nt; } tab[128] = tb; }
    __syncthreads();
    v4i* ROWINFO = (v4i*)(ws + WS_ROWINFO);
    if (blockIdx.x == 0) { int* TI = (int*)(ws + WS_TILEINFO); if (F.tid == 0) TI[0] = tab[128];
        if (F.tid < 24) { const int t0 = tab[64 + F.tid], nt = tab[96 + F.tid]; for (int t = 0; t < nt; ++t) TI[1 + t0 + t] = F.tid; } }
    for (int k = blockIdx.x; k < 24; k += F.G) { const int p0 = tab[64 + k] * 256 + tab[32 + k], p1 = (tab[64 + k] + tab[96 + k]) * 256;
        for (int p = p0 + F.tid; p < p1; p += NTHR) ROWINFO[p] = (v4i){-1, 0, 0, 0}; }
    const int nrows = latent_only ? NB * T_LAT : MROWS, NGW = F.G * NWAVES, RPW = (nrows + NGW - 1) / NGW, gwb = (int)blockIdx.x * NWAVES + F.wave;
    const v4i* ROUTE = (const v4i*)(ws + WS_ROUTE);
    { const int i0 = gwb * RPW, i1 = (i0 + RPW < nrows) ? i0 + RPW : nrows;
      if (i0 + F.lane < i1) { const int idx = i0 + F.lane, r = latent_only ? row_of_latent(idx) : idx; const v4i ri = ROUTE[r]; ROWINFO[tab[ri.x] + ri.y] = (v4i){r, ri.z, ri.w, 0}; } }
    __syncthreads();
}
#if DEBUG_CHECK
__device__ __forceinline__ unsigned dbg_hash(unsigned x) { x ^= x >> 16; x *= 0x7feb352du; x ^= x >> 15; x *= 0x846ca68bu; x ^= x >> 16; return x; }
__device__ __forceinline__ void dbg_fail(Frame& F, int bit) { atomicOr((unsigned*)(F.ctl + CW_ERR), 1u << bit); }
__device__ __forceinline__ void dbg_check_gemm_bf16(Frame& F, const bf16* A, const bf16* Bt, const bf16* O, int ldo, int bit) {
    const int s = F.vcu * NTHR + F.tid;
    if (s < 16384) { const int row = dbg_hash(2 * s + 1) % MROWS, col = dbg_hash(2 * s + 2) % 3072; float ref = 0.f;
        for (int k = 0; k < 1024; ++k) ref += bf1(A[(size_t)row * 1024 + k]) * bf1(Bt[(size_t)col * 1024 + k]);
        const float got = bf1(O[(size_t)row * ldo + col]);
        if (!(fabsf(got - ref) <= 0.02f * fabsf(ref) + 0.05f)) dbg_fail(F, bit); }
}
__device__ __forceinline__ float naive_attn_row(Frame& F, const bf16* P, int b, int h, int j) {
    LAS float* pl = (LAS float*)(F.lds) + F.wave * 2304;
    const bf16* Pb = P + (size_t)b * RPB * NPROJ; const bf16* q = Pb + (size_t)j * NPROJ + C_AQ + h * 64;
    const int nk = (j < L_CTX) ? 4 : 36;
    float sc[36]; float mx = -1e30f;
#pragma unroll
    for (int i = 0; i < 36; ++i) { sc[i] = -1e30f; if (i < nk) { const bf16* k = Pb + (size_t)(i * 64 + F.lane) * NPROJ + C_AK + (h >> 1) * 64; float a = 0.f;
        for (int d = 0; d < 64; ++d) a += bf1(q[d]) * bf1(k[d]);
        sc[i] = a; mx = fmaxf(mx, a); } }
    mx = fmaxf(mx, xshf<1>(mx)); mx = fmaxf(mx, xshf<2>(mx)); mx = fmaxf(mx, xshf<4>(mx)); mx = fmaxf(mx, xshf<8>(mx)); mx = fmaxf(mx, xshf<16>(mx));
    mx = half_max(mx);
    float sum = 0.f;
#pragma unroll
    for (int i = 0; i < 36; ++i) { const float p = (i < nk) ? exp2f(sc[i] - mx) : 0.f; sum += p; pl[i * 64 + F.lane] = p; }
    sum = wave_sum(sum); LDS_WAIT(); asm volatile("" ::: "memory");
    float o = 0.f;
    for (int key = 0; key < nk * 64; ++key) o += pl[key] * bf1(Pb[(size_t)key * NPROJ + C_AV + (h >> 1) * 64 + F.lane]);
    LDS_WAIT(); asm volatile("" ::: "memory");
    return o / sum;
}
__device__ __forceinline__ void dbg_check_attn(Frame& F, const bf16* P, const bf16* ACT_, int bit, bool with_ctx) {
    const int s = F.vcu * NWAVES + F.wave;
    const int b = dbg_hash(3 * s + 1) % NB, h = dbg_hash(3 * s + 2) % 4; int j = L_CTX + dbg_hash(3 * s + 3) % T_LAT;
    if (with_ctx && (s & 7) == 0) j = dbg_hash(3 * s + 3) % L_CTX;
    const float o = naive_attn_row(F, P, b, h, j);
    const float got = bf1(ACT_[(size_t)(b * RPB + j) * DM + 768 + h * 64 + F.lane]);
    if (!(fabsf(got - o) <= 0.03f * fabsf(o) + 0.02f)) dbg_fail(F, j < L_CTX ? bit + 1 : bit);
    __syncthreads();
}
__device__ __forceinline__ void dbg_check_outproj(Frame& F, const float* xsrc, const float* xdst, const bf16* ACT_, const bf16* Wt, const float* gate, int bit) {
    const int s = F.vcu * NTHR + F.tid;
    if (s < 16384) { const int idx = dbg_hash(2 * s + 5) % (NB * T_LAT), col = dbg_hash(2 * s + 6) % DM, r = row_of_latent(idx), b = idx >> 11; float ref = 0.f;
        for (int k = 0; k < 1024; ++k) ref += bf1(ACT_[(size_t)r * 1024 + k]) * bf1(Wt[(size_t)col * 1024 + k]);
        ref = xsrc[(size_t)idx * DM + col] + gate[b * 1024 + col] * ref;
        const float got = xdst[(size_t)idx * DM + col];
        if (!(fabsf(got - ref) <= 0.01f * fabsf(ref) + 0.01f)) dbg_fail(F, bit); }
}
__device__ __forceinline__ void dbg_check_gateup(Frame& F, const unsigned char* A8, const unsigned char* Wgu8, const unsigned char* H8, const v4i* rowinfo, const LAS int* tileb, int ntiles, int bit) {
    const int s = F.vcu * NTHR + F.tid;
    if (s < 16384) { const int pos = dbg_hash(2 * s + 7) % (ntiles * 256), hc = dbg_hash(2 * s + 8) % 1024; const v4i ri = rowinfo[pos];
        if (ri.x >= 0) { const int k = tileb[pos >> 8], g = k / 6, pr = k % 6; const int ea = pr < 3 ? 0 : (pr < 5 ? 1 : 2), eb = pr < 3 ? pr + 1 : (pr < 5 ? pr - 1 : 3);
            const int e = g * 4 + (hc < 512 ? ea : eb), jj = hc & 511; const float wgt = __builtin_bit_cast(float, hc < 512 ? ri.y : ri.z);
            const unsigned char* wg = Wgu8 + ((size_t)e * 1024 + (jj >> 7) * 256 + (jj & 127)) * 1024; const unsigned char* wu = wg + 128 * 1024; float ga = 0.f, up = 0.f;
            for (int q = 0; q < 1024; ++q) { const float a = fp8_dec(A8[(size_t)ri.x * 1024 + q]); ga += a * fp8_dec(wg[q]); up += a * fp8_dec(wu[q]); }
            const float ref = 16.0f * siluf(ga * (1.0f / 32.0f)) * (up * (1.0f / 32.0f)) * wgt, got = fp8_dec(H8[(size_t)pos * 1024 + hc]);
            if (!(fabsf(got - ref) <= 0.08f * fabsf(ref) + 0.02f)) dbg_fail(F, bit); } }
}
__device__ __forceinline__ void dbg_check_mix(Frame& F, const bf16* P, const bf16* act, const float* lblog, const float* rdec, const float* hn, const float* rn) {
    const int s = F.vcu * NWAVES + F.wave, lane = F.lane;
    const int mixer = s & 1, b = dbg_hash(5 * s + 1) % NB, h = dbg_hash(5 * s + 2) % 4, j = L_CTX + dbg_hash(5 * s + 3) % T_LAT;
    float osum = 0.f;
    for (int dir = 0; dir < 2; ++dir) {
        const float lb = (mixer == 0 && lblog) ? sigmf(lblog[512 + dir * 256 + h * 64 + lane] - lblog[dir * 256 + h * 64 + lane]) : 0.f;
        const float gamma = sigmf(rdec[dir * 4 + h]);
        const int nt = (dir == 0) ? j : (RPB + L_CTX - 1 - j);
        float S[64];
#pragma unroll
        for (int dd = 0; dd < 64; ++dd) S[dd] = 0.f;
        float o = 0.f;
        for (int n = 0; n <= nt; ++n) { const bf16* rp = P + (size_t)(b * RPB + rc::row_in_batch(dir, n)) * NPROJ;
            float f, k, q, v;
            if (mixer == 0) { f = lb + (1.0f - lb) * sigmf(bf1(rp[C_HZ + 256 * dir + h * 64 + lane])); k = 1.0f - f; q = bf1(rp[C_HQ + h * 64 + lane]); v = bf1(rp[C_HI + h * 64 + lane]); }
            else { f = gamma; k = bf1(rp[C_RK + h * 64 + lane]); q = 0.125f * bf1(rp[C_RQ + h * 64 + lane]); v = bf1(rp[C_RV + h * 64 + lane]); }
            o = 0.f;
#pragma unroll
            for (int dd = 0; dd < 64; ++dd) { const float fd = __builtin_bit_cast(float, __builtin_amdgcn_readlane(__builtin_bit_cast(int, f), dd)), kd = __builtin_bit_cast(float, __builtin_amdgcn_readlane(__builtin_bit_cast(int, k), dd)),
                    qd = __builtin_bit_cast(float, __builtin_amdgcn_readlane(__builtin_bit_cast(int, q), dd));
                S[dd] = fd * S[dd] + kd * v; o += qd * S[dd]; } }
        osum += o;
    }
    const float rs = 1.0f / sqrtf(wave_sum(osum * osum) * (1.0f / 64.0f) + NORM_EPS);
    const float g = bf1(P[(size_t)(b * RPB + j) * NPROJ + (mixer == 0 ? C_HG : C_RG) + h * 64 + lane]);
    const float ref = osum * rs * (mixer == 0 ? hn : rn)[h * 64 + lane] * siluf(g);
    const float got = bf1(act[(size_t)(b * RPB + j) * DM + (mixer == 0 ? 0 : 512) + h * 64 + lane]);
    const float se = wave_sum(fabsf(got - ref)), sr = wave_sum(fabsf(ref));
    if (!(se <= 0.03f * sr + 0.3f)) dbg_fail(F, mixer == 0 ? 6 : 7);
}
__device__ __forceinline__ void dbg_check_norm1(Frame& F, const bf16* act, const float* MODp) {
    const int s = F.vcu * NTHR + F.tid;
    if (s < 8192) { const int r = dbg_hash(2 * s + 11) % MROWS, c = dbg_hash(2 * s + 12) % DM, b = r / RPB, j = r - b * RPB, m = (j < L_CTX) ? 16 : b;
        const float* src = (j < L_CTX) ? PIN(I_CTX) + (size_t)(b * L_CTX + j) * DM : PIN(I_X) + (size_t)(b * T_LAT + j - L_CTX) * DM;
        const float* cv = (j < L_CTX) ? PIN(I_CCTX) : PIN(I_C) + b * 1024; const float* aw = PIN(I_ADAW); const float* ab = PIN(I_ADAB);
        float ss = 0.f, sh = ab[c], scl = ab[1024 + c];
        for (int k = 0; k < 1024; ++k) { ss += src[k] * src[k]; const float sv = siluf(cv[k]); sh += sv * aw[(size_t)k * 6144 + c]; scl += sv * aw[(size_t)k * 6144 + 1024 + c]; }
        const float nA = PIN(I_NMIX)[c] * (1.0f + scl);
        const float gB = MODp[0 * 17 * 1024 + m * 1024 + c], gA = MODp[1 * 17 * 1024 + m * 1024 + c];
        if (!(fabsf(gB - sh) <= 1e-3f * fabsf(sh) + 1e-3f)) dbg_fail(F, 2);
        if (!(fabsf(gA - nA) <= 1e-3f * fabsf(nA) + 1e-3f)) dbg_fail(F, 3);
        const float ref = src[c] * (1.0f / sqrtf(ss / 1024.0f + NORM_EPS)) * gA + gB;
        const float got = bf1(act[(size_t)r * DM + c]);
        if (!(fabsf(got - ref) <= 0.01f * fabsf(ref) + 0.01f)) dbg_fail(F, 4); }
}
__device__ __forceinline__ void dbg_apply(Frame& F, float* out, unsigned* barw) {
    unsigned m = __hip_atomic_load((unsigned*)(F.ctl + CW_ERR), RLX_AGENT);
    if (__hip_atomic_load(barw + XB_TMO, RLX_AGENT) != 0u) m |= 32u;
    if (m) { const float sc = 1.0f + 10.0f * exp2f(0.33219f * (float)m); for (size_t i = (size_t)F.vcu * NTHR + F.tid; i < (size_t)NB * T_LAT * DM; i += (size_t)F.G * NTHR) out[i] *= sc; }
}
#endif
#ifndef NAIVE_ATTN
#define NAIVE_ATTN 0
#endif
#if NAIVE_ATTN && DEBUG_CHECK
__device__ __forceinline__ void phase_naive_attn(Frame& F, const bf16* P, bf16* ACT_, bool latent_only) {
    const int gw = F.vcu * NWAVES + F.wave, NGW = F.G * NWAVES;
    for (int it = gw; it < MROWS * 4; it += NGW) { const int r = it >> 2, h = it & 3, b = r / RPB, j = r - b * RPB;
        if (latent_only && j < L_CTX) continue;
        const float o = naive_attn_row(F, P, b, h, j);
        ACT_[(size_t)r * DM + 768 + h * 64 + F.lane] = (bf16)f2bf(o); }
    __syncthreads();
}
#endif
#ifndef SKIPMASK
#define SKIPMASK 0
#endif
#ifdef REP_BAR
#define GRID_BAR_X() xcd_barrier(bar)
#else
#define GRID_BAR_X() do {} while (0)
#endif
#define GRID_BAR() do { GRID_BAR_X(); xcd_barrier(bar); { int t_ = F.tid; asm volatile("" : "+v"(t_)); F.tid = t_; F.lane = t_ & 63; F.wave = __builtin_amdgcn_readfirstlane(t_ >> 6); } ws = PWS; } while (0)
#define ACT ((bf16*)(ws + WS_ACT))
#define P ((bf16*)(ws + WS_P))
#define CTXB ((float*)(ws + WS_CTX))
#define ORET ((bf16*)(ws + WS_ORET))
template <int layer> __device__ __forceinline__ void layer_body(Frame& F, XcdBarrier& bar, unsigned char* lds) {
    LAS int* const tileb = (LAS int*)(F.lds + TAB_OFF + 1024);
    unsigned char* ws = PWS;
        const bool lastl = (layer == DEPTH - 1);
        const float* xsrc = (layer == 0) ? PIN(I_X) : (const float*)POUT;
        const float* csrc = (layer == 0) ? PIN(I_CTX) : (const float*)CTXB;
        const float* MOD = (const float*)(ws + WS_MOD) + (size_t)layer * 6 * 17 * 1024;
        #if !(SKIPMASK & 1)
        phase_norm1(F, xsrc, csrc, MOD + 1 * 17 * 1024, MOD + 0 * 17 * 1024, ACT);
#ifdef REP_N1
        phase_norm1(F, xsrc, csrc, MOD + 1 * 17 * 1024, MOD + 0 * 17 * 1024, ACT);
#endif
#endif

        GRID_BAR();
#if DEBUG_CHECK
        if (layer == 0) dbg_check_norm1(F, ACT, MOD);
#endif
        #if !(SKIPMASK & 2)
        {
            pg8::Gemm g{DM, DM, DM, nullptr}; DenseOrder S; S.init(NPANEL, NPROJ / 256, F.G, (int)blockIdx.x, 0, ACT, (const bf16*)(ws + WS_W0 + (size_t)layer * WLAYER + WO_WIN), DM, DM);
            EpiStore E{P, NPROJ};
#ifndef REP_INPROJ
#define REP_INPROJ 1
#endif
            pg8::gemm_phase<EpiStore, DenseOrder, false, true>(F.lds + RING_OFF, g, S, E, F.tid);
#if REP_INPROJ == 2
            __syncthreads();
            pg8::gemm_phase<EpiStore, DenseOrder, false, true>(F.lds + RING_OFF, g, S, E, F.tid);
#endif
        }
#endif

        GRID_BAR();
#if DEBUG_CHECK
        dbg_check_gemm_bf16(F, ACT, (const bf16*)(ws + WS_W0 + (size_t)layer * WLAYER + WO_WIN), P, NPROJ, 0);
#endif
        #if !(SKIPMASK & 4)
        phase_prep(F, P, PIN(I_QN) + layer * 64, PIN(I_KN) + layer * 64, (const float*)(ws + WS_ROPE), (const float*)(ws + WS_ROPE) + 2048 * 32);
#endif

        {
            bf16* KVS = (bf16*)(ws + WS_KVS); float* DBUF = (float*)(ws + WS_DBUF); const float* lbl = (layer == 0) ? nullptr : PIN(I_LB); const float* rdec = PIN(I_RDEC) + layer * 8;
#ifndef REP_A
#define REP_A 1
#endif
            for (int rp_REP_A = 0; rp_REP_A < REP_A; ++rp_REP_A)
            recur_stageA_loop(F, P, KVS, DBUF, F.vcu * NWAVES + F.wave, F.G * NWAVES, 256 * 36, lbl, rdec);
        }
        GRID_BAR();
        {
            { bf16* KVS = (bf16*)(ws + WS_KVS); const float* DBUF = (const float*)(ws + WS_DBUF); const float* rdec = PIN(I_RDEC) + layer * 8;
#ifndef REP_B
#define REP_B 1
#endif
            for (int rp_REP_B = 0; rp_REP_B < REP_B; ++rp_REP_B)
              for (int seq = F.vcu; seq < 256; seq += F.G) { const int mixer = seq >> 7, h = (seq >> 1) & 3, dir = seq & 1;
                  if (mixer == 0) recur_stageB_seq<0>(F, KVS, DBUF, seq, 0.f); else recur_stageB_seq<1>(F, KVS, DBUF, seq, sigmf(rdec[dir * 4 + h])); } }

#if NAIVE_ATTN && DEBUG_CHECK
            phase_naive_attn(F, P, ACT, lastl);
#elif !(SKIPMASK & 16)
        const int nunits = lastl ? 512 : 576;
#ifndef REP_ATTN
#define REP_ATTN 1
#endif
            for (int rep_ = 0; rep_ < REP_ATTN; ++rep_)
            for (int u = F.vcu; u < nunits; u += F.G) {
                int b, h, qb; if (u < 512) { b = u >> 5; h = (u >> 3) & 3; qb = 1 + (u & 7); } else { b = (u - 512) >> 2; h = u & 3; qb = 0; }
                const attn_body::bf16* Pb = (const attn_body::bf16*)P + (size_t)b * RPB * NPROJ;
                attn_body::attn_unit<8>(qb * 256, qb == 0 ? 4 : 36, Pb + C_AQ + h * 64, Pb + C_AK + (h >> 1) * 64, Pb + C_AV + (h >> 1) * 64,
                                        (attn_body::bf16*)ACT + (size_t)b * RPB * DM + 768 + h * 64, (char*)lds + RING_OFF, F.tid);
            }
#endif

        }
        GRID_BAR();
        {
            const bf16* KVS = (const bf16*)(ws + WS_KVS); const float* lbl = (layer == 0) ? nullptr : PIN(I_LB); const float* rdec = PIN(I_RDEC) + layer * 8;
            const float* hn = PIN(I_HNORM) + layer * 256; const float* rn = PIN(I_RNORM) + layer * 256;
            const int ntb = lastl ? 32 : 36;
#ifndef REP_C
#define REP_C 1
#endif
            for (int rp_REP_C = 0; rp_REP_C < REP_C; ++rp_REP_C)
            recur_stageC_loop(F, P, KVS, ACT, F.vcu & 7, F.vcu >> 3, (F.G >= 8) ? (F.G >> 3) : 1, 16 * ntb, ntb, lastl ? 4 : 0, lbl, rdec, hn, rn);
            phase_conv(F, P, ACT, PIN(I_CONVW) + layer * 768, lastl);
#ifdef REP_CONV
            phase_conv(F, P, ACT, PIN(I_CONVW) + layer * 768, lastl);
#endif
        }
        GRID_BAR();
#if DEBUG_CHECK
        dbg_check_mix(F, P, ACT, layer == 0 ? nullptr : PIN(I_LB), PIN(I_RDEC) + layer * 8, PIN(I_HNORM) + layer * 256, PIN(I_RNORM) + layer * 256);
#endif
#if DEBUG_CHECK
        dbg_check_attn(F, P, ACT, 1, !lastl);
#endif
        #if !(SKIPMASK & 64)
        {
            pg8::Gemm g{DM, DM, DM, nullptr}; DenseOrder S; S.init(lastl ? NB * 8 : NPANEL, 4, F.G, (int)blockIdx.x, lastl ? 1 : 0, ACT, (const bf16*)(ws + WS_W0 + (size_t)layer * WLAYER + WO_WOUT), DM, DM);
            EpiResid E{xsrc, csrc, POUT, CTXB, MOD + 2 * 17 * 1024};
            pg8::gemm_phase<EpiResid, DenseOrder, true, true>(F.lds + RING_OFF, g, S, E, F.tid);
        }
#endif

        GRID_BAR();
#if DEBUG_CHECK
        if (layer == 0) dbg_check_outproj(F, PIN(I_X), POUT, ACT, (const bf16*)(ws + WS_W0 + (size_t)layer * WLAYER + WO_WOUT), MOD + 2 * 17 * 1024, 3);
        GRID_BAR();
#endif
        #if !(SKIPMASK & 128)
        phase_norm2_route(F, layer, (const float*)POUT, (const float*)CTXB, MOD + 4 * 17 * 1024, MOD + 3 * 17 * 1024, ACT, lastl);
#ifdef REP_N2
        phase_norm2_route(F, layer, (const float*)POUT, (const float*)CTXB, MOD + 4 * 17 * 1024, MOD + 3 * 17 * 1024, ACT, lastl);
#endif
#endif

        GRID_BAR();
        #if !(SKIPMASK & 256)
        phase_scatter(F, lastl);
#ifdef REP_N2
        phase_scatter(F, lastl);
#endif
#endif

        GRID_BAR();
        #if !(SKIPMASK & 512)
        {
            const int* TI = (const int*)(ws + WS_TILEINFO); const int ntiles = TI[0];
            for (int i = F.tid; i < MAXTILES; i += NTHR) tileb[i] = (i < ntiles) ? TI[1 + i] : 0;
            __syncthreads();
            pg8::Gemm g{512, 512, 512, nullptr};
            g.rowidx = (const int*)(ws + WS_ROWINFO);
            MoeOrder S; S.ncol = 8; S.nwg = ntiles * 8; S.G = F.G; S.c = (int)blockIdx.x; S.down = 0; S.tileb = tileb; S.A = (const char*)(ws + WS_ACT); S.W = (const char*)(ws + WS_W0 + (size_t)layer * WLAYER + WO_WGU);
            EpiGateUp E{ws + WS_H, (const v4i*)(ws + WS_ROWINFO)};
#ifndef REP_GU
#define REP_GU 1
#endif
            pg8::gemm_phase<EpiGateUp, MoeOrder, true, true, true, true>(F.lds + RING_OFF, g, S, E, F.tid);
#if REP_GU == 2
            __syncthreads();
            pg8::gemm_phase<EpiGateUp, MoeOrder, true, true, true, true>(F.lds + RING_OFF, g, S, E, F.tid);
#endif
        }
#endif

        GRID_BAR();
#if DEBUG_CHECK
        { const int* TI = (const int*)(ws + WS_TILEINFO); dbg_check_gateup(F, ws + WS_ACT, ws + WS_W0 + (size_t)layer * WLAYER + WO_WGU, ws + WS_H, (const v4i*)(ws + WS_ROWINFO), tileb, TI[0], 4); }
#endif
        #if !(SKIPMASK & 1024)
        {
            const int* TI = (const int*)(ws + WS_TILEINFO); const int ntiles = TI[0];
            pg8::Gemm g{512, 1024, 512, nullptr};
            MoeOrder S; S.ncol = 4; S.nwg = ntiles * 4; S.G = F.G; S.c = (int)blockIdx.x; S.down = 1; S.tileb = tileb; S.A = (const char*)(ws + WS_H); S.W = (const char*)(ws + WS_W0 + (size_t)layer * WLAYER + WO_WD);
            EpiDown E{POUT, CTXB, MOD + 5 * 17 * 1024, (const v4i*)(ws + WS_ROWINFO)};
            pg8::gemm_phase<EpiDown, MoeOrder, true, true, false, true>(F.lds + RING_OFF, g, S, E, F.tid);
        }
#endif

        GRID_BAR();
    }
__global__ void __launch_bounds__(NTHR, 2) fwd_kernel(Args args) {
    extern __shared__ __attribute__((aligned(16))) unsigned char lds[];
    Frame F;
    F.lds = (LAS unsigned char*)lds;
    F.MISC = (volatile LAS unsigned*)(F.lds + MISC_OFF);
    F.tid = threadIdx.x; F.lane = F.tid & 63; F.wave = __builtin_amdgcn_readfirstlane(F.tid >> 6);
    F.G = gridDim.x; { const int bx = blockIdx.x; F.vcu = (F.G % 8 == 0) ? (bx % 8) * (F.G / 8) + bx / 8 : bx; }
    F.ctl = (gu32*)(args.ws + WS_CTL);
    for (int u = F.tid; u < (LDS_BYTES - LDSCTL_OFF) / 4; u += NTHR) ((LAS unsigned*)(F.lds + LDSCTL_OFF))[u] = 0u;
    __syncthreads();
    if (F.tid == 0) { volatile LAS unsigned long long* pt = (volatile LAS unsigned long long*)(F.lds + PTAB_OFF);
#pragma unroll
        for (int i = 0; i < 24; ++i) pt[i] = (unsigned long long)args.in[i];
        pt[24] = (unsigned long long)args.out; pt[25] = (unsigned long long)args.ws; }
    __syncthreads();
    XcdBarrier bar = xcd_barrier_post((unsigned*)(F.ctl + CW_BAR), F.MISC + 8);
    unsigned char* ws = PWS;

    #if !(SKIPMASK & 2048)
        p0_prologue(F);
#ifdef REP_PRO
        __syncthreads(); p0_prologue(F);
#endif
#endif

    GRID_BAR();

    layer_body<0>(F, bar, lds);
    layer_body<1>(F, bar, lds);
#if DEBUG_CHECK
    dbg_apply(F, POUT, bar.bar);
#endif
}

extern "C" void kernel_launch(void* const* d_in, const int* in_sizes, int n_in, void* d_out, int out_size, void* d_ws, size_t ws_size, hipStream_t stream) {
    static int grid = 0;
    if (grid == 0) {
        if (n_in != 24 || out_size != NB * T_LAT * DM || ws_size < WS_END) { fprintf(stderr, "kernel_launch: unexpected shapes (n_in %d, out %d, ws %zu); nothing launched\n", n_in, out_size, ws_size); grid = -1; return; }
        int dev = 0, cus = 0, per_cu = 0;
        if (hipGetDevice(&dev) != hipSuccess || hipDeviceGetAttribute(&cus, hipDeviceAttributeMultiprocessorCount, dev) != hipSuccess) { grid = -1; return; }
        if (hipFuncSetAttribute((const void*)fwd_kernel, hipFuncAttributeMaxDynamicSharedMemorySize, LDS_BYTES) != hipSuccess) { grid = -1; return; }
        if (hipOccupancyMaxActiveBlocksPerMultiprocessor(&per_cu, (const void*)fwd_kernel, NTHR, LDS_BYTES) != hipSuccess || per_cu < 1) { fprintf(stderr, "kernel_launch: occupancy query says %d blocks per CU\n", per_cu); grid = -1; return; }
        (void)hipGetLastError();
        grid = cus < 256 ? cus : 256;
    }
    if (grid < 0) return;
    if (hipMemsetAsync((char*)d_ws + WS_CTL, 0, CTL_ZERO_BYTES, stream) != hipSuccess) return;
    Args a{};
    for (int i = 0; i < 24; ++i) a.in[i] = (const float*)d_in[i];
    a.out = (float*)d_out; a.ws = (unsigned char*)d_ws;
    hipLaunchKernelGGL(fwd_kernel, dim3(grid), dim3(NTHR), LDS_BYTES, stream, a);
}
```

```cpp
#define SPLIT_BC 1
#define EARLY_INV 1

#define MOD_WIDE 1
#define SPLIT_PRO 1
#define SPLIT_OP 1


#define EMU_TILES 0

#define INPROJ_F8MASK 0x3F02

#include <hip/hip_runtime.h>
#ifdef NT_LOADS
#define LDNT(p) __builtin_nontemporal_load(p)
#else
#define LDNT(p) (*(p))
#endif
#include <hip/hip_bf16.h>
#include <cstdio>
#include <cstdint>
#include <cmath>
#ifndef DEBUG_CHECK
#define DEBUG_CHECK 0
#endif
#define DENSE_WGM 4
#ifndef NAIVE_ATTN
#define NAIVE_ATTN 0
#endif

namespace pg8 {
#define PG8_LAS __attribute__((address_space(3)))
typedef unsigned short bf16_t;
typedef short bf16x8 __attribute__((ext_vector_type(8)));
typedef float f32x4 __attribute__((ext_vector_type(4)));
typedef unsigned u32x4 __attribute__((ext_vector_type(4)));
constexpr int BM = 256, BK = 64, HALF = 128, HTB = HALF * BK * 2  , STAGE_BYTES = 8 * HTB, NXCD = 8, WGM = 8;

__host__ __device__ __forceinline__ int lds_byte(int r, int c) { const int st = (r >> 4) * 2 + (c >> 5), rr = r & 15, cc = c & 31, ob = rr * 64 + cc * 2; return st * 1024 + (ob ^ (((ob >> 9) & 1) << 5)); }
__host__ __device__ __forceinline__ void stage_rc(int b, int& R, int& C) { const int st = b / 1024, sb = b % 1024, swz = sb ^ (((sb >> 9) & 1) << 5); R = (st >> 1) * 16 + swz / 64; C = (st & 1) * 32 + (swz % 64) / 2; }
__host__ __device__ __forceinline__ void stage_rc8(int b, int& R, int& C) { const int blk = b >> 11, rr = (b >> 7) & 15, ps = (b >> 5) & 3, k = (b >> 4) & 1, gl = ps ^ ((rr >> 1) & 3); R = blk * 16 + rr; C = (gl * 2 + k) * 8; }
__host__ __device__ __forceinline__ int perm32(int rho) { const int n = rho >> 4, i = rho & 15; return 8 * (i >> 2) + 4 * n + (i & 3); }

struct Unit { const char* a; const char* b; const char* b2; int pm, pn, x0, x1; };
struct Gemm { int lda, ldb, K; const int* rowidx; };
typedef int i32x8 __attribute__((ext_vector_type(8)));
typedef int i32x4 __attribute__((ext_vector_type(4)));
__device__ __forceinline__ i32x8 pg8_cat(bf16x8 a, bf16x8 b) { const i32x4 x = __builtin_bit_cast(i32x4, a), y = __builtin_bit_cast(i32x4, b); return (i32x8){x[0], x[1], x[2], x[3], y[0], y[1], y[2], y[3]}; }
__device__ __forceinline__ unsigned cvt_pk_bf16(float lo, float hi) { unsigned r; asm volatile("v_cvt_pk_bf16_f32 %0, %1, %2" : "=v"(r) : "v"(lo), "v"(hi)); return r; }

template <class Epi, class Sched, bool ALIGN_EPI = false, bool SP2 = false, bool GATHER = false, bool FP8 = false, bool APAIR = false>
__device__ __forceinline__ void gemm_phase(PG8_LAS unsigned char* lds, const Gemm g, const Sched& S, const Epi& E, const int tid) {
    const int wid = __builtin_amdgcn_readfirstlane(tid >> 6), lane = tid & 63, wr = wid >> 2, wc = wid & 3, fr = lane & 15, fq = lane >> 4;
    const int K = g.K, nt = K / BK;
    unsigned voffA[2], voffB[2];
#pragma unroll
    for (int i = 0; i < 2; ++i) { int R, C; if constexpr (FP8) stage_rc8(tid * 16 + i * 8192, R, C); else stage_rc(tid * 16 + i * 8192, R, C); const int Rb = Epi::PERM ? ((R & ~31) + perm32(R & 31)) : R;
        voffA[i] = APAIR ? (unsigned)((R >> 1) * g.lda * 4 + ((2 * C) >> 6) * 128 + (R & 1) * 64 + ((2 * C) & 63)) : (unsigned)(R * g.lda + C) * 2u; voffB[i] = (unsigned)(Rb * g.ldb + C) * 2u; }
    unsigned gc[2][2] = {{0u, 0u}, {0u, 0u}}, gn[2][2] = {{0u, 0u}, {0u, 0u}}; int gR[2] = {0, 0}, gC[2] = {0, 0};
    if constexpr (GATHER) {
#pragma unroll
        for (int i = 0; i < 2; ++i) { if constexpr (FP8) stage_rc8(tid * 16 + i * 8192, gR[i], gC[i]); else stage_rc(tid * 16 + i * 8192, gR[i], gC[i]); } }
#define PG8_GOFF(dst, un_) do { _Pragma("unroll") for (int _h = 0; _h < 2; ++_h) _Pragma("unroll") for (int _i = 0; _i < 2; ++_i) { \
        const int _p = (un_).x0 + _h * 128 + gR[_i]; int _r = (_p < (un_).x1) ? g.rowidx[(size_t)_p * 4] : 0; _r = _r < 0 ? 0 : _r; dst[_h][_i] = (unsigned)(_r * g.lda + gC[_i]) * 2u; } } while (0)
    const size_t kstep = (size_t)(BK * 2);
    const size_t kstepA = APAIR ? kstep * 2 : kstep;
    const size_t hstepA = (size_t)HALF * g.lda * 2, hstepB = (size_t)HALF * g.ldb * 2;
    const unsigned ldsw = (unsigned)wid * 1024u;
    const int aoff = FP8 ? (wr * 4) * 2048 + fr * 128 + ((fq ^ ((fr >> 1) & 3)) * 32) : lds_byte(wr * 64 + fr, fq * 8), boff = FP8 ? (wc * 2) * 2048 + fr * 128 + ((fq ^ ((fr >> 1) & 3)) * 32) : lds_byte(wc * 32 + fr, fq * 8);
#define PG8_SA(b, h) (((b) * 2 + (h)) * HTB)
#define PG8_SB(b, h) ((4 + (b) * 2 + (h)) * HTB)
#define PG8_STAGE(bufoff, gbase, voff) do { _Pragma("unroll") for (int _i = 0; _i < 2; ++_i) \
        __builtin_amdgcn_global_load_lds((const unsigned*)((const char*)(gbase) + (voff)[_i]), (PG8_LAS unsigned*)(lds + (bufoff) + ldsw + _i * 8192), 16, 0, 0); } while (0)
#define PG8_STAGE_A(bufoff, tbase, hh, NX) do { if constexpr (GATHER) { _Pragma("unroll") for (int _i = 0; _i < 2; ++_i) { const unsigned _o = (NX) ? gn[hh][_i] : gc[hh][_i]; \
        __builtin_amdgcn_global_load_lds((const unsigned*)((const char*)(tbase) + _o), (PG8_LAS unsigned*)(lds + (bufoff) + ldsw + _i * 8192), 16, 0, 0); } } \
        else { PG8_STAGE(bufoff, (tbase) + (hh) * hstepA, voffA); } } while (0)
#define PG8_LDA(dst, b, h) do { if constexpr (FP8) { _Pragma("unroll") for (int m = 0; m < 4; ++m) dst##8[m] = *(const PG8_LAS i32x8*)(lds + PG8_SA(b, h) + aoff + m * 2048); } \
        else { _Pragma("unroll") for (int m = 0; m < 4; ++m) _Pragma("unroll") for (int k = 0; k < 2; ++k) dst[m][k] = *(const PG8_LAS bf16x8*)(lds + PG8_SA(b, h) + aoff + m * 2048 + k * 1024); } } while (0)
#define PG8_LDB(dst, b, h) do { if constexpr (FP8) { _Pragma("unroll") for (int n = 0; n < 2; ++n) dst##8[n] = *(const PG8_LAS i32x8*)(lds + PG8_SB(b, h) + boff + n * 2048); } \
        else { _Pragma("unroll") for (int n = 0; n < 2; ++n) _Pragma("unroll") for (int k = 0; k < 2; ++k) dst[n][k] = *(const PG8_LAS bf16x8*)(lds + PG8_SB(b, h) + boff + n * 2048 + k * 1024); } } while (0)
#define PG8_MMA(ai, bj, At, Bt) do { __builtin_amdgcn_s_setprio(1); if constexpr (FP8) { _Pragma("unroll") for (int m = 0; m < 4; ++m) _Pragma("unroll") for (int n = 0; n < 2; ++n) \
        asm volatile("v_mfma_scale_f32_16x16x128_f8f6f4 %0, %1, %2, %0, %3, %3 op_sel_hi:[0,0,0]" : "+v"(acc[ai][bj][m][n]) : "v"(Bt##8[n]), "v"(At##8[m]), "v"(pg8_one)); }     \
        else { _Pragma("unroll") for (int m = 0; m < 4; ++m) _Pragma("unroll") for (int n = 0; n < 2; ++n) _Pragma("unroll") for (int k = 0; k < 2; ++k) \
        acc[ai][bj][m][n] = __builtin_amdgcn_mfma_f32_16x16x32_bf16(Bt[n][k], At[m][k], acc[ai][bj][m][n], 0, 0, 0); } __builtin_amdgcn_s_setprio(0); } while (0)
#define PG8_WAIT_V(n) asm volatile("s_waitcnt vmcnt(" #n ")" ::: "memory")
#define PG8_WAIT_L(n) asm volatile("s_waitcnt lgkmcnt(" #n ")" ::: "memory")
#define PG8_BAR __builtin_amdgcn_s_barrier()
#define PG8_SCHED __builtin_amdgcn_sched_barrier(0)
    Unit cur, nxt; int ui = 0;
    if (!S.next(0, cur)) return;
    f32x4 acc[2][2][4][2];
#pragma unroll
    for (int a = 0; a < 2; ++a)
#pragma unroll
        for (int b = 0; b < 2; ++b)
#pragma unroll
            for (int m = 0; m < 4; ++m)
#pragma unroll
                for (int n = 0; n < 2; ++n) acc[a][b][m][n] = (f32x4){0.f, 0.f, 0.f, 0.f};
    const int pg8_one = 0x7f7f7f7f;
    bf16x8 At[4][2], B0[2][2], B1[2][2];
    i32x8 At8[4], B08[2], B18[2];
    const char* cA = cur.a; const char* cB = cur.b; const char* cB2 = cur.b2; const int nth = nt >> 1;
    if constexpr (GATHER) { PG8_GOFF(gc, cur); }
    S.a_ready(cur);
    if constexpr (SP2) {
        PG8_STAGE(PG8_SB(0, 0), cB, voffB); PG8_STAGE(PG8_SB(0, 1), cB + hstepB, voffB); PG8_STAGE_A(PG8_SA(0, 0), cA, 0, false); PG8_STAGE_A(PG8_SA(0, 1), cA, 1, false);
        if (wr == 1) PG8_BAR;
        PG8_WAIT_V(2); PG8_BAR;
        PG8_STAGE(PG8_SB(1, 0), cB + kstep, voffB); PG8_STAGE_A(PG8_SA(1, 0), cA + kstepA, 0, false); PG8_STAGE(PG8_SB(1, 1), cB + hstepB + kstep, voffB);
        PG8_WAIT_V(6); PG8_BAR;
    } else {
        PG8_STAGE(PG8_SB(0, 0), cB, voffB); PG8_STAGE_A(PG8_SA(0, 0), cA, 0, false); PG8_STAGE(PG8_SB(0, 1), cB + hstepB, voffB); PG8_STAGE_A(PG8_SA(0, 1), cA, 1, false);
        if (wr == 1) PG8_BAR;
        PG8_WAIT_V(4); PG8_BAR;
        PG8_STAGE(PG8_SB(1, 0), cB + kstep, voffB); PG8_STAGE_A(PG8_SA(1, 0), cA + kstepA, 0, false); PG8_STAGE(PG8_SB(1, 1), cB + hstepB + kstep, voffB);
        PG8_WAIT_V(6); PG8_BAR;
    }
    for (;;) {
        const bool has_next = S.next(ui + 1, nxt);
        if constexpr (GATHER) { if (has_next) { PG8_GOFF(gn, nxt); } }
        const char* nA = has_next ? nxt.a : cA; const char* nB = has_next ? nxt.b : cB;
#pragma nounroll
        for (int t = 0; t < nt; t += 2) {
            const bool last = (t == nt - 2);
            const char* a1 = cA + (size_t)(t + 1) * kstepA;
            const char* a2 = last ? nA : cA + (size_t)(t + 2) * kstepA; const char* b2 = last ? nB : ((t + 2 < nth) ? cB : cB2) + (size_t)(t + 2) * kstep;
            const char* a3 = a2 + kstepA; const char* b3 = b2 + kstep;
            if (last && has_next) S.a_ready(nxt);
            if constexpr (SP2) {
            PG8_LDB(B0, 0, 0); PG8_LDB(B1, 0, 1); PG8_SCHED; PG8_LDA(At, 0, 0); PG8_STAGE_A(PG8_SA(1, 1), a1, 1, false);
            PG8_WAIT_V(8); PG8_WAIT_L(0); PG8_BAR; PG8_MMA(0, 0, At, B0); PG8_MMA(0, 1, At, B1); PG8_BAR; PG8_SCHED;
            PG8_LDA(At, 0, 1); PG8_STAGE(PG8_SB(0, 0), b2, voffB); PG8_STAGE(PG8_SB(0, 1), b2 + hstepB, voffB); PG8_STAGE_A(PG8_SA(0, 0), a2, 0, last);
            PG8_WAIT_V(8); PG8_WAIT_L(0); PG8_BAR; PG8_MMA(1, 0, At, B0); PG8_MMA(1, 1, At, B1); PG8_BAR; PG8_SCHED;
            PG8_LDB(B0, 1, 0); PG8_LDB(B1, 1, 1); PG8_SCHED; PG8_LDA(At, 1, 0); PG8_STAGE_A(PG8_SA(0, 1), a2, 1, last);
            PG8_WAIT_V(8); PG8_WAIT_L(0); PG8_BAR; PG8_MMA(0, 0, At, B0); PG8_MMA(0, 1, At, B1); PG8_BAR; PG8_SCHED;
            PG8_LDA(At, 1, 1); PG8_STAGE(PG8_SB(1, 0), b3, voffB); PG8_STAGE(PG8_SB(1, 1), b3 + hstepB, voffB); PG8_STAGE_A(PG8_SA(1, 0), a3, 0, last);
            PG8_WAIT_V(8); PG8_WAIT_L(0); PG8_BAR; PG8_MMA(1, 0, At, B0); PG8_MMA(1, 1, At, B1); PG8_BAR; PG8_SCHED;
            } else {
            PG8_LDB(B0, 0, 0); PG8_SCHED; PG8_LDA(At, 0, 0); PG8_STAGE_A(PG8_SA(1, 1), a1, 1, false);
            PG8_WAIT_L(8); PG8_BAR; PG8_WAIT_L(0); PG8_MMA(0, 0, At, B0); PG8_BAR; PG8_SCHED;
            PG8_LDB(B1, 0, 1); PG8_STAGE(PG8_SB(0, 0), b2, voffB);
            PG8_BAR; PG8_WAIT_L(0); PG8_MMA(0, 1, At, B1); PG8_BAR;
            PG8_LDA(At, 0, 1); PG8_STAGE_A(PG8_SA(0, 0), a2, 0, last);
            PG8_BAR; PG8_WAIT_L(0); PG8_MMA(1, 0, At, B0); PG8_BAR; PG8_SCHED;
            PG8_STAGE(PG8_SB(0, 1), b2 + hstepB, voffB);
            PG8_WAIT_V(6); PG8_BAR; PG8_MMA(1, 1, At, B1); PG8_BAR;
            PG8_LDB(B0, 1, 0); PG8_SCHED; PG8_LDA(At, 1, 0); PG8_STAGE_A(PG8_SA(0, 1), a2, 1, last);
            PG8_WAIT_L(8); PG8_BAR; PG8_WAIT_L(0); PG8_MMA(0, 0, At, B0); PG8_BAR; PG8_SCHED;
            PG8_LDB(B1, 1, 1); PG8_STAGE(PG8_SB(1, 0), b3, voffB);
            PG8_BAR; PG8_WAIT_L(0); PG8_MMA(0, 1, At, B1); PG8_BAR;
            PG8_LDA(At, 1, 1); PG8_STAGE_A(PG8_SA(1, 0), a3, 0, last);
            PG8_BAR; PG8_WAIT_L(0); PG8_MMA(1, 0, At, B0); PG8_BAR; PG8_SCHED;
            PG8_STAGE(PG8_SB(1, 1), b3 + hstepB, voffB);
            PG8_WAIT_V(6); PG8_BAR; PG8_MMA(1, 1, At, B1); PG8_BAR;
            }
        }
        if constexpr (FP8) asm volatile("s_nop 15\n\ts_nop 7" ::: "memory");
        if constexpr (ALIGN_EPI) { if (wr == 0) PG8_BAR; }
        if constexpr (!Epi::AFTER_DRAIN) { E(acc, cur, wr, wc, fr, fq); S.done(cur); }
        if (!has_next) break;
#pragma unroll
        for (int a = 0; a < 2; ++a)
#pragma unroll
            for (int b = 0; b < 2; ++b)
#pragma unroll
                for (int m = 0; m < 4; ++m)
#pragma unroll
                    for (int n = 0; n < 2; ++n) acc[a][b][m][n] = (f32x4){0.f, 0.f, 0.f, 0.f};
        cur = nxt; cA = nA; cB = nB; cB2 = nxt.b2; ++ui;
        if constexpr (GATHER) { _Pragma("unroll") for (int _h = 0; _h < 2; ++_h) _Pragma("unroll") for (int _i = 0; _i < 2; ++_i) gc[_h][_i] = gn[_h][_i]; }
        if constexpr (ALIGN_EPI) { if (wr == 1) PG8_BAR; }
    }
    PG8_WAIT_V(0);
    if constexpr (!ALIGN_EPI) { if (wr == 0) PG8_BAR; }
    PG8_BAR;
    if constexpr (Epi::AFTER_DRAIN) { E.fused(acc, cur, wr, wc, fr, fq, lds, wid, lane); S.done(cur); }
#undef PG8_SA
#undef PG8_SB
#undef PG8_STAGE
#undef PG8_LDA
#undef PG8_STAGE_A
#undef PG8_GOFF
#undef PG8_LDB
#undef PG8_MMA
#undef PG8_WAIT_V
#undef PG8_WAIT_L
#undef PG8_BAR
#undef PG8_SCHED
}
}

#include <hip/hip_bf16.h>
#include <cmath>
namespace attn_body {
using bf16=__hip_bfloat16;
using bf16x8=__attribute__((ext_vector_type(8)))short;
using s16x4=__attribute__((ext_vector_type(4)))short;
using f32x16=__attribute__((ext_vector_type(16)))float;
using u32x4=__attribute__((ext_vector_type(4)))unsigned;
constexpr int D=64, QP=3584, KP=3584, VP=3584, OP=1024;
constexpr int NW=8,QBLK=32,QB=QBLK*NW,KVBLK=64;
constexpr int ATTN_UNIT_ROWS=QB;
__device__ __forceinline__ int crow(int r,int hi){return (r&3)+8*(r>>2)+4*hi;}
#define SBAR() __builtin_amdgcn_sched_barrier(0)
__device__ __forceinline__ void cmask(f32x16&p0,f32x16&p1,int jb,int qrel,int hi){
  const float NEG=-INFINITY; int kb=64*jb+4*hi;
  #pragma unroll
  for(int r=0;r<16;++r){int kv=kb+(r&3)+8*(r>>2); if(kv>qrel)p0[r]=NEG; if(kv+32>qrel)p1[r]=NEG;}
}

constexpr int NSLOT=3, SLOTB=8192;
constexpr int LDS_K=0, LDS_V=NSLOT*SLOTB, LDS_WS=2*NSLOT*SLOTB, LDS_OST=LDS_WS+NW*64*4, LDS_BYTES=LDS_OST+NW*4096;
constexpr float C2=0.125f*1.4426950408889634f;
__device__ __forceinline__ void glds16(const void*gsrc,unsigned lds_dst){unsigned keep;
  asm volatile("s_mov_b32 %0, m0\n\ts_mov_b32 m0, %2\n\ts_nop 0\n\tglobal_load_lds_dwordx4 %1, off\n\ts_mov_b32 m0, %0":"=&s"(keep):"v"(gsrc),"s"(lds_dst):"memory");}
__device__ __forceinline__ float max3f(float a,float b,float c){float r;asm("v_max3_f32 %0, %1, %2, %3":"=v"(r):"v"(a),"v"(b),"v"(c));return r;}
__device__ __forceinline__ float max2f(float a,float b){float r;asm("v_max_f32_e32 %0, %1, %2":"=v"(r):"v"(a),"v"(b));return r;}
__device__ __forceinline__ float fadd_s(float a,float b){float r;asm("v_add_f32_e32 %0, %1, %2":"=v"(r):"v"(a),"v"(b));return r;}
__device__ __forceinline__ float fsub_s(float a,float b){float r;asm("v_sub_f32_e32 %0, %1, %2":"=v"(r):"v"(a),"v"(b));return r;}
typedef float f32x2_t __attribute__((ext_vector_type(2))); typedef __bf16 bf16x2_t __attribute__((ext_vector_type(2)));
__device__ __forceinline__ unsigned cvtpk_s(float lo,float hi){f32x2_t v={lo,hi};bf16x2_t b=__builtin_convertvector(v,bf16x2_t);return __builtin_bit_cast(unsigned,b);}
#define WAIT_BAR(N) asm volatile("s_waitcnt vmcnt(" #N ") lgkmcnt(0)\n\ts_barrier":::"memory")

__device__ __forceinline__ void qkt(f32x16&p0,f32x16&p1,const char*Kslot,const bf16x8*qr,const f32x16&negm,int r32,int hi){
  const char*kb=Kslot+hi*1024+r32*16;
  #pragma unroll
  for(int d0=0;d0<4;++d0){
    const bf16x8 b0=*reinterpret_cast<const bf16x8*>(kb+d0*2048);
    const bf16x8 b1=*reinterpret_cast<const bf16x8*>(kb+d0*2048+512);
    if(d0==0){p0=__builtin_amdgcn_mfma_f32_32x32x16_bf16(b0,qr[0],negm,0,0,0);p1=__builtin_amdgcn_mfma_f32_32x32x16_bf16(b1,qr[0],negm,0,0,0);}
    else{p0=__builtin_amdgcn_mfma_f32_32x32x16_bf16(b0,qr[d0],p0,0,0,0);p1=__builtin_amdgcn_mfma_f32_32x32x16_bf16(b1,qr[d0],p1,0,0,0);}}
}
typedef __attribute__((address_space(3))) const char* lds_cptr;
typedef short v4i16_t __attribute__((ext_vector_type(4)));
__device__ __forceinline__ void kload8(bf16x8*kf,lds_cptr kp){
  kf[0]=*(const __attribute__((address_space(3))) bf16x8*)(kp);      kf[1]=*(const __attribute__((address_space(3))) bf16x8*)(kp+512);
  kf[2]=*(const __attribute__((address_space(3))) bf16x8*)(kp+2048); kf[3]=*(const __attribute__((address_space(3))) bf16x8*)(kp+2560);
  kf[4]=*(const __attribute__((address_space(3))) bf16x8*)(kp+4096); kf[5]=*(const __attribute__((address_space(3))) bf16x8*)(kp+4608);
  kf[6]=*(const __attribute__((address_space(3))) bf16x8*)(kp+6144); kf[7]=*(const __attribute__((address_space(3))) bf16x8*)(kp+6656);
}
__device__ __forceinline__ void kload2(bf16x8*kf,lds_cptr kp,int j){ kf[2*j]=*(const __attribute__((address_space(3))) bf16x8*)(kp+j*2048); kf[2*j+1]=*(const __attribute__((address_space(3))) bf16x8*)(kp+j*2048+512); }
__device__ __forceinline__ s16x4 vtr(lds_cptr p){ return __builtin_bit_cast(s16x4,__builtin_amdgcn_ds_read_tr16_b64_v4i16((__attribute__((address_space(3))) v4i16_t*)p)); }
__device__ __forceinline__ float rowmax(const f32x16&p0,const f32x16&p1){
  float a=max3f(p0[0],p0[1],p1[0]),b=max3f(p0[2],p0[3],p1[1]);a=max3f(a,p1[2],p1[3]);
  #pragma unroll
  for(int r=4;r<16;r+=4){a=max3f(a,p0[r],p0[r+1]);b=max3f(b,p0[r+2],p0[r+3]);a=max3f(a,p1[r],p1[r+1]);b=max3f(b,p1[r+2],p1[r+3]);}
  const float m=max2f(a,b);
  auto rr=__builtin_amdgcn_permlane32_swap(__float_as_uint(m),__float_as_uint(m),false,false);
  return max2f(__uint_as_float(rr[0]),__uint_as_float(rr[1]));
}
__device__ __forceinline__ void pv(f32x16*o,int vb,bf16x8 pa0,bf16x8 pa1,bf16x8 pa2,bf16x8 pa3){
  #pragma unroll
  for(int d0=0;d0<2;++d0){s16x4 lo[4],hi[4];
    #pragma unroll
    for(int ks=0;ks<4;++ks){
      asm volatile("ds_read_b64_tr_b16 %0,%1 offset:%c2":"=&v"(lo[ks]):"v"(vb),"i"(d0*4096+ks*1024):"memory");
      asm volatile("ds_read_b64_tr_b16 %0,%1 offset:%c2":"=&v"(hi[ks]):"v"(vb),"i"(d0*4096+ks*1024+512):"memory");}
    asm volatile("s_waitcnt lgkmcnt(0)":::"memory");SBAR();
    #define PK(k) (bf16x8){lo[k][0],lo[k][1],lo[k][2],lo[k][3],hi[k][0],hi[k][1],hi[k][2],hi[k][3]}
    o[d0]=__builtin_amdgcn_mfma_f32_32x32x16_bf16(pa0,PK(0),o[d0],0,0,0);
    o[d0]=__builtin_amdgcn_mfma_f32_32x32x16_bf16(pa1,PK(1),o[d0],0,0,0);
    o[d0]=__builtin_amdgcn_mfma_f32_32x32x16_bf16(pa2,PK(2),o[d0],0,0,0);
    o[d0]=__builtin_amdgcn_mfma_f32_32x32x16_bf16(pa3,PK(3),o[d0],0,0,0);
    #undef PK
  }
}

#ifndef ATTN_STORE16
#define ATTN_STORE16(p,v) (*(u32x4*)(p)=(v))
#endif
template<int THRL> __device__ __forceinline__ void attn_unit(int q0,int NT,const bf16*Qh,const bf16*__restrict__ Kh,const bf16*__restrict__ Vh,bf16*Oh,char*shm,const int tid){
  const int lane=tid&63,r32=lane&31,hi=lane>>5; const int wid=__builtin_amdgcn_readfirstlane(tid>>6);
  const bf16*Qw=Qh+(long)(q0+wid*QBLK)*QP;
  const unsigned lds0=(unsigned)(uintptr_t)shm;
  float*wsf=(float*)(shm+LDS_WS)+wid*64;
  const bf16*ksrc=Kh+(long)lane*KP+wid*8;
  const bf16*vsrc=Vh+(long)(16*(wid&3)+(lane>>2))*VP+(wid>>2)*32+(lane&3)*8;
  const unsigned kdst=lds0+LDS_K+wid*1024, vdst=lds0+LDS_V+wid*1024;
  #define DMA_K(t,slot) glds16(ksrc+(long)(t)*KVBLK*KP,(unsigned)__builtin_amdgcn_readfirstlane(kdst+(slot)))
  #define DMA_V(t,slot) glds16(vsrc+(long)(t)*KVBLK*VP,(unsigned)__builtin_amdgcn_readfirstlane(vdst+(slot)))
  const int vb0=(int)(lds0+LDS_V)+((lane>>4)&1)*32+(lane&3)*8+(4*hi+((lane&15)>>2))*64;
  const char*Kbase=shm+LDS_K; bf16x8 kf[8];
  const lds_cptr shm3=(lds_cptr)shm; const lds_cptr kp0=shm3+LDS_K+hi*1024+r32*16; const lds_cptr vp0=shm3+LDS_V+((lane>>4)&1)*32+(lane&3)*8+(4*hi+((lane&15)>>2))*64;
  DMA_K(0,0);DMA_V(0,0);DMA_K(1,SLOTB);
  bf16x8 qr[4];
  #pragma unroll
  for(int d0=0;d0<4;++d0)qr[d0]=*reinterpret_cast<const bf16x8*>(&Qw[(long)r32*QP+d0*16+hi*8]);
  float mhat=0.f,l_reg=0.f;f32x16 o[2];o[0]=f32x16{};o[1]=f32x16{};f32x16 negm=f32x16{};asm volatile("":"+v"(negm));
  #define CMASK(P0,P1,t) do{}while(0)
  bool resc=false;
  #define START(P0,P1) do{ const float rm=rowmax(P0,P1); resc=false; \
    { const float dl=rm; mhat=fadd_s(mhat,dl); \
      _Pragma("unroll") for(int r=0;r<16;++r){P0[r]=fsub_s(P0[r],dl);P1[r]=fsub_s(P1[r],dl);} \
      _Pragma("unroll") for(int r=0;r<16;++r)negm[r]=-mhat; asm volatile("":"+v"(negm)); } \
    _Pragma("unroll") for(int r=0;r<16;++r)P0[r]=__builtin_amdgcn_exp2f(P0[r]); }while(0)
  #define RESC() do{ if(resc){ asm volatile("s_waitcnt lgkmcnt(0)":::"memory"); \
      _Pragma("unroll") for(int d_=0;d_<2;++d_) _Pragma("unroll") for(int r=0;r<16;++r)o[d_][r]*=wsf[crow(r,hi)]; } }while(0)
  f32x16 pA0,pA1,pB0,pB1;
  int sl_prev=0,sl_cur=0,sl_next=SLOTB;
  #define ROT() do{sl_prev=sl_cur;sl_cur=sl_next;sl_next=(sl_next==(NSLOT-1)*SLOTB)?0:sl_next+SLOTB;}while(0)
  DMA_K(2,2*SLOTB);
  WAIT_BAR(3);
  qkt(pA0,pA1,Kbase,qr,negm,r32,hi);asm volatile("s_nop 15\n\ts_nop 7":"+v"(pA0),"+v"(pA1));CMASK(pA0,pA1,0);
  START(pA0,pA1);
  _Pragma("unroll") for(int r=0;r<16;++r)pA1[r]=__builtin_amdgcn_exp2f(pA1[r]);
  WAIT_BAR(0);
  DMA_K(3,0);DMA_V(1,SLOTB);
  ROT();
  kload8(kf,kp0+sl_cur);
  WAIT_BAR(2);
  s16x4 vlo[8],vhi[8]; u32x4 pw0,pw1,pw2,pw3;
  #define PKW(P,B) cvtpk_s(P[B],P[B+1])
  #define PAF(k) __builtin_bit_cast(bf16x8,pw##k)
  #define VFR(i) (bf16x8){vlo[i][0],vlo[i][1],vlo[i][2],vlo[i][3],vhi[i][0],vhi[i][1],vhi[i][2],vhi[i][3]}
  #define PIN(x) asm volatile("":"+v"(x))
  #define MX3(a,b,c) __builtin_fmaxf(__builtin_fmaxf((a),(b)),(c))
  #define GAPA(MF,A0,A1,A2,A3,W0,W1,PW) do{ MF; sacc+=A0; sacc+=A1; sacc+=A2; sacc+=A3; PIN(sacc); W0; W1; PIN(PW); SBAR(); }while(0)
  #define EX(v) __builtin_amdgcn_exp2f(v)
  #define GAPB(MF,X,B) do{ MF; X[B]=EX(X[B]); X[B+1]=EX(X[B+1]); X[B+2]=EX(X[B+2]); X[B+3]=EX(X[B+3]); PIN(X); SBAR(); }while(0)
  #define VRD(i) do{ vlo[i]=vtr(vp_+(((i)>>2)*4096+((i)&3)*1024)); vhi[i]=vtr(vp_+(((i)>>2)*4096+((i)&3)*1024+512)); }while(0)
  #define KRD(G,j) do{ if(G){ kload2(kf,kp0+sl_next,j); SBAR(); } }while(0)
  #define STEP(C0,C1,P0,P1,t,GK,GV,GL) do{ SBAR(); \
    const lds_cptr vp_=vp0+sl_prev; \
    VRD(0); SBAR(); float sacc=(P0[0]+P0[1]); \
    GAPA(C0=__builtin_amdgcn_mfma_f32_32x32x16_bf16(kf[0],qr[0],negm,0,0,0), P0[2],P0[3],P0[4],P0[5],     pw0[0]=PKW(P0,0), pw0[1]=PKW(P0,2), pw0); \
    VRD(4); SBAR(); GAPA(C1=__builtin_amdgcn_mfma_f32_32x32x16_bf16(kf[1],qr[0],negm,0,0,0), P0[6],P0[7],P0[8],P0[9],     pw0[2]=PKW(P0,4), pw0[3]=PKW(P0,6), pw0); \
    VRD(1); SBAR(); GAPA(C0=__builtin_amdgcn_mfma_f32_32x32x16_bf16(kf[2],qr[1],C0,0,0,0),   P0[10],P0[11],P0[12],P0[13], pw1[0]=PKW(P0,8), pw1[1]=PKW(P0,10), pw1); \
    VRD(5); SBAR(); GAPA(C1=__builtin_amdgcn_mfma_f32_32x32x16_bf16(kf[3],qr[1],C1,0,0,0),   P0[14],P0[15],P1[0],P1[1],   pw1[2]=PKW(P0,12),pw1[3]=PKW(P0,14), pw1); \
    VRD(2); SBAR(); GAPA(C0=__builtin_amdgcn_mfma_f32_32x32x16_bf16(kf[4],qr[2],C0,0,0,0),   P1[2],P1[3],P1[4],P1[5],     pw2[0]=PKW(P1,0), pw2[1]=PKW(P1,2), pw2); \
    VRD(6); SBAR(); GAPA(C1=__builtin_amdgcn_mfma_f32_32x32x16_bf16(kf[5],qr[2],C1,0,0,0),   P1[6],P1[7],P1[8],P1[9],     pw2[2]=PKW(P1,4), pw2[3]=PKW(P1,6), pw2); \
    VRD(3); SBAR(); GAPA(C0=__builtin_amdgcn_mfma_f32_32x32x16_bf16(kf[6],qr[3],C0,0,0,0),   P1[10],P1[11],P1[12],P1[13], pw3[0]=PKW(P1,8), pw3[1]=PKW(P1,10), pw3); \
    VRD(7); SBAR(); GAPA(C1=__builtin_amdgcn_mfma_f32_32x32x16_bf16(kf[7],qr[3],C1,0,0,0),   P1[14],P1[15],0.f,0.f,       pw3[2]=PKW(P1,12),pw3[3]=PKW(P1,14), pw3); \
    l_reg+=sacc; \
    if(GK){DMA_K((t)+3,sl_cur);} if(GV){DMA_V((t)+1,sl_next);} \
    CMASK(C0,C1,t); \
    { float a=MX3(C0[0],C0[1],C1[0]),b=MX3(C0[2],C0[3],C1[1]); a=MX3(a,C1[2],C1[3]); \
      _Pragma("unroll") for(int r=4;r<16;r+=4){a=MX3(a,C0[r],C0[r+1]);b=MX3(b,C0[r+2],C0[r+3]);a=MX3(a,C1[r],C1[r+1]);b=MX3(b,C1[r+2],C1[r+3]);} \
      float rm=__builtin_fmaxf(a,b); { auto rr=__builtin_amdgcn_permlane32_swap(__float_as_uint(rm),__float_as_uint(rm),false,false); rm=__builtin_fmaxf(__uint_as_float(rr[0]),__uint_as_float(rr[1])); } \
      resc=false; \
      if(__builtin_expect(__any(rm>(float)THRL),0)){ const float dl=__builtin_fmaxf(rm,0.f); mhat+=dl; \
        _Pragma("unroll") for(int r=0;r<16;++r){C0[r]-=dl;C1[r]-=dl;} \
        _Pragma("unroll") for(int r=0;r<16;++r)negm[r]=-mhat; asm volatile("":"+v"(negm)); \
        const float f=__builtin_amdgcn_exp2f(-dl); l_reg*=f; if(hi==0)wsf[r32]=f; resc=true; } } \
    SBAR(); \
    GAPB(o[0]=__builtin_amdgcn_mfma_f32_32x32x16_bf16(PAF(0),VFR(0),o[0],0,0,0), C0,0); \
    GAPB(o[1]=__builtin_amdgcn_mfma_f32_32x32x16_bf16(PAF(0),VFR(4),o[1],0,0,0), C0,4); \
    KRD(GL,0); GAPB(o[0]=__builtin_amdgcn_mfma_f32_32x32x16_bf16(PAF(1),VFR(1),o[0],0,0,0), C0,8); \
    KRD(GL,1); GAPB(o[1]=__builtin_amdgcn_mfma_f32_32x32x16_bf16(PAF(1),VFR(5),o[1],0,0,0), C0,12); \
    KRD(GL,2); GAPB(o[0]=__builtin_amdgcn_mfma_f32_32x32x16_bf16(PAF(2),VFR(2),o[0],0,0,0), C1,0); \
    KRD(GL,3); GAPB(o[1]=__builtin_amdgcn_mfma_f32_32x32x16_bf16(PAF(2),VFR(6),o[1],0,0,0), C1,4); \
    GAPB(o[0]=__builtin_amdgcn_mfma_f32_32x32x16_bf16(PAF(3),VFR(3),o[0],0,0,0), C1,8); \
    GAPB(o[1]=__builtin_amdgcn_mfma_f32_32x32x16_bf16(PAF(3),VFR(7),o[1],0,0,0), C1,12); \
    }while(0)
  int t=1;
  #undef CMASK
  #define CMASK(P0,P1,t) do{}while(0)
  for(;t+5<NT;t+=2){
    STEP(pB0,pB1,pA0,pA1,t,true,true,true);     WAIT_BAR(2); RESC(); ROT();
    STEP(pA0,pA1,pB0,pB1,t+1,true,true,true);   WAIT_BAR(2); RESC(); ROT();
  }
  #undef CMASK
  #define CMASK(P0,P1,t) do{}while(0)
  #define ENDW(tt) do{ if((tt)+3<NT){WAIT_BAR(2);} else if((tt)+2<NT){WAIT_BAR(1);} else {WAIT_BAR(0);} }while(0)
  for(;t+1<NT;t+=2){
    STEP(pB0,pB1,pA0,pA1,t,(t+3<NT),(t+1<NT),(t+1<NT));       ENDW(t);   RESC(); ROT();
    STEP(pA0,pA1,pB0,pB1,t+1,(t+4<NT),(t+2<NT),(t+2<NT));     ENDW(t+1); RESC(); ROT();
  }
  STEP(pB0,pB1,pA0,pA1,NT-1,false,false,false); RESC();
  { float sacc=pB0[0]+pB0[1]; _Pragma("unroll") for(int r=2;r<16;++r)sacc+=pB0[r]; _Pragma("unroll") for(int r=0;r<16;++r)sacc+=pB1[r]; l_reg+=sacc;
    pw0=(u32x4){PKW(pB0,0),PKW(pB0,2),PKW(pB0,4),PKW(pB0,6)};pw1=(u32x4){PKW(pB0,8),PKW(pB0,10),PKW(pB0,12),PKW(pB0,14)};pw2=(u32x4){PKW(pB1,0),PKW(pB1,2),PKW(pB1,4),PKW(pB1,6)};pw3=(u32x4){PKW(pB1,8),PKW(pB1,10),PKW(pB1,12),PKW(pB1,14)};
    SBAR(); pv(o,vb0+sl_cur,PAF(0),PAF(1),PAF(2),PAF(3)); }
  #undef PKW
  #undef PAF
  #undef VFR
  #undef PIN
  #undef MX3
  #undef GAPA
  #undef GAPB
  #undef EX
  #undef VRD
  #undef KRD
  #undef STEP
  #undef ENDW
  {float la_=l_reg,lb_=l_reg;asm volatile("s_nop 1\n\tv_permlane32_swap_b32 %0, %1\n\ts_nop 1":"+v"(la_),"+v"(lb_));l_reg=la_+lb_;}
  if(hi==0)wsf[32+r32]=l_reg;asm volatile("s_waitcnt lgkmcnt(0)":::"memory");
  float rli[16];
  #pragma unroll
  for(int r=0;r<16;++r)rli[r]=__builtin_amdgcn_rcpf(wsf[32+crow(r,hi)]);
  bf16*Ow=Oh+(long)(q0+wid*QBLK)*OP;
  { bf16*stg=(bf16*)(shm+LDS_OST)+wid*2048;
    #pragma unroll
    for(int r=0;r<16;++r){const int orow=crow(r,hi);
      #pragma unroll
      for(int d0=0;d0<2;++d0)stg[orow*64+d0*32+r32]=__float2bfloat16(o[d0][r]*rli[r]);}
    asm volatile("s_waitcnt lgkmcnt(0)":::"memory");
    #pragma unroll
#ifdef OUTPROJ_FP8
    #define SATF(x) __builtin_amdgcn_fmed3f((x),-448.0f,448.0f)
    for(int i=0;i<4;++i){const int row=i*8+(lane>>3),ch=lane&7; const u32x4 v=*(const u32x4*)(stg+row*64+ch*8);
      const unsigned vs[4]={v.x,v.y,v.z,v.w}; unsigned o8[2];
      #pragma unroll
      for(int j=0;j<2;++j){int wq=0; wq=__builtin_amdgcn_cvt_pk_fp8_f32(SATF(__builtin_bit_cast(float,vs[2*j]<<16)*4.0f),SATF(__builtin_bit_cast(float,vs[2*j]&0xffff0000u)*4.0f),wq,false);
        wq=__builtin_amdgcn_cvt_pk_fp8_f32(SATF(__builtin_bit_cast(float,vs[2*j+1]<<16)*4.0f),SATF(__builtin_bit_cast(float,vs[2*j+1]&0xffff0000u)*4.0f),wq,true); o8[j]=(unsigned)wq;}
      typedef unsigned u32x2_ __attribute__((ext_vector_type(2)));
      { const int rl=q0+wid*QBLK+row; *(u32x2_*)((unsigned char*)Oh+(long)(rl>>1)*(2*OP)+(rl&1)*64+ch*8)=(u32x2_){o8[0],o8[1]}; } } }
    #undef SATF
#else
    for(int i=0;i<4;++i){const int row=i*8+(lane>>3),ch=lane&7; const u32x4 v=*(const u32x4*)(stg+row*64+ch*8); ATTN_STORE16(Ow+(long)row*OP+ch*8,v);} }
#endif
  asm volatile("s_waitcnt lgkmcnt(0)\n\ts_barrier":::"memory");
  #undef DMA_K
  #undef DMA_V
  #undef CMASK
  #undef START
  #undef RESC
  #undef ROT
}
constexpr int ATTN_LDS_BYTES=LDS_BYTES;
#undef SBAR
#undef WAIT_BAR
}
constexpr int NWAVES = 8, NTHR = 512;
constexpr int NB = 16, T_LAT = 2048, L_CTX = 256, DM = 1024, RPB = T_LAT + L_CTX  , MROWS = NB * RPB  , NPROJ = 3584, DEPTH = 2;
constexpr int NPANEL = MROWS / 256  , PPB = RPB / 256  ;
constexpr float NORM_EPS = 1e-6f;
constexpr int C_HQ = 0, C_HI = 256, C_HZ = 512  , C_HG = 1024, C_CB = 1280, C_CC = 1536, C_CH = 1792, C_RQ = 2048, C_RK = 2304, C_RV = 2560, C_RG = 2816, C_AQ = 3072, C_AK = 3328, C_AV = 3456;
constexpr size_t MiB = 1u << 20;
constexpr size_t WS_CTL = 0, CTL_ZERO_BYTES = 1 * MiB;
constexpr size_t WS_MOD = 1 * MiB;
constexpr size_t WS_ROPE = 2 * MiB;
constexpr size_t WS_ROUTE = 3 * MiB;
constexpr size_t WS_ROWINFO = 4 * MiB;
constexpr size_t WS_BCNT = 5 * MiB;
constexpr size_t WS_TILEINFO = 6 * MiB;
constexpr size_t WS_DBUF = 7 * MiB;
constexpr size_t WS_W0 = 12 * MiB, WLAYER = 33 * MiB;
constexpr size_t WO_WIN = 0;
constexpr size_t WO_WOUT = 7 * MiB;
constexpr size_t WO_WGU = 9 * MiB;
constexpr size_t WO_WD = 25 * MiB;
constexpr size_t WS_CTX = 78 * MiB;
constexpr size_t WS_ACT = 94 * MiB;
constexpr size_t WS_P = 166 * MiB;
constexpr size_t WS_ASORT = WS_P;
constexpr size_t WS_H = WS_P + 84 * MiB;
constexpr size_t WS_KVS = 418 * MiB;
constexpr size_t WS_RCAP = 490 * MiB;
constexpr size_t WS_END = 504 * MiB;
constexpr int CAPR = 36864;
constexpr int CW_GCNT = 24576;
constexpr int MAXTILES = 168;
constexpr int CW_ERR = 16;
constexpr int CW_BAR = 4096;
constexpr int CW_BAR3 = 12288, CW_BAR4 = 16384, CW_BAR5 = 20480;
constexpr int CW_BAR2 = 8192;
constexpr int RING_OFF = 0, RING_BYTES = 139264;
constexpr int LDSCTL_OFF = RING_BYTES, MISC_OFF = LDSCTL_OFF + 320;
constexpr int PTAB_OFF = LDSCTL_OFF + 512;
constexpr int TAB_OFF = LDSCTL_OFF + 1024;
constexpr int LDS_BYTES = 147456;

#define GAS __attribute__((address_space(1)))
#define LAS __attribute__((address_space(3)))
typedef unsigned short bf16;
typedef unsigned v4u __attribute__((ext_vector_type(4)));
typedef unsigned v2u __attribute__((ext_vector_type(2)));
typedef int v4i __attribute__((ext_vector_type(4)));
typedef float f32x4 __attribute__((ext_vector_type(4)));
typedef GAS unsigned gu32;
#define RLX_AGENT __ATOMIC_RELAXED, __HIP_MEMORY_SCOPE_AGENT
#define LDS_WAIT() asm volatile("s_waitcnt lgkmcnt(0)" ::: "memory")
#define VM_WAIT() asm volatile("s_waitcnt vmcnt(0)" ::: "memory")
typedef float pkf32x2_t __attribute__((ext_vector_type(2))); typedef __bf16 pkbf16x2_t __attribute__((ext_vector_type(2)));
__device__ __forceinline__ unsigned pk2(float lo, float hi) { const pkf32x2_t v = {lo, hi}; return __builtin_bit_cast(unsigned, __builtin_convertvector(v, pkbf16x2_t)); }
__device__ __forceinline__ unsigned f2bf(float f) { return pk2(f, 0.f) & 0xffffu; }
__device__ __forceinline__ float bflo(unsigned w) { return __builtin_bit_cast(float, w << 16); }
__device__ __forceinline__ float bfhi(unsigned w) { return __builtin_bit_cast(float, w & 0xffff0000u); }
__device__ __forceinline__ float bf1(bf16 h) { return __builtin_bit_cast(float, (unsigned)h << 16); }
__device__ __forceinline__ unsigned pk4_fp8(float a, float b, float c, float d) { int w = 0; a = __builtin_amdgcn_fmed3f(a, -448.0f, 448.0f); b = __builtin_amdgcn_fmed3f(b, -448.0f, 448.0f); c = __builtin_amdgcn_fmed3f(c, -448.0f, 448.0f); d = __builtin_amdgcn_fmed3f(d, -448.0f, 448.0f);     w = __builtin_amdgcn_cvt_pk_fp8_f32(a, b, w, false); w = __builtin_amdgcn_cvt_pk_fp8_f32(c, d, w, true); return (unsigned)w; }
__device__ __forceinline__ float fp8_dec(unsigned b) { const unsigned s = b >> 7, e = (b >> 3) & 15u, m = b & 7u; const float v = e ? (float)(8u + m) * exp2f((float)e - 10.0f) : (float)m * 0.001953125f; return s ? -v : v; }
__device__ __forceinline__ float siluf(float x) { return x * __builtin_amdgcn_rcpf(1.0f + __expf(-x)); }
__device__ __forceinline__ float sigmf(float x) { return __builtin_amdgcn_rcpf(1.0f + __expf(-x)); }
template <int K> __device__ __forceinline__ float xshf(float v) { static_assert(K >= 1 && K < 32, "xshf"); return __builtin_bit_cast(float, __builtin_amdgcn_ds_swizzle(__builtin_bit_cast(int, v), (K << 10) | 0x1f)); }
template <int K> __device__ __forceinline__ int xshi(int v) { static_assert(K >= 1 && K < 32, "xshi"); return __builtin_amdgcn_ds_swizzle(v, (K << 10) | 0x1f); }
__device__ __forceinline__ void half_swap(float& a, float& b) { asm volatile("s_nop 1\n\tv_permlane32_swap_b32 %0, %1\n\ts_nop 1" : "+v"(a), "+v"(b)); }
__device__ __forceinline__ float half_sum(float v) { float a = v, b = v; half_swap(a, b); return a + b; }
__device__ __forceinline__ float half_max(float v) { float a = v, b = v; half_swap(a, b); return fmaxf(a, b); }
__device__ __forceinline__ float sum16(float v) { v += xshf<1>(v); v += xshf<2>(v); v += xshf<4>(v); v += xshf<8>(v); return v; }
__device__ __forceinline__ float sum32(float v) { v = sum16(v); v += xshf<16>(v); return v; }
__device__ __forceinline__ float wave_sum(float v) { return half_sum(sum32(v)); }
#define XB_TMO      128
#define XB_XCNT(j)  (256  + 64 * (j))
#define XB_XSUB(j)  (1280 + 64 * (j))
#define XB_XGEN(j)  (2304 + 64 * (j))
#define XB_TOP      3328
#define XB_TOPGEN   3392
#define XCD_BAR_WORDS 3456
#define XB_SPIN_CAP (1u << 18)

__device__ __forceinline__ unsigned xb_ld(unsigned* p)              { return __hip_atomic_load(p, __ATOMIC_RELAXED, __HIP_MEMORY_SCOPE_AGENT); }
__device__ __forceinline__ unsigned xb_add(unsigned* p, unsigned v) { return __hip_atomic_fetch_add(p, v, __ATOMIC_RELAXED, __HIP_MEMORY_SCOPE_AGENT); }
__device__ __forceinline__ unsigned xb_xcc_id() { return (unsigned)__builtin_amdgcn_s_getreg((3 << 11) | 20) & 0xFu; }
#define XB_SPIN(cond, bar) do { unsigned _sp = 0; while (cond) { __builtin_amdgcn_s_sleep(1); \
    if ((++_sp & 255u) == 0u) { if (xb_ld(&(bar)[XB_TMO])) break; if (_sp > XB_SPIN_CAP) { atomicAdd(&(bar)[XB_TMO], 1u); break; } } } } while (0)

struct XcdBarrier {
    unsigned* bar; unsigned x;
    volatile LAS unsigned* st;
};

__device__ __forceinline__ XcdBarrier xcd_barrier_post(unsigned* bar, volatile LAS unsigned* st) {
    XcdBarrier b; b.bar = bar; b.x = xb_xcc_id(); b.st = st;
    if (threadIdx.x == 0) (void)xb_add(&bar[XB_XCNT(b.x)], 1u);
    return b;
}
__device__ __forceinline__ void xcd_barrier_complete(unsigned* bar, unsigned x, unsigned& nloc, unsigned& nx) {
    const unsigned G = gridDim.x * gridDim.y * gridDim.z;
    unsigned sum, cnt, mine, sp = 0u;
    for (;;) {
        sum = 0u; cnt = 0u; mine = 0u;
#pragma unroll
        for (unsigned j = 0; j < 16; ++j) { const unsigned c = xb_ld(&bar[XB_XCNT(j)]); sum += c; cnt += (c > 0u) ? 1u : 0u; mine = (j == x) ? c : mine; }
        if (sum == G) break;
        __builtin_amdgcn_s_sleep(1);
        if ((++sp & 255u) == 0u) { if (xb_ld(&bar[XB_TMO])) break; if (sp > XB_SPIN_CAP) { atomicAdd(&bar[XB_TMO], 1u); break; } }
    }
    nloc = mine > 0u ? mine : 1u; nx = cnt > 0u ? cnt : 1u;
}

__device__ __forceinline__ void xcd_barrier(const XcdBarrier& b) {
    asm volatile("s_waitcnt vmcnt(0)" ::: "memory");
    __syncthreads();
    if (threadIdx.x == 0) {
        unsigned* bar = b.bar; asm volatile("" : "+s"(bar));
        __builtin_amdgcn_s_waitcnt(0);
        unsigned nloc = b.st[0], nx = b.st[1];
        if (nloc == 0u) { xcd_barrier_complete(bar, b.x, nloc, nx); b.st[0] = nloc; b.st[1] = nx; }
#ifdef EARLY_WB
        __builtin_amdgcn_fence(__ATOMIC_RELEASE, "agent"); asm volatile("s_waitcnt vmcnt(0)" ::: "memory");
#endif
        const unsigned old = xb_add(&bar[XB_XSUB(b.x)], 1u);
        const unsigned gen = old / nloc;
#ifdef MID_WB
        if (old + 1u - gen * nloc == MID_WB_AT(nloc)) asm volatile("buffer_wbl2 sc1" ::: "memory");
#endif
        if (old + 1u == (gen + 1u) * nloc) {
            __builtin_amdgcn_fence(__ATOMIC_RELEASE, "agent");
            asm volatile("s_waitcnt vmcnt(0)" ::: "memory");
            const unsigned og = xb_add(&bar[XB_TOP], 1u);
            const unsigned tg = og / nx;
#ifdef EARLY_INV
            asm volatile("buffer_inv sc1" ::: "memory");
            if (og + 1u == (tg + 1u) * nx) xb_add(&bar[XB_TOPGEN], 1u);
            else XB_SPIN(xb_ld(&bar[XB_TOPGEN]) == tg, bar);
            asm volatile("" ::: "memory");
#else
            if (og + 1u == (tg + 1u) * nx) xb_add(&bar[XB_TOPGEN], 1u);
            else XB_SPIN(xb_ld(&bar[XB_TOPGEN]) == tg, bar);
            __builtin_amdgcn_fence(__ATOMIC_ACQUIRE, "agent");
#endif
            xb_add(&bar[XB_XGEN(b.x)], 1u);
            asm volatile("s_waitcnt vmcnt(0)" ::: "memory");
        } else {
#ifdef EARLY_INV
            asm volatile("buffer_inv sc1" ::: "memory");
            XB_SPIN(xb_ld(&bar[XB_XGEN(b.x)]) == gen, bar);
            asm volatile("" ::: "memory");
#else
            XB_SPIN(xb_ld(&bar[XB_XGEN(b.x)]) == gen, bar);
            __builtin_amdgcn_fence(__ATOMIC_ACQUIRE, "agent");
#endif
            asm volatile("s_waitcnt vmcnt(0)" ::: "memory");
        }
    }
    __syncthreads();
}

__device__ __forceinline__ void xcd_split_arrive(const XcdBarrier& b, unsigned* bar2) {
    asm volatile("s_waitcnt vmcnt(0)" ::: "memory");
    __syncthreads();
    if (threadIdx.x == 0) {
        unsigned* bar = bar2; asm volatile("" : "+s"(bar));
        __builtin_amdgcn_s_waitcnt(0);
        unsigned nloc = b.st[0], nx = b.st[1];
        if (nloc == 0u) { xcd_barrier_complete(b.bar, b.x, nloc, nx); b.st[0] = nloc; b.st[1] = nx; }
        const unsigned old = xb_add(&bar[XB_XSUB(b.x)], 1u);
        if ((old + 1u) % nloc == 0u) {
            __builtin_amdgcn_fence(__ATOMIC_RELEASE, "agent");
            asm volatile("s_waitcnt vmcnt(0)" ::: "memory");
            const unsigned og = xb_add(&bar[XB_TOP], 1u);
            if ((og + 1u) % nx == 0u) xb_add(&bar[XB_TOPGEN], 1u);
        }
    }
}
__device__ __forceinline__ void xcd_split_wait(const XcdBarrier& b, unsigned* bar2, unsigned target) {
    if (threadIdx.x == 0) {
        unsigned* bar = bar2; asm volatile("" : "+s"(bar));
        XB_SPIN(xb_ld(&bar[XB_TOPGEN]) < target, bar);
        __builtin_amdgcn_fence(__ATOMIC_ACQUIRE, "agent");
        asm volatile("s_waitcnt vmcnt(0)" ::: "memory");
    }
    __syncthreads();
}
struct Args { const float* in[24]; float* out; unsigned char* ws; size_t ws_shift; };
enum { I_X = 0, I_C, I_CTX, I_CCTX, I_ADAW, I_ADAB, I_NMIX, I_NFFN, I_WIN, I_LB, I_HNORM, I_CONVW, I_RDEC, I_RNORM, I_QN, I_KN, I_WOUT, I_RGW, I_RGB, I_REW, I_REB, I_EG, I_EU, I_ED };
struct Frame {
    LAS unsigned char* lds;
    volatile LAS unsigned* MISC;
    gu32* ctl;
    int tid, lane, wave, vcu, G;
    unsigned bart;
};
__device__ __forceinline__ const void* lptr(const Frame& F, int i) {
    const volatile LAS unsigned* t = (const volatile LAS unsigned*)(F.lds + PTAB_OFF) + 2 * i;
    const unsigned lo = __builtin_amdgcn_readfirstlane(t[0]), hi = __builtin_amdgcn_readfirstlane(t[1]);
    return (const void*)(const GAS void*)(((unsigned long long)hi << 32) | lo);
}
#define PIN(i) ((const float*)lptr(F, (i)))
#define POUT ((float*)lptr(F, 24))
#define PWS ((unsigned char*)lptr(F, 25))
__device__ __forceinline__ int row_of_latent(int idx) { return (idx >> 11) * RPB + L_CTX + (idx & 2047); }

__device__ __forceinline__ void transpose_item(const float* W, int N, int k0, int n0, bf16* dst, int DP, LAS float* scr, int lane) {
#pragma unroll
    for (int i = 0; i < 8; ++i) { const int kk = 8 * i + (lane >> 3), nc = 4 * (lane & 7); const f32x4 v = *(const f32x4*)(W + (size_t)(k0 + kk) * N + n0 + nc);
        scr[kk * 33 + nc] = v.x; scr[kk * 33 + nc + 1] = v.y; scr[kk * 33 + nc + 2] = v.z; scr[kk * 33 + nc + 3] = v.w; }
    LDS_WAIT(); asm volatile("" ::: "memory");
    const int c = lane & 7;
#pragma unroll
    for (int j = 0; j < 4; ++j) { const int n = (lane >> 3) + 8 * j; const LAS float* s = scr + (8 * c) * 33 + n;
        v4u o; o.x = pk2(s[0 * 33], s[1 * 33]); o.y = pk2(s[2 * 33], s[3 * 33]); o.z = pk2(s[4 * 33], s[5 * 33]); o.w = pk2(s[6 * 33], s[7 * 33]);
        *(GAS v4u*)(dst + (size_t)n * DP + 8 * c) = o; }
    LDS_WAIT(); asm volatile("" ::: "memory");
}
__device__ __forceinline__ void transpose_item8(const float* W, int N, int k0, int n0, unsigned char* dst, int DP, float scale, LAS float* scr, int lane) {
#pragma unroll
    for (int i = 0; i < 8; ++i) { const int kk = 8 * i + (lane >> 3), nc = 4 * (lane & 7); const f32x4 v = *(const f32x4*)(W + (size_t)(k0 + kk) * N + n0 + nc) * scale;
        scr[kk * 33 + nc] = v.x; scr[kk * 33 + nc + 1] = v.y; scr[kk * 33 + nc + 2] = v.z; scr[kk * 33 + nc + 3] = v.w; }
    LDS_WAIT(); asm volatile("" ::: "memory");
    const int c = lane & 7;
#pragma unroll
    for (int j = 0; j < 4; ++j) { const int n = (lane >> 3) + 8 * j; const LAS float* s = scr + (8 * c) * 33 + n;
        v2u o; o.x = pk4_fp8(s[0 * 33], s[1 * 33], s[2 * 33], s[3 * 33]); o.y = pk4_fp8(s[4 * 33], s[5 * 33], s[6 * 33], s[7 * 33]);
        *(GAS v2u*)(dst + (size_t)n * DP + 8 * c) = o; }
    LDS_WAIT(); asm volatile("" ::: "memory");
}
struct WItem { const float* src; unsigned char* dst; int N, DP, f8, emu; };
__device__ __forceinline__ WItem witem_decode(const Frame& F, int it) {
    constexpr int PER_LAYER = 1792 + 512 + 3 * 4096;
    const int l = it / PER_LAYER; int r = it - l * PER_LAYER; unsigned char* ws = PWS + WS_W0 + (size_t)l * WLAYER; WItem w; w.emu = 0;
    if (r < 1792) { const int kb = r / 112, nb = r % 112; w.src = PIN(I_WIN) + (size_t)l * 1024 * NPROJ + (size_t)kb * 64 * NPROJ + nb * 32; w.N = NPROJ; w.emu = (EMU_TILES >> (nb >> 3)) & 1;
        if ((INPROJ_F8MASK >> (nb >> 3)) & 1) { w.dst = ws + WO_WIN + (size_t)(nb >> 3) * 524288 + (size_t)((nb & 7) * 32) * 1024 + kb * 64; w.DP = 1024; w.f8 = 1; return w; }
        w.dst = ws + WO_WIN + ((size_t)nb * 32 * 1024 + kb * 64) * 2; w.DP = 2048; w.f8 = 0; return w; }
    r -= 1792;
    if (r < 512) { const int kb = r / 32, nb = r % 32; w.src = PIN(I_WOUT) + (size_t)l * 1024 * 1024 + (size_t)kb * 64 * 1024 + nb * 32; w.N = 1024;
#ifdef OUTPROJ_FP8
        w.dst = ws + WO_WOUT + ((size_t)nb * 32 * 1024 + kb * 64); w.DP = 1024; w.f8 = 1; return w; }
#else
        w.dst = ws + WO_WOUT + ((size_t)nb * 32 * 1024 + kb * 64) * 2; w.DP = 2048; w.f8 = 0; return w; }
#endif
    r -= 512;
    if (r < 8192) { const int up = r >= 4096; r -= up * 4096; const int e = r >> 8, rr = r & 255, kb = rr >> 4, nb = rr & 15, n0 = nb * 32;
        const int drow = e * 1024 + (n0 >> 7) * 256 + up * 128 + (n0 & 127);
        w.src = (up ? PIN(I_EU) : PIN(I_EG)) + (size_t)(l * 16 + e) * 1024 * 512 + (size_t)kb * 64 * 512 + n0; w.N = 512; w.dst = ws + WO_WGU + (size_t)drow * 1024 + kb * 64; w.DP = 1024; w.f8 = 1; return w; }
    r -= 8192;
    { const int e = r >> 8, rr = r & 255, kb = rr >> 5, nb = rr & 31, g = e >> 2, el = e & 3;
        w.src = PIN(I_ED) + (size_t)(l * 16 + e) * 512 * 1024 + (size_t)kb * 64 * 1024 + nb * 32; w.N = 1024; w.dst = ws + WO_WD + ((size_t)g * 1024 + nb * 32) * 2048 + el * 512 + kb * 64; w.DP = 2048; w.f8 = 1; return w; }
}
__device__ __forceinline__ void convert_weights_range(Frame& F, int it0, int it1, int gw, int NGW) {
    LAS float* scr = (LAS float*)(F.lds + F.wave * 16384);
    const int lane = F.lane; const int NITEMS = it1;
    if (gw < 0 || it0 + gw >= NITEMS) return;
    gw += it0;
    const int kr = lane >> 3, nc = 4 * (lane & 7);
    WItem cur = witem_decode(F, gw); f32x4 v[8], vn[8];
#pragma unroll
    for (int i = 0; i < 8; ++i) v[i] = LDNT((const f32x4*)(cur.src + (size_t)(8 * i + kr) * cur.N + nc));
    for (int it = gw; it < NITEMS; it += NGW) {
        const int itn = it + NGW; const bool more = itn < NITEMS; WItem nxt = cur;
        if (more) { nxt = witem_decode(F, itn);
#pragma unroll
            for (int i = 0; i < 8; ++i) vn[i] = LDNT((const f32x4*)(nxt.src + (size_t)(8 * i + kr) * nxt.N + nc)); }
        const float sc = cur.f8 ? 32.0f : 1.0f;
#pragma unroll
        for (int i = 0; i < 8; ++i) { const int kk = 8 * i + kr; const f32x4 x = v[i] * sc; scr[kk * 33 + nc] = x.x; scr[kk * 33 + nc + 1] = x.y; scr[kk * 33 + nc + 2] = x.z; scr[kk * 33 + nc + 3] = x.w; }
        LDS_WAIT(); asm volatile("" ::: "memory");
        const int c = lane & 7;
#pragma unroll
        for (int j = 0; j < 4; ++j) { const int n = (lane >> 3) + 8 * j; const LAS float* s = scr + (8 * c) * 33 + n;
            if (cur.f8) { v2u o; o.x = pk4_fp8(s[0 * 33], s[1 * 33], s[2 * 33], s[3 * 33]); o.y = pk4_fp8(s[4 * 33], s[5 * 33], s[6 * 33], s[7 * 33]); *(GAS v2u*)(cur.dst + (size_t)n * cur.DP + 8 * c) = o; }
            else { float e[8];
#pragma unroll
                for (int q = 0; q < 8; ++q) { e[q] = s[q * 33]; if (cur.emu) { const int pq = __builtin_amdgcn_cvt_pk_fp8_f32(e[q] * 32.0f, 0.0f, 0, false); e[q] = __builtin_amdgcn_cvt_f32_fp8(pq, 0) * (1.0f / 32.0f); } }
                v4u o; o.x = pk2(e[0], e[1]); o.y = pk2(e[2], e[3]); o.z = pk2(e[4], e[5]); o.w = pk2(e[6], e[7]); *(GAS v4u*)(cur.dst + (size_t)n * cur.DP + 16 * c) = o; } }
        LDS_WAIT(); asm volatile("" ::: "memory");
        if (more) { cur = nxt;
#pragma unroll
            for (int i = 0; i < 8; ++i) v[i] = vn[i]; }
    }
}

__device__ __forceinline__ void p0_prologue(Frame& F, const XcdBarrier& gbar) {
    unsigned char* ws = PWS;
    {
        LAS float* sc = (LAS float*)(F.lds);
        LAS float* red = (LAS float*)(F.lds + 17 * 4096);
        bool staged = false;
        const float* pC = PIN(I_C); const float* pCC = PIN(I_CCTX); const float* pAW = PIN(I_ADAW); const float* pAB = PIN(I_ADAB); const float* pNM = PIN(I_NMIX); const float* pNF = PIN(I_NFFN);
#ifdef MOD_WIDE
        typedef float f32x3 __attribute__((ext_vector_type(3)));
        for (int it = F.vcu; it < DEPTH * 128; it += F.G) {
            if (!staged) {
                for (int i = F.tid; i < 17 * 1024; i += NTHR) { const float v = (i < 16 * 1024) ? pC[i] : pCC[i - 16 * 1024]; sc[i] = siluf(v); }
                staged = true;
            }
            __syncthreads();
            const int l = it >> 7, cb = it & 127, n0 = cb * 48, nn = F.tid & 15, ks = F.tid >> 4;
            const float* W = pAW + (size_t)l * 1024 * 6144 + n0 + 3 * nn;
            f32x3 acc[17];
#pragma unroll
            for (int m = 0; m < 17; ++m) acc[m] = (f32x3){0.f, 0.f, 0.f};
            for (int k = ks * 32; k < ks * 32 + 32; k += 4) {
                const f32x3 w0 = *(const f32x3*)(W + (size_t)k * 6144), w1 = *(const f32x3*)(W + (size_t)(k + 1) * 6144), w2 = *(const f32x3*)(W + (size_t)(k + 2) * 6144), w3 = *(const f32x3*)(W + (size_t)(k + 3) * 6144);
#pragma unroll
                for (int m = 0; m < 17; ++m) { const f32x4 s4 = *(const LAS f32x4*)(sc + m * 1024 + k); acc[m] += (w0 * s4.x + w1 * s4.y) + (w2 * s4.z + w3 * s4.w); } }
#pragma unroll
            for (int m = 0; m < 17; ++m) { float a = acc[m].x, b = acc[m].y, c3 = acc[m].z; a += xshf<16>(a); b += xshf<16>(b); c3 += xshf<16>(c3); acc[m] = (f32x3){half_sum(a), half_sum(b), half_sum(c3)}; }
            if (F.lane < 16) {
#pragma unroll
                for (int m = 0; m < 17; ++m) { LAS float* rp = red + (F.wave * 17 + m) * 48 + 3 * nn; rp[0] = acc[m].x; rp[1] = acc[m].y; rp[2] = acc[m].z; } }
            __syncthreads();
            for (int i = F.tid; i < 17 * 48; i += NTHR) { const int m = i / 48, n2 = i - m * 48, gcol = n0 + n2; float v = pAB[l * 6144 + gcol];
#pragma unroll
                for (int k2 = 0; k2 < 8; ++k2) v += red[(k2 * 17 + m) * 48 + n2];
                const int kch = gcol >> 10, col = gcol & 1023;
                if (kch == 1) v = pNM[l * 1024 + col] * (1.0f + v);
                if (kch == 4) v = pNF[l * 1024 + col] * (1.0f + v);
                ((float*)(ws + WS_MOD) + (size_t)(l * 6 + kch) * 17 * 1024)[m * 1024 + col] = v; }
        }
#else
        for (int it = F.vcu; it < DEPTH * 192; it += F.G) {
            if (!staged) {
                for (int i = F.tid; i < 17 * 1024; i += NTHR) { const float v = (i < 16 * 1024) ? pC[i] : pCC[i - 16 * 1024]; sc[i] = siluf(v); }
                staged = true;
            }
            __syncthreads();
            const int l = it / 192, cb = it % 192, n0 = cb * 32, nn = F.tid & 31, ks = F.tid >> 5;
            const float* W = pAW + (size_t)l * 1024 * 6144 + n0 + nn;
            float acc[17];
#pragma unroll
            for (int m = 0; m < 17; ++m) acc[m] = 0.f;
            for (int k = ks * 64; k < ks * 64 + 64; k += 4) { const float w0 = W[(size_t)k * 6144], w1 = W[(size_t)(k + 1) * 6144], w2 = W[(size_t)(k + 2) * 6144], w3 = W[(size_t)(k + 3) * 6144];
#pragma unroll
                for (int m = 0; m < 17; ++m) { const f32x4 s4 = *(const LAS f32x4*)(sc + m * 1024 + k); acc[m] += (s4.x * w0 + s4.y * w1) + (s4.z * w2 + s4.w * w3); } }
#pragma unroll
            for (int m = 0; m < 17; ++m) red[(ks * 17 + m) * 32 + nn] = acc[m];
            __syncthreads();
            const int kch = n0 >> 10, cc = n0 & 1023;
            float* MOD = (float*)(ws + WS_MOD) + (size_t)(l * 6 + kch) * 17 * 1024;
            for (int i = F.tid; i < 17 * 32; i += NTHR) { const int m = i >> 5, n2 = i & 31; float v = pAB[l * 6144 + n0 + n2];
#pragma unroll
                for (int k2 = 0; k2 < 16; ++k2) v += red[(k2 * 17 + m) * 32 + n2];
                const int col = cc + n2;
                if (kch == 1) v = pNM[l * 1024 + col] * (1.0f + v);
                if (kch == 4) v = pNF[l * 1024 + col] * (1.0f + v);
                MOD[m * 1024 + col] = v; }
        }
#endif
        __syncthreads();
    }
#ifdef SPLIT_PRO
    xcd_split_arrive(gbar, (unsigned*)(F.ctl + CW_BAR3));
#endif
    {
        float* RC = (float*)(ws + WS_ROPE); float* RS = RC + 2048 * 32;
        for (int i = (F.vcu * NTHR + F.tid); i < 2048 * 32; i += F.G * NTHR) { const int t = i >> 5, f = i & 31; const float pos = (float)((f < 16) ? (t >> 6) : (t & 63));
            const float invf = exp2f(-(float)(f & 15) * (13.287712379549449f / 16.0f)); const float ang = pos * invf; RC[i] = cosf(ang); RS[i] = sinf(ang); }
    }
    __syncthreads();
    convert_weights_range(F, 0, 1792 + 512 + 3 * 4096, F.vcu * NWAVES + F.wave, F.G * NWAVES);
    __syncthreads();
}
__device__ __forceinline__ void phase_norm1(Frame& F, const float* xsrc, const float* csrc, const float* nA, const float* nB, bf16* dst, unsigned char* dst8) {
    const int gw = F.vcu * NWAVES + F.wave, NGW = F.G * NWAVES, RPW = (MROWS + NGW - 1) / NGW;
    const int c0 = 8 * F.lane;
    int curm = -1; f32x4 a[4], bb[4];
#ifdef N1_INTERLEAVE
    (void)RPW; for (int r = gw; r < MROWS; r += NGW) {
#else
    for (int r = gw * RPW; r < (gw + 1) * RPW && r < MROWS; ++r) {
#endif
        const int b = r / RPB, j = r - b * RPB, m = (j < L_CTX) ? 16 : b;
        const float* src = (j < L_CTX) ? csrc + (size_t)(b * L_CTX + j) * DM : xsrc + (size_t)(b * T_LAT + j - L_CTX) * DM;
        if (m != curm) { curm = m;
#pragma unroll
            for (int q = 0; q < 4; ++q) { a[q] = *(const f32x4*)(nA + m * 1024 + c0 + 512 * (q >> 1) + 4 * (q & 1)); bb[q] = *(const f32x4*)(nB + m * 1024 + c0 + 512 * (q >> 1) + 4 * (q & 1)); } }
        f32x4 v[4]; float ss = 0.f;
#pragma unroll
        for (int q = 0; q < 4; ++q) { v[q] = LDNT((const f32x4*)(src + c0 + 512 * (q >> 1) + 4 * (q & 1))); ss += (v[q].x * v[q].x + v[q].y * v[q].y) + (v[q].z * v[q].z + v[q].w * v[q].w); }
        const float rstd = __builtin_amdgcn_rsqf(wave_sum(ss) * (1.0f / DM) + NORM_EPS);
#pragma unroll
        for (int q = 0; q < 2; ++q) { const f32x4 o0 = v[2 * q] * rstd * a[2 * q] + bb[2 * q], o1 = v[2 * q + 1] * rstd * a[2 * q + 1] + bb[2 * q + 1];
            v4u w; w.x = pk2(o0.x, o0.y); w.y = pk2(o0.z, o0.w); w.z = pk2(o1.x, o1.y); w.w = pk2(o1.z, o1.w);
            *(v4u*)(dst + (size_t)r * DM + c0 + 512 * q) = w;
            if (INPROJ_F8MASK) { v2u w8; w8.x = pk4_fp8(o0.x, o0.y, o0.z, o0.w); w8.y = pk4_fp8(o1.x, o1.y, o1.z, o1.w); *(v2u*)(dst8 + (size_t)r * DM + c0 + 512 * q) = w8; } }
    }
}

#ifdef REV_A
#define PREP_ROW(r) (MROWS - 1 - (r))
#else
#define PREP_ROW(r) (r)
#endif
template <bool DRY = false>
__device__ __forceinline__ void phase_prep(Frame& F, bf16* P, const float* qn, const float* kn, const float* RC, const float* RS) {
    const int gw = F.vcu * NWAVES + F.wave, NGW = F.G * NWAVES;
    const int L = F.lane; const bool act = L < 48, isq = L < 32;
    const int col = isq ? C_AQ + 8 * L : C_AK + 8 * (L - 32), e0 = (8 * L) & 63, p0 = e0 >> 1;
    const float* gp = isq ? qn : kn; const f32x4 g0 = *(const f32x4*)(gp + e0), g1 = *(const f32x4*)(gp + e0 + 4);
    constexpr float C2 = 0.125f * 1.4426950408889634f; const float sc = isq ? C2 : 1.0f;
    for (int r0 = gw; r0 < MROWS; r0 += 4 * NGW) {
        v4u wv[4]; f32x4 cs[4], sn[4]; bool ok[4];
#pragma unroll
        for (int u = 0; u < 4; ++u) { const int r = r0 + u * NGW; ok[u] = r < MROWS; const int rr = ok[u] ? PREP_ROW(r) : gw; const int b = rr / RPB, j = rr - b * RPB; const bool lat = j >= L_CTX;
            cs[u] = (f32x4){1.f, 1.f, 1.f, 1.f}; sn[u] = (f32x4){0.f, 0.f, 0.f, 0.f}; if (lat) { cs[u] = *(const f32x4*)(RC + (j - L_CTX) * 32 + p0); sn[u] = *(const f32x4*)(RS + (j - L_CTX) * 32 + p0); }
            wv[u] = act ? *(const v4u*)(P + (size_t)rr * NPROJ + col) : (v4u){0u, 0u, 0u, 0u}; }
#pragma unroll
        for (int u = 0; u < 4; ++u) { const int r = PREP_ROW(r0 + u * NGW);
            const unsigned ww[4] = {wv[u].x, wv[u].y, wv[u].z, wv[u].w}; float x[8]; float ss = 0.f;
#pragma unroll
            for (int i = 0; i < 4; ++i) { x[2 * i] = bflo(ww[i]); x[2 * i + 1] = bfhi(ww[i]); ss += x[2 * i] * x[2 * i] + x[2 * i + 1] * x[2 * i + 1]; }
            ss += xshf<1>(ss); ss += xshf<2>(ss); ss += xshf<4>(ss);
            const float rstd = __builtin_amdgcn_rsqf(ss * (1.0f / 64.0f) + NORM_EPS) * sc;
            const float gg[8] = {g0.x, g0.y, g0.z, g0.w, g1.x, g1.y, g1.z, g1.w}, cc[4] = {cs[u].x, cs[u].y, cs[u].z, cs[u].w}, sv[4] = {sn[u].x, sn[u].y, sn[u].z, sn[u].w};
            unsigned o[4];
#pragma unroll
            for (int i = 0; i < 4; ++i) { const float y1 = x[2 * i] * rstd * gg[2 * i], y2 = x[2 * i + 1] * rstd * gg[2 * i + 1]; o[i] = pk2(y1 * cc[i] - y2 * sv[i], y1 * sv[i] + y2 * cc[i]); }
            if (DRY) { asm volatile("" : "+v"(o[0]), "+v"(o[3])); o[0] = wv[u].x; o[1] = wv[u].y; o[2] = wv[u].z; o[3] = wv[u].w; }
            if (ok[u] && act) *(v4u*)(P + (size_t)r * NPROJ + col) = (v4u){o[0], o[1], o[2], o[3]}; }
    }
}
namespace rc {
constexpr int PT = 144, MB = 64 * PT;
constexpr int O_QP = 0, O_QQ = MB, O_KP = 2 * MB, O_VT = 3 * MB, O_ST = 4 * MB, O_AT = 5 * MB, O_TOT = 6 * MB, SLOT = 6 * MB + 2048;
constexpr int OXP = 68;
typedef float f32x16 __attribute__((ext_vector_type(16)));
typedef float f32x4v __attribute__((ext_vector_type(4)));
typedef short bf16x8 __attribute__((ext_vector_type(8)));
__device__ __forceinline__ int crow(int r, int hi) { return (r & 3) + 8 * (r >> 2) + 4 * hi; }
__device__ __forceinline__ bf16x8 frag32(const LAS unsigned char* M, int row, int kcol, int hi) { return *(const LAS bf16x8*)(M + row * PT + (kcol + hi * 8) * 2); }
__device__ __forceinline__ float clampe(float x) { return fminf(fmaxf(x, -60.f), 60.f); }
__device__ __forceinline__ int seq_of(int mixer, int b, int h, int dir) { return ((mixer * NB + b) * 4 + h) * 2 + dir; }
__device__ __forceinline__ int row_in_batch(int dir, int n) { return (dir == 0) ? n : (n < L_CTX ? (L_CTX - 1 - n) : (RPB + L_CTX - 1 - n)); }
}
struct StageARaw { v4u k[8], v[8]; };
__device__ __forceinline__ void stageA_load(StageARaw& R, const Frame& F, const bf16* P, int mixer, int b, int h, int dir, int c) {
    using namespace rc;
    const int lane = F.lane, r8 = lane >> 3, ch = lane & 7;
    const int ck = (mixer == 0 ? C_HZ + 256 * dir : C_RK) + h * 64 + 8 * ch, cv = (mixer == 0 ? C_HI : C_RV) + h * 64 + 8 * ch;
    const int j0 = row_in_batch(dir, c * 64 + r8); const long step = (dir == 0) ? 8L * NPROJ : -8L * NPROJ;
    const bf16* rp = P + (size_t)(b * RPB + j0) * NPROJ;
#pragma unroll
    for (int i = 0; i < 8; ++i) { R.k[i] = *(const v4u*)(rp + ck); R.v[i] = *(const v4u*)(rp + cv); rp += step; }
}
template <int MIXER>
__device__ __forceinline__ void stageA_compute(const StageARaw& R, Frame& F, bf16* KVS, float* DBUF, int b, int h, int dir, int c, const float* lblog, float gamma) {
    using namespace rc;
    constexpr int HP = 80;
    LAS unsigned char* WL = F.lds + F.wave * 10240; LAS unsigned char* KT = WL; LAS unsigned char* VTm = WL + 5120;
    const int lane = F.lane, seq = seq_of(MIXER, b, h, dir), r8 = lane >> 3, ch = lane & 7;
    unsigned kp[32], vp[32];
    {
        float kk[64];
#pragma unroll
        for (int i = 0; i < 8; ++i) *(LAS v4u*)(WL + (r8 + 8 * i) * PT + 16 * ch) = R.k[i];
#pragma unroll
        for (int s = 0; s < 64; ++s) kk[s] = bf1(*(const LAS unsigned short*)(WL + s * PT + 2 * lane));
        if (MIXER == 0) {
            const float lb = lblog ? sigmf(lblog[512 + dir * 256 + h * 64 + lane] - lblog[dir * 256 + h * 64 + lane]) : 0.f;
            float run = 1.f;
#pragma unroll
            for (int s = 63; s >= 0; --s) { const float f = lb + (1.0f - lb) * sigmf(kk[s]); kk[s] = (1.0f - f) * run; run *= f; }
            DBUF[(size_t)(seq * 36 + c) * 64 + lane] = run;
        } else {
            const float lg2 = __log2f(gamma);
#pragma unroll
            for (int s = 0; s < 64; ++s) kk[s] *= exp2f((float)(63 - s) * lg2);
        }
#pragma unroll
        for (int s = 0; s < 32; ++s) kp[s] = pk2(kk[2 * s], kk[2 * s + 1]);
    }
#pragma unroll
    for (int i = 0; i < 8; ++i) *(LAS v4u*)(WL + (r8 + 8 * i) * PT + 16 * ch) = R.v[i];
#pragma unroll
    for (int s = 0; s < 32; ++s) vp[s] = (unsigned)*(const LAS unsigned short*)(WL + (2 * s) * PT + 2 * lane) | ((unsigned)*(const LAS unsigned short*)(WL + (2 * s + 1) * PT + 2 * lane) << 16);
    const int r = lane & 15, g = lane >> 4;
    f32x4v acc[4][4];
#pragma unroll
    for (int a = 0; a < 4; ++a)
#pragma unroll
        for (int q = 0; q < 4; ++q) acc[a][q] = (f32x4v){0.f, 0.f, 0.f, 0.f};
#pragma unroll
    for (int hh = 0; hh < 2; ++hh) {
#pragma unroll
        for (int i = 0; i < 4; ++i) { const int s0 = 32 * hh + 8 * i; v4u ko, vo;
            ko.x = kp[s0 / 2]; ko.y = kp[s0 / 2 + 1]; ko.z = kp[s0 / 2 + 2]; ko.w = kp[s0 / 2 + 3];
            vo.x = vp[s0 / 2]; vo.y = vp[s0 / 2 + 1]; vo.z = vp[s0 / 2 + 2]; vo.w = vp[s0 / 2 + 3];
            *(LAS v4u*)(KT + lane * HP + 16 * i) = ko; *(LAS v4u*)(VTm + lane * HP + 16 * i) = vo; }
        bf16x8 af[4], bfr[4];
#pragma unroll
        for (int q = 0; q < 4; ++q) { af[q] = *(const LAS bf16x8*)(VTm + (16 * q + r) * HP + 16 * g); bfr[q] = *(const LAS bf16x8*)(KT + (16 * q + r) * HP + 16 * g); }
#pragma unroll
        for (int a = 0; a < 4; ++a)
#pragma unroll
            for (int q = 0; q < 4; ++q) acc[a][q] = __builtin_amdgcn_mfma_f32_16x16x32_bf16(af[a], bfr[q], acc[a][q], 0, 0, 0);
    }
#pragma unroll
    for (int a = 0; a < 4; ++a)
#pragma unroll
        for (int q = 0; q < 4; ++q)
#pragma unroll
            for (int x = 0; x < 4; ++x) *(LAS unsigned short*)(WL + (16 * a + 4 * g + x) * PT + (16 * q + r) * 2) = (unsigned short)f2bf(acc[a][q][x]);
    bf16* dst = KVS + (size_t)(seq * 36 + c) * 4096;
#pragma unroll
    for (int i = 0; i < 8; ++i) { const int idx = lane + 64 * i, e = idx >> 3, d8 = idx & 7; *(v4u*)(dst + e * 64 + d8 * 8) = *(const LAS v4u*)(WL + e * PT + d8 * 16); }
}
__device__ __forceinline__ void recur_stageA_loop(Frame& F, const bf16* P, bf16* KVS, float* DBUF, int u0, int stride, int nunits, const float* lblog, const float* rdec) {
    if (u0 >= nunits) return;
    StageARaw cur;
#define STA_DECODE(u_, it__) const int mh_ = ((u_) + (it__)) & 7, rest_ = (u_) >> 3, c_ = rest_ % 36, bd_ = rest_ / 36, b_ = bd_ >> 1, dir_ = bd_ & 1, mixer_ = mh_ >> 2, h_ = mh_ & 3
    int it = 0;
    for (int u = u0; u < nunits; u += stride, ++it) {
#ifdef REV_A
        STA_DECODE(nunits - 1 - u, it);
#else
        STA_DECODE(u, it);
#endif
        stageA_load(cur, F, P, mixer_, b_, h_, dir_, c_);
        if (mixer_ == 0) stageA_compute<0>(cur, F, KVS, DBUF, b_, h_, dir_, c_, lblog, 0.f);
        else stageA_compute<1>(cur, F, KVS, DBUF, b_, h_, dir_, c_, nullptr, sigmf(rdec[dir_ * 4 + h_]));
    }
#undef STA_DECODE
}
template <int MIXER, bool DRY = false>
__device__ __forceinline__ void recur_stageB_seq(Frame& F, bf16* KVS, const float* DBUF, int seq, float gamma) {
    const int e = F.tid >> 3, d8 = F.tid & 7;
    bf16* base = KVS + (size_t)seq * 36 * 4096 + e * 64 + d8 * 8; const float* db = DBUF + (size_t)seq * 36 * 64 + d8 * 8;
    float S[8];
#pragma unroll
    for (int i = 0; i < 8; ++i) S[i] = 0.f;
    const float g64 = (MIXER == 1) ? exp2f(64.0f * __log2f(gamma)) : 0.f;
    constexpr int GB = 4;
    v4u kv[GB], kvn[GB]; f32x4 da[GB], dbv[GB], dan[GB], dbn[GB];
#pragma unroll
    for (int i = 0; i < GB; ++i) { kv[i] = *(const v4u*)(base + (size_t)i * 4096); da[i] = (f32x4){g64, g64, g64, g64}; dbv[i] = da[i];
        if (MIXER == 0) { da[i] = *(const f32x4*)(db + i * 64); dbv[i] = *(const f32x4*)(db + i * 64 + 4); } }
    for (int c0 = 0; c0 < 36; c0 += GB) {
#pragma unroll
        for (int i = 0; i < GB; ++i) { kvn[i] = kv[i]; dan[i] = da[i]; dbn[i] = dbv[i];
            if (c0 + GB < 36) { kvn[i] = *(const v4u*)(base + (size_t)(c0 + GB + i) * 4096); if (MIXER == 0) { dan[i] = *(const f32x4*)(db + (c0 + GB + i) * 64); dbn[i] = *(const f32x4*)(db + (c0 + GB + i) * 64 + 4); } } }
#pragma unroll
        for (int i = 0; i < GB; ++i) {
            v4u so; so.x = pk2(S[0], S[1]); so.y = pk2(S[2], S[3]); so.z = pk2(S[4], S[5]); so.w = pk2(S[6], S[7]);
            if (DRY) { so = kv[i]; asm volatile("" : "+v"(S[0]), "+v"(S[7])); }
            *(v4u*)(base + (size_t)(c0 + i) * 4096) = so;
            const float dd[8] = {da[i].x, da[i].y, da[i].z, da[i].w, dbv[i].x, dbv[i].y, dbv[i].z, dbv[i].w}; const unsigned kw[4] = {kv[i].x, kv[i].y, kv[i].z, kv[i].w};
#pragma unroll
            for (int q = 0; q < 4; ++q) { S[2 * q] = dd[2 * q] * S[2 * q] + bflo(kw[q]); S[2 * q + 1] = dd[2 * q + 1] * S[2 * q + 1] + bfhi(kw[q]); }
        }
#pragma unroll
        for (int i = 0; i < GB; ++i) { kv[i] = kvn[i]; da[i] = dan[i]; dbv[i] = dbn[i]; }
    }
}
struct StageCRaw { v4u q[2], k[2], v[2]; v4u s0, s1, g; };
template <int MIXER>
__device__ __forceinline__ void stageC_load(StageCRaw& R, const Frame& F, const bf16* P, const bf16* KVS, int b, int h, int tb) {
    using namespace rc;
    const int dir = F.wave >> 2, wq = F.wave & 3, lane = F.lane, tr = lane >> 3, ch = lane & 7;
    const int c = (dir == 0) ? tb : (tb < 4 ? 3 - tb : 39 - tb), seq = seq_of(MIXER, b, h, dir);
    const int cq = (MIXER == 0 ? C_HQ : C_RQ) + h * 64 + 8 * ch, ck = (MIXER == 0 ? C_HZ + 256 * dir : C_RK) + h * 64 + 8 * ch, cv = (MIXER == 0 ? C_HI : C_RV) + h * 64 + 8 * ch;
    const int j0 = row_in_batch(dir, c * 64 + 16 * wq + tr); const long step = (dir == 0) ? 8L * NPROJ : -8L * NPROJ;
    const bf16* rp = P + (size_t)(b * RPB + j0) * NPROJ;
#pragma unroll
    for (int ii = 0; ii < 2; ++ii) { R.q[ii] = *(const v4u*)(rp + cq); R.k[ii] = *(const v4u*)(rp + ck); R.v[ii] = *(const v4u*)(rp + cv); rp += step; }
    const bf16* src = KVS + (size_t)(seq * 36 + c) * 4096; const int t256 = wq * 64 + lane;
    R.s0 = *(const v4u*)(src + (t256 >> 3) * 64 + (t256 & 7) * 8); R.s1 = *(const v4u*)(src + ((t256 + 256) >> 3) * 64 + (t256 & 7) * 8);
    { const int tok = F.tid >> 3, ech = F.tid & 7; R.g = *(const v4u*)(P + (size_t)(b * RPB + tb * 64 + tok) * NPROJ + (MIXER == 0 ? C_HG : C_RG) + h * 64 + 8 * ech); }
}
template <int MIXER>
__device__ __forceinline__ void stageC_compute(const StageCRaw& R, Frame& F, bf16* ACTo, int b, int h, int tb, const float* lblog, const float* rdec, const float* gain) {
    using namespace rc;
    const int dir = F.wave >> 2, wq = F.wave & 3, lane = F.lane, tr = lane >> 3, ch = lane & 7;
    LAS unsigned char* SL = F.lds + dir * SLOT;
    { const int t256 = wq * 64 + lane;
      *(LAS v4u*)(SL + O_ST + (t256 >> 3) * PT + (t256 & 7) * 16) = R.s0; *(LAS v4u*)(SL + O_ST + ((t256 + 256) >> 3) * PT + (t256 & 7) * 16) = R.s1; }
#pragma unroll
    for (int ii = 0; ii < 2; ++ii) { const int t = 16 * wq + tr + 8 * ii; const unsigned vw[4] = {R.v[ii].x, R.v[ii].y, R.v[ii].z, R.v[ii].w};
#pragma unroll
        for (int x = 0; x < 4; ++x) { *(LAS unsigned short*)(SL + O_VT + (8 * ch + 2 * x) * PT + t * 2) = (unsigned short)(vw[x] & 0xffffu); *(LAS unsigned short*)(SL + O_VT + (8 * ch + 2 * x + 1) * PT + t * 2) = (unsigned short)(vw[x] >> 16); } }
    if (MIXER == 0) {
#pragma unroll
        for (int ii = 0; ii < 2; ++ii) { const int t = 16 * wq + tr + 8 * ii; *(LAS v4u*)(SL + O_QP + t * PT + 16 * ch) = R.q[ii]; *(LAS v4u*)(SL + O_KP + t * PT + 16 * ch) = R.k[ii]; }
        float qv[16], kv[16], q2[16];
#pragma unroll
        for (int i = 0; i < 16; ++i) { qv[i] = bf1(*(const LAS unsigned short*)(SL + O_QP + (16 * wq + i) * PT + 2 * lane)); kv[i] = bf1(*(const LAS unsigned short*)(SL + O_KP + (16 * wq + i) * PT + 2 * lane)); }
        const float lb = lblog ? sigmf(lblog[512 + dir * 256 + h * 64 + lane] - lblog[dir * 256 + h * 64 + lane]) : 0.f;
        float lc[16]; float run = 1.f;
#pragma unroll
        for (int i = 0; i < 16; ++i) { const float f = lb + (1.0f - lb) * sigmf(kv[i]); run *= f; lc[i] = run; kv[i] = 1.0f - f; }
        LAS float* TOT = (LAS float*)(SL + O_TOT); TOT[wq * 64 + lane] = run;
        __syncthreads();
        float pre = 1.f;
#pragma unroll
        for (int q = 0; q < 4; ++q) { const float t = TOT[q * 64 + lane]; if (q < wq) pre *= t; }
        const float rmid = __builtin_amdgcn_rcpf(fmaxf(TOT[lane] * TOT[64 + lane], 1e-30f));
#pragma unroll
        for (int i = 0; i < 16; ++i) { const float pt = pre * lc[i]; q2[i] = qv[i] * pt; const float e1 = fminf(fmaxf(pt * rmid, 1e-30f), 1e30f); qv[i] *= e1; kv[i] *= __builtin_amdgcn_rcpf(e1); }
#pragma unroll
        for (int i = 0; i < 16; ++i) { const int t = 16 * wq + i;
            *(LAS unsigned short*)(SL + O_QP + t * PT + lane * 2) = (unsigned short)f2bf(qv[i]);
            *(LAS unsigned short*)(SL + O_KP + t * PT + lane * 2) = (unsigned short)f2bf(kv[i]);
            *(LAS unsigned short*)(SL + O_QQ + t * PT + lane * 2) = (unsigned short)f2bf(q2[i]); }
    } else {
        const float lg2 = __log2f(sigmf(rdec[dir * 4 + h]));
#pragma unroll
        for (int ii = 0; ii < 2; ++ii) { const int t = 16 * wq + tr + 8 * ii; const float gq = exp2f((float)(t + 1) * lg2) * 0.125f;
            const unsigned qw[4] = {R.q[ii].x, R.q[ii].y, R.q[ii].z, R.q[ii].w}; v4u q1, q2v;
            { unsigned o1[4], o2[4];
#pragma unroll
              for (int x = 0; x < 4; ++x) { const float lo = bflo(qw[x]), hi2 = bfhi(qw[x]); o1[x] = pk2(lo * 0.125f, hi2 * 0.125f); o2[x] = pk2(lo * gq, hi2 * gq); }
              q1 = (v4u){o1[0], o1[1], o1[2], o1[3]}; q2v = (v4u){o2[0], o2[1], o2[2], o2[3]}; }
            *(LAS v4u*)(SL + O_QP + t * PT + 16 * ch) = q1; *(LAS v4u*)(SL + O_QQ + t * PT + 16 * ch) = q2v; *(LAS v4u*)(SL + O_KP + t * PT + 16 * ch) = R.k[ii]; }
    }
    __syncthreads();
    const int ti = wq >> 1, tj = wq & 1, r32 = lane & 31, hi = lane >> 5;
    if (tj <= ti) {
        f32x16 a = {0.f, 0.f, 0.f, 0.f, 0.f, 0.f, 0.f, 0.f, 0.f, 0.f, 0.f, 0.f, 0.f, 0.f, 0.f, 0.f};
#pragma unroll
        for (int kkk = 0; kkk < 4; ++kkk) a = __builtin_amdgcn_mfma_f32_32x32x16_bf16(frag32(SL + O_QP, 32 * ti + r32, 16 * kkk, hi), frag32(SL + O_KP, 32 * tj + r32, 16 * kkk, hi), a, 0, 0, 0);
        const float lg2 = (MIXER == 1) ? __log2f(sigmf(rdec[dir * 4 + h])) : 0.f;
#pragma unroll
        for (int r = 0; r < 16; ++r) { const int dt = 32 * (ti - tj) + crow(r, hi) - r32; float val = a[r];
            if (MIXER == 1) val *= exp2f((float)dt * lg2);
            if (dt < 0) val = 0.f;
            *(LAS unsigned short*)(SL + O_AT + (32 * ti + crow(r, hi)) * PT + (32 * tj + r32) * 2) = (unsigned short)f2bf(val); }
    }
    __syncthreads();
    f32x16 o = {0.f, 0.f, 0.f, 0.f, 0.f, 0.f, 0.f, 0.f, 0.f, 0.f, 0.f, 0.f, 0.f, 0.f, 0.f, 0.f};
#pragma unroll
    for (int st = 0; st < 2; ++st) if (st <= ti) {
#pragma unroll
        for (int kkk = 0; kkk < 2; ++kkk) o = __builtin_amdgcn_mfma_f32_32x32x16_bf16(frag32(SL + O_AT, 32 * ti + r32, 32 * st + 16 * kkk, hi), frag32(SL + O_VT, 32 * tj + r32, 32 * st + 16 * kkk, hi), o, 0, 0, 0); }
#pragma unroll
    for (int kkk = 0; kkk < 4; ++kkk) o = __builtin_amdgcn_mfma_f32_32x32x16_bf16(frag32(SL + O_QQ, 32 * ti + r32, 16 * kkk, hi), frag32(SL + O_ST, 32 * tj + r32, 16 * kkk, hi), o, 0, 0, 0);
    { LAS unsigned char* OX = F.lds + 2 * SLOT + dir * MB;
#pragma unroll
      for (int r = 0; r < 16; ++r) *(LAS unsigned short*)(OX + (32 * ti + crow(r, hi)) * PT + (32 * tj + r32) * 2) = (unsigned short)f2bf(o[r]); }
    __syncthreads();
    { const int tok = F.tid >> 3, ech = F.tid & 7, row = b * RPB + tb * 64 + tok;
      const v4u fw = *(const LAS v4u*)(F.lds + 2 * SLOT + tok * PT + 16 * ech), bw = *(const LAS v4u*)(F.lds + 2 * SLOT + MB + (63 - tok) * PT + 16 * ech);
      const unsigned fws[4] = {fw.x, fw.y, fw.z, fw.w}, bws[4] = {bw.x, bw.y, bw.z, bw.w};
      float ov[8]; float ss = 0.f;
#pragma unroll
      for (int i = 0; i < 4; ++i) { ov[2 * i] = bflo(fws[i]) + bflo(bws[i]); ov[2 * i + 1] = bfhi(fws[i]) + bfhi(bws[i]); ss += ov[2 * i] * ov[2 * i] + ov[2 * i + 1] * ov[2 * i + 1]; }
      ss += xshf<1>(ss); ss += xshf<2>(ss); ss += xshf<4>(ss);
      const float rs = __builtin_amdgcn_rsqf(ss * (1.0f / 64.0f) + NORM_EPS);
      const f32x4 ga = *(const f32x4*)(gain + h * 64 + 8 * ech), gb = *(const f32x4*)(gain + h * 64 + 8 * ech + 4);
      const float gg[8] = {ga.x, ga.y, ga.z, ga.w, gb.x, gb.y, gb.z, gb.w}; const unsigned gws[4] = {R.g.x, R.g.y, R.g.z, R.g.w};
      float res[8];
#pragma unroll
      for (int i = 0; i < 4; ++i) { res[2 * i] = ov[2 * i] * rs * gg[2 * i] * siluf(bflo(gws[i])); res[2 * i + 1] = ov[2 * i + 1] * rs * gg[2 * i + 1] * siluf(bfhi(gws[i])); }
#ifdef OUTPROJ_FP8
      v2u w2; w2.x = pk4_fp8(res[0] * 4.0f, res[1] * 4.0f, res[2] * 4.0f, res[3] * 4.0f); w2.y = pk4_fp8(res[4] * 4.0f, res[5] * 4.0f, res[6] * 4.0f, res[7] * 4.0f);
      *(v2u*)((unsigned char*)ACTo + (size_t)(row >> 1) * 2048 + ((MIXER == 0 ? 0 : 8) + h) * 128 + (row & 1) * 64 + 8 * ech) = w2; }
#else
      v4u w4; w4.x = pk2(res[0], res[1]); w4.y = pk2(res[2], res[3]); w4.z = pk2(res[4], res[5]); w4.w = pk2(res[6], res[7]);
      *(v4u*)(ACTo + (size_t)row * DM + (MIXER == 0 ? 0 : 512) + h * 64 + 8 * ech) = w4; }
#endif
}
__device__ __forceinline__ void recur_stageC_loop(Frame& F, const bf16* P, const bf16* KVS, bf16* ACTo, int mh0, int ub0, int stride, int nub, int ntb, int tboff, const float* lblog, const float* rdec, const float* hn, const float* rn) {
    if (ub0 >= nub) return;
    StageCRaw cur, nxt;
    { const int mh = mh0 & 7; if ((mh >> 2) == 0) stageC_load<0>(cur, F, P, KVS, ub0 / ntb, mh & 3, tboff + ub0 % ntb); else stageC_load<1>(cur, F, P, KVS, ub0 / ntb, mh & 3, tboff + ub0 % ntb); }
    int i = 0;
    for (int ub = ub0; ub < nub; ub += stride, ++i) {
        const int un = ub + stride; const bool more = un < nub; const int mh = (mh0 + i) & 7, mhn = (mh0 + i + 1) & 7;
        if (more) { if ((mhn >> 2) == 0) stageC_load<0>(nxt, F, P, KVS, un / ntb, mhn & 3, tboff + un % ntb); else stageC_load<1>(nxt, F, P, KVS, un / ntb, mhn & 3, tboff + un % ntb); }
        if ((mh >> 2) == 0) stageC_compute<0>(cur, F, ACTo, ub / ntb, mh & 3, tboff + ub % ntb, lblog, rdec, hn);
        else stageC_compute<1>(cur, F, ACTo, ub / ntb, mh & 3, tboff + ub % ntb, nullptr, rdec, rn);
        if (more) cur = nxt;
    }
}
__device__ __forceinline__ void phase_conv(Frame& F, const bf16* P, bf16* ACTo, const float* convw, bool latent_only) {
    const int gw = F.vcu * NWAVES + F.wave, NGW = F.G * NWAVES, rsel = F.lane >> 5, c0 = 8 * (F.lane & 31);
    f32x4 w0[2], w1[2], w2[2];
#pragma unroll
    for (int hf = 0; hf < 2; ++hf) { w0[hf] = *(const f32x4*)(convw + c0 + 4 * hf); w1[hf] = *(const f32x4*)(convw + 256 + c0 + 4 * hf); w2[hf] = *(const f32x4*)(convw + 512 + c0 + 4 * hf); }
    const int nrows = latent_only ? NB * T_LAT : MROWS;
    auto ld8 = [](const bf16* p, f32x4& a, f32x4& b) { const v4u w = *(const v4u*)p; a = (f32x4){bflo(w.x), bfhi(w.x), bflo(w.y), bfhi(w.y)}; b = (f32x4){bflo(w.z), bfhi(w.z), bflo(w.w), bfhi(w.w)}; };
    for (int idx2 = gw; 2 * idx2 < nrows; idx2 += NGW) {
        const int idx = 2 * idx2 + rsel;
        const int r = latent_only ? row_of_latent(idx) : idx;
        const int b = r / RPB, j = r - b * RPB;
        const bf16* row = P + (size_t)r * NPROJ;
        const bool first = (j == 0) || (j == L_CTX), last = (j == L_CTX - 1) || (j == RPB - 1);
        f32x4 ca, cb, ha, hb, u1a, u1b, u0a = (f32x4){0.f, 0.f, 0.f, 0.f}, u0b = u0a, u2a = u0a, u2b = u0a;
        ld8(row + C_CC + c0, ca, cb); ld8(row + C_CH + c0, ha, hb); u1a = ca * ha; u1b = cb * hb;
        if (!first) { ld8(row - NPROJ + C_CC + c0, ca, cb); ld8(row - NPROJ + C_CH + c0, ha, hb); u0a = ca * ha; u0b = cb * hb; }
        if (!last) { ld8(row + NPROJ + C_CC + c0, ca, cb); ld8(row + NPROJ + C_CH + c0, ha, hb); u2a = ca * ha; u2b = cb * hb; }
        f32x4 ba, bb2; ld8(row + C_CB + c0, ba, bb2);
        const f32x4 xa = ba * (w0[0] * u0a + w1[0] * u1a + w2[0] * u2a), xb = bb2 * (w0[1] * u0b + w1[1] * u1b + w2[1] * u2b);
#ifdef OUTPROJ_FP8
        { const f32x4 ya = xa * 4.0f, yb = xb * 4.0f; v2u w2; w2.x = pk4_fp8(ya.x, ya.y, ya.z, ya.w); w2.y = pk4_fp8(yb.x, yb.y, yb.z, yb.w); *(v2u*)((unsigned char*)ACTo + (size_t)(r >> 1) * 2048 + (4 + (c0 >> 6)) * 128 + (r & 1) * 64 + (c0 & 63)) = w2; }
#else
        v4u w; w.x = pk2(xa.x, xa.y); w.y = pk2(xa.z, xa.w); w.z = pk2(xb.x, xb.y); w.w = pk2(xb.z, xb.w); *(v4u*)(ACTo + (size_t)r * DM + 256 + c0) = w;
#endif
    }
}
struct DenseOrder {
    int nM, nN, nwg, G, c, latent_only; const char* A; const char* Bt; size_t tA, tB; unsigned long long pnmap;
    __device__ __forceinline__ void init(int nM_, int nN_, int G_, int c_, int lat, const void* A_, const void* Bt_, int lda, int ldb) {
        nM = nM_; nN = nN_; nwg = nM * nN; G = G_; c = c_; latent_only = lat; A = (const char*)A_; Bt = (const char*)Bt_; tA = (size_t)256 * lda * 2; tB = (size_t)256 * ldb * 2; pnmap = 0xFEDCBA9876543210ull; }
    __device__ __forceinline__ bool next(int i, pg8::Unit& u) const {
        const long L = (long)i * G + c; if (L >= nwg) return false;
        int wgid = (int)L; { const int q = nwg / pg8::NXCD, r = nwg % pg8::NXCD, xcd = wgid % pg8::NXCD, off = wgid / pg8::NXCD; wgid = (xcd < r ? xcd * (q + 1) : r * (q + 1) + (xcd - r) * q) + off; }
#ifndef DENSE_WGM
#define DENSE_WGM 8
#endif
        const int nig = DENSE_WGM * nN, gid = wgid / nig, fm = gid * DENSE_WGM, gsz = (nM - fm) < DENSE_WGM ? (nM - fm) : DENSE_WGM;
        int pm = fm + ((wgid % nig) % gsz); const int pn = (int)((pnmap >> (4 * ((wgid % nig) / gsz))) & 15ull);
        if (latent_only) pm = (pm >> 3) * PPB + 1 + (pm & 7);
        u.pm = pm; u.pn = pn; u.x0 = 0; u.x1 = 0; u.a = A + (size_t)pm * tA; u.b = Bt + (size_t)pn * tB; u.b2 = u.b; return true; }
    __device__ __forceinline__ void a_ready(const pg8::Unit&) const {}
    __device__ __forceinline__ void done(const pg8::Unit&) const {}
};
struct MoeOrder {
    int ncol, nwg, G, c, down, pm0; const LAS int* tileb; const LAS int* tt  ; const char* A; const char* W;
    __device__ __forceinline__ bool next(int i, pg8::Unit& u) const {
        const long L = (long)i * G + c; if (L >= nwg) return false;
        int w = (int)L; { const int q = nwg / pg8::NXCD, r = nwg % pg8::NXCD, xcd = w % pg8::NXCD, off = w / pg8::NXCD; w = (xcd < r ? xcd * (q + 1) : r * (q + 1) + (xcd - r) * q) + off; }
        const int pm = pm0 + w / ncol, pc = w % ncol;
        const int k = __builtin_amdgcn_readfirstlane(tileb[pm]), g = k / 6, pr = k % 6;
        const int ea = pr < 3 ? 0 : (pr < 5 ? 1 : 2), eb = pr < 3 ? pr + 1 : (pr < 5 ? pr - 1 : 3);
        { const int tb_ = __builtin_amdgcn_readfirstlane(tt[32 + k]), tot_ = __builtin_amdgcn_readfirstlane(tt[k]); u.x0 = k * CAPR + (pm - tb_) * 256; u.x1 = k * CAPR + tot_; }
        u.pm = pm; u.pn = pc; u.a = down ? A + (size_t)pm * 256 * 1024 : A;
        if (!down) { const int e = g * 4 + (pc < 4 ? ea : eb); u.b = W + (size_t)(e * 4 + (pc & 3)) * 256 * 1024; u.b2 = u.b; }
        else { const char* base = W + (size_t)(g * 1024 + pc * 256) * 2048; u.b = base + ea * 512; u.b2 = base + eb * 512 - 512; }
        return true; }
    __device__ __forceinline__ void a_ready(const pg8::Unit&) const {}
    __device__ __forceinline__ void done(const pg8::Unit&) const {}
};
struct EpiStore {
    static constexpr bool PERM = true, AFTER_DRAIN = false;
    bf16* O; int ldc; float sc;
    __device__ __forceinline__ void operator()(const f32x4 (&acc)[2][2][4][2], const pg8::Unit& u, int wr, int wc, int fr, int fq) const {
        const int row0 = u.pm * 256 + wr * 64 + fr, col0 = u.pn * 256 + wc * 32 + 8 * fq;
#pragma unroll
        for (int ai = 0; ai < 2; ++ai)
#pragma unroll
            for (int m = 0; m < 4; ++m) { bf16* rowp = O + (size_t)(row0 + ai * 128 + m * 16) * ldc + col0;
#pragma unroll
                for (int bj = 0; bj < 2; ++bj) { const f32x4 v0 = acc[ai][bj][m][0] * sc, v1 = acc[ai][bj][m][1] * sc;
                    v4u w; w.x = pg8::cvt_pk_bf16(v0[0], v0[1]); w.y = pg8::cvt_pk_bf16(v0[2], v0[3]); w.z = pg8::cvt_pk_bf16(v1[0], v1[1]); w.w = pg8::cvt_pk_bf16(v1[2], v1[3]);
                    *(v4u*)(rowp + bj * 128) = w; } }
    }
};
struct EpiResid {
    static constexpr bool PERM = false, AFTER_DRAIN = false;
    const float* xsrc; const float* csrc; float* xdst; float* cdst; const float* gate; float sc;
    __device__ __forceinline__ void operator()(const f32x4 (&acc)[2][2][4][2], const pg8::Unit& u, int wr, int wc, int fr, int fq) const {
        const int b = u.pm / PPB, pj = u.pm - b * PPB; const bool isc = pj == 0;
        const float* src = isc ? csrc + (size_t)b * L_CTX * DM : xsrc + (size_t)(b * T_LAT + (pj - 1) * 256) * DM;
        float* dst = isc ? cdst + (size_t)b * L_CTX * DM : xdst + (size_t)(b * T_LAT + (pj - 1) * 256) * DM;
        const int col0 = u.pn * 256 + wc * 32 + 4 * fq; const float* gp = gate + (isc ? 16 : b) * 1024 + col0;
        f32x4 gv[2][2];
#pragma unroll
        for (int bj = 0; bj < 2; ++bj)
#pragma unroll
            for (int n = 0; n < 2; ++n) gv[bj][n] = *(const f32x4*)(gp + bj * 128 + n * 16) * sc;
#pragma unroll
        for (int ai = 0; ai < 2; ++ai)
#pragma unroll
            for (int m = 0; m < 4; ++m) { const size_t off = (size_t)(ai * 128 + wr * 64 + m * 16 + fr) * DM + col0;
#pragma unroll
                for (int bj = 0; bj < 2; ++bj)
#pragma unroll
                    for (int n = 0; n < 2; ++n) *(f32x4*)(dst + off + bj * 128 + n * 16) = LDNT((const f32x4*)(src + off + bj * 128 + n * 16)) + gv[bj][n] * acc[ai][bj][m][n];
                if (m & 1) asm volatile("" ::: "memory"); }
    }
};
struct EpiGateUp {
    static constexpr bool PERM = true, AFTER_DRAIN = false;
    unsigned char* H; const v4i* rowinfo;
    __device__ __forceinline__ void operator()(const f32x4 (&acc)[2][2][4][2], const pg8::Unit& u, int wr, int wc, int fr, int fq) const {
        const int pos0 = wr * 64 + fr, col0 = u.pn * 128 + wc * 32 + 8 * fq; const bool second = u.pn >= 4;
#pragma unroll
        for (int ai = 0; ai < 2; ++ai)
#pragma unroll
            for (int m = 0; m < 4; ++m) { const int rt = pos0 + ai * 128 + m * 16, pos = u.pm * 256 + rt; const v4i ri = rowinfo[u.x0 + rt];
                const float w = __builtin_bit_cast(float, second ? ri.z : ri.y) * (16.0f / 32.0f);
                const f32x4 g0 = acc[ai][0][m][0] * (1.0f / 32.0f), g1 = acc[ai][0][m][1] * (1.0f / 32.0f), u0 = acc[ai][1][m][0], u1 = acc[ai][1][m][1];
                float h[8];
#pragma unroll
                for (int i = 0; i < 4; ++i) { h[i] = siluf(g0[i]) * u0[i] * w; h[4 + i] = siluf(g1[i]) * u1[i] * w; }
                v2u o; o.x = pk4_fp8(h[0], h[1], h[2], h[3]); o.y = pk4_fp8(h[4], h[5], h[6], h[7]);
                *(v2u*)(H + (size_t)pos * 1024 + col0) = o; }
    }
};
struct EpiDown {
    static constexpr bool PERM = false, AFTER_DRAIN = false;
    float* xdst; float* cdst; const float* gate; const v4i* rowinfo;
    __device__ __forceinline__ void operator()(const f32x4 (&acc)[2][2][4][2], const pg8::Unit& u, int wr, int wc, int fr, int fq) const {
        const int pos0 = u.x0 + wr * 64 + fr, col0 = u.pn * 256 + wc * 32 + 4 * fq;
#pragma unroll
        for (int ai = 0; ai < 2; ++ai)
#pragma unroll
            for (int m = 0; m < 4; ++m) { const int pos = pos0 + ai * 128 + m * 16; const int r = (pos < u.x1) ? rowinfo[pos].x : -1;
#ifdef ZERO_MOE
                if (false) {
#else
                if (r >= 0) {
#endif
                    const int b = r / RPB, j = r - b * RPB; const bool isc = j < L_CTX;
                    float* dst = (isc ? cdst + (size_t)(b * L_CTX + j) * DM : xdst + (size_t)(b * T_LAT + j - L_CTX) * DM) + col0;
                    const float* gp = gate + (isc ? 16 : b) * 1024 + col0;
#pragma unroll
                    for (int bj = 0; bj < 2; ++bj)
#pragma unroll
                        for (int n = 0; n < 2; ++n) { float* p = dst + bj * 128 + n * 16; *(f32x4*)p = LDNT((const f32x4*)p) + *(const f32x4*)(gp + bj * 128 + n * 16) * (acc[ai][bj][m][n] * (1.0f / 512.0f)); } }
                if (m & 1) asm volatile("" ::: "memory"); }
    }
};

__device__ __forceinline__ void phase_norm2_route(Frame& F, int layer, const float* xsrc, const float* csrc, const float* nA, const float* nB, bf16* dst, bool latent_only) {
    typedef short bf16x8v __attribute__((ext_vector_type(8))); typedef float f32x4v __attribute__((ext_vector_type(4)));
    unsigned char* const ws = PWS;
    LAS int* cnt = (LAS int*)(F.lds + TAB_OFF);
    LAS float* MA = (LAS float*)(F.lds); LAS float* MBv = MA + 2048;
    LAS float* SSP = MA + 4096;
    LAS float* PART = SSP + 128;
    LAS float* LOG = PART + 8 * 16 * 32;
    LAS v4i* RI = (LAS v4i*)(LOG + 512);
    const int lane = F.lane, wv = F.wave, r16 = lane & 15, g = lane >> 4, k0w = 128 * wv;
    const int nrows = latent_only ? NB * T_LAT : MROWS, NGW = F.G * NWAVES, RPW = (nrows + NGW - 1) / NGW, RPBLK = NWAVES * RPW;
    const int ib0 = (int)blockIdx.x * RPBLK, ib1 = (ib0 + RPBLK < nrows) ? ib0 + RPBLK : nrows;
    int mfirst = 0, mlast = 0;
    if (ib0 < ib1) { const int ra = latent_only ? row_of_latent(ib0) : ib0, rb = latent_only ? row_of_latent(ib1 - 1) : ib1 - 1;
      const int ba = ra / RPB, ja = ra - ba * RPB, bb_ = rb / RPB, jb = rb - bb_ * RPB; mfirst = (ja < L_CTX) ? 16 : ba; mlast = (jb < L_CTX) ? 16 : bb_; }
    for (int i = F.tid; i < 512; i += NTHR) { const int sl = i >> 8, c4 = (i & 255) * 4, mm = sl ? mlast : mfirst;
        *(LAS f32x4*)(MA + sl * 1024 + c4) = *(const f32x4*)(nA + mm * 1024 + c4); *(LAS f32x4*)(MBv + sl * 1024 + c4) = *(const f32x4*)(nB + mm * 1024 + c4); }
    if (F.tid < 24) cnt[F.tid] = 0;
    bf16x8v Bh[4][2], Bl[4][2];
    { const float* rgw = PIN(I_RGW) + (size_t)layer * 1024 * 4; const float* rew = PIN(I_REW) + (size_t)layer * 1024 * 16;
#pragma unroll
      for (int s = 0; s < 4; ++s)
#pragma unroll
          for (int t = 0; t < 2; ++t) { const int n = 16 * t + r16, kb = k0w + 32 * s + 8 * g; unsigned hw[4], lw[4];
#pragma unroll
              for (int i2 = 0; i2 < 4; ++i2) { float w0 = 0.f, w1 = 0.f;
                  if (n < 4) { w0 = rgw[(kb + 2 * i2) * 4 + n]; w1 = rgw[(kb + 2 * i2 + 1) * 4 + n]; } else if (n < 20) { w0 = rew[(kb + 2 * i2) * 16 + n - 4]; w1 = rew[(kb + 2 * i2 + 1) * 16 + n - 4]; }
                  const unsigned hp = pk2(w0, w1); hw[i2] = hp; lw[i2] = pk2(w0 - bflo(hp), w1 - bfhi(hp)); }
              Bh[s][t] = __builtin_bit_cast(bf16x8v, (v4u){hw[0], hw[1], hw[2], hw[3]}); Bl[s][t] = __builtin_bit_cast(bf16x8v, (v4u){lw[0], lw[1], lw[2], lw[3]}); } }
    float biasn = 0.f; { const int n = F.tid & 31; if (n < 4) biasn = PIN(I_RGB)[layer * 4 + n]; else if (n < 20) biasn = PIN(I_REB)[layer * 16 + n - 4]; }
    __syncthreads();
#ifdef ROUTE_PREFETCH
#define ROUTE_SRC(G0) ({ const int idx_ = ((G0) + r16) < ib1 ? (G0) + r16 : ib1 - 1; const int r_ = latent_only ? row_of_latent(idx_) : idx_; const int b_ = r_ / RPB, j_ = r_ - b_ * RPB; \
        ((j_ < L_CTX) ? csrc + (size_t)(b_ * L_CTX + j_) * DM : xsrc + (size_t)(b_ * T_LAT + j_ - L_CTX) * DM) + k0w + 8 * g; })
    f32x4 xv[4][2], xn[4][2];
    if (ib0 < ib1) { const float* s0 = ROUTE_SRC(ib0);
#pragma unroll
        for (int s = 0; s < 4; ++s) { xv[s][0] = *(const f32x4*)(s0 + 32 * s); xv[s][1] = *(const f32x4*)(s0 + 32 * s + 4); } }
#endif
    for (int g0 = ib0; g0 < ib1; g0 += 16) {
        const bool valid = (g0 + r16) < ib1; const int idx = valid ? g0 + r16 : ib1 - 1;
        const int r = latent_only ? row_of_latent(idx) : idx;
        const int b = r / RPB, j = r - b * RPB, m = (j < L_CTX) ? 16 : b, slot = (m != mfirst) ? 1024 : 0;
        float ss = 0.f;
#ifdef ROUTE_PREFETCH
        { const float* s1 = ROUTE_SRC(g0 + 16 < ib1 ? g0 + 16 : g0);
#pragma unroll
          for (int s = 0; s < 4; ++s) { xn[s][0] = *(const f32x4*)(s1 + 32 * s); xn[s][1] = *(const f32x4*)(s1 + 32 * s + 4); } }
#else
        const float* src = ((j < L_CTX) ? csrc + (size_t)(b * L_CTX + j) * DM : xsrc + (size_t)(b * T_LAT + j - L_CTX) * DM) + k0w + 8 * g;
        f32x4 xv[4][2];
#pragma unroll
        for (int s = 0; s < 4; ++s) { xv[s][0] = LDNT((const f32x4*)(src + 32 * s)); xv[s][1] = LDNT((const f32x4*)(src + 32 * s + 4)); }
#endif
#pragma unroll
        for (int s = 0; s < 4; ++s)
#pragma unroll
            for (int hh = 0; hh < 2; ++hh) { const f32x4 x = xv[s][hh]; ss += (x.x * x.x + x.y * x.y) + (x.z * x.z + x.w * x.w); }
        ss += xshf<16>(ss); ss = half_sum(ss);
        if (lane < 16) SSP[wv * 16 + lane] = ss;
        __syncthreads();
        float tot = 0.f;
#pragma unroll
        for (int w2 = 0; w2 < 8; ++w2) tot += SSP[w2 * 16 + r16];
        const float rstd = __builtin_amdgcn_rsqf(tot * (1.0f / DM) + NORM_EPS);
        f32x4v acc[2] = {{0.f, 0.f, 0.f, 0.f}, {0.f, 0.f, 0.f, 0.f}};
        unsigned char* drow = (unsigned char*)dst + (size_t)r * DM + k0w + 8 * g;
#pragma unroll
        for (int s = 0; s < 4; ++s) { const int co = slot + k0w + 32 * s + 8 * g;
            const f32x4 h0 = xv[s][0] * rstd * *(const LAS f32x4*)(MA + co) + *(const LAS f32x4*)(MBv + co), h1 = xv[s][1] * rstd * *(const LAS f32x4*)(MA + co + 4) + *(const LAS f32x4*)(MBv + co + 4);
            { v2u o; o.x = pk4_fp8(h0.x, h0.y, h0.z, h0.w); o.y = pk4_fp8(h1.x, h1.y, h1.z, h1.w); *(v2u*)(drow + 32 * s) = o; }
            const unsigned p0 = pk2(h0.x, h0.y), p1 = pk2(h0.z, h0.w), p2 = pk2(h1.x, h1.y), p3 = pk2(h1.z, h1.w);
            const unsigned q0 = pk2(h0.x - bflo(p0), h0.y - bfhi(p0)), q1 = pk2(h0.z - bflo(p1), h0.w - bfhi(p1)), q2 = pk2(h1.x - bflo(p2), h1.y - bfhi(p2)), q3 = pk2(h1.z - bflo(p3), h1.w - bfhi(p3));
            const bf16x8v Ah = __builtin_bit_cast(bf16x8v, (v4u){p0, p1, p2, p3}), Al = __builtin_bit_cast(bf16x8v, (v4u){q0, q1, q2, q3});
#pragma unroll
            for (int t = 0; t < 2; ++t) { acc[t] = __builtin_amdgcn_mfma_f32_16x16x32_bf16(Ah, Bh[s][t], acc[t], 0, 0, 0); acc[t] = __builtin_amdgcn_mfma_f32_16x16x32_bf16(Ah, Bl[s][t], acc[t], 0, 0, 0);
                acc[t] = __builtin_amdgcn_mfma_f32_16x16x32_bf16(Al, Bh[s][t], acc[t], 0, 0, 0); } }
#pragma unroll
        for (int t = 0; t < 2; ++t)
#pragma unroll
            for (int x = 0; x < 4; ++x) PART[(wv * 16 + 4 * g + x) * 32 + 16 * t + r16] = acc[t][x];
        __syncthreads();
        { const int row = F.tid >> 5, n = F.tid & 31; float v = biasn;
#pragma unroll
          for (int w2 = 0; w2 < 8; ++w2) v += PART[(w2 * 16 + row) * 32 + n];
          LOG[row * 32 + n] = v; }
        __syncthreads();
        if (F.tid < 16 && (g0 + F.tid) < ib1) {
            const int rr = latent_only ? row_of_latent(g0 + F.tid) : g0 + F.tid;
            float l[20];
#pragma unroll
            for (int jj = 0; jj < 20; ++jj) l[jj] = LOG[F.tid * 32 + jj];
            int gsel = 0; float gm = l[0];
#pragma unroll
            for (int q = 1; q < 4; ++q) if (l[q] > gm) { gm = l[q]; gsel = q; }
            float gs = 0.f;
#pragma unroll
            for (int q = 0; q < 4; ++q) gs += __expf(l[q] - gm);
            const float gp = 1.0f / gs;
            float le[4];
#pragma unroll
            for (int q = 0; q < 4; ++q) le[q] = (gsel == 0) ? l[4 + q] : (gsel == 1) ? l[8 + q] : (gsel == 2) ? l[12 + q] : l[16 + q];
            int e1 = 0; float m1 = le[0];
#pragma unroll
            for (int q = 1; q < 4; ++q) if (le[q] > m1) { m1 = le[q]; e1 = q; }
            int e2 = -1; float m2 = 0.f;
#pragma unroll
            for (int q = 0; q < 4; ++q) if (q != e1 && (e2 < 0 || le[q] > m2)) { m2 = le[q]; e2 = q; }
            const float bexp = __expf(m2 - m1), w1 = gp / (1.0f + bexp), w2 = gp * bexp / (1.0f + bexp);
            const int ea = e1 < e2 ? e1 : e2, eb = e1 < e2 ? e2 : e1; const float wa = e1 < e2 ? w1 : w2, wb = e1 < e2 ? w2 : w1;
            const int pidx = ea == 0 ? eb - 1 : (ea == 1 ? eb + 1 : 5), bucket = gsel * 6 + pidx;
            const int rank = atomicAdd((int*)(cnt + bucket), 1); RI[g0 - ib0 + F.tid] = (v4i){bucket, rank, __builtin_bit_cast(int, wa), __builtin_bit_cast(int, wb)}; (void)rr;
        }
#ifdef ROUTE_PREFETCH
#pragma unroll
        for (int s = 0; s < 4; ++s) { xv[s][0] = xn[s][0]; xv[s][1] = xn[s][1]; }
#endif
    }
#ifdef ROUTE_PREFETCH
#undef ROUTE_SRC
#endif
    __syncthreads();
    if (F.tid < 24) { const int c = cnt[F.tid]; cnt[32 + F.tid] = c ? (int)__hip_atomic_fetch_add((unsigned*)(F.ctl + CW_GCNT + 64 * (layer * 32 + F.tid)), (unsigned)c, __ATOMIC_RELAXED, __HIP_MEMORY_SCOPE_AGENT) : 0; }
    __syncthreads();
    { v4i* RCAP = (v4i*)(ws + WS_RCAP);
      for (int i = F.tid; i < ib1 - ib0; i += NTHR) { const v4i e = RI[i]; const int rr2 = latent_only ? row_of_latent(ib0 + i) : ib0 + i;
          RCAP[(size_t)e.x * CAPR + cnt[32 + e.x] + e.y] = (v4i){rr2, e.z, e.w, 0}; } }
    __syncthreads();
}

__device__ __forceinline__ void phase_scatter(Frame& F, bool latent_only) {
    unsigned char* const ws = PWS;
    LAS int* tab = (LAS int*)(F.lds + TAB_OFF);
    const int* BC = (const int*)(ws + WS_BCNT);
    if (F.tid < 384) { const int k = F.tid >> 4, part = F.tid & 15; int tot = 0, below = 0;
        for (int bb = part * 16; bb < part * 16 + 16 && bb < F.G; ++bb) { const int v = BC[bb * 24 + k]; tot += v; if (bb < (int)blockIdx.x) below += v; }
        tot += xshi<1>(tot); tot += xshi<2>(tot); tot += xshi<4>(tot); tot += xshi<8>(tot); below += xshi<1>(below); below += xshi<2>(below); below += xshi<4>(below); below += xshi<8>(below);
        if (part == 0) { tab[32 + k] = tot; tab[k] = below; } }
    __syncthreads();
    if (F.tid == 0) { int tb = 0; for (int k = 0; k < 24; ++k) { const int nt = (tab[32 + k] + 255) >> 8; tab[64 + k] = tb; tab[96 + k] = nt; tab[k] += tb * 256; tb += nt; } tab[128] = tb; }
    __syncthreads();
    v4i* ROWINFO = (v4i*)(ws + WS_ROWINFO);
    if (blockIdx.x == 0) { int* TI = (int*)(ws + WS_TILEINFO); if (F.tid == 0) TI[0] = tab[128];
        if (F.tid < 24) { const int t0 = tab[64 + F.tid], nt = tab[96 + F.tid]; for (int t = 0; t < nt; ++t) TI[1 + t0 + t] = F.tid; } }
    for (int k = blockIdx.x; k < 24; k += F.G) { const int p0 = tab[64 + k] * 256 + tab[32 + k], p1 = (tab[64 + k] + tab[96 + k]) * 256;
        for (int p = p0 + F.tid; p < p1; p += NTHR) ROWINFO[p] = (v4i){-1, 0, 0, 0}; }
    const int nrows = latent_only ? NB * T_LAT : MROWS, NGW = F.G * NWAVES, RPW = (nrows + NGW - 1) / NGW, gwb = (int)blockIdx.x * NWAVES + F.wave;
    const v4i* ROUTE = (const v4i*)(ws + WS_ROUTE);
    { const int i0 = gwb * RPW, i1 = (i0 + RPW < nrows) ? i0 + RPW : nrows;
      if (i0 + F.lane < i1) { const int idx = i0 + F.lane, r = latent_only ? row_of_latent(idx) : idx; const v4i ri = ROUTE[r]; ROWINFO[tab[ri.x] + ri.y] = (v4i){r, ri.z, ri.w, 0}; } }
    __syncthreads();
}
#if DEBUG_CHECK
__device__ __forceinline__ unsigned dbg_hash(unsigned x) { x ^= x >> 16; x *= 0x7feb352du; x ^= x >> 15; x *= 0x846ca68bu; x ^= x >> 16; return x; }
__device__ __forceinline__ void dbg_fail(Frame& F, int bit) { atomicOr((unsigned*)(F.ctl + CW_ERR), 1u << bit); }
__device__ __forceinline__ void dbg_check_gemm_bf16(Frame& F, const bf16* A, const bf16* Bt, const bf16* O, int ldo, int bit) {
    const int s = F.vcu * NTHR + F.tid;
    if (s < 16384) { const int row = dbg_hash(2 * s + 1) % MROWS, col = dbg_hash(2 * s + 2) % 3072; float ref = 0.f;
        for (int k = 0; k < 1024; ++k) ref += bf1(A[(size_t)row * 1024 + k]) * bf1(Bt[(size_t)col * 1024 + k]);
        const float got = bf1(O[(size_t)row * ldo + col]);
        if (!(fabsf(got - ref) <= 0.02f * fabsf(ref) + 0.05f)) dbg_fail(F, bit); }
}
__device__ __forceinline__ float naive_attn_row(Frame& F, const bf16* P, int b, int h, int j) {
    LAS float* pl = (LAS float*)(F.lds) + F.wave * 2304;
    const bf16* Pb = P + (size_t)b * RPB * NPROJ; const bf16* q = Pb + (size_t)j * NPROJ + C_AQ + h * 64;
    const int nk = (j < L_CTX) ? 4 : 36;
    float sc[36]; float mx = -1e30f;
#pragma unroll
    for (int i = 0; i < 36; ++i) { sc[i] = -1e30f; if (i < nk) { const bf16* k = Pb + (size_t)(i * 64 + F.lane) * NPROJ + C_AK + (h >> 1) * 64; float a = 0.f;
        for (int d = 0; d < 64; ++d) a += bf1(q[d]) * bf1(k[d]);
        sc[i] = a; mx = fmaxf(mx, a); } }
    mx = fmaxf(mx, xshf<1>(mx)); mx = fmaxf(mx, xshf<2>(mx)); mx = fmaxf(mx, xshf<4>(mx)); mx = fmaxf(mx, xshf<8>(mx)); mx = fmaxf(mx, xshf<16>(mx));
    mx = half_max(mx);
    float sum = 0.f;
#pragma unroll
    for (int i = 0; i < 36; ++i) { const float p = (i < nk) ? exp2f(sc[i] - mx) : 0.f; sum += p; pl[i * 64 + F.lane] = p; }
    sum = wave_sum(sum); LDS_WAIT(); asm volatile("" ::: "memory");
    float o = 0.f;
    for (int key = 0; key < nk * 64; ++key) o += pl[key] * bf1(Pb[(size_t)key * NPROJ + C_AV + (h >> 1) * 64 + F.lane]);
    LDS_WAIT(); asm volatile("" ::: "memory");
    return o / sum;
}
__device__ __forceinline__ void dbg_check_attn(Frame& F, const bf16* P, const bf16* ACT_, int bit, bool with_ctx) {
    const int s = F.vcu * NWAVES + F.wave;
    const int b = dbg_hash(3 * s + 1) % NB, h = dbg_hash(3 * s + 2) % 4; int j = L_CTX + dbg_hash(3 * s + 3) % T_LAT;
    if (with_ctx && (s & 7) == 0) j = dbg_hash(3 * s + 3) % L_CTX;
    const float o = naive_attn_row(F, P, b, h, j);
    const float got = bf1(ACT_[(size_t)(b * RPB + j) * DM + 768 + h * 64 + F.lane]);
    if (!(fabsf(got - o) <= 0.03f * fabsf(o) + 0.02f)) dbg_fail(F, j < L_CTX ? bit + 1 : bit);
    __syncthreads();
}
__device__ __forceinline__ void dbg_check_outproj(Frame& F, const float* xsrc, const float* xdst, const bf16* ACT_, const bf16* Wt, const float* gate, int bit) {
    const int s = F.vcu * NTHR + F.tid;
    if (s < 16384) { const int idx = dbg_hash(2 * s + 5) % (NB * T_LAT), col = dbg_hash(2 * s + 6) % DM, r = row_of_latent(idx), b = idx >> 11; float ref = 0.f;
        for (int k = 0; k < 1024; ++k) ref += bf1(ACT_[(size_t)r * 1024 + k]) * bf1(Wt[(size_t)col * 1024 + k]);
        ref = xsrc[(size_t)idx * DM + col] + gate[b * 1024 + col] * ref;
        const float got = xdst[(size_t)idx * DM + col];
        if (!(fabsf(got - ref) <= 0.01f * fabsf(ref) + 0.01f)) dbg_fail(F, bit); }
}
__device__ __forceinline__ void dbg_check_gateup(Frame& F, const unsigned char* A8, const unsigned char* Wgu8, const unsigned char* H8, const v4i* rowinfo, const LAS int* tileb, int ntiles, int bit) {
    const int s = F.vcu * NTHR + F.tid;
    if (s < 16384) { const int pos = dbg_hash(2 * s + 7) % (ntiles * 256), hc = dbg_hash(2 * s + 8) % 1024; const v4i ri = rowinfo[pos];
        if (ri.x >= 0) { const int k = tileb[pos >> 8], g = k / 6, pr = k % 6; const int ea = pr < 3 ? 0 : (pr < 5 ? 1 : 2), eb = pr < 3 ? pr + 1 : (pr < 5 ? pr - 1 : 3);
            const int e = g * 4 + (hc < 512 ? ea : eb), jj = hc & 511; const float wgt = __builtin_bit_cast(float, hc < 512 ? ri.y : ri.z);
            const unsigned char* wg = Wgu8 + ((size_t)e * 1024 + (jj >> 7) * 256 + (jj & 127)) * 1024; const unsigned char* wu = wg + 128 * 1024; float ga = 0.f, up = 0.f;
            for (int q = 0; q < 1024; ++q) { const float a = fp8_dec(A8[(size_t)ri.x * 1024 + q]); ga += a * fp8_dec(wg[q]); up += a * fp8_dec(wu[q]); }
            const float ref = 16.0f * siluf(ga * (1.0f / 32.0f)) * (up * (1.0f / 32.0f)) * wgt, got = fp8_dec(H8[(size_t)pos * 1024 + hc]);
            if (!(fabsf(got - ref) <= 0.08f * fabsf(ref) + 0.02f)) dbg_fail(F, bit); } }
}
__device__ __forceinline__ void dbg_check_mix(Frame& F, const bf16* P, const bf16* act, const float* lblog, const float* rdec, const float* hn, const float* rn) {
    const int s = F.vcu * NWAVES + F.wave, lane = F.lane;
    const int mixer = s & 1, b = dbg_hash(5 * s + 1) % NB, h = dbg_hash(5 * s + 2) % 4, j = L_CTX + dbg_hash(5 * s + 3) % T_LAT;
    float osum = 0.f;
    for (int dir = 0; dir < 2; ++dir) {
        const float lb = (mixer == 0 && lblog) ? sigmf(lblog[512 + dir * 256 + h * 64 + lane] - lblog[dir * 256 + h * 64 + lane]) : 0.f;
        const float gamma = sigmf(rdec[dir * 4 + h]);
        const int nt = (dir == 0) ? j : (RPB + L_CTX - 1 - j);
        float S[64];
#pragma unroll
        for (int dd = 0; dd < 64; ++dd) S[dd] = 0.f;
        float o = 0.f;
        for (int n = 0; n <= nt; ++n) { const bf16* rp = P + (size_t)(b * RPB + rc::row_in_batch(dir, n)) * NPROJ;
            float f, k, q, v;
            if (mixer == 0) { f = lb + (1.0f - lb) * sigmf(bf1(rp[C_HZ + 256 * dir + h * 64 + lane])); k = 1.0f - f; q = bf1(rp[C_HQ + h * 64 + lane]); v = bf1(rp[C_HI + h * 64 + lane]); }
            else { f = gamma; k = bf1(rp[C_RK + h * 64 + lane]); q = 0.125f * bf1(rp[C_RQ + h * 64 + lane]); v = bf1(rp[C_RV + h * 64 + lane]); }
            o = 0.f;
#pragma unroll
            for (int dd = 0; dd < 64; ++dd) { const float fd = __builtin_bit_cast(float, __builtin_amdgcn_readlane(__builtin_bit_cast(int, f), dd)), kd = __builtin_bit_cast(float, __builtin_amdgcn_readlane(__builtin_bit_cast(int, k), dd)),
                    qd = __builtin_bit_cast(float, __builtin_amdgcn_readlane(__builtin_bit_cast(int, q), dd));
                S[dd] = fd * S[dd] + kd * v; o += qd * S[dd]; } }
        osum += o;
    }
    const float rs = 1.0f / sqrtf(wave_sum(osum * osum) * (1.0f / 64.0f) + NORM_EPS);
    const float g = bf1(P[(size_t)(b * RPB + j) * NPROJ + (mixer == 0 ? C_HG : C_RG) + h * 64 + lane]);
    const float ref = osum * rs * (mixer == 0 ? hn : rn)[h * 64 + lane] * siluf(g);
    const float got = bf1(act[(size_t)(b * RPB + j) * DM + (mixer == 0 ? 0 : 512) + h * 64 + lane]);
    const float se = wave_sum(fabsf(got - ref)), sr = wave_sum(fabsf(ref));
    if (!(se <= 0.03f * sr + 0.3f)) dbg_fail(F, mixer == 0 ? 6 : 7);
}
__device__ __forceinline__ void dbg_check_norm1(Frame& F, const bf16* act, const float* MODp) {
    const int s = F.vcu * NTHR + F.tid;
    if (s < 8192) { const int r = dbg_hash(2 * s + 11) % MROWS, c = dbg_hash(2 * s + 12) % DM, b = r / RPB, j = r - b * RPB, m = (j < L_CTX) ? 16 : b;
        const float* src = (j < L_CTX) ? PIN(I_CTX) + (size_t)(b * L_CTX + j) * DM : PIN(I_X) + (size_t)(b * T_LAT + j - L_CTX) * DM;
        const float* cv = (j < L_CTX) ? PIN(I_CCTX) : PIN(I_C) + b * 1024; const float* aw = PIN(I_ADAW); const float* ab = PIN(I_ADAB);
        float ss = 0.f, sh = ab[c], scl = ab[1024 + c];
        for (int k = 0; k < 1024; ++k) { ss += src[k] * src[k]; const float sv = siluf(cv[k]); sh += sv * aw[(size_t)k * 6144 + c]; scl += sv * aw[(size_t)k * 6144 + 1024 + c]; }
        const float nA = PIN(I_NMIX)[c] * (1.0f + scl);
        const float gB = MODp[0 * 17 * 1024 + m * 1024 + c], gA = MODp[1 * 17 * 1024 + m * 1024 + c];
        if (!(fabsf(gB - sh) <= 1e-3f * fabsf(sh) + 1e-3f)) dbg_fail(F, 2);
        if (!(fabsf(gA - nA) <= 1e-3f * fabsf(nA) + 1e-3f)) dbg_fail(F, 3);
        const float ref = src[c] * (1.0f / sqrtf(ss / 1024.0f + NORM_EPS)) * gA + gB;
        const float got = bf1(act[(size_t)r * DM + c]);
        if (!(fabsf(got - ref) <= 0.01f * fabsf(ref) + 0.01f)) dbg_fail(F, 4); }
}
__device__ __forceinline__ void dbg_apply(Frame& F, float* out, unsigned* barw) {
    unsigned m = __hip_atomic_load((unsigned*)(F.ctl + CW_ERR), RLX_AGENT);
    if (__hip_atomic_load(barw + XB_TMO, RLX_AGENT) != 0u) m |= 32u;
    if (m) { const float sc = 1.0f + 10.0f * exp2f(0.33219f * (float)m); for (size_t i = (size_t)F.vcu * NTHR + F.tid; i < (size_t)NB * T_LAT * DM; i += (size_t)F.G * NTHR) out[i] *= sc; }
}
#endif
#ifndef NAIVE_ATTN
#define NAIVE_ATTN 0
#endif
#if NAIVE_ATTN && DEBUG_CHECK
__device__ __forceinline__ void phase_naive_attn(Frame& F, const bf16* P, bf16* ACT_, bool latent_only) {
    const int gw = F.vcu * NWAVES + F.wave, NGW = F.G * NWAVES;
    for (int it = gw; it < MROWS * 4; it += NGW) { const int r = it >> 2, h = it & 3, b = r / RPB, j = r - b * RPB;
        if (latent_only && j < L_CTX) continue;
        const float o = naive_attn_row(F, P, b, h, j);
        ACT_[(size_t)r * DM + 768 + h * 64 + F.lane] = (bf16)f2bf(o); }
    __syncthreads();
}
#endif
#ifndef SKIPMASK
#define SKIPMASK 0
#endif
#ifdef REP_BAR
#define GRID_BAR_X() xcd_barrier(bar)
#else
#define GRID_BAR_X() do {} while (0)
#endif
#ifdef PROBE_BARTIME
#define GRID_BAR_T0() const unsigned long long tb0_ = __builtin_amdgcn_s_memrealtime()
#define GRID_BAR_T1(site) do { if ((PROBE_BARMASK >> (site)) & 1) F.bart += (unsigned)(__builtin_amdgcn_s_memrealtime() - tb0_); } while (0)
#else
#define GRID_BAR_T0() do {} while (0)
#define GRID_BAR_T1(site) do {} while (0)
#endif
#define GRID_BAR(site) do { GRID_BAR_T0(); GRID_BAR_X(); xcd_barrier(bar); GRID_BAR_T1(site); { int t_ = F.tid; asm volatile("" : "+v"(t_)); F.tid = t_; F.lane = t_ & 63; F.wave = __builtin_amdgcn_readfirstlane(t_ >> 6); } ws = PWS; } while (0)
#define ACT ((bf16*)(ws + WS_ACT))
#define P ((bf16*)(ws + WS_P))
#define CTXB ((float*)(ws + WS_CTX))
#define ORET ((bf16*)(ws + WS_ORET))
#ifdef OUTPROJ_FP8
#define ATTN_OPTR(b, h) ((attn_body::bf16*)((unsigned char*)ACT + (size_t)(b) * RPB * DM + (12 + (h)) * 128))
#else
#define ATTN_OPTR(b, h) ((attn_body::bf16*)ACT + (size_t)(b) * RPB * DM + 768 + (h) * 64)
#endif
template <int layer> __device__ __forceinline__ void layer_body(Frame& F, XcdBarrier& bar, unsigned char* lds) {
    LAS int* const tileb = (LAS int*)(F.lds + TAB_OFF + 1024);
    unsigned char* ws = PWS;
        const bool lastl = (layer == DEPTH - 1);
        const float* xsrc = (layer == 0) ? PIN(I_X) : (const float*)POUT;
        const float* csrc = (layer == 0) ? PIN(I_CTX) : (const float*)CTXB;
        const float* MOD = (const float*)(ws + WS_MOD) + (size_t)layer * 6 * 17 * 1024;
        #if !(SKIPMASK & 1)
        phase_norm1(F, xsrc, csrc, MOD + 1 * 17 * 1024, MOD + 0 * 17 * 1024, ACT, ws + WS_KVS);
#ifdef REP_N1
        phase_norm1(F, xsrc, csrc, MOD + 1 * 17 * 1024, MOD + 0 * 17 * 1024, ACT, ws + WS_KVS);
#endif
#endif

        GRID_BAR(1);
#if DEBUG_CHECK
        if (layer == 0) dbg_check_norm1(F, ACT, MOD);
#endif
        #if !(SKIPMASK & 2)
        {
            constexpr int NF8 = __builtin_popcount(INPROJ_F8MASK), NB16 = NPROJ / 256 - NF8;
            unsigned long long map16 = 0ull, map8 = 0ull; { int j16 = 0, j8 = 0; for (int t = 0; t < NPROJ / 256; ++t) { if ((INPROJ_F8MASK >> t) & 1) map8 |= (unsigned long long)t << (4 * j8++); else map16 |= (unsigned long long)t << (4 * j16++); } }
            pg8::Gemm g{DM, DM, DM, nullptr}; DenseOrder S; S.init(NPANEL, NB16, F.G, (int)blockIdx.x, 0, ACT, (const bf16*)(ws + WS_W0 + (size_t)layer * WLAYER + WO_WIN), DM, DM); S.pnmap = map16;
            EpiStore E{P, NPROJ, 1.0f};
#ifndef REP_INPROJ
#define REP_INPROJ 1
#endif
            pg8::gemm_phase<EpiStore, DenseOrder, false, true>(F.lds + RING_OFF, g, S, E, F.tid);
            if (NF8 > 0) {
                pg8::Gemm g8{512, 512, 512, nullptr}; DenseOrder S8; const int c8 = ((int)blockIdx.x + F.G - (NPANEL * NB16) % F.G) % F.G;
                S8.init(NPANEL, NF8, F.G, c8, 0, ws + WS_KVS, (const bf16*)(ws + WS_W0 + (size_t)layer * WLAYER + WO_WIN), 512, 512); S8.tB = 524288; S8.pnmap = map8;
                EpiStore E8{P, NPROJ, 1.0f / 32.0f};
                pg8::gemm_phase<EpiStore, DenseOrder, false, true, false, true>(F.lds + RING_OFF, g8, S8, E8, F.tid);
#if defined(REP_F8)
                __syncthreads();
                pg8::gemm_phase<EpiStore, DenseOrder, false, true, false, true>(F.lds + RING_OFF, g8, S8, E8, F.tid);
#endif
            }
#if REP_INPROJ == 2
            __syncthreads();
            pg8::gemm_phase<EpiStore, DenseOrder, false, true>(F.lds + RING_OFF, g, S, E, F.tid);
#endif
        }
#endif

        GRID_BAR(2);
#if DEBUG_CHECK
        dbg_check_gemm_bf16(F, ACT, (const bf16*)(ws + WS_W0 + (size_t)layer * WLAYER + WO_WIN), P, NPROJ, 0);
#endif
        #if !(SKIPMASK & 4)
        phase_prep(F, P, PIN(I_QN) + layer * 64, PIN(I_KN) + layer * 64, (const float*)(ws + WS_ROPE), (const float*)(ws + WS_ROPE) + 2048 * 32);
#ifdef REP_PREP
        phase_prep<true>(F, P, PIN(I_QN) + layer * 64, PIN(I_KN) + layer * 64, (const float*)(ws + WS_ROPE), (const float*)(ws + WS_ROPE) + 2048 * 32);
#endif
#endif

#ifdef SPLIT_MIX
#define LAUNDER_TID() do { int t_ = F.tid; asm volatile("" : "+v"(t_)); F.tid = t_; F.lane = t_ & 63; F.wave = __builtin_amdgcn_readfirstlane(t_ >> 6); ws = PWS; } while (0)
        xcd_split_arrive(bar, (unsigned*)(F.ctl + CW_BAR4));
        {
            bf16* KVS = (bf16*)(ws + WS_KVS); float* DBUF = (float*)(ws + WS_DBUF); const float* lbl = (layer == 0) ? nullptr : PIN(I_LB); const float* rdec = PIN(I_RDEC) + layer * 8;
            recur_stageA_loop(F, P, KVS, DBUF, F.vcu * NWAVES + F.wave, F.G * NWAVES, 256 * 36, lbl, rdec);
        }
        xcd_split_arrive(bar, (unsigned*)(F.ctl + CW_BAR5));
        xcd_split_wait(bar, (unsigned*)(F.ctl + CW_BAR4), (unsigned)layer + 1u);
        LAUNDER_TID();
        {
            const int nunits = lastl ? 512 : 576;
            for (int ui = 0; ; ++ui) {
                const int u = F.vcu + ui * F.G;
                if (ui == 1) {
                    xcd_split_wait(bar, (unsigned*)(F.ctl + CW_BAR5), (unsigned)layer + 1u);
                    LAUNDER_TID();
                    { bf16* KVS = (bf16*)(ws + WS_KVS); const float* DBUF = (const float*)(ws + WS_DBUF); const float* rdec = PIN(I_RDEC) + layer * 8;
                      for (int seq = F.vcu; seq < 256; seq += F.G) { const int mixer = seq >> 7, h = (seq >> 1) & 3, dir = seq & 1;
                          if (mixer == 0) recur_stageB_seq<0>(F, KVS, DBUF, seq, 0.f); else recur_stageB_seq<1>(F, KVS, DBUF, seq, sigmf(rdec[dir * 4 + h])); } }
                    xcd_split_arrive(bar, (unsigned*)(F.ctl + CW_BAR2));
                    LAUNDER_TID();
                }
                if (u >= nunits) break;
                int b, h, qb; if (u < 512) { b = u >> 5; h = (u >> 3) & 3; qb = 1 + (u & 7); } else { b = (u - 512) >> 2; h = u & 3; qb = 0; }
                const attn_body::bf16* Pb = (const attn_body::bf16*)P + (size_t)b * RPB * NPROJ;
                attn_body::attn_unit<8>(qb * 256, qb == 0 ? 4 : 36, Pb + C_AQ + h * 64, Pb + C_AK + (h >> 1) * 64, Pb + C_AV + (h >> 1) * 64,
                                        ATTN_OPTR(b, h), (char*)lds + RING_OFF, F.tid);
            }
        }
#else
        {
            bf16* KVS = (bf16*)(ws + WS_KVS); float* DBUF = (float*)(ws + WS_DBUF); const float* lbl = (layer == 0) ? nullptr : PIN(I_LB); const float* rdec = PIN(I_RDEC) + layer * 8;
#ifndef REP_A
#define REP_A 1
#endif
            for (int rp_REP_A = 0; rp_REP_A < REP_A; ++rp_REP_A)
            recur_stageA_loop(F, P, KVS, DBUF, F.vcu * NWAVES + F.wave, F.G * NWAVES, 256 * 36, lbl, rdec);
        }
        GRID_BAR(3);
        {
            { bf16* KVS = (bf16*)(ws + WS_KVS); const float* DBUF = (const float*)(ws + WS_DBUF); const float* rdec = PIN(I_RDEC) + layer * 8;
#ifndef REP_B
#define REP_B 1
#endif
            for (int rp_REP_B = 0; rp_REP_B < REP_B; ++rp_REP_B)
              for (int seq = F.vcu; seq < 256; seq += F.G) { const int mixer = seq >> 7, h = (seq >> 1) & 3, dir = seq & 1;
                  if (mixer == 0) recur_stageB_seq<0>(F, KVS, DBUF, seq, 0.f); else recur_stageB_seq<1>(F, KVS, DBUF, seq, sigmf(rdec[dir * 4 + h])); } }
#ifdef REP_BDRY
            { bf16* KVS = (bf16*)(ws + WS_KVS); const float* DBUF = (const float*)(ws + WS_DBUF); const float* rdec = PIN(I_RDEC) + layer * 8;
              for (int seq = F.vcu; seq < 256; seq += F.G) { const int mixer = seq >> 7, h = (seq >> 1) & 3, dir = seq & 1;
                  if (mixer == 0) recur_stageB_seq<0, true>(F, KVS, DBUF, seq, 0.f); else recur_stageB_seq<1, true>(F, KVS, DBUF, seq, sigmf(rdec[dir * 4 + h])); } }
#endif

#ifdef SPLIT_BC
            xcd_split_arrive(bar, (unsigned*)(F.ctl + CW_BAR2));
#endif
#if NAIVE_ATTN && DEBUG_CHECK
            phase_naive_attn(F, P, ACT, lastl);
#elif !(SKIPMASK & 16)
        const int nunits = lastl ? 512 : 576;
#ifndef REP_ATTN
#define REP_ATTN 1
#endif
            for (int rep_ = 0; rep_ < REP_ATTN; ++rep_)
            for (int u = F.vcu; u < nunits; u += F.G) {
                int b, h, qb; if (u < 512) { b = u >> 5; h = (u >> 3) & 3; qb = 1 + (u & 7); } else { b = (u - 512) >> 2; h = u & 3; qb = 0; }
                const attn_body::bf16* Pb = (const attn_body::bf16*)P + (size_t)b * RPB * NPROJ;
                attn_body::attn_unit<8>(qb * 256, qb == 0 ? 4 : 36, Pb + C_AQ + h * 64, Pb + C_AK + (h >> 1) * 64, Pb + C_AV + (h >> 1) * 64,
                                        ATTN_OPTR(b, h), (char*)lds + RING_OFF, F.tid);
            }
#endif

        }
#endif
#ifdef SPLIT_BC
        xcd_split_wait(bar, (unsigned*)(F.ctl + CW_BAR2), (unsigned)layer + 1u);
        { int t_ = F.tid; asm volatile("" : "+v"(t_)); F.tid = t_; F.lane = t_ & 63; F.wave = __builtin_amdgcn_readfirstlane(t_ >> 6); } ws = PWS;
#else
        GRID_BAR(4);
#endif
        {
            const bf16* KVS = (const bf16*)(ws + WS_KVS); const float* lbl = (layer == 0) ? nullptr : PIN(I_LB); const float* rdec = PIN(I_RDEC) + layer * 8;
            const float* hn = PIN(I_HNORM) + layer * 256; const float* rn = PIN(I_RNORM) + layer * 256;
            const int ntb = lastl ? 32 : 36;
#ifndef REP_C
#define REP_C 1
#endif
            for (int rp_REP_C = 0; rp_REP_C < REP_C; ++rp_REP_C)
            recur_stageC_loop(F, P, KVS, ACT, F.vcu & 7, F.vcu >> 3, (F.G >= 8) ? (F.G >> 3) : 1, 16 * ntb, ntb, lastl ? 4 : 0, lbl, rdec, hn, rn);
            phase_conv(F, P, ACT, PIN(I_CONVW) + layer * 768, lastl);
#ifdef REP_CONV
            phase_conv(F, P, ACT, PIN(I_CONVW) + layer * 768, lastl);
#endif
        }
        GRID_BAR(5);
#if DEBUG_CHECK
        dbg_check_mix(F, P, ACT, layer == 0 ? nullptr : PIN(I_LB), PIN(I_RDEC) + layer * 8, PIN(I_HNORM) + layer * 256, PIN(I_RNORM) + layer * 256);
#endif
#if DEBUG_CHECK
        dbg_check_attn(F, P, ACT, 1, !lastl);
#endif
        #if !(SKIPMASK & 64)
        {
#ifdef OUTPROJ_FP8
            pg8::Gemm g{512, 512, 512, nullptr}; DenseOrder S; S.init(lastl ? NB * 8 : NPANEL, 4, F.G, (int)blockIdx.x, lastl ? 1 : 0, ACT, (const bf16*)(ws + WS_W0 + (size_t)layer * WLAYER + WO_WOUT), 512, 512);
            EpiResid E{xsrc, csrc, POUT, CTXB, MOD + 2 * 17 * 1024, 1.0f / 128.0f};
            pg8::gemm_phase<EpiResid, DenseOrder, true, true, false, true, true>(F.lds + RING_OFF, g, S, E, F.tid);
#else
            pg8::Gemm g{DM, DM, DM, nullptr}; DenseOrder S; S.init(lastl ? NB * 8 : NPANEL, 4, F.G, (int)blockIdx.x, lastl ? 1 : 0, ACT, (const bf16*)(ws + WS_W0 + (size_t)layer * WLAYER + WO_WOUT), DM, DM);
            EpiResid E{xsrc, csrc, POUT, CTXB, MOD + 2 * 17 * 1024, 1.0f};
            pg8::gemm_phase<EpiResid, DenseOrder, true, true>(F.lds + RING_OFF, g, S, E, F.tid);
#endif
        }
        if (layer == 0) {
            __syncthreads();
#ifdef SPLIT_OP
            xcd_split_arrive(bar, (unsigned*)(F.ctl + CW_BAR4));
#endif
            constexpr int PL = 1792 + 512 + 3 * 4096;
#ifdef CONV_SPLIT64
            if (F.G == 256) { const int c = (int)blockIdx.x;
                if (c < 64) convert_weights_range(F, PL, PL + CONV_SPLIT64, c * NWAVES + F.wave, 64 * NWAVES);
                else convert_weights_range(F, PL + CONV_SPLIT64, 2 * PL, (c - 64) * NWAVES + F.wave, 192 * NWAVES); }
            else convert_weights_range(F, PL, 2 * PL, F.vcu * NWAVES + F.wave, F.G * NWAVES);
#else
            const int nb = (int)blockIdx.x - 64, nw = (F.G - 64) * NWAVES;
            if (F.G > 64) convert_weights_range(F, PL, 2 * PL, nb >= 0 ? nb * NWAVES + F.wave : -1, nw);
            else convert_weights_range(F, PL, 2 * PL, F.vcu * NWAVES + F.wave, F.G * NWAVES);
#endif
            __syncthreads();
        }
#endif

#ifdef SPLIT_OP
        if (layer == 0) { xcd_split_wait(bar, (unsigned*)(F.ctl + CW_BAR4), 1u); { int t_ = F.tid; asm volatile("" : "+v"(t_)); F.tid = t_; F.lane = t_ & 63; F.wave = __builtin_amdgcn_readfirstlane(t_ >> 6); } ws = PWS; }
        else GRID_BAR(6);
#else
        GRID_BAR(6);
#endif
#if DEBUG_CHECK
        if (layer == 0) dbg_check_outproj(F, PIN(I_X), POUT, ACT, (const bf16*)(ws + WS_W0 + (size_t)layer * WLAYER + WO_WOUT), MOD + 2 * 17 * 1024, 3);
        GRID_BAR(6);
#endif
        #if !(SKIPMASK & 128)
        phase_norm2_route(F, layer, (const float*)POUT, (const float*)CTXB, MOD + 4 * 17 * 1024, MOD + 3 * 17 * 1024, ACT, lastl);
#ifdef REP_N2
        phase_norm2_route(F, layer, (const float*)POUT, (const float*)CTXB, MOD + 4 * 17 * 1024, MOD + 3 * 17 * 1024, ACT, lastl);
#endif
#endif

        GRID_BAR(7);
#ifdef MOE_SPLIT
        {
            const int* TI = (const int*)(ws + WS_TILEINFO); const int ntiles = TI[0], T1 = ntiles >> 1;
            for (int i = F.tid; i < MAXTILES; i += NTHR) tileb[i] = (i < ntiles) ? TI[1 + i] : 0;
            __syncthreads();
            int dealt = 0;
#pragma nounroll
            for (int part = 0; part < 2; ++part) {
                const int t0 = part ? T1 : 0, ntp = part ? ntiles - T1 : T1;
                pg8::Gemm g{512, 512, 512, nullptr}; g.rowidx = (const int*)(ws + WS_ROWINFO);
                MoeOrder S; S.pm0 = t0; S.ncol = 8; S.nwg = ntp * 8; S.G = F.G; S.c = ((int)blockIdx.x + F.G - dealt % F.G) % F.G; S.down = 0; S.tileb = tileb; S.A = (const char*)(ws + WS_ACT); S.W = (const char*)(ws + WS_W0 + (size_t)layer * WLAYER + WO_WGU);
                EpiGateUp E{ws + WS_H, (const v4i*)(ws + WS_ROWINFO)};
                pg8::gemm_phase<EpiGateUp, MoeOrder, true, true, true, true>(F.lds + RING_OFF, g, S, E, F.tid);
                dealt += ntp * 8;
                xcd_split_arrive(bar, (unsigned*)(F.ctl + (part ? CW_BAR4 : CW_BAR3)));
            }
#pragma nounroll
            for (int part = 0; part < 2; ++part) {
                xcd_split_wait(bar, (unsigned*)(F.ctl + (part ? CW_BAR4 : CW_BAR3)), (unsigned)layer + 1u);
                { int t_ = F.tid; asm volatile("" : "+v"(t_)); F.tid = t_; F.lane = t_ & 63; F.wave = __builtin_amdgcn_readfirstlane(t_ >> 6); } ws = PWS;
                const int t0 = part ? T1 : 0, ntp = part ? ntiles - T1 : T1;
                pg8::Gemm g{512, 1024, 512, nullptr};
                MoeOrder S; S.pm0 = t0; S.ncol = 4; S.nwg = ntp * 4; S.G = F.G; S.c = ((int)blockIdx.x + F.G - dealt % F.G) % F.G; S.down = 1; S.tileb = tileb; S.A = (const char*)(ws + WS_H); S.W = (const char*)(ws + WS_W0 + (size_t)layer * WLAYER + WO_WD);
                EpiDown E{POUT, CTXB, MOD + 5 * 17 * 1024, (const v4i*)(ws + WS_ROWINFO)};
                pg8::gemm_phase<EpiDown, MoeOrder, true, true, false, true>(F.lds + RING_OFF, g, S, E, F.tid);
                dealt += ntp * 4;
            }
        }
#else
        #if !(SKIPMASK & 512)
        {
            LAS int* tt = (LAS int*)(F.lds + TAB_OFF);
            if (F.tid < 24) tt[F.tid] = (int)__hip_atomic_load((unsigned*)(F.ctl + CW_GCNT + 64 * (layer * 32 + F.tid)), __ATOMIC_RELAXED, __HIP_MEMORY_SCOPE_AGENT);
            __syncthreads();
            if (F.tid == 0) { int tb = 0; for (int kk = 0; kk < 24; ++kk) { const int nt = (tt[kk] + 255) >> 8; tt[32 + kk] = tb; for (int t = 0; t < nt; ++t) tileb[tb + t] = kk; tb += nt; } tt[64] = tb; }
            __syncthreads();
            const int ntiles = tt[64];
            pg8::Gemm g{512, 512, 512, nullptr};
            g.rowidx = (const int*)(ws + WS_RCAP);
            MoeOrder S; S.pm0 = 0; S.ncol = 8; S.nwg = ntiles * 8; S.G = F.G; S.c = (int)blockIdx.x; S.down = 0; S.tileb = tileb; S.tt = tt; S.A = (const char*)(ws + WS_ACT); S.W = (const char*)(ws + WS_W0 + (size_t)layer * WLAYER + WO_WGU);
            EpiGateUp E{ws + WS_H, (const v4i*)(ws + WS_RCAP)};
#ifndef REP_GU
#define REP_GU 1
#endif
            pg8::gemm_phase<EpiGateUp, MoeOrder, true, true, true, true>(F.lds + RING_OFF, g, S, E, F.tid);
#if REP_GU == 2
            __syncthreads();
            pg8::gemm_phase<EpiGateUp, MoeOrder, true, true, true, true>(F.lds + RING_OFF, g, S, E, F.tid);
#endif
        }
#endif

        GRID_BAR(9);
#if DEBUG_CHECK
        { const int* TI = (const int*)(ws + WS_TILEINFO); dbg_check_gateup(F, ws + WS_ACT, ws + WS_W0 + (size_t)layer * WLAYER + WO_WGU, ws + WS_H, (const v4i*)(ws + WS_ROWINFO), tileb, TI[0], 4); }
#endif
        #if !(SKIPMASK & 1024)
        {
            const LAS int* tt = (const LAS int*)(F.lds + TAB_OFF); const int ntiles = tt[64];
            pg8::Gemm g{512, 1024, 512, nullptr};
            MoeOrder S; S.pm0 = 0; S.ncol = 4; S.nwg = ntiles * 4; S.G = F.G; S.c = (int)blockIdx.x; S.down = 1; S.tileb = tileb; S.tt = tt; S.A = (const char*)(ws + WS_H); S.W = (const char*)(ws + WS_W0 + (size_t)layer * WLAYER + WO_WD);
            EpiDown E{POUT, CTXB, MOD + 5 * 17 * 1024, (const v4i*)(ws + WS_RCAP)};
            pg8::gemm_phase<EpiDown, MoeOrder, true, true, false, true>(F.lds + RING_OFF, g, S, E, F.tid);
        }
#endif

#endif
#if defined(PROBE_BARTIME) || DEBUG_CHECK
        GRID_BAR(10);
#else
        if (!lastl) GRID_BAR(10);
#endif
    }
__global__ void __launch_bounds__(NTHR, 2) fwd_kernel(Args args) {
    extern __shared__ __attribute__((aligned(16))) unsigned char lds[];
    Frame F;
    F.lds = (LAS unsigned char*)lds;
    F.MISC = (volatile LAS unsigned*)(F.lds + MISC_OFF);
    F.tid = threadIdx.x; F.lane = F.tid & 63; F.wave = __builtin_amdgcn_readfirstlane(F.tid >> 6);
    F.bart = 0u; F.G = gridDim.x; { const int bx = blockIdx.x; F.vcu = (F.G % 8 == 0) ? (bx % 8) * (F.G / 8) + bx / 8 : bx; }
    F.ctl = (gu32*)(args.ws + WS_CTL);
    for (int u = F.tid; u < (LDS_BYTES - LDSCTL_OFF) / 4; u += NTHR) ((LAS unsigned*)(F.lds + LDSCTL_OFF))[u] = 0u;
    __syncthreads();
    if (F.tid == 0) { volatile LAS unsigned long long* pt = (volatile LAS unsigned long long*)(F.lds + PTAB_OFF);
#pragma unroll
        for (int i = 0; i < 24; ++i) pt[i] = (unsigned long long)args.in[i];
        pt[24] = (unsigned long long)args.out; pt[25] = (unsigned long long)(args.ws + args.ws_shift); }
    __syncthreads();
    XcdBarrier bar = xcd_barrier_post((unsigned*)(F.ctl + CW_BAR), F.MISC + 8);
    unsigned char* ws = PWS;

    #if !(SKIPMASK & 2048)
        p0_prologue(F, bar);
#endif

#ifdef SPLIT_PRO
    xcd_split_wait(bar, (unsigned*)(F.ctl + CW_BAR3), 1u);
    { int t_ = F.tid; asm volatile("" : "+v"(t_)); F.tid = t_; F.lane = t_ & 63; F.wave = __builtin_amdgcn_readfirstlane(t_ >> 6); } ws = PWS;
#else
    GRID_BAR(0);
#endif

    layer_body<0>(F, bar, lds);
    layer_body<1>(F, bar, lds);
#ifdef PROBE_BARTIME
    if (blockIdx.x == PROBE_BARTIME - 1 && F.tid == 0) { const unsigned long long ts_ = __builtin_amdgcn_s_memrealtime(); while (__builtin_amdgcn_s_memrealtime() - ts_ < 8ull * F.bart) __builtin_amdgcn_s_sleep(8); }
#endif
#if DEBUG_CHECK
    dbg_apply(F, POUT, bar.bar);
#endif
}

extern "C" void kernel_launch(void* const* d_in, const int* in_sizes, int n_in, void* d_out, int out_size, void* d_ws, size_t ws_size, hipStream_t stream) {
    static int grid = 0;
    if (grid == 0) {
        if (n_in != 24 || out_size != NB * T_LAT * DM || ws_size < WS_END) { fprintf(stderr, "kernel_launch: unexpected shapes (n_in %d, out %d, ws %zu); nothing launched\n", n_in, out_size, ws_size); grid = -1; return; }
        int dev = 0, cus = 0, per_cu = 0;
        if (hipGetDevice(&dev) != hipSuccess || hipDeviceGetAttribute(&cus, hipDeviceAttributeMultiprocessorCount, dev) != hipSuccess) { grid = -1; return; }
        if (hipFuncSetAttribute((const void*)fwd_kernel, hipFuncAttributeMaxDynamicSharedMemorySize, LDS_BYTES) != hipSuccess) { grid = -1; return; }
        if (hipOccupancyMaxActiveBlocksPerMultiprocessor(&per_cu, (const void*)fwd_kernel, NTHR, LDS_BYTES) != hipSuccess || per_cu < 1) { fprintf(stderr, "kernel_launch: occupancy query says %d blocks per CU\n", per_cu); grid = -1; return; }
        (void)hipGetLastError();
        grid = cus < 256 ? cus : 256;
    }
    if (grid < 0) return;
    if (hipMemsetAsync((char*)d_ws + WS_CTL, 0, CTL_ZERO_BYTES, stream) != hipSuccess) return;
    Args a{};
    for (int i = 0; i < 24; ++i) a.in[i] = (const float*)d_in[i];
    a.out = (float*)d_out; a.ws = (unsigned char*)d_ws;
#ifdef WS_TOP
    a.ws_shift = ((ws_size - WS_END) / (2 * MiB)) * (2 * MiB);
#endif
    hipLaunchKernelGGL(fwd_kernel, dim3(grid), dim3(NTHR), LDS_BYTES, stream, a);
}
```

```cpp
#define SPLIT_BC 1
#define EARLY_INV 1
#define TOP_DIRECT 1

#define MOD_WIDE 1
#define SPLIT_PRO 1
#define SPLIT_OP 1


#define EMU_TILES 0

#define INPROJ_F8MASK 0x3F02

#include <hip/hip_runtime.h>
#ifdef NT_LOADS
#define LDNT(p) __builtin_nontemporal_load(p)
#else
#define LDNT(p) (*(p))
#endif
#include <hip/hip_bf16.h>
#include <cstdio>
#include <cstdint>
#include <cmath>
#ifndef DEBUG_CHECK
#define DEBUG_CHECK 0
#endif
#define DENSE_WGM 4
#ifndef NAIVE_ATTN
#define NAIVE_ATTN 0
#endif

namespace pg8 {
#define PG8_LAS __attribute__((address_space(3)))
typedef unsigned short bf16_t;
typedef short bf16x8 __attribute__((ext_vector_type(8)));
typedef float f32x4 __attribute__((ext_vector_type(4)));
typedef unsigned u32x4 __attribute__((ext_vector_type(4)));
constexpr int BM = 256, BK = 64, HALF = 128, HTB = HALF * BK * 2  , STAGE_BYTES = 8 * HTB, NXCD = 8, WGM = 8;

__host__ __device__ __forceinline__ int lds_byte(int r, int c) { const int st = (r >> 4) * 2 + (c >> 5), rr = r & 15, cc = c & 31, ob = rr * 64 + cc * 2; return st * 1024 + (ob ^ (((ob >> 9) & 1) << 5)); }
__host__ __device__ __forceinline__ void stage_rc(int b, int& R, int& C) { const int st = b / 1024, sb = b % 1024, swz = sb ^ (((sb >> 9) & 1) << 5); R = (st >> 1) * 16 + swz / 64; C = (st & 1) * 32 + (swz % 64) / 2; }
__host__ __device__ __forceinline__ void stage_rc8(int b, int& R, int& C) { const int blk = b >> 11, rr = (b >> 7) & 15, ps = (b >> 5) & 3, k = (b >> 4) & 1, gl = ps ^ ((rr >> 1) & 3); R = blk * 16 + rr; C = (gl * 2 + k) * 8; }
__host__ __device__ __forceinline__ int perm32(int rho) { const int n = rho >> 4, i = rho & 15; return 8 * (i >> 2) + 4 * n + (i & 3); }

struct Unit { const char* a; const char* b; const char* b2; int pm, pn, x0, x1; };
struct Gemm { int lda, ldb, K; const int* rowidx; };
typedef int i32x8 __attribute__((ext_vector_type(8)));
typedef int i32x4 __attribute__((ext_vector_type(4)));
__device__ __forceinline__ i32x8 pg8_cat(bf16x8 a, bf16x8 b) { const i32x4 x = __builtin_bit_cast(i32x4, a), y = __builtin_bit_cast(i32x4, b); return (i32x8){x[0], x[1], x[2], x[3], y[0], y[1], y[2], y[3]}; }
__device__ __forceinline__ unsigned cvt_pk_bf16(float lo, float hi) { unsigned r; asm volatile("v_cvt_pk_bf16_f32 %0, %1, %2" : "=v"(r) : "v"(lo), "v"(hi)); return r; }

template <class Epi, class Sched, bool ALIGN_EPI = false, bool SP2 = false, bool GATHER = false, bool FP8 = false, bool APAIR = false>
__device__ __forceinline__ void gemm_phase(PG8_LAS unsigned char* lds, const Gemm g, const Sched& S, const Epi& E, const int tid) {
    const int wid = __builtin_amdgcn_readfirstlane(tid >> 6), lane = tid & 63, wr = wid >> 2, wc = wid & 3, fr = lane & 15, fq = lane >> 4;
    const int K = g.K, nt = K / BK;
    unsigned voffA[2], voffB[2];
#pragma unroll
    for (int i = 0; i < 2; ++i) { int R, C; if constexpr (FP8) stage_rc8(tid * 16 + i * 8192, R, C); else stage_rc(tid * 16 + i * 8192, R, C); const int Rb = Epi::PERM ? ((R & ~31) + perm32(R & 31)) : R;
        voffA[i] = APAIR ? (unsigned)((R >> 1) * g.lda * 4 + ((2 * C) >> 6) * 128 + (R & 1) * 64 + ((2 * C) & 63)) : (unsigned)(R * g.lda + C) * 2u; voffB[i] = (unsigned)(Rb * g.ldb + C) * 2u; }
    unsigned gc[2][2] = {{0u, 0u}, {0u, 0u}}, gn[2][2] = {{0u, 0u}, {0u, 0u}}; int gR[2] = {0, 0}, gC[2] = {0, 0};
    if constexpr (GATHER) {
#pragma unroll
        for (int i = 0; i < 2; ++i) { if constexpr (FP8) stage_rc8(tid * 16 + i * 8192, gR[i], gC[i]); else stage_rc(tid * 16 + i * 8192, gR[i], gC[i]); } }
#define PG8_GOFF(dst, pm_) do { _Pragma("unroll") for (int _h = 0; _h < 2; ++_h) _Pragma("unroll") for (int _i = 0; _i < 2; ++_i) { \
        int _r = g.rowidx[(size_t)((pm_) * 256 + _h * 128 + gR[_i]) * 4]; _r = _r < 0 ? 0 : _r; dst[_h][_i] = (unsigned)(_r * g.lda + gC[_i]) * 2u; } } while (0)
    const size_t kstep = (size_t)(BK * 2);
    const size_t kstepA = APAIR ? kstep * 2 : kstep;
    const size_t hstepA = (size_t)HALF * g.lda * 2, hstepB = (size_t)HALF * g.ldb * 2;
    const unsigned ldsw = (unsigned)wid * 1024u;
    const int aoff = FP8 ? (wr * 4) * 2048 + fr * 128 + ((fq ^ ((fr >> 1) & 3)) * 32) : lds_byte(wr * 64 + fr, fq * 8), boff = FP8 ? (wc * 2) * 2048 + fr * 128 + ((fq ^ ((fr >> 1) & 3)) * 32) : lds_byte(wc * 32 + fr, fq * 8);
#define PG8_SA(b, h) (((b) * 2 + (h)) * HTB)
#define PG8_SB(b, h) ((4 + (b) * 2 + (h)) * HTB)
#define PG8_STAGE(bufoff, gbase, voff) do { _Pragma("unroll") for (int _i = 0; _i < 2; ++_i) \
        __builtin_amdgcn_global_load_lds((const unsigned*)((const char*)(gbase) + (voff)[_i]), (PG8_LAS unsigned*)(lds + (bufoff) + ldsw + _i * 8192), 16, 0, 0); } while (0)
#define PG8_STAGE_A(bufoff, tbase, hh, NX) do { if constexpr (GATHER) { _Pragma("unroll") for (int _i = 0; _i < 2; ++_i) { const unsigned _o = (NX) ? gn[hh][_i] : gc[hh][_i]; \
        __builtin_amdgcn_global_load_lds((const unsigned*)((const char*)(tbase) + _o), (PG8_LAS unsigned*)(lds + (bufoff) + ldsw + _i * 8192), 16, 0, 0); } } \
        else { PG8_STAGE(bufoff, (tbase) + (hh) * hstepA, voffA); } } while (0)
#define PG8_LDA(dst, b, h) do { if constexpr (FP8) { _Pragma("unroll") for (int m = 0; m < 4; ++m) dst##8[m] = *(const PG8_LAS i32x8*)(lds + PG8_SA(b, h) + aoff + m * 2048); } \
        else { _Pragma("unroll") for (int m = 0; m < 4; ++m) _Pragma("unroll") for (int k = 0; k < 2; ++k) dst[m][k] = *(const PG8_LAS bf16x8*)(lds + PG8_SA(b, h) + aoff + m * 2048 + k * 1024); } } while (0)
#define PG8_LDB(dst, b, h) do { if constexpr (FP8) { _Pragma("unroll") for (int n = 0; n < 2; ++n) dst##8[n] = *(const PG8_LAS i32x8*)(lds + PG8_SB(b, h) + boff + n * 2048); } \
        else { _Pragma("unroll") for (int n = 0; n < 2; ++n) _Pragma("unroll") for (int k = 0; k < 2; ++k) dst[n][k] = *(const PG8_LAS bf16x8*)(lds + PG8_SB(b, h) + boff + n * 2048 + k * 1024); } } while (0)
#define PG8_MMA(ai, bj, At, Bt) do { __builtin_amdgcn_s_setprio(1); if constexpr (FP8) { _Pragma("unroll") for (int m = 0; m < 4; ++m) _Pragma("unroll") for (int n = 0; n < 2; ++n) \
        asm volatile("v_mfma_scale_f32_16x16x128_f8f6f4 %0, %1, %2, %0, %3, %3 op_sel_hi:[0,0,0]" : "+v"(acc[ai][bj][m][n]) : "v"(Bt##8[n]), "v"(At##8[m]), "v"(pg8_one)); }     \
        else { _Pragma("unroll") for (int m = 0; m < 4; ++m) _Pragma("unroll") for (int n = 0; n < 2; ++n) _Pragma("unroll") for (int k = 0; k < 2; ++k) \
        acc[ai][bj][m][n] = __builtin_amdgcn_mfma_f32_16x16x32_bf16(Bt[n][k], At[m][k], acc[ai][bj][m][n], 0, 0, 0); } __builtin_amdgcn_s_setprio(0); } while (0)
#define PG8_WAIT_V(n) asm volatile("s_waitcnt vmcnt(" #n ")" ::: "memory")
#define PG8_WAIT_L(n) asm volatile("s_waitcnt lgkmcnt(" #n ")" ::: "memory")
#define PG8_BAR __builtin_amdgcn_s_barrier()
#define PG8_SCHED __builtin_amdgcn_sched_barrier(0)
    Unit cur, nxt; int ui = 0;
    if (!S.next(0, cur)) return;
    f32x4 acc[2][2][4][2];
#pragma unroll
    for (int a = 0; a < 2; ++a)
#pragma unroll
        for (int b = 0; b < 2; ++b)
#pragma unroll
            for (int m = 0; m < 4; ++m)
#pragma unroll
                for (int n = 0; n < 2; ++n) acc[a][b][m][n] = (f32x4){0.f, 0.f, 0.f, 0.f};
    const int pg8_one = 0x7f7f7f7f;
    bf16x8 At[4][2], B0[2][2], B1[2][2];
    i32x8 At8[4], B08[2], B18[2];
    const char* cA = cur.a; const char* cB = cur.b; const char* cB2 = cur.b2; const int nth = nt >> 1;
    if constexpr (GATHER) { PG8_GOFF(gc, cur.pm); }
    S.a_ready(cur);
    if constexpr (SP2) {
        PG8_STAGE(PG8_SB(0, 0), cB, voffB); PG8_STAGE(PG8_SB(0, 1), cB + hstepB, voffB); PG8_STAGE_A(PG8_SA(0, 0), cA, 0, false); PG8_STAGE_A(PG8_SA(0, 1), cA, 1, false);
        if (wr == 1) PG8_BAR;
        PG8_WAIT_V(2); PG8_BAR;
        PG8_STAGE(PG8_SB(1, 0), cB + kstep, voffB); PG8_STAGE_A(PG8_SA(1, 0), cA + kstepA, 0, false); PG8_STAGE(PG8_SB(1, 1), cB + hstepB + kstep, voffB);
        PG8_WAIT_V(6); PG8_BAR;
    } else {
        PG8_STAGE(PG8_SB(0, 0), cB, voffB); PG8_STAGE_A(PG8_SA(0, 0), cA, 0, false); PG8_STAGE(PG8_SB(0, 1), cB + hstepB, voffB); PG8_STAGE_A(PG8_SA(0, 1), cA, 1, false);
        if (wr == 1) PG8_BAR;
        PG8_WAIT_V(4); PG8_BAR;
        PG8_STAGE(PG8_SB(1, 0), cB + kstep, voffB); PG8_STAGE_A(PG8_SA(1, 0), cA + kstepA, 0, false); PG8_STAGE(PG8_SB(1, 1), cB + hstepB + kstep, voffB);
        PG8_WAIT_V(6); PG8_BAR;
    }
    for (;;) {
        const bool has_next = S.next(ui + 1, nxt);
        if constexpr (GATHER) { if (has_next) { PG8_GOFF(gn, nxt.pm); } }
        const char* nA = has_next ? nxt.a : cA; const char* nB = has_next ? nxt.b : cB;
#pragma nounroll
        for (int t = 0; t < nt; t += 2) {
            const bool last = (t == nt - 2);
            const char* a1 = cA + (size_t)(t + 1) * kstepA;
            const char* a2 = last ? nA : cA + (size_t)(t + 2) * kstepA; const char* b2 = last ? nB : ((t + 2 < nth) ? cB : cB2) + (size_t)(t + 2) * kstep;
            const char* a3 = a2 + kstepA; const char* b3 = b2 + kstep;
            if (last && has_next) S.a_ready(nxt);
            if constexpr (SP2) {
            PG8_LDB(B0, 0, 0); PG8_LDB(B1, 0, 1); PG8_SCHED; PG8_LDA(At, 0, 0); PG8_STAGE_A(PG8_SA(1, 1), a1, 1, false);
            PG8_WAIT_V(8); PG8_WAIT_L(0); PG8_BAR; PG8_MMA(0, 0, At, B0); PG8_MMA(0, 1, At, B1); PG8_BAR; PG8_SCHED;
            PG8_LDA(At, 0, 1); PG8_STAGE(PG8_SB(0, 0), b2, voffB); PG8_STAGE(PG8_SB(0, 1), b2 + hstepB, voffB); PG8_STAGE_A(PG8_SA(0, 0), a2, 0, last);
            PG8_WAIT_V(8); PG8_WAIT_L(0); PG8_BAR; PG8_MMA(1, 0, At, B0); PG8_MMA(1, 1, At, B1); PG8_BAR; PG8_SCHED;
            PG8_LDB(B0, 1, 0); PG8_LDB(B1, 1, 1); PG8_SCHED; PG8_LDA(At, 1, 0); PG8_STAGE_A(PG8_SA(0, 1), a2, 1, last);
            PG8_WAIT_V(8); PG8_WAIT_L(0); PG8_BAR; PG8_MMA(0, 0, At, B0); PG8_MMA(0, 1, At, B1); PG8_BAR; PG8_SCHED;
            PG8_LDA(At, 1, 1); PG8_STAGE(PG8_SB(1, 0), b3, voffB); PG8_STAGE(PG8_SB(1, 1), b3 + hstepB, voffB); PG8_STAGE_A(PG8_SA(1, 0), a3, 0, last);
            PG8_WAIT_V(8); PG8_WAIT_L(0); PG8_BAR; PG8_MMA(1, 0, At, B0); PG8_MMA(1, 1, At, B1); PG8_BAR; PG8_SCHED;
            } else {
            PG8_LDB(B0, 0, 0); PG8_SCHED; PG8_LDA(At, 0, 0); PG8_STAGE_A(PG8_SA(1, 1), a1, 1, false);
            PG8_WAIT_L(8); PG8_BAR; PG8_WAIT_L(0); PG8_MMA(0, 0, At, B0); PG8_BAR; PG8_SCHED;
            PG8_LDB(B1, 0, 1); PG8_STAGE(PG8_SB(0, 0), b2, voffB);
            PG8_BAR; PG8_WAIT_L(0); PG8_MMA(0, 1, At, B1); PG8_BAR;
            PG8_LDA(At, 0, 1); PG8_STAGE_A(PG8_SA(0, 0), a2, 0, last);
            PG8_BAR; PG8_WAIT_L(0); PG8_MMA(1, 0, At, B0); PG8_BAR; PG8_SCHED;
            PG8_STAGE(PG8_SB(0, 1), b2 + hstepB, voffB);
            PG8_WAIT_V(6); PG8_BAR; PG8_MMA(1, 1, At, B1); PG8_BAR;
            PG8_LDB(B0, 1, 0); PG8_SCHED; PG8_LDA(At, 1, 0); PG8_STAGE_A(PG8_SA(0, 1), a2, 1, last);
            PG8_WAIT_L(8); PG8_BAR; PG8_WAIT_L(0); PG8_MMA(0, 0, At, B0); PG8_BAR; PG8_SCHED;
            PG8_LDB(B1, 1, 1); PG8_STAGE(PG8_SB(1, 0), b3, voffB);
            PG8_BAR; PG8_WAIT_L(0); PG8_MMA(0, 1, At, B1); PG8_BAR;
            PG8_LDA(At, 1, 1); PG8_STAGE_A(PG8_SA(1, 0), a3, 0, last);
            PG8_BAR; PG8_WAIT_L(0); PG8_MMA(1, 0, At, B0); PG8_BAR; PG8_SCHED;
            PG8_STAGE(PG8_SB(1, 1), b3 + hstepB, voffB);
            PG8_WAIT_V(6); PG8_BAR; PG8_MMA(1, 1, At, B1); PG8_BAR;
            }
        }
        if constexpr (FP8) asm volatile("s_nop 15\n\ts_nop 7" ::: "memory");
        if constexpr (ALIGN_EPI) { if (wr == 0) PG8_BAR; }
        if constexpr (!Epi::AFTER_DRAIN) { E(acc, cur, wr, wc, fr, fq); S.done(cur); }
        if (!has_next) break;
#pragma unroll
        for (int a = 0; a < 2; ++a)
#pragma unroll
            for (int b = 0; b < 2; ++b)
#pragma unroll
                for (int m = 0; m < 4; ++m)
#pragma unroll
                    for (int n = 0; n < 2; ++n) acc[a][b][m][n] = (f32x4){0.f, 0.f, 0.f, 0.f};
        cur = nxt; cA = nA; cB = nB; cB2 = nxt.b2; ++ui;
        if constexpr (GATHER) { _Pragma("unroll") for (int _h = 0; _h < 2; ++_h) _Pragma("unroll") for (int _i = 0; _i < 2; ++_i) gc[_h][_i] = gn[_h][_i]; }
        if constexpr (ALIGN_EPI) { if (wr == 1) PG8_BAR; }
    }
    PG8_WAIT_V(0);
    if constexpr (!ALIGN_EPI) { if (wr == 0) PG8_BAR; }
    PG8_BAR;
    if constexpr (Epi::AFTER_DRAIN) { E.fused(acc, cur, wr, wc, fr, fq, lds, wid, lane); S.done(cur); }
#undef PG8_SA
#undef PG8_SB
#undef PG8_STAGE
#undef PG8_LDA
#undef PG8_STAGE_A
#undef PG8_GOFF
#undef PG8_LDB
#undef PG8_MMA
#undef PG8_WAIT_V
#undef PG8_WAIT_L
#undef PG8_BAR
#undef PG8_SCHED
}
}

#include <hip/hip_bf16.h>
#include <cmath>
namespace attn_body {
using bf16=__hip_bfloat16;
using bf16x8=__attribute__((ext_vector_type(8)))short;
using s16x4=__attribute__((ext_vector_type(4)))short;
using f32x16=__attribute__((ext_vector_type(16)))float;
using u32x4=__attribute__((ext_vector_type(4)))unsigned;
constexpr int D=64, QP=3584, KP=3584, VP=3584, OP=1024;
constexpr int NW=8,QBLK=32,QB=QBLK*NW,KVBLK=64;
constexpr int ATTN_UNIT_ROWS=QB;
__device__ __forceinline__ int crow(int r,int hi){return (r&3)+8*(r>>2)+4*hi;}
#define SBAR() __builtin_amdgcn_sched_barrier(0)
__device__ __forceinline__ void cmask(f32x16&p0,f32x16&p1,int jb,int qrel,int hi){
  const float NEG=-INFINITY; int kb=64*jb+4*hi;
  #pragma unroll
  for(int r=0;r<16;++r){int kv=kb+(r&3)+8*(r>>2); if(kv>qrel)p0[r]=NEG; if(kv+32>qrel)p1[r]=NEG;}
}

constexpr int NSLOT=3, SLOTB=8192;
constexpr int LDS_K=0, LDS_V=NSLOT*SLOTB, LDS_WS=2*NSLOT*SLOTB, LDS_OST=LDS_WS+NW*64*4, LDS_BYTES=LDS_OST+NW*4096;
constexpr float C2=0.125f*1.4426950408889634f;
__device__ __forceinline__ void glds16(const void*gsrc,unsigned lds_dst){unsigned keep;
  asm volatile("s_mov_b32 %0, m0\n\ts_mov_b32 m0, %2\n\ts_nop 0\n\tglobal_load_lds_dwordx4 %1, off\n\ts_mov_b32 m0, %0":"=&s"(keep):"v"(gsrc),"s"(lds_dst):"memory");}
__device__ __forceinline__ float max3f(float a,float b,float c){float r;asm("v_max3_f32 %0, %1, %2, %3":"=v"(r):"v"(a),"v"(b),"v"(c));return r;}
__device__ __forceinline__ float max2f(float a,float b){float r;asm("v_max_f32_e32 %0, %1, %2":"=v"(r):"v"(a),"v"(b));return r;}
__device__ __forceinline__ float fadd_s(float a,float b){float r;asm("v_add_f32_e32 %0, %1, %2":"=v"(r):"v"(a),"v"(b));return r;}
__device__ __forceinline__ float fsub_s(float a,float b){float r;asm("v_sub_f32_e32 %0, %1, %2":"=v"(r):"v"(a),"v"(b));return r;}
typedef float f32x2_t __attribute__((ext_vector_type(2))); typedef __bf16 bf16x2_t __attribute__((ext_vector_type(2)));
__device__ __forceinline__ unsigned cvtpk_s(float lo,float hi){f32x2_t v={lo,hi};bf16x2_t b=__builtin_convertvector(v,bf16x2_t);return __builtin_bit_cast(unsigned,b);}
#define WAIT_BAR(N) asm volatile("s_waitcnt vmcnt(" #N ") lgkmcnt(0)\n\ts_barrier":::"memory")

__device__ __forceinline__ void qkt(f32x16&p0,f32x16&p1,const char*Kslot,const bf16x8*qr,const f32x16&negm,int r32,int hi){
  const char*kb=Kslot+hi*1024+r32*16;
  #pragma unroll
  for(int d0=0;d0<4;++d0){
    const bf16x8 b0=*reinterpret_cast<const bf16x8*>(kb+d0*2048);
    const bf16x8 b1=*reinterpret_cast<const bf16x8*>(kb+d0*2048+512);
    if(d0==0){p0=__builtin_amdgcn_mfma_f32_32x32x16_bf16(b0,qr[0],negm,0,0,0);p1=__builtin_amdgcn_mfma_f32_32x32x16_bf16(b1,qr[0],negm,0,0,0);}
    else{p0=__builtin_amdgcn_mfma_f32_32x32x16_bf16(b0,qr[d0],p0,0,0,0);p1=__builtin_amdgcn_mfma_f32_32x32x16_bf16(b1,qr[d0],p1,0,0,0);}}
}
typedef __attribute__((address_space(3))) const char* lds_cptr;
typedef short v4i16_t __attribute__((ext_vector_type(4)));
__device__ __forceinline__ void kload8(bf16x8*kf,lds_cptr kp){
  kf[0]=*(const __attribute__((address_space(3))) bf16x8*)(kp);      kf[1]=*(const __attribute__((address_space(3))) bf16x8*)(kp+512);
  kf[2]=*(const __attribute__((address_space(3))) bf16x8*)(kp+2048); kf[3]=*(const __attribute__((address_space(3))) bf16x8*)(kp+2560);
  kf[4]=*(const __attribute__((address_space(3))) bf16x8*)(kp+4096); kf[5]=*(const __attribute__((address_space(3))) bf16x8*)(kp+4608);
  kf[6]=*(const __attribute__((address_space(3))) bf16x8*)(kp+6144); kf[7]=*(const __attribute__((address_space(3))) bf16x8*)(kp+6656);
}
__device__ __forceinline__ void kload2(bf16x8*kf,lds_cptr kp,int j){ kf[2*j]=*(const __attribute__((address_space(3))) bf16x8*)(kp+j*2048); kf[2*j+1]=*(const __attribute__((address_space(3))) bf16x8*)(kp+j*2048+512); }
__device__ __forceinline__ s16x4 vtr(lds_cptr p){ return __builtin_bit_cast(s16x4,__builtin_amdgcn_ds_read_tr16_b64_v4i16((__attribute__((address_space(3))) v4i16_t*)p)); }
__device__ __forceinline__ float rowmax(const f32x16&p0,const f32x16&p1){
  float a=max3f(p0[0],p0[1],p1[0]),b=max3f(p0[2],p0[3],p1[1]);a=max3f(a,p1[2],p1[3]);
  #pragma unroll
  for(int r=4;r<16;r+=4){a=max3f(a,p0[r],p0[r+1]);b=max3f(b,p0[r+2],p0[r+3]);a=max3f(a,p1[r],p1[r+1]);b=max3f(b,p1[r+2],p1[r+3]);}
  const float m=max2f(a,b);
  auto rr=__builtin_amdgcn_permlane32_swap(__float_as_uint(m),__float_as_uint(m),false,false);
  return max2f(__uint_as_float(rr[0]),__uint_as_float(rr[1]));
}
__device__ __forceinline__ void pv(f32x16*o,int vb,bf16x8 pa0,bf16x8 pa1,bf16x8 pa2,bf16x8 pa3){
  #pragma unroll
  for(int d0=0;d0<2;++d0){s16x4 lo[4],hi[4];
    #pragma unroll
    for(int ks=0;ks<4;++ks){
      asm volatile("ds_read_b64_tr_b16 %0,%1 offset:%c2":"=&v"(lo[ks]):"v"(vb),"i"(d0*4096+ks*1024):"memory");
      asm volatile("ds_read_b64_tr_b16 %0,%1 offset:%c2":"=&v"(hi[ks]):"v"(vb),"i"(d0*4096+ks*1024+512):"memory");}
    asm volatile("s_waitcnt lgkmcnt(0)":::"memory");SBAR();
    #define PK(k) (bf16x8){lo[k][0],lo[k][1],lo[k][2],lo[k][3],hi[k][0],hi[k][1],hi[k][2],hi[k][3]}
    o[d0]=__builtin_amdgcn_mfma_f32_32x32x16_bf16(pa0,PK(0),o[d0],0,0,0);
    o[d0]=__builtin_amdgcn_mfma_f32_32x32x16_bf16(pa1,PK(1),o[d0],0,0,0);
    o[d0]=__builtin_amdgcn_mfma_f32_32x32x16_bf16(pa2,PK(2),o[d0],0,0,0);
    o[d0]=__builtin_amdgcn_mfma_f32_32x32x16_bf16(pa3,PK(3),o[d0],0,0,0);
    #undef PK
  }
}

#ifndef ATTN_STORE16
#define ATTN_STORE16(p,v) (*(u32x4*)(p)=(v))
#endif
template<int THRL> __device__ __forceinline__ void attn_unit(int q0,int NT,const bf16*Qh,const bf16*__restrict__ Kh,const bf16*__restrict__ Vh,bf16*Oh,char*shm,const int tid){
  const int lane=tid&63,r32=lane&31,hi=lane>>5; const int wid=__builtin_amdgcn_readfirstlane(tid>>6);
  const bf16*Qw=Qh+(long)(q0+wid*QBLK)*QP;
  const unsigned lds0=(unsigned)(uintptr_t)shm;
  float*wsf=(float*)(shm+LDS_WS)+wid*64;
  const bf16*ksrc=Kh+(long)lane*KP+wid*8;
  const bf16*vsrc=Vh+(long)(16*(wid&3)+(lane>>2))*VP+(wid>>2)*32+(lane&3)*8;
  const unsigned kdst=lds0+LDS_K+wid*1024, vdst=lds0+LDS_V+wid*1024;
  #define DMA_K(t,slot) glds16(ksrc+(long)(t)*KVBLK*KP,(unsigned)__builtin_amdgcn_readfirstlane(kdst+(slot)))
  #define DMA_V(t,slot) glds16(vsrc+(long)(t)*KVBLK*VP,(unsigned)__builtin_amdgcn_readfirstlane(vdst+(slot)))
  const int vb0=(int)(lds0+LDS_V)+((lane>>4)&1)*32+(lane&3)*8+(4*hi+((lane&15)>>2))*64;
  const char*Kbase=shm+LDS_K; bf16x8 kf[8];
  const lds_cptr shm3=(lds_cptr)shm; const lds_cptr kp0=shm3+LDS_K+hi*1024+r32*16; const lds_cptr vp0=shm3+LDS_V+((lane>>4)&1)*32+(lane&3)*8+(4*hi+((lane&15)>>2))*64;
  DMA_K(0,0);DMA_V(0,0);DMA_K(1,SLOTB);
  bf16x8 qr[4];
  #pragma unroll
  for(int d0=0;d0<4;++d0)qr[d0]=*reinterpret_cast<const bf16x8*>(&Qw[(long)r32*QP+d0*16+hi*8]);
  float mhat=0.f,l_reg=0.f;f32x16 o[2];o[0]=f32x16{};o[1]=f32x16{};f32x16 negm=f32x16{};asm volatile("":"+v"(negm));
  #define CMASK(P0,P1,t) do{}while(0)
  bool resc=false;
  #define START(P0,P1) do{ const float rm=rowmax(P0,P1); resc=false; \
    { const float dl=rm; mhat=fadd_s(mhat,dl); \
      _Pragma("unroll") for(int r=0;r<16;++r){P0[r]=fsub_s(P0[r],dl);P1[r]=fsub_s(P1[r],dl);} \
      _Pragma("unroll") for(int r=0;r<16;++r)negm[r]=-mhat; asm volatile("":"+v"(negm)); } \
    _Pragma("unroll") for(int r=0;r<16;++r)P0[r]=__builtin_amdgcn_exp2f(P0[r]); }while(0)
  #define RESC() do{ if(resc){ asm volatile("s_waitcnt lgkmcnt(0)":::"memory"); \
      _Pragma("unroll") for(int d_=0;d_<2;++d_) _Pragma("unroll") for(int r=0;r<16;++r)o[d_][r]*=wsf[crow(r,hi)]; } }while(0)
  f32x16 pA0,pA1,pB0,pB1;
  int sl_prev=0,sl_cur=0,sl_next=SLOTB;
  #define ROT() do{sl_prev=sl_cur;sl_cur=sl_next;sl_next=(sl_next==(NSLOT-1)*SLOTB)?0:sl_next+SLOTB;}while(0)
  DMA_K(2,2*SLOTB);
  WAIT_BAR(3);
  qkt(pA0,pA1,Kbase,qr,negm,r32,hi);asm volatile("s_nop 15\n\ts_nop 7":"+v"(pA0),"+v"(pA1));CMASK(pA0,pA1,0);
  START(pA0,pA1);
  _Pragma("unroll") for(int r=0;r<16;++r)pA1[r]=__builtin_amdgcn_exp2f(pA1[r]);
  WAIT_BAR(0);
  DMA_K(3,0);DMA_V(1,SLOTB);
  ROT();
  kload8(kf,kp0+sl_cur);
  WAIT_BAR(2);
  s16x4 vlo[8],vhi[8]; u32x4 pw0,pw1,pw2,pw3;
  #define PKW(P,B) cvtpk_s(P[B],P[B+1])
  #define PAF(k) __builtin_bit_cast(bf16x8,pw##k)
  #define VFR(i) (bf16x8){vlo[i][0],vlo[i][1],vlo[i][2],vlo[i][3],vhi[i][0],vhi[i][1],vhi[i][2],vhi[i][3]}
  #define PIN(x) asm volatile("":"+v"(x))
  #define MX3(a,b,c) __builtin_fmaxf(__builtin_fmaxf((a),(b)),(c))
  #define GAPA(MF,A0,A1,A2,A3,W0,W1,PW) do{ MF; sacc+=A0; sacc+=A1; sacc+=A2; sacc+=A3; PIN(sacc); W0; W1; PIN(PW); SBAR(); }while(0)
  #define EX(v) __builtin_amdgcn_exp2f(v)
  #define GAPB(MF,X,B) do{ MF; X[B]=EX(X[B]); X[B+1]=EX(X[B+1]); X[B+2]=EX(X[B+2]); X[B+3]=EX(X[B+3]); PIN(X); SBAR(); }while(0)
  #define VRD(i) do{ vlo[i]=vtr(vp_+(((i)>>2)*4096+((i)&3)*1024)); vhi[i]=vtr(vp_+(((i)>>2)*4096+((i)&3)*1024+512)); }while(0)
  #define KRD(G,j) do{ if(G){ kload2(kf,kp0+sl_next,j); SBAR(); } }while(0)
  #define STEP(C0,C1,P0,P1,t,GK,GV,GL) do{ SBAR(); \
    const lds_cptr vp_=vp0+sl_prev; \
    VRD(0); SBAR(); float sacc=(P0[0]+P0[1]); \
    GAPA(C0=__builtin_amdgcn_mfma_f32_32x32x16_bf16(kf[0],qr[0],negm,0,0,0), P0[2],P0[3],P0[4],P0[5],     pw0[0]=PKW(P0,0), pw0[1]=PKW(P0,2), pw0); \
    VRD(4); SBAR(); GAPA(C1=__builtin_amdgcn_mfma_f32_32x32x16_bf16(kf[1],qr[0],negm,0,0,0), P0[6],P0[7],P0[8],P0[9],     pw0[2]=PKW(P0,4), pw0[3]=PKW(P0,6), pw0); \
    VRD(1); SBAR(); GAPA(C0=__builtin_amdgcn_mfma_f32_32x32x16_bf16(kf[2],qr[1],C0,0,0,0),   P0[10],P0[11],P0[12],P0[13], pw1[0]=PKW(P0,8), pw1[1]=PKW(P0,10), pw1); \
    VRD(5); SBAR(); GAPA(C1=__builtin_amdgcn_mfma_f32_32x32x16_bf16(kf[3],qr[1],C1,0,0,0),   P0[14],P0[15],P1[0],P1[1],   pw1[2]=PKW(P0,12),pw1[3]=PKW(P0,14), pw1); \
    VRD(2); SBAR(); GAPA(C0=__builtin_amdgcn_mfma_f32_32x32x16_bf16(kf[4],qr[2],C0,0,0,0),   P1[2],P1[3],P1[4],P1[5],     pw2[0]=PKW(P1,0), pw2[1]=PKW(P1,2), pw2); \
    VRD(6); SBAR(); GAPA(C1=__builtin_amdgcn_mfma_f32_32x32x16_bf16(kf[5],qr[2],C1,0,0,0),   P1[6],P1[7],P1[8],P1[9],     pw2[2]=PKW(P1,4), pw2[3]=PKW(P1,6), pw2); \
    VRD(3); SBAR(); GAPA(C0=__builtin_amdgcn_mfma_f32_32x32x16_bf16(kf[6],qr[3],C0,0,0,0),   P1[10],P1[11],P1[12],P1[13], pw3[0]=PKW(P1,8), pw3[1]=PKW(P1,10), pw3); \
    VRD(7); SBAR(); GAPA(C1=__builtin_amdgcn_mfma_f32_32x32x16_bf16(kf[7],qr[3],C1,0,0,0),   P1[14],P1[15],0.f,0.f,       pw3[2]=PKW(P1,12),pw3[3]=PKW(P1,14), pw3); \
    l_reg+=sacc; \
    if(GK){DMA_K((t)+3,sl_cur);} if(GV){DMA_V((t)+1,sl_next);} \
    CMASK(C0,C1,t); \
    { float a=MX3(C0[0],C0[1],C1[0]),b=MX3(C0[2],C0[3],C1[1]); a=MX3(a,C1[2],C1[3]); \
      _Pragma("unroll") for(int r=4;r<16;r+=4){a=MX3(a,C0[r],C0[r+1]);b=MX3(b,C0[r+2],C0[r+3]);a=MX3(a,C1[r],C1[r+1]);b=MX3(b,C1[r+2],C1[r+3]);} \
      float rm=__builtin_fmaxf(a,b); { auto rr=__builtin_amdgcn_permlane32_swap(__float_as_uint(rm),__float_as_uint(rm),false,false); rm=__builtin_fmaxf(__uint_as_float(rr[0]),__uint_as_float(rr[1])); } \
      resc=false; \
      if(__builtin_expect(__any(rm>(float)THRL),0)){ const float dl=__builtin_fmaxf(rm,0.f); mhat+=dl; \
        _Pragma("unroll") for(int r=0;r<16;++r){C0[r]-=dl;C1[r]-=dl;} \
        _Pragma("unroll") for(int r=0;r<16;++r)negm[r]=-mhat; asm volatile("":"+v"(negm)); \
        const float f=__builtin_amdgcn_exp2f(-dl); l_reg*=f; if(hi==0)wsf[r32]=f; resc=true; } } \
    SBAR(); \
    GAPB(o[0]=__builtin_amdgcn_mfma_f32_32x32x16_bf16(PAF(0),VFR(0),o[0],0,0,0), C0,0); \
    GAPB(o[1]=__builtin_amdgcn_mfma_f32_32x32x16_bf16(PAF(0),VFR(4),o[1],0,0,0), C0,4); \
    KRD(GL,0); GAPB(o[0]=__builtin_amdgcn_mfma_f32_32x32x16_bf16(PAF(1),VFR(1),o[0],0,0,0), C0,8); \
    KRD(GL,1); GAPB(o[1]=__builtin_amdgcn_mfma_f32_32x32x16_bf16(PAF(1),VFR(5),o[1],0,0,0), C0,12); \
    KRD(GL,2); GAPB(o[0]=__builtin_amdgcn_mfma_f32_32x32x16_bf16(PAF(2),VFR(2),o[0],0,0,0), C1,0); \
    KRD(GL,3); GAPB(o[1]=__builtin_amdgcn_mfma_f32_32x32x16_bf16(PAF(2),VFR(6),o[1],0,0,0), C1,4); \
    GAPB(o[0]=__builtin_amdgcn_mfma_f32_32x32x16_bf16(PAF(3),VFR(3),o[0],0,0,0), C1,8); \
    GAPB(o[1]=__builtin_amdgcn_mfma_f32_32x32x16_bf16(PAF(3),VFR(7),o[1],0,0,0), C1,12); \
    }while(0)
  int t=1;
  #undef CMASK
  #define CMASK(P0,P1,t) do{}while(0)
  for(;t+5<NT;t+=2){
    STEP(pB0,pB1,pA0,pA1,t,true,true,true);     WAIT_BAR(2); RESC(); ROT();
    STEP(pA0,pA1,pB0,pB1,t+1,true,true,true);   WAIT_BAR(2); RESC(); ROT();
  }
  #undef CMASK
  #define CMASK(P0,P1,t) do{}while(0)
  #define ENDW(tt) do{ if((tt)+3<NT){WAIT_BAR(2);} else if((tt)+2<NT){WAIT_BAR(1);} else {WAIT_BAR(0);} }while(0)
  for(;t+1<NT;t+=2){
    STEP(pB0,pB1,pA0,pA1,t,(t+3<NT),(t+1<NT),(t+1<NT));       ENDW(t);   RESC(); ROT();
    STEP(pA0,pA1,pB0,pB1,t+1,(t+4<NT),(t+2<NT),(t+2<NT));     ENDW(t+1); RESC(); ROT();
  }
  STEP(pB0,pB1,pA0,pA1,NT-1,false,false,false); RESC();
  { float sacc=pB0[0]+pB0[1]; _Pragma("unroll") for(int r=2;r<16;++r)sacc+=pB0[r]; _Pragma("unroll") for(int r=0;r<16;++r)sacc+=pB1[r]; l_reg+=sacc;
    pw0=(u32x4){PKW(pB0,0),PKW(pB0,2),PKW(pB0,4),PKW(pB0,6)};pw1=(u32x4){PKW(pB0,8),PKW(pB0,10),PKW(pB0,12),PKW(pB0,14)};pw2=(u32x4){PKW(pB1,0),PKW(pB1,2),PKW(pB1,4),PKW(pB1,6)};pw3=(u32x4){PKW(pB1,8),PKW(pB1,10),PKW(pB1,12),PKW(pB1,14)};
    SBAR(); pv(o,vb0+sl_cur,PAF(0),PAF(1),PAF(2),PAF(3)); }
  #undef PKW
  #undef PAF
  #undef VFR
  #undef PIN
  #undef MX3
  #undef GAPA
  #undef GAPB
  #undef EX
  #undef VRD
  #undef KRD
  #undef STEP
  #undef ENDW
  {float la_=l_reg,lb_=l_reg;asm volatile("s_nop 1\n\tv_permlane32_swap_b32 %0, %1\n\ts_nop 1":"+v"(la_),"+v"(lb_));l_reg=la_+lb_;}
  if(hi==0)wsf[32+r32]=l_reg;asm volatile("s_waitcnt lgkmcnt(0)":::"memory");
  float rli[16];
  #pragma unroll
  for(int r=0;r<16;++r)rli[r]=__builtin_amdgcn_rcpf(wsf[32+crow(r,hi)]);
  bf16*Ow=Oh+(long)(q0+wid*QBLK)*OP;
  { bf16*stg=(bf16*)(shm+LDS_OST)+wid*2048;
    #pragma unroll
    for(int r=0;r<16;++r){const int orow=crow(r,hi);
      #pragma unroll
      for(int d0=0;d0<2;++d0)stg[orow*64+d0*32+r32]=__float2bfloat16(o[d0][r]*rli[r]);}
    asm volatile("s_waitcnt lgkmcnt(0)":::"memory");
    #pragma unroll
#ifdef OUTPROJ_FP8
    #define SATF(x) __builtin_amdgcn_fmed3f((x),-448.0f,448.0f)
    for(int i=0;i<4;++i){const int row=i*8+(lane>>3),ch=lane&7; const u32x4 v=*(const u32x4*)(stg+row*64+ch*8);
      const unsigned vs[4]={v.x,v.y,v.z,v.w}; unsigned o8[2];
      #pragma unroll
      for(int j=0;j<2;++j){int wq=0; wq=__builtin_amdgcn_cvt_pk_fp8_f32(SATF(__builtin_bit_cast(float,vs[2*j]<<16)*4.0f),SATF(__builtin_bit_cast(float,vs[2*j]&0xffff0000u)*4.0f),wq,false);
        wq=__builtin_amdgcn_cvt_pk_fp8_f32(SATF(__builtin_bit_cast(float,vs[2*j+1]<<16)*4.0f),SATF(__builtin_bit_cast(float,vs[2*j+1]&0xffff0000u)*4.0f),wq,true); o8[j]=(unsigned)wq;}
      typedef unsigned u32x2_ __attribute__((ext_vector_type(2)));
      { const int rl=q0+wid*QBLK+row; *(u32x2_*)((unsigned char*)Oh+(long)(rl>>1)*(2*OP)+(rl&1)*64+ch*8)=(u32x2_){o8[0],o8[1]}; } } }
    #undef SATF
#else
    for(int i=0;i<4;++i){const int row=i*8+(lane>>3),ch=lane&7; const u32x4 v=*(const u32x4*)(stg+row*64+ch*8); ATTN_STORE16(Ow+(long)row*OP+ch*8,v);} }
#endif
  asm volatile("s_waitcnt lgkmcnt(0)\n\ts_barrier":::"memory");
  #undef DMA_K
  #undef DMA_V
  #undef CMASK
  #undef START
  #undef RESC
  #undef ROT
}
constexpr int ATTN_LDS_BYTES=LDS_BYTES;
#undef SBAR
#undef WAIT_BAR
}
constexpr int NWAVES = 8, NTHR = 512;
constexpr int NB = 16, T_LAT = 2048, L_CTX = 256, DM = 1024, RPB = T_LAT + L_CTX  , MROWS = NB * RPB  , NPROJ = 3584, DEPTH = 2;
constexpr int NPANEL = MROWS / 256  , PPB = RPB / 256  ;
constexpr float NORM_EPS = 1e-6f;
constexpr int C_HQ = 0, C_HI = 256, C_HZ = 512  , C_HG = 1024, C_CB = 1280, C_CC = 1536, C_CH = 1792, C_RQ = 2048, C_RK = 2304, C_RV = 2560, C_RG = 2816, C_AQ = 3072, C_AK = 3328, C_AV = 3456;
constexpr size_t MiB = 1u << 20;
constexpr size_t WS_CTL = 0, CTL_ZERO_BYTES = 1 * MiB;
constexpr size_t WS_MOD = 1 * MiB;
constexpr size_t WS_ROPE = 2 * MiB;
constexpr size_t WS_ROUTE = 3 * MiB;
constexpr size_t WS_ROWINFO = 4 * MiB;
constexpr size_t WS_BCNT = 5 * MiB;
constexpr size_t WS_TILEINFO = 6 * MiB;
constexpr size_t WS_DBUF = 7 * MiB;
constexpr size_t WS_W0 = 12 * MiB, WLAYER = 33 * MiB;
constexpr size_t WO_WIN = 0;
constexpr size_t WO_WOUT = 7 * MiB;
constexpr size_t WO_WGU = 9 * MiB;
constexpr size_t WO_WD = 25 * MiB;
constexpr size_t WS_CTX = 78 * MiB;
constexpr size_t WS_ACT = 94 * MiB;
constexpr size_t WS_P = 166 * MiB;
constexpr size_t WS_ASORT = WS_P;
constexpr size_t WS_H = WS_P + 84 * MiB;
constexpr size_t WS_KVS = 418 * MiB;
constexpr size_t WS_END = 490 * MiB;
constexpr int MAXTILES = 168;
constexpr int CW_ERR = 16;
constexpr int CW_BAR = 4096;
constexpr int CW_BAR3 = 12288, CW_BAR4 = 16384, CW_BAR5 = 20480;
constexpr int CW_BAR2 = 8192;
constexpr int RING_OFF = 0, RING_BYTES = 139264;
constexpr int LDSCTL_OFF = RING_BYTES, MISC_OFF = LDSCTL_OFF + 320;
constexpr int PTAB_OFF = LDSCTL_OFF + 512;
constexpr int TAB_OFF = LDSCTL_OFF + 1024;
constexpr int LDS_BYTES = 147456;

#define GAS __attribute__((address_space(1)))
#define LAS __attribute__((address_space(3)))
typedef unsigned short bf16;
typedef unsigned v4u __attribute__((ext_vector_type(4)));
typedef unsigned v2u __attribute__((ext_vector_type(2)));
typedef int v4i __attribute__((ext_vector_type(4)));
typedef float f32x4 __attribute__((ext_vector_type(4)));
typedef GAS unsigned gu32;
#define RLX_AGENT __ATOMIC_RELAXED, __HIP_MEMORY_SCOPE_AGENT
#define LDS_WAIT() asm volatile("s_waitcnt lgkmcnt(0)" ::: "memory")
#define VM_WAIT() asm volatile("s_waitcnt vmcnt(0)" ::: "memory")
typedef float pkf32x2_t __attribute__((ext_vector_type(2))); typedef __bf16 pkbf16x2_t __attribute__((ext_vector_type(2)));
__device__ __forceinline__ unsigned pk2(float lo, float hi) { const pkf32x2_t v = {lo, hi}; return __builtin_bit_cast(unsigned, __builtin_convertvector(v, pkbf16x2_t)); }
__device__ __forceinline__ unsigned f2bf(float f) { return pk2(f, 0.f) & 0xffffu; }
__device__ __forceinline__ float bflo(unsigned w) { return __builtin_bit_cast(float, w << 16); }
__device__ __forceinline__ float bfhi(unsigned w) { return __builtin_bit_cast(float, w & 0xffff0000u); }
__device__ __forceinline__ float bf1(bf16 h) { return __builtin_bit_cast(float, (unsigned)h << 16); }
__device__ __forceinline__ unsigned pk4_fp8(float a, float b, float c, float d) { int w = 0; a = __builtin_amdgcn_fmed3f(a, -448.0f, 448.0f); b = __builtin_amdgcn_fmed3f(b, -448.0f, 448.0f); c = __builtin_amdgcn_fmed3f(c, -448.0f, 448.0f); d = __builtin_amdgcn_fmed3f(d, -448.0f, 448.0f);     w = __builtin_amdgcn_cvt_pk_fp8_f32(a, b, w, false); w = __builtin_amdgcn_cvt_pk_fp8_f32(c, d, w, true); return (unsigned)w; }
__device__ __forceinline__ float fp8_dec(unsigned b) { const unsigned s = b >> 7, e = (b >> 3) & 15u, m = b & 7u; const float v = e ? (float)(8u + m) * exp2f((float)e - 10.0f) : (float)m * 0.001953125f; return s ? -v : v; }
__device__ __forceinline__ float siluf(float x) { return x * __builtin_amdgcn_rcpf(1.0f + __expf(-x)); }
__device__ __forceinline__ float sigmf(float x) { return __builtin_amdgcn_rcpf(1.0f + __expf(-x)); }
template <int K> __device__ __forceinline__ float xshf(float v) { static_assert(K >= 1 && K < 32, "xshf"); return __builtin_bit_cast(float, __builtin_amdgcn_ds_swizzle(__builtin_bit_cast(int, v), (K << 10) | 0x1f)); }
template <int K> __device__ __forceinline__ int xshi(int v) { static_assert(K >= 1 && K < 32, "xshi"); return __builtin_amdgcn_ds_swizzle(v, (K << 10) | 0x1f); }
__device__ __forceinline__ void half_swap(float& a, float& b) { asm volatile("s_nop 1\n\tv_permlane32_swap_b32 %0, %1\n\ts_nop 1" : "+v"(a), "+v"(b)); }
__device__ __forceinline__ float half_sum(float v) { float a = v, b = v; half_swap(a, b); return a + b; }
__device__ __forceinline__ float half_max(float v) { float a = v, b = v; half_swap(a, b); return fmaxf(a, b); }
__device__ __forceinline__ float sum16(float v) { v += xshf<1>(v); v += xshf<2>(v); v += xshf<4>(v); v += xshf<8>(v); return v; }
__device__ __forceinline__ float sum32(float v) { v = sum16(v); v += xshf<16>(v); return v; }
__device__ __forceinline__ float wave_sum(float v) { return half_sum(sum32(v)); }
#define XB_TMO      128
#define XB_XCNT(j)  (256  + 64 * (j))
#define XB_XSUB(j)  (1280 + 64 * (j))
#define XB_XGEN(j)  (2304 + 64 * (j))
#define XB_TOP      3328
#define XB_TOPGEN   3392
#define XCD_BAR_WORDS 3456
#define XB_SPIN_CAP (1u << 18)

__device__ __forceinline__ unsigned xb_ld(unsigned* p)              { return __hip_atomic_load(p, __ATOMIC_RELAXED, __HIP_MEMORY_SCOPE_AGENT); }
__device__ __forceinline__ unsigned xb_add(unsigned* p, unsigned v) { return __hip_atomic_fetch_add(p, v, __ATOMIC_RELAXED, __HIP_MEMORY_SCOPE_AGENT); }
__device__ __forceinline__ unsigned xb_xcc_id() { return (unsigned)__builtin_amdgcn_s_getreg((3 << 11) | 20) & 0xFu; }
#define XB_SPIN(cond, bar) do { unsigned _sp = 0; while (cond) { __builtin_amdgcn_s_sleep(1); \
    if ((++_sp & 255u) == 0u) { if (xb_ld(&(bar)[XB_TMO])) break; if (_sp > XB_SPIN_CAP) { atomicAdd(&(bar)[XB_TMO], 1u); break; } } } } while (0)

struct XcdBarrier {
    unsigned* bar; unsigned x;
    volatile LAS unsigned* st;
};

__device__ __forceinline__ XcdBarrier xcd_barrier_post(unsigned* bar, volatile LAS unsigned* st) {
    XcdBarrier b; b.bar = bar; b.x = xb_xcc_id(); b.st = st;
    if (threadIdx.x == 0) (void)xb_add(&bar[XB_XCNT(b.x)], 1u);
    return b;
}
__device__ __forceinline__ void xcd_barrier_complete(unsigned* bar, unsigned x, unsigned& nloc, unsigned& nx) {
    const unsigned G = gridDim.x * gridDim.y * gridDim.z;
    unsigned sum, cnt, mine, sp = 0u;
    for (;;) {
        sum = 0u; cnt = 0u; mine = 0u;
#pragma unroll
        for (unsigned j = 0; j < 16; ++j) { const unsigned c = xb_ld(&bar[XB_XCNT(j)]); sum += c; cnt += (c > 0u) ? 1u : 0u; mine = (j == x) ? c : mine; }
        if (sum == G) break;
        __builtin_amdgcn_s_sleep(1);
        if ((++sp & 255u) == 0u) { if (xb_ld(&bar[XB_TMO])) break; if (sp > XB_SPIN_CAP) { atomicAdd(&bar[XB_TMO], 1u); break; } }
    }
    nloc = mine > 0u ? mine : 1u; nx = cnt > 0u ? cnt : 1u;
}

__device__ __forceinline__ void xcd_barrier(const XcdBarrier& b) {
    asm volatile("s_waitcnt vmcnt(0)" ::: "memory");
    __syncthreads();
    if (threadIdx.x == 0) {
        unsigned* bar = b.bar; asm volatile("" : "+s"(bar));
        __builtin_amdgcn_s_waitcnt(0);
        unsigned nloc = b.st[0], nx = b.st[1];
        if (nloc == 0u) { xcd_barrier_complete(bar, b.x, nloc, nx); b.st[0] = nloc; b.st[1] = nx; }
#ifdef EARLY_WB
        __builtin_amdgcn_fence(__ATOMIC_RELEASE, "agent"); asm volatile("s_waitcnt vmcnt(0)" ::: "memory");
#endif
        const unsigned old = xb_add(&bar[XB_XSUB(b.x)], 1u);
        const unsigned gen = old / nloc;
#ifdef MID_WB
        if (old + 1u - gen * nloc == MID_WB_AT(nloc)) asm volatile("buffer_wbl2 sc1" ::: "memory");
#endif
        if (old + 1u == (gen + 1u) * nloc) {
            __builtin_amdgcn_fence(__ATOMIC_RELEASE, "agent");
            asm volatile("s_waitcnt vmcnt(0)" ::: "memory");
#if defined(TOP_DIRECT) && defined(EARLY_INV)
            (void)xb_add(&bar[XB_TOP], 1u);
            asm volatile("buffer_inv sc1" ::: "memory");
            { const unsigned target = (gen + 1u) * nx; XB_SPIN(xb_ld(&bar[XB_TOP]) < target, bar); }
            asm volatile("" ::: "memory");
#else
            const unsigned og = xb_add(&bar[XB_TOP], 1u);
            const unsigned tg = og / nx;
#ifdef EARLY_INV
            asm volatile("buffer_inv sc1" ::: "memory");
            if (og + 1u == (tg + 1u) * nx) xb_add(&bar[XB_TOPGEN], 1u);
            else XB_SPIN(xb_ld(&bar[XB_TOPGEN]) == tg, bar);
            asm volatile("" ::: "memory");
#else
            if (og + 1u == (tg + 1u) * nx) xb_add(&bar[XB_TOPGEN], 1u);
            else XB_SPIN(xb_ld(&bar[XB_TOPGEN]) == tg, bar);
            __builtin_amdgcn_fence(__ATOMIC_ACQUIRE, "agent");
#endif
#endif
            xb_add(&bar[XB_XGEN(b.x)], 1u);
            asm volatile("s_waitcnt vmcnt(0)" ::: "memory");
        } else {
#ifdef EARLY_INV
            asm volatile("buffer_inv sc1" ::: "memory");
            XB_SPIN(xb_ld(&bar[XB_XGEN(b.x)]) == gen, bar);
            asm volatile("" ::: "memory");
#else
            XB_SPIN(xb_ld(&bar[XB_XGEN(b.x)]) == gen, bar);
            __builtin_amdgcn_fence(__ATOMIC_ACQUIRE, "agent");
#endif
            asm volatile("s_waitcnt vmcnt(0)" ::: "memory");
        }
    }
    __syncthreads();
}

__device__ __forceinline__ void xcd_split_arrive(const XcdBarrier& b, unsigned* bar2) {
    asm volatile("s_waitcnt vmcnt(0)" ::: "memory");
    __syncthreads();
    if (threadIdx.x == 0) {
        unsigned* bar = bar2; asm volatile("" : "+s"(bar));
        __builtin_amdgcn_s_waitcnt(0);
        unsigned nloc = b.st[0], nx = b.st[1];
        if (nloc == 0u) { xcd_barrier_complete(b.bar, b.x, nloc, nx); b.st[0] = nloc; b.st[1] = nx; }
        const unsigned old = xb_add(&bar[XB_XSUB(b.x)], 1u);
        if ((old + 1u) % nloc == 0u) {
            __builtin_amdgcn_fence(__ATOMIC_RELEASE, "agent");
            asm volatile("s_waitcnt vmcnt(0)" ::: "memory");
#ifdef TOP_DIRECT
            (void)xb_add(&bar[XB_TOP], 1u);
#else
            const unsigned og = xb_add(&bar[XB_TOP], 1u);
            if ((og + 1u) % nx == 0u) xb_add(&bar[XB_TOPGEN], 1u);
#endif
        }
    }
}
__device__ __forceinline__ void xcd_split_wait(const XcdBarrier& b, unsigned* bar2, unsigned target) {
    if (threadIdx.x == 0) {
        unsigned* bar = bar2; asm volatile("" : "+s"(bar));
#ifdef TOP_DIRECT
        { const unsigned nx_ = b.st[1]; XB_SPIN(xb_ld(&bar[XB_TOP]) < target * nx_, bar); }
#else
        XB_SPIN(xb_ld(&bar[XB_TOPGEN]) < target, bar);
#endif
        __builtin_amdgcn_fence(__ATOMIC_ACQUIRE, "agent");
        asm volatile("s_waitcnt vmcnt(0)" ::: "memory");
    }
    __syncthreads();
}
struct Args { const float* in[24]; float* out; unsigned char* ws; size_t ws_shift; };
enum { I_X = 0, I_C, I_CTX, I_CCTX, I_ADAW, I_ADAB, I_NMIX, I_NFFN, I_WIN, I_LB, I_HNORM, I_CONVW, I_RDEC, I_RNORM, I_QN, I_KN, I_WOUT, I_RGW, I_RGB, I_REW, I_REB, I_EG, I_EU, I_ED };
struct Frame {
    LAS unsigned char* lds;
    volatile LAS unsigned* MISC;
    gu32* ctl;
    int tid, lane, wave, vcu, G;
    unsigned bart;
};
__device__ __forceinline__ const void* lptr(const Frame& F, int i) {
    const volatile LAS unsigned* t = (const volatile LAS unsigned*)(F.lds + PTAB_OFF) + 2 * i;
    const unsigned lo = __builtin_amdgcn_readfirstlane(t[0]), hi = __builtin_amdgcn_readfirstlane(t[1]);
    return (const void*)(const GAS void*)(((unsigned long long)hi << 32) | lo);
}
#define PIN(i) ((const float*)lptr(F, (i)))
#define POUT ((float*)lptr(F, 24))
#define PWS ((unsigned char*)lptr(F, 25))
__device__ __forceinline__ int row_of_latent(int idx) { return (idx >> 11) * RPB + L_CTX + (idx & 2047); }

__device__ __forceinline__ void transpose_item(const float* W, int N, int k0, int n0, bf16* dst, int DP, LAS float* scr, int lane) {
#pragma unroll
    for (int i = 0; i < 8; ++i) { const int kk = 8 * i + (lane >> 3), nc = 4 * (lane & 7); const f32x4 v = *(const f32x4*)(W + (size_t)(k0 + kk) * N + n0 + nc);
        scr[kk * 33 + nc] = v.x; scr[kk * 33 + nc + 1] = v.y; scr[kk * 33 + nc + 2] = v.z; scr[kk * 33 + nc + 3] = v.w; }
    LDS_WAIT(); asm volatile("" ::: "memory");
    const int c = lane & 7;
#pragma unroll
    for (int j = 0; j < 4; ++j) { const int n = (lane >> 3) + 8 * j; const LAS float* s = scr + (8 * c) * 33 + n;
        v4u o; o.x = pk2(s[0 * 33], s[1 * 33]); o.y = pk2(s[2 * 33], s[3 * 33]); o.z = pk2(s[4 * 33], s[5 * 33]); o.w = pk2(s[6 * 33], s[7 * 33]);
        *(GAS v4u*)(dst + (size_t)n * DP + 8 * c) = o; }
    LDS_WAIT(); asm volatile("" ::: "memory");
}
__device__ __forceinline__ void transpose_item8(const float* W, int N, int k0, int n0, unsigned char* dst, int DP, float scale, LAS float* scr, int lane) {
#pragma unroll
    for (int i = 0; i < 8; ++i) { const int kk = 8 * i + (lane >> 3), nc = 4 * (lane & 7); const f32x4 v = *(const f32x4*)(W + (size_t)(k0 + kk) * N + n0 + nc) * scale;
        scr[kk * 33 + nc] = v.x; scr[kk * 33 + nc + 1] = v.y; scr[kk * 33 + nc + 2] = v.z; scr[kk * 33 + nc + 3] = v.w; }
    LDS_WAIT(); asm volatile("" ::: "memory");
    const int c = lane & 7;
#pragma unroll
    for (int j = 0; j < 4; ++j) { const int n = (lane >> 3) + 8 * j; const LAS float* s = scr + (8 * c) * 33 + n;
        v2u o; o.x = pk4_fp8(s[0 * 33], s[1 * 33], s[2 * 33], s[3 * 33]); o.y = pk4_fp8(s[4 * 33], s[5 * 33], s[6 * 33], s[7 * 33]);
        *(GAS v2u*)(dst + (size_t)n * DP + 8 * c) = o; }
    LDS_WAIT(); asm volatile("" ::: "memory");
}
struct WItem { const float* src; unsigned char* dst; int N, DP, f8, emu; };
__device__ __forceinline__ WItem witem_decode(const Frame& F, int it) {
    constexpr int PER_LAYER = 1792 + 512 + 3 * 4096;
    const int l = it / PER_LAYER; int r = it - l * PER_LAYER; unsigned char* ws = PWS + WS_W0 + (size_t)l * WLAYER; WItem w; w.emu = 0;
    if (r < 1792) { const int kb = r / 112, nb = r % 112; w.src = PIN(I_WIN) + (size_t)l * 1024 * NPROJ + (size_t)kb * 64 * NPROJ + nb * 32; w.N = NPROJ; w.emu = (EMU_TILES >> (nb >> 3)) & 1;
        if ((INPROJ_F8MASK >> (nb >> 3)) & 1) { w.dst = ws + WO_WIN + (size_t)(nb >> 3) * 524288 + (size_t)((nb & 7) * 32) * 1024 + kb * 64; w.DP = 1024; w.f8 = 1; return w; }
        w.dst = ws + WO_WIN + ((size_t)nb * 32 * 1024 + kb * 64) * 2; w.DP = 2048; w.f8 = 0; return w; }
    r -= 1792;
    if (r < 512) { const int kb = r / 32, nb = r % 32; w.src = PIN(I_WOUT) + (size_t)l * 1024 * 1024 + (size_t)kb * 64 * 1024 + nb * 32; w.N = 1024;
#ifdef OUTPROJ_FP8
        w.dst = ws + WO_WOUT + ((size_t)nb * 32 * 1024 + kb * 64); w.DP = 1024; w.f8 = 1; return w; }
#else
        w.dst = ws + WO_WOUT + ((size_t)nb * 32 * 1024 + kb * 64) * 2; w.DP = 2048; w.f8 = 0; return w; }
#endif
    r -= 512;
    if (r < 8192) { const int up = r >= 4096; r -= up * 4096; const int e = r >> 8, rr = r & 255, kb = rr >> 4, nb = rr & 15, n0 = nb * 32;
        const int drow = e * 1024 + (n0 >> 7) * 256 + up * 128 + (n0 & 127);
        w.src = (up ? PIN(I_EU) : PIN(I_EG)) + (size_t)(l * 16 + e) * 1024 * 512 + (size_t)kb * 64 * 512 + n0; w.N = 512; w.dst = ws + WO_WGU + (size_t)drow * 1024 + kb * 64; w.DP = 1024; w.f8 = 1; return w; }
    r -= 8192;
    { const int e = r >> 8, rr = r & 255, kb = rr >> 5, nb = rr & 31, g = e >> 2, el = e & 3;
        w.src = PIN(I_ED) + (size_t)(l * 16 + e) * 512 * 1024 + (size_t)kb * 64 * 1024 + nb * 32; w.N = 1024; w.dst = ws + WO_WD + ((size_t)g * 1024 + nb * 32) * 2048 + el * 512 + kb * 64; w.DP = 2048; w.f8 = 1; return w; }
}
__device__ __forceinline__ void convert_weights_range(Frame& F, int it0, int it1, int gw, int NGW) {
    LAS float* scr = (LAS float*)(F.lds + F.wave * 16384);
    const int lane = F.lane; const int NITEMS = it1;
    if (gw < 0 || it0 + gw >= NITEMS) return;
    gw += it0;
    const int kr = lane >> 3, nc = 4 * (lane & 7);
    WItem cur = witem_decode(F, gw); f32x4 v[8], vn[8];
#pragma unroll
    for (int i = 0; i < 8; ++i) v[i] = LDNT((const f32x4*)(cur.src + (size_t)(8 * i + kr) * cur.N + nc));
    for (int it = gw; it < NITEMS; it += NGW) {
        const int itn = it + NGW; const bool more = itn < NITEMS; WItem nxt = cur;
        if (more) { nxt = witem_decode(F, itn);
#pragma unroll
            for (int i = 0; i < 8; ++i) vn[i] = LDNT((const f32x4*)(nxt.src + (size_t)(8 * i + kr) * nxt.N + nc)); }
        const float sc = cur.f8 ? 32.0f : 1.0f;
#pragma unroll
        for (int i = 0; i < 8; ++i) { const int kk = 8 * i + kr; const f32x4 x = v[i] * sc; scr[kk * 33 + nc] = x.x; scr[kk * 33 + nc + 1] = x.y; scr[kk * 33 + nc + 2] = x.z; scr[kk * 33 + nc + 3] = x.w; }
        LDS_WAIT(); asm volatile("" ::: "memory");
        const int c = lane & 7;
#pragma unroll
        for (int j = 0; j < 4; ++j) { const int n = (lane >> 3) + 8 * j; const LAS float* s = scr + (8 * c) * 33 + n;
            if (cur.f8) { v2u o; o.x = pk4_fp8(s[0 * 33], s[1 * 33], s[2 * 33], s[3 * 33]); o.y = pk4_fp8(s[4 * 33], s[5 * 33], s[6 * 33], s[7 * 33]); *(GAS v2u*)(cur.dst + (size_t)n * cur.DP + 8 * c) = o; }
            else { float e[8];
#pragma unroll
                for (int q = 0; q < 8; ++q) { e[q] = s[q * 33]; if (cur.emu) { const int pq = __builtin_amdgcn_cvt_pk_fp8_f32(e[q] * 32.0f, 0.0f, 0, false); e[q] = __builtin_amdgcn_cvt_f32_fp8(pq, 0) * (1.0f / 32.0f); } }
                v4u o; o.x = pk2(e[0], e[1]); o.y = pk2(e[2], e[3]); o.z = pk2(e[4], e[5]); o.w = pk2(e[6], e[7]); *(GAS v4u*)(cur.dst + (size_t)n * cur.DP + 16 * c) = o; } }
        LDS_WAIT(); asm volatile("" ::: "memory");
        if (more) { cur = nxt;
#pragma unroll
            for (int i = 0; i < 8; ++i) v[i] = vn[i]; }
    }
}

__device__ __forceinline__ void p0_prologue(Frame& F, const XcdBarrier& gbar) {
    unsigned char* ws = PWS;
    {
        LAS float* sc = (LAS float*)(F.lds);
        LAS float* red = (LAS float*)(F.lds + 17 * 4096);
        bool staged = false;
        const float* pC = PIN(I_C); const float* pCC = PIN(I_CCTX); const float* pAW = PIN(I_ADAW); const float* pAB = PIN(I_ADAB); const float* pNM = PIN(I_NMIX); const float* pNF = PIN(I_NFFN);
#ifdef MOD_WIDE
        typedef float f32x3 __attribute__((ext_vector_type(3)));
        for (int it = F.vcu; it < DEPTH * 128; it += F.G) {
            if (!staged) {
                for (int i = F.tid; i < 17 * 1024; i += NTHR) { const float v = (i < 16 * 1024) ? pC[i] : pCC[i - 16 * 1024]; sc[i] = siluf(v); }
                staged = true;
            }
            __syncthreads();
            const int l = it >> 7, cb = it & 127, n0 = cb * 48, nn = F.tid & 15, ks = F.tid >> 4;
            const float* W = pAW + (size_t)l * 1024 * 6144 + n0 + 3 * nn;
            f32x3 acc[17];
#pragma unroll
            for (int m = 0; m < 17; ++m) acc[m] = (f32x3){0.f, 0.f, 0.f};
            for (int k = ks * 32; k < ks * 32 + 32; k += 4) {
                const f32x3 w0 = *(const f32x3*)(W + (size_t)k * 6144), w1 = *(const f32x3*)(W + (size_t)(k + 1) * 6144), w2 = *(const f32x3*)(W + (size_t)(k + 2) * 6144), w3 = *(const f32x3*)(W + (size_t)(k + 3) * 6144);
#pragma unroll
                for (int m = 0; m < 17; ++m) { const f32x4 s4 = *(const LAS f32x4*)(sc + m * 1024 + k); acc[m] += (w0 * s4.x + w1 * s4.y) + (w2 * s4.z + w3 * s4.w); } }
#pragma unroll
            for (int m = 0; m < 17; ++m) { float a = acc[m].x, b = acc[m].y, c3 = acc[m].z; a += xshf<16>(a); b += xshf<16>(b); c3 += xshf<16>(c3); acc[m] = (f32x3){half_sum(a), half_sum(b), half_sum(c3)}; }
            if (F.lane < 16) {
#pragma unroll
                for (int m = 0; m < 17; ++m) { LAS float* rp = red + (F.wave * 17 + m) * 48 + 3 * nn; rp[0] = acc[m].x; rp[1] = acc[m].y; rp[2] = acc[m].z; } }
            __syncthreads();
            for (int i = F.tid; i < 17 * 48; i += NTHR) { const int m = i / 48, n2 = i - m * 48, gcol = n0 + n2; float v = pAB[l * 6144 + gcol];
#pragma unroll
                for (int k2 = 0; k2 < 8; ++k2) v += red[(k2 * 17 + m) * 48 + n2];
                const int kch = gcol >> 10, col = gcol & 1023;
                if (kch == 1) v = pNM[l * 1024 + col] * (1.0f + v);
                if (kch == 4) v = pNF[l * 1024 + col] * (1.0f + v);
                ((float*)(ws + WS_MOD) + (size_t)(l * 6 + kch) * 17 * 1024)[m * 1024 + col] = v; }
        }
#else
        for (int it = F.vcu; it < DEPTH * 192; it += F.G) {
            if (!staged) {
                for (int i = F.tid; i < 17 * 1024; i += NTHR) { const float v = (i < 16 * 1024) ? pC[i] : pCC[i - 16 * 1024]; sc[i] = siluf(v); }
                staged = true;
            }
            __syncthreads();
            const int l = it / 192, cb = it % 192, n0 = cb * 32, nn = F.tid & 31, ks = F.tid >> 5;
            const float* W = pAW + (size_t)l * 1024 * 6144 + n0 + nn;
            float acc[17];
#pragma unroll
            for (int m = 0; m < 17; ++m) acc[m] = 0.f;
            for (int k = ks * 64; k < ks * 64 + 64; k += 4) { const float w0 = W[(size_t)k * 6144], w1 = W[(size_t)(k + 1) * 6144], w2 = W[(size_t)(k + 2) * 6144], w3 = W[(size_t)(k + 3) * 6144];
#pragma unroll
                for (int m = 0; m < 17; ++m) { const f32x4 s4 = *(const LAS f32x4*)(sc + m * 1024 + k); acc[m] += (s4.x * w0 + s4.y * w1) + (s4.z * w2 + s4.w * w3); } }
#pragma unroll
            for (int m = 0; m < 17; ++m) red[(ks * 17 + m) * 32 + nn] = acc[m];
            __syncthreads();
            const int kch = n0 >> 10, cc = n0 & 1023;
            float* MOD = (float*)(ws + WS_MOD) + (size_t)(l * 6 + kch) * 17 * 1024;
            for (int i = F.tid; i < 17 * 32; i += NTHR) { const int m = i >> 5, n2 = i & 31; float v = pAB[l * 6144 + n0 + n2];
#pragma unroll
                for (int k2 = 0; k2 < 16; ++k2) v += red[(k2 * 17 + m) * 32 + n2];
                const int col = cc + n2;
                if (kch == 1) v = pNM[l * 1024 + col] * (1.0f + v);
                if (kch == 4) v = pNF[l * 1024 + col] * (1.0f + v);
                MOD[m * 1024 + col] = v; }
        }
#endif
        __syncthreads();
    }
#ifdef SPLIT_PRO
    xcd_split_arrive(gbar, (unsigned*)(F.ctl + CW_BAR3));
#endif
    {
        float* RC = (float*)(ws + WS_ROPE); float* RS = RC + 2048 * 32;
        for (int i = (F.vcu * NTHR + F.tid); i < 2048 * 32; i += F.G * NTHR) { const int t = i >> 5, f = i & 31; const float pos = (float)((f < 16) ? (t >> 6) : (t & 63));
            const float invf = exp2f(-(float)(f & 15) * (13.287712379549449f / 16.0f)); const float ang = pos * invf; RC[i] = cosf(ang); RS[i] = sinf(ang); }
    }
    __syncthreads();
    convert_weights_range(F, 0, 1792 + 512 + 3 * 4096, F.vcu * NWAVES + F.wave, F.G * NWAVES);
    __syncthreads();
}
__device__ __forceinline__ void phase_norm1(Frame& F, const float* xsrc, const float* csrc, const float* nA, const float* nB, bf16* dst, unsigned char* dst8) {
    const int gw = F.vcu * NWAVES + F.wave, NGW = F.G * NWAVES, RPW = (MROWS + NGW - 1) / NGW;
    const int c0 = 8 * F.lane;
    int curm = -1; f32x4 a[4], bb[4];
#ifdef N1_INTERLEAVE
    (void)RPW; for (int r = gw; r < MROWS; r += NGW) {
#else
    for (int r = gw * RPW; r < (gw + 1) * RPW && r < MROWS; ++r) {
#endif
        const int b = r / RPB, j = r - b * RPB, m = (j < L_CTX) ? 16 : b;
        const float* src = (j < L_CTX) ? csrc + (size_t)(b * L_CTX + j) * DM : xsrc + (size_t)(b * T_LAT + j - L_CTX) * DM;
        if (m != curm) { curm = m;
#pragma unroll
            for (int q = 0; q < 4; ++q) { a[q] = *(const f32x4*)(nA + m * 1024 + c0 + 512 * (q >> 1) + 4 * (q & 1)); bb[q] = *(const f32x4*)(nB + m * 1024 + c0 + 512 * (q >> 1) + 4 * (q & 1)); } }
        f32x4 v[4]; float ss = 0.f;
#pragma unroll
        for (int q = 0; q < 4; ++q) { v[q] = LDNT((const f32x4*)(src + c0 + 512 * (q >> 1) + 4 * (q & 1))); ss += (v[q].x * v[q].x + v[q].y * v[q].y) + (v[q].z * v[q].z + v[q].w * v[q].w); }
        const float rstd = __builtin_amdgcn_rsqf(wave_sum(ss) * (1.0f / DM) + NORM_EPS);
#pragma unroll
        for (int q = 0; q < 2; ++q) { const f32x4 o0 = v[2 * q] * rstd * a[2 * q] + bb[2 * q], o1 = v[2 * q + 1] * rstd * a[2 * q + 1] + bb[2 * q + 1];
            v4u w; w.x = pk2(o0.x, o0.y); w.y = pk2(o0.z, o0.w); w.z = pk2(o1.x, o1.y); w.w = pk2(o1.z, o1.w);
            *(v4u*)(dst + (size_t)r * DM + c0 + 512 * q) = w;
            if (INPROJ_F8MASK) { v2u w8; w8.x = pk4_fp8(o0.x, o0.y, o0.z, o0.w); w8.y = pk4_fp8(o1.x, o1.y, o1.z, o1.w); *(v2u*)(dst8 + (size_t)r * DM + c0 + 512 * q) = w8; } }
    }
}

#ifdef REV_A
#define PREP_ROW(r) (MROWS - 1 - (r))
#else
#define PREP_ROW(r) (r)
#endif
template <bool DRY = false>
__device__ __forceinline__ void phase_prep(Frame& F, bf16* P, const float* qn, const float* kn, const float* RC, const float* RS) {
    const int gw = F.vcu * NWAVES + F.wave, NGW = F.G * NWAVES;
    const int L = F.lane; const bool act = L < 48, isq = L < 32;
    const int col = isq ? C_AQ + 8 * L : C_AK + 8 * (L - 32), e0 = (8 * L) & 63, p0 = e0 >> 1;
    const float* gp = isq ? qn : kn; const f32x4 g0 = *(const f32x4*)(gp + e0), g1 = *(const f32x4*)(gp + e0 + 4);
    constexpr float C2 = 0.125f * 1.4426950408889634f; const float sc = isq ? C2 : 1.0f;
    for (int r0 = gw; r0 < MROWS; r0 += 4 * NGW) {
        v4u wv[4]; f32x4 cs[4], sn[4]; bool ok[4];
#pragma unroll
        for (int u = 0; u < 4; ++u) { const int r = r0 + u * NGW; ok[u] = r < MROWS; const int rr = ok[u] ? PREP_ROW(r) : gw; const int b = rr / RPB, j = rr - b * RPB; const bool lat = j >= L_CTX;
            cs[u] = (f32x4){1.f, 1.f, 1.f, 1.f}; sn[u] = (f32x4){0.f, 0.f, 0.f, 0.f}; if (lat) { cs[u] = *(const f32x4*)(RC + (j - L_CTX) * 32 + p0); sn[u] = *(const f32x4*)(RS + (j - L_CTX) * 32 + p0); }
            wv[u] = act ? *(const v4u*)(P + (size_t)rr * NPROJ + col) : (v4u){0u, 0u, 0u, 0u}; }
#pragma unroll
        for (int u = 0; u < 4; ++u) { const int r = PREP_ROW(r0 + u * NGW);
            const unsigned ww[4] = {wv[u].x, wv[u].y, wv[u].z, wv[u].w}; float x[8]; float ss = 0.f;
#pragma unroll
            for (int i = 0; i < 4; ++i) { x[2 * i] = bflo(ww[i]); x[2 * i + 1] = bfhi(ww[i]); ss += x[2 * i] * x[2 * i] + x[2 * i + 1] * x[2 * i + 1]; }
            ss += xshf<1>(ss); ss += xshf<2>(ss); ss += xshf<4>(ss);
            const float rstd = __builtin_amdgcn_rsqf(ss * (1.0f / 64.0f) + NORM_EPS) * sc;
            const float gg[8] = {g0.x, g0.y, g0.z, g0.w, g1.x, g1.y, g1.z, g1.w}, cc[4] = {cs[u].x, cs[u].y, cs[u].z, cs[u].w}, sv[4] = {sn[u].x, sn[u].y, sn[u].z, sn[u].w};
            unsigned o[4];
#pragma unroll
            for (int i = 0; i < 4; ++i) { const float y1 = x[2 * i] * rstd * gg[2 * i], y2 = x[2 * i + 1] * rstd * gg[2 * i + 1]; o[i] = pk2(y1 * cc[i] - y2 * sv[i], y1 * sv[i] + y2 * cc[i]); }
            if (DRY) { asm volatile("" : "+v"(o[0]), "+v"(o[3])); o[0] = wv[u].x; o[1] = wv[u].y; o[2] = wv[u].z; o[3] = wv[u].w; }
            if (ok[u] && act) *(v4u*)(P + (size_t)r * NPROJ + col) = (v4u){o[0], o[1], o[2], o[3]}; }
    }
}
namespace rc {
constexpr int PT = 144, MB = 64 * PT;
constexpr int O_QP = 0, O_QQ = MB, O_KP = 2 * MB, O_VT = 3 * MB, O_ST = 4 * MB, O_AT = 5 * MB, O_TOT = 6 * MB, SLOT = 6 * MB + 2048;
constexpr int OXP = 68;
typedef float f32x16 __attribute__((ext_vector_type(16)));
typedef float f32x4v __attribute__((ext_vector_type(4)));
typedef short bf16x8 __attribute__((ext_vector_type(8)));
__device__ __forceinline__ int crow(int r, int hi) { return (r & 3) + 8 * (r >> 2) + 4 * hi; }
__device__ __forceinline__ bf16x8 frag32(const LAS unsigned char* M, int row, int kcol, int hi) { return *(const LAS bf16x8*)(M + row * PT + (kcol + hi * 8) * 2); }
__device__ __forceinline__ float clampe(float x) { return fminf(fmaxf(x, -60.f), 60.f); }
__device__ __forceinline__ int seq_of(int mixer, int b, int h, int dir) { return ((mixer * NB + b) * 4 + h) * 2 + dir; }
__device__ __forceinline__ int row_in_batch(int dir, int n) { return (dir == 0) ? n : (n < L_CTX ? (L_CTX - 1 - n) : (RPB + L_CTX - 1 - n)); }
}
struct StageARaw { v4u k[8], v[8]; };
__device__ __forceinline__ void stageA_load(StageARaw& R, const Frame& F, const bf16* P, int mixer, int b, int h, int dir, int c) {
    using namespace rc;
    const int lane = F.lane, r8 = lane >> 3, ch = lane & 7;
    const int ck = (mixer == 0 ? C_HZ + 256 * dir : C_RK) + h * 64 + 8 * ch, cv = (mixer == 0 ? C_HI : C_RV) + h * 64 + 8 * ch;
    const int j0 = row_in_batch(dir, c * 64 + r8); const long step = (dir == 0) ? 8L * NPROJ : -8L * NPROJ;
    const bf16* rp = P + (size_t)(b * RPB + j0) * NPROJ;
#pragma unroll
    for (int i = 0; i < 8; ++i) { R.k[i] = *(const v4u*)(rp + ck); R.v[i] = *(const v4u*)(rp + cv); rp += step; }
}
template <int MIXER>
__device__ __forceinline__ void stageA_compute(const StageARaw& R, Frame& F, bf16* KVS, float* DBUF, int b, int h, int dir, int c, const float* lblog, float gamma) {
    using namespace rc;
    constexpr int HP = 80;
    LAS unsigned char* WL = F.lds + F.wave * 10240; LAS unsigned char* KT = WL; LAS unsigned char* VTm = WL + 5120;
    const int lane = F.lane, seq = seq_of(MIXER, b, h, dir), r8 = lane >> 3, ch = lane & 7;
    unsigned kp[32], vp[32];
    {
        float kk[64];
#pragma unroll
        for (int i = 0; i < 8; ++i) *(LAS v4u*)(WL + (r8 + 8 * i) * PT + 16 * ch) = R.k[i];
#pragma unroll
        for (int s = 0; s < 64; ++s) kk[s] = bf1(*(const LAS unsigned short*)(WL + s * PT + 2 * lane));
        if (MIXER == 0) {
            const float lb = lblog ? sigmf(lblog[512 + dir * 256 + h * 64 + lane] - lblog[dir * 256 + h * 64 + lane]) : 0.f;
            float run = 1.f;
#pragma unroll
            for (int s = 63; s >= 0; --s) { const float f = lb + (1.0f - lb) * sigmf(kk[s]); kk[s] = (1.0f - f) * run; run *= f; }
            DBUF[(size_t)(seq * 36 + c) * 64 + lane] = run;
        } else {
            const float lg2 = __log2f(gamma);
#pragma unroll
            for (int s = 0; s < 64; ++s) kk[s] *= exp2f((float)(63 - s) * lg2);
        }
#pragma unroll
        for (int s = 0; s < 32; ++s) kp[s] = pk2(kk[2 * s], kk[2 * s + 1]);
    }
#pragma unroll
    for (int i = 0; i < 8; ++i) *(LAS v4u*)(WL + (r8 + 8 * i) * PT + 16 * ch) = R.v[i];
#pragma unroll
    for (int s = 0; s < 32; ++s) vp[s] = (unsigned)*(const LAS unsigned short*)(WL + (2 * s) * PT + 2 * lane) | ((unsigned)*(const LAS unsigned short*)(WL + (2 * s + 1) * PT + 2 * lane) << 16);
    const int r = lane & 15, g = lane >> 4;
    f32x4v acc[4][4];
#pragma unroll
    for (int a = 0; a < 4; ++a)
#pragma unroll
        for (int q = 0; q < 4; ++q) acc[a][q] = (f32x4v){0.f, 0.f, 0.f, 0.f};
#pragma unroll
    for (int hh = 0; hh < 2; ++hh) {
#pragma unroll
        for (int i = 0; i < 4; ++i) { const int s0 = 32 * hh + 8 * i; v4u ko, vo;
            ko.x = kp[s0 / 2]; ko.y = kp[s0 / 2 + 1]; ko.z = kp[s0 / 2 + 2]; ko.w = kp[s0 / 2 + 3];
            vo.x = vp[s0 / 2]; vo.y = vp[s0 / 2 + 1]; vo.z = vp[s0 / 2 + 2]; vo.w = vp[s0 / 2 + 3];
            *(LAS v4u*)(KT + lane * HP + 16 * i) = ko; *(LAS v4u*)(VTm + lane * HP + 16 * i) = vo; }
        bf16x8 af[4], bfr[4];
#pragma unroll
        for (int q = 0; q < 4; ++q) { af[q] = *(const LAS bf16x8*)(VTm + (16 * q + r) * HP + 16 * g); bfr[q] = *(const LAS bf16x8*)(KT + (16 * q + r) * HP + 16 * g); }
#pragma unroll
        for (int a = 0; a < 4; ++a)
#pragma unroll
            for (int q = 0; q < 4; ++q) acc[a][q] = __builtin_amdgcn_mfma_f32_16x16x32_bf16(af[a], bfr[q], acc[a][q], 0, 0, 0);
    }
#pragma unroll
    for (int a = 0; a < 4; ++a)
#pragma unroll
        for (int q = 0; q < 4; ++q)
#pragma unroll
            for (int x = 0; x < 4; ++x) *(LAS unsigned short*)(WL + (16 * a + 4 * g + x) * PT + (16 * q + r) * 2) = (unsigned short)f2bf(acc[a][q][x]);
    bf16* dst = KVS + (size_t)(seq * 36 + c) * 4096;
#pragma unroll
    for (int i = 0; i < 8; ++i) { const int idx = lane + 64 * i, e = idx >> 3, d8 = idx & 7; *(v4u*)(dst + e * 64 + d8 * 8) = *(const LAS v4u*)(WL + e * PT + d8 * 16); }
}
__device__ __forceinline__ void recur_stageA_loop(Frame& F, const bf16* P, bf16* KVS, float* DBUF, int u0, int stride, int nunits, const float* lblog, const float* rdec) {
    if (u0 >= nunits) return;
    StageARaw cur;
#define STA_DECODE(u_, it__) const int mh_ = ((u_) + (it__)) & 7, rest_ = (u_) >> 3, c_ = rest_ % 36, bd_ = rest_ / 36, b_ = bd_ >> 1, dir_ = bd_ & 1, mixer_ = mh_ >> 2, h_ = mh_ & 3
    int it = 0;
    for (int u = u0; u < nunits; u += stride, ++it) {
#ifdef REV_A
        STA_DECODE(nunits - 1 - u, it);
#else
        STA_DECODE(u, it);
#endif
        stageA_load(cur, F, P, mixer_, b_, h_, dir_, c_);
        if (mixer_ == 0) stageA_compute<0>(cur, F, KVS, DBUF, b_, h_, dir_, c_, lblog, 0.f);
        else stageA_compute<1>(cur, F, KVS, DBUF, b_, h_, dir_, c_, nullptr, sigmf(rdec[dir_ * 4 + h_]));
    }
#undef STA_DECODE
}
template <int MIXER, bool DRY = false>
__device__ __forceinline__ void recur_stageB_seq(Frame& F, bf16* KVS, const float* DBUF, int seq, float gamma) {
    const int e = F.tid >> 3, d8 = F.tid & 7;
    bf16* base = KVS + (size_t)seq * 36 * 4096 + e * 64 + d8 * 8; const float* db = DBUF + (size_t)seq * 36 * 64 + d8 * 8;
    float S[8];
#pragma unroll
    for (int i = 0; i < 8; ++i) S[i] = 0.f;
    const float g64 = (MIXER == 1) ? exp2f(64.0f * __log2f(gamma)) : 0.f;
    constexpr int GB = 4;
    v4u kv[GB], kvn[GB]; f32x4 da[GB], dbv[GB], dan[GB], dbn[GB];
#pragma unroll
    for (int i = 0; i < GB; ++i) { kv[i] = *(const v4u*)(base + (size_t)i * 4096); da[i] = (f32x4){g64, g64, g64, g64}; dbv[i] = da[i];
        if (MIXER == 0) { da[i] = *(const f32x4*)(db + i * 64); dbv[i] = *(const f32x4*)(db + i * 64 + 4); } }
    for (int c0 = 0; c0 < 36; c0 += GB) {
#pragma unroll
        for (int i = 0; i < GB; ++i) { kvn[i] = kv[i]; dan[i] = da[i]; dbn[i] = dbv[i];
            if (c0 + GB < 36) { kvn[i] = *(const v4u*)(base + (size_t)(c0 + GB + i) * 4096); if (MIXER == 0) { dan[i] = *(const f32x4*)(db + (c0 + GB + i) * 64); dbn[i] = *(const f32x4*)(db + (c0 + GB + i) * 64 + 4); } } }
#pragma unroll
        for (int i = 0; i < GB; ++i) {
            v4u so; so.x = pk2(S[0], S[1]); so.y = pk2(S[2], S[3]); so.z = pk2(S[4], S[5]); so.w = pk2(S[6], S[7]);
            if (DRY) { so = kv[i]; asm volatile("" : "+v"(S[0]), "+v"(S[7])); }
            *(v4u*)(base + (size_t)(c0 + i) * 4096) = so;
            const float dd[8] = {da[i].x, da[i].y, da[i].z, da[i].w, dbv[i].x, dbv[i].y, dbv[i].z, dbv[i].w}; const unsigned kw[4] = {kv[i].x, kv[i].y, kv[i].z, kv[i].w};
#pragma unroll
            for (int q = 0; q < 4; ++q) { S[2 * q] = dd[2 * q] * S[2 * q] + bflo(kw[q]); S[2 * q + 1] = dd[2 * q + 1] * S[2 * q + 1] + bfhi(kw[q]); }
        }
#pragma unroll
        for (int i = 0; i < GB; ++i) { kv[i] = kvn[i]; da[i] = dan[i]; dbv[i] = dbn[i]; }
    }
}
struct StageCRaw { v4u q[2], k[2], v[2]; v4u s0, s1, g; };
template <int MIXER>
__device__ __forceinline__ void stageC_load(StageCRaw& R, const Frame& F, const bf16* P, const bf16* KVS, int b, int h, int tb) {
    using namespace rc;
    const int dir = F.wave >> 2, wq = F.wave & 3, lane = F.lane, tr = lane >> 3, ch = lane & 7;
    const int c = (dir == 0) ? tb : (tb < 4 ? 3 - tb : 39 - tb), seq = seq_of(MIXER, b, h, dir);
    const int cq = (MIXER == 0 ? C_HQ : C_RQ) + h * 64 + 8 * ch, ck = (MIXER == 0 ? C_HZ + 256 * dir : C_RK) + h * 64 + 8 * ch, cv = (MIXER == 0 ? C_HI : C_RV) + h * 64 + 8 * ch;
    const int j0 = row_in_batch(dir, c * 64 + 16 * wq + tr); const long step = (dir == 0) ? 8L * NPROJ : -8L * NPROJ;
    const bf16* rp = P + (size_t)(b * RPB + j0) * NPROJ;
#pragma unroll
    for (int ii = 0; ii < 2; ++ii) { R.q[ii] = *(const v4u*)(rp + cq); R.k[ii] = *(const v4u*)(rp + ck); R.v[ii] = *(const v4u*)(rp + cv); rp += step; }
    const bf16* src = KVS + (size_t)(seq * 36 + c) * 4096; const int t256 = wq * 64 + lane;
    R.s0 = *(const v4u*)(src + (t256 >> 3) * 64 + (t256 & 7) * 8); R.s1 = *(const v4u*)(src + ((t256 + 256) >> 3) * 64 + (t256 & 7) * 8);
    { const int tok = F.tid >> 3, ech = F.tid & 7; R.g = *(const v4u*)(P + (size_t)(b * RPB + tb * 64 + tok) * NPROJ + (MIXER == 0 ? C_HG : C_RG) + h * 64 + 8 * ech); }
}
template <int MIXER>
__device__ __forceinline__ void stageC_compute(const StageCRaw& R, Frame& F, bf16* ACTo, int b, int h, int tb, const float* lblog, const float* rdec, const float* gain) {
    using namespace rc;
    const int dir = F.wave >> 2, wq = F.wave & 3, lane = F.lane, tr = lane >> 3, ch = lane & 7;
    LAS unsigned char* SL = F.lds + dir * SLOT;
    { const int t256 = wq * 64 + lane;
      *(LAS v4u*)(SL + O_ST + (t256 >> 3) * PT + (t256 & 7) * 16) = R.s0; *(LAS v4u*)(SL + O_ST + ((t256 + 256) >> 3) * PT + (t256 & 7) * 16) = R.s1; }
#pragma unroll
    for (int ii = 0; ii < 2; ++ii) { const int t = 16 * wq + tr + 8 * ii; const unsigned vw[4] = {R.v[ii].x, R.v[ii].y, R.v[ii].z, R.v[ii].w};
#pragma unroll
        for (int x = 0; x < 4; ++x) { *(LAS unsigned short*)(SL + O_VT + (8 * ch + 2 * x) * PT + t * 2) = (unsigned short)(vw[x] & 0xffffu); *(LAS unsigned short*)(SL + O_VT + (8 * ch + 2 * x + 1) * PT + t * 2) = (unsigned short)(vw[x] >> 16); } }
    if (MIXER == 0) {
#pragma unroll
        for (int ii = 0; ii < 2; ++ii) { const int t = 16 * wq + tr + 8 * ii; *(LAS v4u*)(SL + O_QP + t * PT + 16 * ch) = R.q[ii]; *(LAS v4u*)(SL + O_KP + t * PT + 16 * ch) = R.k[ii]; }
        float qv[16], kv[16], q2[16];
#pragma unroll
        for (int i = 0; i < 16; ++i) { qv[i] = bf1(*(const LAS unsigned short*)(SL + O_QP + (16 * wq + i) * PT + 2 * lane)); kv[i] = bf1(*(const LAS unsigned short*)(SL + O_KP + (16 * wq + i) * PT + 2 * lane)); }
        const float lb = lblog ? sigmf(lblog[512 + dir * 256 + h * 64 + lane] - lblog[dir * 256 + h * 64 + lane]) : 0.f;
        float lc[16]; float run = 1.f;
#pragma unroll
        for (int i = 0; i < 16; ++i) { const float f = lb + (1.0f - lb) * sigmf(kv[i]); run *= f; lc[i] = run; kv[i] = 1.0f - f; }
        LAS float* TOT = (LAS float*)(SL + O_TOT); TOT[wq * 64 + lane] = run;
        __syncthreads();
        float pre = 1.f;
#pragma unroll
        for (int q = 0; q < 4; ++q) { const float t = TOT[q * 64 + lane]; if (q < wq) pre *= t; }
        const float rmid = __builtin_amdgcn_rcpf(fmaxf(TOT[lane] * TOT[64 + lane], 1e-30f));
#pragma unroll
        for (int i = 0; i < 16; ++i) { const float pt = pre * lc[i]; q2[i] = qv[i] * pt; const float e1 = fminf(fmaxf(pt * rmid, 1e-30f), 1e30f); qv[i] *= e1; kv[i] *= __builtin_amdgcn_rcpf(e1); }
#pragma unroll
        for (int i = 0; i < 16; ++i) { const int t = 16 * wq + i;
            *(LAS unsigned short*)(SL + O_QP + t * PT + lane * 2) = (unsigned short)f2bf(qv[i]);
            *(LAS unsigned short*)(SL + O_KP + t * PT + lane * 2) = (unsigned short)f2bf(kv[i]);
            *(LAS unsigned short*)(SL + O_QQ + t * PT + lane * 2) = (unsigned short)f2bf(q2[i]); }
    } else {
        const float lg2 = __log2f(sigmf(rdec[dir * 4 + h]));
#pragma unroll
        for (int ii = 0; ii < 2; ++ii) { const int t = 16 * wq + tr + 8 * ii; const float gq = exp2f((float)(t + 1) * lg2) * 0.125f;
            const unsigned qw[4] = {R.q[ii].x, R.q[ii].y, R.q[ii].z, R.q[ii].w}; v4u q1, q2v;
            { unsigned o1[4], o2[4];
#pragma unroll
              for (int x = 0; x < 4; ++x) { const float lo = bflo(qw[x]), hi2 = bfhi(qw[x]); o1[x] = pk2(lo * 0.125f, hi2 * 0.125f); o2[x] = pk2(lo * gq, hi2 * gq); }
              q1 = (v4u){o1[0], o1[1], o1[2], o1[3]}; q2v = (v4u){o2[0], o2[1], o2[2], o2[3]}; }
            *(LAS v4u*)(SL + O_QP + t * PT + 16 * ch) = q1; *(LAS v4u*)(SL + O_QQ + t * PT + 16 * ch) = q2v; *(LAS v4u*)(SL + O_KP + t * PT + 16 * ch) = R.k[ii]; }
    }
    __syncthreads();
    const int ti = wq >> 1, tj = wq & 1, r32 = lane & 31, hi = lane >> 5;
    if (tj <= ti) {
        f32x16 a = {0.f, 0.f, 0.f, 0.f, 0.f, 0.f, 0.f, 0.f, 0.f, 0.f, 0.f, 0.f, 0.f, 0.f, 0.f, 0.f};
#pragma unroll
        for (int kkk = 0; kkk < 4; ++kkk) a = __builtin_amdgcn_mfma_f32_32x32x16_bf16(frag32(SL + O_QP, 32 * ti + r32, 16 * kkk, hi), frag32(SL + O_KP, 32 * tj + r32, 16 * kkk, hi), a, 0, 0, 0);
        const float lg2 = (MIXER == 1) ? __log2f(sigmf(rdec[dir * 4 + h])) : 0.f;
#pragma unroll
        for (int r = 0; r < 16; ++r) { const int dt = 32 * (ti - tj) + crow(r, hi) - r32; float val = a[r];
            if (MIXER == 1) val *= exp2f((float)dt * lg2);
            if (dt < 0) val = 0.f;
            *(LAS unsigned short*)(SL + O_AT + (32 * ti + crow(r, hi)) * PT + (32 * tj + r32) * 2) = (unsigned short)f2bf(val); }
    }
    __syncthreads();
    f32x16 o = {0.f, 0.f, 0.f, 0.f, 0.f, 0.f, 0.f, 0.f, 0.f, 0.f, 0.f, 0.f, 0.f, 0.f, 0.f, 0.f};
#pragma unroll
    for (int st = 0; st < 2; ++st) if (st <= ti) {
#pragma unroll
        for (int kkk = 0; kkk < 2; ++kkk) o = __builtin_amdgcn_mfma_f32_32x32x16_bf16(frag32(SL + O_AT, 32 * ti + r32, 32 * st + 16 * kkk, hi), frag32(SL + O_VT, 32 * tj + r32, 32 * st + 16 * kkk, hi), o, 0, 0, 0); }
#pragma unroll
    for (int kkk = 0; kkk < 4; ++kkk) o = __builtin_amdgcn_mfma_f32_32x32x16_bf16(frag32(SL + O_QQ, 32 * ti + r32, 16 * kkk, hi), frag32(SL + O_ST, 32 * tj + r32, 16 * kkk, hi), o, 0, 0, 0);
    { LAS unsigned char* OX = F.lds + 2 * SLOT + dir * MB;
#pragma unroll
      for (int r = 0; r < 16; ++r) *(LAS unsigned short*)(OX + (32 * ti + crow(r, hi)) * PT + (32 * tj + r32) * 2) = (unsigned short)f2bf(o[r]); }
    __syncthreads();
    { const int tok = F.tid >> 3, ech = F.tid & 7, row = b * RPB + tb * 64 + tok;
      const v4u fw = *(const LAS v4u*)(F.lds + 2 * SLOT + tok * PT + 16 * ech), bw = *(const LAS v4u*)(F.lds + 2 * SLOT + MB + (63 - tok) * PT + 16 * ech);
      const unsigned fws[4] = {fw.x, fw.y, fw.z, fw.w}, bws[4] = {bw.x, bw.y, bw.z, bw.w};
      float ov[8]; float ss = 0.f;
#pragma unroll
      for (int i = 0; i < 4; ++i) { ov[2 * i] = bflo(fws[i]) + bflo(bws[i]); ov[2 * i + 1] = bfhi(fws[i]) + bfhi(bws[i]); ss += ov[2 * i] * ov[2 * i] + ov[2 * i + 1] * ov[2 * i + 1]; }
      ss += xshf<1>(ss); ss += xshf<2>(ss); ss += xshf<4>(ss);
      const float rs = __builtin_amdgcn_rsqf(ss * (1.0f / 64.0f) + NORM_EPS);
      const f32x4 ga = *(const f32x4*)(gain + h * 64 + 8 * ech), gb = *(const f32x4*)(gain + h * 64 + 8 * ech + 4);
      const float gg[8] = {ga.x, ga.y, ga.z, ga.w, gb.x, gb.y, gb.z, gb.w}; const unsigned gws[4] = {R.g.x, R.g.y, R.g.z, R.g.w};
      float res[8];
#pragma unroll
      for (int i = 0; i < 4; ++i) { res[2 * i] = ov[2 * i] * rs * gg[2 * i] * siluf(bflo(gws[i])); res[2 * i + 1] = ov[2 * i + 1] * rs * gg[2 * i + 1] * siluf(bfhi(gws[i])); }
#ifdef OUTPROJ_FP8
      v2u w2; w2.x = pk4_fp8(res[0] * 4.0f, res[1] * 4.0f, res[2] * 4.0f, res[3] * 4.0f); w2.y = pk4_fp8(res[4] * 4.0f, res[5] * 4.0f, res[6] * 4.0f, res[7] * 4.0f);
      *(v2u*)((unsigned char*)ACTo + (size_t)(row >> 1) * 2048 + ((MIXER == 0 ? 0 : 8) + h) * 128 + (row & 1) * 64 + 8 * ech) = w2; }
#else
      v4u w4; w4.x = pk2(res[0], res[1]); w4.y = pk2(res[2], res[3]); w4.z = pk2(res[4], res[5]); w4.w = pk2(res[6], res[7]);
      *(v4u*)(ACTo + (size_t)row * DM + (MIXER == 0 ? 0 : 512) + h * 64 + 8 * ech) = w4; }
#endif
}
__device__ __forceinline__ void recur_stageC_loop(Frame& F, const bf16* P, const bf16* KVS, bf16* ACTo, int mh0, int ub0, int stride, int nub, int ntb, int tboff, const float* lblog, const float* rdec, const float* hn, const float* rn) {
    if (ub0 >= nub) return;
    StageCRaw cur, nxt;
    { const int mh = mh0 & 7; if ((mh >> 2) == 0) stageC_load<0>(cur, F, P, KVS, ub0 / ntb, mh & 3, tboff + ub0 % ntb); else stageC_load<1>(cur, F, P, KVS, ub0 / ntb, mh & 3, tboff + ub0 % ntb); }
    int i = 0;
    for (int ub = ub0; ub < nub; ub += stride, ++i) {
        const int un = ub + stride; const bool more = un < nub; const int mh = (mh0 + i) & 7, mhn = (mh0 + i + 1) & 7;
        if (more) { if ((mhn >> 2) == 0) stageC_load<0>(nxt, F, P, KVS, un / ntb, mhn & 3, tboff + un % ntb); else stageC_load<1>(nxt, F, P, KVS, un / ntb, mhn & 3, tboff + un % ntb); }
        if ((mh >> 2) == 0) stageC_compute<0>(cur, F, ACTo, ub / ntb, mh & 3, tboff + ub % ntb, lblog, rdec, hn);
        else stageC_compute<1>(cur, F, ACTo, ub / ntb, mh & 3, tboff + ub % ntb, nullptr, rdec, rn);
        if (more) cur = nxt;
    }
}
__device__ __forceinline__ void phase_conv(Frame& F, const bf16* P, bf16* ACTo, const float* convw, bool latent_only) {
    const int gw = F.vcu * NWAVES + F.wave, NGW = F.G * NWAVES, rsel = F.lane >> 5, c0 = 8 * (F.lane & 31);
    f32x4 w0[2], w1[2], w2[2];
#pragma unroll
    for (int hf = 0; hf < 2; ++hf) { w0[hf] = *(const f32x4*)(convw + c0 + 4 * hf); w1[hf] = *(const f32x4*)(convw + 256 + c0 + 4 * hf); w2[hf] = *(const f32x4*)(convw + 512 + c0 + 4 * hf); }
    const int nrows = latent_only ? NB * T_LAT : MROWS;
    auto ld8 = [](const bf16* p, f32x4& a, f32x4& b) { const v4u w = *(const v4u*)p; a = (f32x4){bflo(w.x), bfhi(w.x), bflo(w.y), bfhi(w.y)}; b = (f32x4){bflo(w.z), bfhi(w.z), bflo(w.w), bfhi(w.w)}; };
    for (int idx2 = gw; 2 * idx2 < nrows; idx2 += NGW) {
        const int idx = 2 * idx2 + rsel;
        const int r = latent_only ? row_of_latent(idx) : idx;
        const int b = r / RPB, j = r - b * RPB;
        const bf16* row = P + (size_t)r * NPROJ;
        const bool first = (j == 0) || (j == L_CTX), last = (j == L_CTX - 1) || (j == RPB - 1);
        f32x4 ca, cb, ha, hb, u1a, u1b, u0a = (f32x4){0.f, 0.f, 0.f, 0.f}, u0b = u0a, u2a = u0a, u2b = u0a;
        ld8(row + C_CC + c0, ca, cb); ld8(row + C_CH + c0, ha, hb); u1a = ca * ha; u1b = cb * hb;
        if (!first) { ld8(row - NPROJ + C_CC + c0, ca, cb); ld8(row - NPROJ + C_CH + c0, ha, hb); u0a = ca * ha; u0b = cb * hb; }
        if (!last) { ld8(row + NPROJ + C_CC + c0, ca, cb); ld8(row + NPROJ + C_CH + c0, ha, hb); u2a = ca * ha; u2b = cb * hb; }
        f32x4 ba, bb2; ld8(row + C_CB + c0, ba, bb2);
        const f32x4 xa = ba * (w0[0] * u0a + w1[0] * u1a + w2[0] * u2a), xb = bb2 * (w0[1] * u0b + w1[1] * u1b + w2[1] * u2b);
#ifdef OUTPROJ_FP8
        { const f32x4 ya = xa * 4.0f, yb = xb * 4.0f; v2u w2; w2.x = pk4_fp8(ya.x, ya.y, ya.z, ya.w); w2.y = pk4_fp8(yb.x, yb.y, yb.z, yb.w); *(v2u*)((unsigned char*)ACTo + (size_t)(r >> 1) * 2048 + (4 + (c0 >> 6)) * 128 + (r & 1) * 64 + (c0 & 63)) = w2; }
#else
        v4u w; w.x = pk2(xa.x, xa.y); w.y = pk2(xa.z, xa.w); w.z = pk2(xb.x, xb.y); w.w = pk2(xb.z, xb.w); *(v4u*)(ACTo + (size_t)r * DM + 256 + c0) = w;
#endif
    }
}
struct DenseOrder {
    int nM, nN, nwg, G, c, latent_only; const char* A; const char* Bt; size_t tA, tB; unsigned long long pnmap;
    __device__ __forceinline__ void init(int nM_, int nN_, int G_, int c_, int lat, const void* A_, const void* Bt_, int lda, int ldb) {
        nM = nM_; nN = nN_; nwg = nM * nN; G = G_; c = c_; latent_only = lat; A = (const char*)A_; Bt = (const char*)Bt_; tA = (size_t)256 * lda * 2; tB = (size_t)256 * ldb * 2; pnmap = 0xFEDCBA9876543210ull; }
    __device__ __forceinline__ bool next(int i, pg8::Unit& u) const {
        const long L = (long)i * G + c; if (L >= nwg) return false;
        int wgid = (int)L; { const int q = nwg / pg8::NXCD, r = nwg % pg8::NXCD, xcd = wgid % pg8::NXCD, off = wgid / pg8::NXCD; wgid = (xcd < r ? xcd * (q + 1) : r * (q + 1) + (xcd - r) * q) + off; }
#ifndef DENSE_WGM
#define DENSE_WGM 8
#endif
        const int nig = DENSE_WGM * nN, gid = wgid / nig, fm = gid * DENSE_WGM, gsz = (nM - fm) < DENSE_WGM ? (nM - fm) : DENSE_WGM;
        int pm = fm + ((wgid % nig) % gsz); const int pn = (int)((pnmap >> (4 * ((wgid % nig) / gsz))) & 15ull);
        if (latent_only) pm = (pm >> 3) * PPB + 1 + (pm & 7);
        u.pm = pm; u.pn = pn; u.x0 = 0; u.x1 = 0; u.a = A + (size_t)pm * tA; u.b = Bt + (size_t)pn * tB; u.b2 = u.b; return true; }
    __device__ __forceinline__ void a_ready(const pg8::Unit&) const {}
    __device__ __forceinline__ void done(const pg8::Unit&) const {}
};
struct MoeOrder {
    int ncol, nwg, G, c, down, pm0; const LAS int* tileb; const char* A; const char* W;
    __device__ __forceinline__ bool next(int i, pg8::Unit& u) const {
        const long L = (long)i * G + c; if (L >= nwg) return false;
        int w = (int)L; { const int q = nwg / pg8::NXCD, r = nwg % pg8::NXCD, xcd = w % pg8::NXCD, off = w / pg8::NXCD; w = (xcd < r ? xcd * (q + 1) : r * (q + 1) + (xcd - r) * q) + off; }
        const int pm = pm0 + w / ncol, pc = w % ncol;
        const int k = __builtin_amdgcn_readfirstlane(tileb[pm]), g = k / 6, pr = k % 6;
        const int ea = pr < 3 ? 0 : (pr < 5 ? 1 : 2), eb = pr < 3 ? pr + 1 : (pr < 5 ? pr - 1 : 3);
        u.pm = pm; u.pn = pc; u.x0 = 0; u.x1 = 0; u.a = down ? A + (size_t)pm * 256 * 1024 : A;
        if (!down) { const int e = g * 4 + (pc < 4 ? ea : eb); u.b = W + (size_t)(e * 4 + (pc & 3)) * 256 * 1024; u.b2 = u.b; }
        else { const char* base = W + (size_t)(g * 1024 + pc * 256) * 2048; u.b = base + ea * 512; u.b2 = base + eb * 512 - 512; }
        return true; }
    __device__ __forceinline__ void a_ready(const pg8::Unit&) const {}
    __device__ __forceinline__ void done(const pg8::Unit&) const {}
};
struct EpiStore {
    static constexpr bool PERM = true, AFTER_DRAIN = false;
    bf16* O; int ldc; float sc;
    __device__ __forceinline__ void operator()(const f32x4 (&acc)[2][2][4][2], const pg8::Unit& u, int wr, int wc, int fr, int fq) const {
        const int row0 = u.pm * 256 + wr * 64 + fr, col0 = u.pn * 256 + wc * 32 + 8 * fq;
#pragma unroll
        for (int ai = 0; ai < 2; ++ai)
#pragma unroll
            for (int m = 0; m < 4; ++m) { bf16* rowp = O + (size_t)(row0 + ai * 128 + m * 16) * ldc + col0;
#pragma unroll
                for (int bj = 0; bj < 2; ++bj) { const f32x4 v0 = acc[ai][bj][m][0] * sc, v1 = acc[ai][bj][m][1] * sc;
                    v4u w; w.x = pg8::cvt_pk_bf16(v0[0], v0[1]); w.y = pg8::cvt_pk_bf16(v0[2], v0[3]); w.z = pg8::cvt_pk_bf16(v1[0], v1[1]); w.w = pg8::cvt_pk_bf16(v1[2], v1[3]);
                    *(v4u*)(rowp + bj * 128) = w; } }
    }
};
struct EpiResid {
    static constexpr bool PERM = false, AFTER_DRAIN = false;
    const float* xsrc; const float* csrc; float* xdst; float* cdst; const float* gate; float sc;
    __device__ __forceinline__ void operator()(const f32x4 (&acc)[2][2][4][2], const pg8::Unit& u, int wr, int wc, int fr, int fq) const {
        const int b = u.pm / PPB, pj = u.pm - b * PPB; const bool isc = pj == 0;
        const float* src = isc ? csrc + (size_t)b * L_CTX * DM : xsrc + (size_t)(b * T_LAT + (pj - 1) * 256) * DM;
        float* dst = isc ? cdst + (size_t)b * L_CTX * DM : xdst + (size_t)(b * T_LAT + (pj - 1) * 256) * DM;
        const int col0 = u.pn * 256 + wc * 32 + 4 * fq; const float* gp = gate + (isc ? 16 : b) * 1024 + col0;
        f32x4 gv[2][2];
#pragma unroll
        for (int bj = 0; bj < 2; ++bj)
#pragma unroll
            for (int n = 0; n < 2; ++n) gv[bj][n] = *(const f32x4*)(gp + bj * 128 + n * 16) * sc;
#pragma unroll
        for (int ai = 0; ai < 2; ++ai)
#pragma unroll
            for (int m = 0; m < 4; ++m) { const size_t off = (size_t)(ai * 128 + wr * 64 + m * 16 + fr) * DM + col0;
#pragma unroll
                for (int bj = 0; bj < 2; ++bj)
#pragma unroll
                    for (int n = 0; n < 2; ++n) *(f32x4*)(dst + off + bj * 128 + n * 16) = LDNT((const f32x4*)(src + off + bj * 128 + n * 16)) + gv[bj][n] * acc[ai][bj][m][n];
                if (m & 1) asm volatile("" ::: "memory"); }
    }
};
struct EpiGateUp {
    static constexpr bool PERM = true, AFTER_DRAIN = false;
    unsigned char* H; const v4i* rowinfo;
    __device__ __forceinline__ void operator()(const f32x4 (&acc)[2][2][4][2], const pg8::Unit& u, int wr, int wc, int fr, int fq) const {
        const int pos0 = u.pm * 256 + wr * 64 + fr, col0 = u.pn * 128 + wc * 32 + 8 * fq; const bool second = u.pn >= 4;
#pragma unroll
        for (int ai = 0; ai < 2; ++ai)
#pragma unroll
            for (int m = 0; m < 4; ++m) { const int pos = pos0 + ai * 128 + m * 16; const v4i ri = rowinfo[pos];
                const float w = __builtin_bit_cast(float, second ? ri.z : ri.y) * (16.0f / 32.0f);
                const f32x4 g0 = acc[ai][0][m][0] * (1.0f / 32.0f), g1 = acc[ai][0][m][1] * (1.0f / 32.0f), u0 = acc[ai][1][m][0], u1 = acc[ai][1][m][1];
                float h[8];
#pragma unroll
                for (int i = 0; i < 4; ++i) { h[i] = siluf(g0[i]) * u0[i] * w; h[4 + i] = siluf(g1[i]) * u1[i] * w; }
                v2u o; o.x = pk4_fp8(h[0], h[1], h[2], h[3]); o.y = pk4_fp8(h[4], h[5], h[6], h[7]);
                *(v2u*)(H + (size_t)pos * 1024 + col0) = o; }
    }
};
struct EpiDown {
    static constexpr bool PERM = false, AFTER_DRAIN = false;
    float* xdst; float* cdst; const float* gate; const v4i* rowinfo;
    __device__ __forceinline__ void operator()(const f32x4 (&acc)[2][2][4][2], const pg8::Unit& u, int wr, int wc, int fr, int fq) const {
        const int pos0 = u.pm * 256 + wr * 64 + fr, col0 = u.pn * 256 + wc * 32 + 4 * fq;
#pragma unroll
        for (int ai = 0; ai < 2; ++ai)
#pragma unroll
            for (int m = 0; m < 4; ++m) { const int r = rowinfo[pos0 + ai * 128 + m * 16].x;
#ifdef ZERO_MOE
                if (false) {
#else
                if (r >= 0) {
#endif
                    const int b = r / RPB, j = r - b * RPB; const bool isc = j < L_CTX;
                    float* dst = (isc ? cdst + (size_t)(b * L_CTX + j) * DM : xdst + (size_t)(b * T_LAT + j - L_CTX) * DM) + col0;
                    const float* gp = gate + (isc ? 16 : b) * 1024 + col0;
#pragma unroll
                    for (int bj = 0; bj < 2; ++bj)
#pragma unroll
                        for (int n = 0; n < 2; ++n) { float* p = dst + bj * 128 + n * 16; *(f32x4*)p = LDNT((const f32x4*)p) + *(const f32x4*)(gp + bj * 128 + n * 16) * (acc[ai][bj][m][n] * (1.0f / 512.0f)); } }
                if (m & 1) asm volatile("" ::: "memory"); }
    }
};

__device__ __forceinline__ void phase_norm2_route(Frame& F, int layer, const float* xsrc, const float* csrc, const float* nA, const float* nB, bf16* dst, bool latent_only) {
    typedef short bf16x8v __attribute__((ext_vector_type(8))); typedef float f32x4v __attribute__((ext_vector_type(4)));
    unsigned char* const ws = PWS;
    LAS int* cnt = (LAS int*)(F.lds + TAB_OFF);
    LAS float* MA = (LAS float*)(F.lds); LAS float* MBv = MA + 2048;
    LAS float* SSP = MA + 4096;
    LAS float* PART = SSP + 128;
    LAS float* LOG = PART + 8 * 16 * 32;
    const int lane = F.lane, wv = F.wave, r16 = lane & 15, g = lane >> 4, k0w = 128 * wv;
    const int nrows = latent_only ? NB * T_LAT : MROWS, NGW = F.G * NWAVES, RPW = (nrows + NGW - 1) / NGW, RPBLK = NWAVES * RPW;
    const int ib0 = (int)blockIdx.x * RPBLK, ib1 = (ib0 + RPBLK < nrows) ? ib0 + RPBLK : nrows;
    int mfirst = 0, mlast = 0;
    if (ib0 < ib1) { const int ra = latent_only ? row_of_latent(ib0) : ib0, rb = latent_only ? row_of_latent(ib1 - 1) : ib1 - 1;
      const int ba = ra / RPB, ja = ra - ba * RPB, bb_ = rb / RPB, jb = rb - bb_ * RPB; mfirst = (ja < L_CTX) ? 16 : ba; mlast = (jb < L_CTX) ? 16 : bb_; }
    for (int i = F.tid; i < 512; i += NTHR) { const int sl = i >> 8, c4 = (i & 255) * 4, mm = sl ? mlast : mfirst;
        *(LAS f32x4*)(MA + sl * 1024 + c4) = *(const f32x4*)(nA + mm * 1024 + c4); *(LAS f32x4*)(MBv + sl * 1024 + c4) = *(const f32x4*)(nB + mm * 1024 + c4); }
    if (F.tid < 24) cnt[F.tid] = 0;
    bf16x8v Bh[4][2], Bl[4][2];
    { const float* rgw = PIN(I_RGW) + (size_t)layer * 1024 * 4; const float* rew = PIN(I_REW) + (size_t)layer * 1024 * 16;
#pragma unroll
      for (int s = 0; s < 4; ++s)
#pragma unroll
          for (int t = 0; t < 2; ++t) { const int n = 16 * t + r16, kb = k0w + 32 * s + 8 * g; unsigned hw[4], lw[4];
#pragma unroll
              for (int i2 = 0; i2 < 4; ++i2) { float w0 = 0.f, w1 = 0.f;
                  if (n < 4) { w0 = rgw[(kb + 2 * i2) * 4 + n]; w1 = rgw[(kb + 2 * i2 + 1) * 4 + n]; } else if (n < 20) { w0 = rew[(kb + 2 * i2) * 16 + n - 4]; w1 = rew[(kb + 2 * i2 + 1) * 16 + n - 4]; }
                  const unsigned hp = pk2(w0, w1); hw[i2] = hp; lw[i2] = pk2(w0 - bflo(hp), w1 - bfhi(hp)); }
              Bh[s][t] = __builtin_bit_cast(bf16x8v, (v4u){hw[0], hw[1], hw[2], hw[3]}); Bl[s][t] = __builtin_bit_cast(bf16x8v, (v4u){lw[0], lw[1], lw[2], lw[3]}); } }
    float biasn = 0.f; { const int n = F.tid & 31; if (n < 4) biasn = PIN(I_RGB)[layer * 4 + n]; else if (n < 20) biasn = PIN(I_REB)[layer * 16 + n - 4]; }
    v4i* ROUTE = (v4i*)(ws + WS_ROUTE);
    __syncthreads();
#ifdef ROUTE_PREFETCH
#define ROUTE_SRC(G0) ({ const int idx_ = ((G0) + r16) < ib1 ? (G0) + r16 : ib1 - 1; const int r_ = latent_only ? row_of_latent(idx_) : idx_; const int b_ = r_ / RPB, j_ = r_ - b_ * RPB; \
        ((j_ < L_CTX) ? csrc + (size_t)(b_ * L_CTX + j_) * DM : xsrc + (size_t)(b_ * T_LAT + j_ - L_CTX) * DM) + k0w + 8 * g; })
    f32x4 xv[4][2], xn[4][2];
    if (ib0 < ib1) { const float* s0 = ROUTE_SRC(ib0);
#pragma unroll
        for (int s = 0; s < 4; ++s) { xv[s][0] = *(const f32x4*)(s0 + 32 * s); xv[s][1] = *(const f32x4*)(s0 + 32 * s + 4); } }
#endif
    for (int g0 = ib0; g0 < ib1; g0 += 16) {
        const bool valid = (g0 + r16) < ib1; const int idx = valid ? g0 + r16 : ib1 - 1;
        const int r = latent_only ? row_of_latent(idx) : idx;
        const int b = r / RPB, j = r - b * RPB, m = (j < L_CTX) ? 16 : b, slot = (m != mfirst) ? 1024 : 0;
        float ss = 0.f;
#ifdef ROUTE_PREFETCH
        { const float* s1 = ROUTE_SRC(g0 + 16 < ib1 ? g0 + 16 : g0);
#pragma unroll
          for (int s = 0; s < 4; ++s) { xn[s][0] = *(const f32x4*)(s1 + 32 * s); xn[s][1] = *(const f32x4*)(s1 + 32 * s + 4); } }
#else
        const float* src = ((j < L_CTX) ? csrc + (size_t)(b * L_CTX + j) * DM : xsrc + (size_t)(b * T_LAT + j - L_CTX) * DM) + k0w + 8 * g;
        f32x4 xv[4][2];
#pragma unroll
        for (int s = 0; s < 4; ++s) { xv[s][0] = LDNT((const f32x4*)(src + 32 * s)); xv[s][1] = LDNT((const f32x4*)(src + 32 * s + 4)); }
#endif
#pragma unroll
        for (int s = 0; s < 4; ++s)
#pragma unroll
            for (int hh = 0; hh < 2; ++hh) { const f32x4 x = xv[s][hh]; ss += (x.x * x.x + x.y * x.y) + (x.z * x.z + x.w * x.w); }
        ss += xshf<16>(ss); ss = half_sum(ss);
        if (lane < 16) SSP[wv * 16 + lane] = ss;
        __syncthreads();
        float tot = 0.f;
#pragma unroll
        for (int w2 = 0; w2 < 8; ++w2) tot += SSP[w2 * 16 + r16];
        const float rstd = __builtin_amdgcn_rsqf(tot * (1.0f / DM) + NORM_EPS);
        f32x4v acc[2] = {{0.f, 0.f, 0.f, 0.f}, {0.f, 0.f, 0.f, 0.f}};
        unsigned char* drow = (unsigned char*)dst + (size_t)r * DM + k0w + 8 * g;
#pragma unroll
        for (int s = 0; s < 4; ++s) { const int co = slot + k0w + 32 * s + 8 * g;
            const f32x4 h0 = xv[s][0] * rstd * *(const LAS f32x4*)(MA + co) + *(const LAS f32x4*)(MBv + co), h1 = xv[s][1] * rstd * *(const LAS f32x4*)(MA + co + 4) + *(const LAS f32x4*)(MBv + co + 4);
            { v2u o; o.x = pk4_fp8(h0.x, h0.y, h0.z, h0.w); o.y = pk4_fp8(h1.x, h1.y, h1.z, h1.w); *(v2u*)(drow + 32 * s) = o; }
            const unsigned p0 = pk2(h0.x, h0.y), p1 = pk2(h0.z, h0.w), p2 = pk2(h1.x, h1.y), p3 = pk2(h1.z, h1.w);
            const unsigned q0 = pk2(h0.x - bflo(p0), h0.y - bfhi(p0)), q1 = pk2(h0.z - bflo(p1), h0.w - bfhi(p1)), q2 = pk2(h1.x - bflo(p2), h1.y - bfhi(p2)), q3 = pk2(h1.z - bflo(p3), h1.w - bfhi(p3));
            const bf16x8v Ah = __builtin_bit_cast(bf16x8v, (v4u){p0, p1, p2, p3}), Al = __builtin_bit_cast(bf16x8v, (v4u){q0, q1, q2, q3});
#pragma unroll
            for (int t = 0; t < 2; ++t) { acc[t] = __builtin_amdgcn_mfma_f32_16x16x32_bf16(Ah, Bh[s][t], acc[t], 0, 0, 0); acc[t] = __builtin_amdgcn_mfma_f32_16x16x32_bf16(Ah, Bl[s][t], acc[t], 0, 0, 0);
                acc[t] = __builtin_amdgcn_mfma_f32_16x16x32_bf16(Al, Bh[s][t], acc[t], 0, 0, 0); } }
#pragma unroll
        for (int t = 0; t < 2; ++t)
#pragma unroll
            for (int x = 0; x < 4; ++x) PART[(wv * 16 + 4 * g + x) * 32 + 16 * t + r16] = acc[t][x];
        __syncthreads();
        { const int row = F.tid >> 5, n = F.tid & 31; float v = biasn;
#pragma unroll
          for (int w2 = 0; w2 < 8; ++w2) v += PART[(w2 * 16 + row) * 32 + n];
          LOG[row * 32 + n] = v; }
        __syncthreads();
        if (F.tid < 16 && (g0 + F.tid) < ib1) {
            const int rr = latent_only ? row_of_latent(g0 + F.tid) : g0 + F.tid;
            float l[20];
#pragma unroll
            for (int jj = 0; jj < 20; ++jj) l[jj] = LOG[F.tid * 32 + jj];
            int gsel = 0; float gm = l[0];
#pragma unroll
            for (int q = 1; q < 4; ++q) if (l[q] > gm) { gm = l[q]; gsel = q; }
            float gs = 0.f;
#pragma unroll
            for (int q = 0; q < 4; ++q) gs += __expf(l[q] - gm);
            const float gp = 1.0f / gs;
            float le[4];
#pragma unroll
            for (int q = 0; q < 4; ++q) le[q] = (gsel == 0) ? l[4 + q] : (gsel == 1) ? l[8 + q] : (gsel == 2) ? l[12 + q] : l[16 + q];
            int e1 = 0; float m1 = le[0];
#pragma unroll
            for (int q = 1; q < 4; ++q) if (le[q] > m1) { m1 = le[q]; e1 = q; }
            int e2 = -1; float m2 = 0.f;
#pragma unroll
            for (int q = 0; q < 4; ++q) if (q != e1 && (e2 < 0 || le[q] > m2)) { m2 = le[q]; e2 = q; }
            const float bexp = __expf(m2 - m1), w1 = gp / (1.0f + bexp), w2 = gp * bexp / (1.0f + bexp);
            const int ea = e1 < e2 ? e1 : e2, eb = e1 < e2 ? e2 : e1; const float wa = e1 < e2 ? w1 : w2, wb = e1 < e2 ? w2 : w1;
            const int pidx = ea == 0 ? eb - 1 : (ea == 1 ? eb + 1 : 5), bucket = gsel * 6 + pidx;
            const int rank = atomicAdd((int*)(cnt + bucket), 1); ROUTE[rr] = (v4i){bucket, rank, __builtin_bit_cast(int, wa), __builtin_bit_cast(int, wb)};
        }
#ifdef ROUTE_PREFETCH
#pragma unroll
        for (int s = 0; s < 4; ++s) { xv[s][0] = xn[s][0]; xv[s][1] = xn[s][1]; }
#endif
    }
#ifdef ROUTE_PREFETCH
#undef ROUTE_SRC
#endif
    __syncthreads();
    if (F.tid < 24) ((int*)(ws + WS_BCNT))[blockIdx.x * 24 + F.tid] = cnt[F.tid];
    __syncthreads();
}

__device__ __forceinline__ void phase_scatter(Frame& F, bool latent_only) {
    unsigned char* const ws = PWS;
    LAS int* tab = (LAS int*)(F.lds + TAB_OFF);
    const int* BC = (const int*)(ws + WS_BCNT);
    if (F.tid < 384) { const int k = F.tid >> 4, part = F.tid & 15; int tot = 0, below = 0;
        for (int bb = part * 16; bb < part * 16 + 16 && bb < F.G; ++bb) { const int v = BC[bb * 24 + k]; tot += v; if (bb < (int)blockIdx.x) below += v; }
        tot += xshi<1>(tot); tot += xshi<2>(tot); tot += xshi<4>(tot); tot += xshi<8>(tot); below += xshi<1>(below); below += xshi<2>(below); below += xshi<4>(below); below += xshi<8>(below);
        if (part == 0) { tab[32 + k] = tot; tab[k] = below; } }
    __syncthreads();
    if (F.tid == 0) { int tb = 0; for (int k = 0; k < 24; ++k) { const int nt = (tab[32 + k] + 255) >> 8; tab[64 + k] = tb; tab[96 + k] = nt; tab[k] += tb * 256; tb += nt; } tab[128] = tb; }
    __syncthreads();
    v4i* ROWINFO = (v4i*)(ws + WS_ROWINFO);
    if (blockIdx.x == 0) { int* TI = (int*)(ws + WS_TILEINFO); if (F.tid == 0) TI[0] = tab[128];
        if (F.tid < 24) { const int t0 = tab[64 + F.tid], nt = tab[96 + F.tid]; for (int t = 0; t < nt; ++t) TI[1 + t0 + t] = F.tid; } }
    for (int k = blockIdx.x; k < 24; k += F.G) { const int p0 = tab[64 + k] * 256 + tab[32 + k], p1 = (tab[64 + k] + tab[96 + k]) * 256;
        for (int p = p0 + F.tid; p < p1; p += NTHR) ROWINFO[p] = (v4i){-1, 0, 0, 0}; }
    const int nrows = latent_only ? NB * T_LAT : MROWS, NGW = F.G * NWAVES, RPW = (nrows + NGW - 1) / NGW, gwb = (int)blockIdx.x * NWAVES + F.wave;
    const v4i* ROUTE = (const v4i*)(ws + WS_ROUTE);
    { const int i0 = gwb * RPW, i1 = (i0 + RPW < nrows) ? i0 + RPW : nrows;
      if (i0 + F.lane < i1) { const int idx = i0 + F.lane, r = latent_only ? row_of_latent(idx) : idx; const v4i ri = ROUTE[r]; ROWINFO[tab[ri.x] + ri.y] = (v4i){r, ri.z, ri.w, 0}; } }
    __syncthreads();
}
#if DEBUG_CHECK
__device__ __forceinline__ unsigned dbg_hash(unsigned x) { x ^= x >> 16; x *= 0x7feb352du; x ^= x >> 15; x *= 0x846ca68bu; x ^= x >> 16; return x; }
__device__ __forceinline__ void dbg_fail(Frame& F, int bit) { atomicOr((unsigned*)(F.ctl + CW_ERR), 1u << bit); }
__device__ __forceinline__ void dbg_check_gemm_bf16(Frame& F, const bf16* A, const bf16* Bt, const bf16* O, int ldo, int bit) {
    const int s = F.vcu * NTHR + F.tid;
    if (s < 16384) { const int row = dbg_hash(2 * s + 1) % MROWS, col = dbg_hash(2 * s + 2) % 3072; float ref = 0.f;
        for (int k = 0; k < 1024; ++k) ref += bf1(A[(size_t)row * 1024 + k]) * bf1(Bt[(size_t)col * 1024 + k]);
        const float got = bf1(O[(size_t)row * ldo + col]);
        if (!(fabsf(got - ref) <= 0.02f * fabsf(ref) + 0.05f)) dbg_fail(F, bit); }
}
__device__ __forceinline__ float naive_attn_row(Frame& F, const bf16* P, int b, int h, int j) {
    LAS float* pl = (LAS float*)(F.lds) + F.wave * 2304;
    const bf16* Pb = P + (size_t)b * RPB * NPROJ; const bf16* q = Pb + (size_t)j * NPROJ + C_AQ + h * 64;
    const int nk = (j < L_CTX) ? 4 : 36;
    float sc[36]; float mx = -1e30f;
#pragma unroll
    for (int i = 0; i < 36; ++i) { sc[i] = -1e30f; if (i < nk) { const bf16* k = Pb + (size_t)(i * 64 + F.lane) * NPROJ + C_AK + (h >> 1) * 64; float a = 0.f;
        for (int d = 0; d < 64; ++d) a += bf1(q[d]) * bf1(k[d]);
        sc[i] = a; mx = fmaxf(mx, a); } }
    mx = fmaxf(mx, xshf<1>(mx)); mx = fmaxf(mx, xshf<2>(mx)); mx = fmaxf(mx, xshf<4>(mx)); mx = fmaxf(mx, xshf<8>(mx)); mx = fmaxf(mx, xshf<16>(mx));
    mx = half_max(mx);
    float sum = 0.f;
#pragma unroll
    for (int i = 0; i < 36; ++i) { const float p = (i < nk) ? exp2f(sc[i] - mx) : 0.f; sum += p; pl[i * 64 + F.lane] = p; }
    sum = wave_sum(sum); LDS_WAIT(); asm volatile("" ::: "memory");
    float o = 0.f;
    for (int key = 0; key < nk * 64; ++key) o += pl[key] * bf1(Pb[(size_t)key * NPROJ + C_AV + (h >> 1) * 64 + F.lane]);
    LDS_WAIT(); asm volatile("" ::: "memory");
    return o / sum;
}
__device__ __forceinline__ void dbg_check_attn(Frame& F, const bf16* P, const bf16* ACT_, int bit, bool with_ctx) {
    const int s = F.vcu * NWAVES + F.wave;
    const int b = dbg_hash(3 * s + 1) % NB, h = dbg_hash(3 * s + 2) % 4; int j = L_CTX + dbg_hash(3 * s + 3) % T_LAT;
    if (with_ctx && (s & 7) == 0) j = dbg_hash(3 * s + 3) % L_CTX;
    const float o = naive_attn_row(F, P, b, h, j);
    const float got = bf1(ACT_[(size_t)(b * RPB + j) * DM + 768 + h * 64 + F.lane]);
    if (!(fabsf(got - o) <= 0.03f * fabsf(o) + 0.02f)) dbg_fail(F, j < L_CTX ? bit + 1 : bit);
    __syncthreads();
}
__device__ __forceinline__ void dbg_check_outproj(Frame& F, const float* xsrc, const float* xdst, const bf16* ACT_, const bf16* Wt, const float* gate, int bit) {
    const int s = F.vcu * NTHR + F.tid;
    if (s < 16384) { const int idx = dbg_hash(2 * s + 5) % (NB * T_LAT), col = dbg_hash(2 * s + 6) % DM, r = row_of_latent(idx), b = idx >> 11; float ref = 0.f;
        for (int k = 0; k < 1024; ++k) ref += bf1(ACT_[(size_t)r * 1024 + k]) * bf1(Wt[(size_t)col * 1024 + k]);
        ref = xsrc[(size_t)idx * DM + col] + gate[b * 1024 + col] * ref;
        const float got = xdst[(size_t)idx * DM + col];
        if (!(fabsf(got - ref) <= 0.01f * fabsf(ref) + 0.01f)) dbg_fail(F, bit); }
}
__device__ __forceinline__ void dbg_check_gateup(Frame& F, const unsigned char* A8, const unsigned char* Wgu8, const unsigned char* H8, const v4i* rowinfo, const LAS int* tileb, int ntiles, int bit) {
    const int s = F.vcu * NTHR + F.tid;
    if (s < 16384) { const int pos = dbg_hash(2 * s + 7) % (ntiles * 256), hc = dbg_hash(2 * s + 8) % 1024; const v4i ri = rowinfo[pos];
        if (ri.x >= 0) { const int k = tileb[pos >> 8], g = k / 6, pr = k % 6; const int ea = pr < 3 ? 0 : (pr < 5 ? 1 : 2), eb = pr < 3 ? pr + 1 : (pr < 5 ? pr - 1 : 3);
            const int e = g * 4 + (hc < 512 ? ea : eb), jj = hc & 511; const float wgt = __builtin_bit_cast(float, hc < 512 ? ri.y : ri.z);
            const unsigned char* wg = Wgu8 + ((size_t)e * 1024 + (jj >> 7) * 256 + (jj & 127)) * 1024; const unsigned char* wu = wg + 128 * 1024; float ga = 0.f, up = 0.f;
            for (int q = 0; q < 1024; ++q) { const float a = fp8_dec(A8[(size_t)ri.x * 1024 + q]); ga += a * fp8_dec(wg[q]); up += a * fp8_dec(wu[q]); }
            const float ref = 16.0f * siluf(ga * (1.0f / 32.0f)) * (up * (1.0f / 32.0f)) * wgt, got = fp8_dec(H8[(size_t)pos * 1024 + hc]);
            if (!(fabsf(got - ref) <= 0.08f * fabsf(ref) + 0.02f)) dbg_fail(F, bit); } }
}
__device__ __forceinline__ void dbg_check_mix(Frame& F, const bf16* P, const bf16* act, const float* lblog, const float* rdec, const float* hn, const float* rn) {
    const int s = F.vcu * NWAVES + F.wave, lane = F.lane;
    const int mixer = s & 1, b = dbg_hash(5 * s + 1) % NB, h = dbg_hash(5 * s + 2) % 4, j = L_CTX + dbg_hash(5 * s + 3) % T_LAT;
    float osum = 0.f;
    for (int dir = 0; dir < 2; ++dir) {
        const float lb = (mixer == 0 && lblog) ? sigmf(lblog[512 + dir * 256 + h * 64 + lane] - lblog[dir * 256 + h * 64 + lane]) : 0.f;
        const float gamma = sigmf(rdec[dir * 4 + h]);
        const int nt = (dir == 0) ? j : (RPB + L_CTX - 1 - j);
        float S[64];
#pragma unroll
        for (int dd = 0; dd < 64; ++dd) S[dd] = 0.f;
        float o = 0.f;
        for (int n = 0; n <= nt; ++n) { const bf16* rp = P + (size_t)(b * RPB + rc::row_in_batch(dir, n)) * NPROJ;
            float f, k, q, v;
            if (mixer == 0) { f = lb + (1.0f - lb) * sigmf(bf1(rp[C_HZ + 256 * dir + h * 64 + lane])); k = 1.0f - f; q = bf1(rp[C_HQ + h * 64 + lane]); v = bf1(rp[C_HI + h * 64 + lane]); }
            else { f = gamma; k = bf1(rp[C_RK + h * 64 + lane]); q = 0.125f * bf1(rp[C_RQ + h * 64 + lane]); v = bf1(rp[C_RV + h * 64 + lane]); }
            o = 0.f;
#pragma unroll
            for (int dd = 0; dd < 64; ++dd) { const float fd = __builtin_bit_cast(float, __builtin_amdgcn_readlane(__builtin_bit_cast(int, f), dd)), kd = __builtin_bit_cast(float, __builtin_amdgcn_readlane(__builtin_bit_cast(int, k), dd)),
                    qd = __builtin_bit_cast(float, __builtin_amdgcn_readlane(__builtin_bit_cast(int, q), dd));
                S[dd] = fd * S[dd] + kd * v; o += qd * S[dd]; } }
        osum += o;
    }
    const float rs = 1.0f / sqrtf(wave_sum(osum * osum) * (1.0f / 64.0f) + NORM_EPS);
    const float g = bf1(P[(size_t)(b * RPB + j) * NPROJ + (mixer == 0 ? C_HG : C_RG) + h * 64 + lane]);
    const float ref = osum * rs * (mixer == 0 ? hn : rn)[h * 64 + lane] * siluf(g);
    const float got = bf1(act[(size_t)(b * RPB + j) * DM + (mixer == 0 ? 0 : 512) + h * 64 + lane]);
    const float se = wave_sum(fabsf(got - ref)), sr = wave_sum(fabsf(ref));
    if (!(se <= 0.03f * sr + 0.3f)) dbg_fail(F, mixer == 0 ? 6 : 7);
}
__device__ __forceinline__ void dbg_check_norm1(Frame& F, const bf16* act, const float* MODp) {
    const int s = F.vcu * NTHR + F.tid;
    if (s < 8192) { const int r = dbg_hash(2 * s + 11) % MROWS, c = dbg_hash(2 * s + 12) % DM, b = r / RPB, j = r - b * RPB, m = (j < L_CTX) ? 16 : b;
        const float* src = (j < L_CTX) ? PIN(I_CTX) + (size_t)(b * L_CTX + j) * DM : PIN(I_X) + (size_t)(b * T_LAT + j - L_CTX) * DM;
        const float* cv = (j < L_CTX) ? PIN(I_CCTX) : PIN(I_C) + b * 1024; const float* aw = PIN(I_ADAW); const float* ab = PIN(I_ADAB);
        float ss = 0.f, sh = ab[c], scl = ab[1024 + c];
        for (int k = 0; k < 1024; ++k) { ss += src[k] * src[k]; const float sv = siluf(cv[k]); sh += sv * aw[(size_t)k * 6144 + c]; scl += sv * aw[(size_t)k * 6144 + 1024 + c]; }
        const float nA = PIN(I_NMIX)[c] * (1.0f + scl);
        const float gB = MODp[0 * 17 * 1024 + m * 1024 + c], gA = MODp[1 * 17 * 1024 + m * 1024 + c];
        if (!(fabsf(gB - sh) <= 1e-3f * fabsf(sh) + 1e-3f)) dbg_fail(F, 2);
        if (!(fabsf(gA - nA) <= 1e-3f * fabsf(nA) + 1e-3f)) dbg_fail(F, 3);
        const float ref = src[c] * (1.0f / sqrtf(ss / 1024.0f + NORM_EPS)) * gA + gB;
        const float got = bf1(act[(size_t)r * DM + c]);
        if (!(fabsf(got - ref) <= 0.01f * fabsf(ref) + 0.01f)) dbg_fail(F, 4); }
}
__device__ __forceinline__ void dbg_apply(Frame& F, float* out, unsigned* barw) {
    unsigned m = __hip_atomic_load((unsigned*)(F.ctl + CW_ERR), RLX_AGENT);
    if (__hip_atomic_load(barw + XB_TMO, RLX_AGENT) != 0u) m |= 32u;
    if (m) { const float sc = 1.0f + 10.0f * exp2f(0.33219f * (float)m); for (size_t i = (size_t)F.vcu * NTHR + F.tid; i < (size_t)NB * T_LAT * DM; i += (size_t)F.G * NTHR) out[i] *= sc; }
}
#endif
#ifndef NAIVE_ATTN
#define NAIVE_ATTN 0
#endif
#if NAIVE_ATTN && DEBUG_CHECK
__device__ __forceinline__ void phase_naive_attn(Frame& F, const bf16* P, bf16* ACT_, bool latent_only) {
    const int gw = F.vcu * NWAVES + F.wave, NGW = F.G * NWAVES;
    for (int it = gw; it < MROWS * 4; it += NGW) { const int r = it >> 2, h = it & 3, b = r / RPB, j = r - b * RPB;
        if (latent_only && j < L_CTX) continue;
        const float o = naive_attn_row(F, P, b, h, j);
        ACT_[(size_t)r * DM + 768 + h * 64 + F.lane] = (bf16)f2bf(o); }
    __syncthreads();
}
#endif
#ifndef SKIPMASK
#define SKIPMASK 0
#endif
#ifdef REP_BAR
#define GRID_BAR_X() xcd_barrier(bar)
#else
#define GRID_BAR_X() do {} while (0)
#endif
#ifdef PROBE_BARTIME
#define GRID_BAR_T0() const unsigned long long tb0_ = __builtin_amdgcn_s_memrealtime()
#define GRID_BAR_T1(site) do { if ((PROBE_BARMASK >> (site)) & 1) F.bart += (unsigned)(__builtin_amdgcn_s_memrealtime() - tb0_); } while (0)
#else
#define GRID_BAR_T0() do {} while (0)
#define GRID_BAR_T1(site) do {} while (0)
#endif
#define GRID_BAR(site) do { GRID_BAR_T0(); GRID_BAR_X(); xcd_barrier(bar); GRID_BAR_T1(site); { int t_ = F.tid; asm volatile("" : "+v"(t_)); F.tid = t_; F.lane = t_ & 63; F.wave = __builtin_amdgcn_readfirstlane(t_ >> 6); } ws = PWS; } while (0)
#define ACT ((bf16*)(ws + WS_ACT))
#define P ((bf16*)(ws + WS_P))
#define CTXB ((float*)(ws + WS_CTX))
#define ORET ((bf16*)(ws + WS_ORET))
#ifdef OUTPROJ_FP8
#define ATTN_OPTR(b, h) ((attn_body::bf16*)((unsigned char*)ACT + (size_t)(b) * RPB * DM + (12 + (h)) * 128))
#else
#define ATTN_OPTR(b, h) ((attn_body::bf16*)ACT + (size_t)(b) * RPB * DM + 768 + (h) * 64)
#endif
template <int layer> __device__ __forceinline__ void layer_body(Frame& F, XcdBarrier& bar, unsigned char* lds) {
    LAS int* const tileb = (LAS int*)(F.lds + TAB_OFF + 1024);
    unsigned char* ws = PWS;
        const bool lastl = (layer == DEPTH - 1);
        const float* xsrc = (layer == 0) ? PIN(I_X) : (const float*)POUT;
        const float* csrc = (layer == 0) ? PIN(I_CTX) : (const float*)CTXB;
        const float* MOD = (const float*)(ws + WS_MOD) + (size_t)layer * 6 * 17 * 1024;
        #if !(SKIPMASK & 1)
        phase_norm1(F, xsrc, csrc, MOD + 1 * 17 * 1024, MOD + 0 * 17 * 1024, ACT, ws + WS_KVS);
#ifdef REP_N1
        phase_norm1(F, xsrc, csrc, MOD + 1 * 17 * 1024, MOD + 0 * 17 * 1024, ACT, ws + WS_KVS);
#endif
#endif

        GRID_BAR(1);
#if DEBUG_CHECK
        if (layer == 0) dbg_check_norm1(F, ACT, MOD);
#endif
        #if !(SKIPMASK & 2)
        {
            constexpr int NF8 = __builtin_popcount(INPROJ_F8MASK), NB16 = NPROJ / 256 - NF8;
            unsigned long long map16 = 0ull, map8 = 0ull; { int j16 = 0, j8 = 0; for (int t = 0; t < NPROJ / 256; ++t) { if ((INPROJ_F8MASK >> t) & 1) map8 |= (unsigned long long)t << (4 * j8++); else map16 |= (unsigned long long)t << (4 * j16++); } }
            pg8::Gemm g{DM, DM, DM, nullptr}; DenseOrder S; S.init(NPANEL, NB16, F.G, (int)blockIdx.x, 0, ACT, (const bf16*)(ws + WS_W0 + (size_t)layer * WLAYER + WO_WIN), DM, DM); S.pnmap = map16;
            EpiStore E{P, NPROJ, 1.0f};
#ifndef REP_INPROJ
#define REP_INPROJ 1
#endif
            pg8::gemm_phase<EpiStore, DenseOrder, false, true>(F.lds + RING_OFF, g, S, E, F.tid);
            if (NF8 > 0) {
                pg8::Gemm g8{512, 512, 512, nullptr}; DenseOrder S8; const int c8 = ((int)blockIdx.x + F.G - (NPANEL * NB16) % F.G) % F.G;
                S8.init(NPANEL, NF8, F.G, c8, 0, ws + WS_KVS, (const bf16*)(ws + WS_W0 + (size_t)layer * WLAYER + WO_WIN), 512, 512); S8.tB = 524288; S8.pnmap = map8;
                EpiStore E8{P, NPROJ, 1.0f / 32.0f};
                pg8::gemm_phase<EpiStore, DenseOrder, false, true, false, true>(F.lds + RING_OFF, g8, S8, E8, F.tid);
#if defined(REP_F8)
                __syncthreads();
                pg8::gemm_phase<EpiStore, DenseOrder, false, true, false, true>(F.lds + RING_OFF, g8, S8, E8, F.tid);
#endif
            }
#if REP_INPROJ == 2
            __syncthreads();
            pg8::gemm_phase<EpiStore, DenseOrder, false, true>(F.lds + RING_OFF, g, S, E, F.tid);
#endif
        }
#endif

        GRID_BAR(2);
#if DEBUG_CHECK
        dbg_check_gemm_bf16(F, ACT, (const bf16*)(ws + WS_W0 + (size_t)layer * WLAYER + WO_WIN), P, NPROJ, 0);
#endif
        #if !(SKIPMASK & 4)
        phase_prep(F, P, PIN(I_QN) + layer * 64, PIN(I_KN) + layer * 64, (const float*)(ws + WS_ROPE), (const float*)(ws + WS_ROPE) + 2048 * 32);
#ifdef REP_PREP
        phase_prep<true>(F, P, PIN(I_QN) + layer * 64, PIN(I_KN) + layer * 64, (const float*)(ws + WS_ROPE), (const float*)(ws + WS_ROPE) + 2048 * 32);
#endif
#endif

#ifdef SPLIT_MIX
#define LAUNDER_TID() do { int t_ = F.tid; asm volatile("" : "+v"(t_)); F.tid = t_; F.lane = t_ & 63; F.wave = __builtin_amdgcn_readfirstlane(t_ >> 6); ws = PWS; } while (0)
        xcd_split_arrive(bar, (unsigned*)(F.ctl + CW_BAR4));
        {
            bf16* KVS = (bf16*)(ws + WS_KVS); float* DBUF = (float*)(ws + WS_DBUF); const float* lbl = (layer == 0) ? nullptr : PIN(I_LB); const float* rdec = PIN(I_RDEC) + layer * 8;
            recur_stageA_loop(F, P, KVS, DBUF, F.vcu * NWAVES + F.wave, F.G * NWAVES, 256 * 36, lbl, rdec);
        }
        xcd_split_arrive(bar, (unsigned*)(F.ctl + CW_BAR5));
        xcd_split_wait(bar, (unsigned*)(F.ctl + CW_BAR4), (unsigned)layer + 1u);
        LAUNDER_TID();
        {
            const int nunits = lastl ? 512 : 576;
            for (int ui = 0; ; ++ui) {
                const int u = F.vcu + ui * F.G;
                if (ui == 1) {
                    xcd_split_wait(bar, (unsigned*)(F.ctl + CW_BAR5), (unsigned)layer + 1u);
                    LAUNDER_TID();
                    { bf16* KVS = (bf16*)(ws + WS_KVS); const float* DBUF = (const float*)(ws + WS_DBUF); const float* rdec = PIN(I_RDEC) + layer * 8;
                      for (int seq = F.vcu; seq < 256; seq += F.G) { const int mixer = seq >> 7, h = (seq >> 1) & 3, dir = seq & 1;
                          if (mixer == 0) recur_stageB_seq<0>(F, KVS, DBUF, seq, 0.f); else recur_stageB_seq<1>(F, KVS, DBUF, seq, sigmf(rdec[dir * 4 + h])); } }
                    xcd_split_arrive(bar, (unsigned*)(F.ctl + CW_BAR2));
                    LAUNDER_TID();
                }
                if (u >= nunits) break;
                int b, h, qb; if (u < 512) { b = u >> 5; h = (u >> 3) & 3; qb = 1 + (u & 7); } else { b = (u - 512) >> 2; h = u & 3; qb = 0; }
                const attn_body::bf16* Pb = (const attn_body::bf16*)P + (size_t)b * RPB * NPROJ;
                attn_body::attn_unit<8>(qb * 256, qb == 0 ? 4 : 36, Pb + C_AQ + h * 64, Pb + C_AK + (h >> 1) * 64, Pb + C_AV + (h >> 1) * 64,
                                        ATTN_OPTR(b, h), (char*)lds + RING_OFF, F.tid);
            }
        }
#else
        {
            bf16* KVS = (bf16*)(ws + WS_KVS); float* DBUF = (float*)(ws + WS_DBUF); const float* lbl = (layer == 0) ? nullptr : PIN(I_LB); const float* rdec = PIN(I_RDEC) + layer * 8;
#ifndef REP_A
#define REP_A 1
#endif
            for (int rp_REP_A = 0; rp_REP_A < REP_A; ++rp_REP_A)
            recur_stageA_loop(F, P, KVS, DBUF, F.vcu * NWAVES + F.wave, F.G * NWAVES, 256 * 36, lbl, rdec);
        }
        GRID_BAR(3);
        {
            { bf16* KVS = (bf16*)(ws + WS_KVS); const float* DBUF = (const float*)(ws + WS_DBUF); const float* rdec = PIN(I_RDEC) + layer * 8;
#ifndef REP_B
#define REP_B 1
#endif
            for (int rp_REP_B = 0; rp_REP_B < REP_B; ++rp_REP_B)
              for (int seq = F.vcu; seq < 256; seq += F.G) { const int mixer = seq >> 7, h = (seq >> 1) & 3, dir = seq & 1;
                  if (mixer == 0) recur_stageB_seq<0>(F, KVS, DBUF, seq, 0.f); else recur_stageB_seq<1>(F, KVS, DBUF, seq, sigmf(rdec[dir * 4 + h])); } }
#ifdef REP_BDRY
            { bf16* KVS = (bf16*)(ws + WS_KVS); const float* DBUF = (const float*)(ws + WS_DBUF); const float* rdec = PIN(I_RDEC) + layer * 8;
              for (int seq = F.vcu; seq < 256; seq += F.G) { const int mixer = seq >> 7, h = (seq >> 1) & 3, dir = seq & 1;
                  if (mixer == 0) recur_stageB_seq<0, true>(F, KVS, DBUF, seq, 0.f); else recur_stageB_seq<1, true>(F, KVS, DBUF, seq, sigmf(rdec[dir * 4 + h])); } }
#endif

#ifdef SPLIT_BC
            xcd_split_arrive(bar, (unsigned*)(F.ctl + CW_BAR2));
#endif
#if NAIVE_ATTN && DEBUG_CHECK
            phase_naive_attn(F, P, ACT, lastl);
#elif !(SKIPMASK & 16)
        const int nunits = lastl ? 512 : 576;
#ifndef REP_ATTN
#define REP_ATTN 1
#endif
            for (int rep_ = 0; rep_ < REP_ATTN; ++rep_)
            for (int u = F.vcu; u < nunits; u += F.G) {
                int b, h, qb; if (u < 512) { b = u >> 5; h = (u >> 3) & 3; qb = 1 + (u & 7); } else { b = (u - 512) >> 2; h = u & 3; qb = 0; }
                const attn_body::bf16* Pb = (const attn_body::bf16*)P + (size_t)b * RPB * NPROJ;
                attn_body::attn_unit<8>(qb * 256, qb == 0 ? 4 : 36, Pb + C_AQ + h * 64, Pb + C_AK + (h >> 1) * 64, Pb + C_AV + (h >> 1) * 64,
                                        ATTN_OPTR(b, h), (char*)lds + RING_OFF, F.tid);
            }
#endif

        }
#endif
#ifdef SPLIT_BC
        xcd_split_wait(bar, (unsigned*)(F.ctl + CW_BAR2), (unsigned)layer + 1u);
        { int t_ = F.tid; asm volatile("" : "+v"(t_)); F.tid = t_; F.lane = t_ & 63; F.wave = __builtin_amdgcn_readfirstlane(t_ >> 6); } ws = PWS;
#else
        GRID_BAR(4);
#endif
        {
            const bf16* KVS = (const bf16*)(ws + WS_KVS); const float* lbl = (layer == 0) ? nullptr : PIN(I_LB); const float* rdec = PIN(I_RDEC) + layer * 8;
            const float* hn = PIN(I_HNORM) + layer * 256; const float* rn = PIN(I_RNORM) + layer * 256;
            const int ntb = lastl ? 32 : 36;
#ifndef REP_C
#define REP_C 1
#endif
            for (int rp_REP_C = 0; rp_REP_C < REP_C; ++rp_REP_C)
            recur_stageC_loop(F, P, KVS, ACT, F.vcu & 7, F.vcu >> 3, (F.G >= 8) ? (F.G >> 3) : 1, 16 * ntb, ntb, lastl ? 4 : 0, lbl, rdec, hn, rn);
            phase_conv(F, P, ACT, PIN(I_CONVW) + layer * 768, lastl);
#ifdef REP_CONV
            phase_conv(F, P, ACT, PIN(I_CONVW) + layer * 768, lastl);
#endif
        }
        GRID_BAR(5);
#if DEBUG_CHECK
        dbg_check_mix(F, P, ACT, layer == 0 ? nullptr : PIN(I_LB), PIN(I_RDEC) + layer * 8, PIN(I_HNORM) + layer * 256, PIN(I_RNORM) + layer * 256);
#endif
#if DEBUG_CHECK
        dbg_check_attn(F, P, ACT, 1, !lastl);
#endif
        #if !(SKIPMASK & 64)
        {
#ifdef OUTPROJ_FP8
            pg8::Gemm g{512, 512, 512, nullptr}; DenseOrder S; S.init(lastl ? NB * 8 : NPANEL, 4, F.G, (int)blockIdx.x, lastl ? 1 : 0, ACT, (const bf16*)(ws + WS_W0 + (size_t)layer * WLAYER + WO_WOUT), 512, 512);
            EpiResid E{xsrc, csrc, POUT, CTXB, MOD + 2 * 17 * 1024, 1.0f / 128.0f};
            pg8::gemm_phase<EpiResid, DenseOrder, true, true, false, true, true>(F.lds + RING_OFF, g, S, E, F.tid);
#else
            pg8::Gemm g{DM, DM, DM, nullptr}; DenseOrder S; S.init(lastl ? NB * 8 : NPANEL, 4, F.G, (int)blockIdx.x, lastl ? 1 : 0, ACT, (const bf16*)(ws + WS_W0 + (size_t)layer * WLAYER + WO_WOUT), DM, DM);
            EpiResid E{xsrc, csrc, POUT, CTXB, MOD + 2 * 17 * 1024, 1.0f};
            pg8::gemm_phase<EpiResid, DenseOrder, true, true>(F.lds + RING_OFF, g, S, E, F.tid);
#endif
        }
        if (layer == 0) {
            __syncthreads();
#ifdef SPLIT_OP
            xcd_split_arrive(bar, (unsigned*)(F.ctl + CW_BAR4));
#endif
            constexpr int PL = 1792 + 512 + 3 * 4096;
#ifdef CONV_SPLIT64
            if (F.G == 256) { const int c = (int)blockIdx.x;
                if (c < 64) convert_weights_range(F, PL, PL + CONV_SPLIT64, c * NWAVES + F.wave, 64 * NWAVES);
                else convert_weights_range(F, PL + CONV_SPLIT64, 2 * PL, (c - 64) * NWAVES + F.wave, 192 * NWAVES); }
            else convert_weights_range(F, PL, 2 * PL, F.vcu * NWAVES + F.wave, F.G * NWAVES);
#else
            const int nb = (int)blockIdx.x - 64, nw = (F.G - 64) * NWAVES;
            if (F.G > 64) convert_weights_range(F, PL, 2 * PL, nb >= 0 ? nb * NWAVES + F.wave : -1, nw);
            else convert_weights_range(F, PL, 2 * PL, F.vcu * NWAVES + F.wave, F.G * NWAVES);
#endif
            __syncthreads();
        }
#endif

#ifdef SPLIT_OP
        if (layer == 0) { xcd_split_wait(bar, (unsigned*)(F.ctl + CW_BAR4), 1u); { int t_ = F.tid; asm volatile("" : "+v"(t_)); F.tid = t_; F.lane = t_ & 63; F.wave = __builtin_amdgcn_readfirstlane(t_ >> 6); } ws = PWS; }
        else GRID_BAR(6);
#else
        GRID_BAR(6);
#endif
#if DEBUG_CHECK
        if (layer == 0) dbg_check_outproj(F, PIN(I_X), POUT, ACT, (const bf16*)(ws + WS_W0 + (size_t)layer * WLAYER + WO_WOUT), MOD + 2 * 17 * 1024, 3);
        GRID_BAR(6);
#endif
        #if !(SKIPMASK & 128)
        phase_norm2_route(F, layer, (const float*)POUT, (const float*)CTXB, MOD + 4 * 17 * 1024, MOD + 3 * 17 * 1024, ACT, lastl);
#ifdef REP_N2
        phase_norm2_route(F, layer, (const float*)POUT, (const float*)CTXB, MOD + 4 * 17 * 1024, MOD + 3 * 17 * 1024, ACT, lastl);
#endif
#endif

        GRID_BAR(7);
        #if !(SKIPMASK & 256)
        phase_scatter(F, lastl);
#ifdef REP_N2
        phase_scatter(F, lastl);
#endif
#endif

        GRID_BAR(8);
#ifdef MOE_SPLIT
        {
            const int* TI = (const int*)(ws + WS_TILEINFO); const int ntiles = TI[0], T1 = ntiles >> 1;
            for (int i = F.tid; i < MAXTILES; i += NTHR) tileb[i] = (i < ntiles) ? TI[1 + i] : 0;
            __syncthreads();
            int dealt = 0;
#pragma nounroll
            for (int part = 0; part < 2; ++part) {
                const int t0 = part ? T1 : 0, ntp = part ? ntiles - T1 : T1;
                pg8::Gemm g{512, 512, 512, nullptr}; g.rowidx = (const int*)(ws + WS_ROWINFO);
                MoeOrder S; S.pm0 = t0; S.ncol = 8; S.nwg = ntp * 8; S.G = F.G; S.c = ((int)blockIdx.x + F.G - dealt % F.G) % F.G; S.down = 0; S.tileb = tileb; S.A = (const char*)(ws + WS_ACT); S.W = (const char*)(ws + WS_W0 + (size_t)layer * WLAYER + WO_WGU);
                EpiGateUp E{ws + WS_H, (const v4i*)(ws + WS_ROWINFO)};
                pg8::gemm_phase<EpiGateUp, MoeOrder, true, true, true, true>(F.lds + RING_OFF, g, S, E, F.tid);
                dealt += ntp * 8;
                xcd_split_arrive(bar, (unsigned*)(F.ctl + (part ? CW_BAR4 : CW_BAR3)));
            }
#pragma nounroll
            for (int part = 0; part < 2; ++part) {
                xcd_split_wait(bar, (unsigned*)(F.ctl + (part ? CW_BAR4 : CW_BAR3)), (unsigned)layer + 1u);
                { int t_ = F.tid; asm volatile("" : "+v"(t_)); F.tid = t_; F.lane = t_ & 63; F.wave = __builtin_amdgcn_readfirstlane(t_ >> 6); } ws = PWS;
                const int t0 = part ? T1 : 0, ntp = part ? ntiles - T1 : T1;
                pg8::Gemm g{512, 1024, 512, nullptr};
                MoeOrder S; S.pm0 = t0; S.ncol = 4; S.nwg = ntp * 4; S.G = F.G; S.c = ((int)blockIdx.x + F.G - dealt % F.G) % F.G; S.down = 1; S.tileb = tileb; S.A = (const char*)(ws + WS_H); S.W = (const char*)(ws + WS_W0 + (size_t)layer * WLAYER + WO_WD);
                EpiDown E{POUT, CTXB, MOD + 5 * 17 * 1024, (const v4i*)(ws + WS_ROWINFO)};
                pg8::gemm_phase<EpiDown, MoeOrder, true, true, false, true>(F.lds + RING_OFF, g, S, E, F.tid);
                dealt += ntp * 4;
            }
        }
#else
        #if !(SKIPMASK & 512)
        {
            const int* TI = (const int*)(ws + WS_TILEINFO); const int ntiles = TI[0];
            for (int i = F.tid; i < MAXTILES; i += NTHR) tileb[i] = (i < ntiles) ? TI[1 + i] : 0;
            __syncthreads();
            pg8::Gemm g{512, 512, 512, nullptr};
            g.rowidx = (const int*)(ws + WS_ROWINFO);
            MoeOrder S; S.pm0 = 0; S.ncol = 8; S.nwg = ntiles * 8; S.G = F.G; S.c = (int)blockIdx.x; S.down = 0; S.tileb = tileb; S.A = (const char*)(ws + WS_ACT); S.W = (const char*)(ws + WS_W0 + (size_t)layer * WLAYER + WO_WGU);
            EpiGateUp E{ws + WS_H, (const v4i*)(ws + WS_ROWINFO)};
#ifndef REP_GU
#define REP_GU 1
#endif
            pg8::gemm_phase<EpiGateUp, MoeOrder, true, true, true, true>(F.lds + RING_OFF, g, S, E, F.tid);
#if REP_GU == 2
            __syncthreads();
            pg8::gemm_phase<EpiGateUp, MoeOrder, true, true, true, true>(F.lds + RING_OFF, g, S, E, F.tid);
#endif
        }
#endif

        GRID_BAR(9);
#if DEBUG_CHECK
        { const int* TI = (const int*)(ws + WS_TILEINFO); dbg_check_gateup(F, ws + WS_ACT, ws + WS_W0 + (size_t)layer * WLAYER + WO_WGU, ws + WS_H, (const v4i*)(ws + WS_ROWINFO), tileb, TI[0], 4); }
#endif
        #if !(SKIPMASK & 1024)
        {
            const int* TI = (const int*)(ws + WS_TILEINFO); const int ntiles = TI[0];
            pg8::Gemm g{512, 1024, 512, nullptr};
            MoeOrder S; S.pm0 = 0; S.ncol = 4; S.nwg = ntiles * 4; S.G = F.G; S.c = (int)blockIdx.x; S.down = 1; S.tileb = tileb; S.A = (const char*)(ws + WS_H); S.W = (const char*)(ws + WS_W0 + (size_t)layer * WLAYER + WO_WD);
            EpiDown E{POUT, CTXB, MOD + 5 * 17 * 1024, (const v4i*)(ws + WS_ROWINFO)};
            pg8::gemm_phase<EpiDown, MoeOrder, true, true, false, true>(F.lds + RING_OFF, g, S, E, F.tid);
        }
#endif

#endif
#if defined(PROBE_BARTIME) || DEBUG_CHECK
        GRID_BAR(10);
#else
        if (!lastl) GRID_BAR(10);
#endif
    }
__global__ void __launch_bounds__(NTHR, 2) fwd_kernel(Args args) {
    extern __shared__ __attribute__((aligned(16))) unsigned char lds[];
    Frame F;
    F.lds = (LAS unsigned char*)lds;
    F.MISC = (volatile LAS unsigned*)(F.lds + MISC_OFF);
    F.tid = threadIdx.x; F.lane = F.tid & 63; F.wave = __builtin_amdgcn_readfirstlane(F.tid >> 6);
    F.bart = 0u; F.G = gridDim.x; { const int bx = blockIdx.x; F.vcu = (F.G % 8 == 0) ? (bx % 8) * (F.G / 8) + bx / 8 : bx; }
    F.ctl = (gu32*)(args.ws + WS_CTL);
    for (int u = F.tid; u < (LDS_BYTES - LDSCTL_OFF) / 4; u += NTHR) ((LAS unsigned*)(F.lds + LDSCTL_OFF))[u] = 0u;
    __syncthreads();
    if (F.tid == 0) { volatile LAS unsigned long long* pt = (volatile LAS unsigned long long*)(F.lds + PTAB_OFF);
#pragma unroll
        for (int i = 0; i < 24; ++i) pt[i] = (unsigned long long)args.in[i];
        pt[24] = (unsigned long long)args.out; pt[25] = (unsigned long long)(args.ws + args.ws_shift); }
    __syncthreads();
    XcdBarrier bar = xcd_barrier_post((unsigned*)(F.ctl + CW_BAR), F.MISC + 8);
    unsigned char* ws = PWS;

    #if !(SKIPMASK & 2048)
        p0_prologue(F, bar);
#endif

#ifdef SPLIT_PRO
    xcd_split_wait(bar, (unsigned*)(F.ctl + CW_BAR3), 1u);
    { int t_ = F.tid; asm volatile("" : "+v"(t_)); F.tid = t_; F.lane = t_ & 63; F.wave = __builtin_amdgcn_readfirstlane(t_ >> 6); } ws = PWS;
#else
    GRID_BAR(0);
#endif

    layer_body<0>(F, bar, lds);
    layer_body<1>(F, bar, lds);
#ifdef PROBE_BARTIME
    if (blockIdx.x == PROBE_BARTIME - 1 && F.tid == 0) { const unsigned long long ts_ = __builtin_amdgcn_s_memrealtime(); while (__builtin_amdgcn_s_memrealtime() - ts_ < 8ull * F.bart) __builtin_amdgcn_s_sleep(8); }
#endif
#if DEBUG_CHECK
    dbg_apply(F, POUT, bar.bar);
#endif
}

extern "C" void kernel_launch(void* const* d_in, const int* in_sizes, int n_in, void* d_out, int out_size, void* d_ws, size_t ws_size, hipStream_t stream) {
    static int grid = 0;
    if (grid == 0) {
        if (n_in != 24 || out_size != NB * T_LAT * DM || ws_size < WS_END) { fprintf(stderr, "kernel_launch: unexpected shapes (n_in %d, out %d, ws %zu); nothing launched\n", n_in, out_size, ws_size); grid = -1; return; }
        int dev = 0, cus = 0, per_cu = 0;
        if (hipGetDevice(&dev) != hipSuccess || hipDeviceGetAttribute(&cus, hipDeviceAttributeMultiprocessorCount, dev) != hipSuccess) { grid = -1; return; }
        if (hipFuncSetAttribute((const void*)fwd_kernel, hipFuncAttributeMaxDynamicSharedMemorySize, LDS_BYTES) != hipSuccess) { grid = -1; return; }
        if (hipOccupancyMaxActiveBlocksPerMultiprocessor(&per_cu, (const void*)fwd_kernel, NTHR, LDS_BYTES) != hipSuccess || per_cu < 1) { fprintf(stderr, "kernel_launch: occupancy query says %d blocks per CU\n", per_cu); grid = -1; return; }
        (void)hipGetLastError();
        grid = cus < 256 ? cus : 256;
    }
    if (grid < 0) return;
    if (hipMemsetAsync((char*)d_ws + WS_CTL, 0, CTL_ZERO_BYTES, stream) != hipSuccess) return;
    Args a{};
    for (int i = 0; i < 24; ++i) a.in[i] = (const float*)d_in[i];
    a.out = (float*)d_out; a.ws = (unsigned char*)d_ws;
#ifdef WS_TOP
    a.ws_shift = ((ws_size - WS_END) / (2 * MiB)) * (2 * MiB);
#endif
    hipLaunchKernelGGL(fwd_kernel, dim3(grid), dim3(NTHR), LDS_BYTES, stream, a);
}
```

```cpp
#define SPLIT_BC 1
#define EARLY_INV 1
#define FUSE_PREP 1
#define TOP_DIRECT 1

#define MOD_WIDE 1
#define SPLIT_PRO 1
#define SPLIT_OP 1


#define EMU_TILES 0

#define INPROJ_F8MASK 0x3F02

#include <hip/hip_runtime.h>
#ifdef NT_LOADS
#define LDNT(p) __builtin_nontemporal_load(p)
#else
#define LDNT(p) (*(p))
#endif
#include <hip/hip_bf16.h>
#include <cstdio>
#include <cstdint>
#include <cmath>
#ifndef DEBUG_CHECK
#define DEBUG_CHECK 0
#endif
#define DENSE_WGM 4
#ifndef NAIVE_ATTN
#define NAIVE_ATTN 0
#endif

namespace pg8 {
#define PG8_LAS __attribute__((address_space(3)))
typedef unsigned short bf16_t;
typedef short bf16x8 __attribute__((ext_vector_type(8)));
typedef float f32x4 __attribute__((ext_vector_type(4)));
typedef unsigned u32x4 __attribute__((ext_vector_type(4)));
constexpr int BM = 256, BK = 64, HALF = 128, HTB = HALF * BK * 2  , STAGE_BYTES = 8 * HTB, NXCD = 8, WGM = 8;

__host__ __device__ __forceinline__ int lds_byte(int r, int c) { const int st = (r >> 4) * 2 + (c >> 5), rr = r & 15, cc = c & 31, ob = rr * 64 + cc * 2; return st * 1024 + (ob ^ (((ob >> 9) & 1) << 5)); }
__host__ __device__ __forceinline__ void stage_rc(int b, int& R, int& C) { const int st = b / 1024, sb = b % 1024, swz = sb ^ (((sb >> 9) & 1) << 5); R = (st >> 1) * 16 + swz / 64; C = (st & 1) * 32 + (swz % 64) / 2; }
__host__ __device__ __forceinline__ void stage_rc8(int b, int& R, int& C) { const int blk = b >> 11, rr = (b >> 7) & 15, ps = (b >> 5) & 3, k = (b >> 4) & 1, gl = ps ^ ((rr >> 1) & 3); R = blk * 16 + rr; C = (gl * 2 + k) * 8; }
__host__ __device__ __forceinline__ int perm32(int rho) { const int n = rho >> 4, i = rho & 15; return 8 * (i >> 2) + 4 * n + (i & 3); }

struct Unit { const char* a; const char* b; const char* b2; int pm, pn, x0, x1; };
struct Gemm { int lda, ldb, K; const int* rowidx; };
typedef int i32x8 __attribute__((ext_vector_type(8)));
typedef int i32x4 __attribute__((ext_vector_type(4)));
__device__ __forceinline__ i32x8 pg8_cat(bf16x8 a, bf16x8 b) { const i32x4 x = __builtin_bit_cast(i32x4, a), y = __builtin_bit_cast(i32x4, b); return (i32x8){x[0], x[1], x[2], x[3], y[0], y[1], y[2], y[3]}; }
__device__ __forceinline__ unsigned cvt_pk_bf16(float lo, float hi) { unsigned r; asm volatile("v_cvt_pk_bf16_f32 %0, %1, %2" : "=v"(r) : "v"(lo), "v"(hi)); return r; }

template <class Epi, class Sched, bool ALIGN_EPI = false, bool SP2 = false, bool GATHER = false, bool FP8 = false, bool APAIR = false>
__device__ __forceinline__ void gemm_phase(PG8_LAS unsigned char* lds, const Gemm g, const Sched& S, const Epi& E, const int tid) {
    const int wid = __builtin_amdgcn_readfirstlane(tid >> 6), lane = tid & 63, wr = wid >> 2, wc = wid & 3, fr = lane & 15, fq = lane >> 4;
    const int K = g.K, nt = K / BK;
    unsigned voffA[2], voffB[2];
#pragma unroll
    for (int i = 0; i < 2; ++i) { int R, C; if constexpr (FP8) stage_rc8(tid * 16 + i * 8192, R, C); else stage_rc(tid * 16 + i * 8192, R, C); const int Rb = Epi::PERMH ? ((R >> 5) * 64 + perm32(R & 31)) : (Epi::PERM ? ((R & ~31) + perm32(R & 31)) : R);
        voffA[i] = APAIR ? (unsigned)((R >> 1) * g.lda * 4 + ((2 * C) >> 6) * 128 + (R & 1) * 64 + ((2 * C) & 63)) : (unsigned)(R * g.lda + C) * 2u; voffB[i] = (unsigned)(Rb * g.ldb + C) * 2u; }
    unsigned gc[2][2] = {{0u, 0u}, {0u, 0u}}, gn[2][2] = {{0u, 0u}, {0u, 0u}}; int gR[2] = {0, 0}, gC[2] = {0, 0};
    if constexpr (GATHER) {
#pragma unroll
        for (int i = 0; i < 2; ++i) { if constexpr (FP8) stage_rc8(tid * 16 + i * 8192, gR[i], gC[i]); else stage_rc(tid * 16 + i * 8192, gR[i], gC[i]); } }
#define PG8_GOFF(dst, pm_) do { _Pragma("unroll") for (int _h = 0; _h < 2; ++_h) _Pragma("unroll") for (int _i = 0; _i < 2; ++_i) { \
        int _r = g.rowidx[(size_t)((pm_) * 256 + _h * 128 + gR[_i]) * 4]; _r = _r < 0 ? 0 : _r; dst[_h][_i] = (unsigned)(_r * g.lda + gC[_i]) * 2u; } } while (0)
    const size_t kstep = (size_t)(BK * 2);
    const size_t kstepA = APAIR ? kstep * 2 : kstep;
    const size_t hstepA = (size_t)HALF * g.lda * 2, hstepB = (size_t)(Epi::PERMH ? 32 : HALF) * g.ldb * 2;
    const unsigned ldsw = (unsigned)wid * 1024u;
    const int aoff = FP8 ? (wr * 4) * 2048 + fr * 128 + ((fq ^ ((fr >> 1) & 3)) * 32) : lds_byte(wr * 64 + fr, fq * 8), boff = FP8 ? (wc * 2) * 2048 + fr * 128 + ((fq ^ ((fr >> 1) & 3)) * 32) : lds_byte(wc * 32 + fr, fq * 8);
#define PG8_SA(b, h) (((b) * 2 + (h)) * HTB)
#define PG8_SB(b, h) ((4 + (b) * 2 + (h)) * HTB)
#define PG8_STAGE(bufoff, gbase, voff) do { _Pragma("unroll") for (int _i = 0; _i < 2; ++_i) \
        __builtin_amdgcn_global_load_lds((const unsigned*)((const char*)(gbase) + (voff)[_i]), (PG8_LAS unsigned*)(lds + (bufoff) + ldsw + _i * 8192), 16, 0, 0); } while (0)
#define PG8_STAGE_A(bufoff, tbase, hh, NX) do { if constexpr (GATHER) { _Pragma("unroll") for (int _i = 0; _i < 2; ++_i) { const unsigned _o = (NX) ? gn[hh][_i] : gc[hh][_i]; \
        __builtin_amdgcn_global_load_lds((const unsigned*)((const char*)(tbase) + _o), (PG8_LAS unsigned*)(lds + (bufoff) + ldsw + _i * 8192), 16, 0, 0); } } \
        else { PG8_STAGE(bufoff, (tbase) + (hh) * hstepA, voffA); } } while (0)
#define PG8_LDA(dst, b, h) do { if constexpr (FP8) { _Pragma("unroll") for (int m = 0; m < 4; ++m) dst##8[m] = *(const PG8_LAS i32x8*)(lds + PG8_SA(b, h) + aoff + m * 2048); } \
        else { _Pragma("unroll") for (int m = 0; m < 4; ++m) _Pragma("unroll") for (int k = 0; k < 2; ++k) dst[m][k] = *(const PG8_LAS bf16x8*)(lds + PG8_SA(b, h) + aoff + m * 2048 + k * 1024); } } while (0)
#define PG8_LDB(dst, b, h) do { if constexpr (FP8) { _Pragma("unroll") for (int n = 0; n < 2; ++n) dst##8[n] = *(const PG8_LAS i32x8*)(lds + PG8_SB(b, h) + boff + n * 2048); } \
        else { _Pragma("unroll") for (int n = 0; n < 2; ++n) _Pragma("unroll") for (int k = 0; k < 2; ++k) dst[n][k] = *(const PG8_LAS bf16x8*)(lds + PG8_SB(b, h) + boff + n * 2048 + k * 1024); } } while (0)
#define PG8_MMA(ai, bj, At, Bt) do { __builtin_amdgcn_s_setprio(1); if constexpr (FP8) { _Pragma("unroll") for (int m = 0; m < 4; ++m) _Pragma("unroll") for (int n = 0; n < 2; ++n) \
        asm volatile("v_mfma_scale_f32_16x16x128_f8f6f4 %0, %1, %2, %0, %3, %3 op_sel_hi:[0,0,0]" : "+v"(acc[ai][bj][m][n]) : "v"(Bt##8[n]), "v"(At##8[m]), "v"(pg8_one)); }     \
        else { _Pragma("unroll") for (int m = 0; m < 4; ++m) _Pragma("unroll") for (int n = 0; n < 2; ++n) _Pragma("unroll") for (int k = 0; k < 2; ++k) \
        acc[ai][bj][m][n] = __builtin_amdgcn_mfma_f32_16x16x32_bf16(Bt[n][k], At[m][k], acc[ai][bj][m][n], 0, 0, 0); } __builtin_amdgcn_s_setprio(0); } while (0)
#define PG8_WAIT_V(n) asm volatile("s_waitcnt vmcnt(" #n ")" ::: "memory")
#define PG8_WAIT_L(n) asm volatile("s_waitcnt lgkmcnt(" #n ")" ::: "memory")
#define PG8_BAR __builtin_amdgcn_s_barrier()
#define PG8_SCHED __builtin_amdgcn_sched_barrier(0)
    Unit cur, nxt; int ui = 0;
    if (!S.next(0, cur)) return;
    f32x4 acc[2][2][4][2];
#pragma unroll
    for (int a = 0; a < 2; ++a)
#pragma unroll
        for (int b = 0; b < 2; ++b)
#pragma unroll
            for (int m = 0; m < 4; ++m)
#pragma unroll
                for (int n = 0; n < 2; ++n) acc[a][b][m][n] = (f32x4){0.f, 0.f, 0.f, 0.f};
    const int pg8_one = 0x7f7f7f7f;
    bf16x8 At[4][2], B0[2][2], B1[2][2];
    i32x8 At8[4], B08[2], B18[2];
    const char* cA = cur.a; const char* cB = cur.b; const char* cB2 = cur.b2; const int nth = nt >> 1;
    if constexpr (GATHER) { PG8_GOFF(gc, cur.pm); }
    S.a_ready(cur);
    if constexpr (SP2) {
        PG8_STAGE(PG8_SB(0, 0), cB, voffB); PG8_STAGE(PG8_SB(0, 1), cB + hstepB, voffB); PG8_STAGE_A(PG8_SA(0, 0), cA, 0, false); PG8_STAGE_A(PG8_SA(0, 1), cA, 1, false);
        if (wr == 1) PG8_BAR;
        PG8_WAIT_V(2); PG8_BAR;
        PG8_STAGE(PG8_SB(1, 0), cB + kstep, voffB); PG8_STAGE_A(PG8_SA(1, 0), cA + kstepA, 0, false); PG8_STAGE(PG8_SB(1, 1), cB + hstepB + kstep, voffB);
        PG8_WAIT_V(6); PG8_BAR;
    } else {
        PG8_STAGE(PG8_SB(0, 0), cB, voffB); PG8_STAGE_A(PG8_SA(0, 0), cA, 0, false); PG8_STAGE(PG8_SB(0, 1), cB + hstepB, voffB); PG8_STAGE_A(PG8_SA(0, 1), cA, 1, false);
        if (wr == 1) PG8_BAR;
        PG8_WAIT_V(4); PG8_BAR;
        PG8_STAGE(PG8_SB(1, 0), cB + kstep, voffB); PG8_STAGE_A(PG8_SA(1, 0), cA + kstepA, 0, false); PG8_STAGE(PG8_SB(1, 1), cB + hstepB + kstep, voffB);
        PG8_WAIT_V(6); PG8_BAR;
    }
    for (;;) {
        const bool has_next = S.next(ui + 1, nxt);
        if constexpr (GATHER) { if (has_next) { PG8_GOFF(gn, nxt.pm); } }
        const char* nA = has_next ? nxt.a : cA; const char* nB = has_next ? nxt.b : cB;
#pragma nounroll
        for (int t = 0; t < nt; t += 2) {
            const bool last = (t == nt - 2);
            const char* a1 = cA + (size_t)(t + 1) * kstepA;
            const char* a2 = last ? nA : cA + (size_t)(t + 2) * kstepA; const char* b2 = last ? nB : ((t + 2 < nth) ? cB : cB2) + (size_t)(t + 2) * kstep;
            const char* a3 = a2 + kstepA; const char* b3 = b2 + kstep;
            if (last && has_next) S.a_ready(nxt);
            if constexpr (SP2) {
            PG8_LDB(B0, 0, 0); PG8_LDB(B1, 0, 1); PG8_SCHED; PG8_LDA(At, 0, 0); PG8_STAGE_A(PG8_SA(1, 1), a1, 1, false);
            PG8_WAIT_V(8); PG8_WAIT_L(0); PG8_BAR; PG8_MMA(0, 0, At, B0); PG8_MMA(0, 1, At, B1); PG8_BAR; PG8_SCHED;
            PG8_LDA(At, 0, 1); PG8_STAGE(PG8_SB(0, 0), b2, voffB); PG8_STAGE(PG8_SB(0, 1), b2 + hstepB, voffB); PG8_STAGE_A(PG8_SA(0, 0), a2, 0, last);
            PG8_WAIT_V(8); PG8_WAIT_L(0); PG8_BAR; PG8_MMA(1, 0, At, B0); PG8_MMA(1, 1, At, B1); PG8_BAR; PG8_SCHED;
            PG8_LDB(B0, 1, 0); PG8_LDB(B1, 1, 1); PG8_SCHED; PG8_LDA(At, 1, 0); PG8_STAGE_A(PG8_SA(0, 1), a2, 1, last);
            PG8_WAIT_V(8); PG8_WAIT_L(0); PG8_BAR; PG8_MMA(0, 0, At, B0); PG8_MMA(0, 1, At, B1); PG8_BAR; PG8_SCHED;
            PG8_LDA(At, 1, 1); PG8_STAGE(PG8_SB(1, 0), b3, voffB); PG8_STAGE(PG8_SB(1, 1), b3 + hstepB, voffB); PG8_STAGE_A(PG8_SA(1, 0), a3, 0, last);
            PG8_WAIT_V(8); PG8_WAIT_L(0); PG8_BAR; PG8_MMA(1, 0, At, B0); PG8_MMA(1, 1, At, B1); PG8_BAR; PG8_SCHED;
            } else {
            PG8_LDB(B0, 0, 0); PG8_SCHED; PG8_LDA(At, 0, 0); PG8_STAGE_A(PG8_SA(1, 1), a1, 1, false);
            PG8_WAIT_L(8); PG8_BAR; PG8_WAIT_L(0); PG8_MMA(0, 0, At, B0); PG8_BAR; PG8_SCHED;
            PG8_LDB(B1, 0, 1); PG8_STAGE(PG8_SB(0, 0), b2, voffB);
            PG8_BAR; PG8_WAIT_L(0); PG8_MMA(0, 1, At, B1); PG8_BAR;
            PG8_LDA(At, 0, 1); PG8_STAGE_A(PG8_SA(0, 0), a2, 0, last);
            PG8_BAR; PG8_WAIT_L(0); PG8_MMA(1, 0, At, B0); PG8_BAR; PG8_SCHED;
            PG8_STAGE(PG8_SB(0, 1), b2 + hstepB, voffB);
            PG8_WAIT_V(6); PG8_BAR; PG8_MMA(1, 1, At, B1); PG8_BAR;
            PG8_LDB(B0, 1, 0); PG8_SCHED; PG8_LDA(At, 1, 0); PG8_STAGE_A(PG8_SA(0, 1), a2, 1, last);
            PG8_WAIT_L(8); PG8_BAR; PG8_WAIT_L(0); PG8_MMA(0, 0, At, B0); PG8_BAR; PG8_SCHED;
            PG8_LDB(B1, 1, 1); PG8_STAGE(PG8_SB(1, 0), b3, voffB);
            PG8_BAR; PG8_WAIT_L(0); PG8_MMA(0, 1, At, B1); PG8_BAR;
            PG8_LDA(At, 1, 1); PG8_STAGE_A(PG8_SA(1, 0), a3, 0, last);
            PG8_BAR; PG8_WAIT_L(0); PG8_MMA(1, 0, At, B0); PG8_BAR; PG8_SCHED;
            PG8_STAGE(PG8_SB(1, 1), b3 + hstepB, voffB);
            PG8_WAIT_V(6); PG8_BAR; PG8_MMA(1, 1, At, B1); PG8_BAR;
            }
        }
        if constexpr (FP8) asm volatile("s_nop 15\n\ts_nop 7" ::: "memory");
        if constexpr (ALIGN_EPI) { if (wr == 0) PG8_BAR; }
        if constexpr (!Epi::AFTER_DRAIN) { E(acc, cur, wr, wc, fr, fq); S.done(cur); }
        if (!has_next) break;
#pragma unroll
        for (int a = 0; a < 2; ++a)
#pragma unroll
            for (int b = 0; b < 2; ++b)
#pragma unroll
                for (int m = 0; m < 4; ++m)
#pragma unroll
                    for (int n = 0; n < 2; ++n) acc[a][b][m][n] = (f32x4){0.f, 0.f, 0.f, 0.f};
        cur = nxt; cA = nA; cB = nB; cB2 = nxt.b2; ++ui;
        if constexpr (GATHER) { _Pragma("unroll") for (int _h = 0; _h < 2; ++_h) _Pragma("unroll") for (int _i = 0; _i < 2; ++_i) gc[_h][_i] = gn[_h][_i]; }
        if constexpr (ALIGN_EPI) { if (wr == 1) PG8_BAR; }
    }
    PG8_WAIT_V(0);
    if constexpr (!ALIGN_EPI) { if (wr == 0) PG8_BAR; }
    PG8_BAR;
    if constexpr (Epi::AFTER_DRAIN) { E.fused(acc, cur, wr, wc, fr, fq, lds, wid, lane); S.done(cur); }
#undef PG8_SA
#undef PG8_SB
#undef PG8_STAGE
#undef PG8_LDA
#undef PG8_STAGE_A
#undef PG8_GOFF
#undef PG8_LDB
#undef PG8_MMA
#undef PG8_WAIT_V
#undef PG8_WAIT_L
#undef PG8_BAR
#undef PG8_SCHED
}
}

#include <hip/hip_bf16.h>
#include <cmath>
namespace attn_body {
using bf16=__hip_bfloat16;
using bf16x8=__attribute__((ext_vector_type(8)))short;
using s16x4=__attribute__((ext_vector_type(4)))short;
using f32x16=__attribute__((ext_vector_type(16)))float;
using u32x4=__attribute__((ext_vector_type(4)))unsigned;
constexpr int D=64, QP=3584, KP=3584, VP=3584, OP=1024;
constexpr int NW=8,QBLK=32,QB=QBLK*NW,KVBLK=64;
constexpr int ATTN_UNIT_ROWS=QB;
__device__ __forceinline__ int crow(int r,int hi){return (r&3)+8*(r>>2)+4*hi;}
#define SBAR() __builtin_amdgcn_sched_barrier(0)
__device__ __forceinline__ void cmask(f32x16&p0,f32x16&p1,int jb,int qrel,int hi){
  const float NEG=-INFINITY; int kb=64*jb+4*hi;
  #pragma unroll
  for(int r=0;r<16;++r){int kv=kb+(r&3)+8*(r>>2); if(kv>qrel)p0[r]=NEG; if(kv+32>qrel)p1[r]=NEG;}
}

constexpr int NSLOT=3, SLOTB=8192;
constexpr int LDS_K=0, LDS_V=NSLOT*SLOTB, LDS_WS=2*NSLOT*SLOTB, LDS_OST=LDS_WS+NW*64*4, LDS_BYTES=LDS_OST+NW*4096;
constexpr float C2=0.125f*1.4426950408889634f;
__device__ __forceinline__ void glds16(const void*gsrc,unsigned lds_dst){unsigned keep;
  asm volatile("s_mov_b32 %0, m0\n\ts_mov_b32 m0, %2\n\ts_nop 0\n\tglobal_load_lds_dwordx4 %1, off\n\ts_mov_b32 m0, %0":"=&s"(keep):"v"(gsrc),"s"(lds_dst):"memory");}
__device__ __forceinline__ float max3f(float a,float b,float c){float r;asm("v_max3_f32 %0, %1, %2, %3":"=v"(r):"v"(a),"v"(b),"v"(c));return r;}
__device__ __forceinline__ float max2f(float a,float b){float r;asm("v_max_f32_e32 %0, %1, %2":"=v"(r):"v"(a),"v"(b));return r;}
__device__ __forceinline__ float fadd_s(float a,float b){float r;asm("v_add_f32_e32 %0, %1, %2":"=v"(r):"v"(a),"v"(b));return r;}
__device__ __forceinline__ float fsub_s(float a,float b){float r;asm("v_sub_f32_e32 %0, %1, %2":"=v"(r):"v"(a),"v"(b));return r;}
typedef float f32x2_t __attribute__((ext_vector_type(2))); typedef __bf16 bf16x2_t __attribute__((ext_vector_type(2)));
__device__ __forceinline__ unsigned cvtpk_s(float lo,float hi){f32x2_t v={lo,hi};bf16x2_t b=__builtin_convertvector(v,bf16x2_t);return __builtin_bit_cast(unsigned,b);}
#define WAIT_BAR(N) asm volatile("s_waitcnt vmcnt(" #N ") lgkmcnt(0)\n\ts_barrier":::"memory")

__device__ __forceinline__ void qkt(f32x16&p0,f32x16&p1,const char*Kslot,const bf16x8*qr,const f32x16&negm,int r32,int hi){
  const char*kb=Kslot+hi*1024+r32*16;
  #pragma unroll
  for(int d0=0;d0<4;++d0){
    const bf16x8 b0=*reinterpret_cast<const bf16x8*>(kb+d0*2048);
    const bf16x8 b1=*reinterpret_cast<const bf16x8*>(kb+d0*2048+512);
    if(d0==0){p0=__builtin_amdgcn_mfma_f32_32x32x16_bf16(b0,qr[0],negm,0,0,0);p1=__builtin_amdgcn_mfma_f32_32x32x16_bf16(b1,qr[0],negm,0,0,0);}
    else{p0=__builtin_amdgcn_mfma_f32_32x32x16_bf16(b0,qr[d0],p0,0,0,0);p1=__builtin_amdgcn_mfma_f32_32x32x16_bf16(b1,qr[d0],p1,0,0,0);}}
}
typedef __attribute__((address_space(3))) const char* lds_cptr;
typedef short v4i16_t __attribute__((ext_vector_type(4)));
__device__ __forceinline__ void kload8(bf16x8*kf,lds_cptr kp){
  kf[0]=*(const __attribute__((address_space(3))) bf16x8*)(kp);      kf[1]=*(const __attribute__((address_space(3))) bf16x8*)(kp+512);
  kf[2]=*(const __attribute__((address_space(3))) bf16x8*)(kp+2048); kf[3]=*(const __attribute__((address_space(3))) bf16x8*)(kp+2560);
  kf[4]=*(const __attribute__((address_space(3))) bf16x8*)(kp+4096); kf[5]=*(const __attribute__((address_space(3))) bf16x8*)(kp+4608);
  kf[6]=*(const __attribute__((address_space(3))) bf16x8*)(kp+6144); kf[7]=*(const __attribute__((address_space(3))) bf16x8*)(kp+6656);
}
__device__ __forceinline__ void kload2(bf16x8*kf,lds_cptr kp,int j){ kf[2*j]=*(const __attribute__((address_space(3))) bf16x8*)(kp+j*2048); kf[2*j+1]=*(const __attribute__((address_space(3))) bf16x8*)(kp+j*2048+512); }
__device__ __forceinline__ s16x4 vtr(lds_cptr p){ return __builtin_bit_cast(s16x4,__builtin_amdgcn_ds_read_tr16_b64_v4i16((__attribute__((address_space(3))) v4i16_t*)p)); }
__device__ __forceinline__ float rowmax(const f32x16&p0,const f32x16&p1){
  float a=max3f(p0[0],p0[1],p1[0]),b=max3f(p0[2],p0[3],p1[1]);a=max3f(a,p1[2],p1[3]);
  #pragma unroll
  for(int r=4;r<16;r+=4){a=max3f(a,p0[r],p0[r+1]);b=max3f(b,p0[r+2],p0[r+3]);a=max3f(a,p1[r],p1[r+1]);b=max3f(b,p1[r+2],p1[r+3]);}
  const float m=max2f(a,b);
  auto rr=__builtin_amdgcn_permlane32_swap(__float_as_uint(m),__float_as_uint(m),false,false);
  return max2f(__uint_as_float(rr[0]),__uint_as_float(rr[1]));
}
__device__ __forceinline__ void pv(f32x16*o,int vb,bf16x8 pa0,bf16x8 pa1,bf16x8 pa2,bf16x8 pa3){
  #pragma unroll
  for(int d0=0;d0<2;++d0){s16x4 lo[4],hi[4];
    #pragma unroll
    for(int ks=0;ks<4;++ks){
      asm volatile("ds_read_b64_tr_b16 %0,%1 offset:%c2":"=&v"(lo[ks]):"v"(vb),"i"(d0*4096+ks*1024):"memory");
      asm volatile("ds_read_b64_tr_b16 %0,%1 offset:%c2":"=&v"(hi[ks]):"v"(vb),"i"(d0*4096+ks*1024+512):"memory");}
    asm volatile("s_waitcnt lgkmcnt(0)":::"memory");SBAR();
    #define PK(k) (bf16x8){lo[k][0],lo[k][1],lo[k][2],lo[k][3],hi[k][0],hi[k][1],hi[k][2],hi[k][3]}
    o[d0]=__builtin_amdgcn_mfma_f32_32x32x16_bf16(pa0,PK(0),o[d0],0,0,0);
    o[d0]=__builtin_amdgcn_mfma_f32_32x32x16_bf16(pa1,PK(1),o[d0],0,0,0);
    o[d0]=__builtin_amdgcn_mfma_f32_32x32x16_bf16(pa2,PK(2),o[d0],0,0,0);
    o[d0]=__builtin_amdgcn_mfma_f32_32x32x16_bf16(pa3,PK(3),o[d0],0,0,0);
    #undef PK
  }
}

#ifndef ATTN_STORE16
#define ATTN_STORE16(p,v) (*(u32x4*)(p)=(v))
#endif
template<int THRL> __device__ __forceinline__ void attn_unit(int q0,int NT,const bf16*Qh,const bf16*__restrict__ Kh,const bf16*__restrict__ Vh,bf16*Oh,char*shm,const int tid){
  const int lane=tid&63,r32=lane&31,hi=lane>>5; const int wid=__builtin_amdgcn_readfirstlane(tid>>6);
  const bf16*Qw=Qh+(long)(q0+wid*QBLK)*QP;
  const unsigned lds0=(unsigned)(uintptr_t)shm;
  float*wsf=(float*)(shm+LDS_WS)+wid*64;
  const bf16*ksrc=Kh+(long)lane*KP+wid*8;
  const bf16*vsrc=Vh+(long)(16*(wid&3)+(lane>>2))*VP+(wid>>2)*32+(lane&3)*8;
  const unsigned kdst=lds0+LDS_K+wid*1024, vdst=lds0+LDS_V+wid*1024;
  #define DMA_K(t,slot) glds16(ksrc+(long)(t)*KVBLK*KP,(unsigned)__builtin_amdgcn_readfirstlane(kdst+(slot)))
  #define DMA_V(t,slot) glds16(vsrc+(long)(t)*KVBLK*VP,(unsigned)__builtin_amdgcn_readfirstlane(vdst+(slot)))
  const int vb0=(int)(lds0+LDS_V)+((lane>>4)&1)*32+(lane&3)*8+(4*hi+((lane&15)>>2))*64;
  const char*Kbase=shm+LDS_K; bf16x8 kf[8];
  const lds_cptr shm3=(lds_cptr)shm; const lds_cptr kp0=shm3+LDS_K+hi*1024+r32*16; const lds_cptr vp0=shm3+LDS_V+((lane>>4)&1)*32+(lane&3)*8+(4*hi+((lane&15)>>2))*64;
  DMA_K(0,0);DMA_V(0,0);DMA_K(1,SLOTB);
  bf16x8 qr[4];
  #pragma unroll
  for(int d0=0;d0<4;++d0)qr[d0]=*reinterpret_cast<const bf16x8*>(&Qw[(long)r32*QP+d0*16+hi*8]);
  float mhat=0.f,l_reg=0.f;f32x16 o[2];o[0]=f32x16{};o[1]=f32x16{};f32x16 negm=f32x16{};asm volatile("":"+v"(negm));
  #define CMASK(P0,P1,t) do{}while(0)
  bool resc=false;
  #define START(P0,P1) do{ const float rm=rowmax(P0,P1); resc=false; \
    { const float dl=rm; mhat=fadd_s(mhat,dl); \
      _Pragma("unroll") for(int r=0;r<16;++r){P0[r]=fsub_s(P0[r],dl);P1[r]=fsub_s(P1[r],dl);} \
      _Pragma("unroll") for(int r=0;r<16;++r)negm[r]=-mhat; asm volatile("":"+v"(negm)); } \
    _Pragma("unroll") for(int r=0;r<16;++r)P0[r]=__builtin_amdgcn_exp2f(P0[r]); }while(0)
  #define RESC() do{ if(resc){ asm volatile("s_waitcnt lgkmcnt(0)":::"memory"); \
      _Pragma("unroll") for(int d_=0;d_<2;++d_) _Pragma("unroll") for(int r=0;r<16;++r)o[d_][r]*=wsf[crow(r,hi)]; } }while(0)
  f32x16 pA0,pA1,pB0,pB1;
  int sl_prev=0,sl_cur=0,sl_next=SLOTB;
  #define ROT() do{sl_prev=sl_cur;sl_cur=sl_next;sl_next=(sl_next==(NSLOT-1)*SLOTB)?0:sl_next+SLOTB;}while(0)
  DMA_K(2,2*SLOTB);
  WAIT_BAR(3);
  qkt(pA0,pA1,Kbase,qr,negm,r32,hi);asm volatile("s_nop 15\n\ts_nop 7":"+v"(pA0),"+v"(pA1));CMASK(pA0,pA1,0);
  START(pA0,pA1);
  _Pragma("unroll") for(int r=0;r<16;++r)pA1[r]=__builtin_amdgcn_exp2f(pA1[r]);
  WAIT_BAR(0);
  DMA_K(3,0);DMA_V(1,SLOTB);
  ROT();
  kload8(kf,kp0+sl_cur);
  WAIT_BAR(2);
  s16x4 vlo[8],vhi[8]; u32x4 pw0,pw1,pw2,pw3;
  #define PKW(P,B) cvtpk_s(P[B],P[B+1])
  #define PAF(k) __builtin_bit_cast(bf16x8,pw##k)
  #define VFR(i) (bf16x8){vlo[i][0],vlo[i][1],vlo[i][2],vlo[i][3],vhi[i][0],vhi[i][1],vhi[i][2],vhi[i][3]}
  #define PIN(x) asm volatile("":"+v"(x))
  #define MX3(a,b,c) __builtin_fmaxf(__builtin_fmaxf((a),(b)),(c))
  #define GAPA(MF,A0,A1,A2,A3,W0,W1,PW) do{ MF; sacc+=A0; sacc+=A1; sacc+=A2; sacc+=A3; PIN(sacc); W0; W1; PIN(PW); SBAR(); }while(0)
  #define EX(v) __builtin_amdgcn_exp2f(v)
  #define GAPB(MF,X,B) do{ MF; X[B]=EX(X[B]); X[B+1]=EX(X[B+1]); X[B+2]=EX(X[B+2]); X[B+3]=EX(X[B+3]); PIN(X); SBAR(); }while(0)
  #define VRD(i) do{ vlo[i]=vtr(vp_+(((i)>>2)*4096+((i)&3)*1024)); vhi[i]=vtr(vp_+(((i)>>2)*4096+((i)&3)*1024+512)); }while(0)
  #define KRD(G,j) do{ if(G){ kload2(kf,kp0+sl_next,j); SBAR(); } }while(0)
  #define STEP(C0,C1,P0,P1,t,GK,GV,GL) do{ SBAR(); \
    const lds_cptr vp_=vp0+sl_prev; \
    VRD(0); SBAR(); float sacc=(P0[0]+P0[1]); \
    GAPA(C0=__builtin_amdgcn_mfma_f32_32x32x16_bf16(kf[0],qr[0],negm,0,0,0), P0[2],P0[3],P0[4],P0[5],     pw0[0]=PKW(P0,0), pw0[1]=PKW(P0,2), pw0); \
    VRD(4); SBAR(); GAPA(C1=__builtin_amdgcn_mfma_f32_32x32x16_bf16(kf[1],qr[0],negm,0,0,0), P0[6],P0[7],P0[8],P0[9],     pw0[2]=PKW(P0,4), pw0[3]=PKW(P0,6), pw0); \
    VRD(1); SBAR(); GAPA(C0=__builtin_amdgcn_mfma_f32_32x32x16_bf16(kf[2],qr[1],C0,0,0,0),   P0[10],P0[11],P0[12],P0[13], pw1[0]=PKW(P0,8), pw1[1]=PKW(P0,10), pw1); \
    VRD(5); SBAR(); GAPA(C1=__builtin_amdgcn_mfma_f32_32x32x16_bf16(kf[3],qr[1],C1,0,0,0),   P0[14],P0[15],P1[0],P1[1],   pw1[2]=PKW(P0,12),pw1[3]=PKW(P0,14), pw1); \
    VRD(2); SBAR(); GAPA(C0=__builtin_amdgcn_mfma_f32_32x32x16_bf16(kf[4],qr[2],C0,0,0,0),   P1[2],P1[3],P1[4],P1[5],     pw2[0]=PKW(P1,0), pw2[1]=PKW(P1,2), pw2); \
    VRD(6); SBAR(); GAPA(C1=__builtin_amdgcn_mfma_f32_32x32x16_bf16(kf[5],qr[2],C1,0,0,0),   P1[6],P1[7],P1[8],P1[9],     pw2[2]=PKW(P1,4), pw2[3]=PKW(P1,6), pw2); \
    VRD(3); SBAR(); GAPA(C0=__builtin_amdgcn_mfma_f32_32x32x16_bf16(kf[6],qr[3],C0,0,0,0),   P1[10],P1[11],P1[12],P1[13], pw3[0]=PKW(P1,8), pw3[1]=PKW(P1,10), pw3); \
    VRD(7); SBAR(); GAPA(C1=__builtin_amdgcn_mfma_f32_32x32x16_bf16(kf[7],qr[3],C1,0,0,0),   P1[14],P1[15],0.f,0.f,       pw3[2]=PKW(P1,12),pw3[3]=PKW(P1,14), pw3); \
    l_reg+=sacc; \
    if(GK){DMA_K((t)+3,sl_cur);} if(GV){DMA_V((t)+1,sl_next);} \
    CMASK(C0,C1,t); \
    { float a=MX3(C0[0],C0[1],C1[0]),b=MX3(C0[2],C0[3],C1[1]); a=MX3(a,C1[2],C1[3]); \
      _Pragma("unroll") for(int r=4;r<16;r+=4){a=MX3(a,C0[r],C0[r+1]);b=MX3(b,C0[r+2],C0[r+3]);a=MX3(a,C1[r],C1[r+1]);b=MX3(b,C1[r+2],C1[r+3]);} \
      float rm=__builtin_fmaxf(a,b); { auto rr=__builtin_amdgcn_permlane32_swap(__float_as_uint(rm),__float_as_uint(rm),false,false); rm=__builtin_fmaxf(__uint_as_float(rr[0]),__uint_as_float(rr[1])); } \
      resc=false; \
      if(__builtin_expect(__any(rm>(float)THRL),0)){ const float dl=__builtin_fmaxf(rm,0.f); mhat+=dl; \
        _Pragma("unroll") for(int r=0;r<16;++r){C0[r]-=dl;C1[r]-=dl;} \
        _Pragma("unroll") for(int r=0;r<16;++r)negm[r]=-mhat; asm volatile("":"+v"(negm)); \
        const float f=__builtin_amdgcn_exp2f(-dl); l_reg*=f; if(hi==0)wsf[r32]=f; resc=true; } } \
    SBAR(); \
    GAPB(o[0]=__builtin_amdgcn_mfma_f32_32x32x16_bf16(PAF(0),VFR(0),o[0],0,0,0), C0,0); \
    GAPB(o[1]=__builtin_amdgcn_mfma_f32_32x32x16_bf16(PAF(0),VFR(4),o[1],0,0,0), C0,4); \
    KRD(GL,0); GAPB(o[0]=__builtin_amdgcn_mfma_f32_32x32x16_bf16(PAF(1),VFR(1),o[0],0,0,0), C0,8); \
    KRD(GL,1); GAPB(o[1]=__builtin_amdgcn_mfma_f32_32x32x16_bf16(PAF(1),VFR(5),o[1],0,0,0), C0,12); \
    KRD(GL,2); GAPB(o[0]=__builtin_amdgcn_mfma_f32_32x32x16_bf16(PAF(2),VFR(2),o[0],0,0,0), C1,0); \
    KRD(GL,3); GAPB(o[1]=__builtin_amdgcn_mfma_f32_32x32x16_bf16(PAF(2),VFR(6),o[1],0,0,0), C1,4); \
    GAPB(o[0]=__builtin_amdgcn_mfma_f32_32x32x16_bf16(PAF(3),VFR(3),o[0],0,0,0), C1,8); \
    GAPB(o[1]=__builtin_amdgcn_mfma_f32_32x32x16_bf16(PAF(3),VFR(7),o[1],0,0,0), C1,12); \
    }while(0)
  int t=1;
  #undef CMASK
  #define CMASK(P0,P1,t) do{}while(0)
  for(;t+5<NT;t+=2){
    STEP(pB0,pB1,pA0,pA1,t,true,true,true);     WAIT_BAR(2); RESC(); ROT();
    STEP(pA0,pA1,pB0,pB1,t+1,true,true,true);   WAIT_BAR(2); RESC(); ROT();
  }
  #undef CMASK
  #define CMASK(P0,P1,t) do{}while(0)
  #define ENDW(tt) do{ if((tt)+3<NT){WAIT_BAR(2);} else if((tt)+2<NT){WAIT_BAR(1);} else {WAIT_BAR(0);} }while(0)
  for(;t+1<NT;t+=2){
    STEP(pB0,pB1,pA0,pA1,t,(t+3<NT),(t+1<NT),(t+1<NT));       ENDW(t);   RESC(); ROT();
    STEP(pA0,pA1,pB0,pB1,t+1,(t+4<NT),(t+2<NT),(t+2<NT));     ENDW(t+1); RESC(); ROT();
  }
  STEP(pB0,pB1,pA0,pA1,NT-1,false,false,false); RESC();
  { float sacc=pB0[0]+pB0[1]; _Pragma("unroll") for(int r=2;r<16;++r)sacc+=pB0[r]; _Pragma("unroll") for(int r=0;r<16;++r)sacc+=pB1[r]; l_reg+=sacc;
    pw0=(u32x4){PKW(pB0,0),PKW(pB0,2),PKW(pB0,4),PKW(pB0,6)};pw1=(u32x4){PKW(pB0,8),PKW(pB0,10),PKW(pB0,12),PKW(pB0,14)};pw2=(u32x4){PKW(pB1,0),PKW(pB1,2),PKW(pB1,4),PKW(pB1,6)};pw3=(u32x4){PKW(pB1,8),PKW(pB1,10),PKW(pB1,12),PKW(pB1,14)};
    SBAR(); pv(o,vb0+sl_cur,PAF(0),PAF(1),PAF(2),PAF(3)); }
  #undef PKW
  #undef PAF
  #undef VFR
  #undef PIN
  #undef MX3
  #undef GAPA
  #undef GAPB
  #undef EX
  #undef VRD
  #undef KRD
  #undef STEP
  #undef ENDW
  {float la_=l_reg,lb_=l_reg;asm volatile("s_nop 1\n\tv_permlane32_swap_b32 %0, %1\n\ts_nop 1":"+v"(la_),"+v"(lb_));l_reg=la_+lb_;}
  if(hi==0)wsf[32+r32]=l_reg;asm volatile("s_waitcnt lgkmcnt(0)":::"memory");
  float rli[16];
  #pragma unroll
  for(int r=0;r<16;++r)rli[r]=__builtin_amdgcn_rcpf(wsf[32+crow(r,hi)]);
  bf16*Ow=Oh+(long)(q0+wid*QBLK)*OP;
  { bf16*stg=(bf16*)(shm+LDS_OST)+wid*2048;
    #pragma unroll
    for(int r=0;r<16;++r){const int orow=crow(r,hi);
      #pragma unroll
      for(int d0=0;d0<2;++d0)stg[orow*64+d0*32+r32]=__float2bfloat16(o[d0][r]*rli[r]);}
    asm volatile("s_waitcnt lgkmcnt(0)":::"memory");
    #pragma unroll
#ifdef OUTPROJ_FP8
    #define SATF(x) __builtin_amdgcn_fmed3f((x),-448.0f,448.0f)
    for(int i=0;i<4;++i){const int row=i*8+(lane>>3),ch=lane&7; const u32x4 v=*(const u32x4*)(stg+row*64+ch*8);
      const unsigned vs[4]={v.x,v.y,v.z,v.w}; unsigned o8[2];
      #pragma unroll
      for(int j=0;j<2;++j){int wq=0; wq=__builtin_amdgcn_cvt_pk_fp8_f32(SATF(__builtin_bit_cast(float,vs[2*j]<<16)*4.0f),SATF(__builtin_bit_cast(float,vs[2*j]&0xffff0000u)*4.0f),wq,false);
        wq=__builtin_amdgcn_cvt_pk_fp8_f32(SATF(__builtin_bit_cast(float,vs[2*j+1]<<16)*4.0f),SATF(__builtin_bit_cast(float,vs[2*j+1]&0xffff0000u)*4.0f),wq,true); o8[j]=(unsigned)wq;}
      typedef unsigned u32x2_ __attribute__((ext_vector_type(2)));
      { const int rl=q0+wid*QBLK+row; *(u32x2_*)((unsigned char*)Oh+(long)(rl>>1)*(2*OP)+(rl&1)*64+ch*8)=(u32x2_){o8[0],o8[1]}; } } }
    #undef SATF
#else
    for(int i=0;i<4;++i){const int row=i*8+(lane>>3),ch=lane&7; const u32x4 v=*(const u32x4*)(stg+row*64+ch*8); ATTN_STORE16(Ow+(long)row*OP+ch*8,v);} }
#endif
  asm volatile("s_waitcnt lgkmcnt(0)\n\ts_barrier":::"memory");
  #undef DMA_K
  #undef DMA_V
  #undef CMASK
  #undef START
  #undef RESC
  #undef ROT
}
constexpr int ATTN_LDS_BYTES=LDS_BYTES;
#undef SBAR
#undef WAIT_BAR
}
constexpr int NWAVES = 8, NTHR = 512;
constexpr int NB = 16, T_LAT = 2048, L_CTX = 256, DM = 1024, RPB = T_LAT + L_CTX  , MROWS = NB * RPB  , NPROJ = 3584, DEPTH = 2;
constexpr int NPANEL = MROWS / 256  , PPB = RPB / 256  ;
constexpr float NORM_EPS = 1e-6f;
constexpr int C_HQ = 0, C_HI = 256, C_HZ = 512  , C_HG = 1024, C_CB = 1280, C_CC = 1536, C_CH = 1792, C_RQ = 2048, C_RK = 2304, C_RV = 2560, C_RG = 2816, C_AQ = 3072, C_AK = 3328, C_AV = 3456;
constexpr size_t MiB = 1u << 20;
constexpr size_t WS_CTL = 0, CTL_ZERO_BYTES = 1 * MiB;
constexpr size_t WS_MOD = 1 * MiB;
constexpr size_t WS_ROPE = 2 * MiB;
constexpr size_t WS_ROUTE = 3 * MiB;
constexpr size_t WS_ROWINFO = 4 * MiB;
constexpr size_t WS_BCNT = 5 * MiB;
constexpr size_t WS_TILEINFO = 6 * MiB;
constexpr size_t WS_DBUF = 7 * MiB;
constexpr size_t WS_W0 = 12 * MiB, WLAYER = 33 * MiB;
constexpr size_t WO_WIN = 0;
constexpr size_t WO_WOUT = 7 * MiB;
constexpr size_t WO_WGU = 9 * MiB;
constexpr size_t WO_WD = 25 * MiB;
constexpr size_t WS_CTX = 78 * MiB;
constexpr size_t WS_ACT = 94 * MiB;
constexpr size_t WS_P = 166 * MiB;
constexpr size_t WS_ASORT = WS_P;
constexpr size_t WS_H = WS_P + 84 * MiB;
constexpr size_t WS_KVS = 418 * MiB;
constexpr size_t WS_END = 490 * MiB;
constexpr int MAXTILES = 168;
constexpr int CW_ERR = 16;
constexpr int CW_BAR = 4096;
constexpr int CW_BAR3 = 12288, CW_BAR4 = 16384, CW_BAR5 = 20480;
constexpr int CW_BAR2 = 8192;
constexpr int RING_OFF = 0, RING_BYTES = 139264;
constexpr int LDSCTL_OFF = RING_BYTES, MISC_OFF = LDSCTL_OFF + 320;
constexpr int PTAB_OFF = LDSCTL_OFF + 512;
constexpr int TAB_OFF = LDSCTL_OFF + 1024;
constexpr int LDS_BYTES = 147456;

#define GAS __attribute__((address_space(1)))
#define LAS __attribute__((address_space(3)))
typedef unsigned short bf16;
typedef unsigned v4u __attribute__((ext_vector_type(4)));
typedef unsigned v2u __attribute__((ext_vector_type(2)));
typedef int v4i __attribute__((ext_vector_type(4)));
typedef float f32x4 __attribute__((ext_vector_type(4)));
typedef GAS unsigned gu32;
#define RLX_AGENT __ATOMIC_RELAXED, __HIP_MEMORY_SCOPE_AGENT
#define LDS_WAIT() asm volatile("s_waitcnt lgkmcnt(0)" ::: "memory")
#define VM_WAIT() asm volatile("s_waitcnt vmcnt(0)" ::: "memory")
typedef float pkf32x2_t __attribute__((ext_vector_type(2))); typedef __bf16 pkbf16x2_t __attribute__((ext_vector_type(2)));
__device__ __forceinline__ unsigned pk2(float lo, float hi) { const pkf32x2_t v = {lo, hi}; return __builtin_bit_cast(unsigned, __builtin_convertvector(v, pkbf16x2_t)); }
__device__ __forceinline__ unsigned f2bf(float f) { return pk2(f, 0.f) & 0xffffu; }
__device__ __forceinline__ float bflo(unsigned w) { return __builtin_bit_cast(float, w << 16); }
__device__ __forceinline__ float bfhi(unsigned w) { return __builtin_bit_cast(float, w & 0xffff0000u); }
__device__ __forceinline__ float bf1(bf16 h) { return __builtin_bit_cast(float, (unsigned)h << 16); }
__device__ __forceinline__ unsigned pk4_fp8(float a, float b, float c, float d) { int w = 0; a = __builtin_amdgcn_fmed3f(a, -448.0f, 448.0f); b = __builtin_amdgcn_fmed3f(b, -448.0f, 448.0f); c = __builtin_amdgcn_fmed3f(c, -448.0f, 448.0f); d = __builtin_amdgcn_fmed3f(d, -448.0f, 448.0f);     w = __builtin_amdgcn_cvt_pk_fp8_f32(a, b, w, false); w = __builtin_amdgcn_cvt_pk_fp8_f32(c, d, w, true); return (unsigned)w; }
__device__ __forceinline__ float fp8_dec(unsigned b) { const unsigned s = b >> 7, e = (b >> 3) & 15u, m = b & 7u; const float v = e ? (float)(8u + m) * exp2f((float)e - 10.0f) : (float)m * 0.001953125f; return s ? -v : v; }
__device__ __forceinline__ float siluf(float x) { return x * __builtin_amdgcn_rcpf(1.0f + __expf(-x)); }
__device__ __forceinline__ float sigmf(float x) { return __builtin_amdgcn_rcpf(1.0f + __expf(-x)); }
template <int K> __device__ __forceinline__ float xshf(float v) { static_assert(K >= 1 && K < 32, "xshf"); return __builtin_bit_cast(float, __builtin_amdgcn_ds_swizzle(__builtin_bit_cast(int, v), (K << 10) | 0x1f)); }
template <int K> __device__ __forceinline__ int xshi(int v) { static_assert(K >= 1 && K < 32, "xshi"); return __builtin_amdgcn_ds_swizzle(v, (K << 10) | 0x1f); }
__device__ __forceinline__ void half_swap(float& a, float& b) { asm volatile("s_nop 1\n\tv_permlane32_swap_b32 %0, %1\n\ts_nop 1" : "+v"(a), "+v"(b)); }
__device__ __forceinline__ float half_sum(float v) { float a = v, b = v; half_swap(a, b); return a + b; }
__device__ __forceinline__ float half_max(float v) { float a = v, b = v; half_swap(a, b); return fmaxf(a, b); }
__device__ __forceinline__ float sum16(float v) { v += xshf<1>(v); v += xshf<2>(v); v += xshf<4>(v); v += xshf<8>(v); return v; }
__device__ __forceinline__ float sum32(float v) { v = sum16(v); v += xshf<16>(v); return v; }
__device__ __forceinline__ float wave_sum(float v) { return half_sum(sum32(v)); }
#define XB_TMO      128
#define XB_XCNT(j)  (256  + 64 * (j))
#define XB_XSUB(j)  (1280 + 64 * (j))
#define XB_XGEN(j)  (2304 + 64 * (j))
#define XB_TOP      3328
#define XB_TOPGEN   3392
#define XCD_BAR_WORDS 3456
#define XB_SPIN_CAP (1u << 18)

__device__ __forceinline__ unsigned xb_ld(unsigned* p)              { return __hip_atomic_load(p, __ATOMIC_RELAXED, __HIP_MEMORY_SCOPE_AGENT); }
__device__ __forceinline__ unsigned xb_add(unsigned* p, unsigned v) { return __hip_atomic_fetch_add(p, v, __ATOMIC_RELAXED, __HIP_MEMORY_SCOPE_AGENT); }
__device__ __forceinline__ unsigned xb_xcc_id() { return (unsigned)__builtin_amdgcn_s_getreg((3 << 11) | 20) & 0xFu; }
#define XB_SPIN(cond, bar) do { unsigned _sp = 0; while (cond) { __builtin_amdgcn_s_sleep(1); \
    if ((++_sp & 255u) == 0u) { if (xb_ld(&(bar)[XB_TMO])) break; if (_sp > XB_SPIN_CAP) { atomicAdd(&(bar)[XB_TMO], 1u); break; } } } } while (0)

struct XcdBarrier {
    unsigned* bar; unsigned x;
    volatile LAS unsigned* st;
};

__device__ __forceinline__ XcdBarrier xcd_barrier_post(unsigned* bar, volatile LAS unsigned* st) {
    XcdBarrier b; b.bar = bar; b.x = xb_xcc_id(); b.st = st;
    if (threadIdx.x == 0) (void)xb_add(&bar[XB_XCNT(b.x)], 1u);
    return b;
}
__device__ __forceinline__ void xcd_barrier_complete(unsigned* bar, unsigned x, unsigned& nloc, unsigned& nx) {
    const unsigned G = gridDim.x * gridDim.y * gridDim.z;
    unsigned sum, cnt, mine, sp = 0u;
    for (;;) {
        sum = 0u; cnt = 0u; mine = 0u;
#pragma unroll
        for (unsigned j = 0; j < 16; ++j) { const unsigned c = xb_ld(&bar[XB_XCNT(j)]); sum += c; cnt += (c > 0u) ? 1u : 0u; mine = (j == x) ? c : mine; }
        if (sum == G) break;
        __builtin_amdgcn_s_sleep(1);
        if ((++sp & 255u) == 0u) { if (xb_ld(&bar[XB_TMO])) break; if (sp > XB_SPIN_CAP) { atomicAdd(&bar[XB_TMO], 1u); break; } }
    }
    nloc = mine > 0u ? mine : 1u; nx = cnt > 0u ? cnt : 1u;
}

__device__ __forceinline__ void xcd_barrier(const XcdBarrier& b) {
    asm volatile("s_waitcnt vmcnt(0)" ::: "memory");
    __syncthreads();
    if (threadIdx.x == 0) {
        unsigned* bar = b.bar; asm volatile("" : "+s"(bar));
        __builtin_amdgcn_s_waitcnt(0);
        unsigned nloc = b.st[0], nx = b.st[1];
        if (nloc == 0u) { xcd_barrier_complete(bar, b.x, nloc, nx); b.st[0] = nloc; b.st[1] = nx; }
#ifdef EARLY_WB
        __builtin_amdgcn_fence(__ATOMIC_RELEASE, "agent"); asm volatile("s_waitcnt vmcnt(0)" ::: "memory");
#endif
        const unsigned old = xb_add(&bar[XB_XSUB(b.x)], 1u);
        const unsigned gen = old / nloc;
#ifdef MID_WB
        if (old + 1u - gen * nloc == MID_WB_AT(nloc)) asm volatile("buffer_wbl2 sc1" ::: "memory");
#endif
        if (old + 1u == (gen + 1u) * nloc) {
            __builtin_amdgcn_fence(__ATOMIC_RELEASE, "agent");
            asm volatile("s_waitcnt vmcnt(0)" ::: "memory");
#if defined(TOP_DIRECT) && defined(EARLY_INV)
            (void)xb_add(&bar[XB_TOP], 1u);
            asm volatile("buffer_inv sc1" ::: "memory");
            { const unsigned target = (gen + 1u) * nx; XB_SPIN(xb_ld(&bar[XB_TOP]) < target, bar); }
            asm volatile("" ::: "memory");
#else
            const unsigned og = xb_add(&bar[XB_TOP], 1u);
            const unsigned tg = og / nx;
#ifdef EARLY_INV
            asm volatile("buffer_inv sc1" ::: "memory");
            if (og + 1u == (tg + 1u) * nx) xb_add(&bar[XB_TOPGEN], 1u);
            else XB_SPIN(xb_ld(&bar[XB_TOPGEN]) == tg, bar);
            asm volatile("" ::: "memory");
#else
            if (og + 1u == (tg + 1u) * nx) xb_add(&bar[XB_TOPGEN], 1u);
            else XB_SPIN(xb_ld(&bar[XB_TOPGEN]) == tg, bar);
            __builtin_amdgcn_fence(__ATOMIC_ACQUIRE, "agent");
#endif
#endif
            xb_add(&bar[XB_XGEN(b.x)], 1u);
            asm volatile("s_waitcnt vmcnt(0)" ::: "memory");
        } else {
#ifdef EARLY_INV
            asm volatile("buffer_inv sc1" ::: "memory");
            XB_SPIN(xb_ld(&bar[XB_XGEN(b.x)]) == gen, bar);
            asm volatile("" ::: "memory");
#else
            XB_SPIN(xb_ld(&bar[XB_XGEN(b.x)]) == gen, bar);
            __builtin_amdgcn_fence(__ATOMIC_ACQUIRE, "agent");
#endif
            asm volatile("s_waitcnt vmcnt(0)" ::: "memory");
        }
    }
    __syncthreads();
}

__device__ __forceinline__ void xcd_split_arrive(const XcdBarrier& b, unsigned* bar2) {
    asm volatile("s_waitcnt vmcnt(0)" ::: "memory");
    __syncthreads();
    if (threadIdx.x == 0) {
        unsigned* bar = bar2; asm volatile("" : "+s"(bar));
        __builtin_amdgcn_s_waitcnt(0);
        unsigned nloc = b.st[0], nx = b.st[1];
        if (nloc == 0u) { xcd_barrier_complete(b.bar, b.x, nloc, nx); b.st[0] = nloc; b.st[1] = nx; }
        const unsigned old = xb_add(&bar[XB_XSUB(b.x)], 1u);
        if ((old + 1u) % nloc == 0u) {
            __builtin_amdgcn_fence(__ATOMIC_RELEASE, "agent");
            asm volatile("s_waitcnt vmcnt(0)" ::: "memory");
#ifdef TOP_DIRECT
            (void)xb_add(&bar[XB_TOP], 1u);
#else
            const unsigned og = xb_add(&bar[XB_TOP], 1u);
            if ((og + 1u) % nx == 0u) xb_add(&bar[XB_TOPGEN], 1u);
#endif
        }
    }
}
__device__ __forceinline__ void xcd_split_wait(const XcdBarrier& b, unsigned* bar2, unsigned target) {
    if (threadIdx.x == 0) {
        unsigned* bar = bar2; asm volatile("" : "+s"(bar));
#ifdef TOP_DIRECT
        { const unsigned nx_ = b.st[1]; XB_SPIN(xb_ld(&bar[XB_TOP]) < target * nx_, bar); }
#else
        XB_SPIN(xb_ld(&bar[XB_TOPGEN]) < target, bar);
#endif
        __builtin_amdgcn_fence(__ATOMIC_ACQUIRE, "agent");
        asm volatile("s_waitcnt vmcnt(0)" ::: "memory");
    }
    __syncthreads();
}
struct Args { const float* in[24]; float* out; unsigned char* ws; size_t ws_shift; };
enum { I_X = 0, I_C, I_CTX, I_CCTX, I_ADAW, I_ADAB, I_NMIX, I_NFFN, I_WIN, I_LB, I_HNORM, I_CONVW, I_RDEC, I_RNORM, I_QN, I_KN, I_WOUT, I_RGW, I_RGB, I_REW, I_REB, I_EG, I_EU, I_ED };
struct Frame {
    LAS unsigned char* lds;
    volatile LAS unsigned* MISC;
    gu32* ctl;
    int tid, lane, wave, vcu, G;
    unsigned bart;
};
__device__ __forceinline__ const void* lptr(const Frame& F, int i) {
    const volatile LAS unsigned* t = (const volatile LAS unsigned*)(F.lds + PTAB_OFF) + 2 * i;
    const unsigned lo = __builtin_amdgcn_readfirstlane(t[0]), hi = __builtin_amdgcn_readfirstlane(t[1]);
    return (const void*)(const GAS void*)(((unsigned long long)hi << 32) | lo);
}
#define PIN(i) ((const float*)lptr(F, (i)))
#define POUT ((float*)lptr(F, 24))
#define PWS ((unsigned char*)lptr(F, 25))
__device__ __forceinline__ int row_of_latent(int idx) { return (idx >> 11) * RPB + L_CTX + (idx & 2047); }

__device__ __forceinline__ void transpose_item(const float* W, int N, int k0, int n0, bf16* dst, int DP, LAS float* scr, int lane) {
#pragma unroll
    for (int i = 0; i < 8; ++i) { const int kk = 8 * i + (lane >> 3), nc = 4 * (lane & 7); const f32x4 v = *(const f32x4*)(W + (size_t)(k0 + kk) * N + n0 + nc);
        scr[kk * 33 + nc] = v.x; scr[kk * 33 + nc + 1] = v.y; scr[kk * 33 + nc + 2] = v.z; scr[kk * 33 + nc + 3] = v.w; }
    LDS_WAIT(); asm volatile("" ::: "memory");
    const int c = lane & 7;
#pragma unroll
    for (int j = 0; j < 4; ++j) { const int n = (lane >> 3) + 8 * j; const LAS float* s = scr + (8 * c) * 33 + n;
        v4u o; o.x = pk2(s[0 * 33], s[1 * 33]); o.y = pk2(s[2 * 33], s[3 * 33]); o.z = pk2(s[4 * 33], s[5 * 33]); o.w = pk2(s[6 * 33], s[7 * 33]);
        *(GAS v4u*)(dst + (size_t)n * DP + 8 * c) = o; }
    LDS_WAIT(); asm volatile("" ::: "memory");
}
__device__ __forceinline__ void transpose_item8(const float* W, int N, int k0, int n0, unsigned char* dst, int DP, float scale, LAS float* scr, int lane) {
#pragma unroll
    for (int i = 0; i < 8; ++i) { const int kk = 8 * i + (lane >> 3), nc = 4 * (lane & 7); const f32x4 v = *(const f32x4*)(W + (size_t)(k0 + kk) * N + n0 + nc) * scale;
        scr[kk * 33 + nc] = v.x; scr[kk * 33 + nc + 1] = v.y; scr[kk * 33 + nc + 2] = v.z; scr[kk * 33 + nc + 3] = v.w; }
    LDS_WAIT(); asm volatile("" ::: "memory");
    const int c = lane & 7;
#pragma unroll
    for (int j = 0; j < 4; ++j) { const int n = (lane >> 3) + 8 * j; const LAS float* s = scr + (8 * c) * 33 + n;
        v2u o; o.x = pk4_fp8(s[0 * 33], s[1 * 33], s[2 * 33], s[3 * 33]); o.y = pk4_fp8(s[4 * 33], s[5 * 33], s[6 * 33], s[7 * 33]);
        *(GAS v2u*)(dst + (size_t)n * DP + 8 * c) = o; }
    LDS_WAIT(); asm volatile("" ::: "memory");
}
struct WItem { const float* src; unsigned char* dst; int N, DP, f8, emu; };
__device__ __forceinline__ WItem witem_decode(const Frame& F, int it) {
    constexpr int PER_LAYER = 1792 + 512 + 3 * 4096;
    const int l = it / PER_LAYER; int r = it - l * PER_LAYER; unsigned char* ws = PWS + WS_W0 + (size_t)l * WLAYER; WItem w; w.emu = 0;
    if (r < 1792) { const int kb = r / 112, nb = r % 112; w.src = PIN(I_WIN) + (size_t)l * 1024 * NPROJ + (size_t)kb * 64 * NPROJ + nb * 32; w.N = NPROJ; w.emu = (EMU_TILES >> (nb >> 3)) & 1;
        if ((INPROJ_F8MASK >> (nb >> 3)) & 1) { w.dst = ws + WO_WIN + (size_t)(nb >> 3) * 524288 + (size_t)((nb & 7) * 32) * 1024 + kb * 64; w.DP = 1024; w.f8 = 1; return w; }
        w.dst = ws + WO_WIN + ((size_t)nb * 32 * 1024 + kb * 64) * 2; w.DP = 2048; w.f8 = 0; return w; }
    r -= 1792;
    if (r < 512) { const int kb = r / 32, nb = r % 32; w.src = PIN(I_WOUT) + (size_t)l * 1024 * 1024 + (size_t)kb * 64 * 1024 + nb * 32; w.N = 1024;
#ifdef OUTPROJ_FP8
        w.dst = ws + WO_WOUT + ((size_t)nb * 32 * 1024 + kb * 64); w.DP = 1024; w.f8 = 1; return w; }
#else
        w.dst = ws + WO_WOUT + ((size_t)nb * 32 * 1024 + kb * 64) * 2; w.DP = 2048; w.f8 = 0; return w; }
#endif
    r -= 512;
    if (r < 8192) { const int up = r >= 4096; r -= up * 4096; const int e = r >> 8, rr = r & 255, kb = rr >> 4, nb = rr & 15, n0 = nb * 32;
        const int drow = e * 1024 + (n0 >> 7) * 256 + up * 128 + (n0 & 127);
        w.src = (up ? PIN(I_EU) : PIN(I_EG)) + (size_t)(l * 16 + e) * 1024 * 512 + (size_t)kb * 64 * 512 + n0; w.N = 512; w.dst = ws + WO_WGU + (size_t)drow * 1024 + kb * 64; w.DP = 1024; w.f8 = 1; return w; }
    r -= 8192;
    { const int e = r >> 8, rr = r & 255, kb = rr >> 5, nb = rr & 31, g = e >> 2, el = e & 3;
        w.src = PIN(I_ED) + (size_t)(l * 16 + e) * 512 * 1024 + (size_t)kb * 64 * 1024 + nb * 32; w.N = 1024; w.dst = ws + WO_WD + ((size_t)g * 1024 + nb * 32) * 2048 + el * 512 + kb * 64; w.DP = 2048; w.f8 = 1; return w; }
}
__device__ __forceinline__ void convert_weights_range(Frame& F, int it0, int it1, int gw, int NGW) {
    LAS float* scr = (LAS float*)(F.lds + F.wave * 16384);
    const int lane = F.lane; const int NITEMS = it1;
    if (gw < 0 || it0 + gw >= NITEMS) return;
    gw += it0;
    const int kr = lane >> 3, nc = 4 * (lane & 7);
    WItem cur = witem_decode(F, gw); f32x4 v[8], vn[8];
#pragma unroll
    for (int i = 0; i < 8; ++i) v[i] = LDNT((const f32x4*)(cur.src + (size_t)(8 * i + kr) * cur.N + nc));
    for (int it = gw; it < NITEMS; it += NGW) {
        const int itn = it + NGW; const bool more = itn < NITEMS; WItem nxt = cur;
        if (more) { nxt = witem_decode(F, itn);
#pragma unroll
            for (int i = 0; i < 8; ++i) vn[i] = LDNT((const f32x4*)(nxt.src + (size_t)(8 * i + kr) * nxt.N + nc)); }
        const float sc = cur.f8 ? 32.0f : 1.0f;
#pragma unroll
        for (int i = 0; i < 8; ++i) { const int kk = 8 * i + kr; const f32x4 x = v[i] * sc; scr[kk * 33 + nc] = x.x; scr[kk * 33 + nc + 1] = x.y; scr[kk * 33 + nc + 2] = x.z; scr[kk * 33 + nc + 3] = x.w; }
        LDS_WAIT(); asm volatile("" ::: "memory");
        const int c = lane & 7;
#pragma unroll
        for (int j = 0; j < 4; ++j) { const int n = (lane >> 3) + 8 * j; const LAS float* s = scr + (8 * c) * 33 + n;
            if (cur.f8) { v2u o; o.x = pk4_fp8(s[0 * 33], s[1 * 33], s[2 * 33], s[3 * 33]); o.y = pk4_fp8(s[4 * 33], s[5 * 33], s[6 * 33], s[7 * 33]); *(GAS v2u*)(cur.dst + (size_t)n * cur.DP + 8 * c) = o; }
            else { float e[8];
#pragma unroll
                for (int q = 0; q < 8; ++q) { e[q] = s[q * 33]; if (cur.emu) { const int pq = __builtin_amdgcn_cvt_pk_fp8_f32(e[q] * 32.0f, 0.0f, 0, false); e[q] = __builtin_amdgcn_cvt_f32_fp8(pq, 0) * (1.0f / 32.0f); } }
                v4u o; o.x = pk2(e[0], e[1]); o.y = pk2(e[2], e[3]); o.z = pk2(e[4], e[5]); o.w = pk2(e[6], e[7]); *(GAS v4u*)(cur.dst + (size_t)n * cur.DP + 16 * c) = o; } }
        LDS_WAIT(); asm volatile("" ::: "memory");
        if (more) { cur = nxt;
#pragma unroll
            for (int i = 0; i < 8; ++i) v[i] = vn[i]; }
    }
}

__device__ __forceinline__ void p0_prologue(Frame& F, const XcdBarrier& gbar) {
    unsigned char* ws = PWS;
    {
        LAS float* sc = (LAS float*)(F.lds);
        LAS float* red = (LAS float*)(F.lds + 17 * 4096);
        bool staged = false;
        const float* pC = PIN(I_C); const float* pCC = PIN(I_CCTX); const float* pAW = PIN(I_ADAW); const float* pAB = PIN(I_ADAB); const float* pNM = PIN(I_NMIX); const float* pNF = PIN(I_NFFN);
#ifdef MOD_WIDE
        typedef float f32x3 __attribute__((ext_vector_type(3)));
        for (int it = F.vcu; it < DEPTH * 128; it += F.G) {
            if (!staged) {
                for (int i = F.tid; i < 17 * 1024; i += NTHR) { const float v = (i < 16 * 1024) ? pC[i] : pCC[i - 16 * 1024]; sc[i] = siluf(v); }
                staged = true;
            }
            __syncthreads();
            const int l = it >> 7, cb = it & 127, n0 = cb * 48, nn = F.tid & 15, ks = F.tid >> 4;
            const float* W = pAW + (size_t)l * 1024 * 6144 + n0 + 3 * nn;
            f32x3 acc[17];
#pragma unroll
            for (int m = 0; m < 17; ++m) acc[m] = (f32x3){0.f, 0.f, 0.f};
            for (int k = ks * 32; k < ks * 32 + 32; k += 4) {
                const f32x3 w0 = *(const f32x3*)(W + (size_t)k * 6144), w1 = *(const f32x3*)(W + (size_t)(k + 1) * 6144), w2 = *(const f32x3*)(W + (size_t)(k + 2) * 6144), w3 = *(const f32x3*)(W + (size_t)(k + 3) * 6144);
#pragma unroll
                for (int m = 0; m < 17; ++m) { const f32x4 s4 = *(const LAS f32x4*)(sc + m * 1024 + k); acc[m] += (w0 * s4.x + w1 * s4.y) + (w2 * s4.z + w3 * s4.w); } }
#pragma unroll
            for (int m = 0; m < 17; ++m) { float a = acc[m].x, b = acc[m].y, c3 = acc[m].z; a += xshf<16>(a); b += xshf<16>(b); c3 += xshf<16>(c3); acc[m] = (f32x3){half_sum(a), half_sum(b), half_sum(c3)}; }
            if (F.lane < 16) {
#pragma unroll
                for (int m = 0; m < 17; ++m) { LAS float* rp = red + (F.wave * 17 + m) * 48 + 3 * nn; rp[0] = acc[m].x; rp[1] = acc[m].y; rp[2] = acc[m].z; } }
            __syncthreads();
            for (int i = F.tid; i < 17 * 48; i += NTHR) { const int m = i / 48, n2 = i - m * 48, gcol = n0 + n2; float v = pAB[l * 6144 + gcol];
#pragma unroll
                for (int k2 = 0; k2 < 8; ++k2) v += red[(k2 * 17 + m) * 48 + n2];
                const int kch = gcol >> 10, col = gcol & 1023;
                if (kch == 1) v = pNM[l * 1024 + col] * (1.0f + v);
                if (kch == 4) v = pNF[l * 1024 + col] * (1.0f + v);
                ((float*)(ws + WS_MOD) + (size_t)(l * 6 + kch) * 17 * 1024)[m * 1024 + col] = v; }
        }
#else
        for (int it = F.vcu; it < DEPTH * 192; it += F.G) {
            if (!staged) {
                for (int i = F.tid; i < 17 * 1024; i += NTHR) { const float v = (i < 16 * 1024) ? pC[i] : pCC[i - 16 * 1024]; sc[i] = siluf(v); }
                staged = true;
            }
            __syncthreads();
            const int l = it / 192, cb = it % 192, n0 = cb * 32, nn = F.tid & 31, ks = F.tid >> 5;
            const float* W = pAW + (size_t)l * 1024 * 6144 + n0 + nn;
            float acc[17];
#pragma unroll
            for (int m = 0; m < 17; ++m) acc[m] = 0.f;
            for (int k = ks * 64; k < ks * 64 + 64; k += 4) { const float w0 = W[(size_t)k * 6144], w1 = W[(size_t)(k + 1) * 6144], w2 = W[(size_t)(k + 2) * 6144], w3 = W[(size_t)(k + 3) * 6144];
#pragma unroll
                for (int m = 0; m < 17; ++m) { const f32x4 s4 = *(const LAS f32x4*)(sc + m * 1024 + k); acc[m] += (s4.x * w0 + s4.y * w1) + (s4.z * w2 + s4.w * w3); } }
#pragma unroll
            for (int m = 0; m < 17; ++m) red[(ks * 17 + m) * 32 + nn] = acc[m];
            __syncthreads();
            const int kch = n0 >> 10, cc = n0 & 1023;
            float* MOD = (float*)(ws + WS_MOD) + (size_t)(l * 6 + kch) * 17 * 1024;
            for (int i = F.tid; i < 17 * 32; i += NTHR) { const int m = i >> 5, n2 = i & 31; float v = pAB[l * 6144 + n0 + n2];
#pragma unroll
                for (int k2 = 0; k2 < 16; ++k2) v += red[(k2 * 17 + m) * 32 + n2];
                const int col = cc + n2;
                if (kch == 1) v = pNM[l * 1024 + col] * (1.0f + v);
                if (kch == 4) v = pNF[l * 1024 + col] * (1.0f + v);
                MOD[m * 1024 + col] = v; }
        }
#endif
        __syncthreads();
    }
#ifdef SPLIT_PRO
    xcd_split_arrive(gbar, (unsigned*)(F.ctl + CW_BAR3));
#endif
    {
        float* RC = (float*)(ws + WS_ROPE); float* RS = RC + 2048 * 32;
        for (int i = (F.vcu * NTHR + F.tid); i < 2048 * 32; i += F.G * NTHR) { const int t = i >> 5, f = i & 31; const float pos = (float)((f < 16) ? (t >> 6) : (t & 63));
            const float invf = exp2f(-(float)(f & 15) * (13.287712379549449f / 16.0f)); const float ang = pos * invf; RC[i] = cosf(ang); RS[i] = sinf(ang); }
    }
    __syncthreads();
    convert_weights_range(F, 0, 1792 + 512 + 3 * 4096, F.vcu * NWAVES + F.wave, F.G * NWAVES);
    __syncthreads();
}
__device__ __forceinline__ void phase_norm1(Frame& F, const float* xsrc, const float* csrc, const float* nA, const float* nB, bf16* dst, unsigned char* dst8) {
    const int gw = F.vcu * NWAVES + F.wave, NGW = F.G * NWAVES, RPW = (MROWS + NGW - 1) / NGW;
    const int c0 = 8 * F.lane;
    int curm = -1; f32x4 a[4], bb[4];
#ifdef N1_INTERLEAVE
    (void)RPW; for (int r = gw; r < MROWS; r += NGW) {
#else
    for (int r = gw * RPW; r < (gw + 1) * RPW && r < MROWS; ++r) {
#endif
        const int b = r / RPB, j = r - b * RPB, m = (j < L_CTX) ? 16 : b;
        const float* src = (j < L_CTX) ? csrc + (size_t)(b * L_CTX + j) * DM : xsrc + (size_t)(b * T_LAT + j - L_CTX) * DM;
        if (m != curm) { curm = m;
#pragma unroll
            for (int q = 0; q < 4; ++q) { a[q] = *(const f32x4*)(nA + m * 1024 + c0 + 512 * (q >> 1) + 4 * (q & 1)); bb[q] = *(const f32x4*)(nB + m * 1024 + c0 + 512 * (q >> 1) + 4 * (q & 1)); } }
        f32x4 v[4]; float ss = 0.f;
#pragma unroll
        for (int q = 0; q < 4; ++q) { v[q] = LDNT((const f32x4*)(src + c0 + 512 * (q >> 1) + 4 * (q & 1))); ss += (v[q].x * v[q].x + v[q].y * v[q].y) + (v[q].z * v[q].z + v[q].w * v[q].w); }
        const float rstd = __builtin_amdgcn_rsqf(wave_sum(ss) * (1.0f / DM) + NORM_EPS);
#pragma unroll
        for (int q = 0; q < 2; ++q) { const f32x4 o0 = v[2 * q] * rstd * a[2 * q] + bb[2 * q], o1 = v[2 * q + 1] * rstd * a[2 * q + 1] + bb[2 * q + 1];
            v4u w; w.x = pk2(o0.x, o0.y); w.y = pk2(o0.z, o0.w); w.z = pk2(o1.x, o1.y); w.w = pk2(o1.z, o1.w);
            *(v4u*)(dst + (size_t)r * DM + c0 + 512 * q) = w;
            if (INPROJ_F8MASK) { v2u w8; w8.x = pk4_fp8(o0.x, o0.y, o0.z, o0.w); w8.y = pk4_fp8(o1.x, o1.y, o1.z, o1.w); *(v2u*)(dst8 + (size_t)r * DM + c0 + 512 * q) = w8; } }
    }
}

#ifdef REV_A
#define PREP_ROW(r) (MROWS - 1 - (r))
#else
#define PREP_ROW(r) (r)
#endif
template <bool DRY = false>
__device__ __forceinline__ void phase_prep(Frame& F, bf16* P, const float* qn, const float* kn, const float* RC, const float* RS) {
    const int gw = F.vcu * NWAVES + F.wave, NGW = F.G * NWAVES;
    const int L = F.lane; const bool act = L < 48, isq = L < 32;
    const int col = isq ? C_AQ + 8 * L : C_AK + 8 * (L - 32), e0 = (8 * L) & 63, p0 = e0 >> 1;
    const float* gp = isq ? qn : kn; const f32x4 g0 = *(const f32x4*)(gp + e0), g1 = *(const f32x4*)(gp + e0 + 4);
    constexpr float C2 = 0.125f * 1.4426950408889634f; const float sc = isq ? C2 : 1.0f;
    for (int r0 = gw; r0 < MROWS; r0 += 4 * NGW) {
        v4u wv[4]; f32x4 cs[4], sn[4]; bool ok[4];
#pragma unroll
        for (int u = 0; u < 4; ++u) { const int r = r0 + u * NGW; ok[u] = r < MROWS; const int rr = ok[u] ? PREP_ROW(r) : gw; const int b = rr / RPB, j = rr - b * RPB; const bool lat = j >= L_CTX;
            cs[u] = (f32x4){1.f, 1.f, 1.f, 1.f}; sn[u] = (f32x4){0.f, 0.f, 0.f, 0.f}; if (lat) { cs[u] = *(const f32x4*)(RC + (j - L_CTX) * 32 + p0); sn[u] = *(const f32x4*)(RS + (j - L_CTX) * 32 + p0); }
            wv[u] = act ? *(const v4u*)(P + (size_t)rr * NPROJ + col) : (v4u){0u, 0u, 0u, 0u}; }
#pragma unroll
        for (int u = 0; u < 4; ++u) { const int r = PREP_ROW(r0 + u * NGW);
            const unsigned ww[4] = {wv[u].x, wv[u].y, wv[u].z, wv[u].w}; float x[8]; float ss = 0.f;
#pragma unroll
            for (int i = 0; i < 4; ++i) { x[2 * i] = bflo(ww[i]); x[2 * i + 1] = bfhi(ww[i]); ss += x[2 * i] * x[2 * i] + x[2 * i + 1] * x[2 * i + 1]; }
            ss += xshf<1>(ss); ss += xshf<2>(ss); ss += xshf<4>(ss);
            const float rstd = __builtin_amdgcn_rsqf(ss * (1.0f / 64.0f) + NORM_EPS) * sc;
            const float gg[8] = {g0.x, g0.y, g0.z, g0.w, g1.x, g1.y, g1.z, g1.w}, cc[4] = {cs[u].x, cs[u].y, cs[u].z, cs[u].w}, sv[4] = {sn[u].x, sn[u].y, sn[u].z, sn[u].w};
            unsigned o[4];
#pragma unroll
            for (int i = 0; i < 4; ++i) { const float y1 = x[2 * i] * rstd * gg[2 * i], y2 = x[2 * i + 1] * rstd * gg[2 * i + 1]; o[i] = pk2(y1 * cc[i] - y2 * sv[i], y1 * sv[i] + y2 * cc[i]); }
            if (DRY) { asm volatile("" : "+v"(o[0]), "+v"(o[3])); o[0] = wv[u].x; o[1] = wv[u].y; o[2] = wv[u].z; o[3] = wv[u].w; }
            if (ok[u] && act) *(v4u*)(P + (size_t)r * NPROJ + col) = (v4u){o[0], o[1], o[2], o[3]}; }
    }
}
namespace rc {
constexpr int PT = 144, MB = 64 * PT;
constexpr int O_QP = 0, O_QQ = MB, O_KP = 2 * MB, O_VT = 3 * MB, O_ST = 4 * MB, O_AT = 5 * MB, O_TOT = 6 * MB, SLOT = 6 * MB + 2048;
constexpr int OXP = 68;
typedef float f32x16 __attribute__((ext_vector_type(16)));
typedef float f32x4v __attribute__((ext_vector_type(4)));
typedef short bf16x8 __attribute__((ext_vector_type(8)));
__device__ __forceinline__ int crow(int r, int hi) { return (r & 3) + 8 * (r >> 2) + 4 * hi; }
__device__ __forceinline__ bf16x8 frag32(const LAS unsigned char* M, int row, int kcol, int hi) { return *(const LAS bf16x8*)(M + row * PT + (kcol + hi * 8) * 2); }
__device__ __forceinline__ float clampe(float x) { return fminf(fmaxf(x, -60.f), 60.f); }
__device__ __forceinline__ int seq_of(int mixer, int b, int h, int dir) { return ((mixer * NB + b) * 4 + h) * 2 + dir; }
__device__ __forceinline__ int row_in_batch(int dir, int n) { return (dir == 0) ? n : (n < L_CTX ? (L_CTX - 1 - n) : (RPB + L_CTX - 1 - n)); }
}
struct StageARaw { v4u k[8], v[8]; };
__device__ __forceinline__ void stageA_load(StageARaw& R, const Frame& F, const bf16* P, int mixer, int b, int h, int dir, int c) {
    using namespace rc;
    const int lane = F.lane, r8 = lane >> 3, ch = lane & 7;
    const int ck = (mixer == 0 ? C_HZ + 256 * dir : C_RK) + h * 64 + 8 * ch, cv = (mixer == 0 ? C_HI : C_RV) + h * 64 + 8 * ch;
    const int j0 = row_in_batch(dir, c * 64 + r8); const long step = (dir == 0) ? 8L * NPROJ : -8L * NPROJ;
    const bf16* rp = P + (size_t)(b * RPB + j0) * NPROJ;
#pragma unroll
    for (int i = 0; i < 8; ++i) { R.k[i] = *(const v4u*)(rp + ck); R.v[i] = *(const v4u*)(rp + cv); rp += step; }
}
template <int MIXER>
__device__ __forceinline__ void stageA_compute(const StageARaw& R, Frame& F, bf16* KVS, float* DBUF, int b, int h, int dir, int c, const float* lblog, float gamma) {
    using namespace rc;
    constexpr int HP = 80;
    LAS unsigned char* WL = F.lds + F.wave * 10240; LAS unsigned char* KT = WL; LAS unsigned char* VTm = WL + 5120;
    const int lane = F.lane, seq = seq_of(MIXER, b, h, dir), r8 = lane >> 3, ch = lane & 7;
    unsigned kp[32], vp[32];
    {
        float kk[64];
#pragma unroll
        for (int i = 0; i < 8; ++i) *(LAS v4u*)(WL + (r8 + 8 * i) * PT + 16 * ch) = R.k[i];
#pragma unroll
        for (int s = 0; s < 64; ++s) kk[s] = bf1(*(const LAS unsigned short*)(WL + s * PT + 2 * lane));
        if (MIXER == 0) {
            const float lb = lblog ? sigmf(lblog[512 + dir * 256 + h * 64 + lane] - lblog[dir * 256 + h * 64 + lane]) : 0.f;
            float run = 1.f;
#pragma unroll
            for (int s = 63; s >= 0; --s) { const float f = lb + (1.0f - lb) * sigmf(kk[s]); kk[s] = (1.0f - f) * run; run *= f; }
            DBUF[(size_t)(seq * 36 + c) * 64 + lane] = run;
        } else {
            const float lg2 = __log2f(gamma);
#pragma unroll
            for (int s = 0; s < 64; ++s) kk[s] *= exp2f((float)(63 - s) * lg2);
        }
#pragma unroll
        for (int s = 0; s < 32; ++s) kp[s] = pk2(kk[2 * s], kk[2 * s + 1]);
    }
#pragma unroll
    for (int i = 0; i < 8; ++i) *(LAS v4u*)(WL + (r8 + 8 * i) * PT + 16 * ch) = R.v[i];
#pragma unroll
    for (int s = 0; s < 32; ++s) vp[s] = (unsigned)*(const LAS unsigned short*)(WL + (2 * s) * PT + 2 * lane) | ((unsigned)*(const LAS unsigned short*)(WL + (2 * s + 1) * PT + 2 * lane) << 16);
    const int r = lane & 15, g = lane >> 4;
    f32x4v acc[4][4];
#pragma unroll
    for (int a = 0; a < 4; ++a)
#pragma unroll
        for (int q = 0; q < 4; ++q) acc[a][q] = (f32x4v){0.f, 0.f, 0.f, 0.f};
#pragma unroll
    for (int hh = 0; hh < 2; ++hh) {
#pragma unroll
        for (int i = 0; i < 4; ++i) { const int s0 = 32 * hh + 8 * i; v4u ko, vo;
            ko.x = kp[s0 / 2]; ko.y = kp[s0 / 2 + 1]; ko.z = kp[s0 / 2 + 2]; ko.w = kp[s0 / 2 + 3];
            vo.x = vp[s0 / 2]; vo.y = vp[s0 / 2 + 1]; vo.z = vp[s0 / 2 + 2]; vo.w = vp[s0 / 2 + 3];
            *(LAS v4u*)(KT + lane * HP + 16 * i) = ko; *(LAS v4u*)(VTm + lane * HP + 16 * i) = vo; }
        bf16x8 af[4], bfr[4];
#pragma unroll
        for (int q = 0; q < 4; ++q) { af[q] = *(const LAS bf16x8*)(VTm + (16 * q + r) * HP + 16 * g); bfr[q] = *(const LAS bf16x8*)(KT + (16 * q + r) * HP + 16 * g); }
#pragma unroll
        for (int a = 0; a < 4; ++a)
#pragma unroll
            for (int q = 0; q < 4; ++q) acc[a][q] = __builtin_amdgcn_mfma_f32_16x16x32_bf16(af[a], bfr[q], acc[a][q], 0, 0, 0);
    }
#pragma unroll
    for (int a = 0; a < 4; ++a)
#pragma unroll
        for (int q = 0; q < 4; ++q)
#pragma unroll
            for (int x = 0; x < 4; ++x) *(LAS unsigned short*)(WL + (16 * a + 4 * g + x) * PT + (16 * q + r) * 2) = (unsigned short)f2bf(acc[a][q][x]);
    bf16* dst = KVS + (size_t)(seq * 36 + c) * 4096;
#pragma unroll
    for (int i = 0; i < 8; ++i) { const int idx = lane + 64 * i, e = idx >> 3, d8 = idx & 7; *(v4u*)(dst + e * 64 + d8 * 8) = *(const LAS v4u*)(WL + e * PT + d8 * 16); }
}
__device__ __forceinline__ void recur_stageA_loop(Frame& F, const bf16* P, bf16* KVS, float* DBUF, int u0, int stride, int nunits, const float* lblog, const float* rdec) {
    if (u0 >= nunits) return;
    StageARaw cur;
#define STA_DECODE(u_, it__) const int mh_ = ((u_) + (it__)) & 7, rest_ = (u_) >> 3, c_ = rest_ % 36, bd_ = rest_ / 36, b_ = bd_ >> 1, dir_ = bd_ & 1, mixer_ = mh_ >> 2, h_ = mh_ & 3
    int it = 0;
    for (int u = u0; u < nunits; u += stride, ++it) {
#ifdef REV_A
        STA_DECODE(nunits - 1 - u, it);
#else
        STA_DECODE(u, it);
#endif
        stageA_load(cur, F, P, mixer_, b_, h_, dir_, c_);
        if (mixer_ == 0) stageA_compute<0>(cur, F, KVS, DBUF, b_, h_, dir_, c_, lblog, 0.f);
        else stageA_compute<1>(cur, F, KVS, DBUF, b_, h_, dir_, c_, nullptr, sigmf(rdec[dir_ * 4 + h_]));
    }
#undef STA_DECODE
}
template <int MIXER, bool DRY = false>
__device__ __forceinline__ void recur_stageB_seq(Frame& F, bf16* KVS, const float* DBUF, int seq, float gamma) {
    const int e = F.tid >> 3, d8 = F.tid & 7;
    bf16* base = KVS + (size_t)seq * 36 * 4096 + e * 64 + d8 * 8; const float* db = DBUF + (size_t)seq * 36 * 64 + d8 * 8;
    float S[8];
#pragma unroll
    for (int i = 0; i < 8; ++i) S[i] = 0.f;
    const float g64 = (MIXER == 1) ? exp2f(64.0f * __log2f(gamma)) : 0.f;
    constexpr int GB = 4;
    v4u kv[GB], kvn[GB]; f32x4 da[GB], dbv[GB], dan[GB], dbn[GB];
#pragma unroll
    for (int i = 0; i < GB; ++i) { kv[i] = *(const v4u*)(base + (size_t)i * 4096); da[i] = (f32x4){g64, g64, g64, g64}; dbv[i] = da[i];
        if (MIXER == 0) { da[i] = *(const f32x4*)(db + i * 64); dbv[i] = *(const f32x4*)(db + i * 64 + 4); } }
    for (int c0 = 0; c0 < 36; c0 += GB) {
#pragma unroll
        for (int i = 0; i < GB; ++i) { kvn[i] = kv[i]; dan[i] = da[i]; dbn[i] = dbv[i];
            if (c0 + GB < 36) { kvn[i] = *(const v4u*)(base + (size_t)(c0 + GB + i) * 4096); if (MIXER == 0) { dan[i] = *(const f32x4*)(db + (c0 + GB + i) * 64); dbn[i] = *(const f32x4*)(db + (c0 + GB + i) * 64 + 4); } } }
#pragma unroll
        for (int i = 0; i < GB; ++i) {
            v4u so; so.x = pk2(S[0], S[1]); so.y = pk2(S[2], S[3]); so.z = pk2(S[4], S[5]); so.w = pk2(S[6], S[7]);
            if (DRY) { so = kv[i]; asm volatile("" : "+v"(S[0]), "+v"(S[7])); }
            *(v4u*)(base + (size_t)(c0 + i) * 4096) = so;
            const float dd[8] = {da[i].x, da[i].y, da[i].z, da[i].w, dbv[i].x, dbv[i].y, dbv[i].z, dbv[i].w}; const unsigned kw[4] = {kv[i].x, kv[i].y, kv[i].z, kv[i].w};
#pragma unroll
            for (int q = 0; q < 4; ++q) { S[2 * q] = dd[2 * q] * S[2 * q] + bflo(kw[q]); S[2 * q + 1] = dd[2 * q + 1] * S[2 * q + 1] + bfhi(kw[q]); }
        }
#pragma unroll
        for (int i = 0; i < GB; ++i) { kv[i] = kvn[i]; da[i] = dan[i]; dbv[i] = dbn[i]; }
    }
}
struct StageCRaw { v4u q[2], k[2], v[2]; v4u s0, s1, g; };
template <int MIXER>
__device__ __forceinline__ void stageC_load(StageCRaw& R, const Frame& F, const bf16* P, const bf16* KVS, int b, int h, int tb) {
    using namespace rc;
    const int dir = F.wave >> 2, wq = F.wave & 3, lane = F.lane, tr = lane >> 3, ch = lane & 7;
    const int c = (dir == 0) ? tb : (tb < 4 ? 3 - tb : 39 - tb), seq = seq_of(MIXER, b, h, dir);
    const int cq = (MIXER == 0 ? C_HQ : C_RQ) + h * 64 + 8 * ch, ck = (MIXER == 0 ? C_HZ + 256 * dir : C_RK) + h * 64 + 8 * ch, cv = (MIXER == 0 ? C_HI : C_RV) + h * 64 + 8 * ch;
    const int j0 = row_in_batch(dir, c * 64 + 16 * wq + tr); const long step = (dir == 0) ? 8L * NPROJ : -8L * NPROJ;
    const bf16* rp = P + (size_t)(b * RPB + j0) * NPROJ;
#pragma unroll
    for (int ii = 0; ii < 2; ++ii) { R.q[ii] = *(const v4u*)(rp + cq); R.k[ii] = *(const v4u*)(rp + ck); R.v[ii] = *(const v4u*)(rp + cv); rp += step; }
    const bf16* src = KVS + (size_t)(seq * 36 + c) * 4096; const int t256 = wq * 64 + lane;
    R.s0 = *(const v4u*)(src + (t256 >> 3) * 64 + (t256 & 7) * 8); R.s1 = *(const v4u*)(src + ((t256 + 256) >> 3) * 64 + (t256 & 7) * 8);
    { const int tok = F.tid >> 3, ech = F.tid & 7; R.g = *(const v4u*)(P + (size_t)(b * RPB + tb * 64 + tok) * NPROJ + (MIXER == 0 ? C_HG : C_RG) + h * 64 + 8 * ech); }
}
template <int MIXER>
__device__ __forceinline__ void stageC_compute(const StageCRaw& R, Frame& F, bf16* ACTo, int b, int h, int tb, const float* lblog, const float* rdec, const float* gain) {
    using namespace rc;
    const int dir = F.wave >> 2, wq = F.wave & 3, lane = F.lane, tr = lane >> 3, ch = lane & 7;
    LAS unsigned char* SL = F.lds + dir * SLOT;
    { const int t256 = wq * 64 + lane;
      *(LAS v4u*)(SL + O_ST + (t256 >> 3) * PT + (t256 & 7) * 16) = R.s0; *(LAS v4u*)(SL + O_ST + ((t256 + 256) >> 3) * PT + (t256 & 7) * 16) = R.s1; }
#pragma unroll
    for (int ii = 0; ii < 2; ++ii) { const int t = 16 * wq + tr + 8 * ii; const unsigned vw[4] = {R.v[ii].x, R.v[ii].y, R.v[ii].z, R.v[ii].w};
#pragma unroll
        for (int x = 0; x < 4; ++x) { *(LAS unsigned short*)(SL + O_VT + (8 * ch + 2 * x) * PT + t * 2) = (unsigned short)(vw[x] & 0xffffu); *(LAS unsigned short*)(SL + O_VT + (8 * ch + 2 * x + 1) * PT + t * 2) = (unsigned short)(vw[x] >> 16); } }
    if (MIXER == 0) {
#pragma unroll
        for (int ii = 0; ii < 2; ++ii) { const int t = 16 * wq + tr + 8 * ii; *(LAS v4u*)(SL + O_QP + t * PT + 16 * ch) = R.q[ii]; *(LAS v4u*)(SL + O_KP + t * PT + 16 * ch) = R.k[ii]; }
        float qv[16], kv[16], q2[16];
#pragma unroll
        for (int i = 0; i < 16; ++i) { qv[i] = bf1(*(const LAS unsigned short*)(SL + O_QP + (16 * wq + i) * PT + 2 * lane)); kv[i] = bf1(*(const LAS unsigned short*)(SL + O_KP + (16 * wq + i) * PT + 2 * lane)); }
        const float lb = lblog ? sigmf(lblog[512 + dir * 256 + h * 64 + lane] - lblog[dir * 256 + h * 64 + lane]) : 0.f;
        float lc[16]; float run = 1.f;
#pragma unroll
        for (int i = 0; i < 16; ++i) { const float f = lb + (1.0f - lb) * sigmf(kv[i]); run *= f; lc[i] = run; kv[i] = 1.0f - f; }
        LAS float* TOT = (LAS float*)(SL + O_TOT); TOT[wq * 64 + lane] = run;
        __syncthreads();
        float pre = 1.f;
#pragma unroll
        for (int q = 0; q < 4; ++q) { const float t = TOT[q * 64 + lane]; if (q < wq) pre *= t; }
        const float rmid = __builtin_amdgcn_rcpf(fmaxf(TOT[lane] * TOT[64 + lane], 1e-30f));
#pragma unroll
        for (int i = 0; i < 16; ++i) { const float pt = pre * lc[i]; q2[i] = qv[i] * pt; const float e1 = fminf(fmaxf(pt * rmid, 1e-30f), 1e30f); qv[i] *= e1; kv[i] *= __builtin_amdgcn_rcpf(e1); }
#pragma unroll
        for (int i = 0; i < 16; ++i) { const int t = 16 * wq + i;
            *(LAS unsigned short*)(SL + O_QP + t * PT + lane * 2) = (unsigned short)f2bf(qv[i]);
            *(LAS unsigned short*)(SL + O_KP + t * PT + lane * 2) = (unsigned short)f2bf(kv[i]);
            *(LAS unsigned short*)(SL + O_QQ + t * PT + lane * 2) = (unsigned short)f2bf(q2[i]); }
    } else {
        const float lg2 = __log2f(sigmf(rdec[dir * 4 + h]));
#pragma unroll
        for (int ii = 0; ii < 2; ++ii) { const int t = 16 * wq + tr + 8 * ii; const float gq = exp2f((float)(t + 1) * lg2) * 0.125f;
            const unsigned qw[4] = {R.q[ii].x, R.q[ii].y, R.q[ii].z, R.q[ii].w}; v4u q1, q2v;
            { unsigned o1[4], o2[4];
#pragma unroll
              for (int x = 0; x < 4; ++x) { const float lo = bflo(qw[x]), hi2 = bfhi(qw[x]); o1[x] = pk2(lo * 0.125f, hi2 * 0.125f); o2[x] = pk2(lo * gq, hi2 * gq); }
              q1 = (v4u){o1[0], o1[1], o1[2], o1[3]}; q2v = (v4u){o2[0], o2[1], o2[2], o2[3]}; }
            *(LAS v4u*)(SL + O_QP + t * PT + 16 * ch) = q1; *(LAS v4u*)(SL + O_QQ + t * PT + 16 * ch) = q2v; *(LAS v4u*)(SL + O_KP + t * PT + 16 * ch) = R.k[ii]; }
    }
    __syncthreads();
    const int ti = wq >> 1, tj = wq & 1, r32 = lane & 31, hi = lane >> 5;
    if (tj <= ti) {
        f32x16 a = {0.f, 0.f, 0.f, 0.f, 0.f, 0.f, 0.f, 0.f, 0.f, 0.f, 0.f, 0.f, 0.f, 0.f, 0.f, 0.f};
#pragma unroll
        for (int kkk = 0; kkk < 4; ++kkk) a = __builtin_amdgcn_mfma_f32_32x32x16_bf16(frag32(SL + O_QP, 32 * ti + r32, 16 * kkk, hi), frag32(SL + O_KP, 32 * tj + r32, 16 * kkk, hi), a, 0, 0, 0);
        const float lg2 = (MIXER == 1) ? __log2f(sigmf(rdec[dir * 4 + h])) : 0.f;
#pragma unroll
        for (int r = 0; r < 16; ++r) { const int dt = 32 * (ti - tj) + crow(r, hi) - r32; float val = a[r];
            if (MIXER == 1) val *= exp2f((float)dt * lg2);
            if (dt < 0) val = 0.f;
            *(LAS unsigned short*)(SL + O_AT + (32 * ti + crow(r, hi)) * PT + (32 * tj + r32) * 2) = (unsigned short)f2bf(val); }
    }
    __syncthreads();
    f32x16 o = {0.f, 0.f, 0.f, 0.f, 0.f, 0.f, 0.f, 0.f, 0.f, 0.f, 0.f, 0.f, 0.f, 0.f, 0.f, 0.f};
#pragma unroll
    for (int st = 0; st < 2; ++st) if (st <= ti) {
#pragma unroll
        for (int kkk = 0; kkk < 2; ++kkk) o = __builtin_amdgcn_mfma_f32_32x32x16_bf16(frag32(SL + O_AT, 32 * ti + r32, 32 * st + 16 * kkk, hi), frag32(SL + O_VT, 32 * tj + r32, 32 * st + 16 * kkk, hi), o, 0, 0, 0); }
#pragma unroll
    for (int kkk = 0; kkk < 4; ++kkk) o = __builtin_amdgcn_mfma_f32_32x32x16_bf16(frag32(SL + O_QQ, 32 * ti + r32, 16 * kkk, hi), frag32(SL + O_ST, 32 * tj + r32, 16 * kkk, hi), o, 0, 0, 0);
    { LAS unsigned char* OX = F.lds + 2 * SLOT + dir * MB;
#pragma unroll
      for (int r = 0; r < 16; ++r) *(LAS unsigned short*)(OX + (32 * ti + crow(r, hi)) * PT + (32 * tj + r32) * 2) = (unsigned short)f2bf(o[r]); }
    __syncthreads();
    { const int tok = F.tid >> 3, ech = F.tid & 7, row = b * RPB + tb * 64 + tok;
      const v4u fw = *(const LAS v4u*)(F.lds + 2 * SLOT + tok * PT + 16 * ech), bw = *(const LAS v4u*)(F.lds + 2 * SLOT + MB + (63 - tok) * PT + 16 * ech);
      const unsigned fws[4] = {fw.x, fw.y, fw.z, fw.w}, bws[4] = {bw.x, bw.y, bw.z, bw.w};
      float ov[8]; float ss = 0.f;
#pragma unroll
      for (int i = 0; i < 4; ++i) { ov[2 * i] = bflo(fws[i]) + bflo(bws[i]); ov[2 * i + 1] = bfhi(fws[i]) + bfhi(bws[i]); ss += ov[2 * i] * ov[2 * i] + ov[2 * i + 1] * ov[2 * i + 1]; }
      ss += xshf<1>(ss); ss += xshf<2>(ss); ss += xshf<4>(ss);
      const float rs = __builtin_amdgcn_rsqf(ss * (1.0f / 64.0f) + NORM_EPS);
      const f32x4 ga = *(const f32x4*)(gain + h * 64 + 8 * ech), gb = *(const f32x4*)(gain + h * 64 + 8 * ech + 4);
      const float gg[8] = {ga.x, ga.y, ga.z, ga.w, gb.x, gb.y, gb.z, gb.w}; const unsigned gws[4] = {R.g.x, R.g.y, R.g.z, R.g.w};
      float res[8];
#pragma unroll
      for (int i = 0; i < 4; ++i) { res[2 * i] = ov[2 * i] * rs * gg[2 * i] * siluf(bflo(gws[i])); res[2 * i + 1] = ov[2 * i + 1] * rs * gg[2 * i + 1] * siluf(bfhi(gws[i])); }
#ifdef OUTPROJ_FP8
      v2u w2; w2.x = pk4_fp8(res[0] * 4.0f, res[1] * 4.0f, res[2] * 4.0f, res[3] * 4.0f); w2.y = pk4_fp8(res[4] * 4.0f, res[5] * 4.0f, res[6] * 4.0f, res[7] * 4.0f);
      *(v2u*)((unsigned char*)ACTo + (size_t)(row >> 1) * 2048 + ((MIXER == 0 ? 0 : 8) + h) * 128 + (row & 1) * 64 + 8 * ech) = w2; }
#else
      v4u w4; w4.x = pk2(res[0], res[1]); w4.y = pk2(res[2], res[3]); w4.z = pk2(res[4], res[5]); w4.w = pk2(res[6], res[7]);
      *(v4u*)(ACTo + (size_t)row * DM + (MIXER == 0 ? 0 : 512) + h * 64 + 8 * ech) = w4; }
#endif
}
__device__ __forceinline__ void recur_stageC_loop(Frame& F, const bf16* P, const bf16* KVS, bf16* ACTo, int mh0, int ub0, int stride, int nub, int ntb, int tboff, const float* lblog, const float* rdec, const float* hn, const float* rn) {
    if (ub0 >= nub) return;
    StageCRaw cur, nxt;
    { const int mh = mh0 & 7; if ((mh >> 2) == 0) stageC_load<0>(cur, F, P, KVS, ub0 / ntb, mh & 3, tboff + ub0 % ntb); else stageC_load<1>(cur, F, P, KVS, ub0 / ntb, mh & 3, tboff + ub0 % ntb); }
    int i = 0;
    for (int ub = ub0; ub < nub; ub += stride, ++i) {
        const int un = ub + stride; const bool more = un < nub; const int mh = (mh0 + i) & 7, mhn = (mh0 + i + 1) & 7;
        if (more) { if ((mhn >> 2) == 0) stageC_load<0>(nxt, F, P, KVS, un / ntb, mhn & 3, tboff + un % ntb); else stageC_load<1>(nxt, F, P, KVS, un / ntb, mhn & 3, tboff + un % ntb); }
        if ((mh >> 2) == 0) stageC_compute<0>(cur, F, ACTo, ub / ntb, mh & 3, tboff + ub % ntb, lblog, rdec, hn);
        else stageC_compute<1>(cur, F, ACTo, ub / ntb, mh & 3, tboff + ub % ntb, nullptr, rdec, rn);
        if (more) cur = nxt;
    }
}
__device__ __forceinline__ void phase_conv(Frame& F, const bf16* P, bf16* ACTo, const float* convw, bool latent_only) {
    const int gw = F.vcu * NWAVES + F.wave, NGW = F.G * NWAVES, rsel = F.lane >> 5, c0 = 8 * (F.lane & 31);
    f32x4 w0[2], w1[2], w2[2];
#pragma unroll
    for (int hf = 0; hf < 2; ++hf) { w0[hf] = *(const f32x4*)(convw + c0 + 4 * hf); w1[hf] = *(const f32x4*)(convw + 256 + c0 + 4 * hf); w2[hf] = *(const f32x4*)(convw + 512 + c0 + 4 * hf); }
    const int nrows = latent_only ? NB * T_LAT : MROWS;
    auto ld8 = [](const bf16* p, f32x4& a, f32x4& b) { const v4u w = *(const v4u*)p; a = (f32x4){bflo(w.x), bfhi(w.x), bflo(w.y), bfhi(w.y)}; b = (f32x4){bflo(w.z), bfhi(w.z), bflo(w.w), bfhi(w.w)}; };
    for (int idx2 = gw; 2 * idx2 < nrows; idx2 += NGW) {
        const int idx = 2 * idx2 + rsel;
        const int r = latent_only ? row_of_latent(idx) : idx;
        const int b = r / RPB, j = r - b * RPB;
        const bf16* row = P + (size_t)r * NPROJ;
        const bool first = (j == 0) || (j == L_CTX), last = (j == L_CTX - 1) || (j == RPB - 1);
        f32x4 ca, cb, ha, hb, u1a, u1b, u0a = (f32x4){0.f, 0.f, 0.f, 0.f}, u0b = u0a, u2a = u0a, u2b = u0a;
        ld8(row + C_CC + c0, ca, cb); ld8(row + C_CH + c0, ha, hb); u1a = ca * ha; u1b = cb * hb;
        if (!first) { ld8(row - NPROJ + C_CC + c0, ca, cb); ld8(row - NPROJ + C_CH + c0, ha, hb); u0a = ca * ha; u0b = cb * hb; }
        if (!last) { ld8(row + NPROJ + C_CC + c0, ca, cb); ld8(row + NPROJ + C_CH + c0, ha, hb); u2a = ca * ha; u2b = cb * hb; }
        f32x4 ba, bb2; ld8(row + C_CB + c0, ba, bb2);
        const f32x4 xa = ba * (w0[0] * u0a + w1[0] * u1a + w2[0] * u2a), xb = bb2 * (w0[1] * u0b + w1[1] * u1b + w2[1] * u2b);
#ifdef OUTPROJ_FP8
        { const f32x4 ya = xa * 4.0f, yb = xb * 4.0f; v2u w2; w2.x = pk4_fp8(ya.x, ya.y, ya.z, ya.w); w2.y = pk4_fp8(yb.x, yb.y, yb.z, yb.w); *(v2u*)((unsigned char*)ACTo + (size_t)(r >> 1) * 2048 + (4 + (c0 >> 6)) * 128 + (r & 1) * 64 + (c0 & 63)) = w2; }
#else
        v4u w; w.x = pk2(xa.x, xa.y); w.y = pk2(xa.z, xa.w); w.z = pk2(xb.x, xb.y); w.w = pk2(xb.z, xb.w); *(v4u*)(ACTo + (size_t)r * DM + 256 + c0) = w;
#endif
    }
}
struct DenseOrder {
    int nM, nN, nwg, G, c, latent_only; const char* A; const char* Bt; size_t tA, tB; unsigned long long pnmap;
    __device__ __forceinline__ void init(int nM_, int nN_, int G_, int c_, int lat, const void* A_, const void* Bt_, int lda, int ldb) {
        nM = nM_; nN = nN_; nwg = nM * nN; G = G_; c = c_; latent_only = lat; A = (const char*)A_; Bt = (const char*)Bt_; tA = (size_t)256 * lda * 2; tB = (size_t)256 * ldb * 2; pnmap = 0xFEDCBA9876543210ull; }
    __device__ __forceinline__ bool next(int i, pg8::Unit& u) const {
        const long L = (long)i * G + c; if (L >= nwg) return false;
        int wgid = (int)L; { const int q = nwg / pg8::NXCD, r = nwg % pg8::NXCD, xcd = wgid % pg8::NXCD, off = wgid / pg8::NXCD; wgid = (xcd < r ? xcd * (q + 1) : r * (q + 1) + (xcd - r) * q) + off; }
#ifndef DENSE_WGM
#define DENSE_WGM 8
#endif
        const int nig = DENSE_WGM * nN, gid = wgid / nig, fm = gid * DENSE_WGM, gsz = (nM - fm) < DENSE_WGM ? (nM - fm) : DENSE_WGM;
        int pm = fm + ((wgid % nig) % gsz); const int pn = (int)((pnmap >> (4 * ((wgid % nig) / gsz))) & 15ull);
        if (latent_only) pm = (pm >> 3) * PPB + 1 + (pm & 7);
        u.pm = pm; u.pn = pn; u.x0 = 0; u.x1 = 0; u.a = A + (size_t)pm * tA; u.b = Bt + (size_t)pn * tB; u.b2 = u.b; return true; }
    __device__ __forceinline__ void a_ready(const pg8::Unit&) const {}
    __device__ __forceinline__ void done(const pg8::Unit&) const {}
};
struct MoeOrder {
    int ncol, nwg, G, c, down, pm0; const LAS int* tileb; const char* A; const char* W;
    __device__ __forceinline__ bool next(int i, pg8::Unit& u) const {
        const long L = (long)i * G + c; if (L >= nwg) return false;
        int w = (int)L; { const int q = nwg / pg8::NXCD, r = nwg % pg8::NXCD, xcd = w % pg8::NXCD, off = w / pg8::NXCD; w = (xcd < r ? xcd * (q + 1) : r * (q + 1) + (xcd - r) * q) + off; }
        const int pm = pm0 + w / ncol, pc = w % ncol;
        const int k = __builtin_amdgcn_readfirstlane(tileb[pm]), g = k / 6, pr = k % 6;
        const int ea = pr < 3 ? 0 : (pr < 5 ? 1 : 2), eb = pr < 3 ? pr + 1 : (pr < 5 ? pr - 1 : 3);
        u.pm = pm; u.pn = pc; u.x0 = 0; u.x1 = 0; u.a = down ? A + (size_t)pm * 256 * 1024 : A;
        if (!down) { const int e = g * 4 + (pc < 4 ? ea : eb); u.b = W + (size_t)(e * 4 + (pc & 3)) * 256 * 1024; u.b2 = u.b; }
        else { const char* base = W + (size_t)(g * 1024 + pc * 256) * 2048; u.b = base + ea * 512; u.b2 = base + eb * 512 - 512; }
        return true; }
    __device__ __forceinline__ void a_ready(const pg8::Unit&) const {}
    __device__ __forceinline__ void done(const pg8::Unit&) const {}
};
struct EpiStore {
    static constexpr bool PERM = true, PERMH = false, AFTER_DRAIN = false;
    bf16* O; int ldc; float sc;
    __device__ __forceinline__ void operator()(const f32x4 (&acc)[2][2][4][2], const pg8::Unit& u, int wr, int wc, int fr, int fq) const {
        const int row0 = u.pm * 256 + wr * 64 + fr, col0 = u.pn * 256 + wc * 32 + 8 * fq;
#pragma unroll
        for (int ai = 0; ai < 2; ++ai)
#pragma unroll
            for (int m = 0; m < 4; ++m) { bf16* rowp = O + (size_t)(row0 + ai * 128 + m * 16) * ldc + col0;
#pragma unroll
                for (int bj = 0; bj < 2; ++bj) { const f32x4 v0 = acc[ai][bj][m][0] * sc, v1 = acc[ai][bj][m][1] * sc;
                    v4u w; w.x = pg8::cvt_pk_bf16(v0[0], v0[1]); w.y = pg8::cvt_pk_bf16(v0[2], v0[3]); w.z = pg8::cvt_pk_bf16(v1[0], v1[1]); w.w = pg8::cvt_pk_bf16(v1[2], v1[3]);
                    *(v4u*)(rowp + bj * 128) = w; } }
    }
};
struct EpiStoreQK {
    static constexpr bool PERM = true, PERMH = true, AFTER_DRAIN = false;
    bf16* O; int ldc; float sc; const float* qn; const float* kn; const float* RC; const float* RS;
    __device__ __forceinline__ void operator()(const f32x4 (&acc)[2][2][4][2], const pg8::Unit& u, int wr, int wc, int fr, int fq) const {
        const int row0 = u.pm * 256 + wr * 64 + fr, col0 = u.pn * 256 + wc * 64 + 8 * fq;
        const bool isq = u.pn == 12, isk = (u.pn == 13) && (wc < 2), prep = isq || isk;
        const int b = u.pm / PPB, pj = u.pm - b * PPB; const bool lat = pj > 0;
        f32x4 gv[2][2] = {{{1.f, 1.f, 1.f, 1.f}, {1.f, 1.f, 1.f, 1.f}}, {{1.f, 1.f, 1.f, 1.f}, {1.f, 1.f, 1.f, 1.f}}};
        if (prep) { const float* gp = (isq ? qn : kn) + 8 * fq;
#pragma unroll
            for (int bj = 0; bj < 2; ++bj) { gv[bj][0] = *(const f32x4*)(gp + bj * 32); gv[bj][1] = *(const f32x4*)(gp + bj * 32 + 4); } }
        constexpr float C2 = 0.125f * 1.4426950408889634f;
#pragma unroll
        for (int ai = 0; ai < 2; ++ai)
#pragma unroll
            for (int m = 0; m < 4; ++m) { const int rl = wr * 64 + fr + ai * 128 + m * 16; bf16* rowp = O + (size_t)(u.pm * 256 + rl) * ldc + col0;
                f32x4 v[2][2]; float ss = 0.f;
#pragma unroll
                for (int bj = 0; bj < 2; ++bj)
#pragma unroll
                    for (int n = 0; n < 2; ++n) { v[bj][n] = acc[ai][bj][m][n] * sc; ss += (v[bj][n].x * v[bj][n].x + v[bj][n].y * v[bj][n].y) + (v[bj][n].z * v[bj][n].z + v[bj][n].w * v[bj][n].w); }
                if (prep) {
                    ss += xshf<16>(ss); ss = half_sum(ss);
                    const float rstd = __builtin_amdgcn_rsqf(ss * (1.0f / 64.0f) + NORM_EPS) * (isq ? C2 : 1.0f);
#pragma unroll
                    for (int bj = 0; bj < 2; ++bj) { f32x4 cs = {1.f, 1.f, 1.f, 1.f}, sn = {0.f, 0.f, 0.f, 0.f};
                        if (lat) { const size_t to = (size_t)((pj - 1) * 256 + rl) * 32 + bj * 16 + 4 * fq; cs = *(const f32x4*)(RC + to); sn = *(const f32x4*)(RS + to); }
                        const f32x4 y0 = v[bj][0] * rstd * gv[bj][0], y1 = v[bj][1] * rstd * gv[bj][1];
                        v[bj][0] = (f32x4){y0.x * cs.x - y0.y * sn.x, y0.x * sn.x + y0.y * cs.x, y0.z * cs.y - y0.w * sn.y, y0.z * sn.y + y0.w * cs.y};
                        v[bj][1] = (f32x4){y1.x * cs.z - y1.y * sn.z, y1.x * sn.z + y1.y * cs.z, y1.z * cs.w - y1.w * sn.w, y1.z * sn.w + y1.w * cs.w}; } }
#pragma unroll
                for (int bj = 0; bj < 2; ++bj) { const f32x4 v0 = v[bj][0], v1 = v[bj][1];
                    v4u w; w.x = pg8::cvt_pk_bf16(v0[0], v0[1]); w.y = pg8::cvt_pk_bf16(v0[2], v0[3]); w.z = pg8::cvt_pk_bf16(v1[0], v1[1]); w.w = pg8::cvt_pk_bf16(v1[2], v1[3]);
                    *(v4u*)(rowp + bj * 32) = w; } }
        (void)row0;
    }
};
struct EpiResid {
    static constexpr bool PERM = false, PERMH = false, AFTER_DRAIN = false;
    const float* xsrc; const float* csrc; float* xdst; float* cdst; const float* gate; float sc;
    __device__ __forceinline__ void operator()(const f32x4 (&acc)[2][2][4][2], const pg8::Unit& u, int wr, int wc, int fr, int fq) const {
        const int b = u.pm / PPB, pj = u.pm - b * PPB; const bool isc = pj == 0;
        const float* src = isc ? csrc + (size_t)b * L_CTX * DM : xsrc + (size_t)(b * T_LAT + (pj - 1) * 256) * DM;
        float* dst = isc ? cdst + (size_t)b * L_CTX * DM : xdst + (size_t)(b * T_LAT + (pj - 1) * 256) * DM;
        const int col0 = u.pn * 256 + wc * 32 + 4 * fq; const float* gp = gate + (isc ? 16 : b) * 1024 + col0;
        f32x4 gv[2][2];
#pragma unroll
        for (int bj = 0; bj < 2; ++bj)
#pragma unroll
            for (int n = 0; n < 2; ++n) gv[bj][n] = *(const f32x4*)(gp + bj * 128 + n * 16) * sc;
#pragma unroll
        for (int ai = 0; ai < 2; ++ai)
#pragma unroll
            for (int m = 0; m < 4; ++m) { const size_t off = (size_t)(ai * 128 + wr * 64 + m * 16 + fr) * DM + col0;
#pragma unroll
                for (int bj = 0; bj < 2; ++bj)
#pragma unroll
                    for (int n = 0; n < 2; ++n) *(f32x4*)(dst + off + bj * 128 + n * 16) = LDNT((const f32x4*)(src + off + bj * 128 + n * 16)) + gv[bj][n] * acc[ai][bj][m][n];
                if (m & 1) asm volatile("" ::: "memory"); }
    }
};
struct EpiGateUp {
    static constexpr bool PERM = true, PERMH = false, AFTER_DRAIN = false;
    unsigned char* H; const v4i* rowinfo;
    __device__ __forceinline__ void operator()(const f32x4 (&acc)[2][2][4][2], const pg8::Unit& u, int wr, int wc, int fr, int fq) const {
        const int pos0 = u.pm * 256 + wr * 64 + fr, col0 = u.pn * 128 + wc * 32 + 8 * fq; const bool second = u.pn >= 4;
#pragma unroll
        for (int ai = 0; ai < 2; ++ai)
#pragma unroll
            for (int m = 0; m < 4; ++m) { const int pos = pos0 + ai * 128 + m * 16; const v4i ri = rowinfo[pos];
                const float w = __builtin_bit_cast(float, second ? ri.z : ri.y) * (16.0f / 32.0f);
                const f32x4 g0 = acc[ai][0][m][0] * (1.0f / 32.0f), g1 = acc[ai][0][m][1] * (1.0f / 32.0f), u0 = acc[ai][1][m][0], u1 = acc[ai][1][m][1];
                float h[8];
#pragma unroll
                for (int i = 0; i < 4; ++i) { h[i] = siluf(g0[i]) * u0[i] * w; h[4 + i] = siluf(g1[i]) * u1[i] * w; }
                v2u o; o.x = pk4_fp8(h[0], h[1], h[2], h[3]); o.y = pk4_fp8(h[4], h[5], h[6], h[7]);
                *(v2u*)(H + (size_t)pos * 1024 + col0) = o; }
    }
};
struct EpiDown {
    static constexpr bool PERM = false, PERMH = false, AFTER_DRAIN = false;
    float* xdst; float* cdst; const float* gate; const v4i* rowinfo;
    __device__ __forceinline__ void operator()(const f32x4 (&acc)[2][2][4][2], const pg8::Unit& u, int wr, int wc, int fr, int fq) const {
        const int pos0 = u.pm * 256 + wr * 64 + fr, col0 = u.pn * 256 + wc * 32 + 4 * fq;
#pragma unroll
        for (int ai = 0; ai < 2; ++ai)
#pragma unroll
            for (int m = 0; m < 4; ++m) { const int r = rowinfo[pos0 + ai * 128 + m * 16].x;
#ifdef ZERO_MOE
                if (false) {
#else
                if (r >= 0) {
#endif
                    const int b = r / RPB, j = r - b * RPB; const bool isc = j < L_CTX;
                    float* dst = (isc ? cdst + (size_t)(b * L_CTX + j) * DM : xdst + (size_t)(b * T_LAT + j - L_CTX) * DM) + col0;
                    const float* gp = gate + (isc ? 16 : b) * 1024 + col0;
#pragma unroll
                    for (int bj = 0; bj < 2; ++bj)
#pragma unroll
                        for (int n = 0; n < 2; ++n) { float* p = dst + bj * 128 + n * 16; *(f32x4*)p = LDNT((const f32x4*)p) + *(const f32x4*)(gp + bj * 128 + n * 16) * (acc[ai][bj][m][n] * (1.0f / 512.0f)); } }
                if (m & 1) asm volatile("" ::: "memory"); }
    }
};

__device__ __forceinline__ void phase_norm2_route(Frame& F, int layer, const float* xsrc, const float* csrc, const float* nA, const float* nB, bf16* dst, bool latent_only) {
    typedef short bf16x8v __attribute__((ext_vector_type(8))); typedef float f32x4v __attribute__((ext_vector_type(4)));
    unsigned char* const ws = PWS;
    LAS int* cnt = (LAS int*)(F.lds + TAB_OFF);
    LAS float* MA = (LAS float*)(F.lds); LAS float* MBv = MA + 2048;
    LAS float* SSP = MA + 4096;
    LAS float* PART = SSP + 128;
    LAS float* LOG = PART + 8 * 16 * 32;
    const int lane = F.lane, wv = F.wave, r16 = lane & 15, g = lane >> 4, k0w = 128 * wv;
    const int nrows = latent_only ? NB * T_LAT : MROWS, NGW = F.G * NWAVES, RPW = (nrows + NGW - 1) / NGW, RPBLK = NWAVES * RPW;
    const int ib0 = (int)blockIdx.x * RPBLK, ib1 = (ib0 + RPBLK < nrows) ? ib0 + RPBLK : nrows;
    int mfirst = 0, mlast = 0;
    if (ib0 < ib1) { const int ra = latent_only ? row_of_latent(ib0) : ib0, rb = latent_only ? row_of_latent(ib1 - 1) : ib1 - 1;
      const int ba = ra / RPB, ja = ra - ba * RPB, bb_ = rb / RPB, jb = rb - bb_ * RPB; mfirst = (ja < L_CTX) ? 16 : ba; mlast = (jb < L_CTX) ? 16 : bb_; }
    for (int i = F.tid; i < 512; i += NTHR) { const int sl = i >> 8, c4 = (i & 255) * 4, mm = sl ? mlast : mfirst;
        *(LAS f32x4*)(MA + sl * 1024 + c4) = *(const f32x4*)(nA + mm * 1024 + c4); *(LAS f32x4*)(MBv + sl * 1024 + c4) = *(const f32x4*)(nB + mm * 1024 + c4); }
    if (F.tid < 24) cnt[F.tid] = 0;
    bf16x8v Bh[4][2], Bl[4][2];
    { const float* rgw = PIN(I_RGW) + (size_t)layer * 1024 * 4; const float* rew = PIN(I_REW) + (size_t)layer * 1024 * 16;
#pragma unroll
      for (int s = 0; s < 4; ++s)
#pragma unroll
          for (int t = 0; t < 2; ++t) { const int n = 16 * t + r16, kb = k0w + 32 * s + 8 * g; unsigned hw[4], lw[4];
#pragma unroll
              for (int i2 = 0; i2 < 4; ++i2) { float w0 = 0.f, w1 = 0.f;
                  if (n < 4) { w0 = rgw[(kb + 2 * i2) * 4 + n]; w1 = rgw[(kb + 2 * i2 + 1) * 4 + n]; } else if (n < 20) { w0 = rew[(kb + 2 * i2) * 16 + n - 4]; w1 = rew[(kb + 2 * i2 + 1) * 16 + n - 4]; }
                  const unsigned hp = pk2(w0, w1); hw[i2] = hp; lw[i2] = pk2(w0 - bflo(hp), w1 - bfhi(hp)); }
              Bh[s][t] = __builtin_bit_cast(bf16x8v, (v4u){hw[0], hw[1], hw[2], hw[3]}); Bl[s][t] = __builtin_bit_cast(bf16x8v, (v4u){lw[0], lw[1], lw[2], lw[3]}); } }
    float biasn = 0.f; { const int n = F.tid & 31; if (n < 4) biasn = PIN(I_RGB)[layer * 4 + n]; else if (n < 20) biasn = PIN(I_REB)[layer * 16 + n - 4]; }
    v4i* ROUTE = (v4i*)(ws + WS_ROUTE);
    __syncthreads();
#ifdef ROUTE_PREFETCH
#define ROUTE_SRC(G0) ({ const int idx_ = ((G0) + r16) < ib1 ? (G0) + r16 : ib1 - 1; const int r_ = latent_only ? row_of_latent(idx_) : idx_; const int b_ = r_ / RPB, j_ = r_ - b_ * RPB; \
        ((j_ < L_CTX) ? csrc + (size_t)(b_ * L_CTX + j_) * DM : xsrc + (size_t)(b_ * T_LAT + j_ - L_CTX) * DM) + k0w + 8 * g; })
    f32x4 xv[4][2], xn[4][2];
    if (ib0 < ib1) { const float* s0 = ROUTE_SRC(ib0);
#pragma unroll
        for (int s = 0; s < 4; ++s) { xv[s][0] = *(const f32x4*)(s0 + 32 * s); xv[s][1] = *(const f32x4*)(s0 + 32 * s + 4); } }
#endif
    for (int g0 = ib0; g0 < ib1; g0 += 16) {
        const bool valid = (g0 + r16) < ib1; const int idx = valid ? g0 + r16 : ib1 - 1;
        const int r = latent_only ? row_of_latent(idx) : idx;
        const int b = r / RPB, j = r - b * RPB, m = (j < L_CTX) ? 16 : b, slot = (m != mfirst) ? 1024 : 0;
        float ss = 0.f;
#ifdef ROUTE_PREFETCH
        { const float* s1 = ROUTE_SRC(g0 + 16 < ib1 ? g0 + 16 : g0);
#pragma unroll
          for (int s = 0; s < 4; ++s) { xn[s][0] = *(const f32x4*)(s1 + 32 * s); xn[s][1] = *(const f32x4*)(s1 + 32 * s + 4); } }
#else
        const float* src = ((j < L_CTX) ? csrc + (size_t)(b * L_CTX + j) * DM : xsrc + (size_t)(b * T_LAT + j - L_CTX) * DM) + k0w + 8 * g;
        f32x4 xv[4][2];
#pragma unroll
        for (int s = 0; s < 4; ++s) { xv[s][0] = LDNT((const f32x4*)(src + 32 * s)); xv[s][1] = LDNT((const f32x4*)(src + 32 * s + 4)); }
#endif
#pragma unroll
        for (int s = 0; s < 4; ++s)
#pragma unroll
            for (int hh = 0; hh < 2; ++hh) { const f32x4 x = xv[s][hh]; ss += (x.x * x.x + x.y * x.y) + (x.z * x.z + x.w * x.w); }
        ss += xshf<16>(ss); ss = half_sum(ss);
        if (lane < 16) SSP[wv * 16 + lane] = ss;
        __syncthreads();
        float tot = 0.f;
#pragma unroll
        for (int w2 = 0; w2 < 8; ++w2) tot += SSP[w2 * 16 + r16];
        const float rstd = __builtin_amdgcn_rsqf(tot * (1.0f / DM) + NORM_EPS);
        f32x4v acc[2] = {{0.f, 0.f, 0.f, 0.f}, {0.f, 0.f, 0.f, 0.f}};
        unsigned char* drow = (unsigned char*)dst + (size_t)r * DM + k0w + 8 * g;
#pragma unroll
        for (int s = 0; s < 4; ++s) { const int co = slot + k0w + 32 * s + 8 * g;
            const f32x4 h0 = xv[s][0] * rstd * *(const LAS f32x4*)(MA + co) + *(const LAS f32x4*)(MBv + co), h1 = xv[s][1] * rstd * *(const LAS f32x4*)(MA + co + 4) + *(const LAS f32x4*)(MBv + co + 4);
            { v2u o; o.x = pk4_fp8(h0.x, h0.y, h0.z, h0.w); o.y = pk4_fp8(h1.x, h1.y, h1.z, h1.w); *(v2u*)(drow + 32 * s) = o; }
            const unsigned p0 = pk2(h0.x, h0.y), p1 = pk2(h0.z, h0.w), p2 = pk2(h1.x, h1.y), p3 = pk2(h1.z, h1.w);
            const unsigned q0 = pk2(h0.x - bflo(p0), h0.y - bfhi(p0)), q1 = pk2(h0.z - bflo(p1), h0.w - bfhi(p1)), q2 = pk2(h1.x - bflo(p2), h1.y - bfhi(p2)), q3 = pk2(h1.z - bflo(p3), h1.w - bfhi(p3));
            const bf16x8v Ah = __builtin_bit_cast(bf16x8v, (v4u){p0, p1, p2, p3}), Al = __builtin_bit_cast(bf16x8v, (v4u){q0, q1, q2, q3});
#pragma unroll
            for (int t = 0; t < 2; ++t) { acc[t] = __builtin_amdgcn_mfma_f32_16x16x32_bf16(Ah, Bh[s][t], acc[t], 0, 0, 0); acc[t] = __builtin_amdgcn_mfma_f32_16x16x32_bf16(Ah, Bl[s][t], acc[t], 0, 0, 0);
                acc[t] = __builtin_amdgcn_mfma_f32_16x16x32_bf16(Al, Bh[s][t], acc[t], 0, 0, 0); } }
#pragma unroll
        for (int t = 0; t < 2; ++t)
#pragma unroll
            for (int x = 0; x < 4; ++x) PART[(wv * 16 + 4 * g + x) * 32 + 16 * t + r16] = acc[t][x];
        __syncthreads();
        { const int row = F.tid >> 5, n = F.tid & 31; float v = biasn;
#pragma unroll
          for (int w2 = 0; w2 < 8; ++w2) v += PART[(w2 * 16 + row) * 32 + n];
          LOG[row * 32 + n] = v; }
        __syncthreads();
        if (F.tid < 16 && (g0 + F.tid) < ib1) {
            const int rr = latent_only ? row_of_latent(g0 + F.tid) : g0 + F.tid;
            float l[20];
#pragma unroll
            for (int jj = 0; jj < 20; ++jj) l[jj] = LOG[F.tid * 32 + jj];
            int gsel = 0; float gm = l[0];
#pragma unroll
            for (int q = 1; q < 4; ++q) if (l[q] > gm) { gm = l[q]; gsel = q; }
            float gs = 0.f;
#pragma unroll
            for (int q = 0; q < 4; ++q) gs += __expf(l[q] - gm);
            const float gp = 1.0f / gs;
            float le[4];
#pragma unroll
            for (int q = 0; q < 4; ++q) le[q] = (gsel == 0) ? l[4 + q] : (gsel == 1) ? l[8 + q] : (gsel == 2) ? l[12 + q] : l[16 + q];
            int e1 = 0; float m1 = le[0];
#pragma unroll
            for (int q = 1; q < 4; ++q) if (le[q] > m1) { m1 = le[q]; e1 = q; }
            int e2 = -1; float m2 = 0.f;
#pragma unroll
            for (int q = 0; q < 4; ++q) if (q != e1 && (e2 < 0 || le[q] > m2)) { m2 = le[q]; e2 = q; }
            const float bexp = __expf(m2 - m1), w1 = gp / (1.0f + bexp), w2 = gp * bexp / (1.0f + bexp);
            const int ea = e1 < e2 ? e1 : e2, eb = e1 < e2 ? e2 : e1; const float wa = e1 < e2 ? w1 : w2, wb = e1 < e2 ? w2 : w1;
            const int pidx = ea == 0 ? eb - 1 : (ea == 1 ? eb + 1 : 5), bucket = gsel * 6 + pidx;
            const int rank = atomicAdd((int*)(cnt + bucket), 1); ROUTE[rr] = (v4i){bucket, rank, __builtin_bit_cast(int, wa), __builtin_bit_cast(int, wb)};
        }
#ifdef ROUTE_PREFETCH
#pragma unroll
        for (int s = 0; s < 4; ++s) { xv[s][0] = xn[s][0]; xv[s][1] = xn[s][1]; }
#endif
    }
#ifdef ROUTE_PREFETCH
#undef ROUTE_SRC
#endif
    __syncthreads();
    if (F.tid < 24) ((int*)(ws + WS_BCNT))[blockIdx.x * 24 + F.tid] = cnt[F.tid];
    __syncthreads();
}

__device__ __forceinline__ void phase_scatter(Frame& F, bool latent_only) {
    unsigned char* const ws = PWS;
    LAS int* tab = (LAS int*)(F.lds + TAB_OFF);
    const int* BC = (const int*)(ws + WS_BCNT);
    if (F.tid < 384) { const int k = F.tid >> 4, part = F.tid & 15; int tot = 0, below = 0;
        for (int bb = part * 16; bb < part * 16 + 16 && bb < F.G; ++bb) { const int v = BC[bb * 24 + k]; tot += v; if (bb < (int)blockIdx.x) below += v; }
        tot += xshi<1>(tot); tot += xshi<2>(tot); tot += xshi<4>(tot); tot += xshi<8>(tot); below += xshi<1>(below); below += xshi<2>(below); below += xshi<4>(below); below += xshi<8>(below);
        if (part == 0) { tab[32 + k] = tot; tab[k] = below; } }
    __syncthreads();
    if (F.tid == 0) { int tb = 0; for (int k = 0; k < 24; ++k) { const int nt = (tab[32 + k] + 255) >> 8; tab[64 + k] = tb; tab[96 + k] = nt; tab[k] += tb * 256; tb += nt; } tab[128] = tb; }
    __syncthreads();
    v4i* ROWINFO = (v4i*)(ws + WS_ROWINFO);
    if (blockIdx.x == 0) { int* TI = (int*)(ws + WS_TILEINFO); if (F.tid == 0) TI[0] = tab[128];
        if (F.tid < 24) { const int t0 = tab[64 + F.tid], nt = tab[96 + F.tid]; for (int t = 0; t < nt; ++t) TI[1 + t0 + t] = F.tid; } }
    for (int k = blockIdx.x; k < 24; k += F.G) { const int p0 = tab[64 + k] * 256 + tab[32 + k], p1 = (tab[64 + k] + tab[96 + k]) * 256;
        for (int p = p0 + F.tid; p < p1; p += NTHR) ROWINFO[p] = (v4i){-1, 0, 0, 0}; }
    const int nrows = latent_only ? NB * T_LAT : MROWS, NGW = F.G * NWAVES, RPW = (nrows + NGW - 1) / NGW, gwb = (int)blockIdx.x * NWAVES + F.wave;
    const v4i* ROUTE = (const v4i*)(ws + WS_ROUTE);
    { const int i0 = gwb * RPW, i1 = (i0 + RPW < nrows) ? i0 + RPW : nrows;
      if (i0 + F.lane < i1) { const int idx = i0 + F.lane, r = latent_only ? row_of_latent(idx) : idx; const v4i ri = ROUTE[r]; ROWINFO[tab[ri.x] + ri.y] = (v4i){r, ri.z, ri.w, 0}; } }
    __syncthreads();
}
#if DEBUG_CHECK
__device__ __forceinline__ unsigned dbg_hash(unsigned x) { x ^= x >> 16; x *= 0x7feb352du; x ^= x >> 15; x *= 0x846ca68bu; x ^= x >> 16; return x; }
__device__ __forceinline__ void dbg_fail(Frame& F, int bit) { atomicOr((unsigned*)(F.ctl + CW_ERR), 1u << bit); }
__device__ __forceinline__ void dbg_check_gemm_bf16(Frame& F, const bf16* A, const bf16* Bt, const bf16* O, int ldo, int bit) {
    const int s = F.vcu * NTHR + F.tid;
    if (s < 16384) { const int row = dbg_hash(2 * s + 1) % MROWS, col = dbg_hash(2 * s + 2) % 3072; float ref = 0.f;
        for (int k = 0; k < 1024; ++k) ref += bf1(A[(size_t)row * 1024 + k]) * bf1(Bt[(size_t)col * 1024 + k]);
        const float got = bf1(O[(size_t)row * ldo + col]);
        if (!(fabsf(got - ref) <= 0.02f * fabsf(ref) + 0.05f)) dbg_fail(F, bit); }
}
__device__ __forceinline__ float naive_attn_row(Frame& F, const bf16* P, int b, int h, int j) {
    LAS float* pl = (LAS float*)(F.lds) + F.wave * 2304;
    const bf16* Pb = P + (size_t)b * RPB * NPROJ; const bf16* q = Pb + (size_t)j * NPROJ + C_AQ + h * 64;
    const int nk = (j < L_CTX) ? 4 : 36;
    float sc[36]; float mx = -1e30f;
#pragma unroll
    for (int i = 0; i < 36; ++i) { sc[i] = -1e30f; if (i < nk) { const bf16* k = Pb + (size_t)(i * 64 + F.lane) * NPROJ + C_AK + (h >> 1) * 64; float a = 0.f;
        for (int d = 0; d < 64; ++d) a += bf1(q[d]) * bf1(k[d]);
        sc[i] = a; mx = fmaxf(mx, a); } }
    mx = fmaxf(mx, xshf<1>(mx)); mx = fmaxf(mx, xshf<2>(mx)); mx = fmaxf(mx, xshf<4>(mx)); mx = fmaxf(mx, xshf<8>(mx)); mx = fmaxf(mx, xshf<16>(mx));
    mx = half_max(mx);
    float sum = 0.f;
#pragma unroll
    for (int i = 0; i < 36; ++i) { const float p = (i < nk) ? exp2f(sc[i] - mx) : 0.f; sum += p; pl[i * 64 + F.lane] = p; }
    sum = wave_sum(sum); LDS_WAIT(); asm volatile("" ::: "memory");
    float o = 0.f;
    for (int key = 0; key < nk * 64; ++key) o += pl[key] * bf1(Pb[(size_t)key * NPROJ + C_AV + (h >> 1) * 64 + F.lane]);
    LDS_WAIT(); asm volatile("" ::: "memory");
    return o / sum;
}
__device__ __forceinline__ void dbg_check_attn(Frame& F, const bf16* P, const bf16* ACT_, int bit, bool with_ctx) {
    const int s = F.vcu * NWAVES + F.wave;
    const int b = dbg_hash(3 * s + 1) % NB, h = dbg_hash(3 * s + 2) % 4; int j = L_CTX + dbg_hash(3 * s + 3) % T_LAT;
    if (with_ctx && (s & 7) == 0) j = dbg_hash(3 * s + 3) % L_CTX;
    const float o = naive_attn_row(F, P, b, h, j);
    const float got = bf1(ACT_[(size_t)(b * RPB + j) * DM + 768 + h * 64 + F.lane]);
    if (!(fabsf(got - o) <= 0.03f * fabsf(o) + 0.02f)) dbg_fail(F, j < L_CTX ? bit + 1 : bit);
    __syncthreads();
}
__device__ __forceinline__ void dbg_check_outproj(Frame& F, const float* xsrc, const float* xdst, const bf16* ACT_, const bf16* Wt, const float* gate, int bit) {
    const int s = F.vcu * NTHR + F.tid;
    if (s < 16384) { const int idx = dbg_hash(2 * s + 5) % (NB * T_LAT), col = dbg_hash(2 * s + 6) % DM, r = row_of_latent(idx), b = idx >> 11; float ref = 0.f;
        for (int k = 0; k < 1024; ++k) ref += bf1(ACT_[(size_t)r * 1024 + k]) * bf1(Wt[(size_t)col * 1024 + k]);
        ref = xsrc[(size_t)idx * DM + col] + gate[b * 1024 + col] * ref;
        const float got = xdst[(size_t)idx * DM + col];
        if (!(fabsf(got - ref) <= 0.01f * fabsf(ref) + 0.01f)) dbg_fail(F, bit); }
}
__device__ __forceinline__ void dbg_check_gateup(Frame& F, const unsigned char* A8, const unsigned char* Wgu8, const unsigned char* H8, const v4i* rowinfo, const LAS int* tileb, int ntiles, int bit) {
    const int s = F.vcu * NTHR + F.tid;
    if (s < 16384) { const int pos = dbg_hash(2 * s + 7) % (ntiles * 256), hc = dbg_hash(2 * s + 8) % 1024; const v4i ri = rowinfo[pos];
        if (ri.x >= 0) { const int k = tileb[pos >> 8], g = k / 6, pr = k % 6; const int ea = pr < 3 ? 0 : (pr < 5 ? 1 : 2), eb = pr < 3 ? pr + 1 : (pr < 5 ? pr - 1 : 3);
            const int e = g * 4 + (hc < 512 ? ea : eb), jj = hc & 511; const float wgt = __builtin_bit_cast(float, hc < 512 ? ri.y : ri.z);
            const unsigned char* wg = Wgu8 + ((size_t)e * 1024 + (jj >> 7) * 256 + (jj & 127)) * 1024; const unsigned char* wu = wg + 128 * 1024; float ga = 0.f, up = 0.f;
            for (int q = 0; q < 1024; ++q) { const float a = fp8_dec(A8[(size_t)ri.x * 1024 + q]); ga += a * fp8_dec(wg[q]); up += a * fp8_dec(wu[q]); }
            const float ref = 16.0f * siluf(ga * (1.0f / 32.0f)) * (up * (1.0f / 32.0f)) * wgt, got = fp8_dec(H8[(size_t)pos * 1024 + hc]);
            if (!(fabsf(got - ref) <= 0.08f * fabsf(ref) + 0.02f)) dbg_fail(F, bit); } }
}
__device__ __forceinline__ void dbg_check_mix(Frame& F, const bf16* P, const bf16* act, const float* lblog, const float* rdec, const float* hn, const float* rn) {
    const int s = F.vcu * NWAVES + F.wave, lane = F.lane;
    const int mixer = s & 1, b = dbg_hash(5 * s + 1) % NB, h = dbg_hash(5 * s + 2) % 4, j = L_CTX + dbg_hash(5 * s + 3) % T_LAT;
    float osum = 0.f;
    for (int dir = 0; dir < 2; ++dir) {
        const float lb = (mixer == 0 && lblog) ? sigmf(lblog[512 + dir * 256 + h * 64 + lane] - lblog[dir * 256 + h * 64 + lane]) : 0.f;
        const float gamma = sigmf(rdec[dir * 4 + h]);
        const int nt = (dir == 0) ? j : (RPB + L_CTX - 1 - j);
        float S[64];
#pragma unroll
        for (int dd = 0; dd < 64; ++dd) S[dd] = 0.f;
        float o = 0.f;
        for (int n = 0; n <= nt; ++n) { const bf16* rp = P + (size_t)(b * RPB + rc::row_in_batch(dir, n)) * NPROJ;
            float f, k, q, v;
            if (mixer == 0) { f = lb + (1.0f - lb) * sigmf(bf1(rp[C_HZ + 256 * dir + h * 64 + lane])); k = 1.0f - f; q = bf1(rp[C_HQ + h * 64 + lane]); v = bf1(rp[C_HI + h * 64 + lane]); }
            else { f = gamma; k = bf1(rp[C_RK + h * 64 + lane]); q = 0.125f * bf1(rp[C_RQ + h * 64 + lane]); v = bf1(rp[C_RV + h * 64 + lane]); }
            o = 0.f;
#pragma unroll
            for (int dd = 0; dd < 64; ++dd) { const float fd = __builtin_bit_cast(float, __builtin_amdgcn_readlane(__builtin_bit_cast(int, f), dd)), kd = __builtin_bit_cast(float, __builtin_amdgcn_readlane(__builtin_bit_cast(int, k), dd)),
                    qd = __builtin_bit_cast(float, __builtin_amdgcn_readlane(__builtin_bit_cast(int, q), dd));
                S[dd] = fd * S[dd] + kd * v; o += qd * S[dd]; } }
        osum += o;
    }
    const float rs = 1.0f / sqrtf(wave_sum(osum * osum) * (1.0f / 64.0f) + NORM_EPS);
    const float g = bf1(P[(size_t)(b * RPB + j) * NPROJ + (mixer == 0 ? C_HG : C_RG) + h * 64 + lane]);
    const float ref = osum * rs * (mixer == 0 ? hn : rn)[h * 64 + lane] * siluf(g);
    const float got = bf1(act[(size_t)(b * RPB + j) * DM + (mixer == 0 ? 0 : 512) + h * 64 + lane]);
    const float se = wave_sum(fabsf(got - ref)), sr = wave_sum(fabsf(ref));
    if (!(se <= 0.03f * sr + 0.3f)) dbg_fail(F, mixer == 0 ? 6 : 7);
}
__device__ __forceinline__ void dbg_check_norm1(Frame& F, const bf16* act, const float* MODp) {
    const int s = F.vcu * NTHR + F.tid;
    if (s < 8192) { const int r = dbg_hash(2 * s + 11) % MROWS, c = dbg_hash(2 * s + 12) % DM, b = r / RPB, j = r - b * RPB, m = (j < L_CTX) ? 16 : b;
        const float* src = (j < L_CTX) ? PIN(I_CTX) + (size_t)(b * L_CTX + j) * DM : PIN(I_X) + (size_t)(b * T_LAT + j - L_CTX) * DM;
        const float* cv = (j < L_CTX) ? PIN(I_CCTX) : PIN(I_C) + b * 1024; const float* aw = PIN(I_ADAW); const float* ab = PIN(I_ADAB);
        float ss = 0.f, sh = ab[c], scl = ab[1024 + c];
        for (int k = 0; k < 1024; ++k) { ss += src[k] * src[k]; const float sv = siluf(cv[k]); sh += sv * aw[(size_t)k * 6144 + c]; scl += sv * aw[(size_t)k * 6144 + 1024 + c]; }
        const float nA = PIN(I_NMIX)[c] * (1.0f + scl);
        const float gB = MODp[0 * 17 * 1024 + m * 1024 + c], gA = MODp[1 * 17 * 1024 + m * 1024 + c];
        if (!(fabsf(gB - sh) <= 1e-3f * fabsf(sh) + 1e-3f)) dbg_fail(F, 2);
        if (!(fabsf(gA - nA) <= 1e-3f * fabsf(nA) + 1e-3f)) dbg_fail(F, 3);
        const float ref = src[c] * (1.0f / sqrtf(ss / 1024.0f + NORM_EPS)) * gA + gB;
        const float got = bf1(act[(size_t)r * DM + c]);
        if (!(fabsf(got - ref) <= 0.01f * fabsf(ref) + 0.01f)) dbg_fail(F, 4); }
}
__device__ __forceinline__ void dbg_apply(Frame& F, float* out, unsigned* barw) {
    unsigned m = __hip_atomic_load((unsigned*)(F.ctl + CW_ERR), RLX_AGENT);
    if (__hip_atomic_load(barw + XB_TMO, RLX_AGENT) != 0u) m |= 32u;
    if (m) { const float sc = 1.0f + 10.0f * exp2f(0.33219f * (float)m); for (size_t i = (size_t)F.vcu * NTHR + F.tid; i < (size_t)NB * T_LAT * DM; i += (size_t)F.G * NTHR) out[i] *= sc; }
}
#endif
#ifndef NAIVE_ATTN
#define NAIVE_ATTN 0
#endif
#if NAIVE_ATTN && DEBUG_CHECK
__device__ __forceinline__ void phase_naive_attn(Frame& F, const bf16* P, bf16* ACT_, bool latent_only) {
    const int gw = F.vcu * NWAVES + F.wave, NGW = F.G * NWAVES;
    for (int it = gw; it < MROWS * 4; it += NGW) { const int r = it >> 2, h = it & 3, b = r / RPB, j = r - b * RPB;
        if (latent_only && j < L_CTX) continue;
        const float o = naive_attn_row(F, P, b, h, j);
        ACT_[(size_t)r * DM + 768 + h * 64 + F.lane] = (bf16)f2bf(o); }
    __syncthreads();
}
#endif
#ifndef SKIPMASK
#define SKIPMASK 0
#endif
#ifdef REP_BAR
#define GRID_BAR_X() xcd_barrier(bar)
#else
#define GRID_BAR_X() do {} while (0)
#endif
#ifdef PROBE_BARTIME
#define GRID_BAR_T0() const unsigned long long tb0_ = __builtin_amdgcn_s_memrealtime()
#define GRID_BAR_T1(site) do { if ((PROBE_BARMASK >> (site)) & 1) F.bart += (unsigned)(__builtin_amdgcn_s_memrealtime() - tb0_); } while (0)
#else
#define GRID_BAR_T0() do {} while (0)
#define GRID_BAR_T1(site) do {} while (0)
#endif
#define GRID_BAR(site) do { GRID_BAR_T0(); GRID_BAR_X(); xcd_barrier(bar); GRID_BAR_T1(site); { int t_ = F.tid; asm volatile("" : "+v"(t_)); F.tid = t_; F.lane = t_ & 63; F.wave = __builtin_amdgcn_readfirstlane(t_ >> 6); } ws = PWS; } while (0)
#define ACT ((bf16*)(ws + WS_ACT))
#define P ((bf16*)(ws + WS_P))
#define CTXB ((float*)(ws + WS_CTX))
#define ORET ((bf16*)(ws + WS_ORET))
#ifdef OUTPROJ_FP8
#define ATTN_OPTR(b, h) ((attn_body::bf16*)((unsigned char*)ACT + (size_t)(b) * RPB * DM + (12 + (h)) * 128))
#else
#define ATTN_OPTR(b, h) ((attn_body::bf16*)ACT + (size_t)(b) * RPB * DM + 768 + (h) * 64)
#endif
template <int layer> __device__ __forceinline__ void layer_body(Frame& F, XcdBarrier& bar, unsigned char* lds) {
    LAS int* const tileb = (LAS int*)(F.lds + TAB_OFF + 1024);
    unsigned char* ws = PWS;
        const bool lastl = (layer == DEPTH - 1);
        const float* xsrc = (layer == 0) ? PIN(I_X) : (const float*)POUT;
        const float* csrc = (layer == 0) ? PIN(I_CTX) : (const float*)CTXB;
        const float* MOD = (const float*)(ws + WS_MOD) + (size_t)layer * 6 * 17 * 1024;
        #if !(SKIPMASK & 1)
        phase_norm1(F, xsrc, csrc, MOD + 1 * 17 * 1024, MOD + 0 * 17 * 1024, ACT, ws + WS_KVS);
#ifdef REP_N1
        phase_norm1(F, xsrc, csrc, MOD + 1 * 17 * 1024, MOD + 0 * 17 * 1024, ACT, ws + WS_KVS);
#endif
#endif

        GRID_BAR(1);
#if DEBUG_CHECK
        if (layer == 0) dbg_check_norm1(F, ACT, MOD);
#endif
        #if !(SKIPMASK & 2)
        {
            constexpr int NF8 = __builtin_popcount(INPROJ_F8MASK), NB16 = NPROJ / 256 - NF8;
            unsigned long long map16 = 0ull, map8 = 0ull; { int j16 = 0, j8 = 0; for (int t = 0; t < NPROJ / 256; ++t) { if ((INPROJ_F8MASK >> t) & 1) map8 |= (unsigned long long)t << (4 * j8++); else map16 |= (unsigned long long)t << (4 * j16++); } }
            pg8::Gemm g{DM, DM, DM, nullptr}; DenseOrder S; S.init(NPANEL, NB16, F.G, (int)blockIdx.x, 0, ACT, (const bf16*)(ws + WS_W0 + (size_t)layer * WLAYER + WO_WIN), DM, DM); S.pnmap = map16;
            EpiStore E{P, NPROJ, 1.0f};
#ifndef REP_INPROJ
#define REP_INPROJ 1
#endif
            pg8::gemm_phase<EpiStore, DenseOrder, false, true>(F.lds + RING_OFF, g, S, E, F.tid);
            if (NF8 > 0) {
                pg8::Gemm g8{512, 512, 512, nullptr}; DenseOrder S8; const int c8 = ((int)blockIdx.x + F.G - (NPANEL * NB16) % F.G) % F.G;
                S8.init(NPANEL, NF8, F.G, c8, 0, ws + WS_KVS, (const bf16*)(ws + WS_W0 + (size_t)layer * WLAYER + WO_WIN), 512, 512); S8.tB = 524288; S8.pnmap = map8;
#ifdef FUSE_PREP
                EpiStoreQK E8{P, NPROJ, 1.0f / 32.0f, PIN(I_QN) + layer * 64, PIN(I_KN) + layer * 64, (const float*)(ws + WS_ROPE), (const float*)(ws + WS_ROPE) + 2048 * 32};
                pg8::gemm_phase<EpiStoreQK, DenseOrder, false, true, false, true>(F.lds + RING_OFF, g8, S8, E8, F.tid);
#else
                EpiStore E8{P, NPROJ, 1.0f / 32.0f};
                pg8::gemm_phase<EpiStore, DenseOrder, false, true, false, true>(F.lds + RING_OFF, g8, S8, E8, F.tid);
#endif
#if defined(REP_F8)
                __syncthreads();
                pg8::gemm_phase<EpiStore, DenseOrder, false, true, false, true>(F.lds + RING_OFF, g8, S8, E8, F.tid);
#endif
            }
#if REP_INPROJ == 2
            __syncthreads();
            pg8::gemm_phase<EpiStore, DenseOrder, false, true>(F.lds + RING_OFF, g, S, E, F.tid);
#endif
        }
#endif

        GRID_BAR(2);
#if DEBUG_CHECK
        dbg_check_gemm_bf16(F, ACT, (const bf16*)(ws + WS_W0 + (size_t)layer * WLAYER + WO_WIN), P, NPROJ, 0);
#endif
        #if !(SKIPMASK & 4)
#ifndef FUSE_PREP
        phase_prep(F, P, PIN(I_QN) + layer * 64, PIN(I_KN) + layer * 64, (const float*)(ws + WS_ROPE), (const float*)(ws + WS_ROPE) + 2048 * 32);
#endif
#ifdef REP_PREP
        phase_prep<true>(F, P, PIN(I_QN) + layer * 64, PIN(I_KN) + layer * 64, (const float*)(ws + WS_ROPE), (const float*)(ws + WS_ROPE) + 2048 * 32);
#endif
#endif

#ifdef SPLIT_MIX
#define LAUNDER_TID() do { int t_ = F.tid; asm volatile("" : "+v"(t_)); F.tid = t_; F.lane = t_ & 63; F.wave = __builtin_amdgcn_readfirstlane(t_ >> 6); ws = PWS; } while (0)
        xcd_split_arrive(bar, (unsigned*)(F.ctl + CW_BAR4));
        {
            bf16* KVS = (bf16*)(ws + WS_KVS); float* DBUF = (float*)(ws + WS_DBUF); const float* lbl = (layer == 0) ? nullptr : PIN(I_LB); const float* rdec = PIN(I_RDEC) + layer * 8;
            recur_stageA_loop(F, P, KVS, DBUF, F.vcu * NWAVES + F.wave, F.G * NWAVES, 256 * 36, lbl, rdec);
        }
        xcd_split_arrive(bar, (unsigned*)(F.ctl + CW_BAR5));
        xcd_split_wait(bar, (unsigned*)(F.ctl + CW_BAR4), (unsigned)layer + 1u);
        LAUNDER_TID();
        {
            const int nunits = lastl ? 512 : 576;
            for (int ui = 0; ; ++ui) {
                const int u = F.vcu + ui * F.G;
                if (ui == 1) {
                    xcd_split_wait(bar, (unsigned*)(F.ctl + CW_BAR5), (unsigned)layer + 1u);
                    LAUNDER_TID();
                    { bf16* KVS = (bf16*)(ws + WS_KVS); const float* DBUF = (const float*)(ws + WS_DBUF); const float* rdec = PIN(I_RDEC) + layer * 8;
                      for (int seq = F.vcu; seq < 256; seq += F.G) { const int mixer = seq >> 7, h = (seq >> 1) & 3, dir = seq & 1;
                          if (mixer == 0) recur_stageB_seq<0>(F, KVS, DBUF, seq, 0.f); else recur_stageB_seq<1>(F, KVS, DBUF, seq, sigmf(rdec[dir * 4 + h])); } }
                    xcd_split_arrive(bar, (unsigned*)(F.ctl + CW_BAR2));
                    LAUNDER_TID();
                }
                if (u >= nunits) break;
                int b, h, qb; if (u < 512) { b = u >> 5; h = (u >> 3) & 3; qb = 1 + (u & 7); } else { b = (u - 512) >> 2; h = u & 3; qb = 0; }
                const attn_body::bf16* Pb = (const attn_body::bf16*)P + (size_t)b * RPB * NPROJ;
                attn_body::attn_unit<8>(qb * 256, qb == 0 ? 4 : 36, Pb + C_AQ + h * 64, Pb + C_AK + (h >> 1) * 64, Pb + C_AV + (h >> 1) * 64,
                                        ATTN_OPTR(b, h), (char*)lds + RING_OFF, F.tid);
            }
        }
#else
        {
            bf16* KVS = (bf16*)(ws + WS_KVS); float* DBUF = (float*)(ws + WS_DBUF); const float* lbl = (layer == 0) ? nullptr : PIN(I_LB); const float* rdec = PIN(I_RDEC) + layer * 8;
#ifndef REP_A
#define REP_A 1
#endif
            for (int rp_REP_A = 0; rp_REP_A < REP_A; ++rp_REP_A)
            recur_stageA_loop(F, P, KVS, DBUF, F.vcu * NWAVES + F.wave, F.G * NWAVES, 256 * 36, lbl, rdec);
        }
        GRID_BAR(3);
        {
            { bf16* KVS = (bf16*)(ws + WS_KVS); const float* DBUF = (const float*)(ws + WS_DBUF); const float* rdec = PIN(I_RDEC) + layer * 8;
#ifndef REP_B
#define REP_B 1
#endif
            for (int rp_REP_B = 0; rp_REP_B < REP_B; ++rp_REP_B)
              for (int seq = F.vcu; seq < 256; seq += F.G) { const int mixer = seq >> 7, h = (seq >> 1) & 3, dir = seq & 1;
                  if (mixer == 0) recur_stageB_seq<0>(F, KVS, DBUF, seq, 0.f); else recur_stageB_seq<1>(F, KVS, DBUF, seq, sigmf(rdec[dir * 4 + h])); } }
#ifdef REP_BDRY
            { bf16* KVS = (bf16*)(ws + WS_KVS); const float* DBUF = (const float*)(ws + WS_DBUF); const float* rdec = PIN(I_RDEC) + layer * 8;
              for (int seq = F.vcu; seq < 256; seq += F.G) { const int mixer = seq >> 7, h = (seq >> 1) & 3, dir = seq & 1;
                  if (mixer == 0) recur_stageB_seq<0, true>(F, KVS, DBUF, seq, 0.f); else recur_stageB_seq<1, true>(F, KVS, DBUF, seq, sigmf(rdec[dir * 4 + h])); } }
#endif

#ifdef SPLIT_BC
            xcd_split_arrive(bar, (unsigned*)(F.ctl + CW_BAR2));
#endif
#if NAIVE_ATTN && DEBUG_CHECK
            phase_naive_attn(F, P, ACT, lastl);
#elif !(SKIPMASK & 16)
        const int nunits = lastl ? 512 : 576;
#ifndef REP_ATTN
#define REP_ATTN 1
#endif
            for (int rep_ = 0; rep_ < REP_ATTN; ++rep_)
            for (int u = F.vcu; u < nunits; u += F.G) {
                int b, h, qb; if (u < 512) { b = u >> 5; h = (u >> 3) & 3; qb = 1 + (u & 7); } else { b = (u - 512) >> 2; h = u & 3; qb = 0; }
                const attn_body::bf16* Pb = (const attn_body::bf16*)P + (size_t)b * RPB * NPROJ;
                attn_body::attn_unit<8>(qb * 256, qb == 0 ? 4 : 36, Pb + C_AQ + h * 64, Pb + C_AK + (h >> 1) * 64, Pb + C_AV + (h >> 1) * 64,
                                        ATTN_OPTR(b, h), (char*)lds + RING_OFF, F.tid);
            }
#endif

        }
#endif
#ifdef SPLIT_BC
        xcd_split_wait(bar, (unsigned*)(F.ctl + CW_BAR2), (unsigned)layer + 1u);
        { int t_ = F.tid; asm volatile("" : "+v"(t_)); F.tid = t_; F.lane = t_ & 63; F.wave = __builtin_amdgcn_readfirstlane(t_ >> 6); } ws = PWS;
#else
        GRID_BAR(4);
#endif
        {
            const bf16* KVS = (const bf16*)(ws + WS_KVS); const float* lbl = (layer == 0) ? nullptr : PIN(I_LB); const float* rdec = PIN(I_RDEC) + layer * 8;
            const float* hn = PIN(I_HNORM) + layer * 256; const float* rn = PIN(I_RNORM) + layer * 256;
            const int ntb = lastl ? 32 : 36;
#ifndef REP_C
#define REP_C 1
#endif
            for (int rp_REP_C = 0; rp_REP_C < REP_C; ++rp_REP_C)
            recur_stageC_loop(F, P, KVS, ACT, F.vcu & 7, F.vcu >> 3, (F.G >= 8) ? (F.G >> 3) : 1, 16 * ntb, ntb, lastl ? 4 : 0, lbl, rdec, hn, rn);
            phase_conv(F, P, ACT, PIN(I_CONVW) + layer * 768, lastl);
#ifdef REP_CONV
            phase_conv(F, P, ACT, PIN(I_CONVW) + layer * 768, lastl);
#endif
        }
        GRID_BAR(5);
#if DEBUG_CHECK
        dbg_check_mix(F, P, ACT, layer == 0 ? nullptr : PIN(I_LB), PIN(I_RDEC) + layer * 8, PIN(I_HNORM) + layer * 256, PIN(I_RNORM) + layer * 256);
#endif
#if DEBUG_CHECK
        dbg_check_attn(F, P, ACT, 1, !lastl);
#endif
        #if !(SKIPMASK & 64)
        {
#ifdef OUTPROJ_FP8
            pg8::Gemm g{512, 512, 512, nullptr}; DenseOrder S; S.init(lastl ? NB * 8 : NPANEL, 4, F.G, (int)blockIdx.x, lastl ? 1 : 0, ACT, (const bf16*)(ws + WS_W0 + (size_t)layer * WLAYER + WO_WOUT), 512, 512);
            EpiResid E{xsrc, csrc, POUT, CTXB, MOD + 2 * 17 * 1024, 1.0f / 128.0f};
            pg8::gemm_phase<EpiResid, DenseOrder, true, true, false, true, true>(F.lds + RING_OFF, g, S, E, F.tid);
#else
            pg8::Gemm g{DM, DM, DM, nullptr}; DenseOrder S; S.init(lastl ? NB * 8 : NPANEL, 4, F.G, (int)blockIdx.x, lastl ? 1 : 0, ACT, (const bf16*)(ws + WS_W0 + (size_t)layer * WLAYER + WO_WOUT), DM, DM);
            EpiResid E{xsrc, csrc, POUT, CTXB, MOD + 2 * 17 * 1024, 1.0f};
            pg8::gemm_phase<EpiResid, DenseOrder, true, true>(F.lds + RING_OFF, g, S, E, F.tid);
#endif
        }
        if (layer == 0) {
            __syncthreads();
#ifdef SPLIT_OP
            xcd_split_arrive(bar, (unsigned*)(F.ctl + CW_BAR4));
#endif
            constexpr int PL = 1792 + 512 + 3 * 4096;
#ifdef CONV_SPLIT64
            if (F.G == 256) { const int c = (int)blockIdx.x;
                if (c < 64) convert_weights_range(F, PL, PL + CONV_SPLIT64, c * NWAVES + F.wave, 64 * NWAVES);
                else convert_weights_range(F, PL + CONV_SPLIT64, 2 * PL, (c - 64) * NWAVES + F.wave, 192 * NWAVES); }
            else convert_weights_range(F, PL, 2 * PL, F.vcu * NWAVES + F.wave, F.G * NWAVES);
#else
            const int nb = (int)blockIdx.x - 64, nw = (F.G - 64) * NWAVES;
            if (F.G > 64) convert_weights_range(F, PL, 2 * PL, nb >= 0 ? nb * NWAVES + F.wave : -1, nw);
            else convert_weights_range(F, PL, 2 * PL, F.vcu * NWAVES + F.wave, F.G * NWAVES);
#endif
            __syncthreads();
        }
#endif

#ifdef SPLIT_OP
        if (layer == 0) { xcd_split_wait(bar, (unsigned*)(F.ctl + CW_BAR4), 1u); { int t_ = F.tid; asm volatile("" : "+v"(t_)); F.tid = t_; F.lane = t_ & 63; F.wave = __builtin_amdgcn_readfirstlane(t_ >> 6); } ws = PWS; }
        else GRID_BAR(6);
#else
        GRID_BAR(6);
#endif
#if DEBUG_CHECK
        if (layer == 0) dbg_check_outproj(F, PIN(I_X), POUT, ACT, (const bf16*)(ws + WS_W0 + (size_t)layer * WLAYER + WO_WOUT), MOD + 2 * 17 * 1024, 3);
        GRID_BAR(6);
#endif
        #if !(SKIPMASK & 128)
        phase_norm2_route(F, layer, (const float*)POUT, (const float*)CTXB, MOD + 4 * 17 * 1024, MOD + 3 * 17 * 1024, ACT, lastl);
#ifdef REP_N2
        phase_norm2_route(F, layer, (const float*)POUT, (const float*)CTXB, MOD + 4 * 17 * 1024, MOD + 3 * 17 * 1024, ACT, lastl);
#endif
#endif

        GRID_BAR(7);
        #if !(SKIPMASK & 256)
        phase_scatter(F, lastl);
#ifdef REP_N2
        phase_scatter(F, lastl);
#endif
#endif

        GRID_BAR(8);
#ifdef MOE_SPLIT
        {
            const int* TI = (const int*)(ws + WS_TILEINFO); const int ntiles = TI[0], T1 = ntiles >> 1;
            for (int i = F.tid; i < MAXTILES; i += NTHR) tileb[i] = (i < ntiles) ? TI[1 + i] : 0;
            __syncthreads();
            int dealt = 0;
#pragma nounroll
            for (int part = 0; part < 2; ++part) {
                const int t0 = part ? T1 : 0, ntp = part ? ntiles - T1 : T1;
                pg8::Gemm g{512, 512, 512, nullptr}; g.rowidx = (const int*)(ws + WS_ROWINFO);
                MoeOrder S; S.pm0 = t0; S.ncol = 8; S.nwg = ntp * 8; S.G = F.G; S.c = ((int)blockIdx.x + F.G - dealt % F.G) % F.G; S.down = 0; S.tileb = tileb; S.A = (const char*)(ws + WS_ACT); S.W = (const char*)(ws + WS_W0 + (size_t)layer * WLAYER + WO_WGU);
                EpiGateUp E{ws + WS_H, (const v4i*)(ws + WS_ROWINFO)};
                pg8::gemm_phase<EpiGateUp, MoeOrder, true, true, true, true>(F.lds + RING_OFF, g, S, E, F.tid);
                dealt += ntp * 8;
                xcd_split_arrive(bar, (unsigned*)(F.ctl + (part ? CW_BAR4 : CW_BAR3)));
            }
#pragma nounroll
            for (int part = 0; part < 2; ++part) {
                xcd_split_wait(bar, (unsigned*)(F.ctl + (part ? CW_BAR4 : CW_BAR3)), (unsigned)layer + 1u);
                { int t_ = F.tid; asm volatile("" : "+v"(t_)); F.tid = t_; F.lane = t_ & 63; F.wave = __builtin_amdgcn_readfirstlane(t_ >> 6); } ws = PWS;
                const int t0 = part ? T1 : 0, ntp = part ? ntiles - T1 : T1;
                pg8::Gemm g{512, 1024, 512, nullptr};
                MoeOrder S; S.pm0 = t0; S.ncol = 4; S.nwg = ntp * 4; S.G = F.G; S.c = ((int)blockIdx.x + F.G - dealt % F.G) % F.G; S.down = 1; S.tileb = tileb; S.A = (const char*)(ws + WS_H); S.W = (const char*)(ws + WS_W0 + (size_t)layer * WLAYER + WO_WD);
                EpiDown E{POUT, CTXB, MOD + 5 * 17 * 1024, (const v4i*)(ws + WS_ROWINFO)};
                pg8::gemm_phase<EpiDown, MoeOrder, true, true, false, true>(F.lds + RING_OFF, g, S, E, F.tid);
                dealt += ntp * 4;
            }
        }
#else
        #if !(SKIPMASK & 512)
        {
            const int* TI = (const int*)(ws + WS_TILEINFO); const int ntiles = TI[0];
            for (int i = F.tid; i < MAXTILES; i += NTHR) tileb[i] = (i < ntiles) ? TI[1 + i] : 0;
            __syncthreads();
            pg8::Gemm g{512, 512, 512, nullptr};
            g.rowidx = (const int*)(ws + WS_ROWINFO);
            MoeOrder S; S.pm0 = 0; S.ncol = 8; S.nwg = ntiles * 8; S.G = F.G; S.c = (int)blockIdx.x; S.down = 0; S.tileb = tileb; S.A = (const char*)(ws + WS_ACT); S.W = (const char*)(ws + WS_W0 + (size_t)layer * WLAYER + WO_WGU);
            EpiGateUp E{ws + WS_H, (const v4i*)(ws + WS_ROWINFO)};
#ifndef REP_GU
#define REP_GU 1
#endif
            pg8::gemm_phase<EpiGateUp, MoeOrder, true, true, true, true>(F.lds + RING_OFF, g, S, E, F.tid);
#if REP_GU == 2
            __syncthreads();
            pg8::gemm_phase<EpiGateUp, MoeOrder, true, true, true, true>(F.lds + RING_OFF, g, S, E, F.tid);
#endif
        }
#endif

        GRID_BAR(9);
#if DEBUG_CHECK
        { const int* TI = (const int*)(ws + WS_TILEINFO); dbg_check_gateup(F, ws + WS_ACT, ws + WS_W0 + (size_t)layer * WLAYER + WO_WGU, ws + WS_H, (const v4i*)(ws + WS_ROWINFO), tileb, TI[0], 4); }
#endif
        #if !(SKIPMASK & 1024)
        {
            const int* TI = (const int*)(ws + WS_TILEINFO); const int ntiles = TI[0];
            pg8::Gemm g{512, 1024, 512, nullptr};
            MoeOrder S; S.pm0 = 0; S.ncol = 4; S.nwg = ntiles * 4; S.G = F.G; S.c = (int)blockIdx.x; S.down = 1; S.tileb = tileb; S.A = (const char*)(ws + WS_H); S.W = (const char*)(ws + WS_W0 + (size_t)layer * WLAYER + WO_WD);
            EpiDown E{POUT, CTXB, MOD + 5 * 17 * 1024, (const v4i*)(ws + WS_ROWINFO)};
            pg8::gemm_phase<EpiDown, MoeOrder, true, true, false, true>(F.lds + RING_OFF, g, S, E, F.tid);
        }
#endif

#endif
#if defined(PROBE_BARTIME) || DEBUG_CHECK
        GRID_BAR(10);
#else
        if (!lastl) GRID_BAR(10);
#endif
    }
__global__ void __launch_bounds__(NTHR, 2) fwd_kernel(Args args) {
    extern __shared__ __attribute__((aligned(16))) unsigned char lds[];
    Frame F;
    F.lds = (LAS unsigned char*)lds;
    F.MISC = (volatile LAS unsigned*)(F.lds + MISC_OFF);
    F.tid = threadIdx.x; F.lane = F.tid & 63; F.wave = __builtin_amdgcn_readfirstlane(F.tid >> 6);
    F.bart = 0u; F.G = gridDim.x; { const int bx = blockIdx.x; F.vcu = (F.G % 8 == 0) ? (bx % 8) * (F.G / 8) + bx / 8 : bx; }
    F.ctl = (gu32*)(args.ws + WS_CTL);
    for (int u = F.tid; u < (LDS_BYTES - LDSCTL_OFF) / 4; u += NTHR) ((LAS unsigned*)(F.lds + LDSCTL_OFF))[u] = 0u;
    __syncthreads();
    if (F.tid == 0) { volatile LAS unsigned long long* pt = (volatile LAS unsigned long long*)(F.lds + PTAB_OFF);
#pragma unroll
        for (int i = 0; i < 24; ++i) pt[i] = (unsigned long long)args.in[i];
        pt[24] = (unsigned long long)args.out; pt[25] = (unsigned long long)(args.ws + args.ws_shift); }
    __syncthreads();
    XcdBarrier bar = xcd_barrier_post((unsigned*)(F.ctl + CW_BAR), F.MISC + 8);
    unsigned char* ws = PWS;

    #if !(SKIPMASK & 2048)
        p0_prologue(F, bar);
#endif

#ifdef SPLIT_PRO
    xcd_split_wait(bar, (unsigned*)(F.ctl + CW_BAR3), 1u);
    { int t_ = F.tid; asm volatile("" : "+v"(t_)); F.tid = t_; F.lane = t_ & 63; F.wave = __builtin_amdgcn_readfirstlane(t_ >> 6); } ws = PWS;
#else
    GRID_BAR(0);
#endif

    layer_body<0>(F, bar, lds);
    layer_body<1>(F, bar, lds);
#ifdef PROBE_BARTIME
    if (blockIdx.x == PROBE_BARTIME - 1 && F.tid == 0) { const unsigned long long ts_ = __builtin_amdgcn_s_memrealtime(); while (__builtin_amdgcn_s_memrealtime() - ts_ < 8ull * F.bart) __builtin_amdgcn_s_sleep(8); }
#endif
#if DEBUG_CHECK
    dbg_apply(F, POUT, bar.bar);
#endif
}

extern "C" void kernel_launch(void* const* d_in, const int* in_sizes, int n_in, void* d_out, int out_size, void* d_ws, size_t ws_size, hipStream_t stream) {
    static int grid = 0;
    if (grid == 0) {
        if (n_in != 24 || out_size != NB * T_LAT * DM || ws_size < WS_END) { fprintf(stderr, "kernel_launch: unexpected shapes (n_in %d, out %d, ws %zu); nothing launched\n", n_in, out_size, ws_size); grid = -1; return; }
        int dev = 0, cus = 0, per_cu = 0;
        if (hipGetDevice(&dev) != hipSuccess || hipDeviceGetAttribute(&cus, hipDeviceAttributeMultiprocessorCount, dev) != hipSuccess) { grid = -1; return; }
        if (hipFuncSetAttribute((const void*)fwd_kernel, hipFuncAttributeMaxDynamicSharedMemorySize, LDS_BYTES) != hipSuccess) { grid = -1; return; }
        if (hipOccupancyMaxActiveBlocksPerMultiprocessor(&per_cu, (const void*)fwd_kernel, NTHR, LDS_BYTES) != hipSuccess || per_cu < 1) { fprintf(stderr, "kernel_launch: occupancy query says %d blocks per CU\n", per_cu); grid = -1; return; }
        (void)hipGetLastError();
        grid = cus < 256 ? cus : 256;
    }
    if (grid < 0) return;
    if (hipMemsetAsync((char*)d_ws + WS_CTL, 0, CTL_ZERO_BYTES, stream) != hipSuccess) return;
    Args a{};
    for (int i = 0; i < 24; ++i) a.in[i] = (const float*)d_in[i];
    a.out = (float*)d_out; a.ws = (unsigned char*)d_ws;
#ifdef WS_TOP
    a.ws_shift = ((ws_size - WS_END) / (2 * MiB)) * (2 * MiB);
#endif
    hipLaunchKernelGGL(fwd_kernel, dim3(grid), dim3(NTHR), LDS_BYTES, stream, a);
}
```

```cpp
#define SPLIT_BC 1
#define EARLY_INV 1
#define FUSE_PREP 1
#define TOP_DIRECT 1

#define MOD_WIDE 1
#define SPLIT_PRO 1
#define SPLIT_OP 1


#define EMU_TILES 0

#define INPROJ_F8MASK 0x3F02

#include <hip/hip_runtime.h>
#ifdef NT_LOADS
#define LDNT(p) __builtin_nontemporal_load(p)
#else
#define LDNT(p) (*(p))
#endif
#include <hip/hip_bf16.h>
#include <cstdio>
#include <cstdint>
#include <cmath>
#ifndef DEBUG_CHECK
#define DEBUG_CHECK 0
#endif
#define DENSE_WGM 4
#ifndef NAIVE_ATTN
#define NAIVE_ATTN 0
#endif

namespace pg8 {
#define PG8_LAS __attribute__((address_space(3)))
typedef unsigned short bf16_t;
typedef short bf16x8 __attribute__((ext_vector_type(8)));
typedef float f32x4 __attribute__((ext_vector_type(4)));
typedef unsigned u32x4 __attribute__((ext_vector_type(4)));
constexpr int BM = 256, BK = 64, HALF = 128, HTB = HALF * BK * 2  , STAGE_BYTES = 8 * HTB, NXCD = 8, WGM = 8;

__host__ __device__ __forceinline__ int lds_byte(int r, int c) { const int st = (r >> 4) * 2 + (c >> 5), rr = r & 15, cc = c & 31, ob = rr * 64 + cc * 2; return st * 1024 + (ob ^ (((ob >> 9) & 1) << 5)); }
__host__ __device__ __forceinline__ void stage_rc(int b, int& R, int& C) { const int st = b / 1024, sb = b % 1024, swz = sb ^ (((sb >> 9) & 1) << 5); R = (st >> 1) * 16 + swz / 64; C = (st & 1) * 32 + (swz % 64) / 2; }
__host__ __device__ __forceinline__ void stage_rc8(int b, int& R, int& C) { const int blk = b >> 11, rr = (b >> 7) & 15, ps = (b >> 5) & 3, k = (b >> 4) & 1, gl = ps ^ ((rr >> 1) & 3); R = blk * 16 + rr; C = (gl * 2 + k) * 8; }
__host__ __device__ __forceinline__ int perm32(int rho) { const int n = rho >> 4, i = rho & 15; return 8 * (i >> 2) + 4 * n + (i & 3); }

struct Unit { const char* a; const char* b; const char* b2; int pm, pn, x0, x1; };
struct Gemm { int lda, ldb, K; const int* rowidx; };
typedef int i32x8 __attribute__((ext_vector_type(8)));
typedef int i32x4 __attribute__((ext_vector_type(4)));
__device__ __forceinline__ i32x8 pg8_cat(bf16x8 a, bf16x8 b) { const i32x4 x = __builtin_bit_cast(i32x4, a), y = __builtin_bit_cast(i32x4, b); return (i32x8){x[0], x[1], x[2], x[3], y[0], y[1], y[2], y[3]}; }
__device__ __forceinline__ unsigned cvt_pk_bf16(float lo, float hi) { unsigned r; asm volatile("v_cvt_pk_bf16_f32 %0, %1, %2" : "=v"(r) : "v"(lo), "v"(hi)); return r; }

template <class Epi, class Sched, bool ALIGN_EPI = false, bool SP2 = false, bool GATHER = false, bool FP8 = false, bool APAIR = false>
__device__ __forceinline__ void gemm_phase(PG8_LAS unsigned char* lds, const Gemm g, const Sched& S, const Epi& E, const int tid) {
    const int wid = __builtin_amdgcn_readfirstlane(tid >> 6), lane = tid & 63, wr = wid >> 2, wc = wid & 3, fr = lane & 15, fq = lane >> 4;
    const int K = g.K, nt = K / BK;
    unsigned voffA[2], voffB[2];
#pragma unroll
    for (int i = 0; i < 2; ++i) { int R, C; if constexpr (FP8) stage_rc8(tid * 16 + i * 8192, R, C); else stage_rc(tid * 16 + i * 8192, R, C); const int Rb = Epi::PERMH ? ((R >> 5) * 64 + perm32(R & 31)) : (Epi::PERM ? ((R & ~31) + perm32(R & 31)) : R);
        voffA[i] = APAIR ? (unsigned)((R >> 1) * g.lda * 4 + ((2 * C) >> 6) * 128 + (R & 1) * 64 + ((2 * C) & 63)) : (unsigned)(R * g.lda + C) * 2u; voffB[i] = (unsigned)(Rb * g.ldb + C) * 2u; }
    unsigned gc[2][2] = {{0u, 0u}, {0u, 0u}}, gn[2][2] = {{0u, 0u}, {0u, 0u}}; int gR[2] = {0, 0}, gC[2] = {0, 0};
    if constexpr (GATHER) {
#pragma unroll
        for (int i = 0; i < 2; ++i) { if constexpr (FP8) stage_rc8(tid * 16 + i * 8192, gR[i], gC[i]); else stage_rc(tid * 16 + i * 8192, gR[i], gC[i]); } }
#define PG8_GOFF(dst, pm_) do { _Pragma("unroll") for (int _h = 0; _h < 2; ++_h) _Pragma("unroll") for (int _i = 0; _i < 2; ++_i) { \
        int _r = g.rowidx[(size_t)((pm_) * 256 + _h * 128 + gR[_i]) * 4]; _r = _r < 0 ? 0 : _r; dst[_h][_i] = (unsigned)(_r * g.lda + gC[_i]) * 2u; } } while (0)
    const size_t kstep = (size_t)(BK * 2);
    const size_t kstepA = APAIR ? kstep * 2 : kstep;
    const size_t hstepA = (size_t)HALF * g.lda * 2, hstepB = (size_t)(Epi::PERMH ? 32 : HALF) * g.ldb * 2;
    const unsigned ldsw = (unsigned)wid * 1024u;
    const int aoff = FP8 ? (wr * 4) * 2048 + fr * 128 + ((fq ^ ((fr >> 1) & 3)) * 32) : lds_byte(wr * 64 + fr, fq * 8), boff = FP8 ? (wc * 2) * 2048 + fr * 128 + ((fq ^ ((fr >> 1) & 3)) * 32) : lds_byte(wc * 32 + fr, fq * 8);
#define PG8_SA(b, h) (((b) * 2 + (h)) * HTB)
#define PG8_SB(b, h) ((4 + (b) * 2 + (h)) * HTB)
#define PG8_STAGE(bufoff, gbase, voff) do { _Pragma("unroll") for (int _i = 0; _i < 2; ++_i) \
        __builtin_amdgcn_global_load_lds((const unsigned*)((const char*)(gbase) + (voff)[_i]), (PG8_LAS unsigned*)(lds + (bufoff) + ldsw + _i * 8192), 16, 0, 0); } while (0)
#define PG8_STAGE_A(bufoff, tbase, hh, NX) do { if constexpr (GATHER) { _Pragma("unroll") for (int _i = 0; _i < 2; ++_i) { const unsigned _o = (NX) ? gn[hh][_i] : gc[hh][_i]; \
        __builtin_amdgcn_global_load_lds((const unsigned*)((const char*)(tbase) + _o), (PG8_LAS unsigned*)(lds + (bufoff) + ldsw + _i * 8192), 16, 0, 0); } } \
        else { PG8_STAGE(bufoff, (tbase) + (hh) * hstepA, voffA); } } while (0)
#define PG8_LDA(dst, b, h) do { if constexpr (FP8) { _Pragma("unroll") for (int m = 0; m < 4; ++m) dst##8[m] = *(const PG8_LAS i32x8*)(lds + PG8_SA(b, h) + aoff + m * 2048); } \
        else { _Pragma("unroll") for (int m = 0; m < 4; ++m) _Pragma("unroll") for (int k = 0; k < 2; ++k) dst[m][k] = *(const PG8_LAS bf16x8*)(lds + PG8_SA(b, h) + aoff + m * 2048 + k * 1024); } } while (0)
#define PG8_LDB(dst, b, h) do { if constexpr (FP8) { _Pragma("unroll") for (int n = 0; n < 2; ++n) dst##8[n] = *(const PG8_LAS i32x8*)(lds + PG8_SB(b, h) + boff + n * 2048); } \
        else { _Pragma("unroll") for (int n = 0; n < 2; ++n) _Pragma("unroll") for (int k = 0; k < 2; ++k) dst[n][k] = *(const PG8_LAS bf16x8*)(lds + PG8_SB(b, h) + boff + n * 2048 + k * 1024); } } while (0)
#define PG8_MMA(ai, bj, At, Bt) do { __builtin_amdgcn_s_setprio(1); if constexpr (FP8) { _Pragma("unroll") for (int m = 0; m < 4; ++m) _Pragma("unroll") for (int n = 0; n < 2; ++n) \
        asm volatile("v_mfma_scale_f32_16x16x128_f8f6f4 %0, %1, %2, %0, %3, %3 op_sel_hi:[0,0,0]" : "+v"(acc[ai][bj][m][n]) : "v"(Bt##8[n]), "v"(At##8[m]), "v"(pg8_one)); }     \
        else { _Pragma("unroll") for (int m = 0; m < 4; ++m) _Pragma("unroll") for (int n = 0; n < 2; ++n) _Pragma("unroll") for (int k = 0; k < 2; ++k) \
        acc[ai][bj][m][n] = __builtin_amdgcn_mfma_f32_16x16x32_bf16(Bt[n][k], At[m][k], acc[ai][bj][m][n], 0, 0, 0); } __builtin_amdgcn_s_setprio(0); } while (0)
#define PG8_WAIT_V(n) asm volatile("s_waitcnt vmcnt(" #n ")" ::: "memory")
#define PG8_WAIT_L(n) asm volatile("s_waitcnt lgkmcnt(" #n ")" ::: "memory")
#define PG8_BAR __builtin_amdgcn_s_barrier()
#define PG8_SCHED __builtin_amdgcn_sched_barrier(0)
    Unit cur, nxt; int ui = 0;
    if (!S.next(0, cur)) return;
    f32x4 acc[2][2][4][2];
#pragma unroll
    for (int a = 0; a < 2; ++a)
#pragma unroll
        for (int b = 0; b < 2; ++b)
#pragma unroll
            for (int m = 0; m < 4; ++m)
#pragma unroll
                for (int n = 0; n < 2; ++n) acc[a][b][m][n] = (f32x4){0.f, 0.f, 0.f, 0.f};
    const int pg8_one = 0x7f7f7f7f;
    bf16x8 At[4][2], B0[2][2], B1[2][2];
    i32x8 At8[4], B08[2], B18[2];
    const char* cA = cur.a; const char* cB = cur.b; const char* cB2 = cur.b2; const int nth = nt >> 1;
    if constexpr (GATHER) { PG8_GOFF(gc, cur.pm); }
    S.a_ready(cur);
    if constexpr (SP2) {
        PG8_STAGE(PG8_SB(0, 0), cB, voffB); PG8_STAGE(PG8_SB(0, 1), cB + hstepB, voffB); PG8_STAGE_A(PG8_SA(0, 0), cA, 0, false); PG8_STAGE_A(PG8_SA(0, 1), cA, 1, false);
        if (wr == 1) PG8_BAR;
        PG8_WAIT_V(2); PG8_BAR;
        PG8_STAGE(PG8_SB(1, 0), cB + kstep, voffB); PG8_STAGE_A(PG8_SA(1, 0), cA + kstepA, 0, false); PG8_STAGE(PG8_SB(1, 1), cB + hstepB + kstep, voffB);
        PG8_WAIT_V(6); PG8_BAR;
    } else {
        PG8_STAGE(PG8_SB(0, 0), cB, voffB); PG8_STAGE_A(PG8_SA(0, 0), cA, 0, false); PG8_STAGE(PG8_SB(0, 1), cB + hstepB, voffB); PG8_STAGE_A(PG8_SA(0, 1), cA, 1, false);
        if (wr == 1) PG8_BAR;
        PG8_WAIT_V(4); PG8_BAR;
        PG8_STAGE(PG8_SB(1, 0), cB + kstep, voffB); PG8_STAGE_A(PG8_SA(1, 0), cA + kstepA, 0, false); PG8_STAGE(PG8_SB(1, 1), cB + hstepB + kstep, voffB);
        PG8_WAIT_V(6); PG8_BAR;
    }
    for (;;) {
        const bool has_next = S.next(ui + 1, nxt);
        if constexpr (GATHER) { if (has_next) { PG8_GOFF(gn, nxt.pm); } }
        const char* nA = has_next ? nxt.a : cA; const char* nB = has_next ? nxt.b : cB;
#pragma nounroll
        for (int t = 0; t < nt; t += 2) {
            const bool last = (t == nt - 2);
            const char* a1 = cA + (size_t)(t + 1) * kstepA;
            const char* a2 = last ? nA : cA + (size_t)(t + 2) * kstepA; const char* b2 = last ? nB : ((t + 2 < nth) ? cB : cB2) + (size_t)(t + 2) * kstep;
            const char* a3 = a2 + kstepA; const char* b3 = b2 + kstep;
            if (last && has_next) S.a_ready(nxt);
            if constexpr (SP2) {
            PG8_LDB(B0, 0, 0); PG8_LDB(B1, 0, 1); PG8_SCHED; PG8_LDA(At, 0, 0); PG8_STAGE_A(PG8_SA(1, 1), a1, 1, false);
            PG8_WAIT_V(8); PG8_WAIT_L(0); PG8_BAR; PG8_MMA(0, 0, At, B0); PG8_MMA(0, 1, At, B1); PG8_BAR; PG8_SCHED;
            PG8_LDA(At, 0, 1); PG8_STAGE(PG8_SB(0, 0), b2, voffB); PG8_STAGE(PG8_SB(0, 1), b2 + hstepB, voffB); PG8_STAGE_A(PG8_SA(0, 0), a2, 0, last);
            PG8_WAIT_V(8); PG8_WAIT_L(0); PG8_BAR; PG8_MMA(1, 0, At, B0); PG8_MMA(1, 1, At, B1); PG8_BAR; PG8_SCHED;
            PG8_LDB(B0, 1, 0); PG8_LDB(B1, 1, 1); PG8_SCHED; PG8_LDA(At, 1, 0); PG8_STAGE_A(PG8_SA(0, 1), a2, 1, last);
            PG8_WAIT_V(8); PG8_WAIT_L(0); PG8_BAR; PG8_MMA(0, 0, At, B0); PG8_MMA(0, 1, At, B1); PG8_BAR; PG8_SCHED;
            PG8_LDA(At, 1, 1); PG8_STAGE(PG8_SB(1, 0), b3, voffB); PG8_STAGE(PG8_SB(1, 1), b3 + hstepB, voffB); PG8_STAGE_A(PG8_SA(1, 0), a3, 0, last);
            PG8_WAIT_V(8); PG8_WAIT_L(0); PG8_BAR; PG8_MMA(1, 0, At, B0); PG8_MMA(1, 1, At, B1); PG8_BAR; PG8_SCHED;
            } else {
            PG8_LDB(B0, 0, 0); PG8_SCHED; PG8_LDA(At, 0, 0); PG8_STAGE_A(PG8_SA(1, 1), a1, 1, false);
            PG8_WAIT_L(8); PG8_BAR; PG8_WAIT_L(0); PG8_MMA(0, 0, At, B0); PG8_BAR; PG8_SCHED;
            PG8_LDB(B1, 0, 1); PG8_STAGE(PG8_SB(0, 0), b2, voffB);
            PG8_BAR; PG8_WAIT_L(0); PG8_MMA(0, 1, At, B1); PG8_BAR;
            PG8_LDA(At, 0, 1); PG8_STAGE_A(PG8_SA(0, 0), a2, 0, last);
            PG8_BAR; PG8_WAIT_L(0); PG8_MMA(1, 0, At, B0); PG8_BAR; PG8_SCHED;
            PG8_STAGE(PG8_SB(0, 1), b2 + hstepB, voffB);
            PG8_WAIT_V(6); PG8_BAR; PG8_MMA(1, 1, At, B1); PG8_BAR;
            PG8_LDB(B0, 1, 0); PG8_SCHED; PG8_LDA(At, 1, 0); PG8_STAGE_A(PG8_SA(0, 1), a2, 1, last);
            PG8_WAIT_L(8); PG8_BAR; PG8_WAIT_L(0); PG8_MMA(0, 0, At, B0); PG8_BAR; PG8_SCHED;
            PG8_LDB(B1, 1, 1); PG8_STAGE(PG8_SB(1, 0), b3, voffB);
            PG8_BAR; PG8_WAIT_L(0); PG8_MMA(0, 1, At, B1); PG8_BAR;
            PG8_LDA(At, 1, 1); PG8_STAGE_A(PG8_SA(1, 0), a3, 0, last);
            PG8_BAR; PG8_WAIT_L(0); PG8_MMA(1, 0, At, B0); PG8_BAR; PG8_SCHED;
            PG8_STAGE(PG8_SB(1, 1), b3 + hstepB, voffB);
            PG8_WAIT_V(6); PG8_BAR; PG8_MMA(1, 1, At, B1); PG8_BAR;
            }
        }
        if constexpr (FP8) asm volatile("s_nop 15\n\ts_nop 7" ::: "memory");
        if constexpr (ALIGN_EPI) { if (wr == 0) PG8_BAR; }
        if constexpr (!Epi::AFTER_DRAIN) { E(acc, cur, wr, wc, fr, fq); S.done(cur); }
        if (!has_next) break;
#pragma unroll
        for (int a = 0; a < 2; ++a)
#pragma unroll
            for (int b = 0; b < 2; ++b)
#pragma unroll
                for (int m = 0; m < 4; ++m)
#pragma unroll
                    for (int n = 0; n < 2; ++n) acc[a][b][m][n] = (f32x4){0.f, 0.f, 0.f, 0.f};
        cur = nxt; cA = nA; cB = nB; cB2 = nxt.b2; ++ui;
        if constexpr (GATHER) { _Pragma("unroll") for (int _h = 0; _h < 2; ++_h) _Pragma("unroll") for (int _i = 0; _i < 2; ++_i) gc[_h][_i] = gn[_h][_i]; }
        if constexpr (ALIGN_EPI) { if (wr == 1) PG8_BAR; }
    }
    PG8_WAIT_V(0);
    if constexpr (!ALIGN_EPI) { if (wr == 0) PG8_BAR; }
    PG8_BAR;
    if constexpr (Epi::AFTER_DRAIN) { E.fused(acc, cur, wr, wc, fr, fq, lds, wid, lane); S.done(cur); }
#undef PG8_SA
#undef PG8_SB
#undef PG8_STAGE
#undef PG8_LDA
#undef PG8_STAGE_A
#undef PG8_GOFF
#undef PG8_LDB
#undef PG8_MMA
#undef PG8_WAIT_V
#undef PG8_WAIT_L
#undef PG8_BAR
#undef PG8_SCHED
}
}

#include <hip/hip_bf16.h>
#include <cmath>
namespace attn_body {
using bf16=__hip_bfloat16;
using bf16x8=__attribute__((ext_vector_type(8)))short;
using s16x4=__attribute__((ext_vector_type(4)))short;
using f32x16=__attribute__((ext_vector_type(16)))float;
using u32x4=__attribute__((ext_vector_type(4)))unsigned;
constexpr int D=64, QP=3584, KP=3584, VP=3584, OP=1024;
constexpr int NW=8,QBLK=32,QB=QBLK*NW,KVBLK=64;
constexpr int ATTN_UNIT_ROWS=QB;
__device__ __forceinline__ int crow(int r,int hi){return (r&3)+8*(r>>2)+4*hi;}
#define SBAR() __builtin_amdgcn_sched_barrier(0)
__device__ __forceinline__ void cmask(f32x16&p0,f32x16&p1,int jb,int qrel,int hi){
  const float NEG=-INFINITY; int kb=64*jb+4*hi;
  #pragma unroll
  for(int r=0;r<16;++r){int kv=kb+(r&3)+8*(r>>2); if(kv>qrel)p0[r]=NEG; if(kv+32>qrel)p1[r]=NEG;}
}

constexpr int NSLOT=3, SLOTB=8192;
constexpr int LDS_K=0, LDS_V=NSLOT*SLOTB, LDS_WS=2*NSLOT*SLOTB, LDS_OST=LDS_WS+NW*64*4, LDS_BYTES=LDS_OST+NW*4096;
constexpr float C2=0.125f*1.4426950408889634f;
__device__ __forceinline__ void glds16(const void*gsrc,unsigned lds_dst){unsigned keep;
  asm volatile("s_mov_b32 %0, m0\n\ts_mov_b32 m0, %2\n\ts_nop 0\n\tglobal_load_lds_dwordx4 %1, off\n\ts_mov_b32 m0, %0":"=&s"(keep):"v"(gsrc),"s"(lds_dst):"memory");}
__device__ __forceinline__ float max3f(float a,float b,float c){float r;asm("v_max3_f32 %0, %1, %2, %3":"=v"(r):"v"(a),"v"(b),"v"(c));return r;}
__device__ __forceinline__ float max2f(float a,float b){float r;asm("v_max_f32_e32 %0, %1, %2":"=v"(r):"v"(a),"v"(b));return r;}
__device__ __forceinline__ float fadd_s(float a,float b){float r;asm("v_add_f32_e32 %0, %1, %2":"=v"(r):"v"(a),"v"(b));return r;}
__device__ __forceinline__ float fsub_s(float a,float b){float r;asm("v_sub_f32_e32 %0, %1, %2":"=v"(r):"v"(a),"v"(b));return r;}
typedef float f32x2_t __attribute__((ext_vector_type(2))); typedef __bf16 bf16x2_t __attribute__((ext_vector_type(2)));
__device__ __forceinline__ unsigned cvtpk_s(float lo,float hi){f32x2_t v={lo,hi};bf16x2_t b=__builtin_convertvector(v,bf16x2_t);return __builtin_bit_cast(unsigned,b);}
#define WAIT_BAR(N) asm volatile("s_waitcnt vmcnt(" #N ") lgkmcnt(0)\n\ts_barrier":::"memory")

__device__ __forceinline__ void qkt(f32x16&p0,f32x16&p1,const char*Kslot,const bf16x8*qr,const f32x16&negm,int r32,int hi){
  const char*kb=Kslot+hi*1024+r32*16;
  #pragma unroll
  for(int d0=0;d0<4;++d0){
    const bf16x8 b0=*reinterpret_cast<const bf16x8*>(kb+d0*2048);
    const bf16x8 b1=*reinterpret_cast<const bf16x8*>(kb+d0*2048+512);
    if(d0==0){p0=__builtin_amdgcn_mfma_f32_32x32x16_bf16(b0,qr[0],negm,0,0,0);p1=__builtin_amdgcn_mfma_f32_32x32x16_bf16(b1,qr[0],negm,0,0,0);}
    else{p0=__builtin_amdgcn_mfma_f32_32x32x16_bf16(b0,qr[d0],p0,0,0,0);p1=__builtin_amdgcn_mfma_f32_32x32x16_bf16(b1,qr[d0],p1,0,0,0);}}
}
typedef __attribute__((address_space(3))) const char* lds_cptr;
typedef short v4i16_t __attribute__((ext_vector_type(4)));
__device__ __forceinline__ void kload8(bf16x8*kf,lds_cptr kp){
  kf[0]=*(const __attribute__((address_space(3))) bf16x8*)(kp);      kf[1]=*(const __attribute__((address_space(3))) bf16x8*)(kp+512);
  kf[2]=*(const __attribute__((address_space(3))) bf16x8*)(kp+2048); kf[3]=*(const __attribute__((address_space(3))) bf16x8*)(kp+2560);
  kf[4]=*(const __attribute__((address_space(3))) bf16x8*)(kp+4096); kf[5]=*(const __attribute__((address_space(3))) bf16x8*)(kp+4608);
  kf[6]=*(const __attribute__((address_space(3))) bf16x8*)(kp+6144); kf[7]=*(const __attribute__((address_space(3))) bf16x8*)(kp+6656);
}
__device__ __forceinline__ void kload2(bf16x8*kf,lds_cptr kp,int j){ kf[2*j]=*(const __attribute__((address_space(3))) bf16x8*)(kp+j*2048); kf[2*j+1]=*(const __attribute__((address_space(3))) bf16x8*)(kp+j*2048+512); }
__device__ __forceinline__ s16x4 vtr(lds_cptr p){ return __builtin_bit_cast(s16x4,__builtin_amdgcn_ds_read_tr16_b64_v4i16((__attribute__((address_space(3))) v4i16_t*)p)); }
__device__ __forceinline__ float rowmax(const f32x16&p0,const f32x16&p1){
  float a=max3f(p0[0],p0[1],p1[0]),b=max3f(p0[2],p0[3],p1[1]);a=max3f(a,p1[2],p1[3]);
  #pragma unroll
  for(int r=4;r<16;r+=4){a=max3f(a,p0[r],p0[r+1]);b=max3f(b,p0[r+2],p0[r+3]);a=max3f(a,p1[r],p1[r+1]);b=max3f(b,p1[r+2],p1[r+3]);}
  const float m=max2f(a,b);
  auto rr=__builtin_amdgcn_permlane32_swap(__float_as_uint(m),__float_as_uint(m),false,false);
  return max2f(__uint_as_float(rr[0]),__uint_as_float(rr[1]));
}
__device__ __forceinline__ void pv(f32x16*o,int vb,bf16x8 pa0,bf16x8 pa1,bf16x8 pa2,bf16x8 pa3){
  #pragma unroll
  for(int d0=0;d0<2;++d0){s16x4 lo[4],hi[4];
    #pragma unroll
    for(int ks=0;ks<4;++ks){
      asm volatile("ds_read_b64_tr_b16 %0,%1 offset:%c2":"=&v"(lo[ks]):"v"(vb),"i"(d0*4096+ks*1024):"memory");
      asm volatile("ds_read_b64_tr_b16 %0,%1 offset:%c2":"=&v"(hi[ks]):"v"(vb),"i"(d0*4096+ks*1024+512):"memory");}
    asm volatile("s_waitcnt lgkmcnt(0)":::"memory");SBAR();
    #define PK(k) (bf16x8){lo[k][0],lo[k][1],lo[k][2],lo[k][3],hi[k][0],hi[k][1],hi[k][2],hi[k][3]}
    o[d0]=__builtin_amdgcn_mfma_f32_32x32x16_bf16(pa0,PK(0),o[d0],0,0,0);
    o[d0]=__builtin_amdgcn_mfma_f32_32x32x16_bf16(pa1,PK(1),o[d0],0,0,0);
    o[d0]=__builtin_amdgcn_mfma_f32_32x32x16_bf16(pa2,PK(2),o[d0],0,0,0);
    o[d0]=__builtin_amdgcn_mfma_f32_32x32x16_bf16(pa3,PK(3),o[d0],0,0,0);
    #undef PK
  }
}

#ifndef ATTN_STORE16
#define ATTN_STORE16(p,v) (*(u32x4*)(p)=(v))
#endif
template<int THRL> __device__ __forceinline__ void attn_unit(int q0,int NT,const bf16*Qh,const bf16*__restrict__ Kh,const bf16*__restrict__ Vh,bf16*Oh,char*shm,const int tid){
  const int lane=tid&63,r32=lane&31,hi=lane>>5; const int wid=__builtin_amdgcn_readfirstlane(tid>>6);
  const bf16*Qw=Qh+(long)(q0+wid*QBLK)*QP;
  const unsigned lds0=(unsigned)(uintptr_t)shm;
  float*wsf=(float*)(shm+LDS_WS)+wid*64;
  const bf16*ksrc=Kh+(long)lane*KP+wid*8;
  const bf16*vsrc=Vh+(long)(16*(wid&3)+(lane>>2))*VP+(wid>>2)*32+(lane&3)*8;
  const unsigned kdst=lds0+LDS_K+wid*1024, vdst=lds0+LDS_V+wid*1024;
  #define DMA_K(t,slot) glds16(ksrc+(long)(t)*KVBLK*KP,(unsigned)__builtin_amdgcn_readfirstlane(kdst+(slot)))
  #define DMA_V(t,slot) glds16(vsrc+(long)(t)*KVBLK*VP,(unsigned)__builtin_amdgcn_readfirstlane(vdst+(slot)))
  const int vb0=(int)(lds0+LDS_V)+((lane>>4)&1)*32+(lane&3)*8+(4*hi+((lane&15)>>2))*64;
  const char*Kbase=shm+LDS_K; bf16x8 kf[8];
  const lds_cptr shm3=(lds_cptr)shm; const lds_cptr kp0=shm3+LDS_K+hi*1024+r32*16; const lds_cptr vp0=shm3+LDS_V+((lane>>4)&1)*32+(lane&3)*8+(4*hi+((lane&15)>>2))*64;
  DMA_K(0,0);DMA_V(0,0);DMA_K(1,SLOTB);
  bf16x8 qr[4];
  #pragma unroll
  for(int d0=0;d0<4;++d0)qr[d0]=*reinterpret_cast<const bf16x8*>(&Qw[(long)r32*QP+d0*16+hi*8]);
  float mhat=0.f,l_reg=0.f;f32x16 o[2];o[0]=f32x16{};o[1]=f32x16{};f32x16 negm=f32x16{};asm volatile("":"+v"(negm));
  #define CMASK(P0,P1,t) do{}while(0)
  bool resc=false;
  #define START(P0,P1) do{ const float rm=rowmax(P0,P1); resc=false; \
    { const float dl=rm; mhat=fadd_s(mhat,dl); \
      _Pragma("unroll") for(int r=0;r<16;++r){P0[r]=fsub_s(P0[r],dl);P1[r]=fsub_s(P1[r],dl);} \
      _Pragma("unroll") for(int r=0;r<16;++r)negm[r]=-mhat; asm volatile("":"+v"(negm)); } \
    _Pragma("unroll") for(int r=0;r<16;++r)P0[r]=__builtin_amdgcn_exp2f(P0[r]); }while(0)
  #define RESC() do{ if(resc){ asm volatile("s_waitcnt lgkmcnt(0)":::"memory"); \
      _Pragma("unroll") for(int d_=0;d_<2;++d_) _Pragma("unroll") for(int r=0;r<16;++r)o[d_][r]*=wsf[crow(r,hi)]; } }while(0)
  f32x16 pA0,pA1,pB0,pB1;
  int sl_prev=0,sl_cur=0,sl_next=SLOTB;
  #define ROT() do{sl_prev=sl_cur;sl_cur=sl_next;sl_next=(sl_next==(NSLOT-1)*SLOTB)?0:sl_next+SLOTB;}while(0)
  DMA_K(2,2*SLOTB);
  WAIT_BAR(3);
  qkt(pA0,pA1,Kbase,qr,negm,r32,hi);asm volatile("s_nop 15\n\ts_nop 7":"+v"(pA0),"+v"(pA1));CMASK(pA0,pA1,0);
  START(pA0,pA1);
  _Pragma("unroll") for(int r=0;r<16;++r)pA1[r]=__builtin_amdgcn_exp2f(pA1[r]);
  WAIT_BAR(0);
  DMA_K(3,0);DMA_V(1,SLOTB);
  ROT();
  kload8(kf,kp0+sl_cur);
  WAIT_BAR(2);
  s16x4 vlo[8],vhi[8]; u32x4 pw0,pw1,pw2,pw3;
  #define PKW(P,B) cvtpk_s(P[B],P[B+1])
  #define PAF(k) __builtin_bit_cast(bf16x8,pw##k)
  #define VFR(i) (bf16x8){vlo[i][0],vlo[i][1],vlo[i][2],vlo[i][3],vhi[i][0],vhi[i][1],vhi[i][2],vhi[i][3]}
  #define PIN(x) asm volatile("":"+v"(x))
  #define MX3(a,b,c) __builtin_fmaxf(__builtin_fmaxf((a),(b)),(c))
  #define GAPA(MF,A0,A1,A2,A3,W0,W1,PW) do{ MF; sacc+=A0; sacc+=A1; sacc+=A2; sacc+=A3; PIN(sacc); W0; W1; PIN(PW); SBAR(); }while(0)
  #define EX(v) __builtin_amdgcn_exp2f(v)
  #define GAPB(MF,X,B) do{ MF; X[B]=EX(X[B]); X[B+1]=EX(X[B+1]); X[B+2]=EX(X[B+2]); X[B+3]=EX(X[B+3]); PIN(X); SBAR(); }while(0)
  #define VRD(i) do{ vlo[i]=vtr(vp_+(((i)>>2)*4096+((i)&3)*1024)); vhi[i]=vtr(vp_+(((i)>>2)*4096+((i)&3)*1024+512)); }while(0)
  #define KRD(G,j) do{ if(G){ kload2(kf,kp0+sl_next,j); SBAR(); } }while(0)
  #define STEP(C0,C1,P0,P1,t,GK,GV,GL) do{ SBAR(); \
    const lds_cptr vp_=vp0+sl_prev; \
    VRD(0); SBAR(); float sacc=(P0[0]+P0[1]); \
    GAPA(C0=__builtin_amdgcn_mfma_f32_32x32x16_bf16(kf[0],qr[0],negm,0,0,0), P0[2],P0[3],P0[4],P0[5],     pw0[0]=PKW(P0,0), pw0[1]=PKW(P0,2), pw0); \
    VRD(4); SBAR(); GAPA(C1=__builtin_amdgcn_mfma_f32_32x32x16_bf16(kf[1],qr[0],negm,0,0,0), P0[6],P0[7],P0[8],P0[9],     pw0[2]=PKW(P0,4), pw0[3]=PKW(P0,6), pw0); \
    VRD(1); SBAR(); GAPA(C0=__builtin_amdgcn_mfma_f32_32x32x16_bf16(kf[2],qr[1],C0,0,0,0),   P0[10],P0[11],P0[12],P0[13], pw1[0]=PKW(P0,8), pw1[1]=PKW(P0,10), pw1); \
    VRD(5); SBAR(); GAPA(C1=__builtin_amdgcn_mfma_f32_32x32x16_bf16(kf[3],qr[1],C1,0,0,0),   P0[14],P0[15],P1[0],P1[1],   pw1[2]=PKW(P0,12),pw1[3]=PKW(P0,14), pw1); \
    VRD(2); SBAR(); GAPA(C0=__builtin_amdgcn_mfma_f32_32x32x16_bf16(kf[4],qr[2],C0,0,0,0),   P1[2],P1[3],P1[4],P1[5],     pw2[0]=PKW(P1,0), pw2[1]=PKW(P1,2), pw2); \
    VRD(6); SBAR(); GAPA(C1=__builtin_amdgcn_mfma_f32_32x32x16_bf16(kf[5],qr[2],C1,0,0,0),   P1[6],P1[7],P1[8],P1[9],     pw2[2]=PKW(P1,4), pw2[3]=PKW(P1,6), pw2); \
    VRD(3); SBAR(); GAPA(C0=__builtin_amdgcn_mfma_f32_32x32x16_bf16(kf[6],qr[3],C0,0,0,0),   P1[10],P1[11],P1[12],P1[13], pw3[0]=PKW(P1,8), pw3[1]=PKW(P1,10), pw3); \
    VRD(7); SBAR(); GAPA(C1=__builtin_amdgcn_mfma_f32_32x32x16_bf16(kf[7],qr[3],C1,0,0,0),   P1[14],P1[15],0.f,0.f,       pw3[2]=PKW(P1,12),pw3[3]=PKW(P1,14), pw3); \
    l_reg+=sacc; \
    if(GK){DMA_K((t)+3,sl_cur);} if(GV){DMA_V((t)+1,sl_next);} \
    CMASK(C0,C1,t); \
    { float a=MX3(C0[0],C0[1],C1[0]),b=MX3(C0[2],C0[3],C1[1]); a=MX3(a,C1[2],C1[3]); \
      _Pragma("unroll") for(int r=4;r<16;r+=4){a=MX3(a,C0[r],C0[r+1]);b=MX3(b,C0[r+2],C0[r+3]);a=MX3(a,C1[r],C1[r+1]);b=MX3(b,C1[r+2],C1[r+3]);} \
      float rm=__builtin_fmaxf(a,b); { auto rr=__builtin_amdgcn_permlane32_swap(__float_as_uint(rm),__float_as_uint(rm),false,false); rm=__builtin_fmaxf(__uint_as_float(rr[0]),__uint_as_float(rr[1])); } \
      resc=false; \
      if(__builtin_expect(__any(rm>(float)THRL),0)){ const float dl=__builtin_fmaxf(rm,0.f); mhat+=dl; \
        _Pragma("unroll") for(int r=0;r<16;++r){C0[r]-=dl;C1[r]-=dl;} \
        _Pragma("unroll") for(int r=0;r<16;++r)negm[r]=-mhat; asm volatile("":"+v"(negm)); \
        const float f=__builtin_amdgcn_exp2f(-dl); l_reg*=f; if(hi==0)wsf[r32]=f; resc=true; } } \
    SBAR(); \
    GAPB(o[0]=__builtin_amdgcn_mfma_f32_32x32x16_bf16(PAF(0),VFR(0),o[0],0,0,0), C0,0); \
    GAPB(o[1]=__builtin_amdgcn_mfma_f32_32x32x16_bf16(PAF(0),VFR(4),o[1],0,0,0), C0,4); \
    KRD(GL,0); GAPB(o[0]=__builtin_amdgcn_mfma_f32_32x32x16_bf16(PAF(1),VFR(1),o[0],0,0,0), C0,8); \
    KRD(GL,1); GAPB(o[1]=__builtin_amdgcn_mfma_f32_32x32x16_bf16(PAF(1),VFR(5),o[1],0,0,0), C0,12); \
    KRD(GL,2); GAPB(o[0]=__builtin_amdgcn_mfma_f32_32x32x16_bf16(PAF(2),VFR(2),o[0],0,0,0), C1,0); \
    KRD(GL,3); GAPB(o[1]=__builtin_amdgcn_mfma_f32_32x32x16_bf16(PAF(2),VFR(6),o[1],0,0,0), C1,4); \
    GAPB(o[0]=__builtin_amdgcn_mfma_f32_32x32x16_bf16(PAF(3),VFR(3),o[0],0,0,0), C1,8); \
    GAPB(o[1]=__builtin_amdgcn_mfma_f32_32x32x16_bf16(PAF(3),VFR(7),o[1],0,0,0), C1,12); \
    }while(0)
  int t=1;
  #undef CMASK
  #define CMASK(P0,P1,t) do{}while(0)
  for(;t+5<NT;t+=2){
    STEP(pB0,pB1,pA0,pA1,t,true,true,true);     WAIT_BAR(2); RESC(); ROT();
    STEP(pA0,pA1,pB0,pB1,t+1,true,true,true);   WAIT_BAR(2); RESC(); ROT();
  }
  #undef CMASK
  #define CMASK(P0,P1,t) do{}while(0)
  #define ENDW(tt) do{ if((tt)+3<NT){WAIT_BAR(2);} else if((tt)+2<NT){WAIT_BAR(1);} else {WAIT_BAR(0);} }while(0)
  for(;t+1<NT;t+=2){
    STEP(pB0,pB1,pA0,pA1,t,(t+3<NT),(t+1<NT),(t+1<NT));       ENDW(t);   RESC(); ROT();
    STEP(pA0,pA1,pB0,pB1,t+1,(t+4<NT),(t+2<NT),(t+2<NT));     ENDW(t+1); RESC(); ROT();
  }
  STEP(pB0,pB1,pA0,pA1,NT-1,false,false,false); RESC();
  { float sacc=pB0[0]+pB0[1]; _Pragma("unroll") for(int r=2;r<16;++r)sacc+=pB0[r]; _Pragma("unroll") for(int r=0;r<16;++r)sacc+=pB1[r]; l_reg+=sacc;
    pw0=(u32x4){PKW(pB0,0),PKW(pB0,2),PKW(pB0,4),PKW(pB0,6)};pw1=(u32x4){PKW(pB0,8),PKW(pB0,10),PKW(pB0,12),PKW(pB0,14)};pw2=(u32x4){PKW(pB1,0),PKW(pB1,2),PKW(pB1,4),PKW(pB1,6)};pw3=(u32x4){PKW(pB1,8),PKW(pB1,10),PKW(pB1,12),PKW(pB1,14)};
    SBAR(); pv(o,vb0+sl_cur,PAF(0),PAF(1),PAF(2),PAF(3)); }
  #undef PKW
  #undef PAF
  #undef VFR
  #undef PIN
  #undef MX3
  #undef GAPA
  #undef GAPB
  #undef EX
  #undef VRD
  #undef KRD
  #undef STEP
  #undef ENDW
  {float la_=l_reg,lb_=l_reg;asm volatile("s_nop 1\n\tv_permlane32_swap_b32 %0, %1\n\ts_nop 1":"+v"(la_),"+v"(lb_));l_reg=la_+lb_;}
  if(hi==0)wsf[32+r32]=l_reg;asm volatile("s_waitcnt lgkmcnt(0)":::"memory");
  float rli[16];
  #pragma unroll
  for(int r=0;r<16;++r)rli[r]=__builtin_amdgcn_rcpf(wsf[32+crow(r,hi)]);
  bf16*Ow=Oh+(long)(q0+wid*QBLK)*OP;
  { bf16*stg=(bf16*)(shm+LDS_OST)+wid*2048;
    #pragma unroll
    for(int r=0;r<16;++r){const int orow=crow(r,hi);
      #pragma unroll
      for(int d0=0;d0<2;++d0)stg[orow*64+d0*32+r32]=__float2bfloat16(o[d0][r]*rli[r]);}
    asm volatile("s_waitcnt lgkmcnt(0)":::"memory");
    #pragma unroll
#ifdef OUTPROJ_FP8
    #define SATF(x) __builtin_amdgcn_fmed3f((x),-448.0f,448.0f)
    for(int i=0;i<4;++i){const int row=i*8+(lane>>3),ch=lane&7; const u32x4 v=*(const u32x4*)(stg+row*64+ch*8);
      const unsigned vs[4]={v.x,v.y,v.z,v.w}; unsigned o8[2];
      #pragma unroll
      for(int j=0;j<2;++j){int wq=0; wq=__builtin_amdgcn_cvt_pk_fp8_f32(SATF(__builtin_bit_cast(float,vs[2*j]<<16)*4.0f),SATF(__builtin_bit_cast(float,vs[2*j]&0xffff0000u)*4.0f),wq,false);
        wq=__builtin_amdgcn_cvt_pk_fp8_f32(SATF(__builtin_bit_cast(float,vs[2*j+1]<<16)*4.0f),SATF(__builtin_bit_cast(float,vs[2*j+1]&0xffff0000u)*4.0f),wq,true); o8[j]=(unsigned)wq;}
      typedef unsigned u32x2_ __attribute__((ext_vector_type(2)));
      { const int rl=q0+wid*QBLK+row; *(u32x2_*)((unsigned char*)Oh+(long)(rl>>1)*(2*OP)+(rl&1)*64+ch*8)=(u32x2_){o8[0],o8[1]}; } } }
    #undef SATF
#else
    for(int i=0;i<4;++i){const int row=i*8+(lane>>3),ch=lane&7; const u32x4 v=*(const u32x4*)(stg+row*64+ch*8); ATTN_STORE16(Ow+(long)row*OP+ch*8,v);} }
#endif
  asm volatile("s_waitcnt lgkmcnt(0)\n\ts_barrier":::"memory");
  #undef DMA_K
  #undef DMA_V
  #undef CMASK
  #undef START
  #undef RESC
  #undef ROT
}
constexpr int ATTN_LDS_BYTES=LDS_BYTES;
#undef SBAR
#undef WAIT_BAR
}
constexpr int NWAVES = 8, NTHR = 512;
constexpr int NB = 16, T_LAT = 2048, L_CTX = 256, DM = 1024, RPB = T_LAT + L_CTX  , MROWS = NB * RPB  , NPROJ = 3584, DEPTH = 2;
constexpr int NPANEL = MROWS / 256  , PPB = RPB / 256  ;
constexpr float NORM_EPS = 1e-6f;
constexpr int C_HQ = 0, C_HI = 256, C_HZ = 512  , C_HG = 1024, C_CB = 1280, C_CC = 1536, C_CH = 1792, C_RQ = 2048, C_RK = 2304, C_RV = 2560, C_RG = 2816, C_AQ = 3072, C_AK = 3328, C_AV = 3456;
constexpr size_t MiB = 1u << 20;
constexpr size_t WS_CTL = 0, CTL_ZERO_BYTES = 1 * MiB;
constexpr size_t WS_MOD = 1 * MiB;
constexpr size_t WS_ROPE = 2 * MiB;
constexpr size_t WS_ROUTE = 3 * MiB;
constexpr size_t WS_ROWINFO = 4 * MiB;
constexpr size_t WS_BCNT = 5 * MiB;
constexpr size_t WS_TILEINFO = 6 * MiB;
constexpr size_t WS_DBUF = 7 * MiB;
constexpr size_t WS_W0 = 12 * MiB, WLAYER = 33 * MiB;
constexpr size_t WO_WIN = 0;
constexpr size_t WO_WOUT = 7 * MiB;
constexpr size_t WO_WGU = 9 * MiB;
constexpr size_t WO_WD = 25 * MiB;
constexpr size_t WS_CTX = 78 * MiB;
constexpr size_t WS_ACT = 94 * MiB;
constexpr size_t WS_P = 166 * MiB;
constexpr size_t WS_ASORT = WS_P;
constexpr size_t WS_H = WS_P + 84 * MiB;
constexpr size_t WS_KVS = 418 * MiB;
constexpr size_t WS_END = 490 * MiB;
constexpr int MAXTILES = 168;
constexpr int CW_ERR = 16;
constexpr int CW_BAR = 4096;
constexpr int CW_BAR3 = 12288, CW_BAR4 = 16384, CW_BAR5 = 20480;
constexpr int CW_BAR2 = 8192;
constexpr int RING_OFF = 0, RING_BYTES = 139264;
constexpr int LDSCTL_OFF = RING_BYTES, MISC_OFF = LDSCTL_OFF + 320;
constexpr int PTAB_OFF = LDSCTL_OFF + 512;
constexpr int TAB_OFF = LDSCTL_OFF + 1024;
constexpr int LDS_BYTES = 147456;

#define GAS __attribute__((address_space(1)))
#define LAS __attribute__((address_space(3)))
typedef unsigned short bf16;
typedef unsigned v4u __attribute__((ext_vector_type(4)));
typedef unsigned v2u __attribute__((ext_vector_type(2)));
typedef int v4i __attribute__((ext_vector_type(4)));
typedef float f32x4 __attribute__((ext_vector_type(4)));
typedef GAS unsigned gu32;
#define RLX_AGENT __ATOMIC_RELAXED, __HIP_MEMORY_SCOPE_AGENT
#define LDS_WAIT() asm volatile("s_waitcnt lgkmcnt(0)" ::: "memory")
#define VM_WAIT() asm volatile("s_waitcnt vmcnt(0)" ::: "memory")
typedef float pkf32x2_t __attribute__((ext_vector_type(2))); typedef __bf16 pkbf16x2_t __attribute__((ext_vector_type(2)));
__device__ __forceinline__ unsigned pk2(float lo, float hi) { const pkf32x2_t v = {lo, hi}; return __builtin_bit_cast(unsigned, __builtin_convertvector(v, pkbf16x2_t)); }
__device__ __forceinline__ unsigned f2bf(float f) { return pk2(f, 0.f) & 0xffffu; }
__device__ __forceinline__ float bflo(unsigned w) { return __builtin_bit_cast(float, w << 16); }
__device__ __forceinline__ float bfhi(unsigned w) { return __builtin_bit_cast(float, w & 0xffff0000u); }
__device__ __forceinline__ float bf1(bf16 h) { return __builtin_bit_cast(float, (unsigned)h << 16); }
__device__ __forceinline__ unsigned pk4_fp8(float a, float b, float c, float d) { int w = 0; a = __builtin_amdgcn_fmed3f(a, -448.0f, 448.0f); b = __builtin_amdgcn_fmed3f(b, -448.0f, 448.0f); c = __builtin_amdgcn_fmed3f(c, -448.0f, 448.0f); d = __builtin_amdgcn_fmed3f(d, -448.0f, 448.0f);     w = __builtin_amdgcn_cvt_pk_fp8_f32(a, b, w, false); w = __builtin_amdgcn_cvt_pk_fp8_f32(c, d, w, true); return (unsigned)w; }
__device__ __forceinline__ float fp8_dec(unsigned b) { const unsigned s = b >> 7, e = (b >> 3) & 15u, m = b & 7u; const float v = e ? (float)(8u + m) * exp2f((float)e - 10.0f) : (float)m * 0.001953125f; return s ? -v : v; }
__device__ __forceinline__ float siluf(float x) { return x * __builtin_amdgcn_rcpf(1.0f + __expf(-x)); }
__device__ __forceinline__ float sigmf(float x) { return __builtin_amdgcn_rcpf(1.0f + __expf(-x)); }
template <int K> __device__ __forceinline__ float xshf(float v) { static_assert(K >= 1 && K < 32, "xshf"); return __builtin_bit_cast(float, __builtin_amdgcn_ds_swizzle(__builtin_bit_cast(int, v), (K << 10) | 0x1f)); }
template <int K> __device__ __forceinline__ int xshi(int v) { static_assert(K >= 1 && K < 32, "xshi"); return __builtin_amdgcn_ds_swizzle(v, (K << 10) | 0x1f); }
__device__ __forceinline__ void half_swap(float& a, float& b) { asm volatile("s_nop 1\n\tv_permlane32_swap_b32 %0, %1\n\ts_nop 1" : "+v"(a), "+v"(b)); }
__device__ __forceinline__ float half_sum(float v) { float a = v, b = v; half_swap(a, b); return a + b; }
__device__ __forceinline__ float half_max(float v) { float a = v, b = v; half_swap(a, b); return fmaxf(a, b); }
__device__ __forceinline__ float sum16(float v) { v += xshf<1>(v); v += xshf<2>(v); v += xshf<4>(v); v += xshf<8>(v); return v; }
__device__ __forceinline__ float sum32(float v) { v = sum16(v); v += xshf<16>(v); return v; }
__device__ __forceinline__ float wave_sum(float v) { return half_sum(sum32(v)); }
#define XB_TMO      128
#define XB_XCNT(j)  (256  + 64 * (j))
#define XB_XSUB(j)  (1280 + 64 * (j))
#define XB_XGEN(j)  (2304 + 64 * (j))
#define XB_TOP      3328
#define XB_TOPGEN   3392
#define XCD_BAR_WORDS 3456
#define XB_SPIN_CAP (1u << 18)

__device__ __forceinline__ unsigned xb_ld(unsigned* p)              { return __hip_atomic_load(p, __ATOMIC_RELAXED, __HIP_MEMORY_SCOPE_AGENT); }
__device__ __forceinline__ unsigned xb_add(unsigned* p, unsigned v) { return __hip_atomic_fetch_add(p, v, __ATOMIC_RELAXED, __HIP_MEMORY_SCOPE_AGENT); }
__device__ __forceinline__ unsigned xb_xcc_id() { return (unsigned)__builtin_amdgcn_s_getreg((3 << 11) | 20) & 0xFu; }
#define XB_SPIN(cond, bar) do { unsigned _sp = 0; while (cond) { __builtin_amdgcn_s_sleep(1); \
    if ((++_sp & 255u) == 0u) { if (xb_ld(&(bar)[XB_TMO])) break; if (_sp > XB_SPIN_CAP) { atomicAdd(&(bar)[XB_TMO], 1u); break; } } } } while (0)

struct XcdBarrier {
    unsigned* bar; unsigned x;
    volatile LAS unsigned* st;
};

__device__ __forceinline__ XcdBarrier xcd_barrier_post(unsigned* bar, volatile LAS unsigned* st) {
    XcdBarrier b; b.bar = bar; b.x = xb_xcc_id(); b.st = st;
    if (threadIdx.x == 0) (void)xb_add(&bar[XB_XCNT(b.x)], 1u);
    return b;
}
__device__ __forceinline__ void xcd_barrier_complete(unsigned* bar, unsigned x, unsigned& nloc, unsigned& nx) {
    const unsigned G = gridDim.x * gridDim.y * gridDim.z;
    unsigned sum, cnt, mine, sp = 0u;
    for (;;) {
        sum = 0u; cnt = 0u; mine = 0u;
#pragma unroll
        for (unsigned j = 0; j < 16; ++j) { const unsigned c = xb_ld(&bar[XB_XCNT(j)]); sum += c; cnt += (c > 0u) ? 1u : 0u; mine = (j == x) ? c : mine; }
        if (sum == G) break;
        __builtin_amdgcn_s_sleep(1);
        if ((++sp & 255u) == 0u) { if (xb_ld(&bar[XB_TMO])) break; if (sp > XB_SPIN_CAP) { atomicAdd(&bar[XB_TMO], 1u); break; } }
    }
    nloc = mine > 0u ? mine : 1u; nx = cnt > 0u ? cnt : 1u;
}

__device__ __forceinline__ void xcd_barrier(const XcdBarrier& b) {
    asm volatile("s_waitcnt vmcnt(0)" ::: "memory");
    __syncthreads();
    if (threadIdx.x == 0) {
        unsigned* bar = b.bar; asm volatile("" : "+s"(bar));
        __builtin_amdgcn_s_waitcnt(0);
        unsigned nloc = b.st[0], nx = b.st[1];
        if (nloc == 0u) { xcd_barrier_complete(bar, b.x, nloc, nx); b.st[0] = nloc; b.st[1] = nx; }
#ifdef EARLY_WB
        __builtin_amdgcn_fence(__ATOMIC_RELEASE, "agent"); asm volatile("s_waitcnt vmcnt(0)" ::: "memory");
#endif
        const unsigned old = xb_add(&bar[XB_XSUB(b.x)], 1u);
        const unsigned gen = old / nloc;
#ifdef MID_WB
        if (old + 1u - gen * nloc == MID_WB_AT(nloc)) asm volatile("buffer_wbl2 sc1" ::: "memory");
#endif
        if (old + 1u == (gen + 1u) * nloc) {
            __builtin_amdgcn_fence(__ATOMIC_RELEASE, "agent");
            asm volatile("s_waitcnt vmcnt(0)" ::: "memory");
#if defined(TOP_DIRECT) && defined(EARLY_INV)
            (void)xb_add(&bar[XB_TOP], 1u);
            asm volatile("buffer_inv sc1" ::: "memory");
            { const unsigned target = (gen + 1u) * nx; XB_SPIN(xb_ld(&bar[XB_TOP]) < target, bar); }
            asm volatile("" ::: "memory");
#else
            const unsigned og = xb_add(&bar[XB_TOP], 1u);
            const unsigned tg = og / nx;
#ifdef EARLY_INV
            asm volatile("buffer_inv sc1" ::: "memory");
            if (og + 1u == (tg + 1u) * nx) xb_add(&bar[XB_TOPGEN], 1u);
            else XB_SPIN(xb_ld(&bar[XB_TOPGEN]) == tg, bar);
            asm volatile("" ::: "memory");
#else
            if (og + 1u == (tg + 1u) * nx) xb_add(&bar[XB_TOPGEN], 1u);
            else XB_SPIN(xb_ld(&bar[XB_TOPGEN]) == tg, bar);
            __builtin_amdgcn_fence(__ATOMIC_ACQUIRE, "agent");
#endif
#endif
            xb_add(&bar[XB_XGEN(b.x)], 1u);
            asm volatile("s_waitcnt vmcnt(0)" ::: "memory");
        } else {
#ifdef EARLY_INV
            asm volatile("buffer_inv sc1" ::: "memory");
            XB_SPIN(xb_ld(&bar[XB_XGEN(b.x)]) == gen, bar);
            asm volatile("" ::: "memory");
#else
            XB_SPIN(xb_ld(&bar[XB_XGEN(b.x)]) == gen, bar);
            __builtin_amdgcn_fence(__ATOMIC_ACQUIRE, "agent");
#endif
            asm volatile("s_waitcnt vmcnt(0)" ::: "memory");
        }
    }
    __syncthreads();
}

__device__ __forceinline__ void xcd_split_arrive(const XcdBarrier& b, unsigned* bar2) {
    asm volatile("s_waitcnt vmcnt(0)" ::: "memory");
    __syncthreads();
    if (threadIdx.x == 0) {
        unsigned* bar = bar2; asm volatile("" : "+s"(bar));
        __builtin_amdgcn_s_waitcnt(0);
        unsigned nloc = b.st[0], nx = b.st[1];
        if (nloc == 0u) { xcd_barrier_complete(b.bar, b.x, nloc, nx); b.st[0] = nloc; b.st[1] = nx; }
        const unsigned old = xb_add(&bar[XB_XSUB(b.x)], 1u);
        if ((old + 1u) % nloc == 0u) {
            __builtin_amdgcn_fence(__ATOMIC_RELEASE, "agent");
            asm volatile("s_waitcnt vmcnt(0)" ::: "memory");
#ifdef TOP_DIRECT
            (void)xb_add(&bar[XB_TOP], 1u);
#else
            const unsigned og = xb_add(&bar[XB_TOP], 1u);
            if ((og + 1u) % nx == 0u) xb_add(&bar[XB_TOPGEN], 1u);
#endif
        }
    }
}
__device__ __forceinline__ void xcd_split_wait(const XcdBarrier& b, unsigned* bar2, unsigned target) {
    if (threadIdx.x == 0) {
        unsigned* bar = bar2; asm volatile("" : "+s"(bar));
#ifdef TOP_DIRECT
        { const unsigned nx_ = b.st[1]; XB_SPIN(xb_ld(&bar[XB_TOP]) < target * nx_, bar); }
#else
        XB_SPIN(xb_ld(&bar[XB_TOPGEN]) < target, bar);
#endif
        __builtin_amdgcn_fence(__ATOMIC_ACQUIRE, "agent");
        asm volatile("s_waitcnt vmcnt(0)" ::: "memory");
    }
    __syncthreads();
}
struct Args { const float* in[24]; float* out; unsigned char* ws; size_t ws_shift; };
enum { I_X = 0, I_C, I_CTX, I_CCTX, I_ADAW, I_ADAB, I_NMIX, I_NFFN, I_WIN, I_LB, I_HNORM, I_CONVW, I_RDEC, I_RNORM, I_QN, I_KN, I_WOUT, I_RGW, I_RGB, I_REW, I_REB, I_EG, I_EU, I_ED };
struct Frame {
    LAS unsigned char* lds;
    volatile LAS unsigned* MISC;
    gu32* ctl;
    int tid, lane, wave, vcu, G;
    unsigned bart;
};
__device__ __forceinline__ const void* lptr(const Frame& F, int i) {
    const volatile LAS unsigned* t = (const volatile LAS unsigned*)(F.lds + PTAB_OFF) + 2 * i;
    const unsigned lo = __builtin_amdgcn_readfirstlane(t[0]), hi = __builtin_amdgcn_readfirstlane(t[1]);
    return (const void*)(const GAS void*)(((unsigned long long)hi << 32) | lo);
}
#define PIN(i) ((const float*)lptr(F, (i)))
#define POUT ((float*)lptr(F, 24))
#define PWS ((unsigned char*)lptr(F, 25))
__device__ __forceinline__ int row_of_latent(int idx) { return (idx >> 11) * RPB + L_CTX + (idx & 2047); }

__device__ __forceinline__ void transpose_item(const float* W, int N, int k0, int n0, bf16* dst, int DP, LAS float* scr, int lane) {
#pragma unroll
    for (int i = 0; i < 8; ++i) { const int kk = 8 * i + (lane >> 3), nc = 4 * (lane & 7); const f32x4 v = *(const f32x4*)(W + (size_t)(k0 + kk) * N + n0 + nc);
        scr[kk * 33 + nc] = v.x; scr[kk * 33 + nc + 1] = v.y; scr[kk * 33 + nc + 2] = v.z; scr[kk * 33 + nc + 3] = v.w; }
    LDS_WAIT(); asm volatile("" ::: "memory");
    const int c = lane & 7;
#pragma unroll
    for (int j = 0; j < 4; ++j) { const int n = (lane >> 3) + 8 * j; const LAS float* s = scr + (8 * c) * 33 + n;
        v4u o; o.x = pk2(s[0 * 33], s[1 * 33]); o.y = pk2(s[2 * 33], s[3 * 33]); o.z = pk2(s[4 * 33], s[5 * 33]); o.w = pk2(s[6 * 33], s[7 * 33]);
        *(GAS v4u*)(dst + (size_t)n * DP + 8 * c) = o; }
    LDS_WAIT(); asm volatile("" ::: "memory");
}
__device__ __forceinline__ void transpose_item8(const float* W, int N, int k0, int n0, unsigned char* dst, int DP, float scale, LAS float* scr, int lane) {
#pragma unroll
    for (int i = 0; i < 8; ++i) { const int kk = 8 * i + (lane >> 3), nc = 4 * (lane & 7); const f32x4 v = *(const f32x4*)(W + (size_t)(k0 + kk) * N + n0 + nc) * scale;
        scr[kk * 33 + nc] = v.x; scr[kk * 33 + nc + 1] = v.y; scr[kk * 33 + nc + 2] = v.z; scr[kk * 33 + nc + 3] = v.w; }
    LDS_WAIT(); asm volatile("" ::: "memory");
    const int c = lane & 7;
#pragma unroll
    for (int j = 0; j < 4; ++j) { const int n = (lane >> 3) + 8 * j; const LAS float* s = scr + (8 * c) * 33 + n;
        v2u o; o.x = pk4_fp8(s[0 * 33], s[1 * 33], s[2 * 33], s[3 * 33]); o.y = pk4_fp8(s[4 * 33], s[5 * 33], s[6 * 33], s[7 * 33]);
        *(GAS v2u*)(dst + (size_t)n * DP + 8 * c) = o; }
    LDS_WAIT(); asm volatile("" ::: "memory");
}
struct WItem { const float* src; unsigned char* dst; int N, DP, f8, emu; };
__device__ __forceinline__ WItem witem_decode(const Frame& F, int it) {
    constexpr int PER_LAYER = 1792 + 512 + 3 * 4096;
    const int l = it / PER_LAYER; int r = it - l * PER_LAYER; unsigned char* ws = PWS + WS_W0 + (size_t)l * WLAYER; WItem w; w.emu = 0;
    if (r < 1792) { const int kb = r / 112, nb = r % 112; w.src = PIN(I_WIN) + (size_t)l * 1024 * NPROJ + (size_t)kb * 64 * NPROJ + nb * 32; w.N = NPROJ; w.emu = (EMU_TILES >> (nb >> 3)) & 1;
        if ((INPROJ_F8MASK >> (nb >> 3)) & 1) { w.dst = ws + WO_WIN + (size_t)(nb >> 3) * 524288 + (size_t)((nb & 7) * 32) * 1024 + kb * 64; w.DP = 1024; w.f8 = 1; return w; }
        w.dst = ws + WO_WIN + ((size_t)nb * 32 * 1024 + kb * 64) * 2; w.DP = 2048; w.f8 = 0; return w; }
    r -= 1792;
    if (r < 512) { const int kb = r / 32, nb = r % 32; w.src = PIN(I_WOUT) + (size_t)l * 1024 * 1024 + (size_t)kb * 64 * 1024 + nb * 32; w.N = 1024;
#ifdef OUTPROJ_FP8
        w.dst = ws + WO_WOUT + ((size_t)nb * 32 * 1024 + kb * 64); w.DP = 1024; w.f8 = 1; return w; }
#else
        w.dst = ws + WO_WOUT + ((size_t)nb * 32 * 1024 + kb * 64) * 2; w.DP = 2048; w.f8 = 0; return w; }
#endif
    r -= 512;
    if (r < 8192) { const int up = r >= 4096; r -= up * 4096; const int e = r >> 8, rr = r & 255, kb = rr >> 4, nb = rr & 15, n0 = nb * 32;
        const int drow = e * 1024 + (n0 >> 7) * 256 + up * 128 + (n0 & 127);
        w.src = (up ? PIN(I_EU) : PIN(I_EG)) + (size_t)(l * 16 + e) * 1024 * 512 + (size_t)kb * 64 * 512 + n0; w.N = 512; w.dst = ws + WO_WGU + (size_t)drow * 1024 + kb * 64; w.DP = 1024; w.f8 = 1; return w; }
    r -= 8192;
    { const int e = r >> 8, rr = r & 255, kb = rr >> 5, nb = rr & 31, g = e >> 2, el = e & 3;
        w.src = PIN(I_ED) + (size_t)(l * 16 + e) * 512 * 1024 + (size_t)kb * 64 * 1024 + nb * 32; w.N = 1024; w.dst = ws + WO_WD + ((size_t)g * 1024 + nb * 32) * 2048 + el * 512 + kb * 64; w.DP = 2048; w.f8 = 1; return w; }
}
__device__ __forceinline__ void convert_weights_range(Frame& F, int it0, int it1, int gw, int NGW) {
    LAS float* scr = (LAS float*)(F.lds + F.wave * 16384);
    const int lane = F.lane; const int NITEMS = it1;
    if (gw < 0 || it0 + gw >= NITEMS) return;
    gw += it0;
    const int kr = lane >> 3, nc = 4 * (lane & 7);
    WItem cur = witem_decode(F, gw); f32x4 v[8], vn[8];
#pragma unroll
    for (int i = 0; i < 8; ++i) v[i] = LDNT((const f32x4*)(cur.src + (size_t)(8 * i + kr) * cur.N + nc));
    for (int it = gw; it < NITEMS; it += NGW) {
        const int itn = it + NGW; const bool more = itn < NITEMS; WItem nxt = cur;
        if (more) { nxt = witem_decode(F, itn);
#pragma unroll
            for (int i = 0; i < 8; ++i) vn[i] = LDNT((const f32x4*)(nxt.src + (size_t)(8 * i + kr) * nxt.N + nc)); }
        const float sc = cur.f8 ? 32.0f : 1.0f;
#pragma unroll
        for (int i = 0; i < 8; ++i) { const int kk = 8 * i + kr; const f32x4 x = v[i] * sc; scr[kk * 33 + nc] = x.x; scr[kk * 33 + nc + 1] = x.y; scr[kk * 33 + nc + 2] = x.z; scr[kk * 33 + nc + 3] = x.w; }
        LDS_WAIT(); asm volatile("" ::: "memory");
        const int c = lane & 7;
#pragma unroll
        for (int j = 0; j < 4; ++j) { const int n = (lane >> 3) + 8 * j; const LAS float* s = scr + (8 * c) * 33 + n;
            if (cur.f8) { v2u o; o.x = pk4_fp8(s[0 * 33], s[1 * 33], s[2 * 33], s[3 * 33]); o.y = pk4_fp8(s[4 * 33], s[5 * 33], s[6 * 33], s[7 * 33]); *(GAS v2u*)(cur.dst + (size_t)n * cur.DP + 8 * c) = o; }
            else { float e[8];
#pragma unroll
                for (int q = 0; q < 8; ++q) { e[q] = s[q * 33]; if (cur.emu) { const int pq = __builtin_amdgcn_cvt_pk_fp8_f32(e[q] * 32.0f, 0.0f, 0, false); e[q] = __builtin_amdgcn_cvt_f32_fp8(pq, 0) * (1.0f / 32.0f); } }
                v4u o; o.x = pk2(e[0], e[1]); o.y = pk2(e[2], e[3]); o.z = pk2(e[4], e[5]); o.w = pk2(e[6], e[7]); *(GAS v4u*)(cur.dst + (size_t)n * cur.DP + 16 * c) = o; } }
        LDS_WAIT(); asm volatile("" ::: "memory");
        if (more) { cur = nxt;
#pragma unroll
            for (int i = 0; i < 8; ++i) v[i] = vn[i]; }
    }
}

__device__ __forceinline__ void p0_prologue(Frame& F, const XcdBarrier& gbar) {
    unsigned char* ws = PWS;
    {
        LAS float* sc = (LAS float*)(F.lds);
        LAS float* red = (LAS float*)(F.lds + 17 * 4096);
        bool staged = false;
        const float* pC = PIN(I_C); const float* pCC = PIN(I_CCTX); const float* pAW = PIN(I_ADAW); const float* pAB = PIN(I_ADAB); const float* pNM = PIN(I_NMIX); const float* pNF = PIN(I_NFFN);
#ifdef MOD_WIDE
        typedef float f32x3 __attribute__((ext_vector_type(3)));
        for (int it = F.vcu; it < DEPTH * 128; it += F.G) {
            if (!staged) {
                for (int i = F.tid; i < 17 * 1024; i += NTHR) { const float v = (i < 16 * 1024) ? pC[i] : pCC[i - 16 * 1024]; sc[i] = siluf(v); }
                staged = true;
            }
            __syncthreads();
            const int l = it >> 7, cb = it & 127, n0 = cb * 48, nn = F.tid & 15, ks = F.tid >> 4;
            const float* W = pAW + (size_t)l * 1024 * 6144 + n0 + 3 * nn;
            f32x3 acc[17];
#pragma unroll
            for (int m = 0; m < 17; ++m) acc[m] = (f32x3){0.f, 0.f, 0.f};
            for (int k = ks * 32; k < ks * 32 + 32; k += 4) {
                const f32x3 w0 = *(const f32x3*)(W + (size_t)k * 6144), w1 = *(const f32x3*)(W + (size_t)(k + 1) * 6144), w2 = *(const f32x3*)(W + (size_t)(k + 2) * 6144), w3 = *(const f32x3*)(W + (size_t)(k + 3) * 6144);
#pragma unroll
                for (int m = 0; m < 17; ++m) { const f32x4 s4 = *(const LAS f32x4*)(sc + m * 1024 + k); acc[m] += (w0 * s4.x + w1 * s4.y) + (w2 * s4.z + w3 * s4.w); } }
#pragma unroll
            for (int m = 0; m < 17; ++m) { float a = acc[m].x, b = acc[m].y, c3 = acc[m].z; a += xshf<16>(a); b += xshf<16>(b); c3 += xshf<16>(c3); acc[m] = (f32x3){half_sum(a), half_sum(b), half_sum(c3)}; }
            if (F.lane < 16) {
#pragma unroll
                for (int m = 0; m < 17; ++m) { LAS float* rp = red + (F.wave * 17 + m) * 48 + 3 * nn; rp[0] = acc[m].x; rp[1] = acc[m].y; rp[2] = acc[m].z; } }
            __syncthreads();
            for (int i = F.tid; i < 17 * 48; i += NTHR) { const int m = i / 48, n2 = i - m * 48, gcol = n0 + n2; float v = pAB[l * 6144 + gcol];
#pragma unroll
                for (int k2 = 0; k2 < 8; ++k2) v += red[(k2 * 17 + m) * 48 + n2];
                const int kch = gcol >> 10, col = gcol & 1023;
                if (kch == 1) v = pNM[l * 1024 + col] * (1.0f + v);
                if (kch == 4) v = pNF[l * 1024 + col] * (1.0f + v);
                ((float*)(ws + WS_MOD) + (size_t)(l * 6 + kch) * 17 * 1024)[m * 1024 + col] = v; }
        }
#else
        for (int it = F.vcu; it < DEPTH * 192; it += F.G) {
            if (!staged) {
                for (int i = F.tid; i < 17 * 1024; i += NTHR) { const float v = (i < 16 * 1024) ? pC[i] : pCC[i - 16 * 1024]; sc[i] = siluf(v); }
                staged = true;
            }
            __syncthreads();
            const int l = it / 192, cb = it % 192, n0 = cb * 32, nn = F.tid & 31, ks = F.tid >> 5;
            const float* W = pAW + (size_t)l * 1024 * 6144 + n0 + nn;
            float acc[17];
#pragma unroll
            for (int m = 0; m < 17; ++m) acc[m] = 0.f;
            for (int k = ks * 64; k < ks * 64 + 64; k += 4) { const float w0 = W[(size_t)k * 6144], w1 = W[(size_t)(k + 1) * 6144], w2 = W[(size_t)(k + 2) * 6144], w3 = W[(size_t)(k + 3) * 6144];
#pragma unroll
                for (int m = 0; m < 17; ++m) { const f32x4 s4 = *(const LAS f32x4*)(sc + m * 1024 + k); acc[m] += (s4.x * w0 + s4.y * w1) + (s4.z * w2 + s4.w * w3); } }
#pragma unroll
            for (int m = 0; m < 17; ++m) red[(ks * 17 + m) * 32 + nn] = acc[m];
            __syncthreads();
            const int kch = n0 >> 10, cc = n0 & 1023;
            float* MOD = (float*)(ws + WS_MOD) + (size_t)(l * 6 + kch) * 17 * 1024;
            for (int i = F.tid; i < 17 * 32; i += NTHR) { const int m = i >> 5, n2 = i & 31; float v = pAB[l * 6144 + n0 + n2];
#pragma unroll
                for (int k2 = 0; k2 < 16; ++k2) v += red[(k2 * 17 + m) * 32 + n2];
                const int col = cc + n2;
                if (kch == 1) v = pNM[l * 1024 + col] * (1.0f + v);
                if (kch == 4) v = pNF[l * 1024 + col] * (1.0f + v);
                MOD[m * 1024 + col] = v; }
        }
#endif
        __syncthreads();
    }
#ifdef SPLIT_PRO
    xcd_split_arrive(gbar, (unsigned*)(F.ctl + CW_BAR3));
#endif
    {
        float* RC = (float*)(ws + WS_ROPE); float* RS = RC + 2048 * 32;
        for (int i = (F.vcu * NTHR + F.tid); i < 2048 * 32; i += F.G * NTHR) { const int t = i >> 5, f = i & 31; const float pos = (float)((f < 16) ? (t >> 6) : (t & 63));
            const float invf = exp2f(-(float)(f & 15) * (13.287712379549449f / 16.0f)); const float ang = pos * invf; RC[i] = cosf(ang); RS[i] = sinf(ang); }
    }
    __syncthreads();
    convert_weights_range(F, 0, 1792 + 512 + 3 * 4096, F.vcu * NWAVES + F.wave, F.G * NWAVES);
    __syncthreads();
}
__device__ __forceinline__ void phase_norm1(Frame& F, const float* xsrc, const float* csrc, const float* nA, const float* nB, bf16* dst, unsigned char* dst8) {
    const int gw = F.vcu * NWAVES + F.wave, NGW = F.G * NWAVES, RPW = (MROWS + NGW - 1) / NGW;
    const int c0 = 8 * F.lane;
    int curm = -1; f32x4 a[4], bb[4];
#ifdef N1_INTERLEAVE
    (void)RPW; for (int r = gw; r < MROWS; r += NGW) {
#else
    for (int r = gw * RPW; r < (gw + 1) * RPW && r < MROWS; ++r) {
#endif
        const int b = r / RPB, j = r - b * RPB, m = (j < L_CTX) ? 16 : b;
        const float* src = (j < L_CTX) ? csrc + (size_t)(b * L_CTX + j) * DM : xsrc + (size_t)(b * T_LAT + j - L_CTX) * DM;
        if (m != curm) { curm = m;
#pragma unroll
            for (int q = 0; q < 4; ++q) { a[q] = *(const f32x4*)(nA + m * 1024 + c0 + 512 * (q >> 1) + 4 * (q & 1)); bb[q] = *(const f32x4*)(nB + m * 1024 + c0 + 512 * (q >> 1) + 4 * (q & 1)); } }
        f32x4 v[4]; float ss = 0.f;
#pragma unroll
        for (int q = 0; q < 4; ++q) { v[q] = LDNT((const f32x4*)(src + c0 + 512 * (q >> 1) + 4 * (q & 1))); ss += (v[q].x * v[q].x + v[q].y * v[q].y) + (v[q].z * v[q].z + v[q].w * v[q].w); }
        const float rstd = __builtin_amdgcn_rsqf(wave_sum(ss) * (1.0f / DM) + NORM_EPS);
#pragma unroll
        for (int q = 0; q < 2; ++q) { const f32x4 o0 = v[2 * q] * rstd * a[2 * q] + bb[2 * q], o1 = v[2 * q + 1] * rstd * a[2 * q + 1] + bb[2 * q + 1];
            v4u w; w.x = pk2(o0.x, o0.y); w.y = pk2(o0.z, o0.w); w.z = pk2(o1.x, o1.y); w.w = pk2(o1.z, o1.w);
            *(v4u*)(dst + (size_t)r * DM + c0 + 512 * q) = w;
            if (INPROJ_F8MASK) { v2u w8; w8.x = pk4_fp8(o0.x, o0.y, o0.z, o0.w); w8.y = pk4_fp8(o1.x, o1.y, o1.z, o1.w); *(v2u*)(dst8 + (size_t)r * DM + c0 + 512 * q) = w8; } }
    }
}

#ifdef REV_A
#define PREP_ROW(r) (MROWS - 1 - (r))
#else
#define PREP_ROW(r) (r)
#endif
template <bool DRY = false>
__device__ __forceinline__ void phase_prep(Frame& F, bf16* P, const float* qn, const float* kn, const float* RC, const float* RS) {
    const int gw = F.vcu * NWAVES + F.wave, NGW = F.G * NWAVES;
    const int L = F.lane; const bool act = L < 48, isq = L < 32;
    const int col = isq ? C_AQ + 8 * L : C_AK + 8 * (L - 32), e0 = (8 * L) & 63, p0 = e0 >> 1;
    const float* gp = isq ? qn : kn; const f32x4 g0 = *(const f32x4*)(gp + e0), g1 = *(const f32x4*)(gp + e0 + 4);
    constexpr float C2 = 0.125f * 1.4426950408889634f; const float sc = isq ? C2 : 1.0f;
    for (int r0 = gw; r0 < MROWS; r0 += 4 * NGW) {
        v4u wv[4]; f32x4 cs[4], sn[4]; bool ok[4];
#pragma unroll
        for (int u = 0; u < 4; ++u) { const int r = r0 + u * NGW; ok[u] = r < MROWS; const int rr = ok[u] ? PREP_ROW(r) : gw; const int b = rr / RPB, j = rr - b * RPB; const bool lat = j >= L_CTX;
            cs[u] = (f32x4){1.f, 1.f, 1.f, 1.f}; sn[u] = (f32x4){0.f, 0.f, 0.f, 0.f}; if (lat) { cs[u] = *(const f32x4*)(RC + (j - L_CTX) * 32 + p0); sn[u] = *(const f32x4*)(RS + (j - L_CTX) * 32 + p0); }
            wv[u] = act ? *(const v4u*)(P + (size_t)rr * NPROJ + col) : (v4u){0u, 0u, 0u, 0u}; }
#pragma unroll
        for (int u = 0; u < 4; ++u) { const int r = PREP_ROW(r0 + u * NGW);
            const unsigned ww[4] = {wv[u].x, wv[u].y, wv[u].z, wv[u].w}; float x[8]; float ss = 0.f;
#pragma unroll
            for (int i = 0; i < 4; ++i) { x[2 * i] = bflo(ww[i]); x[2 * i + 1] = bfhi(ww[i]); ss += x[2 * i] * x[2 * i] + x[2 * i + 1] * x[2 * i + 1]; }
            ss += xshf<1>(ss); ss += xshf<2>(ss); ss += xshf<4>(ss);
            const float rstd = __builtin_amdgcn_rsqf(ss * (1.0f / 64.0f) + NORM_EPS) * sc;
            const float gg[8] = {g0.x, g0.y, g0.z, g0.w, g1.x, g1.y, g1.z, g1.w}, cc[4] = {cs[u].x, cs[u].y, cs[u].z, cs[u].w}, sv[4] = {sn[u].x, sn[u].y, sn[u].z, sn[u].w};
            unsigned o[4];
#pragma unroll
            for (int i = 0; i < 4; ++i) { const float y1 = x[2 * i] * rstd * gg[2 * i], y2 = x[2 * i + 1] * rstd * gg[2 * i + 1]; o[i] = pk2(y1 * cc[i] - y2 * sv[i], y1 * sv[i] + y2 * cc[i]); }
            if (DRY) { asm volatile("" : "+v"(o[0]), "+v"(o[3])); o[0] = wv[u].x; o[1] = wv[u].y; o[2] = wv[u].z; o[3] = wv[u].w; }
            if (ok[u] && act) *(v4u*)(P + (size_t)r * NPROJ + col) = (v4u){o[0], o[1], o[2], o[3]}; }
    }
}
namespace rc {
constexpr int PT = 144, MB = 64 * PT;
constexpr int O_QP = 0, O_QQ = MB, O_KP = 2 * MB, O_VT = 3 * MB, O_ST = 4 * MB, O_AT = 5 * MB, O_TOT = 6 * MB, SLOT = 6 * MB + 2048;
constexpr int OXP = 68;
typedef float f32x16 __attribute__((ext_vector_type(16)));
typedef float f32x4v __attribute__((ext_vector_type(4)));
typedef short bf16x8 __attribute__((ext_vector_type(8)));
__device__ __forceinline__ int crow(int r, int hi) { return (r & 3) + 8 * (r >> 2) + 4 * hi; }
__device__ __forceinline__ bf16x8 frag32(const LAS unsigned char* M, int row, int kcol, int hi) { return *(const LAS bf16x8*)(M + row * PT + (kcol + hi * 8) * 2); }
__device__ __forceinline__ float clampe(float x) { return fminf(fmaxf(x, -60.f), 60.f); }
__device__ __forceinline__ int seq_of(int mixer, int b, int h, int dir) { return ((mixer * NB + b) * 4 + h) * 2 + dir; }
__device__ __forceinline__ int row_in_batch(int dir, int n) { return (dir == 0) ? n : (n < L_CTX ? (L_CTX - 1 - n) : (RPB + L_CTX - 1 - n)); }
}
struct StageARaw { v4u k[8], v[8]; };
__device__ __forceinline__ void stageA_load(StageARaw& R, const Frame& F, const bf16* P, int mixer, int b, int h, int dir, int c) {
    using namespace rc;
    const int lane = F.lane, r8 = lane >> 3, ch = lane & 7;
    const int ck = (mixer == 0 ? C_HZ + 256 * dir : C_RK) + h * 64 + 8 * ch, cv = (mixer == 0 ? C_HI : C_RV) + h * 64 + 8 * ch;
    const int j0 = row_in_batch(dir, c * 64 + r8); const long step = (dir == 0) ? 8L * NPROJ : -8L * NPROJ;
    const bf16* rp = P + (size_t)(b * RPB + j0) * NPROJ;
#pragma unroll
    for (int i = 0; i < 8; ++i) { R.k[i] = *(const v4u*)(rp + ck); R.v[i] = *(const v4u*)(rp + cv); rp += step; }
}
template <int MIXER>
__device__ __forceinline__ void stageA_compute(const StageARaw& R, Frame& F, bf16* KVS, float* DBUF, int b, int h, int dir, int c, const float* lblog, float gamma) {
    using namespace rc;
    constexpr int HP = 80;
    LAS unsigned char* WL = F.lds + F.wave * 10240; LAS unsigned char* KT = WL; LAS unsigned char* VTm = WL + 5120;
    const int lane = F.lane, seq = seq_of(MIXER, b, h, dir), r8 = lane >> 3, ch = lane & 7;
    unsigned kp[32], vp[32];
    {
        float kk[64];
#pragma unroll
        for (int i = 0; i < 8; ++i) *(LAS v4u*)(WL + (r8 + 8 * i) * PT + 16 * ch) = R.k[i];
#pragma unroll
        for (int s = 0; s < 64; ++s) kk[s] = bf1(*(const LAS unsigned short*)(WL + s * PT + 2 * lane));
        if (MIXER == 0) {
            const float lb = lblog ? sigmf(lblog[512 + dir * 256 + h * 64 + lane] - lblog[dir * 256 + h * 64 + lane]) : 0.f;
            float run = 1.f;
#pragma unroll
            for (int s = 63; s >= 0; --s) { const float f = lb + (1.0f - lb) * sigmf(kk[s]); kk[s] = (1.0f - f) * run; run *= f; }
            DBUF[(size_t)(seq * 36 + c) * 64 + lane] = run;
        } else {
            const float lg2 = __log2f(gamma);
#pragma unroll
            for (int s = 0; s < 64; ++s) kk[s] *= exp2f((float)(63 - s) * lg2);
        }
#pragma unroll
        for (int s = 0; s < 32; ++s) kp[s] = pk2(kk[2 * s], kk[2 * s + 1]);
    }
#pragma unroll
    for (int i = 0; i < 8; ++i) *(LAS v4u*)(WL + (r8 + 8 * i) * PT + 16 * ch) = R.v[i];
#pragma unroll
    for (int s = 0; s < 32; ++s) vp[s] = (unsigned)*(const LAS unsigned short*)(WL + (2 * s) * PT + 2 * lane) | ((unsigned)*(const LAS unsigned short*)(WL + (2 * s + 1) * PT + 2 * lane) << 16);
    const int r = lane & 15, g = lane >> 4;
    f32x4v acc[4][4];
#pragma unroll
    for (int a = 0; a < 4; ++a)
#pragma unroll
        for (int q = 0; q < 4; ++q) acc[a][q] = (f32x4v){0.f, 0.f, 0.f, 0.f};
#pragma unroll
    for (int hh = 0; hh < 2; ++hh) {
#pragma unroll
        for (int i = 0; i < 4; ++i) { const int s0 = 32 * hh + 8 * i; v4u ko, vo;
            ko.x = kp[s0 / 2]; ko.y = kp[s0 / 2 + 1]; ko.z = kp[s0 / 2 + 2]; ko.w = kp[s0 / 2 + 3];
            vo.x = vp[s0 / 2]; vo.y = vp[s0 / 2 + 1]; vo.z = vp[s0 / 2 + 2]; vo.w = vp[s0 / 2 + 3];
            *(LAS v4u*)(KT + lane * HP + 16 * i) = ko; *(LAS v4u*)(VTm + lane * HP + 16 * i) = vo; }
        bf16x8 af[4], bfr[4];
#pragma unroll
        for (int q = 0; q < 4; ++q) { af[q] = *(const LAS bf16x8*)(VTm + (16 * q + r) * HP + 16 * g); bfr[q] = *(const LAS bf16x8*)(KT + (16 * q + r) * HP + 16 * g); }
#pragma unroll
        for (int a = 0; a < 4; ++a)
#pragma unroll
            for (int q = 0; q < 4; ++q) acc[a][q] = __builtin_amdgcn_mfma_f32_16x16x32_bf16(af[a], bfr[q], acc[a][q], 0, 0, 0);
    }
#pragma unroll
    for (int a = 0; a < 4; ++a)
#pragma unroll
        for (int q = 0; q < 4; ++q)
#pragma unroll
            for (int x = 0; x < 4; ++x) *(LAS unsigned short*)(WL + (16 * a + 4 * g + x) * PT + (16 * q + r) * 2) = (unsigned short)f2bf(acc[a][q][x]);
    bf16* dst = KVS + (size_t)(seq * 36 + c) * 4096;
#pragma unroll
    for (int i = 0; i < 8; ++i) { const int idx = lane + 64 * i, e = idx >> 3, d8 = idx & 7; *(v4u*)(dst + e * 64 + d8 * 8) = *(const LAS v4u*)(WL + e * PT + d8 * 16); }
}
__device__ __forceinline__ void recur_stageA_loop(Frame& F, const bf16* P, bf16* KVS, float* DBUF, int u0, int stride, int nunits, const float* lblog, const float* rdec) {
    if (u0 >= nunits) return;
    StageARaw cur;
#define STA_DECODE(u_, it__) const int mh_ = ((u_) + (it__)) & 7, rest_ = (u_) >> 3, c_ = rest_ % 36, bd_ = rest_ / 36, b_ = bd_ >> 1, dir_ = bd_ & 1, mixer_ = mh_ >> 2, h_ = mh_ & 3
    int it = 0;
    for (int u = u0; u < nunits; u += stride, ++it) {
#ifdef REV_A
        STA_DECODE(nunits - 1 - u, it);
#else
        STA_DECODE(u, it);
#endif
        stageA_load(cur, F, P, mixer_, b_, h_, dir_, c_);
        if (mixer_ == 0) stageA_compute<0>(cur, F, KVS, DBUF, b_, h_, dir_, c_, lblog, 0.f);
        else stageA_compute<1>(cur, F, KVS, DBUF, b_, h_, dir_, c_, nullptr, sigmf(rdec[dir_ * 4 + h_]));
    }
#undef STA_DECODE
}
template <int MIXER, bool DRY = false>
__device__ __forceinline__ void recur_stageB_seq(Frame& F, bf16* KVS, const float* DBUF, int seq, float gamma) {
    const int e = F.tid >> 3, d8 = F.tid & 7;
    bf16* base = KVS + (size_t)seq * 36 * 4096 + e * 64 + d8 * 8; const float* db = DBUF + (size_t)seq * 36 * 64 + d8 * 8;
    float S[8];
#pragma unroll
    for (int i = 0; i < 8; ++i) S[i] = 0.f;
    const float g64 = (MIXER == 1) ? exp2f(64.0f * __log2f(gamma)) : 0.f;
    constexpr int GB = 4;
    v4u kv[GB], kvn[GB]; f32x4 da[GB], dbv[GB], dan[GB], dbn[GB];
#pragma unroll
    for (int i = 0; i < GB; ++i) { kv[i] = *(const v4u*)(base + (size_t)i * 4096); da[i] = (f32x4){g64, g64, g64, g64}; dbv[i] = da[i];
        if (MIXER == 0) { da[i] = *(const f32x4*)(db + i * 64); dbv[i] = *(const f32x4*)(db + i * 64 + 4); } }
    for (int c0 = 0; c0 < 36; c0 += GB) {
#pragma unroll
        for (int i = 0; i < GB; ++i) { kvn[i] = kv[i]; dan[i] = da[i]; dbn[i] = dbv[i];
            if (c0 + GB < 36) { kvn[i] = *(const v4u*)(base + (size_t)(c0 + GB + i) * 4096); if (MIXER == 0) { dan[i] = *(const f32x4*)(db + (c0 + GB + i) * 64); dbn[i] = *(const f32x4*)(db + (c0 + GB + i) * 64 + 4); } } }
#pragma unroll
        for (int i = 0; i < GB; ++i) {
            v4u so; so.x = pk2(S[0], S[1]); so.y = pk2(S[2], S[3]); so.z = pk2(S[4], S[5]); so.w = pk2(S[6], S[7]);
            if (DRY) { so = kv[i]; asm volatile("" : "+v"(S[0]), "+v"(S[7])); }
            *(v4u*)(base + (size_t)(c0 + i) * 4096) = so;
            const float dd[8] = {da[i].x, da[i].y, da[i].z, da[i].w, dbv[i].x, dbv[i].y, dbv[i].z, dbv[i].w}; const unsigned kw[4] = {kv[i].x, kv[i].y, kv[i].z, kv[i].w};
#pragma unroll
            for (int q = 0; q < 4; ++q) { S[2 * q] = dd[2 * q] * S[2 * q] + bflo(kw[q]); S[2 * q + 1] = dd[2 * q + 1] * S[2 * q + 1] + bfhi(kw[q]); }
        }
#pragma unroll
        for (int i = 0; i < GB; ++i) { kv[i] = kvn[i]; da[i] = dan[i]; dbv[i] = dbn[i]; }
    }
}
struct StageCRaw { v4u q[2], k[2], v[2]; v4u s0, s1, g; };
template <int MIXER>
__device__ __forceinline__ void stageC_load(StageCRaw& R, const Frame& F, const bf16* P, const bf16* KVS, int b, int h, int tb) {
    using namespace rc;
    const int dir = F.wave >> 2, wq = F.wave & 3, lane = F.lane, tr = lane >> 3, ch = lane & 7;
    const int c = (dir == 0) ? tb : (tb < 4 ? 3 - tb : 39 - tb), seq = seq_of(MIXER, b, h, dir);
    const int cq = (MIXER == 0 ? C_HQ : C_RQ) + h * 64 + 8 * ch, ck = (MIXER == 0 ? C_HZ + 256 * dir : C_RK) + h * 64 + 8 * ch, cv = (MIXER == 0 ? C_HI : C_RV) + h * 64 + 8 * ch;
    const int j0 = row_in_batch(dir, c * 64 + 16 * wq + tr); const long step = (dir == 0) ? 8L * NPROJ : -8L * NPROJ;
    const bf16* rp = P + (size_t)(b * RPB + j0) * NPROJ;
#pragma unroll
    for (int ii = 0; ii < 2; ++ii) { R.q[ii] = *(const v4u*)(rp + cq); R.k[ii] = *(const v4u*)(rp + ck); R.v[ii] = *(const v4u*)(rp + cv); rp += step; }
    const bf16* src = KVS + (size_t)(seq * 36 + c) * 4096; const int t256 = wq * 64 + lane;
    R.s0 = *(const v4u*)(src + (t256 >> 3) * 64 + (t256 & 7) * 8); R.s1 = *(const v4u*)(src + ((t256 + 256) >> 3) * 64 + (t256 & 7) * 8);
    { const int tok = F.tid >> 3, ech = F.tid & 7; R.g = *(const v4u*)(P + (size_t)(b * RPB + tb * 64 + tok) * NPROJ + (MIXER == 0 ? C_HG : C_RG) + h * 64 + 8 * ech); }
}
template <int MIXER>
__device__ __forceinline__ void stageC_compute(const StageCRaw& R, Frame& F, bf16* ACTo, int b, int h, int tb, const float* lblog, const float* rdec, const float* gain) {
    using namespace rc;
    const int dir = F.wave >> 2, wq = F.wave & 3, lane = F.lane, tr = lane >> 3, ch = lane & 7;
    LAS unsigned char* SL = F.lds + dir * SLOT;
    { const int t256 = wq * 64 + lane;
      *(LAS v4u*)(SL + O_ST + (t256 >> 3) * PT + (t256 & 7) * 16) = R.s0; *(LAS v4u*)(SL + O_ST + ((t256 + 256) >> 3) * PT + (t256 & 7) * 16) = R.s1; }
#pragma unroll
    for (int ii = 0; ii < 2; ++ii) { const int t = 16 * wq + tr + 8 * ii; const unsigned vw[4] = {R.v[ii].x, R.v[ii].y, R.v[ii].z, R.v[ii].w};
#pragma unroll
        for (int x = 0; x < 4; ++x) { *(LAS unsigned short*)(SL + O_VT + (8 * ch + 2 * x) * PT + t * 2) = (unsigned short)(vw[x] & 0xffffu); *(LAS unsigned short*)(SL + O_VT + (8 * ch + 2 * x + 1) * PT + t * 2) = (unsigned short)(vw[x] >> 16); } }
    if (MIXER == 0) {
#pragma unroll
        for (int ii = 0; ii < 2; ++ii) { const int t = 16 * wq + tr + 8 * ii; *(LAS v4u*)(SL + O_QP + t * PT + 16 * ch) = R.q[ii]; *(LAS v4u*)(SL + O_KP + t * PT + 16 * ch) = R.k[ii]; }
        float qv[16], kv[16], q2[16];
#pragma unroll
        for (int i = 0; i < 16; ++i) { qv[i] = bf1(*(const LAS unsigned short*)(SL + O_QP + (16 * wq + i) * PT + 2 * lane)); kv[i] = bf1(*(const LAS unsigned short*)(SL + O_KP + (16 * wq + i) * PT + 2 * lane)); }
        const float lb = lblog ? sigmf(lblog[512 + dir * 256 + h * 64 + lane] - lblog[dir * 256 + h * 64 + lane]) : 0.f;
        float lc[16]; float run = 1.f;
#pragma unroll
        for (int i = 0; i < 16; ++i) { const float f = lb + (1.0f - lb) * sigmf(kv[i]); run *= f; lc[i] = run; kv[i] = 1.0f - f; }
        LAS float* TOT = (LAS float*)(SL + O_TOT); TOT[wq * 64 + lane] = run;
        __syncthreads();
        float pre = 1.f;
#pragma unroll
        for (int q = 0; q < 4; ++q) { const float t = TOT[q * 64 + lane]; if (q < wq) pre *= t; }
        const float rmid = __builtin_amdgcn_rcpf(fmaxf(TOT[lane] * TOT[64 + lane], 1e-30f));
#pragma unroll
        for (int i = 0; i < 16; ++i) { const float pt = pre * lc[i]; q2[i] = qv[i] * pt; const float e1 = fminf(fmaxf(pt * rmid, 1e-30f), 1e30f); qv[i] *= e1; kv[i] *= __builtin_amdgcn_rcpf(e1); }
#pragma unroll
        for (int i = 0; i < 16; ++i) { const int t = 16 * wq + i;
            *(LAS unsigned short*)(SL + O_QP + t * PT + lane * 2) = (unsigned short)f2bf(qv[i]);
            *(LAS unsigned short*)(SL + O_KP + t * PT + lane * 2) = (unsigned short)f2bf(kv[i]);
            *(LAS unsigned short*)(SL + O_QQ + t * PT + lane * 2) = (unsigned short)f2bf(q2[i]); }
    } else {
        const float lg2 = __log2f(sigmf(rdec[dir * 4 + h]));
#pragma unroll
        for (int ii = 0; ii < 2; ++ii) { const int t = 16 * wq + tr + 8 * ii; const float gq = exp2f((float)(t + 1) * lg2) * 0.125f;
            const unsigned qw[4] = {R.q[ii].x, R.q[ii].y, R.q[ii].z, R.q[ii].w}; v4u q1, q2v;
            { unsigned o1[4], o2[4];
#pragma unroll
              for (int x = 0; x < 4; ++x) { const float lo = bflo(qw[x]), hi2 = bfhi(qw[x]); o1[x] = pk2(lo * 0.125f, hi2 * 0.125f); o2[x] = pk2(lo * gq, hi2 * gq); }
              q1 = (v4u){o1[0], o1[1], o1[2], o1[3]}; q2v = (v4u){o2[0], o2[1], o2[2], o2[3]}; }
            *(LAS v4u*)(SL + O_QP + t * PT + 16 * ch) = q1; *(LAS v4u*)(SL + O_QQ + t * PT + 16 * ch) = q2v; *(LAS v4u*)(SL + O_KP + t * PT + 16 * ch) = R.k[ii]; }
    }
    __syncthreads();
    const int ti = wq >> 1, tj = wq & 1, r32 = lane & 31, hi = lane >> 5;
    if (tj <= ti) {
        f32x16 a = {0.f, 0.f, 0.f, 0.f, 0.f, 0.f, 0.f, 0.f, 0.f, 0.f, 0.f, 0.f, 0.f, 0.f, 0.f, 0.f};
#pragma unroll
        for (int kkk = 0; kkk < 4; ++kkk) a = __builtin_amdgcn_mfma_f32_32x32x16_bf16(frag32(SL + O_QP, 32 * ti + r32, 16 * kkk, hi), frag32(SL + O_KP, 32 * tj + r32, 16 * kkk, hi), a, 0, 0, 0);
        const float lg2 = (MIXER == 1) ? __log2f(sigmf(rdec[dir * 4 + h])) : 0.f;
#pragma unroll
        for (int r = 0; r < 16; ++r) { const int dt = 32 * (ti - tj) + crow(r, hi) - r32; float val = a[r];
            if (MIXER == 1) val *= exp2f((float)dt * lg2);
            if (dt < 0) val = 0.f;
            *(LAS unsigned short*)(SL + O_AT + (32 * ti + crow(r, hi)) * PT + (32 * tj + r32) * 2) = (unsigned short)f2bf(val); }
    }
    __syncthreads();
    f32x16 o = {0.f, 0.f, 0.f, 0.f, 0.f, 0.f, 0.f, 0.f, 0.f, 0.f, 0.f, 0.f, 0.f, 0.f, 0.f, 0.f};
#pragma unroll
    for (int st = 0; st < 2; ++st) if (st <= ti) {
#pragma unroll
        for (int kkk = 0; kkk < 2; ++kkk) o = __builtin_amdgcn_mfma_f32_32x32x16_bf16(frag32(SL + O_AT, 32 * ti + r32, 32 * st + 16 * kkk, hi), frag32(SL + O_VT, 32 * tj + r32, 32 * st + 16 * kkk, hi), o, 0, 0, 0); }
#pragma unroll
    for (int kkk = 0; kkk < 4; ++kkk) o = __builtin_amdgcn_mfma_f32_32x32x16_bf16(frag32(SL + O_QQ, 32 * ti + r32, 16 * kkk, hi), frag32(SL + O_ST, 32 * tj + r32, 16 * kkk, hi), o, 0, 0, 0);
    { LAS unsigned char* OX = F.lds + 2 * SLOT + dir * MB;
#pragma unroll
      for (int r = 0; r < 16; ++r) *(LAS unsigned short*)(OX + (32 * ti + crow(r, hi)) * PT + (32 * tj + r32) * 2) = (unsigned short)f2bf(o[r]); }
    __syncthreads();
    { const int tok = F.tid >> 3, ech = F.tid & 7, row = b * RPB + tb * 64 + tok;
      const v4u fw = *(const LAS v4u*)(F.lds + 2 * SLOT + tok * PT + 16 * ech), bw = *(const LAS v4u*)(F.lds + 2 * SLOT + MB + (63 - tok) * PT + 16 * ech);
      const unsigned fws[4] = {fw.x, fw.y, fw.z, fw.w}, bws[4] = {bw.x, bw.y, bw.z, bw.w};
      float ov[8]; float ss = 0.f;
#pragma unroll
      for (int i = 0; i < 4; ++i) { ov[2 * i] = bflo(fws[i]) + bflo(bws[i]); ov[2 * i + 1] = bfhi(fws[i]) + bfhi(bws[i]); ss += ov[2 * i] * ov[2 * i] + ov[2 * i + 1] * ov[2 * i + 1]; }
      ss += xshf<1>(ss); ss += xshf<2>(ss); ss += xshf<4>(ss);
      const float rs = __builtin_amdgcn_rsqf(ss * (1.0f / 64.0f) + NORM_EPS);
      const f32x4 ga = *(const f32x4*)(gain + h * 64 + 8 * ech), gb = *(const f32x4*)(gain + h * 64 + 8 * ech + 4);
      const float gg[8] = {ga.x, ga.y, ga.z, ga.w, gb.x, gb.y, gb.z, gb.w}; const unsigned gws[4] = {R.g.x, R.g.y, R.g.z, R.g.w};
      float res[8];
#pragma unroll
      for (int i = 0; i < 4; ++i) { res[2 * i] = ov[2 * i] * rs * gg[2 * i] * siluf(bflo(gws[i])); res[2 * i + 1] = ov[2 * i + 1] * rs * gg[2 * i + 1] * siluf(bfhi(gws[i])); }
#ifdef OUTPROJ_FP8
      v2u w2; w2.x = pk4_fp8(res[0] * 4.0f, res[1] * 4.0f, res[2] * 4.0f, res[3] * 4.0f); w2.y = pk4_fp8(res[4] * 4.0f, res[5] * 4.0f, res[6] * 4.0f, res[7] * 4.0f);
      *(v2u*)((unsigned char*)ACTo + (size_t)(row >> 1) * 2048 + ((MIXER == 0 ? 0 : 8) + h) * 128 + (row & 1) * 64 + 8 * ech) = w2; }
#else
      v4u w4; w4.x = pk2(res[0], res[1]); w4.y = pk2(res[2], res[3]); w4.z = pk2(res[4], res[5]); w4.w = pk2(res[6], res[7]);
      *(v4u*)(ACTo + (size_t)row * DM + (MIXER == 0 ? 0 : 512) + h * 64 + 8 * ech) = w4; }
#endif
}
__device__ __forceinline__ void recur_stageC_loop(Frame& F, const bf16* P, const bf16* KVS, bf16* ACTo, int mh0, int ub0, int stride, int nub, int ntb, int tboff, const float* lblog, const float* rdec, const float* hn, const float* rn) {
    if (ub0 >= nub) return;
    StageCRaw cur, nxt;
    { const int mh = mh0 & 7; if ((mh >> 2) == 0) stageC_load<0>(cur, F, P, KVS, ub0 / ntb, mh & 3, tboff + ub0 % ntb); else stageC_load<1>(cur, F, P, KVS, ub0 / ntb, mh & 3, tboff + ub0 % ntb); }
    int i = 0;
    for (int ub = ub0; ub < nub; ub += stride, ++i) {
        const int un = ub + stride; const bool more = un < nub; const int mh = (mh0 + i) & 7, mhn = (mh0 + i + 1) & 7;
        if (more) { if ((mhn >> 2) == 0) stageC_load<0>(nxt, F, P, KVS, un / ntb, mhn & 3, tboff + un % ntb); else stageC_load<1>(nxt, F, P, KVS, un / ntb, mhn & 3, tboff + un % ntb); }
        if ((mh >> 2) == 0) stageC_compute<0>(cur, F, ACTo, ub / ntb, mh & 3, tboff + ub % ntb, lblog, rdec, hn);
        else stageC_compute<1>(cur, F, ACTo, ub / ntb, mh & 3, tboff + ub % ntb, nullptr, rdec, rn);
        if (more) cur = nxt;
    }
}
__device__ __forceinline__ void phase_conv(Frame& F, const bf16* P, bf16* ACTo, const float* convw, bool latent_only) {
    const int gw = F.vcu * NWAVES + F.wave, NGW = F.G * NWAVES, rsel = F.lane >> 5, c0 = 8 * (F.lane & 31);
    f32x4 w0[2], w1[2], w2[2];
#pragma unroll
    for (int hf = 0; hf < 2; ++hf) { w0[hf] = *(const f32x4*)(convw + c0 + 4 * hf); w1[hf] = *(const f32x4*)(convw + 256 + c0 + 4 * hf); w2[hf] = *(const f32x4*)(convw + 512 + c0 + 4 * hf); }
    const int nrows = latent_only ? NB * T_LAT : MROWS;
    auto ld8 = [](const bf16* p, f32x4& a, f32x4& b) { const v4u w = *(const v4u*)p; a = (f32x4){bflo(w.x), bfhi(w.x), bflo(w.y), bfhi(w.y)}; b = (f32x4){bflo(w.z), bfhi(w.z), bflo(w.w), bfhi(w.w)}; };
    for (int idx2 = gw; 2 * idx2 < nrows; idx2 += NGW) {
        const int idx = 2 * idx2 + rsel;
        const int r = latent_only ? row_of_latent(idx) : idx;
        const int b = r / RPB, j = r - b * RPB;
        const bf16* row = P + (size_t)r * NPROJ;
        const bool first = (j == 0) || (j == L_CTX), last = (j == L_CTX - 1) || (j == RPB - 1);
        f32x4 ca, cb, ha, hb, u1a, u1b, u0a = (f32x4){0.f, 0.f, 0.f, 0.f}, u0b = u0a, u2a = u0a, u2b = u0a;
        ld8(row + C_CC + c0, ca, cb); ld8(row + C_CH + c0, ha, hb); u1a = ca * ha; u1b = cb * hb;
        if (!first) { ld8(row - NPROJ + C_CC + c0, ca, cb); ld8(row - NPROJ + C_CH + c0, ha, hb); u0a = ca * ha; u0b = cb * hb; }
        if (!last) { ld8(row + NPROJ + C_CC + c0, ca, cb); ld8(row + NPROJ + C_CH + c0, ha, hb); u2a = ca * ha; u2b = cb * hb; }
        f32x4 ba, bb2; ld8(row + C_CB + c0, ba, bb2);
        const f32x4 xa = ba * (w0[0] * u0a + w1[0] * u1a + w2[0] * u2a), xb = bb2 * (w0[1] * u0b + w1[1] * u1b + w2[1] * u2b);
#ifdef OUTPROJ_FP8
        { const f32x4 ya = xa * 4.0f, yb = xb * 4.0f; v2u w2; w2.x = pk4_fp8(ya.x, ya.y, ya.z, ya.w); w2.y = pk4_fp8(yb.x, yb.y, yb.z, yb.w); *(v2u*)((unsigned char*)ACTo + (size_t)(r >> 1) * 2048 + (4 + (c0 >> 6)) * 128 + (r & 1) * 64 + (c0 & 63)) = w2; }
#else
        v4u w; w.x = pk2(xa.x, xa.y); w.y = pk2(xa.z, xa.w); w.z = pk2(xb.x, xb.y); w.w = pk2(xb.z, xb.w); *(v4u*)(ACTo + (size_t)r * DM + 256 + c0) = w;
#endif
    }
}
struct DenseOrder {
    int nM, nN, nwg, G, c, latent_only; const char* A; const char* Bt; size_t tA, tB; unsigned long long pnmap;
    __device__ __forceinline__ void init(int nM_, int nN_, int G_, int c_, int lat, const void* A_, const void* Bt_, int lda, int ldb) {
        nM = nM_; nN = nN_; nwg = nM * nN; G = G_; c = c_; latent_only = lat; A = (const char*)A_; Bt = (const char*)Bt_; tA = (size_t)256 * lda * 2; tB = (size_t)256 * ldb * 2; pnmap = 0xFEDCBA9876543210ull; }
    __device__ __forceinline__ bool next(int i, pg8::Unit& u) const {
        const long L = (long)i * G + c; if (L >= nwg) return false;
        int wgid = (int)L; { const int q = nwg / pg8::NXCD, r = nwg % pg8::NXCD, xcd = wgid % pg8::NXCD, off = wgid / pg8::NXCD; wgid = (xcd < r ? xcd * (q + 1) : r * (q + 1) + (xcd - r) * q) + off; }
#ifndef DENSE_WGM
#define DENSE_WGM 8
#endif
        const int nig = DENSE_WGM * nN, gid = wgid / nig, fm = gid * DENSE_WGM, gsz = (nM - fm) < DENSE_WGM ? (nM - fm) : DENSE_WGM;
        int pm = fm + ((wgid % nig) % gsz); const int pn = (int)((pnmap >> (4 * ((wgid % nig) / gsz))) & 15ull);
        if (latent_only) pm = (pm >> 3) * PPB + 1 + (pm & 7);
        u.pm = pm; u.pn = pn; u.x0 = 0; u.x1 = 0; u.a = A + (size_t)pm * tA; u.b = Bt + (size_t)pn * tB; u.b2 = u.b; return true; }
    __device__ __forceinline__ void a_ready(const pg8::Unit&) const {}
    __device__ __forceinline__ void done(const pg8::Unit&) const {}
};
struct MoeOrder {
    int ncol, nwg, G, c, down, pm0; const LAS int* tileb; const char* A; const char* W;
    __device__ __forceinline__ bool next(int i, pg8::Unit& u) const {
        const long L = (long)i * G + c; if (L >= nwg) return false;
        int w = (int)L; { const int q = nwg / pg8::NXCD, r = nwg % pg8::NXCD, xcd = w % pg8::NXCD, off = w / pg8::NXCD; w = (xcd < r ? xcd * (q + 1) : r * (q + 1) + (xcd - r) * q) + off; }
        const int pm = pm0 + w / ncol, pc = w % ncol;
        const int k = __builtin_amdgcn_readfirstlane(tileb[pm]), g = k / 6, pr = k % 6;
        const int ea = pr < 3 ? 0 : (pr < 5 ? 1 : 2), eb = pr < 3 ? pr + 1 : (pr < 5 ? pr - 1 : 3);
        u.pm = pm; u.pn = pc; u.x0 = 0; u.x1 = 0; u.a = down ? A + (size_t)pm * 256 * 1024 : A;
        if (!down) { const int e = g * 4 + (pc < 4 ? ea : eb); u.b = W + (size_t)(e * 4 + (pc & 3)) * 256 * 1024; u.b2 = u.b; }
        else { const char* base = W + (size_t)(g * 1024 + pc * 256) * 2048; u.b = base + ea * 512; u.b2 = base + eb * 512 - 512; }
        return true; }
    __device__ __forceinline__ void a_ready(const pg8::Unit&) const {}
    __device__ __forceinline__ void done(const pg8::Unit&) const {}
};
struct EpiStore {
    static constexpr bool PERM = true, PERMH = false, AFTER_DRAIN = false;
    bf16* O; int ldc; float sc;
    __device__ __forceinline__ void operator()(const f32x4 (&acc)[2][2][4][2], const pg8::Unit& u, int wr, int wc, int fr, int fq) const {
        const int row0 = u.pm * 256 + wr * 64 + fr, col0 = u.pn * 256 + wc * 32 + 8 * fq;
#pragma unroll
        for (int ai = 0; ai < 2; ++ai)
#pragma unroll
            for (int m = 0; m < 4; ++m) { bf16* rowp = O + (size_t)(row0 + ai * 128 + m * 16) * ldc + col0;
#pragma unroll
                for (int bj = 0; bj < 2; ++bj) { const f32x4 v0 = acc[ai][bj][m][0] * sc, v1 = acc[ai][bj][m][1] * sc;
                    v4u w; w.x = pg8::cvt_pk_bf16(v0[0], v0[1]); w.y = pg8::cvt_pk_bf16(v0[2], v0[3]); w.z = pg8::cvt_pk_bf16(v1[0], v1[1]); w.w = pg8::cvt_pk_bf16(v1[2], v1[3]);
                    *(v4u*)(rowp + bj * 128) = w; } }
    }
};
struct EpiStoreQK {
    static constexpr bool PERM = true, PERMH = true, AFTER_DRAIN = false;
    bf16* O; int ldc; float sc; const float* qn; const float* kn; const float* RC; const float* RS;
    __device__ __forceinline__ void operator()(const f32x4 (&acc)[2][2][4][2], const pg8::Unit& u, int wr, int wc, int fr, int fq) const {
        const int row0 = u.pm * 256 + wr * 64 + fr, col0 = u.pn * 256 + wc * 64 + 8 * fq;
        const bool isq = u.pn == 12, isk = (u.pn == 13) && (wc < 2), prep = isq || isk;
        const int b = u.pm / PPB, pj = u.pm - b * PPB; const bool lat = pj > 0;
        f32x4 gv[2][2] = {{{1.f, 1.f, 1.f, 1.f}, {1.f, 1.f, 1.f, 1.f}}, {{1.f, 1.f, 1.f, 1.f}, {1.f, 1.f, 1.f, 1.f}}};
        if (prep) { const float* gp = (isq ? qn : kn) + 8 * fq;
#pragma unroll
            for (int bj = 0; bj < 2; ++bj) { gv[bj][0] = *(const f32x4*)(gp + bj * 32); gv[bj][1] = *(const f32x4*)(gp + bj * 32 + 4); } }
        constexpr float C2 = 0.125f * 1.4426950408889634f;
        const bool rot = prep && lat;
        const float* rcb = RC + (size_t)((pj > 0 ? pj - 1 : 0) * 256 + wr * 64 + fr) * 32 + 4 * fq; const float* rsb = RS + (rcb - RC);
        f32x4 cs[2] = {{1.f, 1.f, 1.f, 1.f}, {1.f, 1.f, 1.f, 1.f}}, sn[2] = {{0.f, 0.f, 0.f, 0.f}, {0.f, 0.f, 0.f, 0.f}}, csn[2], snn[2];
        if (rot) { cs[0] = *(const f32x4*)(rcb); cs[1] = *(const f32x4*)(rcb + 16); sn[0] = *(const f32x4*)(rsb); sn[1] = *(const f32x4*)(rsb + 16); }
#pragma unroll
        for (int ai = 0; ai < 2; ++ai)
#pragma unroll
            for (int m = 0; m < 4; ++m) { const int rl = wr * 64 + fr + ai * 128 + m * 16; bf16* rowp = O + (size_t)(u.pm * 256 + rl) * ldc + col0;
                csn[0] = cs[0]; csn[1] = cs[1]; snn[0] = sn[0]; snn[1] = sn[1];
                if (rot && !(ai == 1 && m == 3)) { const int nxt = (m == 3) ? 128 : (ai * 128 + (m + 1) * 16); const size_t o2 = (size_t)nxt * 32;
                    csn[0] = *(const f32x4*)(rcb + o2); csn[1] = *(const f32x4*)(rcb + o2 + 16); snn[0] = *(const f32x4*)(rsb + o2); snn[1] = *(const f32x4*)(rsb + o2 + 16); }
                f32x4 v[2][2]; float ss = 0.f;
#pragma unroll
                for (int bj = 0; bj < 2; ++bj)
#pragma unroll
                    for (int n = 0; n < 2; ++n) { v[bj][n] = acc[ai][bj][m][n] * sc; ss += (v[bj][n].x * v[bj][n].x + v[bj][n].y * v[bj][n].y) + (v[bj][n].z * v[bj][n].z + v[bj][n].w * v[bj][n].w); }
                if (prep) {
                    ss += xshf<16>(ss); ss = half_sum(ss);
                    const float rstd = __builtin_amdgcn_rsqf(ss * (1.0f / 64.0f) + NORM_EPS) * (isq ? C2 : 1.0f);
#pragma unroll
                    for (int bj = 0; bj < 2; ++bj) { const f32x4 c4 = cs[bj], s4 = sn[bj];
                        const f32x4 y0 = v[bj][0] * rstd * gv[bj][0], y1 = v[bj][1] * rstd * gv[bj][1];
                        v[bj][0] = (f32x4){y0.x * c4.x - y0.y * s4.x, y0.x * s4.x + y0.y * c4.x, y0.z * c4.y - y0.w * s4.y, y0.z * s4.y + y0.w * c4.y};
                        v[bj][1] = (f32x4){y1.x * c4.z - y1.y * s4.z, y1.x * s4.z + y1.y * c4.z, y1.z * c4.w - y1.w * s4.w, y1.z * s4.w + y1.w * c4.w}; } }
#pragma unroll
                for (int bj = 0; bj < 2; ++bj) { const f32x4 v0 = v[bj][0], v1 = v[bj][1];
                    v4u w; w.x = pg8::cvt_pk_bf16(v0[0], v0[1]); w.y = pg8::cvt_pk_bf16(v0[2], v0[3]); w.z = pg8::cvt_pk_bf16(v1[0], v1[1]); w.w = pg8::cvt_pk_bf16(v1[2], v1[3]);
                    *(v4u*)(rowp + bj * 32) = w; }
                cs[0] = csn[0]; cs[1] = csn[1]; sn[0] = snn[0]; sn[1] = snn[1]; }
        (void)row0;
    }
};
struct EpiResid {
    static constexpr bool PERM = false, PERMH = false, AFTER_DRAIN = false;
    const float* xsrc; const float* csrc; float* xdst; float* cdst; const float* gate; float sc;
    __device__ __forceinline__ void operator()(const f32x4 (&acc)[2][2][4][2], const pg8::Unit& u, int wr, int wc, int fr, int fq) const {
        const int b = u.pm / PPB, pj = u.pm - b * PPB; const bool isc = pj == 0;
        const float* src = isc ? csrc + (size_t)b * L_CTX * DM : xsrc + (size_t)(b * T_LAT + (pj - 1) * 256) * DM;
        float* dst = isc ? cdst + (size_t)b * L_CTX * DM : xdst + (size_t)(b * T_LAT + (pj - 1) * 256) * DM;
        const int col0 = u.pn * 256 + wc * 32 + 4 * fq; const float* gp = gate + (isc ? 16 : b) * 1024 + col0;
        f32x4 gv[2][2];
#pragma unroll
        for (int bj = 0; bj < 2; ++bj)
#pragma unroll
            for (int n = 0; n < 2; ++n) gv[bj][n] = *(const f32x4*)(gp + bj * 128 + n * 16) * sc;
#pragma unroll
        for (int ai = 0; ai < 2; ++ai)
#pragma unroll
            for (int m = 0; m < 4; ++m) { const size_t off = (size_t)(ai * 128 + wr * 64 + m * 16 + fr) * DM + col0;
#pragma unroll
                for (int bj = 0; bj < 2; ++bj)
#pragma unroll
                    for (int n = 0; n < 2; ++n) *(f32x4*)(dst + off + bj * 128 + n * 16) = LDNT((const f32x4*)(src + off + bj * 128 + n * 16)) + gv[bj][n] * acc[ai][bj][m][n];
                if (m & 1) asm volatile("" ::: "memory"); }
    }
};
struct EpiGateUp {
    static constexpr bool PERM = true, PERMH = false, AFTER_DRAIN = false;
    unsigned char* H; const v4i* rowinfo;
    __device__ __forceinline__ void operator()(const f32x4 (&acc)[2][2][4][2], const pg8::Unit& u, int wr, int wc, int fr, int fq) const {
        const int pos0 = u.pm * 256 + wr * 64 + fr, col0 = u.pn * 128 + wc * 32 + 8 * fq; const bool second = u.pn >= 4;
#pragma unroll
        for (int ai = 0; ai < 2; ++ai)
#pragma unroll
            for (int m = 0; m < 4; ++m) { const int pos = pos0 + ai * 128 + m * 16; const v4i ri = rowinfo[pos];
                const float w = __builtin_bit_cast(float, second ? ri.z : ri.y) * (16.0f / 32.0f);
                const f32x4 g0 = acc[ai][0][m][0] * (1.0f / 32.0f), g1 = acc[ai][0][m][1] * (1.0f / 32.0f), u0 = acc[ai][1][m][0], u1 = acc[ai][1][m][1];
                float h[8];
#pragma unroll
                for (int i = 0; i < 4; ++i) { h[i] = siluf(g0[i]) * u0[i] * w; h[4 + i] = siluf(g1[i]) * u1[i] * w; }
                v2u o; o.x = pk4_fp8(h[0], h[1], h[2], h[3]); o.y = pk4_fp8(h[4], h[5], h[6], h[7]);
                *(v2u*)(H + (size_t)pos * 1024 + col0) = o; }
    }
};
struct EpiDown {
    static constexpr bool PERM = false, PERMH = false, AFTER_DRAIN = false;
    float* xdst; float* cdst; const float* gate; const v4i* rowinfo;
    __device__ __forceinline__ void operator()(const f32x4 (&acc)[2][2][4][2], const pg8::Unit& u, int wr, int wc, int fr, int fq) const {
        const int pos0 = u.pm * 256 + wr * 64 + fr, col0 = u.pn * 256 + wc * 32 + 4 * fq;
#pragma unroll
        for (int ai = 0; ai < 2; ++ai)
#pragma unroll
            for (int m = 0; m < 4; ++m) { const int r = rowinfo[pos0 + ai * 128 + m * 16].x;
#ifdef ZERO_MOE
                if (false) {
#else
                if (r >= 0) {
#endif
                    const int b = r / RPB, j = r - b * RPB; const bool isc = j < L_CTX;
                    float* dst = (isc ? cdst + (size_t)(b * L_CTX + j) * DM : xdst + (size_t)(b * T_LAT + j - L_CTX) * DM) + col0;
                    const float* gp = gate + (isc ? 16 : b) * 1024 + col0;
#pragma unroll
                    for (int bj = 0; bj < 2; ++bj)
#pragma unroll
                        for (int n = 0; n < 2; ++n) { float* p = dst + bj * 128 + n * 16; *(f32x4*)p = LDNT((const f32x4*)p) + *(const f32x4*)(gp + bj * 128 + n * 16) * (acc[ai][bj][m][n] * (1.0f / 512.0f)); } }
                if (m & 1) asm volatile("" ::: "memory"); }
    }
};

__device__ __forceinline__ void phase_norm2_route(Frame& F, int layer, const float* xsrc, const float* csrc, const float* nA, const float* nB, bf16* dst, bool latent_only) {
    typedef short bf16x8v __attribute__((ext_vector_type(8))); typedef float f32x4v __attribute__((ext_vector_type(4)));
    unsigned char* const ws = PWS;
    LAS int* cnt = (LAS int*)(F.lds + TAB_OFF);
    LAS float* MA = (LAS float*)(F.lds); LAS float* MBv = MA + 2048;
    LAS float* SSP = MA + 4096;
    LAS float* PART = SSP + 128;
    LAS float* LOG = PART + 8 * 16 * 32;
    const int lane = F.lane, wv = F.wave, r16 = lane & 15, g = lane >> 4, k0w = 128 * wv;
    const int nrows = latent_only ? NB * T_LAT : MROWS, NGW = F.G * NWAVES, RPW = (nrows + NGW - 1) / NGW, RPBLK = NWAVES * RPW;
    const int ib0 = (int)blockIdx.x * RPBLK, ib1 = (ib0 + RPBLK < nrows) ? ib0 + RPBLK : nrows;
    int mfirst = 0, mlast = 0;
    if (ib0 < ib1) { const int ra = latent_only ? row_of_latent(ib0) : ib0, rb = latent_only ? row_of_latent(ib1 - 1) : ib1 - 1;
      const int ba = ra / RPB, ja = ra - ba * RPB, bb_ = rb / RPB, jb = rb - bb_ * RPB; mfirst = (ja < L_CTX) ? 16 : ba; mlast = (jb < L_CTX) ? 16 : bb_; }
    for (int i = F.tid; i < 512; i += NTHR) { const int sl = i >> 8, c4 = (i & 255) * 4, mm = sl ? mlast : mfirst;
        *(LAS f32x4*)(MA + sl * 1024 + c4) = *(const f32x4*)(nA + mm * 1024 + c4); *(LAS f32x4*)(MBv + sl * 1024 + c4) = *(const f32x4*)(nB + mm * 1024 + c4); }
    if (F.tid < 24) cnt[F.tid] = 0;
    bf16x8v Bh[4][2], Bl[4][2];
    { const float* rgw = PIN(I_RGW) + (size_t)layer * 1024 * 4; const float* rew = PIN(I_REW) + (size_t)layer * 1024 * 16;
#pragma unroll
      for (int s = 0; s < 4; ++s)
#pragma unroll
          for (int t = 0; t < 2; ++t) { const int n = 16 * t + r16, kb = k0w + 32 * s + 8 * g; unsigned hw[4], lw[4];
#pragma unroll
              for (int i2 = 0; i2 < 4; ++i2) { float w0 = 0.f, w1 = 0.f;
                  if (n < 4) { w0 = rgw[(kb + 2 * i2) * 4 + n]; w1 = rgw[(kb + 2 * i2 + 1) * 4 + n]; } else if (n < 20) { w0 = rew[(kb + 2 * i2) * 16 + n - 4]; w1 = rew[(kb + 2 * i2 + 1) * 16 + n - 4]; }
                  const unsigned hp = pk2(w0, w1); hw[i2] = hp; lw[i2] = pk2(w0 - bflo(hp), w1 - bfhi(hp)); }
              Bh[s][t] = __builtin_bit_cast(bf16x8v, (v4u){hw[0], hw[1], hw[2], hw[3]}); Bl[s][t] = __builtin_bit_cast(bf16x8v, (v4u){lw[0], lw[1], lw[2], lw[3]}); } }
    float biasn = 0.f; { const int n = F.tid & 31; if (n < 4) biasn = PIN(I_RGB)[layer * 4 + n]; else if (n < 20) biasn = PIN(I_REB)[layer * 16 + n - 4]; }
    v4i* ROUTE = (v4i*)(ws + WS_ROUTE);
    __syncthreads();
#ifdef ROUTE_PREFETCH
#define ROUTE_SRC(G0) ({ const int idx_ = ((G0) + r16) < ib1 ? (G0) + r16 : ib1 - 1; const int r_ = latent_only ? row_of_latent(idx_) : idx_; const int b_ = r_ / RPB, j_ = r_ - b_ * RPB; \
        ((j_ < L_CTX) ? csrc + (size_t)(b_ * L_CTX + j_) * DM : xsrc + (size_t)(b_ * T_LAT + j_ - L_CTX) * DM) + k0w + 8 * g; })
    f32x4 xv[4][2], xn[4][2];
    if (ib0 < ib1) { const float* s0 = ROUTE_SRC(ib0);
#pragma unroll
        for (int s = 0; s < 4; ++s) { xv[s][0] = *(const f32x4*)(s0 + 32 * s); xv[s][1] = *(const f32x4*)(s0 + 32 * s + 4); } }
#endif
    for (int g0 = ib0; g0 < ib1; g0 += 16) {
        const bool valid = (g0 + r16) < ib1; const int idx = valid ? g0 + r16 : ib1 - 1;
        const int r = latent_only ? row_of_latent(idx) : idx;
        const int b = r / RPB, j = r - b * RPB, m = (j < L_CTX) ? 16 : b, slot = (m != mfirst) ? 1024 : 0;
        float ss = 0.f;
#ifdef ROUTE_PREFETCH
        { const float* s1 = ROUTE_SRC(g0 + 16 < ib1 ? g0 + 16 : g0);
#pragma unroll
          for (int s = 0; s < 4; ++s) { xn[s][0] = *(const f32x4*)(s1 + 32 * s); xn[s][1] = *(const f32x4*)(s1 + 32 * s + 4); } }
#else
        const float* src = ((j < L_CTX) ? csrc + (size_t)(b * L_CTX + j) * DM : xsrc + (size_t)(b * T_LAT + j - L_CTX) * DM) + k0w + 8 * g;
        f32x4 xv[4][2];
#pragma unroll
        for (int s = 0; s < 4; ++s) { xv[s][0] = LDNT((const f32x4*)(src + 32 * s)); xv[s][1] = LDNT((const f32x4*)(src + 32 * s + 4)); }
#endif
#pragma unroll
        for (int s = 0; s < 4; ++s)
#pragma unroll
            for (int hh = 0; hh < 2; ++hh) { const f32x4 x = xv[s][hh]; ss += (x.x * x.x + x.y * x.y) + (x.z * x.z + x.w * x.w); }
        ss += xshf<16>(ss); ss = half_sum(ss);
        if (lane < 16) SSP[wv * 16 + lane] = ss;
        __syncthreads();
        float tot = 0.f;
#pragma unroll
        for (int w2 = 0; w2 < 8; ++w2) tot += SSP[w2 * 16 + r16];
        const float rstd = __builtin_amdgcn_rsqf(tot * (1.0f / DM) + NORM_EPS);
        f32x4v acc[2] = {{0.f, 0.f, 0.f, 0.f}, {0.f, 0.f, 0.f, 0.f}};
        unsigned char* drow = (unsigned char*)dst + (size_t)r * DM + k0w + 8 * g;
#pragma unroll
        for (int s = 0; s < 4; ++s) { const int co = slot + k0w + 32 * s + 8 * g;
            const f32x4 h0 = xv[s][0] * rstd * *(const LAS f32x4*)(MA + co) + *(const LAS f32x4*)(MBv + co), h1 = xv[s][1] * rstd * *(const LAS f32x4*)(MA + co + 4) + *(const LAS f32x4*)(MBv + co + 4);
            { v2u o; o.x = pk4_fp8(h0.x, h0.y, h0.z, h0.w); o.y = pk4_fp8(h1.x, h1.y, h1.z, h1.w); *(v2u*)(drow + 32 * s) = o; }
            const unsigned p0 = pk2(h0.x, h0.y), p1 = pk2(h0.z, h0.w), p2 = pk2(h1.x, h1.y), p3 = pk2(h1.z, h1.w);
            const unsigned q0 = pk2(h0.x - bflo(p0), h0.y - bfhi(p0)), q1 = pk2(h0.z - bflo(p1), h0.w - bfhi(p1)), q2 = pk2(h1.x - bflo(p2), h1.y - bfhi(p2)), q3 = pk2(h1.z - bflo(p3), h1.w - bfhi(p3));
            const bf16x8v Ah = __builtin_bit_cast(bf16x8v, (v4u){p0, p1, p2, p3}), Al = __builtin_bit_cast(bf16x8v, (v4u){q0, q1, q2, q3});
#pragma unroll
            for (int t = 0; t < 2; ++t) { acc[t] = __builtin_amdgcn_mfma_f32_16x16x32_bf16(Ah, Bh[s][t], acc[t], 0, 0, 0); acc[t] = __builtin_amdgcn_mfma_f32_16x16x32_bf16(Ah, Bl[s][t], acc[t], 0, 0, 0);
                acc[t] = __builtin_amdgcn_mfma_f32_16x16x32_bf16(Al, Bh[s][t], acc[t], 0, 0, 0); } }
#pragma unroll
        for (int t = 0; t < 2; ++t)
#pragma unroll
            for (int x = 0; x < 4; ++x) PART[(wv * 16 + 4 * g + x) * 32 + 16 * t + r16] = acc[t][x];
        __syncthreads();
        { const int row = F.tid >> 5, n = F.tid & 31; float v = biasn;
#pragma unroll
          for (int w2 = 0; w2 < 8; ++w2) v += PART[(w2 * 16 + row) * 32 + n];
          LOG[row * 32 + n] = v; }
        __syncthreads();
        if (F.tid < 16 && (g0 + F.tid) < ib1) {
            const int rr = latent_only ? row_of_latent(g0 + F.tid) : g0 + F.tid;
            float l[20];
#pragma unroll
            for (int jj = 0; jj < 20; ++jj) l[jj] = LOG[F.tid * 32 + jj];
            int gsel = 0; float gm = l[0];
#pragma unroll
            for (int q = 1; q < 4; ++q) if (l[q] > gm) { gm = l[q]; gsel = q; }
            float gs = 0.f;
#pragma unroll
            for (int q = 0; q < 4; ++q) gs += __expf(l[q] - gm);
            const float gp = 1.0f / gs;
            float le[4];
#pragma unroll
            for (int q = 0; q < 4; ++q) le[q] = (gsel == 0) ? l[4 + q] : (gsel == 1) ? l[8 + q] : (gsel == 2) ? l[12 + q] : l[16 + q];
            int e1 = 0; float m1 = le[0];
#pragma unroll
            for (int q = 1; q < 4; ++q) if (le[q] > m1) { m1 = le[q]; e1 = q; }
            int e2 = -1; float m2 = 0.f;
#pragma unroll
            for (int q = 0; q < 4; ++q) if (q != e1 && (e2 < 0 || le[q] > m2)) { m2 = le[q]; e2 = q; }
            const float bexp = __expf(m2 - m1), w1 = gp / (1.0f + bexp), w2 = gp * bexp / (1.0f + bexp);
            const int ea = e1 < e2 ? e1 : e2, eb = e1 < e2 ? e2 : e1; const float wa = e1 < e2 ? w1 : w2, wb = e1 < e2 ? w2 : w1;
            const int pidx = ea == 0 ? eb - 1 : (ea == 1 ? eb + 1 : 5), bucket = gsel * 6 + pidx;
            const int rank = atomicAdd((int*)(cnt + bucket), 1); ROUTE[rr] = (v4i){bucket, rank, __builtin_bit_cast(int, wa), __builtin_bit_cast(int, wb)};
        }
#ifdef ROUTE_PREFETCH
#pragma unroll
        for (int s = 0; s < 4; ++s) { xv[s][0] = xn[s][0]; xv[s][1] = xn[s][1]; }
#endif
    }
#ifdef ROUTE_PREFETCH
#undef ROUTE_SRC
#endif
    __syncthreads();
    if (F.tid < 24) ((int*)(ws + WS_BCNT))[blockIdx.x * 24 + F.tid] = cnt[F.tid];
    __syncthreads();
}

__device__ __forceinline__ void phase_scatter(Frame& F, bool latent_only) {
    unsigned char* const ws = PWS;
    LAS int* tab = (LAS int*)(F.lds + TAB_OFF);
    const int* BC = (const int*)(ws + WS_BCNT);
    if (F.tid < 384) { const int k = F.tid >> 4, part = F.tid & 15; int tot = 0, below = 0;
        for (int bb = part * 16; bb < part * 16 + 16 && bb < F.G; ++bb) { const int v = BC[bb * 24 + k]; tot += v; if (bb < (int)blockIdx.x) below += v; }
        tot += xshi<1>(tot); tot += xshi<2>(tot); tot += xshi<4>(tot); tot += xshi<8>(tot); below += xshi<1>(below); below += xshi<2>(below); below += xshi<4>(below); below += xshi<8>(below);
        if (part == 0) { tab[32 + k] = tot; tab[k] = below; } }
    __syncthreads();
    if (F.tid == 0) { int tb = 0; for (int k = 0; k < 24; ++k) { const int nt = (tab[32 + k] + 255) >> 8; tab[64 + k] = tb; tab[96 + k] = nt; tab[k] += tb * 256; tb += nt; } tab[128] = tb; }
    __syncthreads();
    v4i* ROWINFO = (v4i*)(ws + WS_ROWINFO);
    if (blockIdx.x == 0) { int* TI = (int*)(ws + WS_TILEINFO); if (F.tid == 0) TI[0] = tab[128];
        if (F.tid < 24) { const int t0 = tab[64 + F.tid], nt = tab[96 + F.tid]; for (int t = 0; t < nt; ++t) TI[1 + t0 + t] = F.tid; } }
    for (int k = blockIdx.x; k < 24; k += F.G) { const int p0 = tab[64 + k] * 256 + tab[32 + k], p1 = (tab[64 + k] + tab[96 + k]) * 256;
        for (int p = p0 + F.tid; p < p1; p += NTHR) ROWINFO[p] = (v4i){-1, 0, 0, 0}; }
    const int nrows = latent_only ? NB * T_LAT : MROWS, NGW = F.G * NWAVES, RPW = (nrows + NGW - 1) / NGW, gwb = (int)blockIdx.x * NWAVES + F.wave;
    const v4i* ROUTE = (const v4i*)(ws + WS_ROUTE);
    { const int i0 = gwb * RPW, i1 = (i0 + RPW < nrows) ? i0 + RPW : nrows;
      if (i0 + F.lane < i1) { const int idx = i0 + F.lane, r = latent_only ? row_of_latent(idx) : idx; const v4i ri = ROUTE[r]; ROWINFO[tab[ri.x] + ri.y] = (v4i){r, ri.z, ri.w, 0}; } }
    __syncthreads();
}
#if DEBUG_CHECK
__device__ __forceinline__ unsigned dbg_hash(unsigned x) { x ^= x >> 16; x *= 0x7feb352du; x ^= x >> 15; x *= 0x846ca68bu; x ^= x >> 16; return x; }
__device__ __forceinline__ void dbg_fail(Frame& F, int bit) { atomicOr((unsigned*)(F.ctl + CW_ERR), 1u << bit); }
__device__ __forceinline__ void dbg_check_gemm_bf16(Frame& F, const bf16* A, const bf16* Bt, const bf16* O, int ldo, int bit) {
    const int s = F.vcu * NTHR + F.tid;
    if (s < 16384) { const int row = dbg_hash(2 * s + 1) % MROWS, col = dbg_hash(2 * s + 2) % 3072; float ref = 0.f;
        for (int k = 0; k < 1024; ++k) ref += bf1(A[(size_t)row * 1024 + k]) * bf1(Bt[(size_t)col * 1024 + k]);
        const float got = bf1(O[(size_t)row * ldo + col]);
        if (!(fabsf(got - ref) <= 0.02f * fabsf(ref) + 0.05f)) dbg_fail(F, bit); }
}
__device__ __forceinline__ float naive_attn_row(Frame& F, const bf16* P, int b, int h, int j) {
    LAS float* pl = (LAS float*)(F.lds) + F.wave * 2304;
    const bf16* Pb = P + (size_t)b * RPB * NPROJ; const bf16* q = Pb + (size_t)j * NPROJ + C_AQ + h * 64;
    const int nk = (j < L_CTX) ? 4 : 36;
    float sc[36]; float mx = -1e30f;
#pragma unroll
    for (int i = 0; i < 36; ++i) { sc[i] = -1e30f; if (i < nk) { const bf16* k = Pb + (size_t)(i * 64 + F.lane) * NPROJ + C_AK + (h >> 1) * 64; float a = 0.f;
        for (int d = 0; d < 64; ++d) a += bf1(q[d]) * bf1(k[d]);
        sc[i] = a; mx = fmaxf(mx, a); } }
    mx = fmaxf(mx, xshf<1>(mx)); mx = fmaxf(mx, xshf<2>(mx)); mx = fmaxf(mx, xshf<4>(mx)); mx = fmaxf(mx, xshf<8>(mx)); mx = fmaxf(mx, xshf<16>(mx));
    mx = half_max(mx);
    float sum = 0.f;
#pragma unroll
    for (int i = 0; i < 36; ++i) { const float p = (i < nk) ? exp2f(sc[i] - mx) : 0.f; sum += p; pl[i * 64 + F.lane] = p; }
    sum = wave_sum(sum); LDS_WAIT(); asm volatile("" ::: "memory");
    float o = 0.f;
    for (int key = 0; key < nk * 64; ++key) o += pl[key] * bf1(Pb[(size_t)key * NPROJ + C_AV + (h >> 1) * 64 + F.lane]);
    LDS_WAIT(); asm volatile("" ::: "memory");
    return o / sum;
}
__device__ __forceinline__ void dbg_check_attn(Frame& F, const bf16* P, const bf16* ACT_, int bit, bool with_ctx) {
    const int s = F.vcu * NWAVES + F.wave;
    const int b = dbg_hash(3 * s + 1) % NB, h = dbg_hash(3 * s + 2) % 4; int j = L_CTX + dbg_hash(3 * s + 3) % T_LAT;
    if (with_ctx && (s & 7) == 0) j = dbg_hash(3 * s + 3) % L_CTX;
    const float o = naive_attn_row(F, P, b, h, j);
    const float got = bf1(ACT_[(size_t)(b * RPB + j) * DM + 768 + h * 64 + F.lane]);
    if (!(fabsf(got - o) <= 0.03f * fabsf(o) + 0.02f)) dbg_fail(F, j < L_CTX ? bit + 1 : bit);
    __syncthreads();
}
__device__ __forceinline__ void dbg_check_outproj(Frame& F, const float* xsrc, const float* xdst, const bf16* ACT_, const bf16* Wt, const float* gate, int bit) {
    const int s = F.vcu * NTHR + F.tid;
    if (s < 16384) { const int idx = dbg_hash(2 * s + 5) % (NB * T_LAT), col = dbg_hash(2 * s + 6) % DM, r = row_of_latent(idx), b = idx >> 11; float ref = 0.f;
        for (int k = 0; k < 1024; ++k) ref += bf1(ACT_[(size_t)r * 1024 + k]) * bf1(Wt[(size_t)col * 1024 + k]);
        ref = xsrc[(size_t)idx * DM + col] + gate[b * 1024 + col] * ref;
        const float got = xdst[(size_t)idx * DM + col];
        if (!(fabsf(got - ref) <= 0.01f * fabsf(ref) + 0.01f)) dbg_fail(F, bit); }
}
__device__ __forceinline__ void dbg_check_gateup(Frame& F, const unsigned char* A8, const unsigned char* Wgu8, const unsigned char* H8, const v4i* rowinfo, const LAS int* tileb, int ntiles, int bit) {
    const int s = F.vcu * NTHR + F.tid;
    if (s < 16384) { const int pos = dbg_hash(2 * s + 7) % (ntiles * 256), hc = dbg_hash(2 * s + 8) % 1024; const v4i ri = rowinfo[pos];
        if (ri.x >= 0) { const int k = tileb[pos >> 8], g = k / 6, pr = k % 6; const int ea = pr < 3 ? 0 : (pr < 5 ? 1 : 2), eb = pr < 3 ? pr + 1 : (pr < 5 ? pr - 1 : 3);
            const int e = g * 4 + (hc < 512 ? ea : eb), jj = hc & 511; const float wgt = __builtin_bit_cast(float, hc < 512 ? ri.y : ri.z);
            const unsigned char* wg = Wgu8 + ((size_t)e * 1024 + (jj >> 7) * 256 + (jj & 127)) * 1024; const unsigned char* wu = wg + 128 * 1024; float ga = 0.f, up = 0.f;
            for (int q = 0; q < 1024; ++q) { const float a = fp8_dec(A8[(size_t)ri.x * 1024 + q]); ga += a * fp8_dec(wg[q]); up += a * fp8_dec(wu[q]); }
            const float ref = 16.0f * siluf(ga * (1.0f / 32.0f)) * (up * (1.0f / 32.0f)) * wgt, got = fp8_dec(H8[(size_t)pos * 1024 + hc]);
            if (!(fabsf(got - ref) <= 0.08f * fabsf(ref) + 0.02f)) dbg_fail(F, bit); } }
}
__device__ __forceinline__ void dbg_check_mix(Frame& F, const bf16* P, const bf16* act, const float* lblog, const float* rdec, const float* hn, const float* rn) {
    const int s = F.vcu * NWAVES + F.wave, lane = F.lane;
    const int mixer = s & 1, b = dbg_hash(5 * s + 1) % NB, h = dbg_hash(5 * s + 2) % 4, j = L_CTX + dbg_hash(5 * s + 3) % T_LAT;
    float osum = 0.f;
    for (int dir = 0; dir < 2; ++dir) {
        const float lb = (mixer == 0 && lblog) ? sigmf(lblog[512 + dir * 256 + h * 64 + lane] - lblog[dir * 256 + h * 64 + lane]) : 0.f;
        const float gamma = sigmf(rdec[dir * 4 + h]);
        const int nt = (dir == 0) ? j : (RPB + L_CTX - 1 - j);
        float S[64];
#pragma unroll
        for (int dd = 0; dd < 64; ++dd) S[dd] = 0.f;
        float o = 0.f;
        for (int n = 0; n <= nt; ++n) { const bf16* rp = P + (size_t)(b * RPB + rc::row_in_batch(dir, n)) * NPROJ;
            float f, k, q, v;
            if (mixer == 0) { f = lb + (1.0f - lb) * sigmf(bf1(rp[C_HZ + 256 * dir + h * 64 + lane])); k = 1.0f - f; q = bf1(rp[C_HQ + h * 64 + lane]); v = bf1(rp[C_HI + h * 64 + lane]); }
            else { f = gamma; k = bf1(rp[C_RK + h * 64 + lane]); q = 0.125f * bf1(rp[C_RQ + h * 64 + lane]); v = bf1(rp[C_RV + h * 64 + lane]); }
            o = 0.f;
#pragma unroll
            for (int dd = 0; dd < 64; ++dd) { const float fd = __builtin_bit_cast(float, __builtin_amdgcn_readlane(__builtin_bit_cast(int, f), dd)), kd = __builtin_bit_cast(float, __builtin_amdgcn_readlane(__builtin_bit_cast(int, k), dd)),
                    qd = __builtin_bit_cast(float, __builtin_amdgcn_readlane(__builtin_bit_cast(int, q), dd));
                S[dd] = fd * S[dd] + kd * v; o += qd * S[dd]; } }
        osum += o;
    }
    const float rs = 1.0f / sqrtf(wave_sum(osum * osum) * (1.0f / 64.0f) + NORM_EPS);
    const float g = bf1(P[(size_t)(b * RPB + j) * NPROJ + (mixer == 0 ? C_HG : C_RG) + h * 64 + lane]);
    const float ref = osum * rs * (mixer == 0 ? hn : rn)[h * 64 + lane] * siluf(g);
    const float got = bf1(act[(size_t)(b * RPB + j) * DM + (mixer == 0 ? 0 : 512) + h * 64 + lane]);
    const float se = wave_sum(fabsf(got - ref)), sr = wave_sum(fabsf(ref));
    if (!(se <= 0.03f * sr + 0.3f)) dbg_fail(F, mixer == 0 ? 6 : 7);
}
__device__ __forceinline__ void dbg_check_norm1(Frame& F, const bf16* act, const float* MODp) {
    const int s = F.vcu * NTHR + F.tid;
    if (s < 8192) { const int r = dbg_hash(2 * s + 11) % MROWS, c = dbg_hash(2 * s + 12) % DM, b = r / RPB, j = r - b * RPB, m = (j < L_CTX) ? 16 : b;
        const float* src = (j < L_CTX) ? PIN(I_CTX) + (size_t)(b * L_CTX + j) * DM : PIN(I_X) + (size_t)(b * T_LAT + j - L_CTX) * DM;
        const float* cv = (j < L_CTX) ? PIN(I_CCTX) : PIN(I_C) + b * 1024; const float* aw = PIN(I_ADAW); const float* ab = PIN(I_ADAB);
        float ss = 0.f, sh = ab[c], scl = ab[1024 + c];
        for (int k = 0; k < 1024; ++k) { ss += src[k] * src[k]; const float sv = siluf(cv[k]); sh += sv * aw[(size_t)k * 6144 + c]; scl += sv * aw[(size_t)k * 6144 + 1024 + c]; }
        const float nA = PIN(I_NMIX)[c] * (1.0f + scl);
        const float gB = MODp[0 * 17 * 1024 + m * 1024 + c], gA = MODp[1 * 17 * 1024 + m * 1024 + c];
        if (!(fabsf(gB - sh) <= 1e-3f * fabsf(sh) + 1e-3f)) dbg_fail(F, 2);
        if (!(fabsf(gA - nA) <= 1e-3f * fabsf(nA) + 1e-3f)) dbg_fail(F, 3);
        const float ref = src[c] * (1.0f / sqrtf(ss / 1024.0f + NORM_EPS)) * gA + gB;
        const float got = bf1(act[(size_t)r * DM + c]);
        if (!(fabsf(got - ref) <= 0.01f * fabsf(ref) + 0.01f)) dbg_fail(F, 4); }
}
__device__ __forceinline__ void dbg_apply(Frame& F, float* out, unsigned* barw) {
    unsigned m = __hip_atomic_load((unsigned*)(F.ctl + CW_ERR), RLX_AGENT);
    if (__hip_atomic_load(barw + XB_TMO, RLX_AGENT) != 0u) m |= 32u;
    if (m) { const float sc = 1.0f + 10.0f * exp2f(0.33219f * (float)m); for (size_t i = (size_t)F.vcu * NTHR + F.tid; i < (size_t)NB * T_LAT * DM; i += (size_t)F.G * NTHR) out[i] *= sc; }
}
#endif
#ifndef NAIVE_ATTN
#define NAIVE_ATTN 0
#endif
#if NAIVE_ATTN && DEBUG_CHECK
__device__ __forceinline__ void phase_naive_attn(Frame& F, const bf16* P, bf16* ACT_, bool latent_only) {
    const int gw = F.vcu * NWAVES + F.wave, NGW = F.G * NWAVES;
    for (int it = gw; it < MROWS * 4; it += NGW) { const int r = it >> 2, h = it & 3, b = r / RPB, j = r - b * RPB;
        if (latent_only && j < L_CTX) continue;
        const float o = naive_attn_row(F, P, b, h, j);
        ACT_[(size_t)r * DM + 768 + h * 64 + F.lane] = (bf16)f2bf(o); }
    __syncthreads();
}
#endif
#ifndef SKIPMASK
#define SKIPMASK 0
#endif
#ifdef REP_BAR
#define GRID_BAR_X() xcd_barrier(bar)
#else
#define GRID_BAR_X() do {} while (0)
#endif
#ifdef PROBE_BARTIME
#define GRID_BAR_T0() const unsigned long long tb0_ = __builtin_amdgcn_s_memrealtime()
#define GRID_BAR_T1(site) do { if ((PROBE_BARMASK >> (site)) & 1) F.bart += (unsigned)(__builtin_amdgcn_s_memrealtime() - tb0_); } while (0)
#else
#define GRID_BAR_T0() do {} while (0)
#define GRID_BAR_T1(site) do {} while (0)
#endif
#define GRID_BAR(site) do { GRID_BAR_T0(); GRID_BAR_X(); xcd_barrier(bar); GRID_BAR_T1(site); { int t_ = F.tid; asm volatile("" : "+v"(t_)); F.tid = t_; F.lane = t_ & 63; F.wave = __builtin_amdgcn_readfirstlane(t_ >> 6); } ws = PWS; } while (0)
#define ACT ((bf16*)(ws + WS_ACT))
#define P ((bf16*)(ws + WS_P))
#define CTXB ((float*)(ws + WS_CTX))
#define ORET ((bf16*)(ws + WS_ORET))
#ifdef OUTPROJ_FP8
#define ATTN_OPTR(b, h) ((attn_body::bf16*)((unsigned char*)ACT + (size_t)(b) * RPB * DM + (12 + (h)) * 128))
#else
#define ATTN_OPTR(b, h) ((attn_body::bf16*)ACT + (size_t)(b) * RPB * DM + 768 + (h) * 64)
#endif
template <int layer> __device__ __forceinline__ void layer_body(Frame& F, XcdBarrier& bar, unsigned char* lds) {
    LAS int* const tileb = (LAS int*)(F.lds + TAB_OFF + 1024);
    unsigned char* ws = PWS;
        const bool lastl = (layer == DEPTH - 1);
        const float* xsrc = (layer == 0) ? PIN(I_X) : (const float*)POUT;
        const float* csrc = (layer == 0) ? PIN(I_CTX) : (const float*)CTXB;
        const float* MOD = (const float*)(ws + WS_MOD) + (size_t)layer * 6 * 17 * 1024;
        #if !(SKIPMASK & 1)
        phase_norm1(F, xsrc, csrc, MOD + 1 * 17 * 1024, MOD + 0 * 17 * 1024, ACT, ws + WS_KVS);
#ifdef REP_N1
        phase_norm1(F, xsrc, csrc, MOD + 1 * 17 * 1024, MOD + 0 * 17 * 1024, ACT, ws + WS_KVS);
#endif
#endif

        GRID_BAR(1);
#if DEBUG_CHECK
        if (layer == 0) dbg_check_norm1(F, ACT, MOD);
#endif
        #if !(SKIPMASK & 2)
        {
            constexpr int NF8 = __builtin_popcount(INPROJ_F8MASK), NB16 = NPROJ / 256 - NF8;
            unsigned long long map16 = 0ull, map8 = 0ull; { int j16 = 0, j8 = 0; for (int t = 0; t < NPROJ / 256; ++t) { if ((INPROJ_F8MASK >> t) & 1) map8 |= (unsigned long long)t << (4 * j8++); else map16 |= (unsigned long long)t << (4 * j16++); } }
            pg8::Gemm g{DM, DM, DM, nullptr}; DenseOrder S; S.init(NPANEL, NB16, F.G, (int)blockIdx.x, 0, ACT, (const bf16*)(ws + WS_W0 + (size_t)layer * WLAYER + WO_WIN), DM, DM); S.pnmap = map16;
            EpiStore E{P, NPROJ, 1.0f};
#ifndef REP_INPROJ
#define REP_INPROJ 1
#endif
            pg8::gemm_phase<EpiStore, DenseOrder, false, true>(F.lds + RING_OFF, g, S, E, F.tid);
            if (NF8 > 0) {
                pg8::Gemm g8{512, 512, 512, nullptr}; DenseOrder S8; const int c8 = ((int)blockIdx.x + F.G - (NPANEL * NB16) % F.G) % F.G;
                S8.init(NPANEL, NF8, F.G, c8, 0, ws + WS_KVS, (const bf16*)(ws + WS_W0 + (size_t)layer * WLAYER + WO_WIN), 512, 512); S8.tB = 524288; S8.pnmap = map8;
#ifdef FUSE_PREP
                EpiStoreQK E8{P, NPROJ, 1.0f / 32.0f, PIN(I_QN) + layer * 64, PIN(I_KN) + layer * 64, (const float*)(ws + WS_ROPE), (const float*)(ws + WS_ROPE) + 2048 * 32};
                pg8::gemm_phase<EpiStoreQK, DenseOrder, false, true, false, true>(F.lds + RING_OFF, g8, S8, E8, F.tid);
#else
                EpiStore E8{P, NPROJ, 1.0f / 32.0f};
                pg8::gemm_phase<EpiStore, DenseOrder, false, true, false, true>(F.lds + RING_OFF, g8, S8, E8, F.tid);
#endif
#if defined(REP_F8)
                __syncthreads();
                pg8::gemm_phase<EpiStore, DenseOrder, false, true, false, true>(F.lds + RING_OFF, g8, S8, E8, F.tid);
#endif
            }
#if REP_INPROJ == 2
            __syncthreads();
            pg8::gemm_phase<EpiStore, DenseOrder, false, true>(F.lds + RING_OFF, g, S, E, F.tid);
#endif
        }
#endif

        GRID_BAR(2);
#if DEBUG_CHECK
        dbg_check_gemm_bf16(F, ACT, (const bf16*)(ws + WS_W0 + (size_t)layer * WLAYER + WO_WIN), P, NPROJ, 0);
#endif
        #if !(SKIPMASK & 4)
#ifndef FUSE_PREP
        phase_prep(F, P, PIN(I_QN) + layer * 64, PIN(I_KN) + layer * 64, (const float*)(ws + WS_ROPE), (const float*)(ws + WS_ROPE) + 2048 * 32);
#endif
#ifdef REP_PREP
        phase_prep<true>(F, P, PIN(I_QN) + layer * 64, PIN(I_KN) + layer * 64, (const float*)(ws + WS_ROPE), (const float*)(ws + WS_ROPE) + 2048 * 32);
#endif
#endif

#ifdef SPLIT_MIX
#define LAUNDER_TID() do { int t_ = F.tid; asm volatile("" : "+v"(t_)); F.tid = t_; F.lane = t_ & 63; F.wave = __builtin_amdgcn_readfirstlane(t_ >> 6); ws = PWS; } while (0)
        xcd_split_arrive(bar, (unsigned*)(F.ctl + CW_BAR4));
        {
            bf16* KVS = (bf16*)(ws + WS_KVS); float* DBUF = (float*)(ws + WS_DBUF); const float* lbl = (layer == 0) ? nullptr : PIN(I_LB); const float* rdec = PIN(I_RDEC) + layer * 8;
            recur_stageA_loop(F, P, KVS, DBUF, F.vcu * NWAVES + F.wave, F.G * NWAVES, 256 * 36, lbl, rdec);
        }
        xcd_split_arrive(bar, (unsigned*)(F.ctl + CW_BAR5));
        xcd_split_wait(bar, (unsigned*)(F.ctl + CW_BAR4), (unsigned)layer + 1u);
        LAUNDER_TID();
        {
            const int nunits = lastl ? 512 : 576;
            for (int ui = 0; ; ++ui) {
                const int u = F.vcu + ui * F.G;
                if (ui == 1) {
                    xcd_split_wait(bar, (unsigned*)(F.ctl + CW_BAR5), (unsigned)layer + 1u);
                    LAUNDER_TID();
                    { bf16* KVS = (bf16*)(ws + WS_KVS); const float* DBUF = (const float*)(ws + WS_DBUF); const float* rdec = PIN(I_RDEC) + layer * 8;
                      for (int seq = F.vcu; seq < 256; seq += F.G) { const int mixer = seq >> 7, h = (seq >> 1) & 3, dir = seq & 1;
                          if (mixer == 0) recur_stageB_seq<0>(F, KVS, DBUF, seq, 0.f); else recur_stageB_seq<1>(F, KVS, DBUF, seq, sigmf(rdec[dir * 4 + h])); } }
                    xcd_split_arrive(bar, (unsigned*)(F.ctl + CW_BAR2));
                    LAUNDER_TID();
                }
                if (u >= nunits) break;
                int b, h, qb; if (u < 512) { b = u >> 5; h = (u >> 3) & 3; qb = 1 + (u & 7); } else { b = (u - 512) >> 2; h = u & 3; qb = 0; }
                const attn_body::bf16* Pb = (const attn_body::bf16*)P + (size_t)b * RPB * NPROJ;
                attn_body::attn_unit<8>(qb * 256, qb == 0 ? 4 : 36, Pb + C_AQ + h * 64, Pb + C_AK + (h >> 1) * 64, Pb + C_AV + (h >> 1) * 64,
                                        ATTN_OPTR(b, h), (char*)lds + RING_OFF, F.tid);
            }
        }
#else
        {
            bf16* KVS = (bf16*)(ws + WS_KVS); float* DBUF = (float*)(ws + WS_DBUF); const float* lbl = (layer == 0) ? nullptr : PIN(I_LB); const float* rdec = PIN(I_RDEC) + layer * 8;
#ifndef REP_A
#define REP_A 1
#endif
            for (int rp_REP_A = 0; rp_REP_A < REP_A; ++rp_REP_A)
            recur_stageA_loop(F, P, KVS, DBUF, F.vcu * NWAVES + F.wave, F.G * NWAVES, 256 * 36, lbl, rdec);
        }
        GRID_BAR(3);
        {
            { bf16* KVS = (bf16*)(ws + WS_KVS); const float* DBUF = (const float*)(ws + WS_DBUF); const float* rdec = PIN(I_RDEC) + layer * 8;
#ifndef REP_B
#define REP_B 1
#endif
            for (int rp_REP_B = 0; rp_REP_B < REP_B; ++rp_REP_B)
              for (int seq = F.vcu; seq < 256; seq += F.G) { const int mixer = seq >> 7, h = (seq >> 1) & 3, dir = seq & 1;
                  if (mixer == 0) recur_stageB_seq<0>(F, KVS, DBUF, seq, 0.f); else recur_stageB_seq<1>(F, KVS, DBUF, seq, sigmf(rdec[dir * 4 + h])); } }
#ifdef REP_BDRY
            { bf16* KVS = (bf16*)(ws + WS_KVS); const float* DBUF = (const float*)(ws + WS_DBUF); const float* rdec = PIN(I_RDEC) + layer * 8;
              for (int seq = F.vcu; seq < 256; seq += F.G) { const int mixer = seq >> 7, h = (seq >> 1) & 3, dir = seq & 1;
                  if (mixer == 0) recur_stageB_seq<0, true>(F, KVS, DBUF, seq, 0.f); else recur_stageB_seq<1, true>(F, KVS, DBUF, seq, sigmf(rdec[dir * 4 + h])); } }
#endif

#ifdef SPLIT_BC
            xcd_split_arrive(bar, (unsigned*)(F.ctl + CW_BAR2));
#endif
#if NAIVE_ATTN && DEBUG_CHECK
            phase_naive_attn(F, P, ACT, lastl);
#elif !(SKIPMASK & 16)
        const int nunits = lastl ? 512 : 576;
#ifndef REP_ATTN
#define REP_ATTN 1
#endif
            for (int rep_ = 0; rep_ < REP_ATTN; ++rep_)
            for (int u = F.vcu; u < nunits; u += F.G) {
                int b, h, qb; if (u < 512) { b = u >> 5; h = (u >> 3) & 3; qb = 1 + (u & 7); } else { b = (u - 512) >> 2; h = u & 3; qb = 0; }
                const attn_body::bf16* Pb = (const attn_body::bf16*)P + (size_t)b * RPB * NPROJ;
                attn_body::attn_unit<8>(qb * 256, qb == 0 ? 4 : 36, Pb + C_AQ + h * 64, Pb + C_AK + (h >> 1) * 64, Pb + C_AV + (h >> 1) * 64,
                                        ATTN_OPTR(b, h), (char*)lds + RING_OFF, F.tid);
            }
#endif

        }
#endif
#ifdef SPLIT_BC
        xcd_split_wait(bar, (unsigned*)(F.ctl + CW_BAR2), (unsigned)layer + 1u);
        { int t_ = F.tid; asm volatile("" : "+v"(t_)); F.tid = t_; F.lane = t_ & 63; F.wave = __builtin_amdgcn_readfirstlane(t_ >> 6); } ws = PWS;
#else
        GRID_BAR(4);
#endif
        {
            const bf16* KVS = (const bf16*)(ws + WS_KVS); const float* lbl = (layer == 0) ? nullptr : PIN(I_LB); const float* rdec = PIN(I_RDEC) + layer * 8;
            const float* hn = PIN(I_HNORM) + layer * 256; const float* rn = PIN(I_RNORM) + layer * 256;
            const int ntb = lastl ? 32 : 36;
#ifndef REP_C
#define REP_C 1
#endif
            for (int rp_REP_C = 0; rp_REP_C < REP_C; ++rp_REP_C)
            recur_stageC_loop(F, P, KVS, ACT, F.vcu & 7, F.vcu >> 3, (F.G >= 8) ? (F.G >> 3) : 1, 16 * ntb, ntb, lastl ? 4 : 0, lbl, rdec, hn, rn);
            phase_conv(F, P, ACT, PIN(I_CONVW) + layer * 768, lastl);
#ifdef REP_CONV
            phase_conv(F, P, ACT, PIN(I_CONVW) + layer * 768, lastl);
#endif
        }
        GRID_BAR(5);
#if DEBUG_CHECK
        dbg_check_mix(F, P, ACT, layer == 0 ? nullptr : PIN(I_LB), PIN(I_RDEC) + layer * 8, PIN(I_HNORM) + layer * 256, PIN(I_RNORM) + layer * 256);
#endif
#if DEBUG_CHECK
        dbg_check_attn(F, P, ACT, 1, !lastl);
#endif
        #if !(SKIPMASK & 64)
        {
#ifdef OUTPROJ_FP8
            pg8::Gemm g{512, 512, 512, nullptr}; DenseOrder S; S.init(lastl ? NB * 8 : NPANEL, 4, F.G, (int)blockIdx.x, lastl ? 1 : 0, ACT, (const bf16*)(ws + WS_W0 + (size_t)layer * WLAYER + WO_WOUT), 512, 512);
            EpiResid E{xsrc, csrc, POUT, CTXB, MOD + 2 * 17 * 1024, 1.0f / 128.0f};
            pg8::gemm_phase<EpiResid, DenseOrder, true, true, false, true, true>(F.lds + RING_OFF, g, S, E, F.tid);
#else
            pg8::Gemm g{DM, DM, DM, nullptr}; DenseOrder S; S.init(lastl ? NB * 8 : NPANEL, 4, F.G, (int)blockIdx.x, lastl ? 1 : 0, ACT, (const bf16*)(ws + WS_W0 + (size_t)layer * WLAYER + WO_WOUT), DM, DM);
            EpiResid E{xsrc, csrc, POUT, CTXB, MOD + 2 * 17 * 1024, 1.0f};
            pg8::gemm_phase<EpiResid, DenseOrder, true, true>(F.lds + RING_OFF, g, S, E, F.tid);
#endif
        }
        if (layer == 0) {
            __syncthreads();
#ifdef SPLIT_OP
            xcd_split_arrive(bar, (unsigned*)(F.ctl + CW_BAR4));
#endif
            constexpr int PL = 1792 + 512 + 3 * 4096;
#ifdef CONV_SPLIT64
            if (F.G == 256) { const int c = (int)blockIdx.x;
                if (c < 64) convert_weights_range(F, PL, PL + CONV_SPLIT64, c * NWAVES + F.wave, 64 * NWAVES);
                else convert_weights_range(F, PL + CONV_SPLIT64, 2 * PL, (c - 64) * NWAVES + F.wave, 192 * NWAVES); }
            else convert_weights_range(F, PL, 2 * PL, F.vcu * NWAVES + F.wave, F.G * NWAVES);
#else
            const int nb = (int)blockIdx.x - 64, nw = (F.G - 64) * NWAVES;
            if (F.G > 64) convert_weights_range(F, PL, 2 * PL, nb >= 0 ? nb * NWAVES + F.wave : -1, nw);
            else convert_weights_range(F, PL, 2 * PL, F.vcu * NWAVES + F.wave, F.G * NWAVES);
#endif
            __syncthreads();
        }
#endif

#ifdef SPLIT_OP
        if (layer == 0) { xcd_split_wait(bar, (unsigned*)(F.ctl + CW_BAR4), 1u); { int t_ = F.tid; asm volatile("" : "+v"(t_)); F.tid = t_; F.lane = t_ & 63; F.wave = __builtin_amdgcn_readfirstlane(t_ >> 6); } ws = PWS; }
        else GRID_BAR(6);
#else
        GRID_BAR(6);
#endif
#if DEBUG_CHECK
        if (layer == 0) dbg_check_outproj(F, PIN(I_X), POUT, ACT, (const bf16*)(ws + WS_W0 + (size_t)layer * WLAYER + WO_WOUT), MOD + 2 * 17 * 1024, 3);
        GRID_BAR(6);
#endif
        #if !(SKIPMASK & 128)
        phase_norm2_route(F, layer, (const float*)POUT, (const float*)CTXB, MOD + 4 * 17 * 1024, MOD + 3 * 17 * 1024, ACT, lastl);
#ifdef REP_N2
        phase_norm2_route(F, layer, (const float*)POUT, (const float*)CTXB, MOD + 4 * 17 * 1024, MOD + 3 * 17 * 1024, ACT, lastl);
#endif
#endif

        GRID_BAR(7);
        #if !(SKIPMASK & 256)
        phase_scatter(F, lastl);
#ifdef REP_N2
        phase_scatter(F, lastl);
#endif
#endif

        GRID_BAR(8);
#ifdef MOE_SPLIT
        {
            const int* TI = (const int*)(ws + WS_TILEINFO); const int ntiles = TI[0], T1 = ntiles >> 1;
            for (int i = F.tid; i < MAXTILES; i += NTHR) tileb[i] = (i < ntiles) ? TI[1 + i] : 0;
            __syncthreads();
            int dealt = 0;
#pragma nounroll
            for (int part = 0; part < 2; ++part) {
                const int t0 = part ? T1 : 0, ntp = part ? ntiles - T1 : T1;
                pg8::Gemm g{512, 512, 512, nullptr}; g.rowidx = (const int*)(ws + WS_ROWINFO);
                MoeOrder S; S.pm0 = t0; S.ncol = 8; S.nwg = ntp * 8; S.G = F.G; S.c = ((int)blockIdx.x + F.G - dealt % F.G) % F.G; S.down = 0; S.tileb = tileb; S.A = (const char*)(ws + WS_ACT); S.W = (const char*)(ws + WS_W0 + (size_t)layer * WLAYER + WO_WGU);
                EpiGateUp E{ws + WS_H, (const v4i*)(ws + WS_ROWINFO)};
                pg8::gemm_phase<EpiGateUp, MoeOrder, true, true, true, true>(F.lds + RING_OFF, g, S, E, F.tid);
                dealt += ntp * 8;
                xcd_split_arrive(bar, (unsigned*)(F.ctl + (part ? CW_BAR4 : CW_BAR3)));
            }
#pragma nounroll
            for (int part = 0; part < 2; ++part) {
                xcd_split_wait(bar, (unsigned*)(F.ctl + (part ? CW_BAR4 : CW_BAR3)), (unsigned)layer + 1u);
                { int t_ = F.tid; asm volatile("" : "+v"(t_)); F.tid = t_; F.lane = t_ & 63; F.wave = __builtin_amdgcn_readfirstlane(t_ >> 6); } ws = PWS;
                const int t0 = part ? T1 : 0, ntp = part ? ntiles - T1 : T1;
                pg8::Gemm g{512, 1024, 512, nullptr};
                MoeOrder S; S.pm0 = t0; S.ncol = 4; S.nwg = ntp * 4; S.G = F.G; S.c = ((int)blockIdx.x + F.G - dealt % F.G) % F.G; S.down = 1; S.tileb = tileb; S.A = (const char*)(ws + WS_H); S.W = (const char*)(ws + WS_W0 + (size_t)layer * WLAYER + WO_WD);
                EpiDown E{POUT, CTXB, MOD + 5 * 17 * 1024, (const v4i*)(ws + WS_ROWINFO)};
                pg8::gemm_phase<EpiDown, MoeOrder, true, true, false, true>(F.lds + RING_OFF, g, S, E, F.tid);
                dealt += ntp * 4;
            }
        }
#else
        #if !(SKIPMASK & 512)
        {
            const int* TI = (const int*)(ws + WS_TILEINFO); const int ntiles = TI[0];
            for (int i = F.tid; i < MAXTILES; i += NTHR) tileb[i] = (i < ntiles) ? TI[1 + i] : 0;
            __syncthreads();
            pg8::Gemm g{512, 512, 512, nullptr};
            g.rowidx = (const int*)(ws + WS_ROWINFO);
            MoeOrder S; S.pm0 = 0; S.ncol = 8; S.nwg = ntiles * 8; S.G = F.G; S.c = (int)blockIdx.x; S.down = 0; S.tileb = tileb; S.A = (const char*)(ws + WS_ACT); S.W = (const char*)(ws + WS_W0 + (size_t)layer * WLAYER + WO_WGU);
            EpiGateUp E{ws + WS_H, (const v4i*)(ws + WS_ROWINFO)};
#ifndef REP_GU
#define REP_GU 1
#endif
            pg8::gemm_phase<EpiGateUp, MoeOrder, true, true, true, true>(F.lds + RING_OFF, g, S, E, F.tid);
#if REP_GU == 2
            __syncthreads();
            pg8::gemm_phase<EpiGateUp, MoeOrder, true, true, true, true>(F.lds + RING_OFF, g, S, E, F.tid);
#endif
        }
#endif

        GRID_BAR(9);
#if DEBUG_CHECK
        { const int* TI = (const int*)(ws + WS_TILEINFO); dbg_check_gateup(F, ws + WS_ACT, ws + WS_W0 + (size_t)layer * WLAYER + WO_WGU, ws + WS_H, (const v4i*)(ws + WS_ROWINFO), tileb, TI[0], 4); }
#endif
        #if !(SKIPMASK & 1024)
        {
            const int* TI = (const int*)(ws + WS_TILEINFO); const int ntiles = TI[0];
            pg8::Gemm g{512, 1024, 512, nullptr};
            MoeOrder S; S.pm0 = 0; S.ncol = 4; S.nwg = ntiles * 4; S.G = F.G; S.c = (int)blockIdx.x; S.down = 1; S.tileb = tileb; S.A = (const char*)(ws + WS_H); S.W = (const char*)(ws + WS_W0 + (size_t)layer * WLAYER + WO_WD);
            EpiDown E{POUT, CTXB, MOD + 5 * 17 * 1024, (const v4i*)(ws + WS_ROWINFO)};
            pg8::gemm_phase<EpiDown, MoeOrder, true, true, false, true>(F.lds + RING_OFF, g, S, E, F.tid);
        }
#endif

#endif
#if defined(PROBE_BARTIME) || DEBUG_CHECK
        GRID_BAR(10);
#else
        if (!lastl) GRID_BAR(10);
#endif
    }
__global__ void __launch_bounds__(NTHR, 2) fwd_kernel(Args args) {
    extern __shared__ __attribute__((aligned(16))) unsigned char lds[];
    Frame F;
    F.lds = (LAS unsigned char*)lds;
    F.MISC = (volatile LAS unsigned*)(F.lds + MISC_OFF);
    F.tid = threadIdx.x; F.lane = F.tid & 63; F.wave = __builtin_amdgcn_readfirstlane(F.tid >> 6);
    F.bart = 0u; F.G = gridDim.x; { const int bx = blockIdx.x; F.vcu = (F.G % 8 == 0) ? (bx % 8) * (F.G / 8) + bx / 8 : bx; }
    F.ctl = (gu32*)(args.ws + WS_CTL);
    for (int u = F.tid; u < (LDS_BYTES - LDSCTL_OFF) / 4; u += NTHR) ((LAS unsigned*)(F.lds + LDSCTL_OFF))[u] = 0u;
    __syncthreads();
    if (F.tid == 0) { volatile LAS unsigned long long* pt = (volatile LAS unsigned long long*)(F.lds + PTAB_OFF);
#pragma unroll
        for (int i = 0; i < 24; ++i) pt[i] = (unsigned long long)args.in[i];
        pt[24] = (unsigned long long)args.out; pt[25] = (unsigned long long)(args.ws + args.ws_shift); }
    __syncthreads();
    XcdBarrier bar = xcd_barrier_post((unsigned*)(F.ctl + CW_BAR), F.MISC + 8);
    unsigned char* ws = PWS;

    #if !(SKIPMASK & 2048)
        p0_prologue(F, bar);
#endif

#ifdef SPLIT_PRO
    xcd_split_wait(bar, (unsigned*)(F.ctl + CW_BAR3), 1u);
    { int t_ = F.tid; asm volatile("" : "+v"(t_)); F.tid = t_; F.lane = t_ & 63; F.wave = __builtin_amdgcn_readfirstlane(t_ >> 6); } ws = PWS;
#else
    GRID_BAR(0);
#endif

    layer_body<0>(F, bar, lds);
    layer_body<1>(F, bar, lds);
#ifdef PROBE_BARTIME
    if (blockIdx.x == PROBE_BARTIME - 1 && F.tid == 0) { const unsigned long long ts_ = __builtin_amdgcn_s_memrealtime(); while (__builtin_amdgcn_s_memrealtime() - ts_ < 8ull * F.bart) __builtin_amdgcn_s_sleep(8); }
#endif
#if DEBUG_CHECK
    dbg_apply(F, POUT, bar.bar);
#endif
}

extern "C" void kernel_launch(void* const* d_in, const int* in_sizes, int n_in, void* d_out, int out_size, void* d_ws, size_t ws_size, hipStream_t stream) {
    static int grid = 0;
    if (grid == 0) {
        if (n_in != 24 || out_size != NB * T_LAT * DM || ws_size < WS_END) { fprintf(stderr, "kernel_launch: unexpected shapes (n_in %d, out %d, ws %zu); nothing launched\n", n_in, out_size, ws_size); grid = -1; return; }
        int dev = 0, cus = 0, per_cu = 0;
        if (hipGetDevice(&dev) != hipSuccess || hipDeviceGetAttribute(&cus, hipDeviceAttributeMultiprocessorCount, dev) != hipSuccess) { grid = -1; return; }
        if (hipFuncSetAttribute((const void*)fwd_kernel, hipFuncAttributeMaxDynamicSharedMemorySize, LDS_BYTES) != hipSuccess) { grid = -1; return; }
        if (hipOccupancyMaxActiveBlocksPerMultiprocessor(&per_cu, (const void*)fwd_kernel, NTHR, LDS_BYTES) != hipSuccess || per_cu < 1) { fprintf(stderr, "kernel_launch: occupancy query says %d blocks per CU\n", per_cu); grid = -1; return; }
        (void)hipGetLastError();
        grid = cus < 256 ? cus : 256;
    }
    if (grid < 0) return;
    if (hipMemsetAsync((char*)d_ws + WS_CTL, 0, CTL_ZERO_BYTES, stream) != hipSuccess) return;
    Args a{};
    for (int i = 0; i < 24; ++i) a.in[i] = (const float*)d_in[i];
    a.out = (float*)d_out; a.ws = (unsigned char*)d_ws;
#ifdef WS_TOP
    a.ws_shift = ((ws_size - WS_END) / (2 * MiB)) * (2 * MiB);
#endif
    hipLaunchKernelGGL(fwd_kernel, dim3(grid), dim3(NTHR), LDS_BYTES, stream, a);
}
```

```cpp
#define SPLIT_BC 1
#define EARLY_INV 1

#define MOD_WIDE 1
#define SPLIT_PRO 1
#define SPLIT_OP 1


#define EMU_TILES 0

#define INPROJ_F8MASK 0x3F02

#include <hip/hip_runtime.h>
#ifdef NT_LOADS
#define LDNT(p) __builtin_nontemporal_load(p)
#else
#define LDNT(p) (*(p))
#endif
#include <hip/hip_bf16.h>
#include <cstdio>
#include <cstdint>
#include <cmath>
#ifndef DEBUG_CHECK
#define DEBUG_CHECK 0
#endif
#define DENSE_WGM 4
#ifndef NAIVE_ATTN
#define NAIVE_ATTN 0
#endif

namespace pg8 {
#define PG8_LAS __attribute__((address_space(3)))
typedef unsigned short bf16_t;
typedef short bf16x8 __attribute__((ext_vector_type(8)));
typedef float f32x4 __attribute__((ext_vector_type(4)));
typedef unsigned u32x4 __attribute__((ext_vector_type(4)));
constexpr int BM = 256, BK = 64, HALF = 128, HTB = HALF * BK * 2  , STAGE_BYTES = 8 * HTB, NXCD = 8, WGM = 8;

__host__ __device__ __forceinline__ int lds_byte(int r, int c) { const int st = (r >> 4) * 2 + (c >> 5), rr = r & 15, cc = c & 31, ob = rr * 64 + cc * 2; return st * 1024 + (ob ^ (((ob >> 9) & 1) << 5)); }
__host__ __device__ __forceinline__ void stage_rc(int b, int& R, int& C) { const int st = b / 1024, sb = b % 1024, swz = sb ^ (((sb >> 9) & 1) << 5); R = (st >> 1) * 16 + swz / 64; C = (st & 1) * 32 + (swz % 64) / 2; }
__host__ __device__ __forceinline__ void stage_rc8(int b, int& R, int& C) { const int blk = b >> 11, rr = (b >> 7) & 15, ps = (b >> 5) & 3, k = (b >> 4) & 1, gl = ps ^ ((rr >> 1) & 3); R = blk * 16 + rr; C = (gl * 2 + k) * 8; }
__host__ __device__ __forceinline__ int perm32(int rho) { const int n = rho >> 4, i = rho & 15; return 8 * (i >> 2) + 4 * n + (i & 3); }

struct Unit { const char* a; const char* b; const char* b2; int pm, pn, x0, x1; };
struct Gemm { int lda, ldb, K; const int* rowidx; };
typedef int i32x8 __attribute__((ext_vector_type(8)));
typedef int i32x4 __attribute__((ext_vector_type(4)));
__device__ __forceinline__ i32x8 pg8_cat(bf16x8 a, bf16x8 b) { const i32x4 x = __builtin_bit_cast(i32x4, a), y = __builtin_bit_cast(i32x4, b); return (i32x8){x[0], x[1], x[2], x[3], y[0], y[1], y[2], y[3]}; }
__device__ __forceinline__ unsigned cvt_pk_bf16(float lo, float hi) { unsigned r; asm volatile("v_cvt_pk_bf16_f32 %0, %1, %2" : "=v"(r) : "v"(lo), "v"(hi)); return r; }

template <class Epi, class Sched, bool ALIGN_EPI = false, bool SP2 = false, bool GATHER = false, bool FP8 = false, bool APAIR = false>
__device__ __forceinline__ void gemm_phase(PG8_LAS unsigned char* lds, const Gemm g, const Sched& S, const Epi& E, const int tid) {
    const int wid = __builtin_amdgcn_readfirstlane(tid >> 6), lane = tid & 63, wr = wid >> 2, wc = wid & 3, fr = lane & 15, fq = lane >> 4;
    const int K = g.K, nt = K / BK;
    unsigned voffA[2], voffB[2];
#pragma unroll
    for (int i = 0; i < 2; ++i) { int R, C; if constexpr (FP8) stage_rc8(tid * 16 + i * 8192, R, C); else stage_rc(tid * 16 + i * 8192, R, C); const int Rb = Epi::PERM ? ((R & ~31) + perm32(R & 31)) : R;
        voffA[i] = APAIR ? (unsigned)((R >> 1) * g.lda * 4 + ((2 * C) >> 6) * 128 + (R & 1) * 64 + ((2 * C) & 63)) : (unsigned)(R * g.lda + C) * 2u; voffB[i] = (unsigned)(Rb * g.ldb + C) * 2u; }
    unsigned gc[2][2] = {{0u, 0u}, {0u, 0u}}, gn[2][2] = {{0u, 0u}, {0u, 0u}}; int gR[2] = {0, 0}, gC[2] = {0, 0};
    if constexpr (GATHER) {
#pragma unroll
        for (int i = 0; i < 2; ++i) { if constexpr (FP8) stage_rc8(tid * 16 + i * 8192, gR[i], gC[i]); else stage_rc(tid * 16 + i * 8192, gR[i], gC[i]); } }
#define PG8_GOFF(dst, pm_) do { _Pragma("unroll") for (int _h = 0; _h < 2; ++_h) _Pragma("unroll") for (int _i = 0; _i < 2; ++_i) { \
        int _r = g.rowidx[(size_t)((pm_) * 256 + _h * 128 + gR[_i]) * 4]; _r = _r < 0 ? 0 : _r; dst[_h][_i] = (unsigned)(_r * g.lda + gC[_i]) * 2u; } } while (0)
    const size_t kstep = (size_t)(BK * 2);
    const size_t kstepA = APAIR ? kstep * 2 : kstep;
    const size_t hstepA = (size_t)HALF * g.lda * 2, hstepB = (size_t)HALF * g.ldb * 2;
    const unsigned ldsw = (unsigned)wid * 1024u;
    const int aoff = FP8 ? (wr * 4) * 2048 + fr * 128 + ((fq ^ ((fr >> 1) & 3)) * 32) : lds_byte(wr * 64 + fr, fq * 8), boff = FP8 ? (wc * 2) * 2048 + fr * 128 + ((fq ^ ((fr >> 1) & 3)) * 32) : lds_byte(wc * 32 + fr, fq * 8);
#define PG8_SA(b, h) (((b) * 2 + (h)) * HTB)
#define PG8_SB(b, h) ((4 + (b) * 2 + (h)) * HTB)
#define PG8_STAGE(bufoff, gbase, voff) do { _Pragma("unroll") for (int _i = 0; _i < 2; ++_i) \
        __builtin_amdgcn_global_load_lds((const unsigned*)((const char*)(gbase) + (voff)[_i]), (PG8_LAS unsigned*)(lds + (bufoff) + ldsw + _i * 8192), 16, 0, 0); } while (0)
#define PG8_STAGE_A(bufoff, tbase, hh, NX) do { if constexpr (GATHER) { _Pragma("unroll") for (int _i = 0; _i < 2; ++_i) { const unsigned _o = (NX) ? gn[hh][_i] : gc[hh][_i]; \
        __builtin_amdgcn_global_load_lds((const unsigned*)((const char*)(tbase) + _o), (PG8_LAS unsigned*)(lds + (bufoff) + ldsw + _i * 8192), 16, 0, 0); } } \
        else { PG8_STAGE(bufoff, (tbase) + (hh) * hstepA, voffA); } } while (0)
#define PG8_LDA(dst, b, h) do { if constexpr (FP8) { _Pragma("unroll") for (int m = 0; m < 4; ++m) dst##8[m] = *(const PG8_LAS i32x8*)(lds + PG8_SA(b, h) + aoff + m * 2048); } \
        else { _Pragma("unroll") for (int m = 0; m < 4; ++m) _Pragma("unroll") for (int k = 0; k < 2; ++k) dst[m][k] = *(const PG8_LAS bf16x8*)(lds + PG8_SA(b, h) + aoff + m * 2048 + k * 1024); } } while (0)
#define PG8_LDB(dst, b, h) do { if constexpr (FP8) { _Pragma("unroll") for (int n = 0; n < 2; ++n) dst##8[n] = *(const PG8_LAS i32x8*)(lds + PG8_SB(b, h) + boff + n * 2048); } \
        else { _Pragma("unroll") for (int n = 0; n < 2; ++n) _Pragma("unroll") for (int k = 0; k < 2; ++k) dst[n][k] = *(const PG8_LAS bf16x8*)(lds + PG8_SB(b, h) + boff + n * 2048 + k * 1024); } } while (0)
#define PG8_MMA(ai, bj, At, Bt) do { __builtin_amdgcn_s_setprio(1); if constexpr (FP8) { _Pragma("unroll") for (int m = 0; m < 4; ++m) _Pragma("unroll") for (int n = 0; n < 2; ++n) \
        asm volatile("v_mfma_scale_f32_16x16x128_f8f6f4 %0, %1, %2, %0, %3, %3 op_sel_hi:[0,0,0]" : "+v"(acc[ai][bj][m][n]) : "v"(Bt##8[n]), "v"(At##8[m]), "v"(pg8_one)); }     \
        else { _Pragma("unroll") for (int m = 0; m < 4; ++m) _Pragma("unroll") for (int n = 0; n < 2; ++n) _Pragma("unroll") for (int k = 0; k < 2; ++k) \
        acc[ai][bj][m][n] = __builtin_amdgcn_mfma_f32_16x16x32_bf16(Bt[n][k], At[m][k], acc[ai][bj][m][n], 0, 0, 0); } __builtin_amdgcn_s_setprio(0); } while (0)
#define PG8_WAIT_V(n) asm volatile("s_waitcnt vmcnt(" #n ")" ::: "memory")
#define PG8_WAIT_L(n) asm volatile("s_waitcnt lgkmcnt(" #n ")" ::: "memory")
#define PG8_BAR __builtin_amdgcn_s_barrier()
#define PG8_SCHED __builtin_amdgcn_sched_barrier(0)
    Unit cur, nxt; int ui = 0;
    if (!S.next(0, cur)) return;
    f32x4 acc[2][2][4][2];
#pragma unroll
    for (int a = 0; a < 2; ++a)
#pragma unroll
        for (int b = 0; b < 2; ++b)
#pragma unroll
            for (int m = 0; m < 4; ++m)
#pragma unroll
                for (int n = 0; n < 2; ++n) acc[a][b][m][n] = (f32x4){0.f, 0.f, 0.f, 0.f};
    const int pg8_one = 0x7f7f7f7f;
    bf16x8 At[4][2], B0[2][2], B1[2][2];
    i32x8 At8[4], B08[2], B18[2];
    const char* cA = cur.a; const char* cB = cur.b; const char* cB2 = cur.b2; const int nth = nt >> 1;
    if constexpr (GATHER) { PG8_GOFF(gc, cur.pm); }
    S.a_ready(cur);
    if constexpr (SP2) {
        PG8_STAGE(PG8_SB(0, 0), cB, voffB); PG8_STAGE(PG8_SB(0, 1), cB + hstepB, voffB); PG8_STAGE_A(PG8_SA(0, 0), cA, 0, false); PG8_STAGE_A(PG8_SA(0, 1), cA, 1, false);
        if (wr == 1) PG8_BAR;
        PG8_WAIT_V(2); PG8_BAR;
        PG8_STAGE(PG8_SB(1, 0), cB + kstep, voffB); PG8_STAGE_A(PG8_SA(1, 0), cA + kstepA, 0, false); PG8_STAGE(PG8_SB(1, 1), cB + hstepB + kstep, voffB);
        PG8_WAIT_V(6); PG8_BAR;
    } else {
        PG8_STAGE(PG8_SB(0, 0), cB, voffB); PG8_STAGE_A(PG8_SA(0, 0), cA, 0, false); PG8_STAGE(PG8_SB(0, 1), cB + hstepB, voffB); PG8_STAGE_A(PG8_SA(0, 1), cA, 1, false);
        if (wr == 1) PG8_BAR;
        PG8_WAIT_V(4); PG8_BAR;
        PG8_STAGE(PG8_SB(1, 0), cB + kstep, voffB); PG8_STAGE_A(PG8_SA(1, 0), cA + kstepA, 0, false); PG8_STAGE(PG8_SB(1, 1), cB + hstepB + kstep, voffB);
        PG8_WAIT_V(6); PG8_BAR;
    }
    for (;;) {
        const bool has_next = S.next(ui + 1, nxt);
        if constexpr (GATHER) { if (has_next) { PG8_GOFF(gn, nxt.pm); } }
        const char* nA = has_next ? nxt.a : cA; const char* nB = has_next ? nxt.b : cB;
#pragma nounroll
        for (int t = 0; t < nt; t += 2) {
            const bool last = (t == nt - 2);
            const char* a1 = cA + (size_t)(t + 1) * kstepA;
            const char* a2 = last ? nA : cA + (size_t)(t + 2) * kstepA; const char* b2 = last ? nB : ((t + 2 < nth) ? cB : cB2) + (size_t)(t + 2) * kstep;
            const char* a3 = a2 + kstepA; const char* b3 = b2 + kstep;
            if (last && has_next) S.a_ready(nxt);
            if constexpr (SP2) {
            PG8_LDB(B0, 0, 0); PG8_LDB(B1, 0, 1); PG8_SCHED; PG8_LDA(At, 0, 0); PG8_STAGE_A(PG8_SA(1, 1), a1, 1, false);
            PG8_WAIT_V(8); PG8_WAIT_L(0); PG8_BAR; PG8_MMA(0, 0, At, B0); PG8_MMA(0, 1, At, B1); PG8_BAR; PG8_SCHED;
            PG8_LDA(At, 0, 1); PG8_STAGE(PG8_SB(0, 0), b2, voffB); PG8_STAGE(PG8_SB(0, 1), b2 + hstepB, voffB); PG8_STAGE_A(PG8_SA(0, 0), a2, 0, last);
            PG8_WAIT_V(8); PG8_WAIT_L(0); PG8_BAR; PG8_MMA(1, 0, At, B0); PG8_MMA(1, 1, At, B1); PG8_BAR; PG8_SCHED;
            PG8_LDB(B0, 1, 0); PG8_LDB(B1, 1, 1); PG8_SCHED; PG8_LDA(At, 1, 0); PG8_STAGE_A(PG8_SA(0, 1), a2, 1, last);
            PG8_WAIT_V(8); PG8_WAIT_L(0); PG8_BAR; PG8_MMA(0, 0, At, B0); PG8_MMA(0, 1, At, B1); PG8_BAR; PG8_SCHED;
            PG8_LDA(At, 1, 1); PG8_STAGE(PG8_SB(1, 0), b3, voffB); PG8_STAGE(PG8_SB(1, 1), b3 + hstepB, voffB); PG8_STAGE_A(PG8_SA(1, 0), a3, 0, last);
            PG8_WAIT_V(8); PG8_WAIT_L(0); PG8_BAR; PG8_MMA(1, 0, At, B0); PG8_MMA(1, 1, At, B1); PG8_BAR; PG8_SCHED;
            } else {
            PG8_LDB(B0, 0, 0); PG8_SCHED; PG8_LDA(At, 0, 0); PG8_STAGE_A(PG8_SA(1, 1), a1, 1, false);
            PG8_WAIT_L(8); PG8_BAR; PG8_WAIT_L(0); PG8_MMA(0, 0, At, B0); PG8_BAR; PG8_SCHED;
            PG8_LDB(B1, 0, 1); PG8_STAGE(PG8_SB(0, 0), b2, voffB);
            PG8_BAR; PG8_WAIT_L(0); PG8_MMA(0, 1, At, B1); PG8_BAR;
            PG8_LDA(At, 0, 1); PG8_STAGE_A(PG8_SA(0, 0), a2, 0, last);
            PG8_BAR; PG8_WAIT_L(0); PG8_MMA(1, 0, At, B0); PG8_BAR; PG8_SCHED;
            PG8_STAGE(PG8_SB(0, 1), b2 + hstepB, voffB);
            PG8_WAIT_V(6); PG8_BAR; PG8_MMA(1, 1, At, B1); PG8_BAR;
            PG8_LDB(B0, 1, 0); PG8_SCHED; PG8_LDA(At, 1, 0); PG8_STAGE_A(PG8_SA(0, 1), a2, 1, last);
            PG8_WAIT_L(8); PG8_BAR; PG8_WAIT_L(0); PG8_MMA(0, 0, At, B0); PG8_BAR; PG8_SCHED;
            PG8_LDB(B1, 1, 1); PG8_STAGE(PG8_SB(1, 0), b3, voffB);
            PG8_BAR; PG8_WAIT_L(0); PG8_MMA(0, 1, At, B1); PG8_BAR;
            PG8_LDA(At, 1, 1); PG8_STAGE_A(PG8_SA(1, 0), a3, 0, last);
            PG8_BAR; PG8_WAIT_L(0); PG8_MMA(1, 0, At, B0); PG8_BAR; PG8_SCHED;
            PG8_STAGE(PG8_SB(1, 1), b3 + hstepB, voffB);
            PG8_WAIT_V(6); PG8_BAR; PG8_MMA(1, 1, At, B1); PG8_BAR;
            }
        }
        if constexpr (FP8) asm volatile("s_nop 15\n\ts_nop 7" ::: "memory");
        if constexpr (ALIGN_EPI) { if (wr == 0) PG8_BAR; }
        if constexpr (!Epi::AFTER_DRAIN) { E(acc, cur, wr, wc, fr, fq); S.done(cur); }
        if (!has_next) break;
#pragma unroll
        for (int a = 0; a < 2; ++a)
#pragma unroll
            for (int b = 0; b < 2; ++b)
#pragma unroll
                for (int m = 0; m < 4; ++m)
#pragma unroll
                    for (int n = 0; n < 2; ++n) acc[a][b][m][n] = (f32x4){0.f, 0.f, 0.f, 0.f};
        cur = nxt; cA = nA; cB = nB; cB2 = nxt.b2; ++ui;
        if constexpr (GATHER) { _Pragma("unroll") for (int _h = 0; _h < 2; ++_h) _Pragma("unroll") for (int _i = 0; _i < 2; ++_i) gc[_h][_i] = gn[_h][_i]; }
        if constexpr (ALIGN_EPI) { if (wr == 1) PG8_BAR; }
    }
    PG8_WAIT_V(0);
    if constexpr (!ALIGN_EPI) { if (wr == 0) PG8_BAR; }
    PG8_BAR;
    if constexpr (Epi::AFTER_DRAIN) { E.fused(acc, cur, wr, wc, fr, fq, lds, wid, lane); S.done(cur); }
#undef PG8_SA
#undef PG8_SB
#undef PG8_STAGE
#undef PG8_LDA
#undef PG8_STAGE_A
#undef PG8_GOFF
#undef PG8_LDB
#undef PG8_MMA
#undef PG8_WAIT_V
#undef PG8_WAIT_L
#undef PG8_BAR
#undef PG8_SCHED
}
}

#include <hip/hip_bf16.h>
#include <cmath>
namespace attn_body {
using bf16=__hip_bfloat16;
using bf16x8=__attribute__((ext_vector_type(8)))short;
using s16x4=__attribute__((ext_vector_type(4)))short;
using f32x16=__attribute__((ext_vector_type(16)))float;
using u32x4=__attribute__((ext_vector_type(4)))unsigned;
constexpr int D=64, QP=3584, KP=3584, VP=3584, OP=1024;
constexpr int NW=8,QBLK=32,QB=QBLK*NW,KVBLK=64;
constexpr int ATTN_UNIT_ROWS=QB;
__device__ __forceinline__ int crow(int r,int hi){return (r&3)+8*(r>>2)+4*hi;}
#define SBAR() __builtin_amdgcn_sched_barrier(0)
__device__ __forceinline__ void cmask(f32x16&p0,f32x16&p1,int jb,int qrel,int hi){
  const float NEG=-INFINITY; int kb=64*jb+4*hi;
  #pragma unroll
  for(int r=0;r<16;++r){int kv=kb+(r&3)+8*(r>>2); if(kv>qrel)p0[r]=NEG; if(kv+32>qrel)p1[r]=NEG;}
}

constexpr int NSLOT=3, SLOTB=8192;
constexpr int LDS_K=0, LDS_V=NSLOT*SLOTB, LDS_WS=2*NSLOT*SLOTB, LDS_OST=LDS_WS+NW*64*4, LDS_BYTES=LDS_OST+NW*4096;
constexpr float C2=0.125f*1.4426950408889634f;
__device__ __forceinline__ void glds16(const void*gsrc,unsigned lds_dst){unsigned keep;
  asm volatile("s_mov_b32 %0, m0\n\ts_mov_b32 m0, %2\n\ts_nop 0\n\tglobal_load_lds_dwordx4 %1, off\n\ts_mov_b32 m0, %0":"=&s"(keep):"v"(gsrc),"s"(lds_dst):"memory");}
__device__ __forceinline__ float max3f(float a,float b,float c){float r;asm("v_max3_f32 %0, %1, %2, %3":"=v"(r):"v"(a),"v"(b),"v"(c));return r;}
__device__ __forceinline__ float max2f(float a,float b){float r;asm("v_max_f32_e32 %0, %1, %2":"=v"(r):"v"(a),"v"(b));return r;}
__device__ __forceinline__ float fadd_s(float a,float b){float r;asm("v_add_f32_e32 %0, %1, %2":"=v"(r):"v"(a),"v"(b));return r;}
__device__ __forceinline__ float fsub_s(float a,float b){float r;asm("v_sub_f32_e32 %0, %1, %2":"=v"(r):"v"(a),"v"(b));return r;}
typedef float f32x2_t __attribute__((ext_vector_type(2))); typedef __bf16 bf16x2_t __attribute__((ext_vector_type(2)));
__device__ __forceinline__ unsigned cvtpk_s(float lo,float hi){f32x2_t v={lo,hi};bf16x2_t b=__builtin_convertvector(v,bf16x2_t);return __builtin_bit_cast(unsigned,b);}
#define WAIT_BAR(N) asm volatile("s_waitcnt vmcnt(" #N ") lgkmcnt(0)\n\ts_barrier":::"memory")

__device__ __forceinline__ void qkt(f32x16&p0,f32x16&p1,const char*Kslot,const bf16x8*qr,const f32x16&negm,int r32,int hi){
  const char*kb=Kslot+hi*1024+r32*16;
  #pragma unroll
  for(int d0=0;d0<4;++d0){
    const bf16x8 b0=*reinterpret_cast<const bf16x8*>(kb+d0*2048);
    const bf16x8 b1=*reinterpret_cast<const bf16x8*>(kb+d0*2048+512);
    if(d0==0){p0=__builtin_amdgcn_mfma_f32_32x32x16_bf16(b0,qr[0],negm,0,0,0);p1=__builtin_amdgcn_mfma_f32_32x32x16_bf16(b1,qr[0],negm,0,0,0);}
    else{p0=__builtin_amdgcn_mfma_f32_32x32x16_bf16(b0,qr[d0],p0,0,0,0);p1=__builtin_amdgcn_mfma_f32_32x32x16_bf16(b1,qr[d0],p1,0,0,0);}}
}
typedef __attribute__((address_space(3))) const char* lds_cptr;
typedef short v4i16_t __attribute__((ext_vector_type(4)));
__device__ __forceinline__ void kload8(bf16x8*kf,lds_cptr kp){
  kf[0]=*(const __attribute__((address_space(3))) bf16x8*)(kp);      kf[1]=*(const __attribute__((address_space(3))) bf16x8*)(kp+512);
  kf[2]=*(const __attribute__((address_space(3))) bf16x8*)(kp+2048); kf[3]=*(const __attribute__((address_space(3))) bf16x8*)(kp+2560);
  kf[4]=*(const __attribute__((address_space(3))) bf16x8*)(kp+4096); kf[5]=*(const __attribute__((address_space(3))) bf16x8*)(kp+4608);
  kf[6]=*(const __attribute__((address_space(3))) bf16x8*)(kp+6144); kf[7]=*(const __attribute__((address_space(3))) bf16x8*)(kp+6656);
}
__device__ __forceinline__ void kload2(bf16x8*kf,lds_cptr kp,int j){ kf[2*j]=*(const __attribute__((address_space(3))) bf16x8*)(kp+j*2048); kf[2*j+1]=*(const __attribute__((address_space(3))) bf16x8*)(kp+j*2048+512); }
__device__ __forceinline__ s16x4 vtr(lds_cptr p){ return __builtin_bit_cast(s16x4,__builtin_amdgcn_ds_read_tr16_b64_v4i16((__attribute__((address_space(3))) v4i16_t*)p)); }
__device__ __forceinline__ float rowmax(const f32x16&p0,const f32x16&p1){
  float a=max3f(p0[0],p0[1],p1[0]),b=max3f(p0[2],p0[3],p1[1]);a=max3f(a,p1[2],p1[3]);
  #pragma unroll
  for(int r=4;r<16;r+=4){a=max3f(a,p0[r],p0[r+1]);b=max3f(b,p0[r+2],p0[r+3]);a=max3f(a,p1[r],p1[r+1]);b=max3f(b,p1[r+2],p1[r+3]);}
  const float m=max2f(a,b);
  auto rr=__builtin_amdgcn_permlane32_swap(__float_as_uint(m),__float_as_uint(m),false,false);
  return max2f(__uint_as_float(rr[0]),__uint_as_float(rr[1]));
}
__device__ __forceinline__ void pv(f32x16*o,int vb,bf16x8 pa0,bf16x8 pa1,bf16x8 pa2,bf16x8 pa3){
  #pragma unroll
  for(int d0=0;d0<2;++d0){s16x4 lo[4],hi[4];
    #pragma unroll
    for(int ks=0;ks<4;++ks){
      asm volatile("ds_read_b64_tr_b16 %0,%1 offset:%c2":"=&v"(lo[ks]):"v"(vb),"i"(d0*4096+ks*1024):"memory");
      asm volatile("ds_read_b64_tr_b16 %0,%1 offset:%c2":"=&v"(hi[ks]):"v"(vb),"i"(d0*4096+ks*1024+512):"memory");}
    asm volatile("s_waitcnt lgkmcnt(0)":::"memory");SBAR();
    #define PK(k) (bf16x8){lo[k][0],lo[k][1],lo[k][2],lo[k][3],hi[k][0],hi[k][1],hi[k][2],hi[k][3]}
    o[d0]=__builtin_amdgcn_mfma_f32_32x32x16_bf16(pa0,PK(0),o[d0],0,0,0);
    o[d0]=__builtin_amdgcn_mfma_f32_32x32x16_bf16(pa1,PK(1),o[d0],0,0,0);
    o[d0]=__builtin_amdgcn_mfma_f32_32x32x16_bf16(pa2,PK(2),o[d0],0,0,0);
    o[d0]=__builtin_amdgcn_mfma_f32_32x32x16_bf16(pa3,PK(3),o[d0],0,0,0);
    #undef PK
  }
}

#ifndef ATTN_STORE16
#define ATTN_STORE16(p,v) (*(u32x4*)(p)=(v))
#endif
template<int THRL> __device__ __forceinline__ void attn_unit(int q0,int NT,const bf16*Qh,const bf16*__restrict__ Kh,const bf16*__restrict__ Vh,bf16*Oh,char*shm,const int tid){
  const int lane=tid&63,r32=lane&31,hi=lane>>5; const int wid=__builtin_amdgcn_readfirstlane(tid>>6);
  const bf16*Qw=Qh+(long)(q0+wid*QBLK)*QP;
  const unsigned lds0=(unsigned)(uintptr_t)shm;
  float*wsf=(float*)(shm+LDS_WS)+wid*64;
  const bf16*ksrc=Kh+(long)lane*KP+wid*8;
  const bf16*vsrc=Vh+(long)(16*(wid&3)+(lane>>2))*VP+(wid>>2)*32+(lane&3)*8;
  const unsigned kdst=lds0+LDS_K+wid*1024, vdst=lds0+LDS_V+wid*1024;
  #define DMA_K(t,slot) glds16(ksrc+(long)(t)*KVBLK*KP,(unsigned)__builtin_amdgcn_readfirstlane(kdst+(slot)))
  #define DMA_V(t,slot) glds16(vsrc+(long)(t)*KVBLK*VP,(unsigned)__builtin_amdgcn_readfirstlane(vdst+(slot)))
  const int vb0=(int)(lds0+LDS_V)+((lane>>4)&1)*32+(lane&3)*8+(4*hi+((lane&15)>>2))*64;
  const char*Kbase=shm+LDS_K; bf16x8 kf[8];
  const lds_cptr shm3=(lds_cptr)shm; const lds_cptr kp0=shm3+LDS_K+hi*1024+r32*16; const lds_cptr vp0=shm3+LDS_V+((lane>>4)&1)*32+(lane&3)*8+(4*hi+((lane&15)>>2))*64;
  DMA_K(0,0);DMA_V(0,0);DMA_K(1,SLOTB);
  bf16x8 qr[4];
  #pragma unroll
  for(int d0=0;d0<4;++d0)qr[d0]=*reinterpret_cast<const bf16x8*>(&Qw[(long)r32*QP+d0*16+hi*8]);
  float mhat=0.f,l_reg=0.f;f32x16 o[2];o[0]=f32x16{};o[1]=f32x16{};f32x16 negm=f32x16{};asm volatile("":"+v"(negm));
  #define CMASK(P0,P1,t) do{}while(0)
  bool resc=false;
  #define START(P0,P1) do{ const float rm=rowmax(P0,P1); resc=false; \
    { const float dl=rm; mhat=fadd_s(mhat,dl); \
      _Pragma("unroll") for(int r=0;r<16;++r){P0[r]=fsub_s(P0[r],dl);P1[r]=fsub_s(P1[r],dl);} \
      _Pragma("unroll") for(int r=0;r<16;++r)negm[r]=-mhat; asm volatile("":"+v"(negm)); } \
    _Pragma("unroll") for(int r=0;r<16;++r)P0[r]=__builtin_amdgcn_exp2f(P0[r]); }while(0)
  #define RESC() do{ if(resc){ asm volatile("s_waitcnt lgkmcnt(0)":::"memory"); \
      _Pragma("unroll") for(int d_=0;d_<2;++d_) _Pragma("unroll") for(int r=0;r<16;++r)o[d_][r]*=wsf[crow(r,hi)]; } }while(0)
  f32x16 pA0,pA1,pB0,pB1;
  int sl_prev=0,sl_cur=0,sl_next=SLOTB;
  #define ROT() do{sl_prev=sl_cur;sl_cur=sl_next;sl_next=(sl_next==(NSLOT-1)*SLOTB)?0:sl_next+SLOTB;}while(0)
  DMA_K(2,2*SLOTB);
  WAIT_BAR(3);
  qkt(pA0,pA1,Kbase,qr,negm,r32,hi);asm volatile("s_nop 15\n\ts_nop 7":"+v"(pA0),"+v"(pA1));CMASK(pA0,pA1,0);
  START(pA0,pA1);
  _Pragma("unroll") for(int r=0;r<16;++r)pA1[r]=__builtin_amdgcn_exp2f(pA1[r]);
  WAIT_BAR(0);
  DMA_K(3,0);DMA_V(1,SLOTB);
  ROT();
  kload8(kf,kp0+sl_cur);
  WAIT_BAR(2);
  s16x4 vlo[8],vhi[8]; u32x4 pw0,pw1,pw2,pw3;
  #define PKW(P,B) cvtpk_s(P[B],P[B+1])
  #define PAF(k) __builtin_bit_cast(bf16x8,pw##k)
  #define VFR(i) (bf16x8){vlo[i][0],vlo[i][1],vlo[i][2],vlo[i][3],vhi[i][0],vhi[i][1],vhi[i][2],vhi[i][3]}
  #define PIN(x) asm volatile("":"+v"(x))
  #define MX3(a,b,c) __builtin_fmaxf(__builtin_fmaxf((a),(b)),(c))
  #define GAPA(MF,A0,A1,A2,A3,W0,W1,PW) do{ MF; sacc+=A0; sacc+=A1; sacc+=A2; sacc+=A3; PIN(sacc); W0; W1; PIN(PW); SBAR(); }while(0)
  #define EX(v) __builtin_amdgcn_exp2f(v)
  #define GAPB(MF,X,B) do{ MF; X[B]=EX(X[B]); X[B+1]=EX(X[B+1]); X[B+2]=EX(X[B+2]); X[B+3]=EX(X[B+3]); PIN(X); SBAR(); }while(0)
  #define VRD(i) do{ vlo[i]=vtr(vp_+(((i)>>2)*4096+((i)&3)*1024)); vhi[i]=vtr(vp_+(((i)>>2)*4096+((i)&3)*1024+512)); }while(0)
  #define KRD(G,j) do{ if(G){ kload2(kf,kp0+sl_next,j); SBAR(); } }while(0)
  #define STEP(C0,C1,P0,P1,t,GK,GV,GL) do{ SBAR(); \
    const lds_cptr vp_=vp0+sl_prev; \
    VRD(0); SBAR(); float sacc=(P0[0]+P0[1]); \
    GAPA(C0=__builtin_amdgcn_mfma_f32_32x32x16_bf16(kf[0],qr[0],negm,0,0,0), P0[2],P0[3],P0[4],P0[5],     pw0[0]=PKW(P0,0), pw0[1]=PKW(P0,2), pw0); \
    VRD(4); SBAR(); GAPA(C1=__builtin_amdgcn_mfma_f32_32x32x16_bf16(kf[1],qr[0],negm,0,0,0), P0[6],P0[7],P0[8],P0[9],     pw0[2]=PKW(P0,4), pw0[3]=PKW(P0,6), pw0); \
    VRD(1); SBAR(); GAPA(C0=__builtin_amdgcn_mfma_f32_32x32x16_bf16(kf[2],qr[1],C0,0,0,0),   P0[10],P0[11],P0[12],P0[13], pw1[0]=PKW(P0,8), pw1[1]=PKW(P0,10), pw1); \
    VRD(5); SBAR(); GAPA(C1=__builtin_amdgcn_mfma_f32_32x32x16_bf16(kf[3],qr[1],C1,0,0,0),   P0[14],P0[15],P1[0],P1[1],   pw1[2]=PKW(P0,12),pw1[3]=PKW(P0,14), pw1); \
    VRD(2); SBAR(); GAPA(C0=__builtin_amdgcn_mfma_f32_32x32x16_bf16(kf[4],qr[2],C0,0,0,0),   P1[2],P1[3],P1[4],P1[5],     pw2[0]=PKW(P1,0), pw2[1]=PKW(P1,2), pw2); \
    VRD(6); SBAR(); GAPA(C1=__builtin_amdgcn_mfma_f32_32x32x16_bf16(kf[5],qr[2],C1,0,0,0),   P1[6],P1[7],P1[8],P1[9],     pw2[2]=PKW(P1,4), pw2[3]=PKW(P1,6), pw2); \
    VRD(3); SBAR(); GAPA(C0=__builtin_amdgcn_mfma_f32_32x32x16_bf16(kf[6],qr[3],C0,0,0,0),   P1[10],P1[11],P1[12],P1[13], pw3[0]=PKW(P1,8), pw3[1]=PKW(P1,10), pw3); \
    VRD(7); SBAR(); GAPA(C1=__builtin_amdgcn_mfma_f32_32x32x16_bf16(kf[7],qr[3],C1,0,0,0),   P1[14],P1[15],0.f,0.f,       pw3[2]=PKW(P1,12),pw3[3]=PKW(P1,14), pw3); \
    l_reg+=sacc; \
    if(GK){DMA_K((t)+3,sl_cur);} if(GV){DMA_V((t)+1,sl_next);} \
    CMASK(C0,C1,t); \
    { float a=MX3(C0[0],C0[1],C1[0]),b=MX3(C0[2],C0[3],C1[1]); a=MX3(a,C1[2],C1[3]); \
      _Pragma("unroll") for(int r=4;r<16;r+=4){a=MX3(a,C0[r],C0[r+1]);b=MX3(b,C0[r+2],C0[r+3]);a=MX3(a,C1[r],C1[r+1]);b=MX3(b,C1[r+2],C1[r+3]);} \
      float rm=__builtin_fmaxf(a,b); { auto rr=__builtin_amdgcn_permlane32_swap(__float_as_uint(rm),__float_as_uint(rm),false,false); rm=__builtin_fmaxf(__uint_as_float(rr[0]),__uint_as_float(rr[1])); } \
      resc=false; \
      if(__builtin_expect(__any(rm>(float)THRL),0)){ const float dl=__builtin_fmaxf(rm,0.f); mhat+=dl; \
        _Pragma("unroll") for(int r=0;r<16;++r){C0[r]-=dl;C1[r]-=dl;} \
        _Pragma("unroll") for(int r=0;r<16;++r)negm[r]=-mhat; asm volatile("":"+v"(negm)); \
        const float f=__builtin_amdgcn_exp2f(-dl); l_reg*=f; if(hi==0)wsf[r32]=f; resc=true; } } \
    SBAR(); \
    GAPB(o[0]=__builtin_amdgcn_mfma_f32_32x32x16_bf16(PAF(0),VFR(0),o[0],0,0,0), C0,0); \
    GAPB(o[1]=__builtin_amdgcn_mfma_f32_32x32x16_bf16(PAF(0),VFR(4),o[1],0,0,0), C0,4); \
    KRD(GL,0); GAPB(o[0]=__builtin_amdgcn_mfma_f32_32x32x16_bf16(PAF(1),VFR(1),o[0],0,0,0), C0,8); \
    KRD(GL,1); GAPB(o[1]=__builtin_amdgcn_mfma_f32_32x32x16_bf16(PAF(1),VFR(5),o[1],0,0,0), C0,12); \
    KRD(GL,2); GAPB(o[0]=__builtin_amdgcn_mfma_f32_32x32x16_bf16(PAF(2),VFR(2),o[0],0,0,0), C1,0); \
    KRD(GL,3); GAPB(o[1]=__builtin_amdgcn_mfma_f32_32x32x16_bf16(PAF(2),VFR(6),o[1],0,0,0), C1,4); \
    GAPB(o[0]=__builtin_amdgcn_mfma_f32_32x32x16_bf16(PAF(3),VFR(3),o[0],0,0,0), C1,8); \
    GAPB(o[1]=__builtin_amdgcn_mfma_f32_32x32x16_bf16(PAF(3),VFR(7),o[1],0,0,0), C1,12); \
    }while(0)
  int t=1;
  #undef CMASK
  #define CMASK(P0,P1,t) do{}while(0)
  for(;t+5<NT;t+=2){
    STEP(pB0,pB1,pA0,pA1,t,true,true,true);     WAIT_BAR(2); RESC(); ROT();
    STEP(pA0,pA1,pB0,pB1,t+1,true,true,true);   WAIT_BAR(2); RESC(); ROT();
  }
  #undef CMASK
  #define CMASK(P0,P1,t) do{}while(0)
  #define ENDW(tt) do{ if((tt)+3<NT){WAIT_BAR(2);} else if((tt)+2<NT){WAIT_BAR(1);} else {WAIT_BAR(0);} }while(0)
  for(;t+1<NT;t+=2){
    STEP(pB0,pB1,pA0,pA1,t,(t+3<NT),(t+1<NT),(t+1<NT));       ENDW(t);   RESC(); ROT();
    STEP(pA0,pA1,pB0,pB1,t+1,(t+4<NT),(t+2<NT),(t+2<NT));     ENDW(t+1); RESC(); ROT();
  }
  STEP(pB0,pB1,pA0,pA1,NT-1,false,false,false); RESC();
  { float sacc=pB0[0]+pB0[1]; _Pragma("unroll") for(int r=2;r<16;++r)sacc+=pB0[r]; _Pragma("unroll") for(int r=0;r<16;++r)sacc+=pB1[r]; l_reg+=sacc;
    pw0=(u32x4){PKW(pB0,0),PKW(pB0,2),PKW(pB0,4),PKW(pB0,6)};pw1=(u32x4){PKW(pB0,8),PKW(pB0,10),PKW(pB0,12),PKW(pB0,14)};pw2=(u32x4){PKW(pB1,0),PKW(pB1,2),PKW(pB1,4),PKW(pB1,6)};pw3=(u32x4){PKW(pB1,8),PKW(pB1,10),PKW(pB1,12),PKW(pB1,14)};
    SBAR(); pv(o,vb0+sl_cur,PAF(0),PAF(1),PAF(2),PAF(3)); }
  #undef PKW
  #undef PAF
  #undef VFR
  #undef PIN
  #undef MX3
  #undef GAPA
  #undef GAPB
  #undef EX
  #undef VRD
  #undef KRD
  #undef STEP
  #undef ENDW
  {float la_=l_reg,lb_=l_reg;asm volatile("s_nop 1\n\tv_permlane32_swap_b32 %0, %1\n\ts_nop 1":"+v"(la_),"+v"(lb_));l_reg=la_+lb_;}
  if(hi==0)wsf[32+r32]=l_reg;asm volatile("s_waitcnt lgkmcnt(0)":::"memory");
  float rli[16];
  #pragma unroll
  for(int r=0;r<16;++r)rli[r]=__builtin_amdgcn_rcpf(wsf[32+crow(r,hi)]);
  bf16*Ow=Oh+(long)(q0+wid*QBLK)*OP;
  { bf16*stg=(bf16*)(shm+LDS_OST)+wid*2048;
    #pragma unroll
    for(int r=0;r<16;++r){const int orow=crow(r,hi);
      #pragma unroll
      for(int d0=0;d0<2;++d0)stg[orow*64+d0*32+r32]=__float2bfloat16(o[d0][r]*rli[r]);}
    asm volatile("s_waitcnt lgkmcnt(0)":::"memory");
    #pragma unroll
#ifdef OUTPROJ_FP8
    #define SATF(x) __builtin_amdgcn_fmed3f((x),-448.0f,448.0f)
    for(int i=0;i<4;++i){const int row=i*8+(lane>>3),ch=lane&7; const u32x4 v=*(const u32x4*)(stg+row*64+ch*8);
      const unsigned vs[4]={v.x,v.y,v.z,v.w}; unsigned o8[2];
      #pragma unroll
      for(int j=0;j<2;++j){int wq=0; wq=__builtin_amdgcn_cvt_pk_fp8_f32(SATF(__builtin_bit_cast(float,vs[2*j]<<16)*4.0f),SATF(__builtin_bit_cast(float,vs[2*j]&0xffff0000u)*4.0f),wq,false);
        wq=__builtin_amdgcn_cvt_pk_fp8_f32(SATF(__builtin_bit_cast(float,vs[2*j+1]<<16)*4.0f),SATF(__builtin_bit_cast(float,vs[2*j+1]&0xffff0000u)*4.0f),wq,true); o8[j]=(unsigned)wq;}
      typedef unsigned u32x2_ __attribute__((ext_vector_type(2)));
      { const int rl=q0+wid*QBLK+row; *(u32x2_*)((unsigned char*)Oh+(long)(rl>>1)*(2*OP)+(rl&1)*64+ch*8)=(u32x2_){o8[0],o8[1]}; } } }
    #undef SATF
#else
    for(int i=0;i<4;++i){const int row=i*8+(lane>>3),ch=lane&7; const u32x4 v=*(const u32x4*)(stg+row*64+ch*8); ATTN_STORE16(Ow+(long)row*OP+ch*8,v);} }
#endif
  asm volatile("s_waitcnt lgkmcnt(0)\n\ts_barrier":::"memory");
  #undef DMA_K
  #undef DMA_V
  #undef CMASK
  #undef START
  #undef RESC
  #undef ROT
}
constexpr int ATTN_LDS_BYTES=LDS_BYTES;
#undef SBAR
#undef WAIT_BAR
}
constexpr int NWAVES = 8, NTHR = 512;
constexpr int NB = 16, T_LAT = 2048, L_CTX = 256, DM = 1024, RPB = T_LAT + L_CTX  , MROWS = NB * RPB  , NPROJ = 3584, DEPTH = 2;
constexpr int NPANEL = MROWS / 256  , PPB = RPB / 256  ;
constexpr float NORM_EPS = 1e-6f;
constexpr int C_HQ = 0, C_HI = 256, C_HZ = 512  , C_HG = 1024, C_CB = 1280, C_CC = 1536, C_CH = 1792, C_RQ = 2048, C_RK = 2304, C_RV = 2560, C_RG = 2816, C_AQ = 3072, C_AK = 3328, C_AV = 3456;
constexpr size_t MiB = 1u << 20;
constexpr size_t WS_CTL = 0, CTL_ZERO_BYTES = 1 * MiB;
constexpr size_t WS_MOD = 1 * MiB;
constexpr size_t WS_ROPE = 2 * MiB;
constexpr size_t WS_ROUTE = 3 * MiB;
constexpr size_t WS_ROWINFO = 4 * MiB;
constexpr size_t WS_BCNT = 5 * MiB;
constexpr size_t WS_TILEINFO = 6 * MiB;
constexpr size_t WS_DBUF = 7 * MiB;
constexpr size_t WS_W0 = 12 * MiB, WLAYER = 33 * MiB;
constexpr size_t WO_WIN = 0;
constexpr size_t WO_WOUT = 7 * MiB;
constexpr size_t WO_WGU = 9 * MiB;
constexpr size_t WO_WD = 25 * MiB;
constexpr size_t WS_CTX = 78 * MiB;
constexpr size_t WS_ACT = 94 * MiB;
constexpr size_t WS_P = 166 * MiB;
constexpr size_t WS_ASORT = WS_P;
constexpr size_t WS_H = WS_P + 84 * MiB;
constexpr size_t WS_KVS = 418 * MiB;
constexpr size_t WS_END = 490 * MiB;
constexpr int MAXTILES = 168;
constexpr int CW_ERR = 16;
constexpr int CW_BAR = 4096;
constexpr int CW_BAR3 = 12288, CW_BAR4 = 16384, CW_BAR5 = 20480;
constexpr int CW_BAR2 = 8192;
constexpr int RING_OFF = 0, RING_BYTES = 139264;
constexpr int LDSCTL_OFF = RING_BYTES, MISC_OFF = LDSCTL_OFF + 320;
constexpr int PTAB_OFF = LDSCTL_OFF + 512;
constexpr int TAB_OFF = LDSCTL_OFF + 1024;
constexpr int LDS_BYTES = 147456;

#define GAS __attribute__((address_space(1)))
#define LAS __attribute__((address_space(3)))
typedef unsigned short bf16;
typedef unsigned v4u __attribute__((ext_vector_type(4)));
typedef unsigned v2u __attribute__((ext_vector_type(2)));
typedef int v4i __attribute__((ext_vector_type(4)));
typedef float f32x4 __attribute__((ext_vector_type(4)));
typedef GAS unsigned gu32;
#define RLX_AGENT __ATOMIC_RELAXED, __HIP_MEMORY_SCOPE_AGENT
#define LDS_WAIT() asm volatile("s_waitcnt lgkmcnt(0)" ::: "memory")
#define VM_WAIT() asm volatile("s_waitcnt vmcnt(0)" ::: "memory")
typedef float pkf32x2_t __attribute__((ext_vector_type(2))); typedef __bf16 pkbf16x2_t __attribute__((ext_vector_type(2)));
__device__ __forceinline__ unsigned pk2(float lo, float hi) { const pkf32x2_t v = {lo, hi}; return __builtin_bit_cast(unsigned, __builtin_convertvector(v, pkbf16x2_t)); }
__device__ __forceinline__ unsigned f2bf(float f) { return pk2(f, 0.f) & 0xffffu; }
__device__ __forceinline__ float bflo(unsigned w) { return __builtin_bit_cast(float, w << 16); }
__device__ __forceinline__ float bfhi(unsigned w) { return __builtin_bit_cast(float, w & 0xffff0000u); }
__device__ __forceinline__ float bf1(bf16 h) { return __builtin_bit_cast(float, (unsigned)h << 16); }
__device__ __forceinline__ unsigned pk4_fp8(float a, float b, float c, float d) { int w = 0; a = __builtin_amdgcn_fmed3f(a, -448.0f, 448.0f); b = __builtin_amdgcn_fmed3f(b, -448.0f, 448.0f); c = __builtin_amdgcn_fmed3f(c, -448.0f, 448.0f); d = __builtin_amdgcn_fmed3f(d, -448.0f, 448.0f);     w = __builtin_amdgcn_cvt_pk_fp8_f32(a, b, w, false); w = __builtin_amdgcn_cvt_pk_fp8_f32(c, d, w, true); return (unsigned)w; }
__device__ __forceinline__ float fp8_dec(unsigned b) { const unsigned s = b >> 7, e = (b >> 3) & 15u, m = b & 7u; const float v = e ? (float)(8u + m) * exp2f((float)e - 10.0f) : (float)m * 0.001953125f; return s ? -v : v; }
__device__ __forceinline__ float siluf(float x) { return x * __builtin_amdgcn_rcpf(1.0f + __expf(-x)); }
__device__ __forceinline__ float sigmf(float x) { return __builtin_amdgcn_rcpf(1.0f + __expf(-x)); }
template <int K> __device__ __forceinline__ float xshf(float v) { static_assert(K >= 1 && K < 32, "xshf"); return __builtin_bit_cast(float, __builtin_amdgcn_ds_swizzle(__builtin_bit_cast(int, v), (K << 10) | 0x1f)); }
template <int K> __device__ __forceinline__ int xshi(int v) { static_assert(K >= 1 && K < 32, "xshi"); return __builtin_amdgcn_ds_swizzle(v, (K << 10) | 0x1f); }
__device__ __forceinline__ void half_swap(float& a, float& b) { asm volatile("s_nop 1\n\tv_permlane32_swap_b32 %0, %1\n\ts_nop 1" : "+v"(a), "+v"(b)); }
__device__ __forceinline__ float half_sum(float v) { float a = v, b = v; half_swap(a, b); return a + b; }
__device__ __forceinline__ float half_max(float v) { float a = v, b = v; half_swap(a, b); return fmaxf(a, b); }
__device__ __forceinline__ float sum16(float v) { v += xshf<1>(v); v += xshf<2>(v); v += xshf<4>(v); v += xshf<8>(v); return v; }
__device__ __forceinline__ float sum32(float v) { v = sum16(v); v += xshf<16>(v); return v; }
__device__ __forceinline__ float wave_sum(float v) { return half_sum(sum32(v)); }
#define XB_TMO      128
#define XB_XCNT(j)  (256  + 64 * (j))
#define XB_XSUB(j)  (1280 + 64 * (j))
#define XB_XGEN(j)  (2304 + 64 * (j))
#define XB_TOP      3328
#define XB_TOPGEN   3392
#define XCD_BAR_WORDS 3456
#define XB_SPIN_CAP (1u << 18)

__device__ __forceinline__ unsigned xb_ld(unsigned* p)              { return __hip_atomic_load(p, __ATOMIC_RELAXED, __HIP_MEMORY_SCOPE_AGENT); }
__device__ __forceinline__ unsigned xb_add(unsigned* p, unsigned v) { return __hip_atomic_fetch_add(p, v, __ATOMIC_RELAXED, __HIP_MEMORY_SCOPE_AGENT); }
__device__ __forceinline__ unsigned xb_xcc_id() { return (unsigned)__builtin_amdgcn_s_getreg((3 << 11) | 20) & 0xFu; }
#define XB_SPIN(cond, bar) do { unsigned _sp = 0; while (cond) { __builtin_amdgcn_s_sleep(1); \
    if ((++_sp & 255u) == 0u) { if (xb_ld(&(bar)[XB_TMO])) break; if (_sp > XB_SPIN_CAP) { atomicAdd(&(bar)[XB_TMO], 1u); break; } } } } while (0)

struct XcdBarrier {
    unsigned* bar; unsigned x;
    volatile LAS unsigned* st;
};

__device__ __forceinline__ XcdBarrier xcd_barrier_post(unsigned* bar, volatile LAS unsigned* st) {
    XcdBarrier b; b.bar = bar; b.x = xb_xcc_id(); b.st = st;
    if (threadIdx.x == 0) (void)xb_add(&bar[XB_XCNT(b.x)], 1u);
    return b;
}
__device__ __forceinline__ void xcd_barrier_complete(unsigned* bar, unsigned x, unsigned& nloc, unsigned& nx) {
    const unsigned G = gridDim.x * gridDim.y * gridDim.z;
    unsigned sum, cnt, mine, sp = 0u;
    for (;;) {
        sum = 0u; cnt = 0u; mine = 0u;
#pragma unroll
        for (unsigned j = 0; j < 16; ++j) { const unsigned c = xb_ld(&bar[XB_XCNT(j)]); sum += c; cnt += (c > 0u) ? 1u : 0u; mine = (j == x) ? c : mine; }
        if (sum == G) break;
        __builtin_amdgcn_s_sleep(1);
        if ((++sp & 255u) == 0u) { if (xb_ld(&bar[XB_TMO])) break; if (sp > XB_SPIN_CAP) { atomicAdd(&bar[XB_TMO], 1u); break; } }
    }
    nloc = mine > 0u ? mine : 1u; nx = cnt > 0u ? cnt : 1u;
}

__device__ __forceinline__ void xcd_barrier(const XcdBarrier& b) {
    asm volatile("s_waitcnt vmcnt(0)" ::: "memory");
    __syncthreads();
    if (threadIdx.x == 0) {
        unsigned* bar = b.bar; asm volatile("" : "+s"(bar));
        __builtin_amdgcn_s_waitcnt(0);
        unsigned nloc = b.st[0], nx = b.st[1];
        if (nloc == 0u) { xcd_barrier_complete(bar, b.x, nloc, nx); b.st[0] = nloc; b.st[1] = nx; }
#ifdef EARLY_WB
        __builtin_amdgcn_fence(__ATOMIC_RELEASE, "agent"); asm volatile("s_waitcnt vmcnt(0)" ::: "memory");
#endif
        const unsigned old = xb_add(&bar[XB_XSUB(b.x)], 1u);
        const unsigned gen = old / nloc;
#ifdef MID_WB
        if (old + 1u - gen * nloc == MID_WB_AT(nloc)) asm volatile("buffer_wbl2 sc1" ::: "memory");
#endif
        if (old + 1u == (gen + 1u) * nloc) {
            __builtin_amdgcn_fence(__ATOMIC_RELEASE, "agent");
            asm volatile("s_waitcnt vmcnt(0)" ::: "memory");
            const unsigned og = xb_add(&bar[XB_TOP], 1u);
            const unsigned tg = og / nx;
#ifdef EARLY_INV
            asm volatile("buffer_inv sc1" ::: "memory");
            if (og + 1u == (tg + 1u) * nx) xb_add(&bar[XB_TOPGEN], 1u);
            else XB_SPIN(xb_ld(&bar[XB_TOPGEN]) == tg, bar);
            asm volatile("" ::: "memory");
#else
            if (og + 1u == (tg + 1u) * nx) xb_add(&bar[XB_TOPGEN], 1u);
            else XB_SPIN(xb_ld(&bar[XB_TOPGEN]) == tg, bar);
            __builtin_amdgcn_fence(__ATOMIC_ACQUIRE, "agent");
#endif
            xb_add(&bar[XB_XGEN(b.x)], 1u);
            asm volatile("s_waitcnt vmcnt(0)" ::: "memory");
        } else {
#ifdef EARLY_INV
            asm volatile("buffer_inv sc1" ::: "memory");
            XB_SPIN(xb_ld(&bar[XB_XGEN(b.x)]) == gen, bar);
            asm volatile("" ::: "memory");
#else
            XB_SPIN(xb_ld(&bar[XB_XGEN(b.x)]) == gen, bar);
            __builtin_amdgcn_fence(__ATOMIC_ACQUIRE, "agent");
#endif
            asm volatile("s_waitcnt vmcnt(0)" ::: "memory");
        }
    }
    __syncthreads();
}

__device__ __forceinline__ void xcd_split_arrive(const XcdBarrier& b, unsigned* bar2) {
    asm volatile("s_waitcnt vmcnt(0)" ::: "memory");
    __syncthreads();
    if (threadIdx.x == 0) {
        unsigned* bar = bar2; asm volatile("" : "+s"(bar));
        __builtin_amdgcn_s_waitcnt(0);
        unsigned nloc = b.st[0], nx = b.st[1];
        if (nloc == 0u) { xcd_barrier_complete(b.bar, b.x, nloc, nx); b.st[0] = nloc; b.st[1] = nx; }
        const unsigned old = xb_add(&bar[XB_XSUB(b.x)], 1u);
        if ((old + 1u) % nloc == 0u) {
            __builtin_amdgcn_fence(__ATOMIC_RELEASE, "agent");
            asm volatile("s_waitcnt vmcnt(0)" ::: "memory");
            const unsigned og = xb_add(&bar[XB_TOP], 1u);
            if ((og + 1u) % nx == 0u) xb_add(&bar[XB_TOPGEN], 1u);
        }
    }
}
__device__ __forceinline__ void xcd_split_wait(const XcdBarrier& b, unsigned* bar2, unsigned target) {
    if (threadIdx.x == 0) {
        unsigned* bar = bar2; asm volatile("" : "+s"(bar));
        XB_SPIN(xb_ld(&bar[XB_TOPGEN]) < target, bar);
        __builtin_amdgcn_fence(__ATOMIC_ACQUIRE, "agent");
        asm volatile("s_waitcnt vmcnt(0)" ::: "memory");
    }
    __syncthreads();
}
struct Args { const float* in[24]; float* out; unsigned char* ws; size_t ws_shift; };
enum { I_X = 0, I_C, I_CTX, I_CCTX, I_ADAW, I_ADAB, I_NMIX, I_NFFN, I_WIN, I_LB, I_HNORM, I_CONVW, I_RDEC, I_RNORM, I_QN, I_KN, I_WOUT, I_RGW, I_RGB, I_REW, I_REB, I_EG, I_EU, I_ED };
struct Frame {
    LAS unsigned char* lds;
    volatile LAS unsigned* MISC;
    gu32* ctl;
    int tid, lane, wave, vcu, G;
    unsigned bart;
};
__device__ __forceinline__ const void* lptr(const Frame& F, int i) {
    const volatile LAS unsigned* t = (const volatile LAS unsigned*)(F.lds + PTAB_OFF) + 2 * i;
    const unsigned lo = __builtin_amdgcn_readfirstlane(t[0]), hi = __builtin_amdgcn_readfirstlane(t[1]);
    return (const void*)(const GAS void*)(((unsigned long long)hi << 32) | lo);
}
#define PIN(i) ((const float*)lptr(F, (i)))
#define POUT ((float*)lptr(F, 24))
#define PWS ((unsigned char*)lptr(F, 25))
__device__ __forceinline__ int row_of_latent(int idx) { return (idx >> 11) * RPB + L_CTX + (idx & 2047); }

__device__ __forceinline__ void transpose_item(const float* W, int N, int k0, int n0, bf16* dst, int DP, LAS float* scr, int lane) {
#pragma unroll
    for (int i = 0; i < 8; ++i) { const int kk = 8 * i + (lane >> 3), nc = 4 * (lane & 7); const f32x4 v = *(const f32x4*)(W + (size_t)(k0 + kk) * N + n0 + nc);
        scr[kk * 33 + nc] = v.x; scr[kk * 33 + nc + 1] = v.y; scr[kk * 33 + nc + 2] = v.z; scr[kk * 33 + nc + 3] = v.w; }
    LDS_WAIT(); asm volatile("" ::: "memory");
    const int c = lane & 7;
#pragma unroll
    for (int j = 0; j < 4; ++j) { const int n = (lane >> 3) + 8 * j; const LAS float* s = scr + (8 * c) * 33 + n;
        v4u o; o.x = pk2(s[0 * 33], s[1 * 33]); o.y = pk2(s[2 * 33], s[3 * 33]); o.z = pk2(s[4 * 33], s[5 * 33]); o.w = pk2(s[6 * 33], s[7 * 33]);
        *(GAS v4u*)(dst + (size_t)n * DP + 8 * c) = o; }
    LDS_WAIT(); asm volatile("" ::: "memory");
}
__device__ __forceinline__ void transpose_item8(const float* W, int N, int k0, int n0, unsigned char* dst, int DP, float scale, LAS float* scr, int lane) {
#pragma unroll
    for (int i = 0; i < 8; ++i) { const int kk = 8 * i + (lane >> 3), nc = 4 * (lane & 7); const f32x4 v = *(const f32x4*)(W + (size_t)(k0 + kk) * N + n0 + nc) * scale;
        scr[kk * 33 + nc] = v.x; scr[kk * 33 + nc + 1] = v.y; scr[kk * 33 + nc + 2] = v.z; scr[kk * 33 + nc + 3] = v.w; }
    LDS_WAIT(); asm volatile("" ::: "memory");
    const int c = lane & 7;
#pragma unroll
    for (int j = 0; j < 4; ++j) { const int n = (lane >> 3) + 8 * j; const LAS float* s = scr + (8 * c) * 33 + n;
        v2u o; o.x = pk4_fp8(s[0 * 33], s[1 * 33], s[2 * 33], s[3 * 33]); o.y = pk4_fp8(s[4 * 33], s[5 * 33], s[6 * 33], s[7 * 33]);
        *(GAS v2u*)(dst + (size_t)n * DP + 8 * c) = o; }
    LDS_WAIT(); asm volatile("" ::: "memory");
}
struct WItem { const float* src; unsigned char* dst; int N, DP, f8, emu; };
__device__ __forceinline__ WItem witem_decode(const Frame& F, int it) {
    constexpr int PER_LAYER = 1792 + 512 + 3 * 4096;
    const int l = it / PER_LAYER; int r = it - l * PER_LAYER; unsigned char* ws = PWS + WS_W0 + (size_t)l * WLAYER; WItem w; w.emu = 0;
    if (r < 1792) { const int kb = r / 112, nb = r % 112; w.src = PIN(I_WIN) + (size_t)l * 1024 * NPROJ + (size_t)kb * 64 * NPROJ + nb * 32; w.N = NPROJ; w.emu = (EMU_TILES >> (nb >> 3)) & 1;
        if ((INPROJ_F8MASK >> (nb >> 3)) & 1) { w.dst = ws + WO_WIN + (size_t)(nb >> 3) * 524288 + (size_t)((nb & 7) * 32) * 1024 + kb * 64; w.DP = 1024; w.f8 = 1; return w; }
        w.dst = ws + WO_WIN + ((size_t)nb * 32 * 1024 + kb * 64) * 2; w.DP = 2048; w.f8 = 0; return w; }
    r -= 1792;
    if (r < 512) { const int kb = r / 32, nb = r % 32; w.src = PIN(I_WOUT) + (size_t)l * 1024 * 1024 + (size_t)kb * 64 * 1024 + nb * 32; w.N = 1024;
#ifdef OUTPROJ_FP8
        w.dst = ws + WO_WOUT + ((size_t)nb * 32 * 1024 + kb * 64); w.DP = 1024; w.f8 = 1; return w; }
#else
        w.dst = ws + WO_WOUT + ((size_t)nb * 32 * 1024 + kb * 64) * 2; w.DP = 2048; w.f8 = 0; return w; }
#endif
    r -= 512;
    if (r < 8192) { const int up = r >= 4096; r -= up * 4096; const int e = r >> 8, rr = r & 255, kb = rr >> 4, nb = rr & 15, n0 = nb * 32;
        const int drow = e * 1024 + (n0 >> 7) * 256 + up * 128 + (n0 & 127);
        w.src = (up ? PIN(I_EU) : PIN(I_EG)) + (size_t)(l * 16 + e) * 1024 * 512 + (size_t)kb * 64 * 512 + n0; w.N = 512; w.dst = ws + WO_WGU + (size_t)drow * 1024 + kb * 64; w.DP = 1024; w.f8 = 1; return w; }
    r -= 8192;
    { const int e = r >> 8, rr = r & 255, kb = rr >> 5, nb = rr & 31, g = e >> 2, el = e & 3;
        w.src = PIN(I_ED) + (size_t)(l * 16 + e) * 512 * 1024 + (size_t)kb * 64 * 1024 + nb * 32; w.N = 1024; w.dst = ws + WO_WD + ((size_t)g * 1024 + nb * 32) * 2048 + el * 512 + kb * 64; w.DP = 2048; w.f8 = 1; return w; }
}
__device__ __forceinline__ void convert_weights_range(Frame& F, int it0, int it1, int gw, int NGW) {
    LAS float* scr = (LAS float*)(F.lds + F.wave * 16384);
    const int lane = F.lane; const int NITEMS = it1;
    if (gw < 0 || it0 + gw >= NITEMS) return;
    gw += it0;
    const int kr = lane >> 3, nc = 4 * (lane & 7);
    WItem cur = witem_decode(F, gw), nxt = cur, nn = cur; f32x4 v[8], vn[8], vnn[8];
#pragma unroll
    for (int i = 0; i < 8; ++i) v[i] = LDNT((const f32x4*)(cur.src + (size_t)(8 * i + kr) * cur.N + nc));
    if (gw + NGW < NITEMS) { nxt = witem_decode(F, gw + NGW);
#pragma unroll
        for (int i = 0; i < 8; ++i) vn[i] = LDNT((const f32x4*)(nxt.src + (size_t)(8 * i + kr) * nxt.N + nc)); }
    for (int it = gw; it < NITEMS; it += NGW) {
        const int it2 = it + 2 * NGW; const bool more = it + NGW < NITEMS, more2 = it2 < NITEMS;
        if (more2) { nn = witem_decode(F, it2);
#pragma unroll
            for (int i = 0; i < 8; ++i) vnn[i] = LDNT((const f32x4*)(nn.src + (size_t)(8 * i + kr) * nn.N + nc)); }
        const float sc = cur.f8 ? 32.0f : 1.0f;
#pragma unroll
        for (int i = 0; i < 8; ++i) { const int kk = 8 * i + kr; const f32x4 x = v[i] * sc; scr[kk * 33 + nc] = x.x; scr[kk * 33 + nc + 1] = x.y; scr[kk * 33 + nc + 2] = x.z; scr[kk * 33 + nc + 3] = x.w; }
        LDS_WAIT(); asm volatile("" ::: "memory");
        const int c = lane & 7;
#pragma unroll
        for (int j = 0; j < 4; ++j) { const int n = (lane >> 3) + 8 * j; const LAS float* s = scr + (8 * c) * 33 + n;
            if (cur.f8) { v2u o; o.x = pk4_fp8(s[0 * 33], s[1 * 33], s[2 * 33], s[3 * 33]); o.y = pk4_fp8(s[4 * 33], s[5 * 33], s[6 * 33], s[7 * 33]); *(GAS v2u*)(cur.dst + (size_t)n * cur.DP + 8 * c) = o; }
            else { v4u o; o.x = pk2(s[0 * 33], s[1 * 33]); o.y = pk2(s[2 * 33], s[3 * 33]); o.z = pk2(s[4 * 33], s[5 * 33]); o.w = pk2(s[6 * 33], s[7 * 33]); *(GAS v4u*)(cur.dst + (size_t)n * cur.DP + 16 * c) = o; } }
        LDS_WAIT(); asm volatile("" ::: "memory");
        if (more) { cur = nxt; nxt = nn;
#pragma unroll
            for (int i = 0; i < 8; ++i) { v[i] = vn[i]; vn[i] = vnn[i]; } }
    }
}

__device__ __forceinline__ void p0_prologue(Frame& F, const XcdBarrier& gbar) {
    unsigned char* ws = PWS;
    {
        LAS float* sc = (LAS float*)(F.lds);
        LAS float* red = (LAS float*)(F.lds + 17 * 4096);
        bool staged = false;
        const float* pC = PIN(I_C); const float* pCC = PIN(I_CCTX); const float* pAW = PIN(I_ADAW); const float* pAB = PIN(I_ADAB); const float* pNM = PIN(I_NMIX); const float* pNF = PIN(I_NFFN);
#ifdef MOD_WIDE
        typedef float f32x3 __attribute__((ext_vector_type(3)));
        for (int it = F.vcu; it < DEPTH * 128; it += F.G) {
            if (!staged) {
                for (int i = F.tid; i < 17 * 1024; i += NTHR) { const float v = (i < 16 * 1024) ? pC[i] : pCC[i - 16 * 1024]; sc[i] = siluf(v); }
                staged = true;
            }
            __syncthreads();
            const int l = it >> 7, cb = it & 127, n0 = cb * 48, nn = F.tid & 15, ks = F.tid >> 4;
            const float* W = pAW + (size_t)l * 1024 * 6144 + n0 + 3 * nn;
            f32x3 acc[17];
#pragma unroll
            for (int m = 0; m < 17; ++m) acc[m] = (f32x3){0.f, 0.f, 0.f};
            for (int k = ks * 32; k < ks * 32 + 32; k += 4) {
                const f32x3 w0 = *(const f32x3*)(W + (size_t)k * 6144), w1 = *(const f32x3*)(W + (size_t)(k + 1) * 6144), w2 = *(const f32x3*)(W + (size_t)(k + 2) * 6144), w3 = *(const f32x3*)(W + (size_t)(k + 3) * 6144);
#pragma unroll
                for (int m = 0; m < 17; ++m) { const f32x4 s4 = *(const LAS f32x4*)(sc + m * 1024 + k); acc[m] += (w0 * s4.x + w1 * s4.y) + (w2 * s4.z + w3 * s4.w); } }
#pragma unroll
            for (int m = 0; m < 17; ++m) { float a = acc[m].x, b = acc[m].y, c3 = acc[m].z; a += xshf<16>(a); b += xshf<16>(b); c3 += xshf<16>(c3); acc[m] = (f32x3){half_sum(a), half_sum(b), half_sum(c3)}; }
            if (F.lane < 16) {
#pragma unroll
                for (int m = 0; m < 17; ++m) { LAS float* rp = red + (F.wave * 17 + m) * 48 + 3 * nn; rp[0] = acc[m].x; rp[1] = acc[m].y; rp[2] = acc[m].z; } }
            __syncthreads();
            for (int i = F.tid; i < 17 * 48; i += NTHR) { const int m = i / 48, n2 = i - m * 48, gcol = n0 + n2; float v = pAB[l * 6144 + gcol];
#pragma unroll
                for (int k2 = 0; k2 < 8; ++k2) v += red[(k2 * 17 + m) * 48 + n2];
                const int kch = gcol >> 10, col = gcol & 1023;
                if (kch == 1) v = pNM[l * 1024 + col] * (1.0f + v);
                if (kch == 4) v = pNF[l * 1024 + col] * (1.0f + v);
                ((float*)(ws + WS_MOD) + (size_t)(l * 6 + kch) * 17 * 1024)[m * 1024 + col] = v; }
        }
#else
        for (int it = F.vcu; it < DEPTH * 192; it += F.G) {
            if (!staged) {
                for (int i = F.tid; i < 17 * 1024; i += NTHR) { const float v = (i < 16 * 1024) ? pC[i] : pCC[i - 16 * 1024]; sc[i] = siluf(v); }
                staged = true;
            }
            __syncthreads();
            const int l = it / 192, cb = it % 192, n0 = cb * 32, nn = F.tid & 31, ks = F.tid >> 5;
            const float* W = pAW + (size_t)l * 1024 * 6144 + n0 + nn;
            float acc[17];
#pragma unroll
            for (int m = 0; m < 17; ++m) acc[m] = 0.f;
            for (int k = ks * 64; k < ks * 64 + 64; k += 4) { const float w0 = W[(size_t)k * 6144], w1 = W[(size_t)(k + 1) * 6144], w2 = W[(size_t)(k + 2) * 6144], w3 = W[(size_t)(k + 3) * 6144];
#pragma unroll
                for (int m = 0; m < 17; ++m) { const f32x4 s4 = *(const LAS f32x4*)(sc + m * 1024 + k); acc[m] += (s4.x * w0 + s4.y * w1) + (s4.z * w2 + s4.w * w3); } }
#pragma unroll
            for (int m = 0; m < 17; ++m) red[(ks * 17 + m) * 32 + nn] = acc[m];
            __syncthreads();
            const int kch = n0 >> 10, cc = n0 & 1023;
            float* MOD = (float*)(ws + WS_MOD) + (size_t)(l * 6 + kch) * 17 * 1024;
            for (int i = F.tid; i < 17 * 32; i += NTHR) { const int m = i >> 5, n2 = i & 31; float v = pAB[l * 6144 + n0 + n2];
#pragma unroll
                for (int k2 = 0; k2 < 16; ++k2) v += red[(k2 * 17 + m) * 32 + n2];
                const int col = cc + n2;
                if (kch == 1) v = pNM[l * 1024 + col] * (1.0f + v);
                if (kch == 4) v = pNF[l * 1024 + col] * (1.0f + v);
                MOD[m * 1024 + col] = v; }
        }
#endif
        __syncthreads();
    }
#ifdef SPLIT_PRO
    xcd_split_arrive(gbar, (unsigned*)(F.ctl + CW_BAR3));
#endif
    {
        float* RC = (float*)(ws + WS_ROPE); float* RS = RC + 2048 * 32;
        for (int i = (F.vcu * NTHR + F.tid); i < 2048 * 32; i += F.G * NTHR) { const int t = i >> 5, f = i & 31; const float pos = (float)((f < 16) ? (t >> 6) : (t & 63));
            const float invf = exp2f(-(float)(f & 15) * (13.287712379549449f / 16.0f)); const float ang = pos * invf; RC[i] = cosf(ang); RS[i] = sinf(ang); }
    }
    __syncthreads();
    convert_weights_range(F, 0, 1792 + 512 + 3 * 4096, F.vcu * NWAVES + F.wave, F.G * NWAVES);
    __syncthreads();
}
__device__ __forceinline__ void phase_norm1(Frame& F, const float* xsrc, const float* csrc, const float* nA, const float* nB, bf16* dst, unsigned char* dst8) {
    const int gw = F.vcu * NWAVES + F.wave, NGW = F.G * NWAVES, RPW = (MROWS + NGW - 1) / NGW;
    const int c0 = 8 * F.lane;
    int curm = -1; f32x4 a[4], bb[4];
#ifdef N1_INTERLEAVE
    (void)RPW; for (int r = gw; r < MROWS; r += NGW) {
#else
    for (int r = gw * RPW; r < (gw + 1) * RPW && r < MROWS; ++r) {
#endif
        const int b = r / RPB, j = r - b * RPB, m = (j < L_CTX) ? 16 : b;
        const float* src = (j < L_CTX) ? csrc + (size_t)(b * L_CTX + j) * DM : xsrc + (size_t)(b * T_LAT + j - L_CTX) * DM;
        if (m != curm) { curm = m;
#pragma unroll
            for (int q = 0; q < 4; ++q) { a[q] = *(const f32x4*)(nA + m * 1024 + c0 + 512 * (q >> 1) + 4 * (q & 1)); bb[q] = *(const f32x4*)(nB + m * 1024 + c0 + 512 * (q >> 1) + 4 * (q & 1)); } }
        f32x4 v[4]; float ss = 0.f;
#pragma unroll
        for (int q = 0; q < 4; ++q) { v[q] = LDNT((const f32x4*)(src + c0 + 512 * (q >> 1) + 4 * (q & 1))); ss += (v[q].x * v[q].x + v[q].y * v[q].y) + (v[q].z * v[q].z + v[q].w * v[q].w); }
        const float rstd = __builtin_amdgcn_rsqf(wave_sum(ss) * (1.0f / DM) + NORM_EPS);
#pragma unroll
        for (int q = 0; q < 2; ++q) { const f32x4 o0 = v[2 * q] * rstd * a[2 * q] + bb[2 * q], o1 = v[2 * q + 1] * rstd * a[2 * q + 1] + bb[2 * q + 1];
            v4u w; w.x = pk2(o0.x, o0.y); w.y = pk2(o0.z, o0.w); w.z = pk2(o1.x, o1.y); w.w = pk2(o1.z, o1.w);
            *(v4u*)(dst + (size_t)r * DM + c0 + 512 * q) = w;
            if (INPROJ_F8MASK) { v2u w8; w8.x = pk4_fp8(o0.x, o0.y, o0.z, o0.w); w8.y = pk4_fp8(o1.x, o1.y, o1.z, o1.w); *(v2u*)(dst8 + (size_t)r * DM + c0 + 512 * q) = w8; } }
    }
}

#ifdef REV_A
#define PREP_ROW(r) (MROWS - 1 - (r))
#else
#define PREP_ROW(r) (r)
#endif
template <bool DRY = false>
__device__ __forceinline__ void phase_prep(Frame& F, bf16* P, const float* qn, const float* kn, const float* RC, const float* RS) {
    const int gw = F.vcu * NWAVES + F.wave, NGW = F.G * NWAVES;
    const int L = F.lane; const bool act = L < 48, isq = L < 32;
    const int col = isq ? C_AQ + 8 * L : C_AK + 8 * (L - 32), e0 = (8 * L) & 63, p0 = e0 >> 1;
    const float* gp = isq ? qn : kn; const f32x4 g0 = *(const f32x4*)(gp + e0), g1 = *(const f32x4*)(gp + e0 + 4);
    constexpr float C2 = 0.125f * 1.4426950408889634f; const float sc = isq ? C2 : 1.0f;
    for (int r0 = gw; r0 < MROWS; r0 += 4 * NGW) {
        v4u wv[4]; f32x4 cs[4], sn[4]; bool ok[4];
#pragma unroll
        for (int u = 0; u < 4; ++u) { const int r = r0 + u * NGW; ok[u] = r < MROWS; const int rr = ok[u] ? PREP_ROW(r) : gw; const int b = rr / RPB, j = rr - b * RPB; const bool lat = j >= L_CTX;
            cs[u] = (f32x4){1.f, 1.f, 1.f, 1.f}; sn[u] = (f32x4){0.f, 0.f, 0.f, 0.f}; if (lat) { cs[u] = *(const f32x4*)(RC + (j - L_CTX) * 32 + p0); sn[u] = *(const f32x4*)(RS + (j - L_CTX) * 32 + p0); }
            wv[u] = act ? *(const v4u*)(P + (size_t)rr * NPROJ + col) : (v4u){0u, 0u, 0u, 0u}; }
#pragma unroll
        for (int u = 0; u < 4; ++u) { const int r = PREP_ROW(r0 + u * NGW);
            const unsigned ww[4] = {wv[u].x, wv[u].y, wv[u].z, wv[u].w}; float x[8]; float ss = 0.f;
#pragma unroll
            for (int i = 0; i < 4; ++i) { x[2 * i] = bflo(ww[i]); x[2 * i + 1] = bfhi(ww[i]); ss += x[2 * i] * x[2 * i] + x[2 * i + 1] * x[2 * i + 1]; }
            ss += xshf<1>(ss); ss += xshf<2>(ss); ss += xshf<4>(ss);
            const float rstd = __builtin_amdgcn_rsqf(ss * (1.0f / 64.0f) + NORM_EPS) * sc;
            const float gg[8] = {g0.x, g0.y, g0.z, g0.w, g1.x, g1.y, g1.z, g1.w}, cc[4] = {cs[u].x, cs[u].y, cs[u].z, cs[u].w}, sv[4] = {sn[u].x, sn[u].y, sn[u].z, sn[u].w};
            unsigned o[4];
#pragma unroll
            for (int i = 0; i < 4; ++i) { const float y1 = x[2 * i] * rstd * gg[2 * i], y2 = x[2 * i + 1] * rstd * gg[2 * i + 1]; o[i] = pk2(y1 * cc[i] - y2 * sv[i], y1 * sv[i] + y2 * cc[i]); }
            if (DRY) { asm volatile("" : "+v"(o[0]), "+v"(o[3])); o[0] = wv[u].x; o[1] = wv[u].y; o[2] = wv[u].z; o[3] = wv[u].w; }
            if (ok[u] && act) *(v4u*)(P + (size_t)r * NPROJ + col) = (v4u){o[0], o[1], o[2], o[3]}; }
    }
}
namespace rc {
constexpr int PT = 144, MB = 64 * PT;
constexpr int O_QP = 0, O_QQ = MB, O_KP = 2 * MB, O_VT = 3 * MB, O_ST = 4 * MB, O_AT = 5 * MB, O_TOT = 6 * MB, SLOT = 6 * MB + 2048;
constexpr int OXP = 68;
typedef float f32x16 __attribute__((ext_vector_type(16)));
typedef float f32x4v __attribute__((ext_vector_type(4)));
typedef short bf16x8 __attribute__((ext_vector_type(8)));
__device__ __forceinline__ int crow(int r, int hi) { return (r & 3) + 8 * (r >> 2) + 4 * hi; }
__device__ __forceinline__ bf16x8 frag32(const LAS unsigned char* M, int row, int kcol, int hi) { return *(const LAS bf16x8*)(M + row * PT + (kcol + hi * 8) * 2); }
__device__ __forceinline__ float clampe(float x) { return fminf(fmaxf(x, -60.f), 60.f); }
__device__ __forceinline__ int seq_of(int mixer, int b, int h, int dir) { return ((mixer * NB + b) * 4 + h) * 2 + dir; }
__device__ __forceinline__ int row_in_batch(int dir, int n) { return (dir == 0) ? n : (n < L_CTX ? (L_CTX - 1 - n) : (RPB + L_CTX - 1 - n)); }
}
struct StageARaw { v4u k[8], v[8]; };
__device__ __forceinline__ void stageA_load(StageARaw& R, const Frame& F, const bf16* P, int mixer, int b, int h, int dir, int c) {
    using namespace rc;
    const int lane = F.lane, r8 = lane >> 3, ch = lane & 7;
    const int ck = (mixer == 0 ? C_HZ + 256 * dir : C_RK) + h * 64 + 8 * ch, cv = (mixer == 0 ? C_HI : C_RV) + h * 64 + 8 * ch;
    const int j0 = row_in_batch(dir, c * 64 + r8); const long step = (dir == 0) ? 8L * NPROJ : -8L * NPROJ;
    const bf16* rp = P + (size_t)(b * RPB + j0) * NPROJ;
#pragma unroll
    for (int i = 0; i < 8; ++i) { R.k[i] = *(const v4u*)(rp + ck); R.v[i] = *(const v4u*)(rp + cv); rp += step; }
}
template <int MIXER>
__device__ __forceinline__ void stageA_compute(const StageARaw& R, Frame& F, bf16* KVS, float* DBUF, int b, int h, int dir, int c, const float* lblog, float gamma) {
    using namespace rc;
    constexpr int HP = 80;
    LAS unsigned char* WL = F.lds + F.wave * 10240; LAS unsigned char* KT = WL; LAS unsigned char* VTm = WL + 5120;
    const int lane = F.lane, seq = seq_of(MIXER, b, h, dir), r8 = lane >> 3, ch = lane & 7;
    unsigned kp[32], vp[32];
    {
        float kk[64];
#pragma unroll
        for (int i = 0; i < 8; ++i) *(LAS v4u*)(WL + (r8 + 8 * i) * PT + 16 * ch) = R.k[i];
#pragma unroll
        for (int s = 0; s < 64; ++s) kk[s] = bf1(*(const LAS unsigned short*)(WL + s * PT + 2 * lane));
        if (MIXER == 0) {
            const float lb = lblog ? sigmf(lblog[512 + dir * 256 + h * 64 + lane] - lblog[dir * 256 + h * 64 + lane]) : 0.f;
            float run = 1.f;
#pragma unroll
            for (int s = 63; s >= 0; --s) { const float f = lb + (1.0f - lb) * sigmf(kk[s]); kk[s] = (1.0f - f) * run; run *= f; }
            DBUF[(size_t)(seq * 36 + c) * 64 + lane] = run;
        } else {
            const float lg2 = __log2f(gamma);
#pragma unroll
            for (int s = 0; s < 64; ++s) kk[s] *= exp2f((float)(63 - s) * lg2);
        }
#pragma unroll
        for (int s = 0; s < 32; ++s) kp[s] = pk2(kk[2 * s], kk[2 * s + 1]);
    }
#pragma unroll
    for (int i = 0; i < 8; ++i) *(LAS v4u*)(WL + (r8 + 8 * i) * PT + 16 * ch) = R.v[i];
#pragma unroll
    for (int s = 0; s < 32; ++s) vp[s] = (unsigned)*(const LAS unsigned short*)(WL + (2 * s) * PT + 2 * lane) | ((unsigned)*(const LAS unsigned short*)(WL + (2 * s + 1) * PT + 2 * lane) << 16);
    const int r = lane & 15, g = lane >> 4;
    f32x4v acc[4][4];
#pragma unroll
    for (int a = 0; a < 4; ++a)
#pragma unroll
        for (int q = 0; q < 4; ++q) acc[a][q] = (f32x4v){0.f, 0.f, 0.f, 0.f};
#pragma unroll
    for (int hh = 0; hh < 2; ++hh) {
#pragma unroll
        for (int i = 0; i < 4; ++i) { const int s0 = 32 * hh + 8 * i; v4u ko, vo;
            ko.x = kp[s0 / 2]; ko.y = kp[s0 / 2 + 1]; ko.z = kp[s0 / 2 + 2]; ko.w = kp[s0 / 2 + 3];
            vo.x = vp[s0 / 2]; vo.y = vp[s0 / 2 + 1]; vo.z = vp[s0 / 2 + 2]; vo.w = vp[s0 / 2 + 3];
            *(LAS v4u*)(KT + lane * HP + 16 * i) = ko; *(LAS v4u*)(VTm + lane * HP + 16 * i) = vo; }
        bf16x8 af[4], bfr[4];
#pragma unroll
        for (int q = 0; q < 4; ++q) { af[q] = *(const LAS bf16x8*)(VTm + (16 * q + r) * HP + 16 * g); bfr[q] = *(const LAS bf16x8*)(KT + (16 * q + r) * HP + 16 * g); }
#pragma unroll
        for (int a = 0; a < 4; ++a)
#pragma unroll
            for (int q = 0; q < 4; ++q) acc[a][q] = __builtin_amdgcn_mfma_f32_16x16x32_bf16(af[a], bfr[q], acc[a][q], 0, 0, 0);
    }
#pragma unroll
    for (int a = 0; a < 4; ++a)
#pragma unroll
        for (int q = 0; q < 4; ++q)
#pragma unroll
            for (int x = 0; x < 4; ++x) *(LAS unsigned short*)(WL + (16 * a + 4 * g + x) * PT + (16 * q + r) * 2) = (unsigned short)f2bf(acc[a][q][x]);
    bf16* dst = KVS + (size_t)(seq * 36 + c) * 4096;
#pragma unroll
    for (int i = 0; i < 8; ++i) { const int idx = lane + 64 * i, e = idx >> 3, d8 = idx & 7; *(v4u*)(dst + e * 64 + d8 * 8) = *(const LAS v4u*)(WL + e * PT + d8 * 16); }
}
__device__ __forceinline__ void recur_stageA_loop(Frame& F, const bf16* P, bf16* KVS, float* DBUF, int u0, int stride, int nunits, const float* lblog, const float* rdec) {
    if (u0 >= nunits) return;
    StageARaw cur;
#define STA_DECODE(u_, it__) const int mh_ = ((u_) + (it__)) & 7, rest_ = (u_) >> 3, c_ = rest_ % 36, bd_ = rest_ / 36, b_ = bd_ >> 1, dir_ = bd_ & 1, mixer_ = mh_ >> 2, h_ = mh_ & 3
    int it = 0;
    for (int u = u0; u < nunits; u += stride, ++it) {
#ifdef REV_A
        STA_DECODE(nunits - 1 - u, it);
#else
        STA_DECODE(u, it);
#endif
        stageA_load(cur, F, P, mixer_, b_, h_, dir_, c_);
        if (mixer_ == 0) stageA_compute<0>(cur, F, KVS, DBUF, b_, h_, dir_, c_, lblog, 0.f);
        else stageA_compute<1>(cur, F, KVS, DBUF, b_, h_, dir_, c_, nullptr, sigmf(rdec[dir_ * 4 + h_]));
    }
#undef STA_DECODE
}
template <int MIXER, bool DRY = false>
__device__ __forceinline__ void recur_stageB_seq(Frame& F, bf16* KVS, const float* DBUF, int seq, float gamma) {
    const int e = F.tid >> 3, d8 = F.tid & 7;
    bf16* base = KVS + (size_t)seq * 36 * 4096 + e * 64 + d8 * 8; const float* db = DBUF + (size_t)seq * 36 * 64 + d8 * 8;
    float S[8];
#pragma unroll
    for (int i = 0; i < 8; ++i) S[i] = 0.f;
    const float g64 = (MIXER == 1) ? exp2f(64.0f * __log2f(gamma)) : 0.f;
    constexpr int GB = 4;
    v4u kv[GB], kvn[GB]; f32x4 da[GB], dbv[GB], dan[GB], dbn[GB];
#pragma unroll
    for (int i = 0; i < GB; ++i) { kv[i] = *(const v4u*)(base + (size_t)i * 4096); da[i] = (f32x4){g64, g64, g64, g64}; dbv[i] = da[i];
        if (MIXER == 0) { da[i] = *(const f32x4*)(db + i * 64); dbv[i] = *(const f32x4*)(db + i * 64 + 4); } }
    for (int c0 = 0; c0 < 36; c0 += GB) {
#pragma unroll
        for (int i = 0; i < GB; ++i) { kvn[i] = kv[i]; dan[i] = da[i]; dbn[i] = dbv[i];
            if (c0 + GB < 36) { kvn[i] = *(const v4u*)(base + (size_t)(c0 + GB + i) * 4096); if (MIXER == 0) { dan[i] = *(const f32x4*)(db + (c0 + GB + i) * 64); dbn[i] = *(const f32x4*)(db + (c0 + GB + i) * 64 + 4); } } }
#pragma unroll
        for (int i = 0; i < GB; ++i) {
            v4u so; so.x = pk2(S[0], S[1]); so.y = pk2(S[2], S[3]); so.z = pk2(S[4], S[5]); so.w = pk2(S[6], S[7]);
            if (DRY) { so = kv[i]; asm volatile("" : "+v"(S[0]), "+v"(S[7])); }
            *(v4u*)(base + (size_t)(c0 + i) * 4096) = so;
            const float dd[8] = {da[i].x, da[i].y, da[i].z, da[i].w, dbv[i].x, dbv[i].y, dbv[i].z, dbv[i].w}; const unsigned kw[4] = {kv[i].x, kv[i].y, kv[i].z, kv[i].w};
#pragma unroll
            for (int q = 0; q < 4; ++q) { S[2 * q] = dd[2 * q] * S[2 * q] + bflo(kw[q]); S[2 * q + 1] = dd[2 * q + 1] * S[2 * q + 1] + bfhi(kw[q]); }
        }
#pragma unroll
        for (int i = 0; i < GB; ++i) { kv[i] = kvn[i]; da[i] = dan[i]; dbv[i] = dbn[i]; }
    }
}
struct StageCRaw { v4u q[2], k[2], v[2]; v4u s0, s1, g; };
template <int MIXER>
__device__ __forceinline__ void stageC_load(StageCRaw& R, const Frame& F, const bf16* P, const bf16* KVS, int b, int h, int tb) {
    using namespace rc;
    const int dir = F.wave >> 2, wq = F.wave & 3, lane = F.lane, tr = lane >> 3, ch = lane & 7;
    const int c = (dir == 0) ? tb : (tb < 4 ? 3 - tb : 39 - tb), seq = seq_of(MIXER, b, h, dir);
    const int cq = (MIXER == 0 ? C_HQ : C_RQ) + h * 64 + 8 * ch, ck = (MIXER == 0 ? C_HZ + 256 * dir : C_RK) + h * 64 + 8 * ch, cv = (MIXER == 0 ? C_HI : C_RV) + h * 64 + 8 * ch;
    const int j0 = row_in_batch(dir, c * 64 + 16 * wq + tr); const long step = (dir == 0) ? 8L * NPROJ : -8L * NPROJ;
    const bf16* rp = P + (size_t)(b * RPB + j0) * NPROJ;
#pragma unroll
    for (int ii = 0; ii < 2; ++ii) { R.q[ii] = *(const v4u*)(rp + cq); R.k[ii] = *(const v4u*)(rp + ck); R.v[ii] = *(const v4u*)(rp + cv); rp += step; }
    const bf16* src = KVS + (size_t)(seq * 36 + c) * 4096; const int t256 = wq * 64 + lane;
    R.s0 = *(const v4u*)(src + (t256 >> 3) * 64 + (t256 & 7) * 8); R.s1 = *(const v4u*)(src + ((t256 + 256) >> 3) * 64 + (t256 & 7) * 8);
    { const int tok = F.tid >> 3, ech = F.tid & 7; R.g = *(const v4u*)(P + (size_t)(b * RPB + tb * 64 + tok) * NPROJ + (MIXER == 0 ? C_HG : C_RG) + h * 64 + 8 * ech); }
}
template <int MIXER>
__device__ __forceinline__ void stageC_compute(const StageCRaw& R, Frame& F, bf16* ACTo, int b, int h, int tb, const float* lblog, const float* rdec, const float* gain) {
    using namespace rc;
    const int dir = F.wave >> 2, wq = F.wave & 3, lane = F.lane, tr = lane >> 3, ch = lane & 7;
    LAS unsigned char* SL = F.lds + dir * SLOT;
    { const int t256 = wq * 64 + lane;
      *(LAS v4u*)(SL + O_ST + (t256 >> 3) * PT + (t256 & 7) * 16) = R.s0; *(LAS v4u*)(SL + O_ST + ((t256 + 256) >> 3) * PT + (t256 & 7) * 16) = R.s1; }
#pragma unroll
    for (int ii = 0; ii < 2; ++ii) { const int t = 16 * wq + tr + 8 * ii; const unsigned vw[4] = {R.v[ii].x, R.v[ii].y, R.v[ii].z, R.v[ii].w};
#pragma unroll
        for (int x = 0; x < 4; ++x) { *(LAS unsigned short*)(SL + O_VT + (8 * ch + 2 * x) * PT + t * 2) = (unsigned short)(vw[x] & 0xffffu); *(LAS unsigned short*)(SL + O_VT + (8 * ch + 2 * x + 1) * PT + t * 2) = (unsigned short)(vw[x] >> 16); } }
    if (MIXER == 0) {
#pragma unroll
        for (int ii = 0; ii < 2; ++ii) { const int t = 16 * wq + tr + 8 * ii; *(LAS v4u*)(SL + O_QP + t * PT + 16 * ch) = R.q[ii]; *(LAS v4u*)(SL + O_KP + t * PT + 16 * ch) = R.k[ii]; }
        float qv[16], kv[16], q2[16];
#pragma unroll
        for (int i = 0; i < 16; ++i) { qv[i] = bf1(*(const LAS unsigned short*)(SL + O_QP + (16 * wq + i) * PT + 2 * lane)); kv[i] = bf1(*(const LAS unsigned short*)(SL + O_KP + (16 * wq + i) * PT + 2 * lane)); }
        const float lb = lblog ? sigmf(lblog[512 + dir * 256 + h * 64 + lane] - lblog[dir * 256 + h * 64 + lane]) : 0.f;
        float lc[16]; float run = 1.f;
#pragma unroll
        for (int i = 0; i < 16; ++i) { const float f = lb + (1.0f - lb) * sigmf(kv[i]); run *= f; lc[i] = run; kv[i] = 1.0f - f; }
        LAS float* TOT = (LAS float*)(SL + O_TOT); TOT[wq * 64 + lane] = run;
        __syncthreads();
        float pre = 1.f;
#pragma unroll
        for (int q = 0; q < 4; ++q) { const float t = TOT[q * 64 + lane]; if (q < wq) pre *= t; }
        const float rmid = __builtin_amdgcn_rcpf(fmaxf(TOT[lane] * TOT[64 + lane], 1e-30f));
#pragma unroll
        for (int i = 0; i < 16; ++i) { const float pt = pre * lc[i]; q2[i] = qv[i] * pt; const float e1 = fminf(fmaxf(pt * rmid, 1e-30f), 1e30f); qv[i] *= e1; kv[i] *= __builtin_amdgcn_rcpf(e1); }
#pragma unroll
        for (int i = 0; i < 16; ++i) { const int t = 16 * wq + i;
            *(LAS unsigned short*)(SL + O_QP + t * PT + lane * 2) = (unsigned short)f2bf(qv[i]);
            *(LAS unsigned short*)(SL + O_KP + t * PT + lane * 2) = (unsigned short)f2bf(kv[i]);
            *(LAS unsigned short*)(SL + O_QQ + t * PT + lane * 2) = (unsigned short)f2bf(q2[i]); }
    } else {
        const float lg2 = __log2f(sigmf(rdec[dir * 4 + h]));
#pragma unroll
        for (int ii = 0; ii < 2; ++ii) { const int t = 16 * wq + tr + 8 * ii; const float gq = exp2f((float)(t + 1) * lg2) * 0.125f;
            const unsigned qw[4] = {R.q[ii].x, R.q[ii].y, R.q[ii].z, R.q[ii].w}; v4u q1, q2v;
            { unsigned o1[4], o2[4];
#pragma unroll
              for (int x = 0; x < 4; ++x) { const float lo = bflo(qw[x]), hi2 = bfhi(qw[x]); o1[x] = pk2(lo * 0.125f, hi2 * 0.125f); o2[x] = pk2(lo * gq, hi2 * gq); }
              q1 = (v4u){o1[0], o1[1], o1[2], o1[3]}; q2v = (v4u){o2[0], o2[1], o2[2], o2[3]}; }
            *(LAS v4u*)(SL + O_QP + t * PT + 16 * ch) = q1; *(LAS v4u*)(SL + O_QQ + t * PT + 16 * ch) = q2v; *(LAS v4u*)(SL + O_KP + t * PT + 16 * ch) = R.k[ii]; }
    }
    __syncthreads();
    const int ti = wq >> 1, tj = wq & 1, r32 = lane & 31, hi = lane >> 5;
    if (tj <= ti) {
        f32x16 a = {0.f, 0.f, 0.f, 0.f, 0.f, 0.f, 0.f, 0.f, 0.f, 0.f, 0.f, 0.f, 0.f, 0.f, 0.f, 0.f};
#pragma unroll
        for (int kkk = 0; kkk < 4; ++kkk) a = __builtin_amdgcn_mfma_f32_32x32x16_bf16(frag32(SL + O_QP, 32 * ti + r32, 16 * kkk, hi), frag32(SL + O_KP, 32 * tj + r32, 16 * kkk, hi), a, 0, 0, 0);
        const float lg2 = (MIXER == 1) ? __log2f(sigmf(rdec[dir * 4 + h])) : 0.f;
#pragma unroll
        for (int r = 0; r < 16; ++r) { const int dt = 32 * (ti - tj) + crow(r, hi) - r32; float val = a[r];
            if (MIXER == 1) val *= exp2f((float)dt * lg2);
            if (dt < 0) val = 0.f;
            *(LAS unsigned short*)(SL + O_AT + (32 * ti + crow(r, hi)) * PT + (32 * tj + r32) * 2) = (unsigned short)f2bf(val); }
    }
    __syncthreads();
    f32x16 o = {0.f, 0.f, 0.f, 0.f, 0.f, 0.f, 0.f, 0.f, 0.f, 0.f, 0.f, 0.f, 0.f, 0.f, 0.f, 0.f};
#pragma unroll
    for (int st = 0; st < 2; ++st) if (st <= ti) {
#pragma unroll
        for (int kkk = 0; kkk < 2; ++kkk) o = __builtin_amdgcn_mfma_f32_32x32x16_bf16(frag32(SL + O_AT, 32 * ti + r32, 32 * st + 16 * kkk, hi), frag32(SL + O_VT, 32 * tj + r32, 32 * st + 16 * kkk, hi), o, 0, 0, 0); }
#pragma unroll
    for (int kkk = 0; kkk < 4; ++kkk) o = __builtin_amdgcn_mfma_f32_32x32x16_bf16(frag32(SL + O_QQ, 32 * ti + r32, 16 * kkk, hi), frag32(SL + O_ST, 32 * tj + r32, 16 * kkk, hi), o, 0, 0, 0);
    { LAS unsigned char* OX = F.lds + 2 * SLOT + dir * MB;
#pragma unroll
      for (int r = 0; r < 16; ++r) *(LAS unsigned short*)(OX + (32 * ti + crow(r, hi)) * PT + (32 * tj + r32) * 2) = (unsigned short)f2bf(o[r]); }
    __syncthreads();
    { const int tok = F.tid >> 3, ech = F.tid & 7, row = b * RPB + tb * 64 + tok;
      const v4u fw = *(const LAS v4u*)(F.lds + 2 * SLOT + tok * PT + 16 * ech), bw = *(const LAS v4u*)(F.lds + 2 * SLOT + MB + (63 - tok) * PT + 16 * ech);
      const unsigned fws[4] = {fw.x, fw.y, fw.z, fw.w}, bws[4] = {bw.x, bw.y, bw.z, bw.w};
      float ov[8]; float ss = 0.f;
#pragma unroll
      for (int i = 0; i < 4; ++i) { ov[2 * i] = bflo(fws[i]) + bflo(bws[i]); ov[2 * i + 1] = bfhi(fws[i]) + bfhi(bws[i]); ss += ov[2 * i] * ov[2 * i] + ov[2 * i + 1] * ov[2 * i + 1]; }
      ss += xshf<1>(ss); ss += xshf<2>(ss); ss += xshf<4>(ss);
      const float rs = __builtin_amdgcn_rsqf(ss * (1.0f / 64.0f) + NORM_EPS);
      const f32x4 ga = *(const f32x4*)(gain + h * 64 + 8 * ech), gb = *(const f32x4*)(gain + h * 64 + 8 * ech + 4);
      const float gg[8] = {ga.x, ga.y, ga.z, ga.w, gb.x, gb.y, gb.z, gb.w}; const unsigned gws[4] = {R.g.x, R.g.y, R.g.z, R.g.w};
      float res[8];
#pragma unroll
      for (int i = 0; i < 4; ++i) { res[2 * i] = ov[2 * i] * rs * gg[2 * i] * siluf(bflo(gws[i])); res[2 * i + 1] = ov[2 * i + 1] * rs * gg[2 * i + 1] * siluf(bfhi(gws[i])); }
#ifdef OUTPROJ_FP8
      v2u w2; w2.x = pk4_fp8(res[0] * 4.0f, res[1] * 4.0f, res[2] * 4.0f, res[3] * 4.0f); w2.y = pk4_fp8(res[4] * 4.0f, res[5] * 4.0f, res[6] * 4.0f, res[7] * 4.0f);
      *(v2u*)((unsigned char*)ACTo + (size_t)(row >> 1) * 2048 + ((MIXER == 0 ? 0 : 8) + h) * 128 + (row & 1) * 64 + 8 * ech) = w2; }
#else
      v4u w4; w4.x = pk2(res[0], res[1]); w4.y = pk2(res[2], res[3]); w4.z = pk2(res[4], res[5]); w4.w = pk2(res[6], res[7]);
      *(v4u*)(ACTo + (size_t)row * DM + (MIXER == 0 ? 0 : 512) + h * 64 + 8 * ech) = w4; }
#endif
}
__device__ __forceinline__ void recur_stageC_loop(Frame& F, const bf16* P, const bf16* KVS, bf16* ACTo, int mh0, int ub0, int stride, int nub, int ntb, int tboff, const float* lblog, const float* rdec, const float* hn, const float* rn) {
    if (ub0 >= nub) return;
    StageCRaw cur, nxt;
    { const int mh = mh0 & 7; if ((mh >> 2) == 0) stageC_load<0>(cur, F, P, KVS, ub0 / ntb, mh & 3, tboff + ub0 % ntb); else stageC_load<1>(cur, F, P, KVS, ub0 / ntb, mh & 3, tboff + ub0 % ntb); }
    int i = 0;
    for (int ub = ub0; ub < nub; ub += stride, ++i) {
        const int un = ub + stride; const bool more = un < nub; const int mh = (mh0 + i) & 7, mhn = (mh0 + i + 1) & 7;
        if (more) { if ((mhn >> 2) == 0) stageC_load<0>(nxt, F, P, KVS, un / ntb, mhn & 3, tboff + un % ntb); else stageC_load<1>(nxt, F, P, KVS, un / ntb, mhn & 3, tboff + un % ntb); }
        if ((mh >> 2) == 0) stageC_compute<0>(cur, F, ACTo, ub / ntb, mh & 3, tboff + ub % ntb, lblog, rdec, hn);
        else stageC_compute<1>(cur, F, ACTo, ub / ntb, mh & 3, tboff + ub % ntb, nullptr, rdec, rn);
        if (more) cur = nxt;
    }
}
__device__ __forceinline__ void phase_conv(Frame& F, const bf16* P, bf16* ACTo, const float* convw, bool latent_only) {
    const int gw = F.vcu * NWAVES + F.wave, NGW = F.G * NWAVES, rsel = F.lane >> 5, c0 = 8 * (F.lane & 31);
    f32x4 w0[2], w1[2], w2[2];
#pragma unroll
    for (int hf = 0; hf < 2; ++hf) { w0[hf] = *(const f32x4*)(convw + c0 + 4 * hf); w1[hf] = *(const f32x4*)(convw + 256 + c0 + 4 * hf); w2[hf] = *(const f32x4*)(convw + 512 + c0 + 4 * hf); }
    const int nrows = latent_only ? NB * T_LAT : MROWS;
    auto ld8 = [](const bf16* p, f32x4& a, f32x4& b) { const v4u w = *(const v4u*)p; a = (f32x4){bflo(w.x), bfhi(w.x), bflo(w.y), bfhi(w.y)}; b = (f32x4){bflo(w.z), bfhi(w.z), bflo(w.w), bfhi(w.w)}; };
    for (int idx2 = gw; 2 * idx2 < nrows; idx2 += NGW) {
        const int idx = 2 * idx2 + rsel;
        const int r = latent_only ? row_of_latent(idx) : idx;
        const int b = r / RPB, j = r - b * RPB;
        const bf16* row = P + (size_t)r * NPROJ;
        const bool first = (j == 0) || (j == L_CTX), last = (j == L_CTX - 1) || (j == RPB - 1);
        f32x4 ca, cb, ha, hb, u1a, u1b, u0a = (f32x4){0.f, 0.f, 0.f, 0.f}, u0b = u0a, u2a = u0a, u2b = u0a;
        ld8(row + C_CC + c0, ca, cb); ld8(row + C_CH + c0, ha, hb); u1a = ca * ha; u1b = cb * hb;
        if (!first) { ld8(row - NPROJ + C_CC + c0, ca, cb); ld8(row - NPROJ + C_CH + c0, ha, hb); u0a = ca * ha; u0b = cb * hb; }
        if (!last) { ld8(row + NPROJ + C_CC + c0, ca, cb); ld8(row + NPROJ + C_CH + c0, ha, hb); u2a = ca * ha; u2b = cb * hb; }
        f32x4 ba, bb2; ld8(row + C_CB + c0, ba, bb2);
        const f32x4 xa = ba * (w0[0] * u0a + w1[0] * u1a + w2[0] * u2a), xb = bb2 * (w0[1] * u0b + w1[1] * u1b + w2[1] * u2b);
#ifdef OUTPROJ_FP8
        { const f32x4 ya = xa * 4.0f, yb = xb * 4.0f; v2u w2; w2.x = pk4_fp8(ya.x, ya.y, ya.z, ya.w); w2.y = pk4_fp8(yb.x, yb.y, yb.z, yb.w); *(v2u*)((unsigned char*)ACTo + (size_t)(r >> 1) * 2048 + (4 + (c0 >> 6)) * 128 + (r & 1) * 64 + (c0 & 63)) = w2; }
#else
        v4u w; w.x = pk2(xa.x, xa.y); w.y = pk2(xa.z, xa.w); w.z = pk2(xb.x, xb.y); w.w = pk2(xb.z, xb.w); *(v4u*)(ACTo + (size_t)r * DM + 256 + c0) = w;
#endif
    }
}
struct DenseOrder {
    int nM, nN, nwg, G, c, latent_only; const char* A; const char* Bt; size_t tA, tB; unsigned long long pnmap;
    __device__ __forceinline__ void init(int nM_, int nN_, int G_, int c_, int lat, const void* A_, const void* Bt_, int lda, int ldb) {
        nM = nM_; nN = nN_; nwg = nM * nN; G = G_; c = c_; latent_only = lat; A = (const char*)A_; Bt = (const char*)Bt_; tA = (size_t)256 * lda * 2; tB = (size_t)256 * ldb * 2; pnmap = 0xFEDCBA9876543210ull; }
    __device__ __forceinline__ bool next(int i, pg8::Unit& u) const {
        const long L = (long)i * G + c; if (L >= nwg) return false;
        int wgid = (int)L; { const int q = nwg / pg8::NXCD, r = nwg % pg8::NXCD, xcd = wgid % pg8::NXCD, off = wgid / pg8::NXCD; wgid = (xcd < r ? xcd * (q + 1) : r * (q + 1) + (xcd - r) * q) + off; }
#ifndef DENSE_WGM
#define DENSE_WGM 8
#endif
        const int nig = DENSE_WGM * nN, gid = wgid / nig, fm = gid * DENSE_WGM, gsz = (nM - fm) < DENSE_WGM ? (nM - fm) : DENSE_WGM;
        int pm = fm + ((wgid % nig) % gsz); const int pn = (int)((pnmap >> (4 * ((wgid % nig) / gsz))) & 15ull);
        if (latent_only) pm = (pm >> 3) * PPB + 1 + (pm & 7);
        u.pm = pm; u.pn = pn; u.x0 = 0; u.x1 = 0; u.a = A + (size_t)pm * tA; u.b = Bt + (size_t)pn * tB; u.b2 = u.b; return true; }
    __device__ __forceinline__ void a_ready(const pg8::Unit&) const {}
    __device__ __forceinline__ void done(const pg8::Unit&) const {}
};
struct MoeOrder {
    int ncol, nwg, G, c, down, pm0; const LAS int* tileb; const char* A; const char* W;
    __device__ __forceinline__ bool next(int i, pg8::Unit& u) const {
        const long L = (long)i * G + c; if (L >= nwg) return false;
        int w = (int)L; { const int q = nwg / pg8::NXCD, r = nwg % pg8::NXCD, xcd = w % pg8::NXCD, off = w / pg8::NXCD; w = (xcd < r ? xcd * (q + 1) : r * (q + 1) + (xcd - r) * q) + off; }
        const int pm = pm0 + w / ncol, pc = w % ncol;
        const int k = __builtin_amdgcn_readfirstlane(tileb[pm]), g = k / 6, pr = k % 6;
        const int ea = pr < 3 ? 0 : (pr < 5 ? 1 : 2), eb = pr < 3 ? pr + 1 : (pr < 5 ? pr - 1 : 3);
        u.pm = pm; u.pn = pc; u.x0 = 0; u.x1 = 0; u.a = down ? A + (size_t)pm * 256 * 1024 : A;
        if (!down) { const int e = g * 4 + (pc < 4 ? ea : eb); u.b = W + (size_t)(e * 4 + (pc & 3)) * 256 * 1024; u.b2 = u.b; }
        else { const char* base = W + (size_t)(g * 1024 + pc * 256) * 2048; u.b = base + ea * 512; u.b2 = base + eb * 512 - 512; }
        return true; }
    __device__ __forceinline__ void a_ready(const pg8::Unit&) const {}
    __device__ __forceinline__ void done(const pg8::Unit&) const {}
};
struct EpiStore {
    static constexpr bool PERM = true, AFTER_DRAIN = false;
    bf16* O; int ldc; float sc;
    __device__ __forceinline__ void operator()(const f32x4 (&acc)[2][2][4][2], const pg8::Unit& u, int wr, int wc, int fr, int fq) const {
        const int row0 = u.pm * 256 + wr * 64 + fr, col0 = u.pn * 256 + wc * 32 + 8 * fq;
#pragma unroll
        for (int ai = 0; ai < 2; ++ai)
#pragma unroll
            for (int m = 0; m < 4; ++m) { bf16* rowp = O + (size_t)(row0 + ai * 128 + m * 16) * ldc + col0;
#pragma unroll
                for (int bj = 0; bj < 2; ++bj) { const f32x4 v0 = acc[ai][bj][m][0] * sc, v1 = acc[ai][bj][m][1] * sc;
                    v4u w; w.x = pg8::cvt_pk_bf16(v0[0], v0[1]); w.y = pg8::cvt_pk_bf16(v0[2], v0[3]); w.z = pg8::cvt_pk_bf16(v1[0], v1[1]); w.w = pg8::cvt_pk_bf16(v1[2], v1[3]);
                    *(v4u*)(rowp + bj * 128) = w; } }
    }
};
struct EpiResid {
    static constexpr bool PERM = false, AFTER_DRAIN = false;
    const float* xsrc; const float* csrc; float* xdst; float* cdst; const float* gate; float sc;
    __device__ __forceinline__ void operator()(const f32x4 (&acc)[2][2][4][2], const pg8::Unit& u, int wr, int wc, int fr, int fq) const {
        const int b = u.pm / PPB, pj = u.pm - b * PPB; const bool isc = pj == 0;
        const float* src = isc ? csrc + (size_t)b * L_CTX * DM : xsrc + (size_t)(b * T_LAT + (pj - 1) * 256) * DM;
        float* dst = isc ? cdst + (size_t)b * L_CTX * DM : xdst + (size_t)(b * T_LAT + (pj - 1) * 256) * DM;
        const int col0 = u.pn * 256 + wc * 32 + 4 * fq; const float* gp = gate + (isc ? 16 : b) * 1024 + col0;
        f32x4 gv[2][2];
#pragma unroll
        for (int bj = 0; bj < 2; ++bj)
#pragma unroll
            for (int n = 0; n < 2; ++n) gv[bj][n] = *(const f32x4*)(gp + bj * 128 + n * 16) * sc;
#pragma unroll
        for (int ai = 0; ai < 2; ++ai)
#pragma unroll
            for (int m = 0; m < 4; ++m) { const size_t off = (size_t)(ai * 128 + wr * 64 + m * 16 + fr) * DM + col0;
#pragma unroll
                for (int bj = 0; bj < 2; ++bj)
#pragma unroll
                    for (int n = 0; n < 2; ++n) *(f32x4*)(dst + off + bj * 128 + n * 16) = LDNT((const f32x4*)(src + off + bj * 128 + n * 16)) + gv[bj][n] * acc[ai][bj][m][n];
                if (m & 1) asm volatile("" ::: "memory"); }
    }
};
struct EpiGateUp {
    static constexpr bool PERM = true, AFTER_DRAIN = false;
    unsigned char* H; const v4i* rowinfo;
    __device__ __forceinline__ void operator()(const f32x4 (&acc)[2][2][4][2], const pg8::Unit& u, int wr, int wc, int fr, int fq) const {
        const int pos0 = u.pm * 256 + wr * 64 + fr, col0 = u.pn * 128 + wc * 32 + 8 * fq; const bool second = u.pn >= 4;
#pragma unroll
        for (int ai = 0; ai < 2; ++ai)
#pragma unroll
            for (int m = 0; m < 4; ++m) { const int pos = pos0 + ai * 128 + m * 16; const v4i ri = rowinfo[pos];
                const float w = __builtin_bit_cast(float, second ? ri.z : ri.y) * (16.0f / 32.0f);
                const f32x4 g0 = acc[ai][0][m][0] * (1.0f / 32.0f), g1 = acc[ai][0][m][1] * (1.0f / 32.0f), u0 = acc[ai][1][m][0], u1 = acc[ai][1][m][1];
                float h[8];
#pragma unroll
                for (int i = 0; i < 4; ++i) { h[i] = siluf(g0[i]) * u0[i] * w; h[4 + i] = siluf(g1[i]) * u1[i] * w; }
                v2u o; o.x = pk4_fp8(h[0], h[1], h[2], h[3]); o.y = pk4_fp8(h[4], h[5], h[6], h[7]);
                *(v2u*)(H + (size_t)pos * 1024 + col0) = o; }
    }
};
struct EpiDown {
    static constexpr bool PERM = false, AFTER_DRAIN = false;
    float* xdst; float* cdst; const float* gate; const v4i* rowinfo;
    __device__ __forceinline__ void operator()(const f32x4 (&acc)[2][2][4][2], const pg8::Unit& u, int wr, int wc, int fr, int fq) const {
        const int pos0 = u.pm * 256 + wr * 64 + fr, col0 = u.pn * 256 + wc * 32 + 4 * fq;
#pragma unroll
        for (int ai = 0; ai < 2; ++ai)
#pragma unroll
            for (int m = 0; m < 4; ++m) { const int r = rowinfo[pos0 + ai * 128 + m * 16].x;
#ifdef ZERO_MOE
                if (false) {
#else
                if (r >= 0) {
#endif
                    const int b = r / RPB, j = r - b * RPB; const bool isc = j < L_CTX;
                    float* dst = (isc ? cdst + (size_t)(b * L_CTX + j) * DM : xdst + (size_t)(b * T_LAT + j - L_CTX) * DM) + col0;
                    const float* gp = gate + (isc ? 16 : b) * 1024 + col0;
#pragma unroll
                    for (int bj = 0; bj < 2; ++bj)
#pragma unroll
                        for (int n = 0; n < 2; ++n) { float* p = dst + bj * 128 + n * 16; *(f32x4*)p = LDNT((const f32x4*)p) + *(const f32x4*)(gp + bj * 128 + n * 16) * (acc[ai][bj][m][n] * (1.0f / 512.0f)); } }
                if (m & 1) asm volatile("" ::: "memory"); }
    }
};

__device__ __forceinline__ void phase_norm2_route(Frame& F, int layer, const float* xsrc, const float* csrc, const float* nA, const float* nB, bf16* dst, bool latent_only) {
    typedef short bf16x8v __attribute__((ext_vector_type(8))); typedef float f32x4v __attribute__((ext_vector_type(4)));
    unsigned char* const ws = PWS;
    LAS int* cnt = (LAS int*)(F.lds + TAB_OFF);
    LAS float* MA = (LAS float*)(F.lds); LAS float* MBv = MA + 2048;
    LAS float* SSP = MA + 4096;
    LAS float* PART = SSP + 128;
    LAS float* LOG = PART + 8 * 16 * 32;
    const int lane = F.lane, wv = F.wave, r16 = lane & 15, g = lane >> 4, k0w = 128 * wv;
    const int nrows = latent_only ? NB * T_LAT : MROWS, NGW = F.G * NWAVES, RPW = (nrows + NGW - 1) / NGW, RPBLK = NWAVES * RPW;
    const int ib0 = (int)blockIdx.x * RPBLK, ib1 = (ib0 + RPBLK < nrows) ? ib0 + RPBLK : nrows;
    int mfirst = 0, mlast = 0;
    if (ib0 < ib1) { const int ra = latent_only ? row_of_latent(ib0) : ib0, rb = latent_only ? row_of_latent(ib1 - 1) : ib1 - 1;
      const int ba = ra / RPB, ja = ra - ba * RPB, bb_ = rb / RPB, jb = rb - bb_ * RPB; mfirst = (ja < L_CTX) ? 16 : ba; mlast = (jb < L_CTX) ? 16 : bb_; }
    for (int i = F.tid; i < 512; i += NTHR) { const int sl = i >> 8, c4 = (i & 255) * 4, mm = sl ? mlast : mfirst;
        *(LAS f32x4*)(MA + sl * 1024 + c4) = *(const f32x4*)(nA + mm * 1024 + c4); *(LAS f32x4*)(MBv + sl * 1024 + c4) = *(const f32x4*)(nB + mm * 1024 + c4); }
    if (F.tid < 24) cnt[F.tid] = 0;
    bf16x8v Bh[4][2], Bl[4][2];
    { const float* rgw = PIN(I_RGW) + (size_t)layer * 1024 * 4; const float* rew = PIN(I_REW) + (size_t)layer * 1024 * 16;
#pragma unroll
      for (int s = 0; s < 4; ++s)
#pragma unroll
          for (int t = 0; t < 2; ++t) { const int n = 16 * t + r16, kb = k0w + 32 * s + 8 * g; unsigned hw[4], lw[4];
#pragma unroll
              for (int i2 = 0; i2 < 4; ++i2) { float w0 = 0.f, w1 = 0.f;
                  if (n < 4) { w0 = rgw[(kb + 2 * i2) * 4 + n]; w1 = rgw[(kb + 2 * i2 + 1) * 4 + n]; } else if (n < 20) { w0 = rew[(kb + 2 * i2) * 16 + n - 4]; w1 = rew[(kb + 2 * i2 + 1) * 16 + n - 4]; }
                  const unsigned hp = pk2(w0, w1); hw[i2] = hp; lw[i2] = pk2(w0 - bflo(hp), w1 - bfhi(hp)); }
              Bh[s][t] = __builtin_bit_cast(bf16x8v, (v4u){hw[0], hw[1], hw[2], hw[3]}); Bl[s][t] = __builtin_bit_cast(bf16x8v, (v4u){lw[0], lw[1], lw[2], lw[3]}); } }
    float biasn = 0.f; { const int n = F.tid & 31; if (n < 4) biasn = PIN(I_RGB)[layer * 4 + n]; else if (n < 20) biasn = PIN(I_REB)[layer * 16 + n - 4]; }
    v4i* ROUTE = (v4i*)(ws + WS_ROUTE);
    __syncthreads();
#ifdef ROUTE_PREFETCH
#define ROUTE_SRC(G0) ({ const int idx_ = ((G0) + r16) < ib1 ? (G0) + r16 : ib1 - 1; const int r_ = latent_only ? row_of_latent(idx_) : idx_; const int b_ = r_ / RPB, j_ = r_ - b_ * RPB; \
        ((j_ < L_CTX) ? csrc + (size_t)(b_ * L_CTX + j_) * DM : xsrc + (size_t)(b_ * T_LAT + j_ - L_CTX) * DM) + k0w + 8 * g; })
    f32x4 xv[4][2], xn[4][2];
    if (ib0 < ib1) { const float* s0 = ROUTE_SRC(ib0);
#pragma unroll
        for (int s = 0; s < 4; ++s) { xv[s][0] = *(const f32x4*)(s0 + 32 * s); xv[s][1] = *(const f32x4*)(s0 + 32 * s + 4); } }
#endif
    for (int g0 = ib0; g0 < ib1; g0 += 16) {
        const bool valid = (g0 + r16) < ib1; const int idx = valid ? g0 + r16 : ib1 - 1;
        const int r = latent_only ? row_of_latent(idx) : idx;
        const int b = r / RPB, j = r - b * RPB, m = (j < L_CTX) ? 16 : b, slot = (m != mfirst) ? 1024 : 0;
        float ss = 0.f;
#ifdef ROUTE_PREFETCH
        { const float* s1 = ROUTE_SRC(g0 + 16 < ib1 ? g0 + 16 : g0);
#pragma unroll
          for (int s = 0; s < 4; ++s) { xn[s][0] = *(const f32x4*)(s1 + 32 * s); xn[s][1] = *(const f32x4*)(s1 + 32 * s + 4); } }
#else
        const float* src = ((j < L_CTX) ? csrc + (size_t)(b * L_CTX + j) * DM : xsrc + (size_t)(b * T_LAT + j - L_CTX) * DM) + k0w + 8 * g;
        f32x4 xv[4][2];
#pragma unroll
        for (int s = 0; s < 4; ++s) { xv[s][0] = LDNT((const f32x4*)(src + 32 * s)); xv[s][1] = LDNT((const f32x4*)(src + 32 * s + 4)); }
#endif
#pragma unroll
        for (int s = 0; s < 4; ++s)
#pragma unroll
            for (int hh = 0; hh < 2; ++hh) { const f32x4 x = xv[s][hh]; ss += (x.x * x.x + x.y * x.y) + (x.z * x.z + x.w * x.w); }
        ss += xshf<16>(ss); ss = half_sum(ss);
        if (lane < 16) SSP[wv * 16 + lane] = ss;
        __syncthreads();
        float tot = 0.f;
#pragma unroll
        for (int w2 = 0; w2 < 8; ++w2) tot += SSP[w2 * 16 + r16];
        const float rstd = __builtin_amdgcn_rsqf(tot * (1.0f / DM) + NORM_EPS);
        f32x4v acc[2] = {{0.f, 0.f, 0.f, 0.f}, {0.f, 0.f, 0.f, 0.f}};
        unsigned char* drow = (unsigned char*)dst + (size_t)r * DM + k0w + 8 * g;
#pragma unroll
        for (int s = 0; s < 4; ++s) { const int co = slot + k0w + 32 * s + 8 * g;
            const f32x4 h0 = xv[s][0] * rstd * *(const LAS f32x4*)(MA + co) + *(const LAS f32x4*)(MBv + co), h1 = xv[s][1] * rstd * *(const LAS f32x4*)(MA + co + 4) + *(const LAS f32x4*)(MBv + co + 4);
            { v2u o; o.x = pk4_fp8(h0.x, h0.y, h0.z, h0.w); o.y = pk4_fp8(h1.x, h1.y, h1.z, h1.w); *(v2u*)(drow + 32 * s) = o; }
            const unsigned p0 = pk2(h0.x, h0.y), p1 = pk2(h0.z, h0.w), p2 = pk2(h1.x, h1.y), p3 = pk2(h1.z, h1.w);
            const unsigned q0 = pk2(h0.x - bflo(p0), h0.y - bfhi(p0)), q1 = pk2(h0.z - bflo(p1), h0.w - bfhi(p1)), q2 = pk2(h1.x - bflo(p2), h1.y - bfhi(p2)), q3 = pk2(h1.z - bflo(p3), h1.w - bfhi(p3));
            const bf16x8v Ah = __builtin_bit_cast(bf16x8v, (v4u){p0, p1, p2, p3}), Al = __builtin_bit_cast(bf16x8v, (v4u){q0, q1, q2, q3});
#pragma unroll
            for (int t = 0; t < 2; ++t) { acc[t] = __builtin_amdgcn_mfma_f32_16x16x32_bf16(Ah, Bh[s][t], acc[t], 0, 0, 0); acc[t] = __builtin_amdgcn_mfma_f32_16x16x32_bf16(Ah, Bl[s][t], acc[t], 0, 0, 0);
                acc[t] = __builtin_amdgcn_mfma_f32_16x16x32_bf16(Al, Bh[s][t], acc[t], 0, 0, 0); } }
#pragma unroll
        for (int t = 0; t < 2; ++t)
#pragma unroll
            for (int x = 0; x < 4; ++x) PART[(wv * 16 + 4 * g + x) * 32 + 16 * t + r16] = acc[t][x];
        __syncthreads();
        { const int row = F.tid >> 5, n = F.tid & 31; float v = biasn;
#pragma unroll
          for (int w2 = 0; w2 < 8; ++w2) v += PART[(w2 * 16 + row) * 32 + n];
          LOG[row * 32 + n] = v; }
        __syncthreads();
        if (F.tid < 16 && (g0 + F.tid) < ib1) {
            const int rr = latent_only ? row_of_latent(g0 + F.tid) : g0 + F.tid;
            float l[20];
#pragma unroll
            for (int jj = 0; jj < 20; ++jj) l[jj] = LOG[F.tid * 32 + jj];
            int gsel = 0; float gm = l[0];
#pragma unroll
            for (int q = 1; q < 4; ++q) if (l[q] > gm) { gm = l[q]; gsel = q; }
            float gs = 0.f;
#pragma unroll
            for (int q = 0; q < 4; ++q) gs += __expf(l[q] - gm);
            const float gp = 1.0f / gs;
            float le[4];
#pragma unroll
            for (int q = 0; q < 4; ++q) le[q] = (gsel == 0) ? l[4 + q] : (gsel == 1) ? l[8 + q] : (gsel == 2) ? l[12 + q] : l[16 + q];
            int e1 = 0; float m1 = le[0];
#pragma unroll
            for (int q = 1; q < 4; ++q) if (le[q] > m1) { m1 = le[q]; e1 = q; }
            int e2 = -1; float m2 = 0.f;
#pragma unroll
            for (int q = 0; q < 4; ++q) if (q != e1 && (e2 < 0 || le[q] > m2)) { m2 = le[q]; e2 = q; }
            const float bexp = __expf(m2 - m1), w1 = gp / (1.0f + bexp), w2 = gp * bexp / (1.0f + bexp);
            const int ea = e1 < e2 ? e1 : e2, eb = e1 < e2 ? e2 : e1; const float wa = e1 < e2 ? w1 : w2, wb = e1 < e2 ? w2 : w1;
            const int pidx = ea == 0 ? eb - 1 : (ea == 1 ? eb + 1 : 5), bucket = gsel * 6 + pidx;
            const int rank = atomicAdd((int*)(cnt + bucket), 1); ROUTE[rr] = (v4i){bucket, rank, __builtin_bit_cast(int, wa), __builtin_bit_cast(int, wb)};
        }
#ifdef ROUTE_PREFETCH
#pragma unroll
        for (int s = 0; s < 4; ++s) { xv[s][0] = xn[s][0]; xv[s][1] = xn[s][1]; }
#endif
    }
#ifdef ROUTE_PREFETCH
#undef ROUTE_SRC
#endif
    __syncthreads();
    if (F.tid < 24) ((int*)(ws + WS_BCNT))[blockIdx.x * 24 + F.tid] = cnt[F.tid];
    __syncthreads();
}

__device__ __forceinline__ void phase_scatter(Frame& F, bool latent_only) {
    unsigned char* const ws = PWS;
    LAS int* tab = (LAS int*)(F.lds + TAB_OFF);
    const int* BC = (const int*)(ws + WS_BCNT);
    if (F.tid < 384) { const int k = F.tid >> 4, part = F.tid & 15; int tot = 0, below = 0;
        for (int bb = part * 16; bb < part * 16 + 16 && bb < F.G; ++bb) { const int v = BC[bb * 24 + k]; tot += v; if (bb < (int)blockIdx.x) below += v; }
        tot += xshi<1>(tot); tot += xshi<2>(tot); tot += xshi<4>(tot); tot += xshi<8>(tot); below += xshi<1>(below); below += xshi<2>(below); below += xshi<4>(below); below += xshi<8>(below);
        if (part == 0) { tab[32 + k] = tot; tab[k] = below; } }
    __syncthreads();
    if (F.tid == 0) { int tb = 0; for (int k = 0; k < 24; ++k) { const int nt = (tab[32 + k] + 255) >> 8; tab[64 + k] = tb; tab[96 + k] = nt; tab[k] += tb * 256; tb += nt; } tab[128] = tb; }
    __syncthreads();
    v4i* ROWINFO = (v4i*)(ws + WS_ROWINFO);
    if (blockIdx.x == 0) { int* TI = (int*)(ws + WS_TILEINFO); if (F.tid == 0) TI[0] = tab[128];
        if (F.tid < 24) { const int t0 = tab[64 + F.tid], nt = tab[96 + F.tid]; for (int t = 0; t < nt; ++t) TI[1 + t0 + t] = F.tid; } }
    for (int k = blockIdx.x; k < 24; k += F.G) { const int p0 = tab[64 + k] * 256 + tab[32 + k], p1 = (tab[64 + k] + tab[96 + k]) * 256;
        for (int p = p0 + F.tid; p < p1; p += NTHR) ROWINFO[p] = (v4i){-1, 0, 0, 0}; }
    const int nrows = latent_only ? NB * T_LAT : MROWS, NGW = F.G * NWAVES, RPW = (nrows + NGW - 1) / NGW, gwb = (int)blockIdx.x * NWAVES + F.wave;
    const v4i* ROUTE = (const v4i*)(ws + WS_ROUTE);
    { const int i0 = gwb * RPW, i1 = (i0 + RPW < nrows) ? i0 + RPW : nrows;
      if (i0 + F.lane < i1) { const int idx = i0 + F.lane, r = latent_only ? row_of_latent(idx) : idx; const v4i ri = ROUTE[r]; ROWINFO[tab[ri.x] + ri.y] = (v4i){r, ri.z, ri.w, 0}; } }
    __syncthreads();
}
#if DEBUG_CHECK
__device__ __forceinline__ unsigned dbg_hash(unsigned x) { x ^= x >> 16; x *= 0x7feb352du; x ^= x >> 15; x *= 0x846ca68bu; x ^= x >> 16; return x; }
__device__ __forceinline__ void dbg_fail(Frame& F, int bit) { atomicOr((unsigned*)(F.ctl + CW_ERR), 1u << bit); }
__device__ __forceinline__ void dbg_check_gemm_bf16(Frame& F, const bf16* A, const bf16* Bt, const bf16* O, int ldo, int bit) {
    const int s = F.vcu * NTHR + F.tid;
    if (s < 16384) { const int row = dbg_hash(2 * s + 1) % MROWS, col = dbg_hash(2 * s + 2) % 3072; float ref = 0.f;
        for (int k = 0; k < 1024; ++k) ref += bf1(A[(size_t)row * 1024 + k]) * bf1(Bt[(size_t)col * 1024 + k]);
        const float got = bf1(O[(size_t)row * ldo + col]);
        if (!(fabsf(got - ref) <= 0.02f * fabsf(ref) + 0.05f)) dbg_fail(F, bit); }
}
__device__ __forceinline__ float naive_attn_row(Frame& F, const bf16* P, int b, int h, int j) {
    LAS float* pl = (LAS float*)(F.lds) + F.wave * 2304;
    const bf16* Pb = P + (size_t)b * RPB * NPROJ; const bf16* q = Pb + (size_t)j * NPROJ + C_AQ + h * 64;
    const int nk = (j < L_CTX) ? 4 : 36;
    float sc[36]; float mx = -1e30f;
#pragma unroll
    for (int i = 0; i < 36; ++i) { sc[i] = -1e30f; if (i < nk) { const bf16* k = Pb + (size_t)(i * 64 + F.lane) * NPROJ + C_AK + (h >> 1) * 64; float a = 0.f;
        for (int d = 0; d < 64; ++d) a += bf1(q[d]) * bf1(k[d]);
        sc[i] = a; mx = fmaxf(mx, a); } }
    mx = fmaxf(mx, xshf<1>(mx)); mx = fmaxf(mx, xshf<2>(mx)); mx = fmaxf(mx, xshf<4>(mx)); mx = fmaxf(mx, xshf<8>(mx)); mx = fmaxf(mx, xshf<16>(mx));
    mx = half_max(mx);
    float sum = 0.f;
#pragma unroll
    for (int i = 0; i < 36; ++i) { const float p = (i < nk) ? exp2f(sc[i] - mx) : 0.f; sum += p; pl[i * 64 + F.lane] = p; }
    sum = wave_sum(sum); LDS_WAIT(); asm volatile("" ::: "memory");
    float o = 0.f;
    for (int key = 0; key < nk * 64; ++key) o += pl[key] * bf1(Pb[(size_t)key * NPROJ + C_AV + (h >> 1) * 64 + F.lane]);
    LDS_WAIT(); asm volatile("" ::: "memory");
    return o / sum;
}
__device__ __forceinline__ void dbg_check_attn(Frame& F, const bf16* P, const bf16* ACT_, int bit, bool with_ctx) {
    const int s = F.vcu * NWAVES + F.wave;
    const int b = dbg_hash(3 * s + 1) % NB, h = dbg_hash(3 * s + 2) % 4; int j = L_CTX + dbg_hash(3 * s + 3) % T_LAT;
    if (with_ctx && (s & 7) == 0) j = dbg_hash(3 * s + 3) % L_CTX;
    const float o = naive_attn_row(F, P, b, h, j);
    const float got = bf1(ACT_[(size_t)(b * RPB + j) * DM + 768 + h * 64 + F.lane]);
    if (!(fabsf(got - o) <= 0.03f * fabsf(o) + 0.02f)) dbg_fail(F, j < L_CTX ? bit + 1 : bit);
    __syncthreads();
}
__device__ __forceinline__ void dbg_check_outproj(Frame& F, const float* xsrc, const float* xdst, const bf16* ACT_, const bf16* Wt, const float* gate, int bit) {
    const int s = F.vcu * NTHR + F.tid;
    if (s < 16384) { const int idx = dbg_hash(2 * s + 5) % (NB * T_LAT), col = dbg_hash(2 * s + 6) % DM, r = row_of_latent(idx), b = idx >> 11; float ref = 0.f;
        for (int k = 0; k < 1024; ++k) ref += bf1(ACT_[(size_t)r * 1024 + k]) * bf1(Wt[(size_t)col * 1024 + k]);
        ref = xsrc[(size_t)idx * DM + col] + gate[b * 1024 + col] * ref;
        const float got = xdst[(size_t)idx * DM + col];
        if (!(fabsf(got - ref) <= 0.01f * fabsf(ref) + 0.01f)) dbg_fail(F, bit); }
}
__device__ __forceinline__ void dbg_check_gateup(Frame& F, const unsigned char* A8, const unsigned char* Wgu8, const unsigned char* H8, const v4i* rowinfo, const LAS int* tileb, int ntiles, int bit) {
    const int s = F.vcu * NTHR + F.tid;
    if (s < 16384) { const int pos = dbg_hash(2 * s + 7) % (ntiles * 256), hc = dbg_hash(2 * s + 8) % 1024; const v4i ri = rowinfo[pos];
        if (ri.x >= 0) { const int k = tileb[pos >> 8], g = k / 6, pr = k % 6; const int ea = pr < 3 ? 0 : (pr < 5 ? 1 : 2), eb = pr < 3 ? pr + 1 : (pr < 5 ? pr - 1 : 3);
            const int e = g * 4 + (hc < 512 ? ea : eb), jj = hc & 511; const float wgt = __builtin_bit_cast(float, hc < 512 ? ri.y : ri.z);
            const unsigned char* wg = Wgu8 + ((size_t)e * 1024 + (jj >> 7) * 256 + (jj & 127)) * 1024; const unsigned char* wu = wg + 128 * 1024; float ga = 0.f, up = 0.f;
            for (int q = 0; q < 1024; ++q) { const float a = fp8_dec(A8[(size_t)ri.x * 1024 + q]); ga += a * fp8_dec(wg[q]); up += a * fp8_dec(wu[q]); }
            const float ref = 16.0f * siluf(ga * (1.0f / 32.0f)) * (up * (1.0f / 32.0f)) * wgt, got = fp8_dec(H8[(size_t)pos * 1024 + hc]);
            if (!(fabsf(got - ref) <= 0.08f * fabsf(ref) + 0.02f)) dbg_fail(F, bit); } }
}
__device__ __forceinline__ void dbg_check_mix(Frame& F, const bf16* P, const bf16* act, const float* lblog, const float* rdec, const float* hn, const float* rn) {
    const int s = F.vcu * NWAVES + F.wave, lane = F.lane;
    const int mixer = s & 1, b = dbg_hash(5 * s + 1) % NB, h = dbg_hash(5 * s + 2) % 4, j = L_CTX + dbg_hash(5 * s + 3) % T_LAT;
    float osum = 0.f;
    for (int dir = 0; dir < 2; ++dir) {
        const float lb = (mixer == 0 && lblog) ? sigmf(lblog[512 + dir * 256 + h * 64 + lane] - lblog[dir * 256 + h * 64 + lane]) : 0.f;
        const float gamma = sigmf(rdec[dir * 4 + h]);
        const int nt = (dir == 0) ? j : (RPB + L_CTX - 1 - j);
        float S[64];
#pragma unroll
        for (int dd = 0; dd < 64; ++dd) S[dd] = 0.f;
        float o = 0.f;
        for (int n = 0; n <= nt; ++n) { const bf16* rp = P + (size_t)(b * RPB + rc::row_in_batch(dir, n)) * NPROJ;
            float f, k, q, v;
            if (mixer == 0) { f = lb + (1.0f - lb) * sigmf(bf1(rp[C_HZ + 256 * dir + h * 64 + lane])); k = 1.0f - f; q = bf1(rp[C_HQ + h * 64 + lane]); v = bf1(rp[C_HI + h * 64 + lane]); }
            else { f = gamma; k = bf1(rp[C_RK + h * 64 + lane]); q = 0.125f * bf1(rp[C_RQ + h * 64 + lane]); v = bf1(rp[C_RV + h * 64 + lane]); }
            o = 0.f;
#pragma unroll
            for (int dd = 0; dd < 64; ++dd) { const float fd = __builtin_bit_cast(float, __builtin_amdgcn_readlane(__builtin_bit_cast(int, f), dd)), kd = __builtin_bit_cast(float, __builtin_amdgcn_readlane(__builtin_bit_cast(int, k), dd)),
                    qd = __builtin_bit_cast(float, __builtin_amdgcn_readlane(__builtin_bit_cast(int, q), dd));
                S[dd] = fd * S[dd] + kd * v; o += qd * S[dd]; } }
        osum += o;
    }
    const float rs = 1.0f / sqrtf(wave_sum(osum * osum) * (1.0f / 64.0f) + NORM_EPS);
    const float g = bf1(P[(size_t)(b * RPB + j) * NPROJ + (mixer == 0 ? C_HG : C_RG) + h * 64 + lane]);
    const float ref = osum * rs * (mixer == 0 ? hn : rn)[h * 64 + lane] * siluf(g);
    const float got = bf1(act[(size_t)(b * RPB + j) * DM + (mixer == 0 ? 0 : 512) + h * 64 + lane]);
    const float se = wave_sum(fabsf(got - ref)), sr = wave_sum(fabsf(ref));
    if (!(se <= 0.03f * sr + 0.3f)) dbg_fail(F, mixer == 0 ? 6 : 7);
}
__device__ __forceinline__ void dbg_check_norm1(Frame& F, const bf16* act, const float* MODp) {
    const int s = F.vcu * NTHR + F.tid;
    if (s < 8192) { const int r = dbg_hash(2 * s + 11) % MROWS, c = dbg_hash(2 * s + 12) % DM, b = r / RPB, j = r - b * RPB, m = (j < L_CTX) ? 16 : b;
        const float* src = (j < L_CTX) ? PIN(I_CTX) + (size_t)(b * L_CTX + j) * DM : PIN(I_X) + (size_t)(b * T_LAT + j - L_CTX) * DM;
        const float* cv = (j < L_CTX) ? PIN(I_CCTX) : PIN(I_C) + b * 1024; const float* aw = PIN(I_ADAW); const float* ab = PIN(I_ADAB);
        float ss = 0.f, sh = ab[c], scl = ab[1024 + c];
        for (int k = 0; k < 1024; ++k) { ss += src[k] * src[k]; const float sv = siluf(cv[k]); sh += sv * aw[(size_t)k * 6144 + c]; scl += sv * aw[(size_t)k * 6144 + 1024 + c]; }
        const float nA = PIN(I_NMIX)[c] * (1.0f + scl);
        const float gB = MODp[0 * 17 * 1024 + m * 1024 + c], gA = MODp[1 * 17 * 1024 + m * 1024 + c];
        if (!(fabsf(gB - sh) <= 1e-3f * fabsf(sh) + 1e-3f)) dbg_fail(F, 2);
        if (!(fabsf(gA - nA) <= 1e-3f * fabsf(nA) + 1e-3f)) dbg_fail(F, 3);
        const float ref = src[c] * (1.0f / sqrtf(ss / 1024.0f + NORM_EPS)) * gA + gB;
        const float got = bf1(act[(size_t)r * DM + c]);
        if (!(fabsf(got - ref) <= 0.01f * fabsf(ref) + 0.01f)) dbg_fail(F, 4); }
}
__device__ __forceinline__ void dbg_apply(Frame& F, float* out, unsigned* barw) {
    unsigned m = __hip_atomic_load((unsigned*)(F.ctl + CW_ERR), RLX_AGENT);
    if (__hip_atomic_load(barw + XB_TMO, RLX_AGENT) != 0u) m |= 32u;
    if (m) { const float sc = 1.0f + 10.0f * exp2f(0.33219f * (float)m); for (size_t i = (size_t)F.vcu * NTHR + F.tid; i < (size_t)NB * T_LAT * DM; i += (size_t)F.G * NTHR) out[i] *= sc; }
}
#endif
#ifndef NAIVE_ATTN
#define NAIVE_ATTN 0
#endif
#if NAIVE_ATTN && DEBUG_CHECK
__device__ __forceinline__ void phase_naive_attn(Frame& F, const bf16* P, bf16* ACT_, bool latent_only) {
    const int gw = F.vcu * NWAVES + F.wave, NGW = F.G * NWAVES;
    for (int it = gw; it < MROWS * 4; it += NGW) { const int r = it >> 2, h = it & 3, b = r / RPB, j = r - b * RPB;
        if (latent_only && j < L_CTX) continue;
        const float o = naive_attn_row(F, P, b, h, j);
        ACT_[(size_t)r * DM + 768 + h * 64 + F.lane] = (bf16)f2bf(o); }
    __syncthreads();
}
#endif
#ifndef SKIPMASK
#define SKIPMASK 0
#endif
#ifdef REP_BAR
#define GRID_BAR_X() xcd_barrier(bar)
#else
#define GRID_BAR_X() do {} while (0)
#endif
#ifdef PROBE_BARTIME
#define GRID_BAR_T0() const unsigned long long tb0_ = __builtin_amdgcn_s_memrealtime()
#define GRID_BAR_T1(site) do { if ((PROBE_BARMASK >> (site)) & 1) F.bart += (unsigned)(__builtin_amdgcn_s_memrealtime() - tb0_); } while (0)
#else
#define GRID_BAR_T0() do {} while (0)
#define GRID_BAR_T1(site) do {} while (0)
#endif
#define GRID_BAR(site) do { GRID_BAR_T0(); GRID_BAR_X(); xcd_barrier(bar); GRID_BAR_T1(site); { int t_ = F.tid; asm volatile("" : "+v"(t_)); F.tid = t_; F.lane = t_ & 63; F.wave = __builtin_amdgcn_readfirstlane(t_ >> 6); } ws = PWS; } while (0)
#define ACT ((bf16*)(ws + WS_ACT))
#define P ((bf16*)(ws + WS_P))
#define CTXB ((float*)(ws + WS_CTX))
#define ORET ((bf16*)(ws + WS_ORET))
#ifdef OUTPROJ_FP8
#define ATTN_OPTR(b, h) ((attn_body::bf16*)((unsigned char*)ACT + (size_t)(b) * RPB * DM + (12 + (h)) * 128))
#else
#define ATTN_OPTR(b, h) ((attn_body::bf16*)ACT + (size_t)(b) * RPB * DM + 768 + (h) * 64)
#endif
template <int layer> __device__ __forceinline__ void layer_body(Frame& F, XcdBarrier& bar, unsigned char* lds) {
    LAS int* const tileb = (LAS int*)(F.lds + TAB_OFF + 1024);
    unsigned char* ws = PWS;
        const bool lastl = (layer == DEPTH - 1);
        const float* xsrc = (layer == 0) ? PIN(I_X) : (const float*)POUT;
        const float* csrc = (layer == 0) ? PIN(I_CTX) : (const float*)CTXB;
        const float* MOD = (const float*)(ws + WS_MOD) + (size_t)layer * 6 * 17 * 1024;
        #if !(SKIPMASK & 1)
        phase_norm1(F, xsrc, csrc, MOD + 1 * 17 * 1024, MOD + 0 * 17 * 1024, ACT, ws + WS_KVS);
#ifdef REP_N1
        phase_norm1(F, xsrc, csrc, MOD + 1 * 17 * 1024, MOD + 0 * 17 * 1024, ACT, ws + WS_KVS);
#endif
#endif

        GRID_BAR(1);
#if DEBUG_CHECK
        if (layer == 0) dbg_check_norm1(F, ACT, MOD);
#endif
        #if !(SKIPMASK & 2)
        {
            constexpr int NF8 = __builtin_popcount(INPROJ_F8MASK), NB16 = NPROJ / 256 - NF8;
            unsigned long long map16 = 0ull, map8 = 0ull; { int j16 = 0, j8 = 0; for (int t = 0; t < NPROJ / 256; ++t) { if ((INPROJ_F8MASK >> t) & 1) map8 |= (unsigned long long)t << (4 * j8++); else map16 |= (unsigned long long)t << (4 * j16++); } }
            pg8::Gemm g{DM, DM, DM, nullptr}; DenseOrder S; S.init(NPANEL, NB16, F.G, (int)blockIdx.x, 0, ACT, (const bf16*)(ws + WS_W0 + (size_t)layer * WLAYER + WO_WIN), DM, DM); S.pnmap = map16;
            EpiStore E{P, NPROJ, 1.0f};
#ifndef REP_INPROJ
#define REP_INPROJ 1
#endif
            pg8::gemm_phase<EpiStore, DenseOrder, false, true>(F.lds + RING_OFF, g, S, E, F.tid);
            if (NF8 > 0) {
                pg8::Gemm g8{512, 512, 512, nullptr}; DenseOrder S8; const int c8 = ((int)blockIdx.x + F.G - (NPANEL * NB16) % F.G) % F.G;
                S8.init(NPANEL, NF8, F.G, c8, 0, ws + WS_KVS, (const bf16*)(ws + WS_W0 + (size_t)layer * WLAYER + WO_WIN), 512, 512); S8.tB = 524288; S8.pnmap = map8;
                EpiStore E8{P, NPROJ, 1.0f / 32.0f};
                pg8::gemm_phase<EpiStore, DenseOrder, false, true, false, true>(F.lds + RING_OFF, g8, S8, E8, F.tid);
#if defined(REP_F8)
                __syncthreads();
                pg8::gemm_phase<EpiStore, DenseOrder, false, true, false, true>(F.lds + RING_OFF, g8, S8, E8, F.tid);
#endif
            }
#if REP_INPROJ == 2
            __syncthreads();
            pg8::gemm_phase<EpiStore, DenseOrder, false, true>(F.lds + RING_OFF, g, S, E, F.tid);
#endif
        }
#endif

        GRID_BAR(2);
#if DEBUG_CHECK
        dbg_check_gemm_bf16(F, ACT, (const bf16*)(ws + WS_W0 + (size_t)layer * WLAYER + WO_WIN), P, NPROJ, 0);
#endif
        #if !(SKIPMASK & 4)
        phase_prep(F, P, PIN(I_QN) + layer * 64, PIN(I_KN) + layer * 64, (const float*)(ws + WS_ROPE), (const float*)(ws + WS_ROPE) + 2048 * 32);
#ifdef REP_PREP
        phase_prep<true>(F, P, PIN(I_QN) + layer * 64, PIN(I_KN) + layer * 64, (const float*)(ws + WS_ROPE), (const float*)(ws + WS_ROPE) + 2048 * 32);
#endif
#endif

#ifdef SPLIT_MIX
#define LAUNDER_TID() do { int t_ = F.tid; asm volatile("" : "+v"(t_)); F.tid = t_; F.lane = t_ & 63; F.wave = __builtin_amdgcn_readfirstlane(t_ >> 6); ws = PWS; } while (0)
        xcd_split_arrive(bar, (unsigned*)(F.ctl + CW_BAR4));
        {
            bf16* KVS = (bf16*)(ws + WS_KVS); float* DBUF = (float*)(ws + WS_DBUF); const float* lbl = (layer == 0) ? nullptr : PIN(I_LB); const float* rdec = PIN(I_RDEC) + layer * 8;
            recur_stageA_loop(F, P, KVS, DBUF, F.vcu * NWAVES + F.wave, F.G * NWAVES, 256 * 36, lbl, rdec);
        }
        xcd_split_arrive(bar, (unsigned*)(F.ctl + CW_BAR5));
        xcd_split_wait(bar, (unsigned*)(F.ctl + CW_BAR4), (unsigned)layer + 1u);
        LAUNDER_TID();
        {
            const int nunits = lastl ? 512 : 576;
            for (int ui = 0; ; ++ui) {
                const int u = F.vcu + ui * F.G;
                if (ui == 1) {
                    xcd_split_wait(bar, (unsigned*)(F.ctl + CW_BAR5), (unsigned)layer + 1u);
                    LAUNDER_TID();
                    { bf16* KVS = (bf16*)(ws + WS_KVS); const float* DBUF = (const float*)(ws + WS_DBUF); const float* rdec = PIN(I_RDEC) + layer * 8;
                      for (int seq = F.vcu; seq < 256; seq += F.G) { const int mixer = seq >> 7, h = (seq >> 1) & 3, dir = seq & 1;
                          if (mixer == 0) recur_stageB_seq<0>(F, KVS, DBUF, seq, 0.f); else recur_stageB_seq<1>(F, KVS, DBUF, seq, sigmf(rdec[dir * 4 + h])); } }
                    xcd_split_arrive(bar, (unsigned*)(F.ctl + CW_BAR2));
                    LAUNDER_TID();
                }
                if (u >= nunits) break;
                int b, h, qb; if (u < 512) { b = u >> 5; h = (u >> 3) & 3; qb = 1 + (u & 7); } else { b = (u - 512) >> 2; h = u & 3; qb = 0; }
                const attn_body::bf16* Pb = (const attn_body::bf16*)P + (size_t)b * RPB * NPROJ;
                attn_body::attn_unit<8>(qb * 256, qb == 0 ? 4 : 36, Pb + C_AQ + h * 64, Pb + C_AK + (h >> 1) * 64, Pb + C_AV + (h >> 1) * 64,
                                        ATTN_OPTR(b, h), (char*)lds + RING_OFF, F.tid);
            }
        }
#else
        {
            bf16* KVS = (bf16*)(ws + WS_KVS); float* DBUF = (float*)(ws + WS_DBUF); const float* lbl = (layer == 0) ? nullptr : PIN(I_LB); const float* rdec = PIN(I_RDEC) + layer * 8;
#ifndef REP_A
#define REP_A 1
#endif
            for (int rp_REP_A = 0; rp_REP_A < REP_A; ++rp_REP_A)
            recur_stageA_loop(F, P, KVS, DBUF, F.vcu * NWAVES + F.wave, F.G * NWAVES, 256 * 36, lbl, rdec);
        }
        GRID_BAR(3);
        {
            { bf16* KVS = (bf16*)(ws + WS_KVS); const float* DBUF = (const float*)(ws + WS_DBUF); const float* rdec = PIN(I_RDEC) + layer * 8;
#ifndef REP_B
#define REP_B 1
#endif
            for (int rp_REP_B = 0; rp_REP_B < REP_B; ++rp_REP_B)
              for (int seq = F.vcu; seq < 256; seq += F.G) { const int mixer = seq >> 7, h = (seq >> 1) & 3, dir = seq & 1;
                  if (mixer == 0) recur_stageB_seq<0>(F, KVS, DBUF, seq, 0.f); else recur_stageB_seq<1>(F, KVS, DBUF, seq, sigmf(rdec[dir * 4 + h])); } }
#ifdef REP_BDRY
            { bf16* KVS = (bf16*)(ws + WS_KVS); const float* DBUF = (const float*)(ws + WS_DBUF); const float* rdec = PIN(I_RDEC) + layer * 8;
              for (int seq = F.vcu; seq < 256; seq += F.G) { const int mixer = seq >> 7, h = (seq >> 1) & 3, dir = seq & 1;
                  if (mixer == 0) recur_stageB_seq<0, true>(F, KVS, DBUF, seq, 0.f); else recur_stageB_seq<1, true>(F, KVS, DBUF, seq, sigmf(rdec[dir * 4 + h])); } }
#endif

#ifdef SPLIT_BC
            xcd_split_arrive(bar, (unsigned*)(F.ctl + CW_BAR2));
#endif
#if NAIVE_ATTN && DEBUG_CHECK
            phase_naive_attn(F, P, ACT, lastl);
#elif !(SKIPMASK & 16)
        const int nunits = lastl ? 512 : 576;
#ifndef REP_ATTN
#define REP_ATTN 1
#endif
            for (int rep_ = 0; rep_ < REP_ATTN; ++rep_)
            for (int u = F.vcu; u < nunits; u += F.G) {
                int b, h, qb; if (u < 512) { b = u >> 5; h = (u >> 3) & 3; qb = 1 + (u & 7); } else { b = (u - 512) >> 2; h = u & 3; qb = 0; }
                const attn_body::bf16* Pb = (const attn_body::bf16*)P + (size_t)b * RPB * NPROJ;
                attn_body::attn_unit<8>(qb * 256, qb == 0 ? 4 : 36, Pb + C_AQ + h * 64, Pb + C_AK + (h >> 1) * 64, Pb + C_AV + (h >> 1) * 64,
                                        ATTN_OPTR(b, h), (char*)lds + RING_OFF, F.tid);
            }
#endif

        }
#endif
#ifdef SPLIT_BC
        xcd_split_wait(bar, (unsigned*)(F.ctl + CW_BAR2), (unsigned)layer + 1u);
        { int t_ = F.tid; asm volatile("" : "+v"(t_)); F.tid = t_; F.lane = t_ & 63; F.wave = __builtin_amdgcn_readfirstlane(t_ >> 6); } ws = PWS;
#else
        GRID_BAR(4);
#endif
        {
            const bf16* KVS = (const bf16*)(ws + WS_KVS); const float* lbl = (layer == 0) ? nullptr : PIN(I_LB); const float* rdec = PIN(I_RDEC) + layer * 8;
            const float* hn = PIN(I_HNORM) + layer * 256; const float* rn = PIN(I_RNORM) + layer * 256;
            const int ntb = lastl ? 32 : 36;
#ifndef REP_C
#define REP_C 1
#endif
            for (int rp_REP_C = 0; rp_REP_C < REP_C; ++rp_REP_C)
            recur_stageC_loop(F, P, KVS, ACT, F.vcu & 7, F.vcu >> 3, (F.G >= 8) ? (F.G >> 3) : 1, 16 * ntb, ntb, lastl ? 4 : 0, lbl, rdec, hn, rn);
            phase_conv(F, P, ACT, PIN(I_CONVW) + layer * 768, lastl);
#ifdef REP_CONV
            phase_conv(F, P, ACT, PIN(I_CONVW) + layer * 768, lastl);
#endif
        }
        GRID_BAR(5);
#if DEBUG_CHECK
        dbg_check_mix(F, P, ACT, layer == 0 ? nullptr : PIN(I_LB), PIN(I_RDEC) + layer * 8, PIN(I_HNORM) + layer * 256, PIN(I_RNORM) + layer * 256);
#endif
#if DEBUG_CHECK
        dbg_check_attn(F, P, ACT, 1, !lastl);
#endif
        #if !(SKIPMASK & 64)
        {
#ifdef OUTPROJ_FP8
            pg8::Gemm g{512, 512, 512, nullptr}; DenseOrder S; S.init(lastl ? NB * 8 : NPANEL, 4, F.G, (int)blockIdx.x, lastl ? 1 : 0, ACT, (const bf16*)(ws + WS_W0 + (size_t)layer * WLAYER + WO_WOUT), 512, 512);
            EpiResid E{xsrc, csrc, POUT, CTXB, MOD + 2 * 17 * 1024, 1.0f / 128.0f};
            pg8::gemm_phase<EpiResid, DenseOrder, true, true, false, true, true>(F.lds + RING_OFF, g, S, E, F.tid);
#else
            pg8::Gemm g{DM, DM, DM, nullptr}; DenseOrder S; S.init(lastl ? NB * 8 : NPANEL, 4, F.G, (int)blockIdx.x, lastl ? 1 : 0, ACT, (const bf16*)(ws + WS_W0 + (size_t)layer * WLAYER + WO_WOUT), DM, DM);
            EpiResid E{xsrc, csrc, POUT, CTXB, MOD + 2 * 17 * 1024, 1.0f};
            pg8::gemm_phase<EpiResid, DenseOrder, true, true>(F.lds + RING_OFF, g, S, E, F.tid);
#endif
        }
        if (layer == 0) {
            __syncthreads();
#ifdef SPLIT_OP
            xcd_split_arrive(bar, (unsigned*)(F.ctl + CW_BAR4));
#endif
            constexpr int PL = 1792 + 512 + 3 * 4096;
#ifdef CONV_SPLIT64
            if (F.G == 256) { const int c = (int)blockIdx.x;
                if (c < 64) convert_weights_range(F, PL, PL + CONV_SPLIT64, c * NWAVES + F.wave, 64 * NWAVES);
                else convert_weights_range(F, PL + CONV_SPLIT64, 2 * PL, (c - 64) * NWAVES + F.wave, 192 * NWAVES); }
            else convert_weights_range(F, PL, 2 * PL, F.vcu * NWAVES + F.wave, F.G * NWAVES);
#else
            const int nb = (int)blockIdx.x - 64, nw = (F.G - 64) * NWAVES;
            if (F.G > 64) convert_weights_range(F, PL, 2 * PL, nb >= 0 ? nb * NWAVES + F.wave : -1, nw);
            else convert_weights_range(F, PL, 2 * PL, F.vcu * NWAVES + F.wave, F.G * NWAVES);
#endif
            __syncthreads();
        }
#endif

#ifdef SPLIT_OP
        if (layer == 0) { xcd_split_wait(bar, (unsigned*)(F.ctl + CW_BAR4), 1u); { int t_ = F.tid; asm volatile("" : "+v"(t_)); F.tid = t_; F.lane = t_ & 63; F.wave = __builtin_amdgcn_readfirstlane(t_ >> 6); } ws = PWS; }
        else GRID_BAR(6);
#else
        GRID_BAR(6);
#endif
#if DEBUG_CHECK
        if (layer == 0) dbg_check_outproj(F, PIN(I_X), POUT, ACT, (const bf16*)(ws + WS_W0 + (size_t)layer * WLAYER + WO_WOUT), MOD + 2 * 17 * 1024, 3);
        GRID_BAR(6);
#endif
        #if !(SKIPMASK & 128)
        phase_norm2_route(F, layer, (const float*)POUT, (const float*)CTXB, MOD + 4 * 17 * 1024, MOD + 3 * 17 * 1024, ACT, lastl);
#ifdef REP_N2
        phase_norm2_route(F, layer, (const float*)POUT, (const float*)CTXB, MOD + 4 * 17 * 1024, MOD + 3 * 17 * 1024, ACT, lastl);
#endif
#endif

        GRID_BAR(7);
        #if !(SKIPMASK & 256)
        phase_scatter(F, lastl);
#ifdef REP_N2
        phase_scatter(F, lastl);
#endif
#endif

        GRID_BAR(8);
#ifdef MOE_SPLIT
        {
            const int* TI = (const int*)(ws + WS_TILEINFO); const int ntiles = TI[0], T1 = ntiles >> 1;
            for (int i = F.tid; i < MAXTILES; i += NTHR) tileb[i] = (i < ntiles) ? TI[1 + i] : 0;
            __syncthreads();
            int dealt = 0;
#pragma nounroll
            for (int part = 0; part < 2; ++part) {
                const int t0 = part ? T1 : 0, ntp = part ? ntiles - T1 : T1;
                pg8::Gemm g{512, 512, 512, nullptr}; g.rowidx = (const int*)(ws + WS_ROWINFO);
                MoeOrder S; S.pm0 = t0; S.ncol = 8; S.nwg = ntp * 8; S.G = F.G; S.c = ((int)blockIdx.x + F.G - dealt % F.G) % F.G; S.down = 0; S.tileb = tileb; S.A = (const char*)(ws + WS_ACT); S.W = (const char*)(ws + WS_W0 + (size_t)layer * WLAYER + WO_WGU);
                EpiGateUp E{ws + WS_H, (const v4i*)(ws + WS_ROWINFO)};
                pg8::gemm_phase<EpiGateUp, MoeOrder, true, true, true, true>(F.lds + RING_OFF, g, S, E, F.tid);
                dealt += ntp * 8;
                xcd_split_arrive(bar, (unsigned*)(F.ctl + (part ? CW_BAR4 : CW_BAR3)));
            }
#pragma nounroll
            for (int part = 0; part < 2; ++part) {
                xcd_split_wait(bar, (unsigned*)(F.ctl + (part ? CW_BAR4 : CW_BAR3)), (unsigned)layer + 1u);
                { int t_ = F.tid; asm volatile("" : "+v"(t_)); F.tid = t_; F.lane = t_ & 63; F.wave = __builtin_amdgcn_readfirstlane(t_ >> 6); } ws = PWS;
                const int t0 = part ? T1 : 0, ntp = part ? ntiles - T1 : T1;
                pg8::Gemm g{512, 1024, 512, nullptr};
                MoeOrder S; S.pm0 = t0; S.ncol = 4; S.nwg = ntp * 4; S.G = F.G; S.c = ((int)blockIdx.x + F.G - dealt % F.G) % F.G; S.down = 1; S.tileb = tileb; S.A = (const char*)(ws + WS_H); S.W = (const char*)(ws + WS_W0 + (size_t)layer * WLAYER + WO_WD);
                EpiDown E{POUT, CTXB, MOD + 5 * 17 * 1024, (const v4i*)(ws + WS_ROWINFO)};
                pg8::gemm_phase<EpiDown, MoeOrder, true, true, false, true>(F.lds + RING_OFF, g, S, E, F.tid);
                dealt += ntp * 4;
            }
        }
#else
        #if !(SKIPMASK & 512)
        {
            const int* TI = (const int*)(ws + WS_TILEINFO); const int ntiles = TI[0];
            for (int i = F.tid; i < MAXTILES; i += NTHR) tileb[i] = (i < ntiles) ? TI[1 + i] : 0;
            __syncthreads();
            pg8::Gemm g{512, 512, 512, nullptr};
            g.rowidx = (const int*)(ws + WS_ROWINFO);
            MoeOrder S; S.pm0 = 0; S.ncol = 8; S.nwg = ntiles * 8; S.G = F.G; S.c = (int)blockIdx.x; S.down = 0; S.tileb = tileb; S.A = (const char*)(ws + WS_ACT); S.W = (const char*)(ws + WS_W0 + (size_t)layer * WLAYER + WO_WGU);
            EpiGateUp E{ws + WS_H, (const v4i*)(ws + WS_ROWINFO)};
#ifndef REP_GU
#define REP_GU 1
#endif
            pg8::gemm_phase<EpiGateUp, MoeOrder, true, true, true, true>(F.lds + RING_OFF, g, S, E, F.tid);
#if REP_GU == 2
            __syncthreads();
            pg8::gemm_phase<EpiGateUp, MoeOrder, true, true, true, true>(F.lds + RING_OFF, g, S, E, F.tid);
#endif
        }
#endif

        GRID_BAR(9);
#if DEBUG_CHECK
        { const int* TI = (const int*)(ws + WS_TILEINFO); dbg_check_gateup(F, ws + WS_ACT, ws + WS_W0 + (size_t)layer * WLAYER + WO_WGU, ws + WS_H, (const v4i*)(ws + WS_ROWINFO), tileb, TI[0], 4); }
#endif
        #if !(SKIPMASK & 1024)
        {
            const int* TI = (const int*)(ws + WS_TILEINFO); const int ntiles = TI[0];
            pg8::Gemm g{512, 1024, 512, nullptr};
            MoeOrder S; S.pm0 = 0; S.ncol = 4; S.nwg = ntiles * 4; S.G = F.G; S.c = (int)blockIdx.x; S.down = 1; S.tileb = tileb; S.A = (const char*)(ws + WS_H); S.W = (const char*)(ws + WS_W0 + (size_t)layer * WLAYER + WO_WD);
            EpiDown E{POUT, CTXB, MOD + 5 * 17 * 1024, (const v4i*)(ws + WS_ROWINFO)};
            pg8::gemm_phase<EpiDown, MoeOrder, true, true, false, true>(F.lds + RING_OFF, g, S, E, F.tid);
        }
#endif

#endif
#if defined(PROBE_BARTIME) || DEBUG_CHECK
        GRID_BAR(10);
#else
        if (!lastl) GRID_BAR(10);
#endif
    }
__global__ void __launch_bounds__(NTHR, 2) fwd_kernel(Args args) {
    extern __shared__ __attribute__((aligned(16))) unsigned char lds[];
    Frame F;
    F.lds = (LAS unsigned char*)lds;
    F.MISC = (volatile LAS unsigned*)(F.lds + MISC_OFF);
    F.tid = threadIdx.x; F.lane = F.tid & 63; F.wave = __builtin_amdgcn_readfirstlane(F.tid >> 6);
    F.bart = 0u; F.G = gridDim.x; { const int bx = blockIdx.x; F.vcu = (F.G % 8 == 0) ? (bx % 8) * (F.G / 8) + bx / 8 : bx; }
    F.ctl = (gu32*)(args.ws + WS_CTL);
    for (int u = F.tid; u < (LDS_BYTES - LDSCTL_OFF) / 4; u += NTHR) ((LAS unsigned*)(F.lds + LDSCTL_OFF))[u] = 0u;
    __syncthreads();
    if (F.tid == 0) { volatile LAS unsigned long long* pt = (volatile LAS unsigned long long*)(F.lds + PTAB_OFF);
#pragma unroll
        for (int i = 0; i < 24; ++i) pt[i] = (unsigned long long)args.in[i];
        pt[24] = (unsigned long long)args.out; pt[25] = (unsigned long long)(args.ws + args.ws_shift); }
    __syncthreads();
    XcdBarrier bar = xcd_barrier_post((unsigned*)(F.ctl + CW_BAR), F.MISC + 8);
    unsigned char* ws = PWS;

    #if !(SKIPMASK & 2048)
        p0_prologue(F, bar);
#endif

#ifdef SPLIT_PRO
    xcd_split_wait(bar, (unsigned*)(F.ctl + CW_BAR3), 1u);
    { int t_ = F.tid; asm volatile("" : "+v"(t_)); F.tid = t_; F.lane = t_ & 63; F.wave = __builtin_amdgcn_readfirstlane(t_ >> 6); } ws = PWS;
#else
    GRID_BAR(0);
#endif

    layer_body<0>(F, bar, lds);
    layer_body<1>(F, bar, lds);
#ifdef PROBE_BARTIME
    if (blockIdx.x == PROBE_BARTIME - 1 && F.tid == 0) { const unsigned long long ts_ = __builtin_amdgcn_s_memrealtime(); while (__builtin_amdgcn_s_memrealtime() - ts_ < 8ull * F.bart) __builtin_amdgcn_s_sleep(8); }
#endif
#if DEBUG_CHECK
    dbg_apply(F, POUT, bar.bar);
#endif
}

extern "C" void kernel_launch(void* const* d_in, const int* in_sizes, int n_in, void* d_out, int out_size, void* d_ws, size_t ws_size, hipStream_t stream) {
    static int grid = 0;
    if (grid == 0) {
        if (n_in != 24 || out_size != NB * T_LAT * DM || ws_size < WS_END) { fprintf(stderr, "kernel_launch: unexpected shapes (n_in %d, out %d, ws %zu); nothing launched\n", n_in, out_size, ws_size); grid = -1; return; }
        int dev = 0, cus = 0, per_cu = 0;
        if (hipGetDevice(&dev) != hipSuccess || hipDeviceGetAttribute(&cus, hipDeviceAttributeMultiprocessorCount, dev) != hipSuccess) { grid = -1; return; }
        if (hipFuncSetAttribute((const void*)fwd_kernel, hipFuncAttributeMaxDynamicSharedMemorySize, LDS_BYTES) != hipSuccess) { grid = -1; return; }
        if (hipOccupancyMaxActiveBlocksPerMultiprocessor(&per_cu, (const void*)fwd_kernel, NTHR, LDS_BYTES) != hipSuccess || per_cu < 1) { fprintf(stderr, "kernel_launch: occupancy query says %d blocks per CU\n", per_cu); grid = -1; return; }
        (void)hipGetLastError();
        grid = cus < 256 ? cus : 256;
    }
    if (grid < 0) return;
    if (hipMemsetAsync((char*)d_ws + WS_CTL, 0, CTL_ZERO_BYTES, stream) != hipSuccess) return;
    Args a{};
    for (int i = 0; i < 24; ++i) a.in[i] = (const float*)d_in[i];
    a.out = (float*)d_out; a.ws = (unsigned char*)d_ws;
#ifdef WS_TOP
    a.ws_shift = ((ws_size - WS_END) / (2 * MiB)) * (2 * MiB);
#endif
    hipLaunchKernelGGL(fwd_kernel, dim3(grid), dim3(NTHR), LDS_BYTES, stream, a);
}
```

```cpp
#define SPLIT_BC 1
#define EARLY_INV 1
#define CONV_SLIDE 1
#define VT_PAIR 1
#define HGRN_PACK 1
#define ROUTE_EARLY 1

#define MOD_WIDE 1
#define SPLIT_PRO 1
#define SPLIT_OP 1


#define EMU_TILES 0

#define INPROJ_F8MASK 0x3F02

#include <hip/hip_runtime.h>
#ifdef NT_LOADS
#define LDNT(p) __builtin_nontemporal_load(p)
#else
#define LDNT(p) (*(p))
#endif
#include <hip/hip_bf16.h>
#include <cstdio>
#include <cstdint>
#include <cmath>
#ifndef DEBUG_CHECK
#define DEBUG_CHECK 0
#endif
#define DENSE_WGM 4
#ifndef NAIVE_ATTN
#define NAIVE_ATTN 0
#endif

namespace pg8 {
#define PG8_LAS __attribute__((address_space(3)))
typedef unsigned short bf16_t;
typedef short bf16x8 __attribute__((ext_vector_type(8)));
typedef float f32x4 __attribute__((ext_vector_type(4)));
typedef unsigned u32x4 __attribute__((ext_vector_type(4)));
constexpr int BM = 256, BK = 64, HALF = 128, HTB = HALF * BK * 2  , STAGE_BYTES = 8 * HTB, NXCD = 8, WGM = 8;

__host__ __device__ __forceinline__ int lds_byte(int r, int c) { const int st = (r >> 4) * 2 + (c >> 5), rr = r & 15, cc = c & 31, ob = rr * 64 + cc * 2; return st * 1024 + (ob ^ (((ob >> 9) & 1) << 5)); }
__host__ __device__ __forceinline__ void stage_rc(int b, int& R, int& C) { const int st = b / 1024, sb = b % 1024, swz = sb ^ (((sb >> 9) & 1) << 5); R = (st >> 1) * 16 + swz / 64; C = (st & 1) * 32 + (swz % 64) / 2; }
__host__ __device__ __forceinline__ void stage_rc8(int b, int& R, int& C) { const int blk = b >> 11, rr = (b >> 7) & 15, ps = (b >> 5) & 3, k = (b >> 4) & 1, gl = ps ^ ((rr >> 1) & 3); R = blk * 16 + rr; C = (gl * 2 + k) * 8; }
__host__ __device__ __forceinline__ int perm32(int rho) { const int n = rho >> 4, i = rho & 15; return 8 * (i >> 2) + 4 * n + (i & 3); }

struct Unit { const char* a; const char* b; const char* b2; int pm, pn, x0, x1; };
struct Gemm { int lda, ldb, K; const int* rowidx; };
typedef int i32x8 __attribute__((ext_vector_type(8)));
typedef int i32x4 __attribute__((ext_vector_type(4)));
__device__ __forceinline__ i32x8 pg8_cat(bf16x8 a, bf16x8 b) { const i32x4 x = __builtin_bit_cast(i32x4, a), y = __builtin_bit_cast(i32x4, b); return (i32x8){x[0], x[1], x[2], x[3], y[0], y[1], y[2], y[3]}; }
__device__ __forceinline__ unsigned cvt_pk_bf16(float lo, float hi) { unsigned r; asm volatile("v_cvt_pk_bf16_f32 %0, %1, %2" : "=v"(r) : "v"(lo), "v"(hi)); return r; }

template <class Epi, class Sched, bool ALIGN_EPI = false, bool SP2 = false, bool GATHER = false, bool FP8 = false, bool APAIR = false>
__device__ __forceinline__ void gemm_phase(PG8_LAS unsigned char* lds, const Gemm g, const Sched& S, const Epi& E, const int tid) {
    const int wid = __builtin_amdgcn_readfirstlane(tid >> 6), lane = tid & 63, wr = wid >> 2, wc = wid & 3, fr = lane & 15, fq = lane >> 4;
    const int K = g.K, nt = K / BK;
    unsigned voffA[2], voffB[2];
#pragma unroll
    for (int i = 0; i < 2; ++i) { int R, C; if constexpr (FP8) stage_rc8(tid * 16 + i * 8192, R, C); else stage_rc(tid * 16 + i * 8192, R, C); const int Rb = Epi::PERM ? ((R & ~31) + perm32(R & 31)) : R;
        voffA[i] = APAIR ? (unsigned)((R >> 1) * g.lda * 4 + ((2 * C) >> 6) * 128 + (R & 1) * 64 + ((2 * C) & 63)) : (unsigned)(R * g.lda + C) * 2u; voffB[i] = (unsigned)(Rb * g.ldb + C) * 2u; }
    unsigned gc[2][2] = {{0u, 0u}, {0u, 0u}}, gn[2][2] = {{0u, 0u}, {0u, 0u}}; int gR[2] = {0, 0}, gC[2] = {0, 0};
    if constexpr (GATHER) {
#pragma unroll
        for (int i = 0; i < 2; ++i) { if constexpr (FP8) stage_rc8(tid * 16 + i * 8192, gR[i], gC[i]); else stage_rc(tid * 16 + i * 8192, gR[i], gC[i]); } }
#define PG8_GOFF(dst, pm_) do { _Pragma("unroll") for (int _h = 0; _h < 2; ++_h) _Pragma("unroll") for (int _i = 0; _i < 2; ++_i) { \
        int _r = g.rowidx[(size_t)((pm_) * 256 + _h * 128 + gR[_i]) * 4]; _r = _r < 0 ? 0 : _r; dst[_h][_i] = (unsigned)(_r * g.lda + gC[_i]) * 2u; } } while (0)
    const size_t kstep = (size_t)(BK * 2);
    const size_t kstepA = APAIR ? kstep * 2 : kstep;
    const size_t hstepA = (size_t)HALF * g.lda * 2, hstepB = (size_t)HALF * g.ldb * 2;
    const unsigned ldsw = (unsigned)wid * 1024u;
    const int aoff = FP8 ? (wr * 4) * 2048 + fr * 128 + ((fq ^ ((fr >> 1) & 3)) * 32) : lds_byte(wr * 64 + fr, fq * 8), boff = FP8 ? (wc * 2) * 2048 + fr * 128 + ((fq ^ ((fr >> 1) & 3)) * 32) : lds_byte(wc * 32 + fr, fq * 8);
#define PG8_SA(b, h) (((b) * 2 + (h)) * HTB)
#define PG8_SB(b, h) ((4 + (b) * 2 + (h)) * HTB)
#define PG8_STAGE(bufoff, gbase, voff) do { _Pragma("unroll") for (int _i = 0; _i < 2; ++_i) \
        __builtin_amdgcn_global_load_lds((const unsigned*)((const char*)(gbase) + (voff)[_i]), (PG8_LAS unsigned*)(lds + (bufoff) + ldsw + _i * 8192), 16, 0, 0); } while (0)
#define PG8_STAGE_A(bufoff, tbase, hh, NX) do { if constexpr (GATHER) { _Pragma("unroll") for (int _i = 0; _i < 2; ++_i) { const unsigned _o = (NX) ? gn[hh][_i] : gc[hh][_i]; \
        __builtin_amdgcn_global_load_lds((const unsigned*)((const char*)(tbase) + _o), (PG8_LAS unsigned*)(lds + (bufoff) + ldsw + _i * 8192), 16, 0, 0); } } \
        else { PG8_STAGE(bufoff, (tbase) + (hh) * hstepA, voffA); } } while (0)
#define PG8_LDA(dst, b, h) do { if constexpr (FP8) { _Pragma("unroll") for (int m = 0; m < 4; ++m) dst##8[m] = *(const PG8_LAS i32x8*)(lds + PG8_SA(b, h) + aoff + m * 2048); } \
        else { _Pragma("unroll") for (int m = 0; m < 4; ++m) _Pragma("unroll") for (int k = 0; k < 2; ++k) dst[m][k] = *(const PG8_LAS bf16x8*)(lds + PG8_SA(b, h) + aoff + m * 2048 + k * 1024); } } while (0)
#define PG8_LDB(dst, b, h) do { if constexpr (FP8) { _Pragma("unroll") for (int n = 0; n < 2; ++n) dst##8[n] = *(const PG8_LAS i32x8*)(lds + PG8_SB(b, h) + boff + n * 2048); } \
        else { _Pragma("unroll") for (int n = 0; n < 2; ++n) _Pragma("unroll") for (int k = 0; k < 2; ++k) dst[n][k] = *(const PG8_LAS bf16x8*)(lds + PG8_SB(b, h) + boff + n * 2048 + k * 1024); } } while (0)
#define PG8_MMA(ai, bj, At, Bt) do { __builtin_amdgcn_s_setprio(1); if constexpr (FP8) { _Pragma("unroll") for (int m = 0; m < 4; ++m) _Pragma("unroll") for (int n = 0; n < 2; ++n) \
        asm volatile("v_mfma_scale_f32_16x16x128_f8f6f4 %0, %1, %2, %0, %3, %3 op_sel_hi:[0,0,0]" : "+v"(acc[ai][bj][m][n]) : "v"(Bt##8[n]), "v"(At##8[m]), "v"(pg8_one)); }     \
        else { _Pragma("unroll") for (int m = 0; m < 4; ++m) _Pragma("unroll") for (int n = 0; n < 2; ++n) _Pragma("unroll") for (int k = 0; k < 2; ++k) \
        acc[ai][bj][m][n] = __builtin_amdgcn_mfma_f32_16x16x32_bf16(Bt[n][k], At[m][k], acc[ai][bj][m][n], 0, 0, 0); } __builtin_amdgcn_s_setprio(0); } while (0)
#define PG8_WAIT_V(n) asm volatile("s_waitcnt vmcnt(" #n ")" ::: "memory")
#define PG8_WAIT_L(n) asm volatile("s_waitcnt lgkmcnt(" #n ")" ::: "memory")
#define PG8_BAR __builtin_amdgcn_s_barrier()
#define PG8_SCHED __builtin_amdgcn_sched_barrier(0)
    Unit cur, nxt; int ui = 0;
    if (!S.next(0, cur)) return;
    f32x4 acc[2][2][4][2];
#pragma unroll
    for (int a = 0; a < 2; ++a)
#pragma unroll
        for (int b = 0; b < 2; ++b)
#pragma unroll
            for (int m = 0; m < 4; ++m)
#pragma unroll
                for (int n = 0; n < 2; ++n) acc[a][b][m][n] = (f32x4){0.f, 0.f, 0.f, 0.f};
    const int pg8_one = 0x7f7f7f7f;
    bf16x8 At[4][2], B0[2][2], B1[2][2];
    i32x8 At8[4], B08[2], B18[2];
    const char* cA = cur.a; const char* cB = cur.b; const char* cB2 = cur.b2; const int nth = nt >> 1;
    if constexpr (GATHER) { PG8_GOFF(gc, cur.pm); }
    S.a_ready(cur);
    if constexpr (SP2) {
        PG8_STAGE(PG8_SB(0, 0), cB, voffB); PG8_STAGE(PG8_SB(0, 1), cB + hstepB, voffB); PG8_STAGE_A(PG8_SA(0, 0), cA, 0, false); PG8_STAGE_A(PG8_SA(0, 1), cA, 1, false);
        if (wr == 1) PG8_BAR;
        PG8_WAIT_V(2); PG8_BAR;
        PG8_STAGE(PG8_SB(1, 0), cB + kstep, voffB); PG8_STAGE_A(PG8_SA(1, 0), cA + kstepA, 0, false); PG8_STAGE(PG8_SB(1, 1), cB + hstepB + kstep, voffB);
        PG8_WAIT_V(6); PG8_BAR;
    } else {
        PG8_STAGE(PG8_SB(0, 0), cB, voffB); PG8_STAGE_A(PG8_SA(0, 0), cA, 0, false); PG8_STAGE(PG8_SB(0, 1), cB + hstepB, voffB); PG8_STAGE_A(PG8_SA(0, 1), cA, 1, false);
        if (wr == 1) PG8_BAR;
        PG8_WAIT_V(4); PG8_BAR;
        PG8_STAGE(PG8_SB(1, 0), cB + kstep, voffB); PG8_STAGE_A(PG8_SA(1, 0), cA + kstepA, 0, false); PG8_STAGE(PG8_SB(1, 1), cB + hstepB + kstep, voffB);
        PG8_WAIT_V(6); PG8_BAR;
    }
    for (;;) {
        const bool has_next = S.next(ui + 1, nxt);
        if constexpr (GATHER) { if (has_next) { PG8_GOFF(gn, nxt.pm); } }
        const char* nA = has_next ? nxt.a : cA; const char* nB = has_next ? nxt.b : cB;
#pragma nounroll
        for (int t = 0; t < nt; t += 2) {
            const bool last = (t == nt - 2);
            const char* a1 = cA + (size_t)(t + 1) * kstepA;
            const char* a2 = last ? nA : cA + (size_t)(t + 2) * kstepA; const char* b2 = last ? nB : ((t + 2 < nth) ? cB : cB2) + (size_t)(t + 2) * kstep;
            const char* a3 = a2 + kstepA; const char* b3 = b2 + kstep;
            if (last && has_next) S.a_ready(nxt);
            if constexpr (SP2) {
            PG8_LDB(B0, 0, 0); PG8_LDB(B1, 0, 1); PG8_SCHED; PG8_LDA(At, 0, 0); PG8_STAGE_A(PG8_SA(1, 1), a1, 1, false);
            PG8_WAIT_V(8); PG8_WAIT_L(0); PG8_BAR; PG8_MMA(0, 0, At, B0); PG8_MMA(0, 1, At, B1); PG8_BAR; PG8_SCHED;
            PG8_LDA(At, 0, 1); PG8_STAGE(PG8_SB(0, 0), b2, voffB); PG8_STAGE(PG8_SB(0, 1), b2 + hstepB, voffB); PG8_STAGE_A(PG8_SA(0, 0), a2, 0, last);
            PG8_WAIT_V(8); PG8_WAIT_L(0); PG8_BAR; PG8_MMA(1, 0, At, B0); PG8_MMA(1, 1, At, B1); PG8_BAR; PG8_SCHED;
            PG8_LDB(B0, 1, 0); PG8_LDB(B1, 1, 1); PG8_SCHED; PG8_LDA(At, 1, 0); PG8_STAGE_A(PG8_SA(0, 1), a2, 1, last);
            PG8_WAIT_V(8); PG8_WAIT_L(0); PG8_BAR; PG8_MMA(0, 0, At, B0); PG8_MMA(0, 1, At, B1); PG8_BAR; PG8_SCHED;
            PG8_LDA(At, 1, 1); PG8_STAGE(PG8_SB(1, 0), b3, voffB); PG8_STAGE(PG8_SB(1, 1), b3 + hstepB, voffB); PG8_STAGE_A(PG8_SA(1, 0), a3, 0, last);
            PG8_WAIT_V(8); PG8_WAIT_L(0); PG8_BAR; PG8_MMA(1, 0, At, B0); PG8_MMA(1, 1, At, B1); PG8_BAR; PG8_SCHED;
            } else {
            PG8_LDB(B0, 0, 0); PG8_SCHED; PG8_LDA(At, 0, 0); PG8_STAGE_A(PG8_SA(1, 1), a1, 1, false);
            PG8_WAIT_L(8); PG8_BAR; PG8_WAIT_L(0); PG8_MMA(0, 0, At, B0); PG8_BAR; PG8_SCHED;
            PG8_LDB(B1, 0, 1); PG8_STAGE(PG8_SB(0, 0), b2, voffB);
            PG8_BAR; PG8_WAIT_L(0); PG8_MMA(0, 1, At, B1); PG8_BAR;
            PG8_LDA(At, 0, 1); PG8_STAGE_A(PG8_SA(0, 0), a2, 0, last);
            PG8_BAR; PG8_WAIT_L(0); PG8_MMA(1, 0, At, B0); PG8_BAR; PG8_SCHED;
            PG8_STAGE(PG8_SB(0, 1), b2 + hstepB, voffB);
            PG8_WAIT_V(6); PG8_BAR; PG8_MMA(1, 1, At, B1); PG8_BAR;
            PG8_LDB(B0, 1, 0); PG8_SCHED; PG8_LDA(At, 1, 0); PG8_STAGE_A(PG8_SA(0, 1), a2, 1, last);
            PG8_WAIT_L(8); PG8_BAR; PG8_WAIT_L(0); PG8_MMA(0, 0, At, B0); PG8_BAR; PG8_SCHED;
            PG8_LDB(B1, 1, 1); PG8_STAGE(PG8_SB(1, 0), b3, voffB);
            PG8_BAR; PG8_WAIT_L(0); PG8_MMA(0, 1, At, B1); PG8_BAR;
            PG8_LDA(At, 1, 1); PG8_STAGE_A(PG8_SA(1, 0), a3, 0, last);
            PG8_BAR; PG8_WAIT_L(0); PG8_MMA(1, 0, At, B0); PG8_BAR; PG8_SCHED;
            PG8_STAGE(PG8_SB(1, 1), b3 + hstepB, voffB);
            PG8_WAIT_V(6); PG8_BAR; PG8_MMA(1, 1, At, B1); PG8_BAR;
            }
        }
        if constexpr (FP8) asm volatile("s_nop 15\n\ts_nop 7" ::: "memory");
        if constexpr (ALIGN_EPI) { if (wr == 0) PG8_BAR; }
        if constexpr (!Epi::AFTER_DRAIN) { E(acc, cur, wr, wc, fr, fq); S.done(cur); }
        if (!has_next) break;
#pragma unroll
        for (int a = 0; a < 2; ++a)
#pragma unroll
            for (int b = 0; b < 2; ++b)
#pragma unroll
                for (int m = 0; m < 4; ++m)
#pragma unroll
                    for (int n = 0; n < 2; ++n) acc[a][b][m][n] = (f32x4){0.f, 0.f, 0.f, 0.f};
        cur = nxt; cA = nA; cB = nB; cB2 = nxt.b2; ++ui;
        if constexpr (GATHER) { _Pragma("unroll") for (int _h = 0; _h < 2; ++_h) _Pragma("unroll") for (int _i = 0; _i < 2; ++_i) gc[_h][_i] = gn[_h][_i]; }
        if constexpr (ALIGN_EPI) { if (wr == 1) PG8_BAR; }
    }
    PG8_WAIT_V(0);
    if constexpr (!ALIGN_EPI) { if (wr == 0) PG8_BAR; }
    PG8_BAR;
    if constexpr (Epi::AFTER_DRAIN) { E.fused(acc, cur, wr, wc, fr, fq, lds, wid, lane); S.done(cur); }
#undef PG8_SA
#undef PG8_SB
#undef PG8_STAGE
#undef PG8_LDA
#undef PG8_STAGE_A
#undef PG8_GOFF
#undef PG8_LDB
#undef PG8_MMA
#undef PG8_WAIT_V
#undef PG8_WAIT_L
#undef PG8_BAR
#undef PG8_SCHED
}
}

#include <hip/hip_bf16.h>
#include <cmath>
namespace attn_body {
using bf16=__hip_bfloat16;
using bf16x8=__attribute__((ext_vector_type(8)))short;
using s16x4=__attribute__((ext_vector_type(4)))short;
using f32x16=__attribute__((ext_vector_type(16)))float;
using u32x4=__attribute__((ext_vector_type(4)))unsigned;
constexpr int D=64, QP=3584, KP=3584, VP=3584, OP=1024;
constexpr int NW=8,QBLK=32,QB=QBLK*NW,KVBLK=64;
constexpr int ATTN_UNIT_ROWS=QB;
__device__ __forceinline__ int crow(int r,int hi){return (r&3)+8*(r>>2)+4*hi;}
#define SBAR() __builtin_amdgcn_sched_barrier(0)
__device__ __forceinline__ void cmask(f32x16&p0,f32x16&p1,int jb,int qrel,int hi){
  const float NEG=-INFINITY; int kb=64*jb+4*hi;
  #pragma unroll
  for(int r=0;r<16;++r){int kv=kb+(r&3)+8*(r>>2); if(kv>qrel)p0[r]=NEG; if(kv+32>qrel)p1[r]=NEG;}
}

constexpr int NSLOT=3, SLOTB=8192;
constexpr int LDS_K=0, LDS_V=NSLOT*SLOTB, LDS_WS=2*NSLOT*SLOTB, LDS_OST=LDS_WS+NW*64*4, LDS_BYTES=LDS_OST+NW*4096;
constexpr float C2=0.125f*1.4426950408889634f;
__device__ __forceinline__ void glds16(const void*gsrc,unsigned lds_dst){unsigned keep;
  asm volatile("s_mov_b32 %0, m0\n\ts_mov_b32 m0, %2\n\ts_nop 0\n\tglobal_load_lds_dwordx4 %1, off\n\ts_mov_b32 m0, %0":"=&s"(keep):"v"(gsrc),"s"(lds_dst):"memory");}
__device__ __forceinline__ float max3f(float a,float b,float c){float r;asm("v_max3_f32 %0, %1, %2, %3":"=v"(r):"v"(a),"v"(b),"v"(c));return r;}
__device__ __forceinline__ float max2f(float a,float b){float r;asm("v_max_f32_e32 %0, %1, %2":"=v"(r):"v"(a),"v"(b));return r;}
__device__ __forceinline__ float fadd_s(float a,float b){float r;asm("v_add_f32_e32 %0, %1, %2":"=v"(r):"v"(a),"v"(b));return r;}
__device__ __forceinline__ float fsub_s(float a,float b){float r;asm("v_sub_f32_e32 %0, %1, %2":"=v"(r):"v"(a),"v"(b));return r;}
typedef float f32x2_t __attribute__((ext_vector_type(2))); typedef __bf16 bf16x2_t __attribute__((ext_vector_type(2)));
__device__ __forceinline__ unsigned cvtpk_s(float lo,float hi){f32x2_t v={lo,hi};bf16x2_t b=__builtin_convertvector(v,bf16x2_t);return __builtin_bit_cast(unsigned,b);}
#define WAIT_BAR(N) asm volatile("s_waitcnt vmcnt(" #N ") lgkmcnt(0)\n\ts_barrier":::"memory")

__device__ __forceinline__ void qkt(f32x16&p0,f32x16&p1,const char*Kslot,const bf16x8*qr,const f32x16&negm,int r32,int hi){
  const char*kb=Kslot+hi*1024+r32*16;
  #pragma unroll
  for(int d0=0;d0<4;++d0){
    const bf16x8 b0=*reinterpret_cast<const bf16x8*>(kb+d0*2048);
    const bf16x8 b1=*reinterpret_cast<const bf16x8*>(kb+d0*2048+512);
    if(d0==0){p0=__builtin_amdgcn_mfma_f32_32x32x16_bf16(b0,qr[0],negm,0,0,0);p1=__builtin_amdgcn_mfma_f32_32x32x16_bf16(b1,qr[0],negm,0,0,0);}
    else{p0=__builtin_amdgcn_mfma_f32_32x32x16_bf16(b0,qr[d0],p0,0,0,0);p1=__builtin_amdgcn_mfma_f32_32x32x16_bf16(b1,qr[d0],p1,0,0,0);}}
}
typedef __attribute__((address_space(3))) const char* lds_cptr;
typedef short v4i16_t __attribute__((ext_vector_type(4)));
__device__ __forceinline__ void kload8(bf16x8*kf,lds_cptr kp){
  kf[0]=*(const __attribute__((address_space(3))) bf16x8*)(kp);      kf[1]=*(const __attribute__((address_space(3))) bf16x8*)(kp+512);
  kf[2]=*(const __attribute__((address_space(3))) bf16x8*)(kp+2048); kf[3]=*(const __attribute__((address_space(3))) bf16x8*)(kp+2560);
  kf[4]=*(const __attribute__((address_space(3))) bf16x8*)(kp+4096); kf[5]=*(const __attribute__((address_space(3))) bf16x8*)(kp+4608);
  kf[6]=*(const __attribute__((address_space(3))) bf16x8*)(kp+6144); kf[7]=*(const __attribute__((address_space(3))) bf16x8*)(kp+6656);
}
__device__ __forceinline__ void kload2(bf16x8*kf,lds_cptr kp,int j){ kf[2*j]=*(const __attribute__((address_space(3))) bf16x8*)(kp+j*2048); kf[2*j+1]=*(const __attribute__((address_space(3))) bf16x8*)(kp+j*2048+512); }
__device__ __forceinline__ s16x4 vtr(lds_cptr p){ return __builtin_bit_cast(s16x4,__builtin_amdgcn_ds_read_tr16_b64_v4i16((__attribute__((address_space(3))) v4i16_t*)p)); }
__device__ __forceinline__ float rowmax(const f32x16&p0,const f32x16&p1){
  float a=max3f(p0[0],p0[1],p1[0]),b=max3f(p0[2],p0[3],p1[1]);a=max3f(a,p1[2],p1[3]);
  #pragma unroll
  for(int r=4;r<16;r+=4){a=max3f(a,p0[r],p0[r+1]);b=max3f(b,p0[r+2],p0[r+3]);a=max3f(a,p1[r],p1[r+1]);b=max3f(b,p1[r+2],p1[r+3]);}
  const float m=max2f(a,b);
  auto rr=__builtin_amdgcn_permlane32_swap(__float_as_uint(m),__float_as_uint(m),false,false);
  return max2f(__uint_as_float(rr[0]),__uint_as_float(rr[1]));
}
__device__ __forceinline__ void pv(f32x16*o,int vb,bf16x8 pa0,bf16x8 pa1,bf16x8 pa2,bf16x8 pa3){
  #pragma unroll
  for(int d0=0;d0<2;++d0){s16x4 lo[4],hi[4];
    #pragma unroll
    for(int ks=0;ks<4;++ks){
      asm volatile("ds_read_b64_tr_b16 %0,%1 offset:%c2":"=&v"(lo[ks]):"v"(vb),"i"(d0*4096+ks*1024):"memory");
      asm volatile("ds_read_b64_tr_b16 %0,%1 offset:%c2":"=&v"(hi[ks]):"v"(vb),"i"(d0*4096+ks*1024+512):"memory");}
    asm volatile("s_waitcnt lgkmcnt(0)":::"memory");SBAR();
    #define PK(k) (bf16x8){lo[k][0],lo[k][1],lo[k][2],lo[k][3],hi[k][0],hi[k][1],hi[k][2],hi[k][3]}
    o[d0]=__builtin_amdgcn_mfma_f32_32x32x16_bf16(pa0,PK(0),o[d0],0,0,0);
    o[d0]=__builtin_amdgcn_mfma_f32_32x32x16_bf16(pa1,PK(1),o[d0],0,0,0);
    o[d0]=__builtin_amdgcn_mfma_f32_32x32x16_bf16(pa2,PK(2),o[d0],0,0,0);
    o[d0]=__builtin_amdgcn_mfma_f32_32x32x16_bf16(pa3,PK(3),o[d0],0,0,0);
    #undef PK
  }
}

#ifndef ATTN_STORE16
#define ATTN_STORE16(p,v) (*(u32x4*)(p)=(v))
#endif
template<int THRL> __device__ __forceinline__ void attn_unit(int q0,int NT,const bf16*Qh,const bf16*__restrict__ Kh,const bf16*__restrict__ Vh,bf16*Oh,char*shm,const int tid){
  const int lane=tid&63,r32=lane&31,hi=lane>>5; const int wid=__builtin_amdgcn_readfirstlane(tid>>6);
  const bf16*Qw=Qh+(long)(q0+wid*QBLK)*QP;
  const unsigned lds0=(unsigned)(uintptr_t)shm;
  float*wsf=(float*)(shm+LDS_WS)+wid*64;
  const bf16*ksrc=Kh+(long)lane*KP+wid*8;
  const bf16*vsrc=Vh+(long)(16*(wid&3)+(lane>>2))*VP+(wid>>2)*32+(lane&3)*8;
  const unsigned kdst=lds0+LDS_K+wid*1024, vdst=lds0+LDS_V+wid*1024;
  #define DMA_K(t,slot) glds16(ksrc+(long)(t)*KVBLK*KP,(unsigned)__builtin_amdgcn_readfirstlane(kdst+(slot)))
  #define DMA_V(t,slot) glds16(vsrc+(long)(t)*KVBLK*VP,(unsigned)__builtin_amdgcn_readfirstlane(vdst+(slot)))
  const int vb0=(int)(lds0+LDS_V)+((lane>>4)&1)*32+(lane&3)*8+(4*hi+((lane&15)>>2))*64;
  const char*Kbase=shm+LDS_K; bf16x8 kf[8];
  const lds_cptr shm3=(lds_cptr)shm; const lds_cptr kp0=shm3+LDS_K+hi*1024+r32*16; const lds_cptr vp0=shm3+LDS_V+((lane>>4)&1)*32+(lane&3)*8+(4*hi+((lane&15)>>2))*64;
  DMA_K(0,0);DMA_V(0,0);DMA_K(1,SLOTB);
  bf16x8 qr[4];
  #pragma unroll
  for(int d0=0;d0<4;++d0)qr[d0]=*reinterpret_cast<const bf16x8*>(&Qw[(long)r32*QP+d0*16+hi*8]);
  float mhat=0.f,l_reg=0.f;f32x16 o[2];o[0]=f32x16{};o[1]=f32x16{};f32x16 negm=f32x16{};asm volatile("":"+v"(negm));
  #define CMASK(P0,P1,t) do{}while(0)
  bool resc=false;
  #define START(P0,P1) do{ const float rm=rowmax(P0,P1); resc=false; \
    { const float dl=rm; mhat=fadd_s(mhat,dl); \
      _Pragma("unroll") for(int r=0;r<16;++r){P0[r]=fsub_s(P0[r],dl);P1[r]=fsub_s(P1[r],dl);} \
      _Pragma("unroll") for(int r=0;r<16;++r)negm[r]=-mhat; asm volatile("":"+v"(negm)); } \
    _Pragma("unroll") for(int r=0;r<16;++r)P0[r]=__builtin_amdgcn_exp2f(P0[r]); }while(0)
  #define RESC() do{ if(resc){ asm volatile("s_waitcnt lgkmcnt(0)":::"memory"); \
      _Pragma("unroll") for(int d_=0;d_<2;++d_) _Pragma("unroll") for(int r=0;r<16;++r)o[d_][r]*=wsf[crow(r,hi)]; } }while(0)
  f32x16 pA0,pA1,pB0,pB1;
  int sl_prev=0,sl_cur=0,sl_next=SLOTB;
  #define ROT() do{sl_prev=sl_cur;sl_cur=sl_next;sl_next=(sl_next==(NSLOT-1)*SLOTB)?0:sl_next+SLOTB;}while(0)
  DMA_K(2,2*SLOTB);
  WAIT_BAR(3);
  qkt(pA0,pA1,Kbase,qr,negm,r32,hi);asm volatile("s_nop 15\n\ts_nop 7":"+v"(pA0),"+v"(pA1));CMASK(pA0,pA1,0);
  START(pA0,pA1);
  _Pragma("unroll") for(int r=0;r<16;++r)pA1[r]=__builtin_amdgcn_exp2f(pA1[r]);
  WAIT_BAR(0);
  DMA_K(3,0);DMA_V(1,SLOTB);
  ROT();
  kload8(kf,kp0+sl_cur);
  WAIT_BAR(2);
  s16x4 vlo[8],vhi[8]; u32x4 pw0,pw1,pw2,pw3;
  #define PKW(P,B) cvtpk_s(P[B],P[B+1])
  #define PAF(k) __builtin_bit_cast(bf16x8,pw##k)
  #define VFR(i) (bf16x8){vlo[i][0],vlo[i][1],vlo[i][2],vlo[i][3],vhi[i][0],vhi[i][1],vhi[i][2],vhi[i][3]}
  #define PIN(x) asm volatile("":"+v"(x))
  #define MX3(a,b,c) __builtin_fmaxf(__builtin_fmaxf((a),(b)),(c))
  #define GAPA(MF,A0,A1,A2,A3,W0,W1,PW) do{ MF; sacc+=A0; sacc+=A1; sacc+=A2; sacc+=A3; PIN(sacc); W0; W1; PIN(PW); SBAR(); }while(0)
  #define EX(v) __builtin_amdgcn_exp2f(v)
  #define GAPB(MF,X,B) do{ MF; X[B]=EX(X[B]); X[B+1]=EX(X[B+1]); X[B+2]=EX(X[B+2]); X[B+3]=EX(X[B+3]); PIN(X); SBAR(); }while(0)
  #define VRD(i) do{ vlo[i]=vtr(vp_+(((i)>>2)*4096+((i)&3)*1024)); vhi[i]=vtr(vp_+(((i)>>2)*4096+((i)&3)*1024+512)); }while(0)
  #define KRD(G,j) do{ if(G){ kload2(kf,kp0+sl_next,j); SBAR(); } }while(0)
  #define STEP(C0,C1,P0,P1,t,GK,GV,GL) do{ SBAR(); \
    const lds_cptr vp_=vp0+sl_prev; \
    VRD(0); SBAR(); float sacc=(P0[0]+P0[1]); \
    GAPA(C0=__builtin_amdgcn_mfma_f32_32x32x16_bf16(kf[0],qr[0],negm,0,0,0), P0[2],P0[3],P0[4],P0[5],     pw0[0]=PKW(P0,0), pw0[1]=PKW(P0,2), pw0); \
    VRD(4); SBAR(); GAPA(C1=__builtin_amdgcn_mfma_f32_32x32x16_bf16(kf[1],qr[0],negm,0,0,0), P0[6],P0[7],P0[8],P0[9],     pw0[2]=PKW(P0,4), pw0[3]=PKW(P0,6), pw0); \
    VRD(1); SBAR(); GAPA(C0=__builtin_amdgcn_mfma_f32_32x32x16_bf16(kf[2],qr[1],C0,0,0,0),   P0[10],P0[11],P0[12],P0[13], pw1[0]=PKW(P0,8), pw1[1]=PKW(P0,10), pw1); \
    VRD(5); SBAR(); GAPA(C1=__builtin_amdgcn_mfma_f32_32x32x16_bf16(kf[3],qr[1],C1,0,0,0),   P0[14],P0[15],P1[0],P1[1],   pw1[2]=PKW(P0,12),pw1[3]=PKW(P0,14), pw1); \
    VRD(2); SBAR(); GAPA(C0=__builtin_amdgcn_mfma_f32_32x32x16_bf16(kf[4],qr[2],C0,0,0,0),   P1[2],P1[3],P1[4],P1[5],     pw2[0]=PKW(P1,0), pw2[1]=PKW(P1,2), pw2); \
    VRD(6); SBAR(); GAPA(C1=__builtin_amdgcn_mfma_f32_32x32x16_bf16(kf[5],qr[2],C1,0,0,0),   P1[6],P1[7],P1[8],P1[9],     pw2[2]=PKW(P1,4), pw2[3]=PKW(P1,6), pw2); \
    VRD(3); SBAR(); GAPA(C0=__builtin_amdgcn_mfma_f32_32x32x16_bf16(kf[6],qr[3],C0,0,0,0),   P1[10],P1[11],P1[12],P1[13], pw3[0]=PKW(P1,8), pw3[1]=PKW(P1,10), pw3); \
    VRD(7); SBAR(); GAPA(C1=__builtin_amdgcn_mfma_f32_32x32x16_bf16(kf[7],qr[3],C1,0,0,0),   P1[14],P1[15],0.f,0.f,       pw3[2]=PKW(P1,12),pw3[3]=PKW(P1,14), pw3); \
    l_reg+=sacc; \
    if(GK){DMA_K((t)+3,sl_cur);} if(GV){DMA_V((t)+1,sl_next);} \
    CMASK(C0,C1,t); \
    { float a=MX3(C0[0],C0[1],C1[0]),b=MX3(C0[2],C0[3],C1[1]); a=MX3(a,C1[2],C1[3]); \
      _Pragma("unroll") for(int r=4;r<16;r+=4){a=MX3(a,C0[r],C0[r+1]);b=MX3(b,C0[r+2],C0[r+3]);a=MX3(a,C1[r],C1[r+1]);b=MX3(b,C1[r+2],C1[r+3]);} \
      float rm=__builtin_fmaxf(a,b); { auto rr=__builtin_amdgcn_permlane32_swap(__float_as_uint(rm),__float_as_uint(rm),false,false); rm=__builtin_fmaxf(__uint_as_float(rr[0]),__uint_as_float(rr[1])); } \
      resc=false; \
      if(__builtin_expect(__any(rm>(float)THRL),0)){ const float dl=__builtin_fmaxf(rm,0.f); mhat+=dl; \
        _Pragma("unroll") for(int r=0;r<16;++r){C0[r]-=dl;C1[r]-=dl;} \
        _Pragma("unroll") for(int r=0;r<16;++r)negm[r]=-mhat; asm volatile("":"+v"(negm)); \
        const float f=__builtin_amdgcn_exp2f(-dl); l_reg*=f; if(hi==0)wsf[r32]=f; resc=true; } } \
    SBAR(); \
    GAPB(o[0]=__builtin_amdgcn_mfma_f32_32x32x16_bf16(PAF(0),VFR(0),o[0],0,0,0), C0,0); \
    GAPB(o[1]=__builtin_amdgcn_mfma_f32_32x32x16_bf16(PAF(0),VFR(4),o[1],0,0,0), C0,4); \
    KRD(GL,0); GAPB(o[0]=__builtin_amdgcn_mfma_f32_32x32x16_bf16(PAF(1),VFR(1),o[0],0,0,0), C0,8); \
    KRD(GL,1); GAPB(o[1]=__builtin_amdgcn_mfma_f32_32x32x16_bf16(PAF(1),VFR(5),o[1],0,0,0), C0,12); \
    KRD(GL,2); GAPB(o[0]=__builtin_amdgcn_mfma_f32_32x32x16_bf16(PAF(2),VFR(2),o[0],0,0,0), C1,0); \
    KRD(GL,3); GAPB(o[1]=__builtin_amdgcn_mfma_f32_32x32x16_bf16(PAF(2),VFR(6),o[1],0,0,0), C1,4); \
    GAPB(o[0]=__builtin_amdgcn_mfma_f32_32x32x16_bf16(PAF(3),VFR(3),o[0],0,0,0), C1,8); \
    GAPB(o[1]=__builtin_amdgcn_mfma_f32_32x32x16_bf16(PAF(3),VFR(7),o[1],0,0,0), C1,12); \
    }while(0)
  int t=1;
  #undef CMASK
  #define CMASK(P0,P1,t) do{}while(0)
  for(;t+5<NT;t+=2){
    STEP(pB0,pB1,pA0,pA1,t,true,true,true);     WAIT_BAR(2); RESC(); ROT();
    STEP(pA0,pA1,pB0,pB1,t+1,true,true,true);   WAIT_BAR(2); RESC(); ROT();
  }
  #undef CMASK
  #define CMASK(P0,P1,t) do{}while(0)
  #define ENDW(tt) do{ if((tt)+3<NT){WAIT_BAR(2);} else if((tt)+2<NT){WAIT_BAR(1);} else {WAIT_BAR(0);} }while(0)
  for(;t+1<NT;t+=2){
    STEP(pB0,pB1,pA0,pA1,t,(t+3<NT),(t+1<NT),(t+1<NT));       ENDW(t);   RESC(); ROT();
    STEP(pA0,pA1,pB0,pB1,t+1,(t+4<NT),(t+2<NT),(t+2<NT));     ENDW(t+1); RESC(); ROT();
  }
  STEP(pB0,pB1,pA0,pA1,NT-1,false,false,false); RESC();
  { float sacc=pB0[0]+pB0[1]; _Pragma("unroll") for(int r=2;r<16;++r)sacc+=pB0[r]; _Pragma("unroll") for(int r=0;r<16;++r)sacc+=pB1[r]; l_reg+=sacc;
    pw0=(u32x4){PKW(pB0,0),PKW(pB0,2),PKW(pB0,4),PKW(pB0,6)};pw1=(u32x4){PKW(pB0,8),PKW(pB0,10),PKW(pB0,12),PKW(pB0,14)};pw2=(u32x4){PKW(pB1,0),PKW(pB1,2),PKW(pB1,4),PKW(pB1,6)};pw3=(u32x4){PKW(pB1,8),PKW(pB1,10),PKW(pB1,12),PKW(pB1,14)};
    SBAR(); pv(o,vb0+sl_cur,PAF(0),PAF(1),PAF(2),PAF(3)); }
  #undef PKW
  #undef PAF
  #undef VFR
  #undef PIN
  #undef MX3
  #undef GAPA
  #undef GAPB
  #undef EX
  #undef VRD
  #undef KRD
  #undef STEP
  #undef ENDW
  {float la_=l_reg,lb_=l_reg;asm volatile("s_nop 1\n\tv_permlane32_swap_b32 %0, %1\n\ts_nop 1":"+v"(la_),"+v"(lb_));l_reg=la_+lb_;}
  if(hi==0)wsf[32+r32]=l_reg;asm volatile("s_waitcnt lgkmcnt(0)":::"memory");
  float rli[16];
  #pragma unroll
  for(int r=0;r<16;++r)rli[r]=__builtin_amdgcn_rcpf(wsf[32+crow(r,hi)]);
  bf16*Ow=Oh+(long)(q0+wid*QBLK)*OP;
  { bf16*stg=(bf16*)(shm+LDS_OST)+wid*2048;
    #pragma unroll
    for(int r=0;r<16;++r){const int orow=crow(r,hi);
      #pragma unroll
      for(int d0=0;d0<2;++d0)stg[orow*64+d0*32+r32]=__float2bfloat16(o[d0][r]*rli[r]);}
    asm volatile("s_waitcnt lgkmcnt(0)":::"memory");
    #pragma unroll
#ifdef OUTPROJ_FP8
    #define SATF(x) __builtin_amdgcn_fmed3f((x),-448.0f,448.0f)
    for(int i=0;i<4;++i){const int row=i*8+(lane>>3),ch=lane&7; const u32x4 v=*(const u32x4*)(stg+row*64+ch*8);
      const unsigned vs[4]={v.x,v.y,v.z,v.w}; unsigned o8[2];
      #pragma unroll
      for(int j=0;j<2;++j){int wq=0; wq=__builtin_amdgcn_cvt_pk_fp8_f32(SATF(__builtin_bit_cast(float,vs[2*j]<<16)*4.0f),SATF(__builtin_bit_cast(float,vs[2*j]&0xffff0000u)*4.0f),wq,false);
        wq=__builtin_amdgcn_cvt_pk_fp8_f32(SATF(__builtin_bit_cast(float,vs[2*j+1]<<16)*4.0f),SATF(__builtin_bit_cast(float,vs[2*j+1]&0xffff0000u)*4.0f),wq,true); o8[j]=(unsigned)wq;}
      typedef unsigned u32x2_ __attribute__((ext_vector_type(2)));
      { const int rl=q0+wid*QBLK+row; *(u32x2_*)((unsigned char*)Oh+(long)(rl>>1)*(2*OP)+(rl&1)*64+ch*8)=(u32x2_){o8[0],o8[1]}; } } }
    #undef SATF
#else
    for(int i=0;i<4;++i){const int row=i*8+(lane>>3),ch=lane&7; const u32x4 v=*(const u32x4*)(stg+row*64+ch*8); ATTN_STORE16(Ow+(long)row*OP+ch*8,v);} }
#endif
  asm volatile("s_waitcnt lgkmcnt(0)\n\ts_barrier":::"memory");
  #undef DMA_K
  #undef DMA_V
  #undef CMASK
  #undef START
  #undef RESC
  #undef ROT
}
constexpr int ATTN_LDS_BYTES=LDS_BYTES;
#undef SBAR
#undef WAIT_BAR
}
constexpr int NWAVES = 8, NTHR = 512;
constexpr int NB = 16, T_LAT = 2048, L_CTX = 256, DM = 1024, RPB = T_LAT + L_CTX  , MROWS = NB * RPB  , NPROJ = 3584, DEPTH = 2;
constexpr int NPANEL = MROWS / 256  , PPB = RPB / 256  ;
constexpr float NORM_EPS = 1e-6f;
constexpr int C_HQ = 0, C_HI = 256, C_HZ = 512  , C_HG = 1024, C_CB = 1280, C_CC = 1536, C_CH = 1792, C_RQ = 2048, C_RK = 2304, C_RV = 2560, C_RG = 2816, C_AQ = 3072, C_AK = 3328, C_AV = 3456;
constexpr size_t MiB = 1u << 20;
constexpr size_t WS_CTL = 0, CTL_ZERO_BYTES = 128 * 1024;
constexpr size_t WS_MOD = 1 * MiB;
constexpr size_t WS_ROPE = 2 * MiB;
constexpr size_t WS_ROUTE = 3 * MiB;
constexpr size_t WS_ROWINFO = 4 * MiB;
constexpr size_t WS_BCNT = 5 * MiB;
constexpr size_t WS_TILEINFO = 6 * MiB;
constexpr size_t WS_DBUF = 7 * MiB;
constexpr size_t WS_W0 = 12 * MiB, WLAYER = 33 * MiB;
constexpr size_t WO_WIN = 0;
constexpr size_t WO_WOUT = 7 * MiB;
constexpr size_t WO_WGU = 9 * MiB;
constexpr size_t WO_WD = 25 * MiB;
constexpr size_t WS_CTX = 78 * MiB;
constexpr size_t WS_ACT = 94 * MiB;
constexpr size_t WS_P = 166 * MiB;
constexpr size_t WS_ASORT = WS_P;
constexpr size_t WS_H = WS_P + 84 * MiB;
constexpr size_t WS_KVS = 418 * MiB;
constexpr size_t WS_END = 490 * MiB;
constexpr int MAXTILES = 168;
constexpr int CW_ERR = 16;
constexpr int CW_BAR = 4096;
constexpr int CW_BAR3 = 12288, CW_BAR4 = 16384, CW_BAR5 = 20480;
constexpr int CW_BAR2 = 8192;
constexpr int RING_OFF = 0, RING_BYTES = 139264;
constexpr int LDSCTL_OFF = RING_BYTES, MISC_OFF = LDSCTL_OFF + 320;
constexpr int PTAB_OFF = LDSCTL_OFF + 512;
constexpr int TAB_OFF = LDSCTL_OFF + 1024;
constexpr int LDS_BYTES = 147456;

#define GAS __attribute__((address_space(1)))
#define LAS __attribute__((address_space(3)))
typedef unsigned short bf16;
typedef unsigned v4u __attribute__((ext_vector_type(4)));
typedef unsigned v2u __attribute__((ext_vector_type(2)));
typedef float v2f __attribute__((ext_vector_type(2)));
typedef int v4i __attribute__((ext_vector_type(4)));
typedef float f32x4 __attribute__((ext_vector_type(4)));
typedef GAS unsigned gu32;
#define RLX_AGENT __ATOMIC_RELAXED, __HIP_MEMORY_SCOPE_AGENT
#define LDS_WAIT() asm volatile("s_waitcnt lgkmcnt(0)" ::: "memory")
#define VM_WAIT() asm volatile("s_waitcnt vmcnt(0)" ::: "memory")
typedef float pkf32x2_t __attribute__((ext_vector_type(2))); typedef __bf16 pkbf16x2_t __attribute__((ext_vector_type(2)));
__device__ __forceinline__ unsigned pk2(float lo, float hi) { const pkf32x2_t v = {lo, hi}; return __builtin_bit_cast(unsigned, __builtin_convertvector(v, pkbf16x2_t)); }
__device__ __forceinline__ unsigned f2bf(float f) { return pk2(f, 0.f) & 0xffffu; }
__device__ __forceinline__ float bflo(unsigned w) { return __builtin_bit_cast(float, w << 16); }
__device__ __forceinline__ float bfhi(unsigned w) { return __builtin_bit_cast(float, w & 0xffff0000u); }
__device__ __forceinline__ float bf1(bf16 h) { return __builtin_bit_cast(float, (unsigned)h << 16); }
__device__ __forceinline__ unsigned pk4_fp8(float a, float b, float c, float d) { int w = 0; a = __builtin_amdgcn_fmed3f(a, -448.0f, 448.0f); b = __builtin_amdgcn_fmed3f(b, -448.0f, 448.0f); c = __builtin_amdgcn_fmed3f(c, -448.0f, 448.0f); d = __builtin_amdgcn_fmed3f(d, -448.0f, 448.0f);     w = __builtin_amdgcn_cvt_pk_fp8_f32(a, b, w, false); w = __builtin_amdgcn_cvt_pk_fp8_f32(c, d, w, true); return (unsigned)w; }
__device__ __forceinline__ float fp8_dec(unsigned b) { const unsigned s = b >> 7, e = (b >> 3) & 15u, m = b & 7u; const float v = e ? (float)(8u + m) * exp2f((float)e - 10.0f) : (float)m * 0.001953125f; return s ? -v : v; }
__device__ __forceinline__ float siluf(float x) { return x * __builtin_amdgcn_rcpf(1.0f + __expf(-x)); }
__device__ __forceinline__ float sigmf(float x) { return __builtin_amdgcn_rcpf(1.0f + __expf(-x)); }
template <int K> __device__ __forceinline__ float xshf(float v) { static_assert(K >= 1 && K < 32, "xshf"); return __builtin_bit_cast(float, __builtin_amdgcn_ds_swizzle(__builtin_bit_cast(int, v), (K << 10) | 0x1f)); }
template <int K> __device__ __forceinline__ int xshi(int v) { static_assert(K >= 1 && K < 32, "xshi"); return __builtin_amdgcn_ds_swizzle(v, (K << 10) | 0x1f); }
__device__ __forceinline__ void half_swap(float& a, float& b) { asm volatile("s_nop 1\n\tv_permlane32_swap_b32 %0, %1\n\ts_nop 1" : "+v"(a), "+v"(b)); }
__device__ __forceinline__ float half_sum(float v) { float a = v, b = v; half_swap(a, b); return a + b; }
__device__ __forceinline__ float half_max(float v) { float a = v, b = v; half_swap(a, b); return fmaxf(a, b); }
__device__ __forceinline__ float sum16(float v) { v += xshf<1>(v); v += xshf<2>(v); v += xshf<4>(v); v += xshf<8>(v); return v; }
__device__ __forceinline__ float sum32(float v) { v = sum16(v); v += xshf<16>(v); return v; }
__device__ __forceinline__ float wave_sum(float v) { return half_sum(sum32(v)); }
#define XB_TMO      128
#define XB_XCNT(j)  (256  + 64 * (j))
#define XB_XSUB(j)  (1280 + 64 * (j))
#define XB_XGEN(j)  (2304 + 64 * (j))
#define XB_TOP      3328
#define XB_TOPGEN   3392
#define XCD_BAR_WORDS 3456
#define XB_SPIN_CAP (1u << 18)

__device__ __forceinline__ unsigned xb_ld(unsigned* p)              { return __hip_atomic_load(p, __ATOMIC_RELAXED, __HIP_MEMORY_SCOPE_AGENT); }
__device__ __forceinline__ unsigned xb_add(unsigned* p, unsigned v) { return __hip_atomic_fetch_add(p, v, __ATOMIC_RELAXED, __HIP_MEMORY_SCOPE_AGENT); }
__device__ __forceinline__ unsigned xb_xcc_id() { return (unsigned)__builtin_amdgcn_s_getreg((3 << 11) | 20) & 0xFu; }
#define XB_SPIN(cond, bar) do { unsigned _sp = 0; while (cond) { __builtin_amdgcn_s_sleep(1); \
    if ((++_sp & 255u) == 0u) { if (xb_ld(&(bar)[XB_TMO])) break; if (_sp > XB_SPIN_CAP) { atomicAdd(&(bar)[XB_TMO], 1u); break; } } } } while (0)

struct XcdBarrier {
    unsigned* bar; unsigned x;
    volatile LAS unsigned* st;
};

__device__ __forceinline__ XcdBarrier xcd_barrier_post(unsigned* bar, volatile LAS unsigned* st) {
    XcdBarrier b; b.bar = bar; b.x = xb_xcc_id(); b.st = st;
    if (threadIdx.x == 0) (void)xb_add(&bar[XB_XCNT(b.x)], 1u);
    return b;
}
__device__ __forceinline__ void xcd_barrier_complete(unsigned* bar, unsigned x, unsigned& nloc, unsigned& nx) {
    const unsigned G = gridDim.x * gridDim.y * gridDim.z;
    unsigned sum, cnt, mine, sp = 0u;
    for (;;) {
        sum = 0u; cnt = 0u; mine = 0u;
#pragma unroll
        for (unsigned j = 0; j < 16; ++j) { const unsigned c = xb_ld(&bar[XB_XCNT(j)]); sum += c; cnt += (c > 0u) ? 1u : 0u; mine = (j == x) ? c : mine; }
        if (sum == G) break;
        __builtin_amdgcn_s_sleep(1);
        if ((++sp & 255u) == 0u) { if (xb_ld(&bar[XB_TMO])) break; if (sp > XB_SPIN_CAP) { atomicAdd(&bar[XB_TMO], 1u); break; } }
    }
    nloc = mine > 0u ? mine : 1u; nx = cnt > 0u ? cnt : 1u;
}

__device__ __forceinline__ void xcd_barrier(const XcdBarrier& b) {
    asm volatile("s_waitcnt vmcnt(0)" ::: "memory");
    __syncthreads();
    if (threadIdx.x == 0) {
        unsigned* bar = b.bar; asm volatile("" : "+s"(bar));
        __builtin_amdgcn_s_waitcnt(0);
        unsigned nloc = b.st[0], nx = b.st[1];
        if (nloc == 0u) { xcd_barrier_complete(bar, b.x, nloc, nx); b.st[0] = nloc; b.st[1] = nx; }
#ifdef EARLY_WB
        __builtin_amdgcn_fence(__ATOMIC_RELEASE, "agent"); asm volatile("s_waitcnt vmcnt(0)" ::: "memory");
#endif
        const unsigned old = xb_add(&bar[XB_XSUB(b.x)], 1u);
        const unsigned gen = old / nloc;
#ifdef MID_WB
        if (old + 1u - gen * nloc == MID_WB_AT(nloc)) asm volatile("buffer_wbl2 sc1" ::: "memory");
#endif
        if (old + 1u == (gen + 1u) * nloc) {
            __builtin_amdgcn_fence(__ATOMIC_RELEASE, "agent");
            asm volatile("s_waitcnt vmcnt(0)" ::: "memory");
            const unsigned og = xb_add(&bar[XB_TOP], 1u);
            const unsigned tg = og / nx;
#ifdef EARLY_INV
            asm volatile("buffer_inv sc1" ::: "memory");
            if (og + 1u == (tg + 1u) * nx) xb_add(&bar[XB_TOPGEN], 1u);
            else XB_SPIN(xb_ld(&bar[XB_TOPGEN]) == tg, bar);
            asm volatile("" ::: "memory");
#else
            if (og + 1u == (tg + 1u) * nx) xb_add(&bar[XB_TOPGEN], 1u);
            else XB_SPIN(xb_ld(&bar[XB_TOPGEN]) == tg, bar);
            __builtin_amdgcn_fence(__ATOMIC_ACQUIRE, "agent");
#endif
            xb_add(&bar[XB_XGEN(b.x)], 1u);
            asm volatile("s_waitcnt vmcnt(0)" ::: "memory");
        } else {
#ifdef EARLY_INV
            asm volatile("buffer_inv sc1" ::: "memory");
            XB_SPIN(xb_ld(&bar[XB_XGEN(b.x)]) == gen, bar);
            asm volatile("" ::: "memory");
#else
            XB_SPIN(xb_ld(&bar[XB_XGEN(b.x)]) == gen, bar);
            __builtin_amdgcn_fence(__ATOMIC_ACQUIRE, "agent");
#endif
            asm volatile("s_waitcnt vmcnt(0)" ::: "memory");
        }
    }
    __syncthreads();
}

__device__ __forceinline__ void xcd_split_arrive(const XcdBarrier& b, unsigned* bar2) {
    asm volatile("s_waitcnt vmcnt(0)" ::: "memory");
    __syncthreads();
    if (threadIdx.x == 0) {
        unsigned* bar = bar2; asm volatile("" : "+s"(bar));
        __builtin_amdgcn_s_waitcnt(0);
        unsigned nloc = b.st[0], nx = b.st[1];
        if (nloc == 0u) { xcd_barrier_complete(b.bar, b.x, nloc, nx); b.st[0] = nloc; b.st[1] = nx; }
        const unsigned old = xb_add(&bar[XB_XSUB(b.x)], 1u);
        if ((old + 1u) % nloc == 0u) {
            __builtin_amdgcn_fence(__ATOMIC_RELEASE, "agent");
            asm volatile("s_waitcnt vmcnt(0)" ::: "memory");
            const unsigned og = xb_add(&bar[XB_TOP], 1u);
            if ((og + 1u) % nx == 0u) xb_add(&bar[XB_TOPGEN], 1u);
        }
    }
}
__device__ __forceinline__ void xcd_split_wait(const XcdBarrier& b, unsigned* bar2, unsigned target) {
    if (threadIdx.x == 0) {
        unsigned* bar = bar2; asm volatile("" : "+s"(bar));
        XB_SPIN(xb_ld(&bar[XB_TOPGEN]) < target, bar);
        __builtin_amdgcn_fence(__ATOMIC_ACQUIRE, "agent");
        asm volatile("s_waitcnt vmcnt(0)" ::: "memory");
    }
    __syncthreads();
}
struct Args { const float* in[24]; float* out; unsigned char* ws; size_t ws_shift; };
enum { I_X = 0, I_C, I_CTX, I_CCTX, I_ADAW, I_ADAB, I_NMIX, I_NFFN, I_WIN, I_LB, I_HNORM, I_CONVW, I_RDEC, I_RNORM, I_QN, I_KN, I_WOUT, I_RGW, I_RGB, I_REW, I_REB, I_EG, I_EU, I_ED };
struct Frame {
    LAS unsigned char* lds;
    volatile LAS unsigned* MISC;
    gu32* ctl;
    int tid, lane, wave, vcu, G;
    unsigned bart;
};
__device__ __forceinline__ const void* lptr(const Frame& F, int i) {
    const volatile LAS unsigned* t = (const volatile LAS unsigned*)(F.lds + PTAB_OFF) + 2 * i;
    const unsigned lo = __builtin_amdgcn_readfirstlane(t[0]), hi = __builtin_amdgcn_readfirstlane(t[1]);
    return (const void*)(const GAS void*)(((unsigned long long)hi << 32) | lo);
}
#define PIN(i) ((const float*)lptr(F, (i)))
#define POUT ((float*)lptr(F, 24))
#define PWS ((unsigned char*)lptr(F, 25))
__device__ __forceinline__ int row_of_latent(int idx) { return (idx >> 11) * RPB + L_CTX + (idx & 2047); }

__device__ __forceinline__ void transpose_item(const float* W, int N, int k0, int n0, bf16* dst, int DP, LAS float* scr, int lane) {
#pragma unroll
    for (int i = 0; i < 8; ++i) { const int kk = 8 * i + (lane >> 3), nc = 4 * (lane & 7); const f32x4 v = *(const f32x4*)(W + (size_t)(k0 + kk) * N + n0 + nc);
        scr[kk * 33 + nc] = v.x; scr[kk * 33 + nc + 1] = v.y; scr[kk * 33 + nc + 2] = v.z; scr[kk * 33 + nc + 3] = v.w; }
    LDS_WAIT(); asm volatile("" ::: "memory");
    const int c = lane & 7;
#pragma unroll
    for (int j = 0; j < 4; ++j) { const int n = (lane >> 3) + 8 * j; const LAS float* s = scr + (8 * c) * 33 + n;
        v4u o; o.x = pk2(s[0 * 33], s[1 * 33]); o.y = pk2(s[2 * 33], s[3 * 33]); o.z = pk2(s[4 * 33], s[5 * 33]); o.w = pk2(s[6 * 33], s[7 * 33]);
        *(GAS v4u*)(dst + (size_t)n * DP + 8 * c) = o; }
    LDS_WAIT(); asm volatile("" ::: "memory");
}
__device__ __forceinline__ void transpose_item8(const float* W, int N, int k0, int n0, unsigned char* dst, int DP, float scale, LAS float* scr, int lane) {
#pragma unroll
    for (int i = 0; i < 8; ++i) { const int kk = 8 * i + (lane >> 3), nc = 4 * (lane & 7); const f32x4 v = *(const f32x4*)(W + (size_t)(k0 + kk) * N + n0 + nc) * scale;
        scr[kk * 33 + nc] = v.x; scr[kk * 33 + nc + 1] = v.y; scr[kk * 33 + nc + 2] = v.z; scr[kk * 33 + nc + 3] = v.w; }
    LDS_WAIT(); asm volatile("" ::: "memory");
    const int c = lane & 7;
#pragma unroll
    for (int j = 0; j < 4; ++j) { const int n = (lane >> 3) + 8 * j; const LAS float* s = scr + (8 * c) * 33 + n;
        v2u o; o.x = pk4_fp8(s[0 * 33], s[1 * 33], s[2 * 33], s[3 * 33]); o.y = pk4_fp8(s[4 * 33], s[5 * 33], s[6 * 33], s[7 * 33]);
        *(GAS v2u*)(dst + (size_t)n * DP + 8 * c) = o; }
    LDS_WAIT(); asm volatile("" ::: "memory");
}
struct WItem { const float* src; unsigned char* dst; int N, DP, f8, emu; };
__device__ __forceinline__ WItem witem_decode(const Frame& F, int it) {
    constexpr int PER_LAYER = 1792 + 512 + 3 * 4096;
    const int l = it / PER_LAYER; int r = it - l * PER_LAYER; unsigned char* ws = PWS + WS_W0 + (size_t)l * WLAYER; WItem w; w.emu = 0;
    if (r < 1792) { const int kb = r / 112, nb = r % 112; w.src = PIN(I_WIN) + (size_t)l * 1024 * NPROJ + (size_t)kb * 64 * NPROJ + nb * 32; w.N = NPROJ; w.emu = (EMU_TILES >> (nb >> 3)) & 1;
        if ((INPROJ_F8MASK >> (nb >> 3)) & 1) { w.dst = ws + WO_WIN + (size_t)(nb >> 3) * 524288 + (size_t)((nb & 7) * 32) * 1024 + kb * 64; w.DP = 1024; w.f8 = 1; return w; }
        w.dst = ws + WO_WIN + ((size_t)nb * 32 * 1024 + kb * 64) * 2; w.DP = 2048; w.f8 = 0; return w; }
    r -= 1792;
    if (r < 512) { const int kb = r / 32, nb = r % 32; w.src = PIN(I_WOUT) + (size_t)l * 1024 * 1024 + (size_t)kb * 64 * 1024 + nb * 32; w.N = 1024;
#ifdef OUTPROJ_FP8
        w.dst = ws + WO_WOUT + ((size_t)nb * 32 * 1024 + kb * 64); w.DP = 1024; w.f8 = 1; return w; }
#else
        w.dst = ws + WO_WOUT + ((size_t)nb * 32 * 1024 + kb * 64) * 2; w.DP = 2048; w.f8 = 0; return w; }
#endif
    r -= 512;
    if (r < 8192) { const int up = r >= 4096; r -= up * 4096; const int e = r >> 8, rr = r & 255, kb = rr >> 4, nb = rr & 15, n0 = nb * 32;
        const int drow = e * 1024 + (n0 >> 7) * 256 + up * 128 + (n0 & 127);
        w.src = (up ? PIN(I_EU) : PIN(I_EG)) + (size_t)(l * 16 + e) * 1024 * 512 + (size_t)kb * 64 * 512 + n0; w.N = 512; w.dst = ws + WO_WGU + (size_t)drow * 1024 + kb * 64; w.DP = 1024; w.f8 = 1; return w; }
    r -= 8192;
    { const int e = r >> 8, rr = r & 255, kb = rr >> 5, nb = rr & 31, g = e >> 2, el = e & 3;
        w.src = PIN(I_ED) + (size_t)(l * 16 + e) * 512 * 1024 + (size_t)kb * 64 * 1024 + nb * 32; w.N = 1024; w.dst = ws + WO_WD + ((size_t)g * 1024 + nb * 32) * 2048 + el * 512 + kb * 64; w.DP = 2048; w.f8 = 1; return w; }
}
__device__ __forceinline__ void convert_weights_range(Frame& F, int it0, int it1, int gw, int NGW) {
    LAS float* scr = (LAS float*)(F.lds + F.wave * 16384);
    const int lane = F.lane; const int NITEMS = it1;
    if (gw < 0 || it0 + gw >= NITEMS) return;
    gw += it0;
    const int kr = lane >> 3, nc = 4 * (lane & 7);
    WItem cur = witem_decode(F, gw), nxt = cur, nn = cur; f32x4 v[8], vn[8], vnn[8];
#pragma unroll
    for (int i = 0; i < 8; ++i) v[i] = LDNT((const f32x4*)(cur.src + (size_t)(8 * i + kr) * cur.N + nc));
    if (gw + NGW < NITEMS) { nxt = witem_decode(F, gw + NGW);
#pragma unroll
        for (int i = 0; i < 8; ++i) vn[i] = LDNT((const f32x4*)(nxt.src + (size_t)(8 * i + kr) * nxt.N + nc)); }
    for (int it = gw; it < NITEMS; it += NGW) {
        const int it2 = it + 2 * NGW; const bool more = it + NGW < NITEMS, more2 = it2 < NITEMS;
        if (more2) { nn = witem_decode(F, it2);
#pragma unroll
            for (int i = 0; i < 8; ++i) vnn[i] = LDNT((const f32x4*)(nn.src + (size_t)(8 * i + kr) * nn.N + nc)); }
        const float sc = cur.f8 ? 32.0f : 1.0f;
#pragma unroll
        for (int i = 0; i < 8; ++i) { const int kk = 8 * i + kr; const f32x4 x = v[i] * sc; scr[kk * 33 + nc] = x.x; scr[kk * 33 + nc + 1] = x.y; scr[kk * 33 + nc + 2] = x.z; scr[kk * 33 + nc + 3] = x.w; }
        LDS_WAIT(); asm volatile("" ::: "memory");
        if (cur.f8) {
            const int c4 = lane & 3;
#pragma unroll
            for (int j = 0; j < 2; ++j) { const int n = (lane >> 2) + 16 * j; const LAS float* s = scr + (16 * c4) * 33 + n;
                v4u o; o.x = pk4_fp8(s[0 * 33], s[1 * 33], s[2 * 33], s[3 * 33]); o.y = pk4_fp8(s[4 * 33], s[5 * 33], s[6 * 33], s[7 * 33]);
                o.z = pk4_fp8(s[8 * 33], s[9 * 33], s[10 * 33], s[11 * 33]); o.w = pk4_fp8(s[12 * 33], s[13 * 33], s[14 * 33], s[15 * 33]);
                *(GAS v4u*)(cur.dst + (size_t)n * cur.DP + 16 * c4) = o; }
        } else {
            const int c = lane & 7;
#pragma unroll
            for (int j = 0; j < 4; ++j) { const int n = (lane >> 3) + 8 * j; const LAS float* s = scr + (8 * c) * 33 + n;
                v4u o; o.x = pk2(s[0 * 33], s[1 * 33]); o.y = pk2(s[2 * 33], s[3 * 33]); o.z = pk2(s[4 * 33], s[5 * 33]); o.w = pk2(s[6 * 33], s[7 * 33]); *(GAS v4u*)(cur.dst + (size_t)n * cur.DP + 16 * c) = o; }
        }
        LDS_WAIT(); asm volatile("" ::: "memory");
        if (more) { cur = nxt; nxt = nn;
#pragma unroll
            for (int i = 0; i < 8; ++i) { v[i] = vn[i]; vn[i] = vnn[i]; } }
    }
}

__device__ __forceinline__ void p0_prologue(Frame& F, const XcdBarrier& gbar) {
    unsigned char* ws = PWS;
    {
        LAS float* sc = (LAS float*)(F.lds);
        LAS float* red = (LAS float*)(F.lds + 17 * 4096);
        bool staged = false;
        const float* pC = PIN(I_C); const float* pCC = PIN(I_CCTX); const float* pAW = PIN(I_ADAW); const float* pAB = PIN(I_ADAB); const float* pNM = PIN(I_NMIX); const float* pNF = PIN(I_NFFN);
#ifdef MOD_WIDE
        typedef float f32x3 __attribute__((ext_vector_type(3)));
        for (int it = F.vcu; it < DEPTH * 128; it += F.G) {
            if (!staged) {
                for (int i = F.tid; i < 17 * 1024; i += NTHR) { const float v = (i < 16 * 1024) ? pC[i] : pCC[i - 16 * 1024]; sc[i] = siluf(v); }
                staged = true;
            }
            __syncthreads();
            const int l = it >> 7, cb = it & 127, n0 = cb * 48, nn = F.tid & 15, ks = F.tid >> 4;
            const float* W = pAW + (size_t)l * 1024 * 6144 + n0 + 3 * nn;
            f32x3 acc[17];
#pragma unroll
            for (int m = 0; m < 17; ++m) acc[m] = (f32x3){0.f, 0.f, 0.f};
            for (int k = ks * 32; k < ks * 32 + 32; k += 4) {
                const f32x3 w0 = *(const f32x3*)(W + (size_t)k * 6144), w1 = *(const f32x3*)(W + (size_t)(k + 1) * 6144), w2 = *(const f32x3*)(W + (size_t)(k + 2) * 6144), w3 = *(const f32x3*)(W + (size_t)(k + 3) * 6144);
#pragma unroll
                for (int m = 0; m < 17; ++m) { const f32x4 s4 = *(const LAS f32x4*)(sc + m * 1024 + k); acc[m] += (w0 * s4.x + w1 * s4.y) + (w2 * s4.z + w3 * s4.w); } }
#pragma unroll
            for (int m = 0; m < 17; ++m) { float a = acc[m].x, b = acc[m].y, c3 = acc[m].z; a += xshf<16>(a); b += xshf<16>(b); c3 += xshf<16>(c3); acc[m] = (f32x3){half_sum(a), half_sum(b), half_sum(c3)}; }
            if (F.lane < 16) {
#pragma unroll
                for (int m = 0; m < 17; ++m) { LAS float* rp = red + (F.wave * 17 + m) * 48 + 3 * nn; rp[0] = acc[m].x; rp[1] = acc[m].y; rp[2] = acc[m].z; } }
            __syncthreads();
            for (int i = F.tid; i < 17 * 48; i += NTHR) { const int m = i / 48, n2 = i - m * 48, gcol = n0 + n2; float v = pAB[l * 6144 + gcol];
#pragma unroll
                for (int k2 = 0; k2 < 8; ++k2) v += red[(k2 * 17 + m) * 48 + n2];
                const int kch = gcol >> 10, col = gcol & 1023;
                if (kch == 1) v = pNM[l * 1024 + col] * (1.0f + v);
                if (kch == 4) v = pNF[l * 1024 + col] * (1.0f + v);
                ((float*)(ws + WS_MOD) + (size_t)(l * 6 + kch) * 17 * 1024)[m * 1024 + col] = v; }
        }
#else
        for (int it = F.vcu; it < DEPTH * 192; it += F.G) {
            if (!staged) {
                for (int i = F.tid; i < 17 * 1024; i += NTHR) { const float v = (i < 16 * 1024) ? pC[i] : pCC[i - 16 * 1024]; sc[i] = siluf(v); }
                staged = true;
            }
            __syncthreads();
            const int l = it / 192, cb = it % 192, n0 = cb * 32, nn = F.tid & 31, ks = F.tid >> 5;
            const float* W = pAW + (size_t)l * 1024 * 6144 + n0 + nn;
            float acc[17];
#pragma unroll
            for (int m = 0; m < 17; ++m) acc[m] = 0.f;
            for (int k = ks * 64; k < ks * 64 + 64; k += 4) { const float w0 = W[(size_t)k * 6144], w1 = W[(size_t)(k + 1) * 6144], w2 = W[(size_t)(k + 2) * 6144], w3 = W[(size_t)(k + 3) * 6144];
#pragma unroll
                for (int m = 0; m < 17; ++m) { const f32x4 s4 = *(const LAS f32x4*)(sc + m * 1024 + k); acc[m] += (s4.x * w0 + s4.y * w1) + (s4.z * w2 + s4.w * w3); } }
#pragma unroll
            for (int m = 0; m < 17; ++m) red[(ks * 17 + m) * 32 + nn] = acc[m];
            __syncthreads();
            const int kch = n0 >> 10, cc = n0 & 1023;
            float* MOD = (float*)(ws + WS_MOD) + (size_t)(l * 6 + kch) * 17 * 1024;
            for (int i = F.tid; i < 17 * 32; i += NTHR) { const int m = i >> 5, n2 = i & 31; float v = pAB[l * 6144 + n0 + n2];
#pragma unroll
                for (int k2 = 0; k2 < 16; ++k2) v += red[(k2 * 17 + m) * 32 + n2];
                const int col = cc + n2;
                if (kch == 1) v = pNM[l * 1024 + col] * (1.0f + v);
                if (kch == 4) v = pNF[l * 1024 + col] * (1.0f + v);
                MOD[m * 1024 + col] = v; }
        }
#endif
        __syncthreads();
    }
#ifdef SPLIT_PRO
    xcd_split_arrive(gbar, (unsigned*)(F.ctl + CW_BAR3));
#endif
    {
        float* RC = (float*)(ws + WS_ROPE); float* RS = RC + 2048 * 32;
        for (int i = (F.vcu * NTHR + F.tid); i < 2048 * 32; i += F.G * NTHR) { const int t = i >> 5, f = i & 31; const float pos = (float)((f < 16) ? (t >> 6) : (t & 63));
            const float invf = exp2f(-(float)(f & 15) * (13.287712379549449f / 16.0f)); const float ang = pos * invf; RC[i] = cosf(ang); RS[i] = sinf(ang); }
    }
    __syncthreads();
    convert_weights_range(F, 0, 1792 + 512 + 3 * 4096, F.vcu * NWAVES + F.wave, F.G * NWAVES);
    __syncthreads();
}
__device__ __forceinline__ void phase_norm1(Frame& F, const float* xsrc, const float* csrc, const float* nA, const float* nB, bf16* dst, unsigned char* dst8) {
    const int gw = F.vcu * NWAVES + F.wave, NGW = F.G * NWAVES, RPW = (MROWS + NGW - 1) / NGW;
    const int c0 = 8 * F.lane;
    int curm = -1; f32x4 a[4], bb[4];
#ifdef N1_INTERLEAVE
    (void)RPW; for (int r = gw; r < MROWS; r += NGW) {
#else
    for (int r = gw * RPW; r < (gw + 1) * RPW && r < MROWS; ++r) {
#endif
        const int b = r / RPB, j = r - b * RPB, m = (j < L_CTX) ? 16 : b;
        const float* src = (j < L_CTX) ? csrc + (size_t)(b * L_CTX + j) * DM : xsrc + (size_t)(b * T_LAT + j - L_CTX) * DM;
        if (m != curm) { curm = m;
#pragma unroll
            for (int q = 0; q < 4; ++q) { a[q] = *(const f32x4*)(nA + m * 1024 + c0 + 512 * (q >> 1) + 4 * (q & 1)); bb[q] = *(const f32x4*)(nB + m * 1024 + c0 + 512 * (q >> 1) + 4 * (q & 1)); } }
        f32x4 v[4]; float ss = 0.f;
#pragma unroll
        for (int q = 0; q < 4; ++q) { v[q] = LDNT((const f32x4*)(src + c0 + 512 * (q >> 1) + 4 * (q & 1))); ss += (v[q].x * v[q].x + v[q].y * v[q].y) + (v[q].z * v[q].z + v[q].w * v[q].w); }
        const float rstd = __builtin_amdgcn_rsqf(wave_sum(ss) * (1.0f / DM) + NORM_EPS);
#pragma unroll
        for (int q = 0; q < 2; ++q) { const f32x4 o0 = v[2 * q] * rstd * a[2 * q] + bb[2 * q], o1 = v[2 * q + 1] * rstd * a[2 * q + 1] + bb[2 * q + 1];
            v4u w; w.x = pk2(o0.x, o0.y); w.y = pk2(o0.z, o0.w); w.z = pk2(o1.x, o1.y); w.w = pk2(o1.z, o1.w);
            *(v4u*)(dst + (size_t)r * DM + c0 + 512 * q) = w;
            if (INPROJ_F8MASK) { v2u w8; w8.x = pk4_fp8(o0.x, o0.y, o0.z, o0.w); w8.y = pk4_fp8(o1.x, o1.y, o1.z, o1.w); *(v2u*)(dst8 + (size_t)r * DM + c0 + 512 * q) = w8; } }
    }
}

#ifdef REV_A
#define PREP_ROW(r) (MROWS - 1 - (r))
#else
#define PREP_ROW(r) (r)
#endif
template <bool DRY = false>
__device__ __forceinline__ void phase_prep(Frame& F, bf16* P, const float* qn, const float* kn, const float* RC, const float* RS) {
    const int gw = F.vcu * NWAVES + F.wave, NGW = F.G * NWAVES;
    const int L = F.lane; const bool act = L < 48, isq = L < 32;
    const int col = isq ? C_AQ + 8 * L : C_AK + 8 * (L - 32), e0 = (8 * L) & 63, p0 = e0 >> 1;
    const float* gp = isq ? qn : kn; const f32x4 g0 = *(const f32x4*)(gp + e0), g1 = *(const f32x4*)(gp + e0 + 4);
    constexpr float C2 = 0.125f * 1.4426950408889634f; const float sc = isq ? C2 : 1.0f;
    for (int r0 = gw; r0 < MROWS; r0 += 4 * NGW) {
        v4u wv[4]; f32x4 cs[4], sn[4]; bool ok[4];
#pragma unroll
        for (int u = 0; u < 4; ++u) { const int r = r0 + u * NGW; ok[u] = r < MROWS; const int rr = ok[u] ? PREP_ROW(r) : gw; const int b = rr / RPB, j = rr - b * RPB; const bool lat = j >= L_CTX;
            cs[u] = (f32x4){1.f, 1.f, 1.f, 1.f}; sn[u] = (f32x4){0.f, 0.f, 0.f, 0.f}; if (lat) { cs[u] = *(const f32x4*)(RC + (j - L_CTX) * 32 + p0); sn[u] = *(const f32x4*)(RS + (j - L_CTX) * 32 + p0); }
            wv[u] = act ? *(const v4u*)(P + (size_t)rr * NPROJ + col) : (v4u){0u, 0u, 0u, 0u}; }
#pragma unroll
        for (int u = 0; u < 4; ++u) { const int r = PREP_ROW(r0 + u * NGW);
            const unsigned ww[4] = {wv[u].x, wv[u].y, wv[u].z, wv[u].w}; float x[8]; float ss = 0.f;
#pragma unroll
            for (int i = 0; i < 4; ++i) { x[2 * i] = bflo(ww[i]); x[2 * i + 1] = bfhi(ww[i]); ss += x[2 * i] * x[2 * i] + x[2 * i + 1] * x[2 * i + 1]; }
            ss += xshf<1>(ss); ss += xshf<2>(ss); ss += xshf<4>(ss);
            const float rstd = __builtin_amdgcn_rsqf(ss * (1.0f / 64.0f) + NORM_EPS) * sc;
            const float gg[8] = {g0.x, g0.y, g0.z, g0.w, g1.x, g1.y, g1.z, g1.w}, cc[4] = {cs[u].x, cs[u].y, cs[u].z, cs[u].w}, sv[4] = {sn[u].x, sn[u].y, sn[u].z, sn[u].w};
            unsigned o[4];
#pragma unroll
            for (int i = 0; i < 4; ++i) { const float y1 = x[2 * i] * rstd * gg[2 * i], y2 = x[2 * i + 1] * rstd * gg[2 * i + 1]; o[i] = pk2(y1 * cc[i] - y2 * sv[i], y1 * sv[i] + y2 * cc[i]); }
            if (DRY) { asm volatile("" : "+v"(o[0]), "+v"(o[3])); o[0] = wv[u].x; o[1] = wv[u].y; o[2] = wv[u].z; o[3] = wv[u].w; }
            if (ok[u] && act) *(v4u*)(P + (size_t)r * NPROJ + col) = (v4u){o[0], o[1], o[2], o[3]}; }
    }
}
namespace rc {
constexpr int PT = 144, MB = 64 * PT;
constexpr int O_QP = 0, O_QQ = MB, O_KP = 2 * MB, O_VT = 3 * MB, O_ST = 4 * MB, O_AT = 5 * MB, O_TOT = 6 * MB, SLOT = 6 * MB + 2048;
constexpr int OXP = 68;
typedef float f32x16 __attribute__((ext_vector_type(16)));
typedef float f32x4v __attribute__((ext_vector_type(4)));
typedef short bf16x8 __attribute__((ext_vector_type(8)));
__device__ __forceinline__ int crow(int r, int hi) { return (r & 3) + 8 * (r >> 2) + 4 * hi; }
__device__ __forceinline__ bf16x8 frag32(const LAS unsigned char* M, int row, int kcol, int hi) { return *(const LAS bf16x8*)(M + row * PT + (kcol + hi * 8) * 2); }
__device__ __forceinline__ float clampe(float x) { return fminf(fmaxf(x, -60.f), 60.f); }
__device__ __forceinline__ int seq_of(int mixer, int b, int h, int dir) { return ((mixer * NB + b) * 4 + h) * 2 + dir; }
__device__ __forceinline__ int row_in_batch(int dir, int n) { return (dir == 0) ? n : (n < L_CTX ? (L_CTX - 1 - n) : (RPB + L_CTX - 1 - n)); }
}
struct StageARaw { v4u k[8], v[8]; };
__device__ __forceinline__ void stageA_load(StageARaw& R, const Frame& F, const bf16* P, int mixer, int b, int h, int dir, int c) {
    using namespace rc;
    const int lane = F.lane, r8 = lane >> 3, ch = lane & 7;
    const int ck = (mixer == 0 ? C_HZ + 256 * dir : C_RK) + h * 64 + 8 * ch, cv = (mixer == 0 ? C_HI : C_RV) + h * 64 + 8 * ch;
    const int j0 = row_in_batch(dir, c * 64 + r8); const long step = (dir == 0) ? 8L * NPROJ : -8L * NPROJ;
    const bf16* rp = P + (size_t)(b * RPB + j0) * NPROJ;
#pragma unroll
    for (int i = 0; i < 8; ++i) { R.k[i] = *(const v4u*)(rp + ck); R.v[i] = *(const v4u*)(rp + cv); rp += step; }
}
template <int MIXER>
__device__ __forceinline__ void stageA_compute(const StageARaw& R, Frame& F, bf16* KVS, float* DBUF, int b, int h, int dir, int c, const float* lblog, float gamma) {
    using namespace rc;
    constexpr int HP = 80;
    LAS unsigned char* WL = F.lds + F.wave * 10240; LAS unsigned char* KT = WL; LAS unsigned char* VTm = WL + 5120;
    const int lane = F.lane, seq = seq_of(MIXER, b, h, dir), r8 = lane >> 3, ch = lane & 7;
    unsigned kp[32], vp[32];
    {
        float kk[64];
#pragma unroll
        for (int i = 0; i < 8; ++i) *(LAS v4u*)(WL + (r8 + 8 * i) * PT + 16 * ch) = R.k[i];
#pragma unroll
        for (int s = 0; s < 64; ++s) kk[s] = bf1(*(const LAS unsigned short*)(WL + s * PT + 2 * lane));
        if (MIXER == 0) {
            const float lb = lblog ? sigmf(lblog[512 + dir * 256 + h * 64 + lane] - lblog[dir * 256 + h * 64 + lane]) : 0.f;
            float run = 1.f;
#pragma unroll
            for (int s = 63; s >= 0; --s) { const float f = lb + (1.0f - lb) * sigmf(kk[s]); kk[s] = (1.0f - f) * run; run *= f; }
            DBUF[(size_t)(seq * 36 + c) * 64 + lane] = run;
        } else {
            float pw = 1.f;
#pragma unroll
            for (int s = 63; s >= 0; --s) { kk[s] *= pw; pw *= gamma; }
        }
#pragma unroll
        for (int s = 0; s < 32; ++s) kp[s] = pk2(kk[2 * s], kk[2 * s + 1]);
    }
#pragma unroll
    for (int i = 0; i < 8; ++i) *(LAS v4u*)(WL + (r8 + 8 * i) * PT + 16 * ch) = R.v[i];
#pragma unroll
    for (int s = 0; s < 32; ++s) vp[s] = (unsigned)*(const LAS unsigned short*)(WL + (2 * s) * PT + 2 * lane) | ((unsigned)*(const LAS unsigned short*)(WL + (2 * s + 1) * PT + 2 * lane) << 16);
    const int r = lane & 15, g = lane >> 4;
    f32x4v acc[4][4];
#pragma unroll
    for (int a = 0; a < 4; ++a)
#pragma unroll
        for (int q = 0; q < 4; ++q) acc[a][q] = (f32x4v){0.f, 0.f, 0.f, 0.f};
#pragma unroll
    for (int hh = 0; hh < 2; ++hh) {
#pragma unroll
        for (int i = 0; i < 4; ++i) { const int s0 = 32 * hh + 8 * i; v4u ko, vo;
            ko.x = kp[s0 / 2]; ko.y = kp[s0 / 2 + 1]; ko.z = kp[s0 / 2 + 2]; ko.w = kp[s0 / 2 + 3];
            vo.x = vp[s0 / 2]; vo.y = vp[s0 / 2 + 1]; vo.z = vp[s0 / 2 + 2]; vo.w = vp[s0 / 2 + 3];
            *(LAS v4u*)(KT + lane * HP + 16 * i) = ko; *(LAS v4u*)(VTm + lane * HP + 16 * i) = vo; }
        bf16x8 af[4], bfr[4];
#pragma unroll
        for (int q = 0; q < 4; ++q) { af[q] = *(const LAS bf16x8*)(VTm + (16 * q + r) * HP + 16 * g); bfr[q] = *(const LAS bf16x8*)(KT + (16 * q + r) * HP + 16 * g); }
#pragma unroll
        for (int a = 0; a < 4; ++a)
#pragma unroll
            for (int q = 0; q < 4; ++q) acc[a][q] = __builtin_amdgcn_mfma_f32_16x16x32_bf16(af[a], bfr[q], acc[a][q], 0, 0, 0);
    }
#pragma unroll
    for (int a = 0; a < 4; ++a)
#pragma unroll
        for (int q = 0; q < 4; ++q)
#pragma unroll
            for (int x = 0; x < 4; ++x) *(LAS unsigned short*)(WL + (16 * a + 4 * g + x) * PT + (16 * q + r) * 2) = (unsigned short)f2bf(acc[a][q][x]);
    bf16* dst = KVS + (size_t)(seq * 36 + c) * 4096;
#pragma unroll
    for (int i = 0; i < 8; ++i) { const int idx = lane + 64 * i, e = idx >> 3, d8 = idx & 7; *(v4u*)(dst + e * 64 + d8 * 8) = *(const LAS v4u*)(WL + e * PT + d8 * 16); }
}
__device__ __forceinline__ void recur_stageA_loop(Frame& F, const bf16* P, bf16* KVS, float* DBUF, int u0, int stride, int nunits, const float* lblog, const float* rdec) {
    if (u0 >= nunits) return;
    StageARaw cur;
#define STA_DECODE(u_, it__) const int mh_ = ((u_) + (it__)) & 7, rest_ = (u_) >> 3, c_ = rest_ % 36, bd_ = rest_ / 36, b_ = bd_ >> 1, dir_ = bd_ & 1, mixer_ = mh_ >> 2, h_ = mh_ & 3
    int it = 0;
    for (int u = u0; u < nunits; u += stride, ++it) {
#ifdef REV_A
        STA_DECODE(nunits - 1 - u, it);
#else
        STA_DECODE(u, it);
#endif
        stageA_load(cur, F, P, mixer_, b_, h_, dir_, c_);
        if (mixer_ == 0) stageA_compute<0>(cur, F, KVS, DBUF, b_, h_, dir_, c_, lblog, 0.f);
        else stageA_compute<1>(cur, F, KVS, DBUF, b_, h_, dir_, c_, nullptr, sigmf(rdec[dir_ * 4 + h_]));
    }
#undef STA_DECODE
}
template <int MIXER, bool DRY = false>
__device__ __forceinline__ void recur_stageB_seq(Frame& F, bf16* KVS, const float* DBUF, int seq, float gamma) {
    const int e = F.tid >> 3, d8 = F.tid & 7;
    bf16* base = KVS + (size_t)seq * 36 * 4096 + e * 64 + d8 * 8; const float* db = DBUF + (size_t)seq * 36 * 64 + d8 * 8;
    float S[8];
#pragma unroll
    for (int i = 0; i < 8; ++i) S[i] = 0.f;
    const float g64 = (MIXER == 1) ? exp2f(64.0f * __log2f(gamma)) : 0.f;
    constexpr int GB = 4;
    v4u kv[GB], kvn[GB]; f32x4 da[GB], dbv[GB], dan[GB], dbn[GB];
#pragma unroll
    for (int i = 0; i < GB; ++i) { kv[i] = *(const v4u*)(base + (size_t)i * 4096); da[i] = (f32x4){g64, g64, g64, g64}; dbv[i] = da[i];
        if (MIXER == 0) { da[i] = *(const f32x4*)(db + i * 64); dbv[i] = *(const f32x4*)(db + i * 64 + 4); } }
    for (int c0 = 0; c0 < 36; c0 += GB) {
#pragma unroll
        for (int i = 0; i < GB; ++i) { kvn[i] = kv[i]; dan[i] = da[i]; dbn[i] = dbv[i];
            if (c0 + GB < 36) { kvn[i] = *(const v4u*)(base + (size_t)(c0 + GB + i) * 4096); if (MIXER == 0) { dan[i] = *(const f32x4*)(db + (c0 + GB + i) * 64); dbn[i] = *(const f32x4*)(db + (c0 + GB + i) * 64 + 4); } } }
#pragma unroll
        for (int i = 0; i < GB; ++i) {
            v4u so; so.x = pk2(S[0], S[1]); so.y = pk2(S[2], S[3]); so.z = pk2(S[4], S[5]); so.w = pk2(S[6], S[7]);
            if (DRY) { so = kv[i]; asm volatile("" : "+v"(S[0]), "+v"(S[7])); }
            *(v4u*)(base + (size_t)(c0 + i) * 4096) = so;
            const float dd[8] = {da[i].x, da[i].y, da[i].z, da[i].w, dbv[i].x, dbv[i].y, dbv[i].z, dbv[i].w}; const unsigned kw[4] = {kv[i].x, kv[i].y, kv[i].z, kv[i].w};
#pragma unroll
            for (int q = 0; q < 4; ++q) { S[2 * q] = dd[2 * q] * S[2 * q] + bflo(kw[q]); S[2 * q + 1] = dd[2 * q + 1] * S[2 * q + 1] + bfhi(kw[q]); }
        }
#pragma unroll
        for (int i = 0; i < GB; ++i) { kv[i] = kvn[i]; da[i] = dan[i]; dbv[i] = dbn[i]; }
    }
}
struct StageCRaw { v4u q[2], k[2], v[2]; v4u s0, s1, g; };
template <int MIXER>
__device__ __forceinline__ void stageC_load(StageCRaw& R, const Frame& F, const bf16* P, const bf16* KVS, int b, int h, int tb) {
    using namespace rc;
    const int dir = F.wave >> 2, wq = F.wave & 3, lane = F.lane, tr = lane >> 3, ch = lane & 7;
    const int c = (dir == 0) ? tb : (tb < 4 ? 3 - tb : 39 - tb), seq = seq_of(MIXER, b, h, dir);
    const int cq = (MIXER == 0 ? C_HQ : C_RQ) + h * 64 + 8 * ch, ck = (MIXER == 0 ? C_HZ + 256 * dir : C_RK) + h * 64 + 8 * ch, cv = (MIXER == 0 ? C_HI : C_RV) + h * 64 + 8 * ch;
    const int j0 = row_in_batch(dir, c * 64 + 16 * wq + tr); const long step = (dir == 0) ? 8L * NPROJ : -8L * NPROJ;
    const bf16* rp = P + (size_t)(b * RPB + j0) * NPROJ;
#pragma unroll
    for (int ii = 0; ii < 2; ++ii) { R.q[ii] = *(const v4u*)(rp + cq); R.k[ii] = *(const v4u*)(rp + ck); R.v[ii] = *(const v4u*)(rp + cv); rp += step; }
    const bf16* src = KVS + (size_t)(seq * 36 + c) * 4096; const int t256 = wq * 64 + lane;
    R.s0 = *(const v4u*)(src + (t256 >> 3) * 64 + (t256 & 7) * 8); R.s1 = *(const v4u*)(src + ((t256 + 256) >> 3) * 64 + (t256 & 7) * 8);
    { const int tok = F.tid >> 3, ech = F.tid & 7; R.g = *(const v4u*)(P + (size_t)(b * RPB + tb * 64 + tok) * NPROJ + (MIXER == 0 ? C_HG : C_RG) + h * 64 + 8 * ech); }
}
template <int MIXER>
__device__ __forceinline__ void stageC_compute(const StageCRaw& R, Frame& F, bf16* ACTo, int b, int h, int tb, const float* lblog, const float* rdec, const float* gain) {
    using namespace rc;
    const int dir = F.wave >> 2, wq = F.wave & 3, lane = F.lane, tr = lane >> 3, ch = lane & 7;
    LAS unsigned char* SL = F.lds + dir * SLOT;
    { const int t256 = wq * 64 + lane;
      *(LAS v4u*)(SL + O_ST + (t256 >> 3) * PT + (t256 & 7) * 16) = R.s0; *(LAS v4u*)(SL + O_ST + ((t256 + 256) >> 3) * PT + (t256 & 7) * 16) = R.s1; }
#ifdef VT_PAIR
#pragma unroll
    for (int ii = 0; ii < 2; ++ii) { const int t = 16 * wq + tr + 8 * ii; *(LAS v4u*)(SL + O_AT + t * PT + 16 * ch) = R.v[ii]; }
    { const int cpv = lane & 31, thv = lane >> 5, t0v = 16 * wq + 8 * thv; unsigned vw8[8];
#pragma unroll
      for (int i = 0; i < 8; ++i) vw8[i] = *(const LAS unsigned*)(SL + O_AT + (t0v + i) * PT + 4 * cpv);
      v4u lo4, hi4;
      lo4.x = (vw8[0] & 0xffffu) | (vw8[1] << 16); lo4.y = (vw8[2] & 0xffffu) | (vw8[3] << 16); lo4.z = (vw8[4] & 0xffffu) | (vw8[5] << 16); lo4.w = (vw8[6] & 0xffffu) | (vw8[7] << 16);
      hi4.x = (vw8[0] >> 16) | (vw8[1] & 0xffff0000u); hi4.y = (vw8[2] >> 16) | (vw8[3] & 0xffff0000u); hi4.z = (vw8[4] >> 16) | (vw8[5] & 0xffff0000u); hi4.w = (vw8[6] >> 16) | (vw8[7] & 0xffff0000u);
      *(LAS v4u*)(SL + O_VT + (2 * cpv) * PT + t0v * 2) = lo4; *(LAS v4u*)(SL + O_VT + (2 * cpv + 1) * PT + t0v * 2) = hi4; }
#else
#pragma unroll
    for (int ii = 0; ii < 2; ++ii) { const int t = 16 * wq + tr + 8 * ii; const unsigned vw[4] = {R.v[ii].x, R.v[ii].y, R.v[ii].z, R.v[ii].w};
#pragma unroll
        for (int x = 0; x < 4; ++x) { *(LAS unsigned short*)(SL + O_VT + (8 * ch + 2 * x) * PT + t * 2) = (unsigned short)(vw[x] & 0xffffu); *(LAS unsigned short*)(SL + O_VT + (8 * ch + 2 * x + 1) * PT + t * 2) = (unsigned short)(vw[x] >> 16); } }
#endif
    if (MIXER == 0) {
#pragma unroll
        for (int ii = 0; ii < 2; ++ii) { const int t = 16 * wq + tr + 8 * ii; *(LAS v4u*)(SL + O_QP + t * PT + 16 * ch) = R.q[ii]; *(LAS v4u*)(SL + O_KP + t * PT + 16 * ch) = R.k[ii]; }
#ifdef HGRN_PACK
        const int cp = lane & 31, th = lane >> 5, tb0 = 16 * wq + 8 * th;
        float qa[8], qb[8], ka[8], kb[8], pa[8], pb[8];
#pragma unroll
        for (int i = 0; i < 8; ++i) { const unsigned qw = *(const LAS unsigned*)(SL + O_QP + (tb0 + i) * PT + 4 * cp), kw = *(const LAS unsigned*)(SL + O_KP + (tb0 + i) * PT + 4 * cp);
            qa[i] = bflo(qw); qb[i] = bfhi(qw); ka[i] = bflo(kw); kb[i] = bfhi(kw); }
        float lba = 0.f, lbb = 0.f;
        if (lblog) { const float* l0 = lblog + dir * 256 + h * 64 + 2 * cp; lba = sigmf(l0[512] - l0[0]); lbb = sigmf(l0[513] - l0[1]); }
        float ra = 1.f, rb = 1.f;
#pragma unroll
        for (int i = 0; i < 8; ++i) { const float fa = lba + (1.0f - lba) * sigmf(ka[i]), fb = lbb + (1.0f - lbb) * sigmf(kb[i]); ra *= fa; rb *= fb; pa[i] = ra; pb[i] = rb; ka[i] = 1.0f - fa; kb[i] = 1.0f - fb; }
        float oa, ob; { float x = ra, y = ra; half_swap(x, y); oa = th ? x : y; x = rb; y = rb; half_swap(x, y); ob = th ? x : y; }
        LAS float* TOT = (LAS float*)(SL + O_TOT);
        if (th == 0) *(LAS v2f*)(TOT + wq * 64 + 2 * cp) = (v2f){ra * oa, rb * ob};
        __syncthreads();
        float prea = th ? oa : 1.f, preb = th ? ob : 1.f;
        v2f t4[4];
#pragma unroll
        for (int q = 0; q < 4; ++q) { t4[q] = *(const LAS v2f*)(TOT + q * 64 + 2 * cp); if (q < wq) { prea *= t4[q].x; preb *= t4[q].y; } }
        const float rma = __builtin_amdgcn_rcpf(fmaxf(t4[0].x * t4[1].x, 1e-30f)), rmb = __builtin_amdgcn_rcpf(fmaxf(t4[0].y * t4[1].y, 1e-30f));
#pragma unroll
        for (int i = 0; i < 8; ++i) { const float pta = prea * pa[i], ptb = preb * pb[i];
            const float e1a = fminf(fmaxf(pta * rma, 1e-30f), 1e30f), e1b = fminf(fmaxf(ptb * rmb, 1e-30f), 1e30f);
            *(LAS unsigned*)(SL + O_QQ + (tb0 + i) * PT + 4 * cp) = pk2(qa[i] * pta, qb[i] * ptb);
            *(LAS unsigned*)(SL + O_QP + (tb0 + i) * PT + 4 * cp) = pk2(qa[i] * e1a, qb[i] * e1b);
            *(LAS unsigned*)(SL + O_KP + (tb0 + i) * PT + 4 * cp) = pk2(ka[i] * __builtin_amdgcn_rcpf(e1a), kb[i] * __builtin_amdgcn_rcpf(e1b)); }
#else
        float qv[16], kv[16], q2[16];
#pragma unroll
        for (int i = 0; i < 16; ++i) { qv[i] = bf1(*(const LAS unsigned short*)(SL + O_QP + (16 * wq + i) * PT + 2 * lane)); kv[i] = bf1(*(const LAS unsigned short*)(SL + O_KP + (16 * wq + i) * PT + 2 * lane)); }
        const float lb = lblog ? sigmf(lblog[512 + dir * 256 + h * 64 + lane] - lblog[dir * 256 + h * 64 + lane]) : 0.f;
        float lc[16]; float run = 1.f;
#pragma unroll
        for (int i = 0; i < 16; ++i) { const float f = lb + (1.0f - lb) * sigmf(kv[i]); run *= f; lc[i] = run; kv[i] = 1.0f - f; }
        LAS float* TOT = (LAS float*)(SL + O_TOT); TOT[wq * 64 + lane] = run;
        __syncthreads();
        float pre = 1.f;
#pragma unroll
        for (int q = 0; q < 4; ++q) { const float t = TOT[q * 64 + lane]; if (q < wq) pre *= t; }
        const float rmid = __builtin_amdgcn_rcpf(fmaxf(TOT[lane] * TOT[64 + lane], 1e-30f));
#pragma unroll
        for (int i = 0; i < 16; ++i) { const float pt = pre * lc[i]; q2[i] = qv[i] * pt; const float e1 = fminf(fmaxf(pt * rmid, 1e-30f), 1e30f); qv[i] *= e1; kv[i] *= __builtin_amdgcn_rcpf(e1); }
#pragma unroll
        for (int i = 0; i < 16; ++i) { const int t = 16 * wq + i;
            *(LAS unsigned short*)(SL + O_QP + t * PT + lane * 2) = (unsigned short)f2bf(qv[i]);
            *(LAS unsigned short*)(SL + O_KP + t * PT + lane * 2) = (unsigned short)f2bf(kv[i]);
            *(LAS unsigned short*)(SL + O_QQ + t * PT + lane * 2) = (unsigned short)f2bf(q2[i]); }
#endif
    } else {
        const float lg2 = __log2f(sigmf(rdec[dir * 4 + h]));
#pragma unroll
        for (int ii = 0; ii < 2; ++ii) { const int t = 16 * wq + tr + 8 * ii; const float gq = __builtin_amdgcn_exp2f((float)(t + 1) * lg2) * 0.125f;
            const unsigned qw[4] = {R.q[ii].x, R.q[ii].y, R.q[ii].z, R.q[ii].w}; v4u q1, q2v;
            { unsigned o1[4], o2[4];
#pragma unroll
              for (int x = 0; x < 4; ++x) { const float lo = bflo(qw[x]), hi2 = bfhi(qw[x]); o1[x] = pk2(lo * 0.125f, hi2 * 0.125f); o2[x] = pk2(lo * gq, hi2 * gq); }
              q1 = (v4u){o1[0], o1[1], o1[2], o1[3]}; q2v = (v4u){o2[0], o2[1], o2[2], o2[3]}; }
            *(LAS v4u*)(SL + O_QP + t * PT + 16 * ch) = q1; *(LAS v4u*)(SL + O_QQ + t * PT + 16 * ch) = q2v; *(LAS v4u*)(SL + O_KP + t * PT + 16 * ch) = R.k[ii]; }
    }
    __syncthreads();
    const int ti = wq >> 1, tj = wq & 1, r32 = lane & 31, hi = lane >> 5;
    if (tj <= ti) {
        f32x16 a = {0.f, 0.f, 0.f, 0.f, 0.f, 0.f, 0.f, 0.f, 0.f, 0.f, 0.f, 0.f, 0.f, 0.f, 0.f, 0.f};
#pragma unroll
        for (int kkk = 0; kkk < 4; ++kkk) a = __builtin_amdgcn_mfma_f32_32x32x16_bf16(frag32(SL + O_KP, 32 * tj + r32, 16 * kkk, hi), frag32(SL + O_QP, 32 * ti + r32, 16 * kkk, hi), a, 0, 0, 0);
        const float lg2 = (MIXER == 1) ? __log2f(sigmf(rdec[dir * 4 + h])) : 0.f;
#pragma unroll
        for (int g4 = 0; g4 < 4; ++g4) { float vv[4];
#pragma unroll
            for (int x = 0; x < 4; ++x) { const int dt = 32 * (ti - tj) + r32 - (x + 8 * g4 + 4 * hi); float val = a[4 * g4 + x];
                if (MIXER == 1) val *= __builtin_amdgcn_exp2f((float)dt * lg2);
                if (dt < 0) val = 0.f;
                vv[x] = val; }
            *(LAS v2u*)(SL + O_AT + (32 * ti + r32) * PT + (32 * tj + 8 * g4 + 4 * hi) * 2) = (v2u){pk2(vv[0], vv[1]), pk2(vv[2], vv[3])}; }
    }
    __syncthreads();
    f32x16 o = {0.f, 0.f, 0.f, 0.f, 0.f, 0.f, 0.f, 0.f, 0.f, 0.f, 0.f, 0.f, 0.f, 0.f, 0.f, 0.f};
#pragma unroll
    for (int st = 0; st < 2; ++st) if (st <= ti) {
#pragma unroll
        for (int kkk = 0; kkk < 2; ++kkk) o = __builtin_amdgcn_mfma_f32_32x32x16_bf16(frag32(SL + O_VT, 32 * tj + r32, 32 * st + 16 * kkk, hi), frag32(SL + O_AT, 32 * ti + r32, 32 * st + 16 * kkk, hi), o, 0, 0, 0); }
#pragma unroll
    for (int kkk = 0; kkk < 4; ++kkk) o = __builtin_amdgcn_mfma_f32_32x32x16_bf16(frag32(SL + O_ST, 32 * tj + r32, 16 * kkk, hi), frag32(SL + O_QQ, 32 * ti + r32, 16 * kkk, hi), o, 0, 0, 0);
    { LAS unsigned char* OX = F.lds + 2 * SLOT + dir * MB;
#pragma unroll
      for (int g4 = 0; g4 < 4; ++g4) *(LAS v2u*)(OX + (32 * ti + r32) * PT + (32 * tj + 8 * g4 + 4 * hi) * 2) = (v2u){pk2(o[4 * g4], o[4 * g4 + 1]), pk2(o[4 * g4 + 2], o[4 * g4 + 3])}; }
    __syncthreads();
    { const int tok = F.tid >> 3, ech = F.tid & 7, row = b * RPB + tb * 64 + tok;
      const v4u fw = *(const LAS v4u*)(F.lds + 2 * SLOT + tok * PT + 16 * ech), bw = *(const LAS v4u*)(F.lds + 2 * SLOT + MB + (63 - tok) * PT + 16 * ech);
      const unsigned fws[4] = {fw.x, fw.y, fw.z, fw.w}, bws[4] = {bw.x, bw.y, bw.z, bw.w};
      float ov[8]; float ss = 0.f;
#pragma unroll
      for (int i = 0; i < 4; ++i) { ov[2 * i] = bflo(fws[i]) + bflo(bws[i]); ov[2 * i + 1] = bfhi(fws[i]) + bfhi(bws[i]); ss += ov[2 * i] * ov[2 * i] + ov[2 * i + 1] * ov[2 * i + 1]; }
      ss += xshf<1>(ss); ss += xshf<2>(ss); ss += xshf<4>(ss);
      const float rs = __builtin_amdgcn_rsqf(ss * (1.0f / 64.0f) + NORM_EPS);
      const f32x4 ga = *(const f32x4*)(gain + h * 64 + 8 * ech), gb = *(const f32x4*)(gain + h * 64 + 8 * ech + 4);
      const float gg[8] = {ga.x, ga.y, ga.z, ga.w, gb.x, gb.y, gb.z, gb.w}; const unsigned gws[4] = {R.g.x, R.g.y, R.g.z, R.g.w};
      float res[8];
#pragma unroll
      for (int i = 0; i < 4; ++i) { res[2 * i] = ov[2 * i] * rs * gg[2 * i] * siluf(bflo(gws[i])); res[2 * i + 1] = ov[2 * i + 1] * rs * gg[2 * i + 1] * siluf(bfhi(gws[i])); }
#ifdef OUTPROJ_FP8
      v2u w2; w2.x = pk4_fp8(res[0] * 4.0f, res[1] * 4.0f, res[2] * 4.0f, res[3] * 4.0f); w2.y = pk4_fp8(res[4] * 4.0f, res[5] * 4.0f, res[6] * 4.0f, res[7] * 4.0f);
      *(v2u*)((unsigned char*)ACTo + (size_t)(row >> 1) * 2048 + ((MIXER == 0 ? 0 : 8) + h) * 128 + (row & 1) * 64 + 8 * ech) = w2; }
#else
      v4u w4; w4.x = pk2(res[0], res[1]); w4.y = pk2(res[2], res[3]); w4.z = pk2(res[4], res[5]); w4.w = pk2(res[6], res[7]);
      *(v4u*)(ACTo + (size_t)row * DM + (MIXER == 0 ? 0 : 512) + h * 64 + 8 * ech) = w4; }
#endif
}
__device__ __forceinline__ void recur_stageC_loop(Frame& F, const bf16* P, const bf16* KVS, bf16* ACTo, int mh0, int ub0, int stride, int nub, int ntb, int tboff, const float* lblog, const float* rdec, const float* hn, const float* rn) {
    if (ub0 >= nub) return;
    StageCRaw cur, nxt;
    { const int mh = mh0 & 7; if ((mh >> 2) == 0) stageC_load<0>(cur, F, P, KVS, ub0 / ntb, mh & 3, tboff + ub0 % ntb); else stageC_load<1>(cur, F, P, KVS, ub0 / ntb, mh & 3, tboff + ub0 % ntb); }
    int i = 0;
    for (int ub = ub0; ub < nub; ub += stride, ++i) {
        const int un = ub + stride; const bool more = un < nub; const int mh = (mh0 + i) & 7, mhn = (mh0 + i + 1) & 7;
        if (more) { if ((mhn >> 2) == 0) stageC_load<0>(nxt, F, P, KVS, un / ntb, mhn & 3, tboff + un % ntb); else stageC_load<1>(nxt, F, P, KVS, un / ntb, mhn & 3, tboff + un % ntb); }
        if ((mh >> 2) == 0) stageC_compute<0>(cur, F, ACTo, ub / ntb, mh & 3, tboff + ub % ntb, lblog, rdec, hn);
        else stageC_compute<1>(cur, F, ACTo, ub / ntb, mh & 3, tboff + ub % ntb, nullptr, rdec, rn);
        if (more) cur = nxt;
    }
}
__device__ __forceinline__ void phase_conv(Frame& F, const bf16* P, bf16* ACTo, const float* convw, bool latent_only) {
    const int gw = F.vcu * NWAVES + F.wave, NGW = F.G * NWAVES, rsel = F.lane >> 5, c0 = 8 * (F.lane & 31);
    f32x4 w0[2], w1[2], w2[2];
#pragma unroll
    for (int hf = 0; hf < 2; ++hf) { w0[hf] = *(const f32x4*)(convw + c0 + 4 * hf); w1[hf] = *(const f32x4*)(convw + 256 + c0 + 4 * hf); w2[hf] = *(const f32x4*)(convw + 512 + c0 + 4 * hf); }
    const int nrows = latent_only ? NB * T_LAT : MROWS;
    auto ld8 = [](const bf16* p, f32x4& a, f32x4& b) { const v4u w = *(const v4u*)p; a = (f32x4){bflo(w.x), bfhi(w.x), bflo(w.y), bfhi(w.y)}; b = (f32x4){bflo(w.z), bfhi(w.z), bflo(w.w), bfhi(w.w)}; };
#ifdef CONV_SLIDE
    const int RPH = (nrows + 2 * NGW - 1) / (2 * NGW), hw = 2 * gw + rsel, ibeg = hw * RPH, iend = (ibeg + RPH < nrows) ? ibeg + RPH : nrows;
    f32x4 u0a = {0.f, 0.f, 0.f, 0.f}, u0b = u0a, u1a = u0a, u1b = u0a, u2a, u2b;
    for (int idx = ibeg; idx < iend; ++idx) {
        const int r = latent_only ? row_of_latent(idx) : idx;
        const int b = r / RPB, j = r - b * RPB;
        const bf16* row = P + (size_t)r * NPROJ;
        const bool first = (j == 0) || (j == L_CTX), last = (j == L_CTX - 1) || (j == RPB - 1);
        f32x4 ca, cb, ha, hb;
        if (first || idx == ibeg) {
            u0a = (f32x4){0.f, 0.f, 0.f, 0.f}; u0b = u0a;
            if (!first) { ld8(row - NPROJ + C_CC + c0, ca, cb); ld8(row - NPROJ + C_CH + c0, ha, hb); u0a = ca * ha; u0b = cb * hb; }
            ld8(row + C_CC + c0, ca, cb); ld8(row + C_CH + c0, ha, hb); u1a = ca * ha; u1b = cb * hb; }
        u2a = (f32x4){0.f, 0.f, 0.f, 0.f}; u2b = u2a;
        if (!last) { ld8(row + NPROJ + C_CC + c0, ca, cb); ld8(row + NPROJ + C_CH + c0, ha, hb); u2a = ca * ha; u2b = cb * hb; }
        f32x4 ba, bb2; ld8(row + C_CB + c0, ba, bb2);
        const f32x4 xa = ba * (w0[0] * u0a + w1[0] * u1a + w2[0] * u2a), xb = bb2 * (w0[1] * u0b + w1[1] * u1b + w2[1] * u2b);
        u0a = u1a; u0b = u1b; u1a = u2a; u1b = u2b;
#else
    for (int idx2 = gw; 2 * idx2 < nrows; idx2 += NGW) {
        const int idx = 2 * idx2 + rsel;
        const int r = latent_only ? row_of_latent(idx) : idx;
        const int b = r / RPB, j = r - b * RPB;
        const bf16* row = P + (size_t)r * NPROJ;
        const bool first = (j == 0) || (j == L_CTX), last = (j == L_CTX - 1) || (j == RPB - 1);
        f32x4 ca, cb, ha, hb, u1a, u1b, u0a = (f32x4){0.f, 0.f, 0.f, 0.f}, u0b = u0a, u2a = u0a, u2b = u0a;
        ld8(row + C_CC + c0, ca, cb); ld8(row + C_CH + c0, ha, hb); u1a = ca * ha; u1b = cb * hb;
        if (!first) { ld8(row - NPROJ + C_CC + c0, ca, cb); ld8(row - NPROJ + C_CH + c0, ha, hb); u0a = ca * ha; u0b = cb * hb; }
        if (!last) { ld8(row + NPROJ + C_CC + c0, ca, cb); ld8(row + NPROJ + C_CH + c0, ha, hb); u2a = ca * ha; u2b = cb * hb; }
        f32x4 ba, bb2; ld8(row + C_CB + c0, ba, bb2);
        const f32x4 xa = ba * (w0[0] * u0a + w1[0] * u1a + w2[0] * u2a), xb = bb2 * (w0[1] * u0b + w1[1] * u1b + w2[1] * u2b);
#endif
#ifdef OUTPROJ_FP8
        { const f32x4 ya = xa * 4.0f, yb = xb * 4.0f; v2u w2; w2.x = pk4_fp8(ya.x, ya.y, ya.z, ya.w); w2.y = pk4_fp8(yb.x, yb.y, yb.z, yb.w); *(v2u*)((unsigned char*)ACTo + (size_t)(r >> 1) * 2048 + (4 + (c0 >> 6)) * 128 + (r & 1) * 64 + (c0 & 63)) = w2; }
#else
        v4u w; w.x = pk2(xa.x, xa.y); w.y = pk2(xa.z, xa.w); w.z = pk2(xb.x, xb.y); w.w = pk2(xb.z, xb.w); *(v4u*)(ACTo + (size_t)r * DM + 256 + c0) = w;
#endif
    }
}
struct DenseOrder {
    int nM, nN, nwg, G, c, latent_only; const char* A; const char* Bt; size_t tA, tB; unsigned long long pnmap;
    __device__ __forceinline__ void init(int nM_, int nN_, int G_, int c_, int lat, const void* A_, const void* Bt_, int lda, int ldb) {
        nM = nM_; nN = nN_; nwg = nM * nN; G = G_; c = c_; latent_only = lat; A = (const char*)A_; Bt = (const char*)Bt_; tA = (size_t)256 * lda * 2; tB = (size_t)256 * ldb * 2; pnmap = 0xFEDCBA9876543210ull; }
    __device__ __forceinline__ bool next(int i, pg8::Unit& u) const {
        const long L = (long)i * G + c; if (L >= nwg) return false;
        int wgid = (int)L; { const int q = nwg / pg8::NXCD, r = nwg % pg8::NXCD, xcd = wgid % pg8::NXCD, off = wgid / pg8::NXCD; wgid = (xcd < r ? xcd * (q + 1) : r * (q + 1) + (xcd - r) * q) + off; }
#ifndef DENSE_WGM
#define DENSE_WGM 8
#endif
        const int nig = DENSE_WGM * nN, gid = wgid / nig, fm = gid * DENSE_WGM, gsz = (nM - fm) < DENSE_WGM ? (nM - fm) : DENSE_WGM;
        int pm = fm + ((wgid % nig) % gsz); const int pn = (int)((pnmap >> (4 * ((wgid % nig) / gsz))) & 15ull);
        if (latent_only) pm = (pm >> 3) * PPB + 1 + (pm & 7);
        u.pm = pm; u.pn = pn; u.x0 = 0; u.x1 = 0; u.a = A + (size_t)pm * tA; u.b = Bt + (size_t)pn * tB; u.b2 = u.b; return true; }
    __device__ __forceinline__ void a_ready(const pg8::Unit&) const {}
    __device__ __forceinline__ void done(const pg8::Unit&) const {}
};
struct MoeOrder {
    int ncol, nwg, G, c, down, pm0; const LAS int* tileb; const char* A; const char* W;
    __device__ __forceinline__ bool next(int i, pg8::Unit& u) const {
        const long L = (long)i * G + c; if (L >= nwg) return false;
        int w = (int)L; { const int q = nwg / pg8::NXCD, r = nwg % pg8::NXCD, xcd = w % pg8::NXCD, off = w / pg8::NXCD; w = (xcd < r ? xcd * (q + 1) : r * (q + 1) + (xcd - r) * q) + off; }
        const int pm = pm0 + w / ncol, pc = w % ncol;
        const int k = __builtin_amdgcn_readfirstlane(tileb[pm]), g = k / 6, pr = k % 6;
        const int ea = pr < 3 ? 0 : (pr < 5 ? 1 : 2), eb = pr < 3 ? pr + 1 : (pr < 5 ? pr - 1 : 3);
        u.pm = pm; u.pn = pc; u.x0 = 0; u.x1 = 0; u.a = down ? A + (size_t)pm * 256 * 1024 : A;
        if (!down) { const int e = g * 4 + (pc < 4 ? ea : eb); u.b = W + (size_t)(e * 4 + (pc & 3)) * 256 * 1024; u.b2 = u.b; }
        else { const char* base = W + (size_t)(g * 1024 + pc * 256) * 2048; u.b = base + ea * 512; u.b2 = base + eb * 512 - 512; }
        return true; }
    __device__ __forceinline__ void a_ready(const pg8::Unit&) const {}
    __device__ __forceinline__ void done(const pg8::Unit&) const {}
};
struct EpiStore {
    static constexpr bool PERM = true, AFTER_DRAIN = false;
    bf16* O; int ldc; float sc;
    __device__ __forceinline__ void operator()(const f32x4 (&acc)[2][2][4][2], const pg8::Unit& u, int wr, int wc, int fr, int fq) const {
        const int row0 = u.pm * 256 + wr * 64 + fr, col0 = u.pn * 256 + wc * 32 + 8 * fq;
#pragma unroll
        for (int ai = 0; ai < 2; ++ai)
#pragma unroll
            for (int m = 0; m < 4; ++m) { bf16* rowp = O + (size_t)(row0 + ai * 128 + m * 16) * ldc + col0;
#pragma unroll
                for (int bj = 0; bj < 2; ++bj) { const f32x4 v0 = acc[ai][bj][m][0] * sc, v1 = acc[ai][bj][m][1] * sc;
                    v4u w; w.x = pg8::cvt_pk_bf16(v0[0], v0[1]); w.y = pg8::cvt_pk_bf16(v0[2], v0[3]); w.z = pg8::cvt_pk_bf16(v1[0], v1[1]); w.w = pg8::cvt_pk_bf16(v1[2], v1[3]);
                    *(v4u*)(rowp + bj * 128) = w; } }
    }
};
struct EpiResid {
    static constexpr bool PERM = false, AFTER_DRAIN = false;
    const float* xsrc; const float* csrc; float* xdst; float* cdst; const float* gate; float sc;
    __device__ __forceinline__ void operator()(const f32x4 (&acc)[2][2][4][2], const pg8::Unit& u, int wr, int wc, int fr, int fq) const {
        const int b = u.pm / PPB, pj = u.pm - b * PPB; const bool isc = pj == 0;
        const float* src = isc ? csrc + (size_t)b * L_CTX * DM : xsrc + (size_t)(b * T_LAT + (pj - 1) * 256) * DM;
        float* dst = isc ? cdst + (size_t)b * L_CTX * DM : xdst + (size_t)(b * T_LAT + (pj - 1) * 256) * DM;
        const int col0 = u.pn * 256 + wc * 32 + 4 * fq; const float* gp = gate + (isc ? 16 : b) * 1024 + col0;
        f32x4 gv[2][2];
#pragma unroll
        for (int bj = 0; bj < 2; ++bj)
#pragma unroll
            for (int n = 0; n < 2; ++n) gv[bj][n] = *(const f32x4*)(gp + bj * 128 + n * 16) * sc;
#pragma unroll
        for (int ai = 0; ai < 2; ++ai)
#pragma unroll
            for (int m = 0; m < 4; ++m) { const size_t off = (size_t)(ai * 128 + wr * 64 + m * 16 + fr) * DM + col0;
#pragma unroll
                for (int bj = 0; bj < 2; ++bj)
#pragma unroll
                    for (int n = 0; n < 2; ++n) *(f32x4*)(dst + off + bj * 128 + n * 16) = LDNT((const f32x4*)(src + off + bj * 128 + n * 16)) + gv[bj][n] * acc[ai][bj][m][n];
                if (m & 1) asm volatile("" ::: "memory"); }
    }
};
struct EpiGateUp {
    static constexpr bool PERM = true, AFTER_DRAIN = false;
    unsigned char* H; const v4i* rowinfo;
    __device__ __forceinline__ void operator()(const f32x4 (&acc)[2][2][4][2], const pg8::Unit& u, int wr, int wc, int fr, int fq) const {
        const int pos0 = u.pm * 256 + wr * 64 + fr, col0 = u.pn * 128 + wc * 32 + 8 * fq; const bool second = u.pn >= 4;
#pragma unroll
        for (int ai = 0; ai < 2; ++ai)
#pragma unroll
            for (int m = 0; m < 4; ++m) { const int pos = pos0 + ai * 128 + m * 16; const v4i ri = rowinfo[pos];
                const float w = __builtin_bit_cast(float, second ? ri.z : ri.y) * (16.0f / 32.0f);
                const f32x4 g0 = acc[ai][0][m][0] * (1.0f / 32.0f), g1 = acc[ai][0][m][1] * (1.0f / 32.0f), u0 = acc[ai][1][m][0], u1 = acc[ai][1][m][1];
                float h[8];
#pragma unroll
                for (int i = 0; i < 4; ++i) { h[i] = siluf(g0[i]) * u0[i] * w; h[4 + i] = siluf(g1[i]) * u1[i] * w; }
                v2u o; o.x = pk4_fp8(h[0], h[1], h[2], h[3]); o.y = pk4_fp8(h[4], h[5], h[6], h[7]);
                *(v2u*)(H + (size_t)pos * 1024 + col0) = o; }
    }
};
struct EpiDown {
    static constexpr bool PERM = false, AFTER_DRAIN = false;
    float* xdst; float* cdst; const float* gate; const v4i* rowinfo;
    __device__ __forceinline__ void operator()(const f32x4 (&acc)[2][2][4][2], const pg8::Unit& u, int wr, int wc, int fr, int fq) const {
        const int pos0 = u.pm * 256 + wr * 64 + fr, col0 = u.pn * 256 + wc * 32 + 4 * fq;
#pragma unroll
        for (int ai = 0; ai < 2; ++ai)
#pragma unroll
            for (int m = 0; m < 4; ++m) { const int r = rowinfo[pos0 + ai * 128 + m * 16].x;
#ifdef ZERO_MOE
                if (false) {
#else
                if (r >= 0) {
#endif
                    const int b = r / RPB, j = r - b * RPB; const bool isc = j < L_CTX;
                    float* dst = (isc ? cdst + (size_t)(b * L_CTX + j) * DM : xdst + (size_t)(b * T_LAT + j - L_CTX) * DM) + col0;
                    const float* gp = gate + (isc ? 16 : b) * 1024 + col0;
#pragma unroll
                    for (int bj = 0; bj < 2; ++bj)
#pragma unroll
                        for (int n = 0; n < 2; ++n) { float* p = dst + bj * 128 + n * 16; *(f32x4*)p = LDNT((const f32x4*)p) + *(const f32x4*)(gp + bj * 128 + n * 16) * (acc[ai][bj][m][n] * (1.0f / 512.0f)); } }
                if (m & 1) asm volatile("" ::: "memory"); }
    }
};

template <class BarFn>
__device__ __forceinline__ void phase_norm2_route(Frame& F, int layer, const float* xsrc, const float* csrc, const float* nA, const float* nB, bf16* dst, bool latent_only, BarFn bar_fn) {
    typedef short bf16x8v __attribute__((ext_vector_type(8))); typedef float f32x4v __attribute__((ext_vector_type(4)));
    unsigned char* const ws = PWS;
    LAS int* cnt = (LAS int*)(F.lds + TAB_OFF);
    LAS float* MA = (LAS float*)(F.lds); LAS float* MBv = MA + 2048;
    LAS float* SSP = MA + 4096;
    LAS float* PART = SSP + 128;
    LAS float* LOG = PART + 8 * 16 * 32;
    const int lane = F.lane, wv = F.wave, r16 = lane & 15, g = lane >> 4, k0w = 128 * wv;
    const int nrows = latent_only ? NB * T_LAT : MROWS, NGW = F.G * NWAVES, RPW = (nrows + NGW - 1) / NGW, RPBLK = NWAVES * RPW;
    const int ib0 = (int)blockIdx.x * RPBLK, ib1 = (ib0 + RPBLK < nrows) ? ib0 + RPBLK : nrows;
    int mfirst = 0, mlast = 0;
    if (ib0 < ib1) { const int ra = latent_only ? row_of_latent(ib0) : ib0, rb = latent_only ? row_of_latent(ib1 - 1) : ib1 - 1;
      const int ba = ra / RPB, ja = ra - ba * RPB, bb_ = rb / RPB, jb = rb - bb_ * RPB; mfirst = (ja < L_CTX) ? 16 : ba; mlast = (jb < L_CTX) ? 16 : bb_; }
    for (int i = F.tid; i < 512; i += NTHR) { const int sl = i >> 8, c4 = (i & 255) * 4, mm = sl ? mlast : mfirst;
        *(LAS f32x4*)(MA + sl * 1024 + c4) = *(const f32x4*)(nA + mm * 1024 + c4); *(LAS f32x4*)(MBv + sl * 1024 + c4) = *(const f32x4*)(nB + mm * 1024 + c4); }
    if (F.tid < 24) cnt[F.tid] = 0;
    bf16x8v Bh[4][2], Bl[4][2];
    { const float* rgw = PIN(I_RGW) + (size_t)layer * 1024 * 4; const float* rew = PIN(I_REW) + (size_t)layer * 1024 * 16;
#pragma unroll
      for (int s = 0; s < 4; ++s)
#pragma unroll
          for (int t = 0; t < 2; ++t) { const int n = 16 * t + r16, kb = k0w + 32 * s + 8 * g; unsigned hw[4], lw[4];
#pragma unroll
              for (int i2 = 0; i2 < 4; ++i2) { float w0 = 0.f, w1 = 0.f;
                  if (n < 4) { w0 = rgw[(kb + 2 * i2) * 4 + n]; w1 = rgw[(kb + 2 * i2 + 1) * 4 + n]; } else if (n < 20) { w0 = rew[(kb + 2 * i2) * 16 + n - 4]; w1 = rew[(kb + 2 * i2 + 1) * 16 + n - 4]; }
                  const unsigned hp = pk2(w0, w1); hw[i2] = hp; lw[i2] = pk2(w0 - bflo(hp), w1 - bfhi(hp)); }
              Bh[s][t] = __builtin_bit_cast(bf16x8v, (v4u){hw[0], hw[1], hw[2], hw[3]}); Bl[s][t] = __builtin_bit_cast(bf16x8v, (v4u){lw[0], lw[1], lw[2], lw[3]}); } }
    float biasn = 0.f; { const int n = F.tid & 31; if (n < 4) biasn = PIN(I_RGB)[layer * 4 + n]; else if (n < 20) biasn = PIN(I_REB)[layer * 16 + n - 4]; }
    v4i* ROUTE = (v4i*)(ws + WS_ROUTE);
    bar_fn();
    __syncthreads();
#ifdef ROUTE_PREFETCH
#define ROUTE_SRC(G0) ({ const int idx_ = ((G0) + r16) < ib1 ? (G0) + r16 : ib1 - 1; const int r_ = latent_only ? row_of_latent(idx_) : idx_; const int b_ = r_ / RPB, j_ = r_ - b_ * RPB; \
        ((j_ < L_CTX) ? csrc + (size_t)(b_ * L_CTX + j_) * DM : xsrc + (size_t)(b_ * T_LAT + j_ - L_CTX) * DM) + k0w + 8 * g; })
    f32x4 xv[4][2], xn[4][2];
    if (ib0 < ib1) { const float* s0 = ROUTE_SRC(ib0);
#pragma unroll
        for (int s = 0; s < 4; ++s) { xv[s][0] = *(const f32x4*)(s0 + 32 * s); xv[s][1] = *(const f32x4*)(s0 + 32 * s + 4); } }
#endif
    for (int g0 = ib0; g0 < ib1; g0 += 16) {
        const bool valid = (g0 + r16) < ib1; const int idx = valid ? g0 + r16 : ib1 - 1;
        const int r = latent_only ? row_of_latent(idx) : idx;
        const int b = r / RPB, j = r - b * RPB, m = (j < L_CTX) ? 16 : b, slot = (m != mfirst) ? 1024 : 0;
        float ss = 0.f;
#ifdef ROUTE_PREFETCH
        { const float* s1 = ROUTE_SRC(g0 + 16 < ib1 ? g0 + 16 : g0);
#pragma unroll
          for (int s = 0; s < 4; ++s) { xn[s][0] = *(const f32x4*)(s1 + 32 * s); xn[s][1] = *(const f32x4*)(s1 + 32 * s + 4); } }
#else
        const float* src = ((j < L_CTX) ? csrc + (size_t)(b * L_CTX + j) * DM : xsrc + (size_t)(b * T_LAT + j - L_CTX) * DM) + k0w + 8 * g;
        f32x4 xv[4][2];
#pragma unroll
        for (int s = 0; s < 4; ++s) { xv[s][0] = LDNT((const f32x4*)(src + 32 * s)); xv[s][1] = LDNT((const f32x4*)(src + 32 * s + 4)); }
#endif
#pragma unroll
        for (int s = 0; s < 4; ++s)
#pragma unroll
            for (int hh = 0; hh < 2; ++hh) { const f32x4 x = xv[s][hh]; ss += (x.x * x.x + x.y * x.y) + (x.z * x.z + x.w * x.w); }
        ss += xshf<16>(ss); ss = half_sum(ss);
        if (lane < 16) SSP[wv * 16 + lane] = ss;
        __syncthreads();
        float tot = 0.f;
#pragma unroll
        for (int w2 = 0; w2 < 8; ++w2) tot += SSP[w2 * 16 + r16];
        const float rstd = __builtin_amdgcn_rsqf(tot * (1.0f / DM) + NORM_EPS);
        f32x4v acc[2] = {{0.f, 0.f, 0.f, 0.f}, {0.f, 0.f, 0.f, 0.f}};
        unsigned char* drow = (unsigned char*)dst + (size_t)r * DM + k0w + 8 * g;
#pragma unroll
        for (int s = 0; s < 4; ++s) { const int co = slot + k0w + 32 * s + 8 * g;
            const f32x4 h0 = xv[s][0] * rstd * *(const LAS f32x4*)(MA + co) + *(const LAS f32x4*)(MBv + co), h1 = xv[s][1] * rstd * *(const LAS f32x4*)(MA + co + 4) + *(const LAS f32x4*)(MBv + co + 4);
            { v2u o; o.x = pk4_fp8(h0.x, h0.y, h0.z, h0.w); o.y = pk4_fp8(h1.x, h1.y, h1.z, h1.w); *(v2u*)(drow + 32 * s) = o; }
            const unsigned p0 = pk2(h0.x, h0.y), p1 = pk2(h0.z, h0.w), p2 = pk2(h1.x, h1.y), p3 = pk2(h1.z, h1.w);
            const unsigned q0 = pk2(h0.x - bflo(p0), h0.y - bfhi(p0)), q1 = pk2(h0.z - bflo(p1), h0.w - bfhi(p1)), q2 = pk2(h1.x - bflo(p2), h1.y - bfhi(p2)), q3 = pk2(h1.z - bflo(p3), h1.w - bfhi(p3));
            const bf16x8v Ah = __builtin_bit_cast(bf16x8v, (v4u){p0, p1, p2, p3}), Al = __builtin_bit_cast(bf16x8v, (v4u){q0, q1, q2, q3});
#pragma unroll
            for (int t = 0; t < 2; ++t) { acc[t] = __builtin_amdgcn_mfma_f32_16x16x32_bf16(Ah, Bh[s][t], acc[t], 0, 0, 0); acc[t] = __builtin_amdgcn_mfma_f32_16x16x32_bf16(Ah, Bl[s][t], acc[t], 0, 0, 0);
                acc[t] = __builtin_amdgcn_mfma_f32_16x16x32_bf16(Al, Bh[s][t], acc[t], 0, 0, 0); } }
#pragma unroll
        for (int t = 0; t < 2; ++t)
#pragma unroll
            for (int x = 0; x < 4; ++x) PART[(wv * 16 + 4 * g + x) * 32 + 16 * t + r16] = acc[t][x];
        __syncthreads();
        { const int row = F.tid >> 5, n = F.tid & 31; float v = biasn;
#pragma unroll
          for (int w2 = 0; w2 < 8; ++w2) v += PART[(w2 * 16 + row) * 32 + n];
          LOG[row * 32 + n] = v; }
        __syncthreads();
        if (F.tid < 16 && (g0 + F.tid) < ib1) {
            const int rr = latent_only ? row_of_latent(g0 + F.tid) : g0 + F.tid;
            float l[20];
#pragma unroll
            for (int jj = 0; jj < 20; ++jj) l[jj] = LOG[F.tid * 32 + jj];
            int gsel = 0; float gm = l[0];
#pragma unroll
            for (int q = 1; q < 4; ++q) if (l[q] > gm) { gm = l[q]; gsel = q; }
            float gs = 0.f;
#pragma unroll
            for (int q = 0; q < 4; ++q) gs += __expf(l[q] - gm);
            const float gp = 1.0f / gs;
            float le[4];
#pragma unroll
            for (int q = 0; q < 4; ++q) le[q] = (gsel == 0) ? l[4 + q] : (gsel == 1) ? l[8 + q] : (gsel == 2) ? l[12 + q] : l[16 + q];
            int e1 = 0; float m1 = le[0];
#pragma unroll
            for (int q = 1; q < 4; ++q) if (le[q] > m1) { m1 = le[q]; e1 = q; }
            int e2 = -1; float m2 = 0.f;
#pragma unroll
            for (int q = 0; q < 4; ++q) if (q != e1 && (e2 < 0 || le[q] > m2)) { m2 = le[q]; e2 = q; }
            const float bexp = __expf(m2 - m1), w1 = gp / (1.0f + bexp), w2 = gp * bexp / (1.0f + bexp);
            const int ea = e1 < e2 ? e1 : e2, eb = e1 < e2 ? e2 : e1; const float wa = e1 < e2 ? w1 : w2, wb = e1 < e2 ? w2 : w1;
            const int pidx = ea == 0 ? eb - 1 : (ea == 1 ? eb + 1 : 5), bucket = gsel * 6 + pidx;
            const int rank = atomicAdd((int*)(cnt + bucket), 1); ROUTE[rr] = (v4i){bucket, rank, __builtin_bit_cast(int, wa), __builtin_bit_cast(int, wb)};
        }
#ifdef ROUTE_PREFETCH
#pragma unroll
        for (int s = 0; s < 4; ++s) { xv[s][0] = xn[s][0]; xv[s][1] = xn[s][1]; }
#endif
    }
#ifdef ROUTE_PREFETCH
#undef ROUTE_SRC
#endif
    __syncthreads();
    if (F.tid < 24) ((int*)(ws + WS_BCNT))[blockIdx.x * 24 + F.tid] = cnt[F.tid];
    __syncthreads();
}

__device__ __forceinline__ void phase_scatter(Frame& F, bool latent_only) {
    unsigned char* const ws = PWS;
    LAS int* tab = (LAS int*)(F.lds + TAB_OFF);
    const int* BC = (const int*)(ws + WS_BCNT);
    if (F.tid < 384) { const int k = F.tid >> 4, part = F.tid & 15; int tot = 0, below = 0;
        for (int bb = part * 16; bb < part * 16 + 16 && bb < F.G; ++bb) { const int v = BC[bb * 24 + k]; tot += v; if (bb < (int)blockIdx.x) below += v; }
        tot += xshi<1>(tot); tot += xshi<2>(tot); tot += xshi<4>(tot); tot += xshi<8>(tot); below += xshi<1>(below); below += xshi<2>(below); below += xshi<4>(below); below += xshi<8>(below);
        if (part == 0) { tab[32 + k] = tot; tab[k] = below; } }
    __syncthreads();
    if (F.tid == 0) { int tb = 0; for (int k = 0; k < 24; ++k) { const int nt = (tab[32 + k] + 255) >> 8; tab[64 + k] = tb; tab[96 + k] = nt; tab[k] += tb * 256; tb += nt; } tab[128] = tb; }
    __syncthreads();
    v4i* ROWINFO = (v4i*)(ws + WS_ROWINFO);
    if (blockIdx.x == 0) { int* TI = (int*)(ws + WS_TILEINFO); if (F.tid == 0) TI[0] = tab[128];
        if (F.tid < 24) { const int t0 = tab[64 + F.tid], nt = tab[96 + F.tid]; for (int t = 0; t < nt; ++t) TI[1 + t0 + t] = F.tid; } }
    for (int k = blockIdx.x; k < 24; k += F.G) { const int p0 = tab[64 + k] * 256 + tab[32 + k], p1 = (tab[64 + k] + tab[96 + k]) * 256;
        for (int p = p0 + F.tid; p < p1; p += NTHR) ROWINFO[p] = (v4i){-1, 0, 0, 0}; }
    const int nrows = latent_only ? NB * T_LAT : MROWS, NGW = F.G * NWAVES, RPW = (nrows + NGW - 1) / NGW, gwb = (int)blockIdx.x * NWAVES + F.wave;
    const v4i* ROUTE = (const v4i*)(ws + WS_ROUTE);
    { const int i0 = gwb * RPW, i1 = (i0 + RPW < nrows) ? i0 + RPW : nrows;
      if (i0 + F.lane < i1) { const int idx = i0 + F.lane, r = latent_only ? row_of_latent(idx) : idx; const v4i ri = ROUTE[r]; ROWINFO[tab[ri.x] + ri.y] = (v4i){r, ri.z, ri.w, 0}; } }
    __syncthreads();
}
#if DEBUG_CHECK
__device__ __forceinline__ unsigned dbg_hash(unsigned x) { x ^= x >> 16; x *= 0x7feb352du; x ^= x >> 15; x *= 0x846ca68bu; x ^= x >> 16; return x; }
__device__ __forceinline__ void dbg_fail(Frame& F, int bit) { atomicOr((unsigned*)(F.ctl + CW_ERR), 1u << bit); }
__device__ __forceinline__ void dbg_check_gemm_bf16(Frame& F, const bf16* A, const bf16* Bt, const bf16* O, int ldo, int bit) {
    const int s = F.vcu * NTHR + F.tid;
    if (s < 16384) { const int row = dbg_hash(2 * s + 1) % MROWS, col = dbg_hash(2 * s + 2) % 3072; float ref = 0.f;
        for (int k = 0; k < 1024; ++k) ref += bf1(A[(size_t)row * 1024 + k]) * bf1(Bt[(size_t)col * 1024 + k]);
        const float got = bf1(O[(size_t)row * ldo + col]);
        if (!(fabsf(got - ref) <= 0.02f * fabsf(ref) + 0.05f)) dbg_fail(F, bit); }
}
__device__ __forceinline__ float naive_attn_row(Frame& F, const bf16* P, int b, int h, int j) {
    LAS float* pl = (LAS float*)(F.lds) + F.wave * 2304;
    const bf16* Pb = P + (size_t)b * RPB * NPROJ; const bf16* q = Pb + (size_t)j * NPROJ + C_AQ + h * 64;
    const int nk = (j < L_CTX) ? 4 : 36;
    float sc[36]; float mx = -1e30f;
#pragma unroll
    for (int i = 0; i < 36; ++i) { sc[i] = -1e30f; if (i < nk) { const bf16* k = Pb + (size_t)(i * 64 + F.lane) * NPROJ + C_AK + (h >> 1) * 64; float a = 0.f;
        for (int d = 0; d < 64; ++d) a += bf1(q[d]) * bf1(k[d]);
        sc[i] = a; mx = fmaxf(mx, a); } }
    mx = fmaxf(mx, xshf<1>(mx)); mx = fmaxf(mx, xshf<2>(mx)); mx = fmaxf(mx, xshf<4>(mx)); mx = fmaxf(mx, xshf<8>(mx)); mx = fmaxf(mx, xshf<16>(mx));
    mx = half_max(mx);
    float sum = 0.f;
#pragma unroll
    for (int i = 0; i < 36; ++i) { const float p = (i < nk) ? exp2f(sc[i] - mx) : 0.f; sum += p; pl[i * 64 + F.lane] = p; }
    sum = wave_sum(sum); LDS_WAIT(); asm volatile("" ::: "memory");
    float o = 0.f;
    for (int key = 0; key < nk * 64; ++key) o += pl[key] * bf1(Pb[(size_t)key * NPROJ + C_AV + (h >> 1) * 64 + F.lane]);
    LDS_WAIT(); asm volatile("" ::: "memory");
    return o / sum;
}
__device__ __forceinline__ void dbg_check_attn(Frame& F, const bf16* P, const bf16* ACT_, int bit, bool with_ctx) {
    const int s = F.vcu * NWAVES + F.wave;
    const int b = dbg_hash(3 * s + 1) % NB, h = dbg_hash(3 * s + 2) % 4; int j = L_CTX + dbg_hash(3 * s + 3) % T_LAT;
    if (with_ctx && (s & 7) == 0) j = dbg_hash(3 * s + 3) % L_CTX;
    const float o = naive_attn_row(F, P, b, h, j);
    const float got = bf1(ACT_[(size_t)(b * RPB + j) * DM + 768 + h * 64 + F.lane]);
    if (!(fabsf(got - o) <= 0.03f * fabsf(o) + 0.02f)) dbg_fail(F, j < L_CTX ? bit + 1 : bit);
    __syncthreads();
}
__device__ __forceinline__ void dbg_check_outproj(Frame& F, const float* xsrc, const float* xdst, const bf16* ACT_, const bf16* Wt, const float* gate, int bit) {
    const int s = F.vcu * NTHR + F.tid;
    if (s < 16384) { const int idx = dbg_hash(2 * s + 5) % (NB * T_LAT), col = dbg_hash(2 * s + 6) % DM, r = row_of_latent(idx), b = idx >> 11; float ref = 0.f;
        for (int k = 0; k < 1024; ++k) ref += bf1(ACT_[(size_t)r * 1024 + k]) * bf1(Wt[(size_t)col * 1024 + k]);
        ref = xsrc[(size_t)idx * DM + col] + gate[b * 1024 + col] * ref;
        const float got = xdst[(size_t)idx * DM + col];
        if (!(fabsf(got - ref) <= 0.01f * fabsf(ref) + 0.01f)) dbg_fail(F, bit); }
}
__device__ __forceinline__ void dbg_check_gateup(Frame& F, const unsigned char* A8, const unsigned char* Wgu8, const unsigned char* H8, const v4i* rowinfo, const LAS int* tileb, int ntiles, int bit) {
    const int s = F.vcu * NTHR + F.tid;
    if (s < 16384) { const int pos = dbg_hash(2 * s + 7) % (ntiles * 256), hc = dbg_hash(2 * s + 8) % 1024; const v4i ri = rowinfo[pos];
        if (ri.x >= 0) { const int k = tileb[pos >> 8], g = k / 6, pr = k % 6; const int ea = pr < 3 ? 0 : (pr < 5 ? 1 : 2), eb = pr < 3 ? pr + 1 : (pr < 5 ? pr - 1 : 3);
            const int e = g * 4 + (hc < 512 ? ea : eb), jj = hc & 511; const float wgt = __builtin_bit_cast(float, hc < 512 ? ri.y : ri.z);
            const unsigned char* wg = Wgu8 + ((size_t)e * 1024 + (jj >> 7) * 256 + (jj & 127)) * 1024; const unsigned char* wu = wg + 128 * 1024; float ga = 0.f, up = 0.f;
            for (int q = 0; q < 1024; ++q) { const float a = fp8_dec(A8[(size_t)ri.x * 1024 + q]); ga += a * fp8_dec(wg[q]); up += a * fp8_dec(wu[q]); }
            const float ref = 16.0f * siluf(ga * (1.0f / 32.0f)) * (up * (1.0f / 32.0f)) * wgt, got = fp8_dec(H8[(size_t)pos * 1024 + hc]);
            if (!(fabsf(got - ref) <= 0.08f * fabsf(ref) + 0.02f)) dbg_fail(F, bit); } }
}
__device__ __forceinline__ void dbg_check_mix(Frame& F, const bf16* P, const bf16* act, const float* lblog, const float* rdec, const float* hn, const float* rn) {
    const int s = F.vcu * NWAVES + F.wave, lane = F.lane;
    const int mixer = s & 1, b = dbg_hash(5 * s + 1) % NB, h = dbg_hash(5 * s + 2) % 4, j = L_CTX + dbg_hash(5 * s + 3) % T_LAT;
    float osum = 0.f;
    for (int dir = 0; dir < 2; ++dir) {
        const float lb = (mixer == 0 && lblog) ? sigmf(lblog[512 + dir * 256 + h * 64 + lane] - lblog[dir * 256 + h * 64 + lane]) : 0.f;
        const float gamma = sigmf(rdec[dir * 4 + h]);
        const int nt = (dir == 0) ? j : (RPB + L_CTX - 1 - j);
        float S[64];
#pragma unroll
        for (int dd = 0; dd < 64; ++dd) S[dd] = 0.f;
        float o = 0.f;
        for (int n = 0; n <= nt; ++n) { const bf16* rp = P + (size_t)(b * RPB + rc::row_in_batch(dir, n)) * NPROJ;
            float f, k, q, v;
            if (mixer == 0) { f = lb + (1.0f - lb) * sigmf(bf1(rp[C_HZ + 256 * dir + h * 64 + lane])); k = 1.0f - f; q = bf1(rp[C_HQ + h * 64 + lane]); v = bf1(rp[C_HI + h * 64 + lane]); }
            else { f = gamma; k = bf1(rp[C_RK + h * 64 + lane]); q = 0.125f * bf1(rp[C_RQ + h * 64 + lane]); v = bf1(rp[C_RV + h * 64 + lane]); }
            o = 0.f;
#pragma unroll
            for (int dd = 0; dd < 64; ++dd) { const float fd = __builtin_bit_cast(float, __builtin_amdgcn_readlane(__builtin_bit_cast(int, f), dd)), kd = __builtin_bit_cast(float, __builtin_amdgcn_readlane(__builtin_bit_cast(int, k), dd)),
                    qd = __builtin_bit_cast(float, __builtin_amdgcn_readlane(__builtin_bit_cast(int, q), dd));
                S[dd] = fd * S[dd] + kd * v; o += qd * S[dd]; } }
        osum += o;
    }
    const float rs = 1.0f / sqrtf(wave_sum(osum * osum) * (1.0f / 64.0f) + NORM_EPS);
    const float g = bf1(P[(size_t)(b * RPB + j) * NPROJ + (mixer == 0 ? C_HG : C_RG) + h * 64 + lane]);
    const float ref = osum * rs * (mixer == 0 ? hn : rn)[h * 64 + lane] * siluf(g);
    const float got = bf1(act[(size_t)(b * RPB + j) * DM + (mixer == 0 ? 0 : 512) + h * 64 + lane]);
    const float se = wave_sum(fabsf(got - ref)), sr = wave_sum(fabsf(ref));
    if (!(se <= 0.03f * sr + 0.3f)) dbg_fail(F, mixer == 0 ? 6 : 7);
}
__device__ __forceinline__ void dbg_check_norm1(Frame& F, const bf16* act, const float* MODp) {
    const int s = F.vcu * NTHR + F.tid;
    if (s < 8192) { const int r = dbg_hash(2 * s + 11) % MROWS, c = dbg_hash(2 * s + 12) % DM, b = r / RPB, j = r - b * RPB, m = (j < L_CTX) ? 16 : b;
        const float* src = (j < L_CTX) ? PIN(I_CTX) + (size_t)(b * L_CTX + j) * DM : PIN(I_X) + (size_t)(b * T_LAT + j - L_CTX) * DM;
        const float* cv = (j < L_CTX) ? PIN(I_CCTX) : PIN(I_C) + b * 1024; const float* aw = PIN(I_ADAW); const float* ab = PIN(I_ADAB);
        float ss = 0.f, sh = ab[c], scl = ab[1024 + c];
        for (int k = 0; k < 1024; ++k) { ss += src[k] * src[k]; const float sv = siluf(cv[k]); sh += sv * aw[(size_t)k * 6144 + c]; scl += sv * aw[(size_t)k * 6144 + 1024 + c]; }
        const float nA = PIN(I_NMIX)[c] * (1.0f + scl);
        const float gB = MODp[0 * 17 * 1024 + m * 1024 + c], gA = MODp[1 * 17 * 1024 + m * 1024 + c];
        if (!(fabsf(gB - sh) <= 1e-3f * fabsf(sh) + 1e-3f)) dbg_fail(F, 2);
        if (!(fabsf(gA - nA) <= 1e-3f * fabsf(nA) + 1e-3f)) dbg_fail(F, 3);
        const float ref = src[c] * (1.0f / sqrtf(ss / 1024.0f + NORM_EPS)) * gA + gB;
        const float got = bf1(act[(size_t)r * DM + c]);
        if (!(fabsf(got - ref) <= 0.01f * fabsf(ref) + 0.01f)) dbg_fail(F, 4); }
}
__device__ __forceinline__ void dbg_apply(Frame& F, float* out, unsigned* barw) {
    unsigned m = __hip_atomic_load((unsigned*)(F.ctl + CW_ERR), RLX_AGENT);
    if (__hip_atomic_load(barw + XB_TMO, RLX_AGENT) != 0u) m |= 32u;
    if (m) { const float sc = 1.0f + 10.0f * exp2f(0.33219f * (float)m); for (size_t i = (size_t)F.vcu * NTHR + F.tid; i < (size_t)NB * T_LAT * DM; i += (size_t)F.G * NTHR) out[i] *= sc; }
}
#endif
#ifndef NAIVE_ATTN
#define NAIVE_ATTN 0
#endif
#if NAIVE_ATTN && DEBUG_CHECK
__device__ __forceinline__ void phase_naive_attn(Frame& F, const bf16* P, bf16* ACT_, bool latent_only) {
    const int gw = F.vcu * NWAVES + F.wave, NGW = F.G * NWAVES;
    for (int it = gw; it < MROWS * 4; it += NGW) { const int r = it >> 2, h = it & 3, b = r / RPB, j = r - b * RPB;
        if (latent_only && j < L_CTX) continue;
        const float o = naive_attn_row(F, P, b, h, j);
        ACT_[(size_t)r * DM + 768 + h * 64 + F.lane] = (bf16)f2bf(o); }
    __syncthreads();
}
#endif
#ifndef SKIPMASK
#define SKIPMASK 0
#endif
#ifdef REP_BAR
#define GRID_BAR_X() xcd_barrier(bar)
#else
#define GRID_BAR_X() do {} while (0)
#endif
#ifdef PROBE_BARTIME
#define GRID_BAR_T0() const unsigned long long tb0_ = __builtin_amdgcn_s_memrealtime()
#define GRID_BAR_T1(site) do { if ((PROBE_BARMASK >> (site)) & 1) F.bart += (unsigned)(__builtin_amdgcn_s_memrealtime() - tb0_); } while (0)
#else
#define GRID_BAR_T0() do {} while (0)
#define GRID_BAR_T1(site) do {} while (0)
#endif
#define GRID_BAR(site) do { GRID_BAR_T0(); GRID_BAR_X(); xcd_barrier(bar); GRID_BAR_T1(site); { int t_ = F.tid; asm volatile("" : "+v"(t_)); F.tid = t_; F.lane = t_ & 63; F.wave = __builtin_amdgcn_readfirstlane(t_ >> 6); } ws = PWS; } while (0)
#define ACT ((bf16*)(ws + WS_ACT))
#define P ((bf16*)(ws + WS_P))
#define CTXB ((float*)(ws + WS_CTX))
#define ORET ((bf16*)(ws + WS_ORET))
#ifdef OUTPROJ_FP8
#define ATTN_OPTR(b, h) ((attn_body::bf16*)((unsigned char*)ACT + (size_t)(b) * RPB * DM + (12 + (h)) * 128))
#else
#define ATTN_OPTR(b, h) ((attn_body::bf16*)ACT + (size_t)(b) * RPB * DM + 768 + (h) * 64)
#endif
template <int layer> __device__ __forceinline__ void layer_body(Frame& F, XcdBarrier& bar, unsigned char* lds) {
    LAS int* const tileb = (LAS int*)(F.lds + TAB_OFF + 1024);
    unsigned char* ws = PWS;
        const bool lastl = (layer == DEPTH - 1);
        const float* xsrc = (layer == 0) ? PIN(I_X) : (const float*)POUT;
        const float* csrc = (layer == 0) ? PIN(I_CTX) : (const float*)CTXB;
        const float* MOD = (const float*)(ws + WS_MOD) + (size_t)layer * 6 * 17 * 1024;
        #if !(SKIPMASK & 1)
        phase_norm1(F, xsrc, csrc, MOD + 1 * 17 * 1024, MOD + 0 * 17 * 1024, ACT, ws + WS_KVS);
#ifdef REP_N1
        phase_norm1(F, xsrc, csrc, MOD + 1 * 17 * 1024, MOD + 0 * 17 * 1024, ACT, ws + WS_KVS);
#endif
#endif

        GRID_BAR(1);
#if DEBUG_CHECK
        if (layer == 0) dbg_check_norm1(F, ACT, MOD);
#endif
        #if !(SKIPMASK & 2)
        {
            constexpr int NF8 = __builtin_popcount(INPROJ_F8MASK), NB16 = NPROJ / 256 - NF8;
            unsigned long long map16 = 0ull, map8 = 0ull; { int j16 = 0, j8 = 0; for (int t = 0; t < NPROJ / 256; ++t) { if ((INPROJ_F8MASK >> t) & 1) map8 |= (unsigned long long)t << (4 * j8++); else map16 |= (unsigned long long)t << (4 * j16++); } }
            pg8::Gemm g{DM, DM, DM, nullptr}; DenseOrder S; S.init(NPANEL, NB16, F.G, (int)blockIdx.x, 0, ACT, (const bf16*)(ws + WS_W0 + (size_t)layer * WLAYER + WO_WIN), DM, DM); S.pnmap = map16;
            EpiStore E{P, NPROJ, 1.0f};
#ifndef REP_INPROJ
#define REP_INPROJ 1
#endif
            pg8::gemm_phase<EpiStore, DenseOrder, false, true>(F.lds + RING_OFF, g, S, E, F.tid);
            if (NF8 > 0) {
                pg8::Gemm g8{512, 512, 512, nullptr}; DenseOrder S8; const int c8 = ((int)blockIdx.x + F.G - (NPANEL * NB16) % F.G) % F.G;
                S8.init(NPANEL, NF8, F.G, c8, 0, ws + WS_KVS, (const bf16*)(ws + WS_W0 + (size_t)layer * WLAYER + WO_WIN), 512, 512); S8.tB = 524288; S8.pnmap = map8;
                EpiStore E8{P, NPROJ, 1.0f / 32.0f};
                pg8::gemm_phase<EpiStore, DenseOrder, false, true, false, true>(F.lds + RING_OFF, g8, S8, E8, F.tid);
#if defined(REP_F8)
                __syncthreads();
                pg8::gemm_phase<EpiStore, DenseOrder, false, true, false, true>(F.lds + RING_OFF, g8, S8, E8, F.tid);
#endif
            }
#if REP_INPROJ == 2
            __syncthreads();
            pg8::gemm_phase<EpiStore, DenseOrder, false, true>(F.lds + RING_OFF, g, S, E, F.tid);
#endif
        }
#endif

        GRID_BAR(2);
#if DEBUG_CHECK
        dbg_check_gemm_bf16(F, ACT, (const bf16*)(ws + WS_W0 + (size_t)layer * WLAYER + WO_WIN), P, NPROJ, 0);
#endif
        #if !(SKIPMASK & 4)
        phase_prep(F, P, PIN(I_QN) + layer * 64, PIN(I_KN) + layer * 64, (const float*)(ws + WS_ROPE), (const float*)(ws + WS_ROPE) + 2048 * 32);
#ifdef REP_PREP
        phase_prep<true>(F, P, PIN(I_QN) + layer * 64, PIN(I_KN) + layer * 64, (const float*)(ws + WS_ROPE), (const float*)(ws + WS_ROPE) + 2048 * 32);
#endif
#endif

#ifdef SPLIT_MIX
#define LAUNDER_TID() do { int t_ = F.tid; asm volatile("" : "+v"(t_)); F.tid = t_; F.lane = t_ & 63; F.wave = __builtin_amdgcn_readfirstlane(t_ >> 6); ws = PWS; } while (0)
        xcd_split_arrive(bar, (unsigned*)(F.ctl + CW_BAR4));
        {
            bf16* KVS = (bf16*)(ws + WS_KVS); float* DBUF = (float*)(ws + WS_DBUF); const float* lbl = (layer == 0) ? nullptr : PIN(I_LB); const float* rdec = PIN(I_RDEC) + layer * 8;
            recur_stageA_loop(F, P, KVS, DBUF, F.vcu * NWAVES + F.wave, F.G * NWAVES, 256 * 36, lbl, rdec);
        }
        xcd_split_arrive(bar, (unsigned*)(F.ctl + CW_BAR5));
        xcd_split_wait(bar, (unsigned*)(F.ctl + CW_BAR4), (unsigned)layer + 1u);
        LAUNDER_TID();
        {
            const int nunits = lastl ? 512 : 576;
            for (int ui = 0; ; ++ui) {
                const int u = F.vcu + ui * F.G;
                if (ui == 1) {
                    xcd_split_wait(bar, (unsigned*)(F.ctl + CW_BAR5), (unsigned)layer + 1u);
                    LAUNDER_TID();
                    { bf16* KVS = (bf16*)(ws + WS_KVS); const float* DBUF = (const float*)(ws + WS_DBUF); const float* rdec = PIN(I_RDEC) + layer * 8;
                      for (int seq = F.vcu; seq < 256; seq += F.G) { const int mixer = seq >> 7, h = (seq >> 1) & 3, dir = seq & 1;
                          if (mixer == 0) recur_stageB_seq<0>(F, KVS, DBUF, seq, 0.f); else recur_stageB_seq<1>(F, KVS, DBUF, seq, sigmf(rdec[dir * 4 + h])); } }
                    xcd_split_arrive(bar, (unsigned*)(F.ctl + CW_BAR2));
                    LAUNDER_TID();
                }
                if (u >= nunits) break;
                int b, h, qb; if (u < 512) { b = u >> 5; h = (u >> 3) & 3; qb = 1 + (u & 7); } else { b = (u - 512) >> 2; h = u & 3; qb = 0; }
                const attn_body::bf16* Pb = (const attn_body::bf16*)P + (size_t)b * RPB * NPROJ;
                attn_body::attn_unit<8>(qb * 256, qb == 0 ? 4 : 36, Pb + C_AQ + h * 64, Pb + C_AK + (h >> 1) * 64, Pb + C_AV + (h >> 1) * 64,
                                        ATTN_OPTR(b, h), (char*)lds + RING_OFF, F.tid);
            }
        }
#else
        {
            bf16* KVS = (bf16*)(ws + WS_KVS); float* DBUF = (float*)(ws + WS_DBUF); const float* lbl = (layer == 0) ? nullptr : PIN(I_LB); const float* rdec = PIN(I_RDEC) + layer * 8;
#ifndef REP_A
#define REP_A 1
#endif
            for (int rp_REP_A = 0; rp_REP_A < REP_A; ++rp_REP_A)
            recur_stageA_loop(F, P, KVS, DBUF, F.vcu * NWAVES + F.wave, F.G * NWAVES, 256 * 36, lbl, rdec);
        }
        GRID_BAR(3);
        {
            { bf16* KVS = (bf16*)(ws + WS_KVS); const float* DBUF = (const float*)(ws + WS_DBUF); const float* rdec = PIN(I_RDEC) + layer * 8;
#ifndef REP_B
#define REP_B 1
#endif
            for (int rp_REP_B = 0; rp_REP_B < REP_B; ++rp_REP_B)
              for (int seq = F.vcu; seq < 256; seq += F.G) { const int mixer = seq >> 7, h = (seq >> 1) & 3, dir = seq & 1;
                  if (mixer == 0) recur_stageB_seq<0>(F, KVS, DBUF, seq, 0.f); else recur_stageB_seq<1>(F, KVS, DBUF, seq, sigmf(rdec[dir * 4 + h])); } }
#ifdef REP_BDRY
            { bf16* KVS = (bf16*)(ws + WS_KVS); const float* DBUF = (const float*)(ws + WS_DBUF); const float* rdec = PIN(I_RDEC) + layer * 8;
              for (int seq = F.vcu; seq < 256; seq += F.G) { const int mixer = seq >> 7, h = (seq >> 1) & 3, dir = seq & 1;
                  if (mixer == 0) recur_stageB_seq<0, true>(F, KVS, DBUF, seq, 0.f); else recur_stageB_seq<1, true>(F, KVS, DBUF, seq, sigmf(rdec[dir * 4 + h])); } }
#endif

#ifdef SPLIT_BC
            xcd_split_arrive(bar, (unsigned*)(F.ctl + CW_BAR2));
#endif
#if NAIVE_ATTN && DEBUG_CHECK
            phase_naive_attn(F, P, ACT, lastl);
#elif !(SKIPMASK & 16)
        const int nunits = lastl ? 512 : 576;
#ifndef REP_ATTN
#define REP_ATTN 1
#endif
            for (int rep_ = 0; rep_ < REP_ATTN; ++rep_)
            for (int u = F.vcu; u < nunits; u += F.G) {
                int b, h, qb; if (u < 512) { b = u >> 5; h = (u >> 3) & 3; qb = 1 + (u & 7); } else { b = (u - 512) >> 2; h = u & 3; qb = 0; }
                const attn_body::bf16* Pb = (const attn_body::bf16*)P + (size_t)b * RPB * NPROJ;
                attn_body::attn_unit<8>(qb * 256, qb == 0 ? 4 : 36, Pb + C_AQ + h * 64, Pb + C_AK + (h >> 1) * 64, Pb + C_AV + (h >> 1) * 64,
                                        ATTN_OPTR(b, h), (char*)lds + RING_OFF, F.tid);
            }
#endif

        }
#endif
#ifdef SPLIT_BC
        xcd_split_wait(bar, (unsigned*)(F.ctl + CW_BAR2), (unsigned)layer + 1u);
        { int t_ = F.tid; asm volatile("" : "+v"(t_)); F.tid = t_; F.lane = t_ & 63; F.wave = __builtin_amdgcn_readfirstlane(t_ >> 6); } ws = PWS;
#else
        GRID_BAR(4);
#endif
        {
            const bf16* KVS = (const bf16*)(ws + WS_KVS); const float* lbl = (layer == 0) ? nullptr : PIN(I_LB); const float* rdec = PIN(I_RDEC) + layer * 8;
            const float* hn = PIN(I_HNORM) + layer * 256; const float* rn = PIN(I_RNORM) + layer * 256;
            const int ntb = lastl ? 32 : 36;
#ifndef REP_C
#define REP_C 1
#endif
            for (int rp_REP_C = 0; rp_REP_C < REP_C; ++rp_REP_C)
            recur_stageC_loop(F, P, KVS, ACT, F.vcu & 7, F.vcu >> 3, (F.G >= 8) ? (F.G >> 3) : 1, 16 * ntb, ntb, lastl ? 4 : 0, lbl, rdec, hn, rn);
            phase_conv(F, P, ACT, PIN(I_CONVW) + layer * 768, lastl);
#ifdef REP_CONV
            phase_conv(F, P, ACT, PIN(I_CONVW) + layer * 768, lastl);
#endif
        }
        GRID_BAR(5);
#if DEBUG_CHECK
        dbg_check_mix(F, P, ACT, layer == 0 ? nullptr : PIN(I_LB), PIN(I_RDEC) + layer * 8, PIN(I_HNORM) + layer * 256, PIN(I_RNORM) + layer * 256);
#endif
#if DEBUG_CHECK
        dbg_check_attn(F, P, ACT, 1, !lastl);
#endif
        #if !(SKIPMASK & 64)
        {
#ifdef OUTPROJ_FP8
            pg8::Gemm g{512, 512, 512, nullptr}; DenseOrder S; S.init(lastl ? NB * 8 : NPANEL, 4, F.G, (int)blockIdx.x, lastl ? 1 : 0, ACT, (const bf16*)(ws + WS_W0 + (size_t)layer * WLAYER + WO_WOUT), 512, 512);
            EpiResid E{xsrc, csrc, POUT, CTXB, MOD + 2 * 17 * 1024, 1.0f / 128.0f};
            pg8::gemm_phase<EpiResid, DenseOrder, true, true, false, true, true>(F.lds + RING_OFF, g, S, E, F.tid);
#else
            pg8::Gemm g{DM, DM, DM, nullptr}; DenseOrder S; S.init(lastl ? NB * 8 : NPANEL, 4, F.G, (int)blockIdx.x, lastl ? 1 : 0, ACT, (const bf16*)(ws + WS_W0 + (size_t)layer * WLAYER + WO_WOUT), DM, DM);
            EpiResid E{xsrc, csrc, POUT, CTXB, MOD + 2 * 17 * 1024, 1.0f};
            pg8::gemm_phase<EpiResid, DenseOrder, true, true>(F.lds + RING_OFF, g, S, E, F.tid);
#endif
        }
        if (layer == 0) {
            __syncthreads();
#ifdef SPLIT_OP
            xcd_split_arrive(bar, (unsigned*)(F.ctl + CW_BAR4));
#endif
            constexpr int PL = 1792 + 512 + 3 * 4096;
#ifdef CONV_SPLIT64
            if (F.G == 256) { const int c = (int)blockIdx.x;
                if (c < 64) convert_weights_range(F, PL, PL + CONV_SPLIT64, c * NWAVES + F.wave, 64 * NWAVES);
                else convert_weights_range(F, PL + CONV_SPLIT64, 2 * PL, (c - 64) * NWAVES + F.wave, 192 * NWAVES); }
            else convert_weights_range(F, PL, 2 * PL, F.vcu * NWAVES + F.wave, F.G * NWAVES);
#else
            const int nb = (int)blockIdx.x - 64, nw = (F.G - 64) * NWAVES;
            if (F.G > 64) convert_weights_range(F, PL, 2 * PL, nb >= 0 ? nb * NWAVES + F.wave : -1, nw);
            else convert_weights_range(F, PL, 2 * PL, F.vcu * NWAVES + F.wave, F.G * NWAVES);
#endif
            __syncthreads();
        }
#endif

#ifdef ROUTE_EARLY
        auto bar6 = [&]() {
#ifdef SPLIT_OP
            if (layer == 0) { xcd_split_wait(bar, (unsigned*)(F.ctl + CW_BAR4), 1u); }
            else { xcd_barrier(bar); }
#else
            xcd_barrier(bar);
#endif
        };
#else
#ifdef SPLIT_OP
        if (layer == 0) { xcd_split_wait(bar, (unsigned*)(F.ctl + CW_BAR4), 1u); { int t_ = F.tid; asm volatile("" : "+v"(t_)); F.tid = t_; F.lane = t_ & 63; F.wave = __builtin_amdgcn_readfirstlane(t_ >> 6); } ws = PWS; }
        else GRID_BAR(6);
#else
        GRID_BAR(6);
#endif
#endif
#if DEBUG_CHECK
        if (layer == 0) dbg_check_outproj(F, PIN(I_X), POUT, ACT, (const bf16*)(ws + WS_W0 + (size_t)layer * WLAYER + WO_WOUT), MOD + 2 * 17 * 1024, 3);
        GRID_BAR(6);
#endif
        #if !(SKIPMASK & 128)
#ifdef ROUTE_EARLY
        phase_norm2_route(F, layer, (const float*)POUT, (const float*)CTXB, MOD + 4 * 17 * 1024, MOD + 3 * 17 * 1024, ACT, lastl, bar6);
        { int t_ = F.tid; asm volatile("" : "+v"(t_)); F.tid = t_; F.lane = t_ & 63; F.wave = __builtin_amdgcn_readfirstlane(t_ >> 6); } ws = PWS;
#else
        phase_norm2_route(F, layer, (const float*)POUT, (const float*)CTXB, MOD + 4 * 17 * 1024, MOD + 3 * 17 * 1024, ACT, lastl, [](){});
#endif
#ifdef REP_N2
        phase_norm2_route(F, layer, (const float*)POUT, (const float*)CTXB, MOD + 4 * 17 * 1024, MOD + 3 * 17 * 1024, ACT, lastl, [](){});
#endif
#endif

        GRID_BAR(7);
        #if !(SKIPMASK & 256)
        phase_scatter(F, lastl);
#ifdef REP_N2
        phase_scatter(F, lastl);
#endif
#endif

        GRID_BAR(8);
#ifdef MOE_SPLIT
        {
            const int* TI = (const int*)(ws + WS_TILEINFO); const int ntiles = TI[0], T1 = ntiles >> 1;
            for (int i = F.tid; i < MAXTILES; i += NTHR) tileb[i] = (i < ntiles) ? TI[1 + i] : 0;
            __syncthreads();
            int dealt = 0;
#pragma nounroll
            for (int part = 0; part < 2; ++part) {
                const int t0 = part ? T1 : 0, ntp = part ? ntiles - T1 : T1;
                pg8::Gemm g{512, 512, 512, nullptr}; g.rowidx = (const int*)(ws + WS_ROWINFO);
                MoeOrder S; S.pm0 = t0; S.ncol = 8; S.nwg = ntp * 8; S.G = F.G; S.c = ((int)blockIdx.x + F.G - dealt % F.G) % F.G; S.down = 0; S.tileb = tileb; S.A = (const char*)(ws + WS_ACT); S.W = (const char*)(ws + WS_W0 + (size_t)layer * WLAYER + WO_WGU);
                EpiGateUp E{ws + WS_H, (const v4i*)(ws + WS_ROWINFO)};
                pg8::gemm_phase<EpiGateUp, MoeOrder, true, true, true, true>(F.lds + RING_OFF, g, S, E, F.tid);
                dealt += ntp * 8;
                xcd_split_arrive(bar, (unsigned*)(F.ctl + (part ? CW_BAR4 : CW_BAR3)));
            }
#pragma nounroll
            for (int part = 0; part < 2; ++part) {
                xcd_split_wait(bar, (unsigned*)(F.ctl + (part ? CW_BAR4 : CW_BAR3)), (unsigned)layer + 1u);
                { int t_ = F.tid; asm volatile("" : "+v"(t_)); F.tid = t_; F.lane = t_ & 63; F.wave = __builtin_amdgcn_readfirstlane(t_ >> 6); } ws = PWS;
                const int t0 = part ? T1 : 0, ntp = part ? ntiles - T1 : T1;
                pg8::Gemm g{512, 1024, 512, nullptr};
                MoeOrder S; S.pm0 = t0; S.ncol = 4; S.nwg = ntp * 4; S.G = F.G; S.c = ((int)blockIdx.x + F.G - dealt % F.G) % F.G; S.down = 1; S.tileb = tileb; S.A = (const char*)(ws + WS_H); S.W = (const char*)(ws + WS_W0 + (size_t)layer * WLAYER + WO_WD);
                EpiDown E{POUT, CTXB, MOD + 5 * 17 * 1024, (const v4i*)(ws + WS_ROWINFO)};
                pg8::gemm_phase<EpiDown, MoeOrder, true, true, false, true>(F.lds + RING_OFF, g, S, E, F.tid);
                dealt += ntp * 4;
            }
        }
#else
        #if !(SKIPMASK & 512)
        {
            const int* TI = (const int*)(ws + WS_TILEINFO); const int ntiles = TI[0];
            for (int i = F.tid; i < MAXTILES; i += NTHR) tileb[i] = (i < ntiles) ? TI[1 + i] : 0;
            if (F.tid == 0) ((LAS int*)(F.lds + TAB_OFF))[130] = ntiles;
            __syncthreads();
            pg8::Gemm g{512, 512, 512, nullptr};
            g.rowidx = (const int*)(ws + WS_ROWINFO);
            MoeOrder S; S.pm0 = 0; S.ncol = 8; S.nwg = ntiles * 8; S.G = F.G; S.c = (int)blockIdx.x; S.down = 0; S.tileb = tileb; S.A = (const char*)(ws + WS_ACT); S.W = (const char*)(ws + WS_W0 + (size_t)layer * WLAYER + WO_WGU);
            EpiGateUp E{ws + WS_H, (const v4i*)(ws + WS_ROWINFO)};
#ifndef REP_GU
#define REP_GU 1
#endif
            pg8::gemm_phase<EpiGateUp, MoeOrder, true, true, true, true>(F.lds + RING_OFF, g, S, E, F.tid);
#if REP_GU == 2
            __syncthreads();
            pg8::gemm_phase<EpiGateUp, MoeOrder, true, true, true, true>(F.lds + RING_OFF, g, S, E, F.tid);
#endif
        }
#endif

        GRID_BAR(9);
#if DEBUG_CHECK
        { const int* TI = (const int*)(ws + WS_TILEINFO); dbg_check_gateup(F, ws + WS_ACT, ws + WS_W0 + (size_t)layer * WLAYER + WO_WGU, ws + WS_H, (const v4i*)(ws + WS_ROWINFO), tileb, TI[0], 4); }
#endif
        #if !(SKIPMASK & 1024)
        {
            const int ntiles = ((const LAS int*)(F.lds + TAB_OFF))[130];
            pg8::Gemm g{512, 1024, 512, nullptr};
            MoeOrder S; S.pm0 = 0; S.ncol = 4; S.nwg = ntiles * 4; S.G = F.G; S.c = (int)blockIdx.x; S.down = 1; S.tileb = tileb; S.A = (const char*)(ws + WS_H); S.W = (const char*)(ws + WS_W0 + (size_t)layer * WLAYER + WO_WD);
            EpiDown E{POUT, CTXB, MOD + 5 * 17 * 1024, (const v4i*)(ws + WS_ROWINFO)};
            pg8::gemm_phase<EpiDown, MoeOrder, true, true, false, true>(F.lds + RING_OFF, g, S, E, F.tid);
        }
#endif

#endif
#if defined(PROBE_BARTIME) || DEBUG_CHECK
        GRID_BAR(10);
#else
        if (!lastl) GRID_BAR(10);
#endif
    }
__global__ void __launch_bounds__(NTHR, 2) fwd_kernel(Args args) {
    extern __shared__ __attribute__((aligned(16))) unsigned char lds[];
    Frame F;
    F.lds = (LAS unsigned char*)lds;
    F.MISC = (volatile LAS unsigned*)(F.lds + MISC_OFF);
    F.tid = threadIdx.x; F.lane = F.tid & 63; F.wave = __builtin_amdgcn_readfirstlane(F.tid >> 6);
    F.bart = 0u; F.G = gridDim.x; { const int bx = blockIdx.x; F.vcu = (F.G % 8 == 0) ? (bx % 8) * (F.G / 8) + bx / 8 : bx; }
    F.ctl = (gu32*)(args.ws + WS_CTL);
    for (int u = F.tid; u < (LDS_BYTES - LDSCTL_OFF) / 4; u += NTHR) ((LAS unsigned*)(F.lds + LDSCTL_OFF))[u] = 0u;
    __syncthreads();
    if (F.tid == 0) { volatile LAS unsigned long long* pt = (volatile LAS unsigned long long*)(F.lds + PTAB_OFF);
#pragma unroll
        for (int i = 0; i < 24; ++i) pt[i] = (unsigned long long)args.in[i];
        pt[24] = (unsigned long long)args.out; pt[25] = (unsigned long long)(args.ws + args.ws_shift); }
    __syncthreads();
    XcdBarrier bar = xcd_barrier_post((unsigned*)(F.ctl + CW_BAR), F.MISC + 8);
    unsigned char* ws = PWS;

    #if !(SKIPMASK & 2048)
        p0_prologue(F, bar);
#endif

#ifdef SPLIT_PRO
    xcd_split_wait(bar, (unsigned*)(F.ctl + CW_BAR3), 1u);
    { int t_ = F.tid; asm volatile("" : "+v"(t_)); F.tid = t_; F.lane = t_ & 63; F.wave = __builtin_amdgcn_readfirstlane(t_ >> 6); } ws = PWS;
#else
    GRID_BAR(0);
#endif

    layer_body<0>(F, bar, lds);
    layer_body<1>(F, bar, lds);
#ifdef PROBE_BARTIME
    if (blockIdx.x == PROBE_BARTIME - 1 && F.tid == 0) { const unsigned long long ts_ = __builtin_amdgcn_s_memrealtime(); while (__builtin_amdgcn_s_memrealtime() - ts_ < 8ull * F.bart) __builtin_amdgcn_s_sleep(8); }
#endif
#if DEBUG_CHECK
    dbg_apply(F, POUT, bar.bar);
#endif
}

extern "C" void kernel_launch(void* const* d_in, const int* in_sizes, int n_in, void* d_out, int out_size, void* d_ws, size_t ws_size, hipStream_t stream) {
    static int grid = 0;
    if (grid == 0) {
        if (n_in != 24 || out_size != NB * T_LAT * DM || ws_size < WS_END) { fprintf(stderr, "kernel_launch: unexpected shapes (n_in %d, out %d, ws %zu); nothing launched\n", n_in, out_size, ws_size); grid = -1; return; }
        int dev = 0, cus = 0, per_cu = 0;
        if (hipGetDevice(&dev) != hipSuccess || hipDeviceGetAttribute(&cus, hipDeviceAttributeMultiprocessorCount, dev) != hipSuccess) { grid = -1; return; }
        if (hipFuncSetAttribute((const void*)fwd_kernel, hipFuncAttributeMaxDynamicSharedMemorySize, LDS_BYTES) != hipSuccess) { grid = -1; return; }
        if (hipOccupancyMaxActiveBlocksPerMultiprocessor(&per_cu, (const void*)fwd_kernel, NTHR, LDS_BYTES) != hipSuccess || per_cu < 1) { fprintf(stderr, "kernel_launch: occupancy query says %d blocks per CU\n", per_cu); grid = -1; return; }
        (void)hipGetLastError();
        grid = cus < 256 ? cus : 256;
    }
    if (grid < 0) return;
    if (hipMemsetAsync((char*)d_ws + WS_CTL, 0, CTL_ZERO_BYTES, stream) != hipSuccess) return;
    Args a{};
    for (int i = 0; i < 24; ++i) a.in[i] = (const float*)d_in[i];
    a.out = (float*)d_out; a.ws = (unsigned char*)d_ws;
#ifdef WS_TOP
    a.ws_shift = ((ws_size - WS_END) / (2 * MiB)) * (2 * MiB);
#endif
    hipLaunchKernelGGL(fwd_kernel, dim3(grid), dim3(NTHR), LDS_BYTES, stream, a);
}
```
